# Optimizing an MI355X kernel written in HIP

```python
import math
import jax
import jax.numpy as jnp
from jax import lax
import numpy as np

D_MODEL = 1024
BATCH = 32
SEQ = 256
DEPTH = 4
DEC_BATCH = 4
DEC_SEQ = 2048
PAST_LEN = 256

GRID_W = 64
SSD_EXPAND = 2
D_SSD = SSD_EXPAND * D_MODEL
SSD_HEADDIM = 64
SSD_HEADS = D_SSD // SSD_HEADDIM
SSD_GROUPS = 8
D_STATE = 128
D_CONV = 5
SSD_CHUNK = 128
CONV_DIM = D_SSD + 2 * SSD_GROUPS * D_STATE
HGRN_HEADS = 8
HGRN_KDIM = 128
HGRN_FDIM = HGRN_HEADS * HGRN_KDIM
HGRN_WIDTH = D_MODEL
HGRN_VDIM = HGRN_WIDTH // HGRN_HEADS
HGRN_CHUNK = 16
N_BRANCHES = 2
IN_COLS = CONV_DIM + D_SSD + 2 * SSD_HEADS + HGRN_FDIM + 2 * HGRN_FDIM + 2 * HGRN_WIDTH + N_BRANCHES * D_MODEL
FFN_HIDDEN = ((8 * D_MODEL + 767) // 768) * 256
RMS_EPS = 1e-6

kernel_name = "hybrid_ssd_hgrn2_diffusion_step"


def _rmsnorm(x, w):
    x32 = x.astype(jnp.float32)
    y = x32 * lax.rsqrt(jnp.mean(x32 * x32, axis=-1, keepdims=True) + RMS_EPS)
    return (y * w.astype(jnp.float32)).astype(x.dtype)


def _centred_dwconv_silu(u, w, b):
    length = u.shape[-2]
    pad = D_CONV // 2
    up = jnp.pad(u, [(0, 0)] * (u.ndim - 2) + [(pad, pad), (0, 0)])
    out = b
    for k in range(D_CONV):
        out = out + up[..., k:k + length, :] * w[k]
    return jax.nn.silu(out)


def _carry_chunk_states(chunk_decay, chunk_contrib, s0):
    def step(s, inp):
        d, u = inp
        return d * s + u, s
    s_final, starts = lax.scan(step, s0, (jnp.moveaxis(chunk_decay, 1, 0), jnp.moveaxis(chunk_contrib, 1, 0)))
    return jnp.moveaxis(starts, 0, 1), s_final


def _ssd_scan(x, dt, a_neg, bmat, cmat, s0):
    f32 = jnp.float32
    bt, length, n_heads, hd = x.shape
    g, n = bmat.shape[2], bmat.shape[3]
    r = n_heads // g
    q = SSD_CHUNK
    nc = length // q
    xg = x.astype(f32).reshape(bt, nc, q, g, r, hd)
    dtg = dt.astype(f32).reshape(bt, nc, q, g, r)
    bg = bmat.astype(f32).reshape(bt, nc, q, g, n)
    cg = cmat.astype(f32).reshape(bt, nc, q, g, n)
    cs = jnp.cumsum(dtg * a_neg.astype(f32).reshape(g, r), axis=2)
    causal = jnp.tril(jnp.ones((q, q), dtype=bool))[:, :, None, None]
    decay = jnp.exp(jnp.where(causal, cs[:, :, :, None] - cs[:, :, None, :], -jnp.inf))
    cb = jnp.einsum("bcign,bcjgn->bcijg", cg, bg)
    xdt = dtg[..., None] * xg
    y_diag = jnp.einsum("bcijgr,bcjgrp->bcigrp", cb[..., None] * decay, xdt)
    to_end = jnp.exp(cs[:, :, -1:] - cs)
    contrib = jnp.einsum("bcjgn,bcjgrp->bcgrpn", bg, to_end[..., None] * xdt)
    chunk_decay = jnp.exp(cs[:, :, -1])[..., None, None]
    starts, s_fin = _carry_chunk_states(chunk_decay, contrib, s0.astype(f32).reshape(bt, g, r, hd, n))
    y_off = jnp.einsum("bcign,bcgrpn->bcigrp", cg, starts) * jnp.exp(cs)[..., None]
    y = (y_diag + y_off).reshape(bt, length, n_heads, hd)
    return y.astype(x.dtype), s_fin.reshape(bt, n_heads, hd, n).astype(x.dtype)


def _hgrn2_scan(q, log_f, k, v, s0):
    f32 = jnp.float32
    bt, length, n_heads, kd = q.shape
    vd = v.shape[-1]
    c = HGRN_CHUNK
    nc = length // c
    qc = q.astype(f32).reshape(bt, nc, c, n_heads, kd)
    kc = k.astype(f32).reshape(bt, nc, c, n_heads, kd)
    vc = v.astype(f32).reshape(bt, nc, c, n_heads, vd)
    b = jnp.cumsum(log_f.astype(f32).reshape(bt, nc, c, n_heads, kd), axis=2)
    causal = jnp.tril(jnp.ones((c, c), dtype=bool))[:, :, None, None]
    decay = jnp.exp(jnp.where(causal, b[:, :, :, None] - b[:, :, None, :], -jnp.inf))
    attn = jnp.einsum("bcihk,bcijhk,bcjhk->bcijh", qc, decay, kc)
    o_intra = jnp.einsum("bcijh,bcjhv->bcihv", attn, vc)
    contrib = jnp.einsum("bcjhk,bcjhv->bchkv", kc * jnp.exp(b[:, :, -1:] - b), vc)
    chunk_decay = jnp.exp(b[:, :, -1])[..., None]
    starts, s_fin = _carry_chunk_states(chunk_decay, contrib, s0.astype(f32))
    o_off = jnp.einsum("bcihk,bchkv->bcihv", qc * jnp.exp(b), starts)
    o = (o_intra + o_off).reshape(bt, length, n_heads, vd)
    return o.astype(q.dtype), s_fin.astype(q.dtype)


def _hybrid_mixer(h, lw, lb, s_ssm0, s_hgrn0, latent):
    f32 = jnp.float32
    bt, length, _ = h.shape
    proj = h @ lw["w_in"]
    cuts = np.cumsum([CONV_DIM, D_SSD, 2 * SSD_HEADS, HGRN_FDIM, 2 * HGRN_FDIM, HGRN_WIDTH, HGRN_WIDTH]).tolist()
    xbc, z, dt_raw, hq, hf, hi, hg, gate_logits = jnp.split(proj, cuts, axis=-1)

    if latent:
        rows = length // GRID_W
        xbc = _centred_dwconv_silu(xbc.reshape(bt, rows, GRID_W, CONV_DIM), lw["ssd_conv_w"], lw["ssd_conv_b"]).reshape(bt, length, CONV_DIM)
    else:
        xbc = _centred_dwconv_silu(xbc, lw["ssd_conv_w"], lw["ssd_conv_b"])
    xs, bm, cm = jnp.split(xbc, [D_SSD, D_SSD + SSD_GROUPS * D_STATE], axis=-1)
    xs = xs.reshape(bt, length, SSD_HEADS, SSD_HEADDIM)
    bm = bm.reshape(bt, length, SSD_GROUPS, D_STATE)
    cm = cm.reshape(bt, length, SSD_GROUPS, D_STATE)
    dt = jax.nn.softplus(dt_raw.astype(f32).reshape(bt, length, 2, SSD_HEADS) + lw["ssd_dt_bias"].astype(f32))
    a_neg = -jnp.exp(lw["ssd_a_log"].astype(f32))
    y_f, sf = _ssd_scan(xs, dt[:, :, 0], a_neg[0], bm, cm, s_ssm0[:, 0])
    y_b, sb = _ssd_scan(xs[:, ::-1], dt[:, ::-1, 1], a_neg[1], bm[:, ::-1], cm[:, ::-1], s_ssm0[:, 1])
    y = y_f + y_b[:, ::-1] + lw["ssd_d"][:, None] * xs
    y = y.reshape(bt, length, D_SSD) * jax.nn.silu(z)
    y = _rmsnorm(y.reshape(bt, length, SSD_GROUPS, D_SSD // SSD_GROUPS), lw["ssd_norm_w"].reshape(SSD_GROUPS, -1)).reshape(bt, length, D_SSD)
    y_ssd = y @ lw["w_ssd_out"]

    q = jax.nn.silu(hq).reshape(bt, length, HGRN_HEADS, HGRN_KDIM)
    v = hi.reshape(bt, length, HGRN_HEADS, HGRN_VDIM)
    u = hf.astype(f32).reshape(bt, length, 2, HGRN_HEADS, HGRN_KDIM)
    lb3 = lb.reshape(2, HGRN_HEADS, HGRN_KDIM)
    log_f = jnp.logaddexp(jnp.log(lb3), jnp.log1p(-lb3) + jax.nn.log_sigmoid(u))
    k = -jnp.expm1(log_f)
    o_f, hf_state = _hgrn2_scan(q, log_f[:, :, 0], k[:, :, 0], v, s_hgrn0[:, 0])
    o_b, hb_state = _hgrn2_scan(q[:, ::-1], log_f[:, ::-1, 1], k[:, ::-1, 1], v[:, ::-1], s_hgrn0[:, 1])
    o = o_f + o_b[:, ::-1]
    o = _rmsnorm(o, lw["hgrn_norm_w"].reshape(HGRN_HEADS, HGRN_VDIM)).reshape(bt, length, HGRN_WIDTH) * jax.nn.silu(hg)
    y_hgrn = o @ lw["w_hgrn_out"]

    g_ssd, g_hgrn = jnp.split(jax.nn.sigmoid(gate_logits), N_BRANCHES, axis=-1)
    out = (g_ssd * y_ssd + g_hgrn * y_hgrn) @ lw["w_out"]
    return out, jnp.stack([sf, sb], axis=1), jnp.stack([hf_state, hb_state], axis=1)


def _layer(x, mod, lw, lb, s_ssm0, s_hgrn0, latent):
    sh_m, sc_m, g_m, sh_f, sc_f, g_f = jnp.split(mod, 6, axis=-1)
    h = _rmsnorm(x, lw["norm_mix_w"]) * (1 + sc_m) + sh_m
    mix, s_ssm, s_hgrn = _hybrid_mixer(h, lw, lb, s_ssm0, s_hgrn0, latent)
    x = x + g_m * mix
    h = _rmsnorm(x, lw["norm_ffn_w"]) * (1 + sc_f) + sh_f
    ffn = (jax.nn.silu(h @ lw["ffn_w1"]) * (h @ lw["ffn_w3"])) @ lw["ffn_w2"]
    x = x + g_f * ffn
    return x, s_ssm, s_hgrn


def setup_inputs(seed: int = 0) -> dict:
    key = jax.random.key(seed)
    ks = jax.random.split(key, 26)
    f32 = jnp.float32

    def nrm(k, shape, scale):
        return jax.random.normal(k, shape, f32) * scale

    dt0 = jnp.exp(jax.random.uniform(ks[13], (DEPTH, 2, SSD_HEADS), f32, math.log(1e-3), math.log(1e-1)))
    return {
        "x_prompt": nrm(ks[0], (BATCH, SEQ, D_MODEL), 1.0),
        "x_sample": nrm(ks[1], (DEC_BATCH, DEC_SEQ, D_MODEL), 1.0),
        "c": nrm(ks[2], (DEC_BATCH, D_MODEL), 1.0),
        "state_ssm": nrm(ks[3], (DEC_BATCH, DEPTH, 2, SSD_HEADS, SSD_HEADDIM, D_STATE), 0.3),
        "state_hgrn": nrm(ks[4], (DEC_BATCH, DEPTH, 2, HGRN_HEADS, HGRN_KDIM, HGRN_VDIM), 0.5),
        "c_ctx": nrm(ks[5], (D_MODEL,), 1.0),
        "norm_mix_w": 1.0 + nrm(ks[6], (DEPTH, D_MODEL), 0.02),
        "norm_ffn_w": 1.0 + nrm(ks[7], (DEPTH, D_MODEL), 0.02),
        "ada_w": nrm(ks[8], (DEPTH, D_MODEL, 6 * D_MODEL), 0.5 * D_MODEL ** -0.5),
        "ada_b": nrm(ks[9], (DEPTH, 6 * D_MODEL), 0.02),
        "w_in": nrm(ks[10], (DEPTH, D_MODEL, IN_COLS), D_MODEL ** -0.5),
        "ssd_conv_w": nrm(ks[11], (DEPTH, D_CONV, CONV_DIM), D_CONV ** -0.5),
        "ssd_conv_b": nrm(ks[12], (DEPTH, CONV_DIM), 0.02),
        "ssd_dt_bias": dt0 + jnp.log(-jnp.expm1(-dt0)),
        "ssd_a_log": jnp.log(jax.random.uniform(ks[14], (DEPTH, 2, SSD_HEADS), f32, 1.0, 16.0)),
        "ssd_d": 1.0 + nrm(ks[15], (DEPTH, SSD_HEADS), 0.1),
        "ssd_norm_w": 1.0 + nrm(ks[16], (DEPTH, D_SSD), 0.02),
        "hgrn_lower_bounds": nrm(ks[17], (DEPTH, 2, HGRN_FDIM), 1.0),
        "hgrn_norm_w": 1.0 + nrm(ks[18], (DEPTH, HGRN_WIDTH), 0.02),
        "w_ssd_out": nrm(ks[19], (DEPTH, D_SSD, D_MODEL), D_SSD ** -0.5),
        "w_hgrn_out": nrm(ks[20], (DEPTH, HGRN_WIDTH, D_MODEL), HGRN_WIDTH ** -0.5),
        "w_out": nrm(ks[21], (DEPTH, D_MODEL, D_MODEL), D_MODEL ** -0.5),
        "ffn_w1": nrm(ks[22], (DEPTH, D_MODEL, FFN_HIDDEN), D_MODEL ** -0.5),
        "ffn_w3": nrm(ks[23], (DEPTH, D_MODEL, FFN_HIDDEN), D_MODEL ** -0.5),
        "ffn_w2": nrm(ks[24], (DEPTH, FFN_HIDDEN, D_MODEL), FFN_HIDDEN ** -0.5),
        "norm_final_w": 1.0 + nrm(ks[25], (D_MODEL,), 0.02),
    }


def reference(x_prompt, x_sample, c, state_ssm, state_hgrn, c_ctx, norm_mix_w, norm_ffn_w, ada_w, ada_b, w_in,
              ssd_conv_w, ssd_conv_b, ssd_dt_bias, ssd_a_log, ssd_d, ssd_norm_w, hgrn_lower_bounds, hgrn_norm_w,
              w_ssd_out, w_hgrn_out, w_out, ffn_w1, ffn_w3, ffn_w2, norm_final_w):
    lb_all = jnp.cumsum(jax.nn.softmax(hgrn_lower_bounds.astype(jnp.float32), axis=0), axis=0)
    lb_all = lb_all - lb_all[:1]
    bp = x_prompt.shape[0]
    zero_ssm = jnp.zeros((bp, 2, SSD_HEADS, SSD_HEADDIM, D_STATE), x_prompt.dtype)
    zero_hgrn = jnp.zeros((bp, 2, HGRN_HEADS, HGRN_KDIM, HGRN_VDIM), x_prompt.dtype)
    ctx, lat = x_prompt, x_sample
    ssm_states, hgrn_states = [], []
    for l in range(DEPTH):
        lw = {
            "norm_mix_w": norm_mix_w[l], "norm_ffn_w": norm_ffn_w[l], "w_in": w_in[l],
            "ssd_conv_w": ssd_conv_w[l], "ssd_conv_b": ssd_conv_b[l], "ssd_dt_bias": ssd_dt_bias[l],
            "ssd_a_log": ssd_a_log[l], "ssd_d": ssd_d[l], "ssd_norm_w": ssd_norm_w[l],
            "hgrn_norm_w": hgrn_norm_w[l], "w_ssd_out": w_ssd_out[l], "w_hgrn_out": w_hgrn_out[l],
            "w_out": w_out[l], "ffn_w1": ffn_w1[l], "ffn_w3": ffn_w3[l], "ffn_w2": ffn_w2[l],
        }
        mod_ctx = (jax.nn.silu(c_ctx) @ ada_w[l] + ada_b[l])[None, None, :]
        mod_lat = (jax.nn.silu(c) @ ada_w[l] + ada_b[l])[:, None, :]
        ctx, s_ssm, s_hgrn = _layer(ctx, mod_ctx, lw, lb_all[l], zero_ssm, zero_hgrn, False)
        lat, _, _ = _layer(lat, mod_lat, lw, lb_all[l], state_ssm[:, l], state_hgrn[:, l], True)
        ssm_states.append(s_ssm)
        hgrn_states.append(s_hgrn)
    y_prompt = _rmsnorm(ctx, norm_final_w)
    y_sample = _rmsnorm(lat, norm_final_w)
    new_state_ssm = jnp.stack(ssm_states, axis=1)
    new_state_hgrn = jnp.stack(hgrn_states, axis=1)
    return (y_prompt, y_sample, new_state_ssm, new_state_hgrn)
```

```cpp
#include <hip/hip_runtime.h>
#include <hip/hip_cooperative_groups.h>
#include <cstdio>
#include <cstdint>
namespace cg = cooperative_groups;

#ifndef MEGA
#define MEGA 0
#endif

typedef unsigned short bf16_t;
typedef short bf16x8 __attribute__((ext_vector_type(8)));
typedef float f32x4 __attribute__((ext_vector_type(4)));
typedef unsigned u32x4 __attribute__((ext_vector_type(4)));

constexpr int D = 1024, T = 16384, TCTX = 8192, DEPTH = 4;
constexpr int NPROJ = 13376, NPROJ_PAD = 13440;
constexpr int FFN = 2816;
constexpr int C_Z = 4096, C_DT = 6144, C_HQ = 6208, C_HF = 7232, C_HI = 9280, C_HG = 10304, C_GATE = 11328;
constexpr size_t WT_IN = 0;
constexpr size_t WT_SSO = WT_IN + (size_t)NPROJ_PAD * 1024;
constexpr size_t WT_HGO = WT_SSO + (size_t)1024 * 2048;
constexpr size_t WT_OUT = WT_HGO + (size_t)1024 * 1024;
constexpr size_t WT_W13 = WT_OUT + (size_t)1024 * 1024;
constexpr size_t WT_W2 = WT_W13 + (size_t)5632 * 1024;
constexpr size_t WT_LAYER = WT_W2 + (size_t)1024 * 2816;
constexpr size_t OFF_WT = 0;
constexpr size_t OFF_H = OFF_WT + WT_LAYER * 2 * DEPTH;
constexpr size_t OFF_PROJ = OFF_H + (size_t)T * 1024 * 2;
constexpr size_t OFF_XC = OFF_PROJ + (size_t)T * NPROJ_PAD * 2;
constexpr size_t OFF_DTRAW = OFF_XC + (size_t)T * 4096 * 2;
constexpr size_t OFF_DT = OFF_DTRAW + (size_t)T * 64 * 4;
constexpr size_t OFF_YF = OFF_DT + (size_t)T * 64 * 4;
constexpr size_t OFF_YB = OFF_YF + (size_t)T * 2048 * 4;
constexpr size_t OFF_OF = OFF_YB + (size_t)T * 2048 * 4;
constexpr size_t OFF_OB = OFF_OF + (size_t)T * 1024 * 4;
constexpr size_t OFF_YBUF = OFF_OB + (size_t)T * 1024 * 4;
constexpr size_t OFF_OBUF = OFF_YBUF + (size_t)T * 2048 * 2;
constexpr size_t OFF_MBUF = OFF_OBUF + (size_t)T * 1024 * 2;
constexpr size_t OFF_MOD = OFF_MBUF + (size_t)T * 1024 * 2;
constexpr size_t OFF_LB = OFF_MOD + (size_t)DEPTH * 5 * 6144 * 4;
constexpr size_t OFF_END = OFF_LB + (size_t)DEPTH * 2 * 1024 * 4;
constexpr size_t OUT_SSM = (size_t)T * 1024;
constexpr size_t OUT_HGRN = OUT_SSM + (size_t)32 * 4 * 2 * 32 * 64 * 128;

constexpr int SMEM_BYTES = 73728;
constexpr int LDS_ROW = 144;
constexpr int LDS_TILE = 128 * LDS_ROW;

struct Params {
  const float *x_prompt, *x_sample, *c, *state_ssm, *state_hgrn, *c_ctx, *norm_mix_w, *norm_ffn_w, *ada_w, *ada_b, *w_in,
      *ssd_conv_w, *ssd_conv_b, *ssd_dt_bias, *ssd_a_log, *ssd_d, *ssd_norm_w, *hgrn_lb, *hgrn_norm_w, *w_ssd_out, *w_hgrn_out,
      *w_out, *ffn_w1, *ffn_w3, *ffn_w2, *norm_final_w;
  float* out;
  char* ws;
};

__device__ __forceinline__ bf16_t f2bf(float f) {
  unsigned u = __float_as_uint(f);
  u += 0x7fffu + ((u >> 16) & 1u);
  return (bf16_t)(u >> 16);
}
__device__ __forceinline__ float bf2f(bf16_t b) { return __uint_as_float(((unsigned)b) << 16); }
__device__ __forceinline__ unsigned pack2(float a, float b) { return (unsigned)f2bf(a) | ((unsigned)f2bf(b) << 16); }
__device__ __forceinline__ float sigmoidf_(float x) { return 1.0f / (1.0f + __expf(-x)); }
__device__ __forceinline__ float siluf_(float x) { return x / (1.0f + __expf(-x)); }
__device__ __forceinline__ float clamp30(float x) { return fminf(fmaxf(x, -30.f), 30.f); }
__device__ __forceinline__ float gate_ratio(float g1, float g2) { return (1.0f + __expf(-clamp30(g2))) / (1.0f + __expf(-clamp30(g1))); }
__device__ __forceinline__ int mod_row(int tok) { return tok < TCTX ? 0 : 1 + ((tok - TCTX) >> 11); }

__device__ void phase_setup(const Params& p, char* smem) {
  const int tid = threadIdx.x, bid = blockIdx.x, G = gridDim.x;
  {
    const size_t n4 = (size_t)T * 1024 / 4, half4 = (size_t)TCTX * 1024 / 4;
    float4* dst = (float4*)p.out;
    const float4* s0 = (const float4*)p.x_prompt;
    const float4* s1 = (const float4*)p.x_sample;
    for (size_t i = (size_t)bid * 256 + tid; i < n4; i += (size_t)G * 256) dst[i] = i < half4 ? s0[i] : s1[i - half4];
  }
  {
    float* lb = (float*)(p.ws + OFF_LB);
    for (int i = bid * 256 + tid; i < 2048; i += G * 256) {
      float v0 = p.hgrn_lb[i], v1 = p.hgrn_lb[2048 + i], v2 = p.hgrn_lb[4096 + i], v3 = p.hgrn_lb[6144 + i];
      float m = fmaxf(fmaxf(v0, v1), fmaxf(v2, v3));
      float e0 = expf(v0 - m), e1 = expf(v1 - m), e2 = expf(v2 - m), e3 = expf(v3 - m);
      float inv = 1.0f / (e0 + e1 + e2 + e3);
      lb[i] = 0.f;
      lb[2048 + i] = e1 * inv;
      lb[4096 + i] = (e1 + e2) * inv;
      lb[6144 + i] = (e1 + e2 + e3) * inv;
    }
  }
  {
    float* sm = (float*)smem;
    float* modb = (float*)(p.ws + OFF_MOD);
    __syncthreads();
    for (int i = tid; i < 5 * 1024; i += 256) {
      int v = i >> 10, k = i & 1023;
      float cv = v == 0 ? p.c_ctx[k] : p.c[(v - 1) * 1024 + k];
      sm[i] = siluf_(cv);
    }
    __syncthreads();
    float* part = sm + 5 * 1024;
    for (int item = bid; item < DEPTH * 96; item += G) {
      int l = item / 96, cg_ = item % 96;
      int col = cg_ * 64 + (tid & 63), kg = tid >> 6;
      const float* w = p.ada_w + (size_t)l * 1024 * 6144 + col;
      float a0 = 0, a1 = 0, a2 = 0, a3 = 0, a4 = 0;
      for (int k = kg * 256; k < kg * 256 + 256; ++k) {
        float wv = w[(size_t)k * 6144];
        a0 += sm[k] * wv; a1 += sm[1024 + k] * wv; a2 += sm[2048 + k] * wv; a3 += sm[3072 + k] * wv; a4 += sm[4096 + k] * wv;
      }
      __syncthreads();
      part[(kg * 5 + 0) * 64 + (tid & 63)] = a0; part[(kg * 5 + 1) * 64 + (tid & 63)] = a1; part[(kg * 5 + 2) * 64 + (tid & 63)] = a2;
      part[(kg * 5 + 3) * 64 + (tid & 63)] = a3; part[(kg * 5 + 4) * 64 + (tid & 63)] = a4;
      __syncthreads();
      for (int i = tid; i < 320; i += 256) {
        int v = i >> 6, cc = i & 63;
        float s = part[(0 * 5 + v) * 64 + cc] + part[(1 * 5 + v) * 64 + cc] + part[(2 * 5 + v) * 64 + cc] + part[(3 * 5 + v) * 64 + cc];
        int colo = cg_ * 64 + cc;
        modb[((size_t)l * 5 + v) * 6144 + colo] = s + p.ada_b[l * 6144 + colo];
      }
    }
    __syncthreads();
  }
  {
    float* tile = (float*)smem;
    const int n_in = 210 * 16, n_sso = 16 * 32, n_hgo = 16 * 16, n_out = 16 * 16, n_w13 = 88 * 16, n_w2 = 16 * 44;
    const int per_layer = n_in + n_sso + n_hgo + n_out + n_w13 + n_w2;
    for (int it = bid; it < per_layer * DEPTH; it += G) {
      int l = it / per_layer, r = it % per_layer;
      bf16_t* wt = (bf16_t*)(p.ws + OFF_WT) + (size_t)l * WT_LAYER;
      const float *src0 = nullptr, *src1 = nullptr;
      int K, Nsrc, nt, kt;
      bf16_t* dst;
      bool zero = false;
      if (r < n_in) {
        nt = r / 16; kt = r % 16; K = 1024; Nsrc = NPROJ;
        dst = wt + WT_IN;
        if (nt >= 209) zero = true;
        src0 = p.w_in + (size_t)l * 1024 * NPROJ + nt * 64; src1 = src0 + 32;
      } else if ((r -= n_in) < n_sso) {
        nt = r / 32; kt = r % 32; K = 2048; Nsrc = 1024; dst = wt + WT_SSO;
        src0 = p.w_ssd_out + (size_t)l * 2048 * 1024 + nt * 64; src1 = src0 + 32;
      } else if ((r -= n_sso) < n_hgo) {
        nt = r / 16; kt = r % 16; K = 1024; Nsrc = 1024; dst = wt + WT_HGO;
        src0 = p.w_hgrn_out + (size_t)l * 1024 * 1024 + nt * 64; src1 = src0 + 32;
      } else if ((r -= n_hgo) < n_out) {
        nt = r / 16; kt = r % 16; K = 1024; Nsrc = 1024; dst = wt + WT_OUT;
        src0 = p.w_out + (size_t)l * 1024 * 1024 + nt * 64; src1 = src0 + 32;
      } else if ((r -= n_out) < n_w13) {
        nt = r / 16; kt = r % 16; K = 1024; Nsrc = FFN; dst = wt + WT_W13;
        src0 = p.ffn_w1 + (size_t)l * 1024 * FFN + nt * 32; src1 = p.ffn_w3 + (size_t)l * 1024 * FFN + nt * 32;
      } else {
        r -= n_w13;
        nt = r / 44; kt = r % 44; K = 2816; Nsrc = 1024; dst = wt + WT_W2;
        src0 = p.ffn_w2 + (size_t)l * 2816 * 1024 + nt * 64; src1 = src0 + 32;
      }
      __syncthreads();
      {
        int c4 = (tid & 15) * 4;
        const float* s = c4 < 32 ? src0 + c4 : src1 + (c4 - 32);
#pragma unroll
        for (int i = 0; i < 4; ++i) {
          int kr = (tid >> 4) + i * 16;
          float4 v = zero ? make_float4(0.f, 0.f, 0.f, 0.f) : *(const float4*)(s + (size_t)(kt * 64 + kr) * Nsrc);
          tile[kr * 65 + c4 + 0] = v.x; tile[kr * 65 + c4 + 1] = v.y; tile[kr * 65 + c4 + 2] = v.z; tile[kr * 65 + c4 + 3] = v.w;
        }
      }
      __syncthreads();
#pragma unroll
      for (int i = 0; i < 2; ++i) {
        int cidx = tid + i * 256, n = cidx >> 3, kc = cidx & 7;
        uint4 o;
        o.x = pack2(tile[(kc * 8 + 0) * 65 + n], tile[(kc * 8 + 1) * 65 + n]);
        o.y = pack2(tile[(kc * 8 + 2) * 65 + n], tile[(kc * 8 + 3) * 65 + n]);
        o.z = pack2(tile[(kc * 8 + 4) * 65 + n], tile[(kc * 8 + 5) * 65 + n]);
        o.w = pack2(tile[(kc * 8 + 6) * 65 + n], tile[(kc * 8 + 7) * 65 + n]);
        *(uint4*)(dst + (size_t)(nt * 64 + n) * K + kt * 64 + kc * 8) = o;
      }
    }
    __syncthreads();
  }
}

__device__ void phase_norm(const Params& p, int l, int which) {
  const int lane = threadIdx.x & 63, wv = threadIdx.x >> 6;
  const float* nw = (which == 0 ? p.norm_mix_w : p.norm_ffn_w) + l * 1024;
  const float* modb = (const float*)(p.ws + OFF_MOD) + (size_t)l * 5 * 6144;
  bf16_t* h = (bf16_t*)(p.ws + OFF_H);
  for (int row = blockIdx.x * 4 + wv; row < T; row += gridDim.x * 4) {
    const float* x = p.out + (size_t)row * 1024;
    const float* md = modb + (size_t)mod_row(row) * 6144 + (which == 0 ? 0 : 3072);
    float4 v[4];
    float ss = 0.f;
#pragma unroll
    for (int i = 0; i < 4; ++i) {
      v[i] = *(const float4*)(x + i * 256 + lane * 4);
      ss += v[i].x * v[i].x + v[i].y * v[i].y + v[i].z * v[i].z + v[i].w * v[i].w;
    }
#pragma unroll
    for (int o = 32; o >= 1; o >>= 1) ss += __shfl_xor(ss, o);
    float rstd = rsqrtf(ss * (1.0f / 1024.f) + 1e-6f);
#pragma unroll
    for (int i = 0; i < 4; ++i) {
      int c = i * 256 + lane * 4;
      float4 w = *(const float4*)(nw + c), sh = *(const float4*)(md + c), sc = *(const float4*)(md + 1024 + c);
      float a0 = v[i].x * rstd * w.x * (1.f + sc.x) + sh.x, a1 = v[i].y * rstd * w.y * (1.f + sc.y) + sh.y;
      float a2 = v[i].z * rstd * w.z * (1.f + sc.z) + sh.z, a3 = v[i].w * rstd * w.w * (1.f + sc.w) + sh.w;
      uint2 o2; o2.x = pack2(a0, a1); o2.y = pack2(a2, a3);
      *(uint2*)(h + (size_t)row * 1024 + c) = o2;
    }
  }
}

__device__ void phase_final_norm(const Params& p) {
  const int lane = threadIdx.x & 63, wv = threadIdx.x >> 6;
  for (int row = blockIdx.x * 4 + wv; row < T; row += gridDim.x * 4) {
    float* x = p.out + (size_t)row * 1024;
    float4 v[4];
    float ss = 0.f;
#pragma unroll
    for (int i = 0; i < 4; ++i) {
      v[i] = *(const float4*)(x + i * 256 + lane * 4);
      ss += v[i].x * v[i].x + v[i].y * v[i].y + v[i].z * v[i].z + v[i].w * v[i].w;
    }
#pragma unroll
    for (int o = 32; o >= 1; o >>= 1) ss += __shfl_xor(ss, o);
    float rstd = rsqrtf(ss * (1.0f / 1024.f) + 1e-6f);
#pragma unroll
    for (int i = 0; i < 4; ++i) {
      int c = i * 256 + lane * 4;
      float4 w = *(const float4*)(p.norm_final_w + c);
      float4 o4 = make_float4(v[i].x * rstd * w.x, v[i].y * rstd * w.y, v[i].z * rstd * w.z, v[i].w * rstd * w.w);
      *(float4*)(x + c) = o4;
    }
  }
}

template <bool HASMID>
__device__ __forceinline__ void gemm_kloop2(f32x4 (&acc)[4][4], const bf16_t* __restrict__ Ag, int lda, const bf16_t* __restrict__ Bg,
                                            int ldb, int K, const bf16_t* __restrict__ Ag2, int lda2, const bf16_t* __restrict__ Bg2,
                                            int ldb2, int K2, char* smem, const bf16_t* __restrict__ gate0) {
  const int tid = threadIdx.x, lane = tid & 63, wid = tid >> 6;
  const int wr = wid >> 1, wc = wid & 1, fr = lane & 15, fq = lane >> 4;
  const int srow = tid >> 3, skc = tid & 7;
  const bf16_t* ap = Ag + (size_t)srow * lda + skc * 8;
  const bf16_t* bp = Bg + (size_t)srow * ldb + skc * 8;
  u32x4 ra[4], rb[4];
  const int nk1 = K >> 6;
  const int nk = nk1 + (K2 >> 6);
#pragma unroll
  for (int i = 0; i < 4; ++i) {
    ra[i] = *(const u32x4*)(ap + (size_t)i * 32 * lda);
    rb[i] = *(const u32x4*)(bp + (size_t)i * 32 * ldb);
  }
#pragma unroll
  for (int i = 0; i < 4; ++i) {
    *(u32x4*)(smem + (srow + i * 32) * LDS_ROW + skc * 16) = ra[i];
    *(u32x4*)(smem + 2 * LDS_TILE + (srow + i * 32) * LDS_ROW + skc * 16) = rb[i];
  }
  __syncthreads();
  for (int kt = 0; kt < nk; ++kt) {
    const int cur = kt & 1;
    if (kt + 1 < nk) {
      if (kt + 1 == nk1) {
        ap = Ag2 + (size_t)srow * lda2 + skc * 8 - (size_t)nk1 * 64;
        bp = Bg2 + (size_t)srow * ldb2 + skc * 8 - (size_t)nk1 * 64;
        lda = lda2; ldb = ldb2;
      }
#pragma unroll
      for (int i = 0; i < 4; ++i) {
        ra[i] = *(const u32x4*)(ap + (size_t)i * 32 * lda + (kt + 1) * 64);
        rb[i] = *(const u32x4*)(bp + (size_t)i * 32 * ldb + (kt + 1) * 64);
      }
    }
    if (HASMID && kt == nk1) {
#pragma unroll
      for (int m = 0; m < 4; ++m)
#pragma unroll
        for (int n = 0; n < 4; ++n) {
          uint2 g1 = *(const uint2*)(gate0 + (size_t)(m * 16) * NPROJ_PAD + n * 16);
          uint2 g2 = *(const uint2*)(gate0 + (size_t)(m * 16) * NPROJ_PAD + 1024 + n * 16);
          acc[m][n][0] *= gate_ratio(bf2f((bf16_t)(g1.x & 0xffff)), bf2f((bf16_t)(g2.x & 0xffff)));
          acc[m][n][1] *= gate_ratio(bf2f((bf16_t)(g1.x >> 16)), bf2f((bf16_t)(g2.x >> 16)));
          acc[m][n][2] *= gate_ratio(bf2f((bf16_t)(g1.y & 0xffff)), bf2f((bf16_t)(g2.y & 0xffff)));
          acc[m][n][3] *= gate_ratio(bf2f((bf16_t)(g1.y >> 16)), bf2f((bf16_t)(g2.y >> 16)));
        }
    }
    const char* sa = smem + cur * LDS_TILE + (wr * 64 + fr) * LDS_ROW + fq * 16;
    const char* sb = smem + (2 + cur) * LDS_TILE + (wc * 64 + fr) * LDS_ROW + fq * 16;
#pragma unroll
    for (int kk = 0; kk < 2; ++kk) {
      bf16x8 af[4], bfv[4];
#pragma unroll
      for (int m = 0; m < 4; ++m) af[m] = *(const bf16x8*)(sa + m * 16 * LDS_ROW + kk * 64);
#pragma unroll
      for (int n = 0; n < 4; ++n) bfv[n] = *(const bf16x8*)(sb + n * 16 * LDS_ROW + kk * 64);
#pragma unroll
      for (int m = 0; m < 4; ++m)
#pragma unroll
        for (int n = 0; n < 4; ++n) acc[m][n] = __builtin_amdgcn_mfma_f32_16x16x32_bf16(bfv[n], af[m], acc[m][n], 0, 0, 0);
    }
    if (kt + 1 < nk) {
#pragma unroll
      for (int i = 0; i < 4; ++i) {
        *(u32x4*)(smem + (cur ^ 1) * LDS_TILE + (srow + i * 32) * LDS_ROW + skc * 16) = ra[i];
        *(u32x4*)(smem + (2 + (cur ^ 1)) * LDS_TILE + (srow + i * 32) * LDS_ROW + skc * 16) = rb[i];
      }
    }
    __syncthreads();
  }
}

__device__ __forceinline__ void gemm_kloop(f32x4 (&acc)[4][4], const bf16_t* __restrict__ Ag, int lda, const bf16_t* __restrict__ Bg,
                                           int ldb, int K, char* smem) {
  gemm_kloop2<false>(acc, Ag, lda, Bg, ldb, K, Ag, lda, Bg, ldb, 0, smem, Ag);
}
enum { G_PROJ = 0, G_MERGE = 1, G_OUT = 2, G_FFN1 = 3, G_FFN2 = 4 };

template <int MODE>
__device__ void phase_gemm(const Params& p, int l, char* smem) {
  const int tid = threadIdx.x, lane = tid & 63, wid = tid >> 6;
  const int wr = wid >> 1, wc = wid & 1, fr = lane & 15, fq = lane >> 4;
  const bf16_t* wt = (const bf16_t*)(p.ws + OFF_WT) + (size_t)l * WT_LAYER;
  const bf16_t* hbuf = (const bf16_t*)(p.ws + OFF_H);
  bf16_t* proj = (bf16_t*)(p.ws + OFF_PROJ);
  bf16_t* hidden = (bf16_t*)(p.ws + OFF_PROJ);
  const float* modb = (const float*)(p.ws + OFF_MOD) + (size_t)l * 5 * 6144;
  constexpr int nM = T / 128;
  constexpr int nN = MODE == G_PROJ ? NPROJ_PAD / 128 : (MODE == G_FFN1 ? 5632 / 128 : 1024 / 128);
  for (int t = blockIdx.x; t < nM * nN; t += gridDim.x) {
    const int pm = t % nM, pn = t / nM;
    const int row0 = pm * 128, col0 = pn * 128;
    f32x4 acc[4][4];
#pragma unroll
    for (int m = 0; m < 4; ++m)
#pragma unroll
      for (int n = 0; n < 4; ++n) acc[m][n] = (f32x4){0.f, 0.f, 0.f, 0.f};
    if (MODE == G_PROJ) {
      gemm_kloop(acc, hbuf + (size_t)row0 * 1024, 1024, wt + WT_IN + (size_t)col0 * 1024, 1024, 1024, smem);
      float* dtraw = (float*)(p.ws + OFF_DTRAW);
#pragma unroll
      for (int m = 0; m < 4; ++m) {
        const int row = row0 + wr * 64 + m * 16 + fr;
#pragma unroll
        for (int n = 0; n < 4; ++n) {
          const int col = col0 + wc * 64 + n * 16 + fq * 4;
          uint2 o; o.x = pack2(acc[m][n][0], acc[m][n][1]); o.y = pack2(acc[m][n][2], acc[m][n][3]);
          *(uint2*)(proj + (size_t)row * NPROJ_PAD + col) = o;
          if (col >= C_DT && col < C_DT + 64) *(f32x4*)(dtraw + (size_t)row * 64 + (col - C_DT)) = acc[m][n];
        }
      }
    } else if (MODE == G_MERGE) {
      const bf16_t* ybuf = (const bf16_t*)(p.ws + OFF_YBUF);
      const bf16_t* obuf = (const bf16_t*)(p.ws + OFF_OBUF);
      bf16_t* mbuf = (bf16_t*)(p.ws + OFF_MBUF);
      gemm_kloop2<true>(acc, ybuf + (size_t)row0 * 2048, 2048, wt + WT_SSO + (size_t)col0 * 2048, 2048, 2048,
                        obuf + (size_t)row0 * 1024, 1024, wt + WT_HGO + (size_t)col0 * 1024, 1024, 1024, smem,
                        proj + (size_t)(row0 + wr * 64 + fr) * NPROJ_PAD + C_GATE + col0 + wc * 64 + fq * 4);
#pragma unroll
      for (int m = 0; m < 4; ++m) {
        const int row = row0 + wr * 64 + m * 16 + fr;
#pragma unroll
        for (int n = 0; n < 4; ++n) {
          const int col = col0 + wc * 64 + n * 16 + fq * 4;
          uint2 g = *(const uint2*)(proj + (size_t)row * NPROJ_PAD + C_GATE + 1024 + col);
          float r0 = acc[m][n][0] * sigmoidf_(clamp30(bf2f((bf16_t)(g.x & 0xffff))));
          float r1 = acc[m][n][1] * sigmoidf_(clamp30(bf2f((bf16_t)(g.x >> 16))));
          float r2 = acc[m][n][2] * sigmoidf_(clamp30(bf2f((bf16_t)(g.y & 0xffff))));
          float r3 = acc[m][n][3] * sigmoidf_(clamp30(bf2f((bf16_t)(g.y >> 16))));
          uint2 o; o.x = pack2(r0, r1); o.y = pack2(r2, r3);
          *(uint2*)(mbuf + (size_t)row * 1024 + col) = o;
        }
      }
    } else if (MODE == G_OUT || MODE == G_FFN2) {
      if (MODE == G_OUT) {
        const bf16_t* mbuf = (const bf16_t*)(p.ws + OFF_MBUF);
        gemm_kloop(acc, mbuf + (size_t)row0 * 1024, 1024, wt + WT_OUT + (size_t)col0 * 1024, 1024, 1024, smem);
      } else {
        gemm_kloop(acc, hidden + (size_t)row0 * FFN, FFN, wt + WT_W2 + (size_t)col0 * FFN, FFN, FFN, smem);
      }
      const float* gate = modb + (size_t)mod_row(row0) * 6144 + (MODE == G_OUT ? 2048 : 5120);
#pragma unroll
      for (int m = 0; m < 4; ++m) {
        const int row = row0 + wr * 64 + m * 16 + fr;
#pragma unroll
        for (int n = 0; n < 4; ++n) {
          const int col = col0 + wc * 64 + n * 16 + fq * 4;
          f32x4 g = *(const f32x4*)(gate + col);
          f32x4* xp = (f32x4*)(p.out + (size_t)row * 1024 + col);
          f32x4 xv = *xp;
          xv += g * acc[m][n];
          *xp = xv;
        }
      }
    } else {
      gemm_kloop(acc, hbuf + (size_t)row0 * 1024, 1024, wt + WT_W13 + (size_t)col0 * 1024, 1024, 1024, smem);
#pragma unroll
      for (int m = 0; m < 4; ++m) {
        const int row = row0 + wr * 64 + m * 16 + fr;
#pragma unroll
        for (int n = 0; n < 2; ++n) {
          const int hcol = (pn * 2 + wc) * 32 + n * 16 + fq * 4;
          float r[4];
#pragma unroll
          for (int j = 0; j < 4; ++j) r[j] = siluf_(acc[m][n][j]) * acc[m][n + 2][j];
          uint2 o; o.x = pack2(r[0], r[1]); o.y = pack2(r[2], r[3]);
          *(uint2*)(hidden + (size_t)row * FFN + hcol) = o;
        }
      }
    }
  }
}

__device__ void phase_conv(const Params& p, int l) {
  const bf16_t* proj = (const bf16_t*)(p.ws + OFF_PROJ);
  bf16_t* xc = (bf16_t*)(p.ws + OFF_XC);
  const float* cw = p.ssd_conv_w + (size_t)l * 5 * 4096;
  const float* cb = p.ssd_conv_b + (size_t)l * 4096;
  const size_t total = (size_t)T * 512;
  for (size_t i = (size_t)blockIdx.x * 256 + threadIdx.x; i < total; i += (size_t)gridDim.x * 256) {
    const int tok = (int)(i >> 9), ch = (int)(i & 511) * 8;
    int pos, len;
    if (tok < TCTX) { pos = tok & 255; len = 256; } else { pos = (tok - TCTX) & 63; len = 64; }
    float a[8];
#pragma unroll
    for (int j = 0; j < 8; ++j) a[j] = cb[ch + j];
#pragma unroll
    for (int k = 0; k < 5; ++k) {
      const int q = pos + k - 2;
      if (q >= 0 && q < len) {
        uint4 v = *(const uint4*)(proj + (size_t)(tok + k - 2) * NPROJ_PAD + ch);
        const float* w = cw + k * 4096 + ch;
        a[0] += w[0] * bf2f((bf16_t)(v.x & 0xffff)); a[1] += w[1] * bf2f((bf16_t)(v.x >> 16));
        a[2] += w[2] * bf2f((bf16_t)(v.y & 0xffff)); a[3] += w[3] * bf2f((bf16_t)(v.y >> 16));
        a[4] += w[4] * bf2f((bf16_t)(v.z & 0xffff)); a[5] += w[5] * bf2f((bf16_t)(v.z >> 16));
        a[6] += w[6] * bf2f((bf16_t)(v.w & 0xffff)); a[7] += w[7] * bf2f((bf16_t)(v.w >> 16));
      }
    }
    uint4 o;
    o.x = pack2(siluf_(a[0]), siluf_(a[1])); o.y = pack2(siluf_(a[2]), siluf_(a[3]));
    o.z = pack2(siluf_(a[4]), siluf_(a[5])); o.w = pack2(siluf_(a[6]), siluf_(a[7]));
    *(uint4*)(xc + (size_t)tok * 4096 + ch) = o;
  }
  const float* dtraw = (const float*)(p.ws + OFF_DTRAW);
  float* dt = (float*)(p.ws + OFF_DT);
  for (size_t i = (size_t)blockIdx.x * 256 + threadIdx.x; i < (size_t)T * 64; i += (size_t)gridDim.x * 256) {
    float v = dtraw[i] + p.ssd_dt_bias[l * 64 + (int)(i & 63)];
    dt[i] = v > 20.f ? v : log1pf(expf(v));
  }
}

__device__ void ssd_naive_item(const Params& p, int l, int item, float* sm) {
  const int d = item & 1, h = (item >> 1) & 31, s = item >> 6;
  int tok0, L;
  if (s < 32) { tok0 = s * 256; L = 256; } else { tok0 = TCTX + (s - 32) * 2048; L = 2048; }
  const int tid = threadIdx.x, pp = tid >> 2, nq = tid & 3, g = h >> 2;
  float S[32];
  if (s < 32) {
#pragma unroll
    for (int i = 0; i < 32; ++i) S[i] = 0.f;
  } else {
    const float* st = p.state_ssm + ((((size_t)(s - 32) * 4 + l) * 2 + d) * 32 + h) * 8192 + pp * 128 + nq * 32;
#pragma unroll
    for (int i = 0; i < 32; ++i) S[i] = st[i];
  }
  const float a = -expf(p.ssd_a_log[l * 64 + d * 32 + h]);
  float* xs = sm; float* Bs = sm + 1024; float* Cs = Bs + 2048; float* dts = Cs + 2048;
  const bf16_t* xc = (const bf16_t*)(p.ws + OFF_XC);
  const float* dtb = (const float*)(p.ws + OFF_DT);
  float* ydir = (float*)(p.ws + (d == 0 ? OFF_YF : OFF_YB));
  for (int bt = 0; bt < L / 16; ++bt) {
    const int tb = d == 0 ? bt * 16 : L - 16 - bt * 16;
    __syncthreads();
    for (int e = tid; e < 16 * 320; e += 256) {
      const int tt = e / 320, c = e % 320;
      const size_t base = (size_t)(tok0 + tb + tt) * 4096;
      if (c < 64) xs[tt * 64 + c] = bf2f(xc[base + h * 64 + c]);
      else if (c < 192) Bs[tt * 128 + c - 64] = bf2f(xc[base + 2048 + g * 128 + c - 64]);
      else Cs[tt * 128 + c - 192] = bf2f(xc[base + 3072 + g * 128 + c - 192]);
    }
    if (tid < 16) dts[tid] = dtb[(size_t)(tok0 + tb + tid) * 64 + d * 32 + h];
    __syncthreads();
    for (int i2 = 0; i2 < 16; ++i2) {
      const int tt = d == 0 ? i2 : 15 - i2;
      const float dt = dts[tt], dA = expf(dt * a), xdt = xs[tt * 64 + pp] * dt;
      float acc = 0.f;
      const float* Bp = Bs + tt * 128 + nq * 32;
      const float* Cp = Cs + tt * 128 + nq * 32;
#pragma unroll
      for (int i = 0; i < 32; ++i) { S[i] = dA * S[i] + xdt * Bp[i]; acc += S[i] * Cp[i]; }
      acc += __shfl_xor(acc, 1); acc += __shfl_xor(acc, 2);
      if (nq == 0) ydir[(size_t)(tok0 + tb + tt) * 2048 + h * 64 + pp] = acc;
    }
  }
  if (s < 32) {
    float* o = p.out + OUT_SSM + ((((size_t)s * 4 + l) * 2 + d) * 32 + h) * 8192 + pp * 128 + nq * 32;
#pragma unroll
    for (int i = 0; i < 32; ++i) o[i] = S[i];
  }
}

__device__ void hgrn_naive_item(const Params& p, int l, int item, float* sm) {
  const int d = item & 1, hd = (item >> 1) & 7, s = item >> 4;
  int tok0, L;
  if (s < 32) { tok0 = s * 256; L = 256; } else { tok0 = TCTX + (s - 32) * 2048; L = 2048; }
  const int tid = threadIdx.x, vv = tid >> 1, kh = tid & 1;
  float S[64];
  if (s < 32) {
#pragma unroll
    for (int i = 0; i < 64; ++i) S[i] = 0.f;
  } else {
    const float* st = p.state_hgrn + ((((size_t)(s - 32) * 4 + l) * 2 + d) * 8 + hd) * 16384 + (size_t)(kh * 64) * 128 + vv;
#pragma unroll
    for (int i = 0; i < 64; ++i) S[i] = st[(size_t)i * 128];
  }
  float* qs = sm; float* fs = sm + 2048; float* ks = sm + 4096; float* vs = sm + 6144;
  const bf16_t* proj = (const bf16_t*)(p.ws + OFF_PROJ);
  const float* lb = (const float*)(p.ws + OFF_LB) + (size_t)l * 2048 + d * 1024 + hd * 128;
  float* odir = (float*)(p.ws + (d == 0 ? OFF_OF : OFF_OB));
  for (int bt = 0; bt < L / 16; ++bt) {
    const int tb = d == 0 ? bt * 16 : L - 16 - bt * 16;
    __syncthreads();
    for (int e = tid; e < 16 * 128; e += 256) {
      const int tt = e >> 7, c = e & 127;
      const size_t base = (size_t)(tok0 + tb + tt) * NPROJ_PAD;
      const float q = bf2f(proj[base + C_HQ + hd * 128 + c]);
      const float u = bf2f(proj[base + C_HF + d * 1024 + hd * 128 + c]);
      const float lbv = lb[c];
      const float sg = sigmoidf_(u);
      qs[e] = siluf_(q);
      fs[e] = lbv + (1.f - lbv) * sg;
      ks[e] = (1.f - lbv) * (1.f - sg);
      vs[e] = bf2f(proj[base + C_HI + hd * 128 + c]);
    }
    __syncthreads();
    for (int i2 = 0; i2 < 16; ++i2) {
      const int tt = d == 0 ? i2 : 15 - i2;
      const float vval = vs[tt * 128 + vv];
      const float* fp = fs + tt * 128 + kh * 64;
      const float* kp = ks + tt * 128 + kh * 64;
      const float* qp = qs + tt * 128 + kh * 64;
      float acc = 0.f;
#pragma unroll
      for (int i = 0; i < 64; ++i) { S[i] = fp[i] * S[i] + kp[i] * vval; acc += S[i] * qp[i]; }
      acc += __shfl_xor(acc, 1);
      if (kh == 0) odir[(size_t)(tok0 + tb + tt) * 1024 + hd * 128 + vv] = acc;
    }
  }
  if (s < 32) {
    float* o = p.out + OUT_HGRN + ((((size_t)s * 4 + l) * 2 + d) * 8 + hd) * 16384 + (size_t)(kh * 64) * 128 + vv;
#pragma unroll
    for (int i = 0; i < 64; ++i) o[(size_t)i * 128] = S[i];
  }
}

__device__ void phase_scan_naive(const Params& p, int l, char* smem) {
  const int n_ssd = 36 * 64, n_hg = 36 * 16;
  for (int it = blockIdx.x; it < n_ssd + n_hg; it += gridDim.x) {
    if (it < 256) ssd_naive_item(p, l, 32 * 64 + it, (float*)smem);
    else if (it < 320) hgrn_naive_item(p, l, 32 * 16 + (it - 256), (float*)smem);
    else if (it < 320 + 2048) ssd_naive_item(p, l, it - 320, (float*)smem);
    else hgrn_naive_item(p, l, it - 320 - 2048, (float*)smem);
  }
}

__device__ void phase_post(const Params& p, int l) {
  const int tid = threadIdx.x;
  const bf16_t* proj = (const bf16_t*)(p.ws + OFF_PROJ);
  const bf16_t* xc = (const bf16_t*)(p.ws + OFF_XC);
  const float* yf = (const float*)(p.ws + OFF_YF);
  const float* yb = (const float*)(p.ws + OFF_YB);
  const float* of = (const float*)(p.ws + OFF_OF);
  const float* ob = (const float*)(p.ws + OFF_OB);
  bf16_t* ybuf = (bf16_t*)(p.ws + OFF_YBUF);
  bf16_t* obuf = (bf16_t*)(p.ws + OFF_OBUF);
  for (int tok = blockIdx.x; tok < T; tok += gridDim.x) {
    {
      const int ch = tid * 8, hh = ch >> 6;
      const float dsk = p.ssd_d[l * 32 + hh];
      const float* a = yf + (size_t)tok * 2048 + ch;
      const float* b = yb + (size_t)tok * 2048 + ch;
      uint4 xv = *(const uint4*)(xc + (size_t)tok * 4096 + ch);
      uint4 zv = *(const uint4*)(proj + (size_t)tok * NPROJ_PAD + C_Z + ch);
      const unsigned xw[4] = {xv.x, xv.y, xv.z, xv.w};
      const unsigned zw[4] = {zv.x, zv.y, zv.z, zv.w};
      float v[8];
      float ss = 0.f;
#pragma unroll
      for (int j = 0; j < 8; ++j) {
        const float xs = bf2f((bf16_t)((j & 1) ? (xw[j >> 1] >> 16) : (xw[j >> 1] & 0xffff)));
        const float z = bf2f((bf16_t)((j & 1) ? (zw[j >> 1] >> 16) : (zw[j >> 1] & 0xffff)));
        v[j] = (a[j] + b[j] + dsk * xs) * siluf_(z);
        ss += v[j] * v[j];
      }
#pragma unroll
      for (int o = 16; o >= 1; o >>= 1) ss += __shfl_xor(ss, o);
      const float rstd = rsqrtf(ss * (1.f / 256.f) + 1e-6f);
      const float* nw = p.ssd_norm_w + l * 2048 + ch;
      uint4 o4;
      o4.x = pack2(v[0] * rstd * nw[0], v[1] * rstd * nw[1]); o4.y = pack2(v[2] * rstd * nw[2], v[3] * rstd * nw[3]);
      o4.z = pack2(v[4] * rstd * nw[4], v[5] * rstd * nw[5]); o4.w = pack2(v[6] * rstd * nw[6], v[7] * rstd * nw[7]);
      *(uint4*)(ybuf + (size_t)tok * 2048 + ch) = o4;
    }
    {
      const int ch = tid * 4;
      const float* a = of + (size_t)tok * 1024 + ch;
      const float* b = ob + (size_t)tok * 1024 + ch;
      uint2 gv = *(const uint2*)(proj + (size_t)tok * NPROJ_PAD + C_HG + ch);
      const unsigned gw[2] = {gv.x, gv.y};
      float v[4];
      float ss = 0.f;
#pragma unroll
      for (int j = 0; j < 4; ++j) { v[j] = a[j] + b[j]; ss += v[j] * v[j]; }
#pragma unroll
      for (int o = 16; o >= 1; o >>= 1) ss += __shfl_xor(ss, o);
      const float rstd = rsqrtf(ss * (1.f / 128.f) + 1e-6f);
      const float* nw = p.hgrn_norm_w + l * 1024 + ch;
      float r[4];
#pragma unroll
      for (int j = 0; j < 4; ++j) {
        const float gz = bf2f((bf16_t)((j & 1) ? (gw[j >> 1] >> 16) : (gw[j >> 1] & 0xffff)));
        r[j] = v[j] * rstd * nw[j] * siluf_(gz);
      }
      uint2 o2; o2.x = pack2(r[0], r[1]); o2.y = pack2(r[2], r[3]);
      *(uint2*)(obuf + (size_t)tok * 1024 + ch) = o2;
    }
  }
}

enum { PH_SETUP = 0, PH_NORM1, PH_PROJ, PH_CONV, PH_SCAN, PH_POST, PH_MERGE, PH_OUT, PH_NORM2, PH_FFN1, PH_FFN2, PH_FINAL };

__device__ __forceinline__ void run_phase(const Params& p, int ph, int l, char* smem) {
  switch (ph) {
    case PH_SETUP: phase_setup(p, smem); break;
    case PH_NORM1: phase_norm(p, l, 0); break;
    case PH_PROJ: phase_gemm<G_PROJ>(p, l, smem); break;
    case PH_CONV: phase_conv(p, l); break;
    case PH_SCAN: phase_scan_naive(p, l, smem); break;
    case PH_POST: phase_post(p, l); break;
    case PH_MERGE: phase_gemm<G_MERGE>(p, l, smem); break;
    case PH_OUT: phase_gemm<G_OUT>(p, l, smem); break;
    case PH_NORM2: phase_norm(p, l, 1); break;
    case PH_FFN1: phase_gemm<G_FFN1>(p, l, smem); break;
    case PH_FFN2: phase_gemm<G_FFN2>(p, l, smem); break;
    case PH_FINAL: phase_final_norm(p); break;
  }
}

extern __shared__ __attribute__((aligned(16))) char dyn_smem[];

__global__ void __launch_bounds__(256, 2) phase_kernel(Params p, int ph, int l) { run_phase(p, ph, l, dyn_smem); }

#if MEGA
__global__ void __launch_bounds__(256, 2) mega_kernel(Params p) {
  cg::grid_group grid = cg::this_grid();
  run_phase(p, PH_SETUP, 0, dyn_smem);
  grid.sync();
  for (int l = 0; l < DEPTH; ++l) {
    for (int ph = PH_NORM1; ph <= PH_FFN2; ++ph) {
      run_phase(p, ph, l, dyn_smem);
      grid.sync();
    }
  }
  run_phase(p, PH_FINAL, 0, dyn_smem);
}
#endif

extern "C" void kernel_launch(void* const* d_in, const int* in_sizes, int n_in, void* d_out, int out_size, void* d_ws, size_t ws_size,
                              hipStream_t stream) {
  static int grid_blocks = 0;
  if (!grid_blocks) {
    int dev = 0, cus = 0, per_cu = 0;
    (void)hipGetDevice(&dev);
    (void)hipDeviceGetAttribute(&cus, hipDeviceAttributeMultiprocessorCount, dev);
#if MEGA
    (void)hipFuncSetAttribute((const void*)mega_kernel, hipFuncAttributeMaxDynamicSharedMemorySize, SMEM_BYTES);
#endif
    (void)hipFuncSetAttribute((const void*)phase_kernel, hipFuncAttributeMaxDynamicSharedMemorySize, SMEM_BYTES);
#if MEGA
    (void)hipOccupancyMaxActiveBlocksPerMultiprocessor(&per_cu, mega_kernel, 256, SMEM_BYTES);
#else
    (void)hipOccupancyMaxActiveBlocksPerMultiprocessor(&per_cu, phase_kernel, 256, SMEM_BYTES);
#endif
    if (per_cu > 2) per_cu = 2;
    if (per_cu < 1) per_cu = 1;
    grid_blocks = cus * per_cu;
  }
  Params p{};
  const float** pf = (const float**)&p;
  for (int i = 0; i < 26; ++i) pf[i] = (const float*)d_in[i];
  p.out = (float*)d_out;
  p.ws = (char*)d_ws;
#if MEGA
  void* args[] = {&p};
  hipError_t e = hipLaunchCooperativeKernel((void*)mega_kernel, dim3(grid_blocks), dim3(256), args, SMEM_BYTES, stream);
  if (e != hipSuccess) fprintf(stderr, "coop launch failed: %s\n", hipGetErrorString(e));
#else
  const int G = grid_blocks;
  phase_kernel<<<G, 256, SMEM_BYTES, stream>>>(p, PH_SETUP, 0);
  for (int l = 0; l < DEPTH; ++l)
    for (int ph = PH_NORM1; ph <= PH_FFN2; ++ph) phase_kernel<<<G, 256, SMEM_BYTES, stream>>>(p, ph, l);
  phase_kernel<<<G, 256, SMEM_BYTES, stream>>>(p, PH_FINAL, 0);
#endif
}
```

```cpp
#include <hip/hip_runtime.h>
#include <hip/hip_cooperative_groups.h>
#include <cstdio>
#include <cstdint>
namespace cg = cooperative_groups;

#ifndef MEGA
#define MEGA 1
#endif

typedef unsigned short bf16_t;
typedef short bf16x8 __attribute__((ext_vector_type(8)));
typedef float f32x4 __attribute__((ext_vector_type(4)));
typedef unsigned u32x4 __attribute__((ext_vector_type(4)));

constexpr int D = 1024, T = 16384, TCTX = 8192, DEPTH = 4;
constexpr int NPROJ = 13376, NPROJ_PAD = 13440;
constexpr int FFN = 2816;
constexpr int C_Z = 4096, C_DT = 6144, C_HQ = 6208, C_HF = 7232, C_HI = 9280, C_HG = 10304, C_GATE = 11328;
constexpr size_t WT_IN = 0;
constexpr size_t WT_SSO = WT_IN + (size_t)NPROJ_PAD * 1024;
constexpr size_t WT_HGO = WT_SSO + (size_t)1024 * 2048;
constexpr size_t WT_OUT = WT_HGO + (size_t)1024 * 1024;
constexpr size_t WT_W13 = WT_OUT + (size_t)1024 * 1024;
constexpr size_t WT_W2 = WT_W13 + (size_t)5632 * 1024;
constexpr size_t WT_LAYER = WT_W2 + (size_t)1024 * 2816;
constexpr size_t OFF_WT = 0;
constexpr size_t OFF_H = OFF_WT + WT_LAYER * 2 * DEPTH;
constexpr size_t OFF_PROJ = OFF_H + (size_t)T * 1024 * 2;
constexpr size_t OFF_XC = OFF_PROJ + (size_t)T * NPROJ_PAD * 2;
constexpr size_t OFF_DTRAW = OFF_XC + (size_t)T * 4096 * 2;
constexpr size_t OFF_DT = OFF_DTRAW + (size_t)T * 64 * 4;
constexpr size_t OFF_YF = OFF_DT + (size_t)T * 64 * 4;
constexpr size_t OFF_YB = OFF_YF + (size_t)T * 2048 * 4;
constexpr size_t OFF_OF = OFF_YB + (size_t)T * 2048 * 4;
constexpr size_t OFF_OB = OFF_OF + (size_t)T * 1024 * 4;
constexpr size_t OFF_YBUF = OFF_OB + (size_t)T * 1024 * 4;
constexpr size_t OFF_OBUF = OFF_YBUF + (size_t)T * 2048 * 2;
constexpr size_t OFF_MBUF = OFF_OBUF + (size_t)T * 1024 * 2;
constexpr size_t OFF_MOD = OFF_MBUF + (size_t)T * 1024 * 2;
constexpr size_t OFF_LB = OFF_MOD + (size_t)DEPTH * 5 * 6144 * 4;
constexpr size_t OFF_END = OFF_LB + (size_t)DEPTH * 2 * 1024 * 4;
constexpr size_t OUT_SSM = (size_t)T * 1024;
constexpr size_t OUT_HGRN = OUT_SSM + (size_t)32 * 4 * 2 * 32 * 64 * 128;

constexpr int SMEM_BYTES = 73728;
constexpr int LDS_ROW = 144;
constexpr int LDS_TILE = 128 * LDS_ROW;

struct Params {
  const float *x_prompt, *x_sample, *c, *state_ssm, *state_hgrn, *c_ctx, *norm_mix_w, *norm_ffn_w, *ada_w, *ada_b, *w_in,
      *ssd_conv_w, *ssd_conv_b, *ssd_dt_bias, *ssd_a_log, *ssd_d, *ssd_norm_w, *hgrn_lb, *hgrn_norm_w, *w_ssd_out, *w_hgrn_out,
      *w_out, *ffn_w1, *ffn_w3, *ffn_w2, *norm_final_w;
  float* out;
  char* ws;
};

__device__ __forceinline__ bf16_t f2bf(float f) {
  unsigned u = __float_as_uint(f);
  u += 0x7fffu + ((u >> 16) & 1u);
  return (bf16_t)(u >> 16);
}
__device__ __forceinline__ float bf2f(bf16_t b) { return __uint_as_float(((unsigned)b) << 16); }
__device__ __forceinline__ unsigned pack2(float a, float b) { return (unsigned)f2bf(a) | ((unsigned)f2bf(b) << 16); }
__device__ __forceinline__ float sigmoidf_(float x) { return 1.0f / (1.0f + __expf(-x)); }
__device__ __forceinline__ float siluf_(float x) { return x / (1.0f + __expf(-x)); }
__device__ __forceinline__ int tid_opaque() { int t = threadIdx.x; asm volatile("" : "+v"(t)); return t; }
__device__ __forceinline__ float clamp30(float x) { return fminf(fmaxf(x, -30.f), 30.f); }
__device__ __forceinline__ float gate_ratio(float g1, float g2) { return (1.0f + __expf(-clamp30(g2))) / (1.0f + __expf(-clamp30(g1))); }
__device__ __forceinline__ int mod_row(int tok) { return tok < TCTX ? 0 : 1 + ((tok - TCTX) >> 11); }

__device__ __forceinline__ void phase_setup(const Params& p, char* smem) {
  const int tid = tid_opaque(), bid = blockIdx.x, G = gridDim.x;
  {
    const size_t n4 = (size_t)T * 1024 / 4, half4 = (size_t)TCTX * 1024 / 4;
    float4* dst = (float4*)p.out;
    const float4* s0 = (const float4*)p.x_prompt;
    const float4* s1 = (const float4*)p.x_sample;
    for (size_t i = (size_t)bid * 256 + tid; i < n4; i += (size_t)G * 256) dst[i] = i < half4 ? s0[i] : s1[i - half4];
  }
  {
    float* lb = (float*)(p.ws + OFF_LB);
    for (int i = bid * 256 + tid; i < 2048; i += G * 256) {
      float v0 = p.hgrn_lb[i], v1 = p.hgrn_lb[2048 + i], v2 = p.hgrn_lb[4096 + i], v3 = p.hgrn_lb[6144 + i];
      float m = fmaxf(fmaxf(v0, v1), fmaxf(v2, v3));
      float e0 = expf(v0 - m), e1 = expf(v1 - m), e2 = expf(v2 - m), e3 = expf(v3 - m);
      float inv = 1.0f / (e0 + e1 + e2 + e3);
      lb[i] = 0.f;
      lb[2048 + i] = e1 * inv;
      lb[4096 + i] = (e1 + e2) * inv;
      lb[6144 + i] = (e1 + e2 + e3) * inv;
    }
  }
  {
    float* sm = (float*)smem;
    float* modb = (float*)(p.ws + OFF_MOD);
    __syncthreads();
    for (int i = tid; i < 5 * 1024; i += 256) {
      int v = i >> 10, k = i & 1023;
      float cv = v == 0 ? p.c_ctx[k] : p.c[(v - 1) * 1024 + k];
      sm[i] = siluf_(cv);
    }
    __syncthreads();
    float* part = sm + 5 * 1024;
    for (int item = bid; item < DEPTH * 96; item += G) {
      int l = item / 96, cg_ = item % 96;
      int col = cg_ * 64 + (tid & 63), kg = tid >> 6;
      const float* w = p.ada_w + (size_t)l * 1024 * 6144 + col;
      float a0 = 0, a1 = 0, a2 = 0, a3 = 0, a4 = 0;
      for (int k = kg * 256; k < kg * 256 + 256; ++k) {
        float wv = w[(size_t)k * 6144];
        a0 += sm[k] * wv; a1 += sm[1024 + k] * wv; a2 += sm[2048 + k] * wv; a3 += sm[3072 + k] * wv; a4 += sm[4096 + k] * wv;
      }
      __syncthreads();
      part[(kg * 5 + 0) * 64 + (tid & 63)] = a0; part[(kg * 5 + 1) * 64 + (tid & 63)] = a1; part[(kg * 5 + 2) * 64 + (tid & 63)] = a2;
      part[(kg * 5 + 3) * 64 + (tid & 63)] = a3; part[(kg * 5 + 4) * 64 + (tid & 63)] = a4;
      __syncthreads();
      for (int i = tid; i < 320; i += 256) {
        int v = i >> 6, cc = i & 63;
        float s = part[(0 * 5 + v) * 64 + cc] + part[(1 * 5 + v) * 64 + cc] + part[(2 * 5 + v) * 64 + cc] + part[(3 * 5 + v) * 64 + cc];
        int colo = cg_ * 64 + cc;
        modb[((size_t)l * 5 + v) * 6144 + colo] = s + p.ada_b[l * 6144 + colo];
      }
    }
    __syncthreads();
  }
  {
    float* tile = (float*)smem;
    const int n_in = 210 * 16, n_sso = 16 * 32, n_hgo = 16 * 16, n_out = 16 * 16, n_w13 = 88 * 16, n_w2 = 16 * 44;
    const int per_layer = n_in + n_sso + n_hgo + n_out + n_w13 + n_w2;
    for (int it = bid; it < per_layer * DEPTH; it += G) {
      int l = it / per_layer, r = it % per_layer;
      bf16_t* wt = (bf16_t*)(p.ws + OFF_WT) + (size_t)l * WT_LAYER;
      const float *src0 = nullptr, *src1 = nullptr;
      int K, Nsrc, nt, kt;
      bf16_t* dst;
      bool zero = false;
      if (r < n_in) {
        nt = r / 16; kt = r % 16; K = 1024; Nsrc = NPROJ;
        dst = wt + WT_IN;
        if (nt >= 209) zero = true;
        src0 = p.w_in + (size_t)l * 1024 * NPROJ + nt * 64; src1 = src0 + 32;
      } else if ((r -= n_in) < n_sso) {
        nt = r / 32; kt = r % 32; K = 2048; Nsrc = 1024; dst = wt + WT_SSO;
        src0 = p.w_ssd_out + (size_t)l * 2048 * 1024 + nt * 64; src1 = src0 + 32;
      } else if ((r -= n_sso) < n_hgo) {
        nt = r / 16; kt = r % 16; K = 1024; Nsrc = 1024; dst = wt + WT_HGO;
        src0 = p.w_hgrn_out + (size_t)l * 1024 * 1024 + nt * 64; src1 = src0 + 32;
      } else if ((r -= n_hgo) < n_out) {
        nt = r / 16; kt = r % 16; K = 1024; Nsrc = 1024; dst = wt + WT_OUT;
        src0 = p.w_out + (size_t)l * 1024 * 1024 + nt * 64; src1 = src0 + 32;
      } else if ((r -= n_out) < n_w13) {
        nt = r / 16; kt = r % 16; K = 1024; Nsrc = FFN; dst = wt + WT_W13;
        src0 = p.ffn_w1 + (size_t)l * 1024 * FFN + nt * 32; src1 = p.ffn_w3 + (size_t)l * 1024 * FFN + nt * 32;
      } else {
        r -= n_w13;
        nt = r / 44; kt = r % 44; K = 2816; Nsrc = 1024; dst = wt + WT_W2;
        src0 = p.ffn_w2 + (size_t)l * 2816 * 1024 + nt * 64; src1 = src0 + 32;
      }
      __syncthreads();
      {
        int c4 = (tid & 15) * 4;
        const float* s = c4 < 32 ? src0 + c4 : src1 + (c4 - 32);
#pragma unroll
        for (int i = 0; i < 4; ++i) {
          int kr = (tid >> 4) + i * 16;
          float4 v = zero ? make_float4(0.f, 0.f, 0.f, 0.f) : *(const float4*)(s + (size_t)(kt * 64 + kr) * Nsrc);
          tile[kr * 65 + c4 + 0] = v.x; tile[kr * 65 + c4 + 1] = v.y; tile[kr * 65 + c4 + 2] = v.z; tile[kr * 65 + c4 + 3] = v.w;
        }
      }
      __syncthreads();
#pragma unroll
      for (int i = 0; i < 2; ++i) {
        int cidx = tid + i * 256, n = cidx >> 3, kc = cidx & 7;
        uint4 o;
        o.x = pack2(tile[(kc * 8 + 0) * 65 + n], tile[(kc * 8 + 1) * 65 + n]);
        o.y = pack2(tile[(kc * 8 + 2) * 65 + n], tile[(kc * 8 + 3) * 65 + n]);
        o.z = pack2(tile[(kc * 8 + 4) * 65 + n], tile[(kc * 8 + 5) * 65 + n]);
        o.w = pack2(tile[(kc * 8 + 6) * 65 + n], tile[(kc * 8 + 7) * 65 + n]);
        *(uint4*)(dst + (size_t)(nt * 64 + n) * K + kt * 64 + kc * 8) = o;
      }
    }
    __syncthreads();
  }
}

__device__ __forceinline__ void phase_norm(const Params& p, int l, int which) {
  const int lane = tid_opaque() & 63, wv = tid_opaque() >> 6;
  const float* nw = (which == 0 ? p.norm_mix_w : p.norm_ffn_w) + l * 1024;
  const float* modb = (const float*)(p.ws + OFF_MOD) + (size_t)l * 5 * 6144;
  bf16_t* h = (bf16_t*)(p.ws + OFF_H);
  for (int row = blockIdx.x * 4 + wv; row < T; row += gridDim.x * 4) {
    const float* x = p.out + (size_t)row * 1024;
    const float* md = modb + (size_t)mod_row(row) * 6144 + (which == 0 ? 0 : 3072);
    float4 v[4];
    float ss = 0.f;
#pragma unroll
    for (int i = 0; i < 4; ++i) {
      v[i] = *(const float4*)(x + i * 256 + lane * 4);
      ss += v[i].x * v[i].x + v[i].y * v[i].y + v[i].z * v[i].z + v[i].w * v[i].w;
    }
#pragma unroll
    for (int o = 32; o >= 1; o >>= 1) ss += __shfl_xor(ss, o);
    float rstd = rsqrtf(ss * (1.0f / 1024.f) + 1e-6f);
#pragma unroll
    for (int i = 0; i < 4; ++i) {
      int c = i * 256 + lane * 4;
      float4 w = *(const float4*)(nw + c), sh = *(const float4*)(md + c), sc = *(const float4*)(md + 1024 + c);
      float a0 = v[i].x * rstd * w.x * (1.f + sc.x) + sh.x, a1 = v[i].y * rstd * w.y * (1.f + sc.y) + sh.y;
      float a2 = v[i].z * rstd * w.z * (1.f + sc.z) + sh.z, a3 = v[i].w * rstd * w.w * (1.f + sc.w) + sh.w;
      uint2 o2; o2.x = pack2(a0, a1); o2.y = pack2(a2, a3);
      *(uint2*)(h + (size_t)row * 1024 + c) = o2;
    }
  }
}

__device__ __forceinline__ void phase_final_norm(const Params& p) {
  const int lane = tid_opaque() & 63, wv = tid_opaque() >> 6;
  for (int row = blockIdx.x * 4 + wv; row < T; row += gridDim.x * 4) {
    float* x = p.out + (size_t)row * 1024;
    float4 v[4];
    float ss = 0.f;
#pragma unroll
    for (int i = 0; i < 4; ++i) {
      v[i] = *(const float4*)(x + i * 256 + lane * 4);
      ss += v[i].x * v[i].x + v[i].y * v[i].y + v[i].z * v[i].z + v[i].w * v[i].w;
    }
#pragma unroll
    for (int o = 32; o >= 1; o >>= 1) ss += __shfl_xor(ss, o);
    float rstd = rsqrtf(ss * (1.0f / 1024.f) + 1e-6f);
#pragma unroll
    for (int i = 0; i < 4; ++i) {
      int c = i * 256 + lane * 4;
      float4 w = *(const float4*)(p.norm_final_w + c);
      float4 o4 = make_float4(v[i].x * rstd * w.x, v[i].y * rstd * w.y, v[i].z * rstd * w.z, v[i].w * rstd * w.w);
      *(float4*)(x + c) = o4;
    }
  }
}

template <bool HASMID>
__device__ __forceinline__ void gemm_kloop2(f32x4 (&acc)[4][4], const bf16_t* __restrict__ Ag, int lda, const bf16_t* __restrict__ Bg,
                                            int ldb, int K, const bf16_t* __restrict__ Ag2, int lda2, const bf16_t* __restrict__ Bg2,
                                            int ldb2, int K2, char* smem, const bf16_t* __restrict__ gate0) {
  const int tid = tid_opaque(), lane = tid & 63, wid = tid >> 6;
  const int wr = wid >> 1, wc = wid & 1, fr = lane & 15, fq = lane >> 4;
  const int srow = tid >> 3, skc = tid & 7;
  const bf16_t* ap = Ag + (size_t)srow * lda + skc * 8;
  const bf16_t* bp = Bg + (size_t)srow * ldb + skc * 8;
  u32x4 ra[4], rb[4];
  const int nk1 = K >> 6;
  const int nk = nk1 + (K2 >> 6);
#pragma unroll
  for (int i = 0; i < 4; ++i) {
    ra[i] = *(const u32x4*)(ap + (size_t)i * 32 * lda);
    rb[i] = *(const u32x4*)(bp + (size_t)i * 32 * ldb);
  }
#pragma unroll
  for (int i = 0; i < 4; ++i) {
    *(u32x4*)(smem + (srow + i * 32) * LDS_ROW + skc * 16) = ra[i];
    *(u32x4*)(smem + 2 * LDS_TILE + (srow + i * 32) * LDS_ROW + skc * 16) = rb[i];
  }
  __syncthreads();
  for (int kt = 0; kt < nk; ++kt) {
    const int cur = kt & 1;
    if (kt + 1 < nk) {
      if (kt + 1 == nk1) {
        ap = Ag2 + (size_t)srow * lda2 + skc * 8 - (size_t)nk1 * 64;
        bp = Bg2 + (size_t)srow * ldb2 + skc * 8 - (size_t)nk1 * 64;
        lda = lda2; ldb = ldb2;
      }
#pragma unroll
      for (int i = 0; i < 4; ++i) {
        ra[i] = *(const u32x4*)(ap + (size_t)i * 32 * lda + (kt + 1) * 64);
        rb[i] = *(const u32x4*)(bp + (size_t)i * 32 * ldb + (kt + 1) * 64);
      }
    }
    if (HASMID && kt == nk1) {
#pragma unroll
      for (int m = 0; m < 4; ++m)
#pragma unroll
        for (int n = 0; n < 4; ++n) {
          uint2 g1 = *(const uint2*)(gate0 + (size_t)(m * 16) * NPROJ_PAD + n * 16);
          uint2 g2 = *(const uint2*)(gate0 + (size_t)(m * 16) * NPROJ_PAD + 1024 + n * 16);
          acc[m][n][0] *= gate_ratio(bf2f((bf16_t)(g1.x & 0xffff)), bf2f((bf16_t)(g2.x & 0xffff)));
          acc[m][n][1] *= gate_ratio(bf2f((bf16_t)(g1.x >> 16)), bf2f((bf16_t)(g2.x >> 16)));
          acc[m][n][2] *= gate_ratio(bf2f((bf16_t)(g1.y & 0xffff)), bf2f((bf16_t)(g2.y & 0xffff)));
          acc[m][n][3] *= gate_ratio(bf2f((bf16_t)(g1.y >> 16)), bf2f((bf16_t)(g2.y >> 16)));
        }
    }
    const char* sa = smem + cur * LDS_TILE + (wr * 64 + fr) * LDS_ROW + fq * 16;
    const char* sb = smem + (2 + cur) * LDS_TILE + (wc * 64 + fr) * LDS_ROW + fq * 16;
#pragma unroll
    for (int kk = 0; kk < 2; ++kk) {
      bf16x8 af[4], bfv[4];
#pragma unroll
      for (int m = 0; m < 4; ++m) af[m] = *(const bf16x8*)(sa + m * 16 * LDS_ROW + kk * 64);
#pragma unroll
      for (int n = 0; n < 4; ++n) bfv[n] = *(const bf16x8*)(sb + n * 16 * LDS_ROW + kk * 64);
#pragma unroll
      for (int m = 0; m < 4; ++m)
#pragma unroll
        for (int n = 0; n < 4; ++n) acc[m][n] = __builtin_amdgcn_mfma_f32_16x16x32_bf16(bfv[n], af[m], acc[m][n], 0, 0, 0);
    }
    if (kt + 1 < nk) {
#pragma unroll
      for (int i = 0; i < 4; ++i) {
        *(u32x4*)(smem + (cur ^ 1) * LDS_TILE + (srow + i * 32) * LDS_ROW + skc * 16) = ra[i];
        *(u32x4*)(smem + (2 + (cur ^ 1)) * LDS_TILE + (srow + i * 32) * LDS_ROW + skc * 16) = rb[i];
      }
    }
    __syncthreads();
  }
}

__device__ __forceinline__ void gemm_kloop(f32x4 (&acc)[4][4], const bf16_t* __restrict__ Ag, int lda, const bf16_t* __restrict__ Bg,
                                           int ldb, int K, char* smem) {
  gemm_kloop2<false>(acc, Ag, lda, Bg, ldb, K, Ag, lda, Bg, ldb, 0, smem, Ag);
}
enum { G_PROJ = 0, G_MERGE = 1, G_OUT = 2, G_FFN1 = 3, G_FFN2 = 4 };

template <int MODE>
__device__ __forceinline__ void phase_gemm(const Params& p, int l, char* smem) {
  const int tid = tid_opaque(), lane = tid & 63, wid = tid >> 6;
  const int wr = wid >> 1, wc = wid & 1, fr = lane & 15, fq = lane >> 4;
  const bf16_t* wt = (const bf16_t*)(p.ws + OFF_WT) + (size_t)l * WT_LAYER;
  const bf16_t* hbuf = (const bf16_t*)(p.ws + OFF_H);
  bf16_t* proj = (bf16_t*)(p.ws + OFF_PROJ);
  bf16_t* hidden = (bf16_t*)(p.ws + OFF_PROJ);
  const float* modb = (const float*)(p.ws + OFF_MOD) + (size_t)l * 5 * 6144;
  constexpr int nM = T / 128;
  constexpr int nN = MODE == G_PROJ ? NPROJ_PAD / 128 : (MODE == G_FFN1 ? 5632 / 128 : 1024 / 128);
  for (int t = blockIdx.x; t < nM * nN; t += gridDim.x) {
    const int pm = t % nM, pn = t / nM;
    const int row0 = pm * 128, col0 = pn * 128;
    f32x4 acc[4][4];
#pragma unroll
    for (int m = 0; m < 4; ++m)
#pragma unroll
      for (int n = 0; n < 4; ++n) acc[m][n] = (f32x4){0.f, 0.f, 0.f, 0.f};
    if (MODE == G_PROJ) {
      gemm_kloop(acc, hbuf + (size_t)row0 * 1024, 1024, wt + WT_IN + (size_t)col0 * 1024, 1024, 1024, smem);
      float* dtraw = (float*)(p.ws + OFF_DTRAW);
#pragma unroll
      for (int m = 0; m < 4; ++m) {
        const int row = row0 + wr * 64 + m * 16 + fr;
#pragma unroll
        for (int n = 0; n < 4; ++n) {
          const int col = col0 + wc * 64 + n * 16 + fq * 4;
          uint2 o; o.x = pack2(acc[m][n][0], acc[m][n][1]); o.y = pack2(acc[m][n][2], acc[m][n][3]);
          *(uint2*)(proj + (size_t)row * NPROJ_PAD + col) = o;
          if (col >= C_DT && col < C_DT + 64) *(f32x4*)(dtraw + (size_t)row * 64 + (col - C_DT)) = acc[m][n];
        }
      }
    } else if (MODE == G_MERGE) {
      const bf16_t* ybuf = (const bf16_t*)(p.ws + OFF_YBUF);
      const bf16_t* obuf = (const bf16_t*)(p.ws + OFF_OBUF);
      bf16_t* mbuf = (bf16_t*)(p.ws + OFF_MBUF);
      gemm_kloop2<true>(acc, ybuf + (size_t)row0 * 2048, 2048, wt + WT_SSO + (size_t)col0 * 2048, 2048, 2048,
                        obuf + (size_t)row0 * 1024, 1024, wt + WT_HGO + (size_t)col0 * 1024, 1024, 1024, smem,
                        proj + (size_t)(row0 + wr * 64 + fr) * NPROJ_PAD + C_GATE + col0 + wc * 64 + fq * 4);
#pragma unroll
      for (int m = 0; m < 4; ++m) {
        const int row = row0 + wr * 64 + m * 16 + fr;
#pragma unroll
        for (int n = 0; n < 4; ++n) {
          const int col = col0 + wc * 64 + n * 16 + fq * 4;
          uint2 g = *(const uint2*)(proj + (size_t)row * NPROJ_PAD + C_GATE + 1024 + col);
          float r0 = acc[m][n][0] * sigmoidf_(clamp30(bf2f((bf16_t)(g.x & 0xffff))));
          float r1 = acc[m][n][1] * sigmoidf_(clamp30(bf2f((bf16_t)(g.x >> 16))));
          float r2 = acc[m][n][2] * sigmoidf_(clamp30(bf2f((bf16_t)(g.y & 0xffff))));
          float r3 = acc[m][n][3] * sigmoidf_(clamp30(bf2f((bf16_t)(g.y >> 16))));
          uint2 o; o.x = pack2(r0, r1); o.y = pack2(r2, r3);
          *(uint2*)(mbuf + (size_t)row * 1024 + col) = o;
        }
      }
    } else if (MODE == G_OUT || MODE == G_FFN2) {
      if (MODE == G_OUT) {
        const bf16_t* mbuf = (const bf16_t*)(p.ws + OFF_MBUF);
        gemm_kloop(acc, mbuf + (size_t)row0 * 1024, 1024, wt + WT_OUT + (size_t)col0 * 1024, 1024, 1024, smem);
      } else {
        gemm_kloop(acc, hidden + (size_t)row0 * FFN, FFN, wt + WT_W2 + (size_t)col0 * FFN, FFN, FFN, smem);
      }
      const float* gate = modb + (size_t)mod_row(row0) * 6144 + (MODE == G_OUT ? 2048 : 5120);
#pragma unroll
      for (int m = 0; m < 4; ++m) {
        const int row = row0 + wr * 64 + m * 16 + fr;
#pragma unroll
        for (int n = 0; n < 4; ++n) {
          const int col = col0 + wc * 64 + n * 16 + fq * 4;
          f32x4 g = *(const f32x4*)(gate + col);
          f32x4* xp = (f32x4*)(p.out + (size_t)row * 1024 + col);
          f32x4 xv = *xp;
          xv += g * acc[m][n];
          *xp = xv;
        }
      }
    } else {
      gemm_kloop(acc, hbuf + (size_t)row0 * 1024, 1024, wt + WT_W13 + (size_t)col0 * 1024, 1024, 1024, smem);
#pragma unroll
      for (int m = 0; m < 4; ++m) {
        const int row = row0 + wr * 64 + m * 16 + fr;
#pragma unroll
        for (int n = 0; n < 2; ++n) {
          const int hcol = (pn * 2 + wc) * 32 + n * 16 + fq * 4;
          float r[4];
#pragma unroll
          for (int j = 0; j < 4; ++j) r[j] = siluf_(acc[m][n][j]) * acc[m][n + 2][j];
          uint2 o; o.x = pack2(r[0], r[1]); o.y = pack2(r[2], r[3]);
          *(uint2*)(hidden + (size_t)row * FFN + hcol) = o;
        }
      }
    }
  }
}

__device__ __forceinline__ void phase_conv(const Params& p, int l) {
  const bf16_t* proj = (const bf16_t*)(p.ws + OFF_PROJ);
  bf16_t* xc = (bf16_t*)(p.ws + OFF_XC);
  const float* cw = p.ssd_conv_w + (size_t)l * 5 * 4096;
  const float* cb = p.ssd_conv_b + (size_t)l * 4096;
  const size_t total = (size_t)T * 512;
  for (size_t i = (size_t)blockIdx.x * 256 + tid_opaque(); i < total; i += (size_t)gridDim.x * 256) {
    const int tok = (int)(i >> 9), ch = (int)(i & 511) * 8;
    int pos, len;
    if (tok < TCTX) { pos = tok & 255; len = 256; } else { pos = (tok - TCTX) & 63; len = 64; }
    float a[8];
#pragma unroll
    for (int j = 0; j < 8; ++j) a[j] = cb[ch + j];
#pragma unroll
    for (int k = 0; k < 5; ++k) {
      const int q = pos + k - 2;
      if (q >= 0 && q < len) {
        uint4 v = *(const uint4*)(proj + (size_t)(tok + k - 2) * NPROJ_PAD + ch);
        const float* w = cw + k * 4096 + ch;
        a[0] += w[0] * bf2f((bf16_t)(v.x & 0xffff)); a[1] += w[1] * bf2f((bf16_t)(v.x >> 16));
        a[2] += w[2] * bf2f((bf16_t)(v.y & 0xffff)); a[3] += w[3] * bf2f((bf16_t)(v.y >> 16));
        a[4] += w[4] * bf2f((bf16_t)(v.z & 0xffff)); a[5] += w[5] * bf2f((bf16_t)(v.z >> 16));
        a[6] += w[6] * bf2f((bf16_t)(v.w & 0xffff)); a[7] += w[7] * bf2f((bf16_t)(v.w >> 16));
      }
    }
    uint4 o;
    o.x = pack2(siluf_(a[0]), siluf_(a[1])); o.y = pack2(siluf_(a[2]), siluf_(a[3]));
    o.z = pack2(siluf_(a[4]), siluf_(a[5])); o.w = pack2(siluf_(a[6]), siluf_(a[7]));
    *(uint4*)(xc + (size_t)tok * 4096 + ch) = o;
  }
  const float* dtraw = (const float*)(p.ws + OFF_DTRAW);
  float* dt = (float*)(p.ws + OFF_DT);
  for (size_t i = (size_t)blockIdx.x * 256 + tid_opaque(); i < (size_t)T * 64; i += (size_t)gridDim.x * 256) {
    float v = dtraw[i] + p.ssd_dt_bias[l * 64 + (int)(i & 63)];
    dt[i] = v > 20.f ? v : log1pf(expf(v));
  }
}

__device__ __forceinline__ void ssd_naive_item(const Params& p, int l, int item, float* sm) {
  const int d = item & 1, h = (item >> 1) & 31, s = item >> 6;
  int tok0, L;
  if (s < 32) { tok0 = s * 256; L = 256; } else { tok0 = TCTX + (s - 32) * 2048; L = 2048; }
  const int tid = tid_opaque(), pp = tid >> 2, nq = tid & 3, g = h >> 2;
  float S[32];
  if (s < 32) {
#pragma unroll
    for (int i = 0; i < 32; ++i) S[i] = 0.f;
  } else {
    const float* st = p.state_ssm + ((((size_t)(s - 32) * 4 + l) * 2 + d) * 32 + h) * 8192 + pp * 128 + nq * 32;
#pragma unroll
    for (int i = 0; i < 32; ++i) S[i] = st[i];
  }
  const float a = -expf(p.ssd_a_log[l * 64 + d * 32 + h]);
  float* xs = sm; float* Bs = sm + 1024; float* Cs = Bs + 2048; float* dts = Cs + 2048;
  const bf16_t* xc = (const bf16_t*)(p.ws + OFF_XC);
  const float* dtb = (const float*)(p.ws + OFF_DT);
  float* ydir = (float*)(p.ws + (d == 0 ? OFF_YF : OFF_YB));
  for (int bt = 0; bt < L / 16; ++bt) {
    const int tb = d == 0 ? bt * 16 : L - 16 - bt * 16;
    __syncthreads();
    for (int e = tid; e < 16 * 320; e += 256) {
      const int tt = e / 320, c = e % 320;
      const size_t base = (size_t)(tok0 + tb + tt) * 4096;
      if (c < 64) xs[tt * 64 + c] = bf2f(xc[base + h * 64 + c]);
      else if (c < 192) Bs[tt * 128 + c - 64] = bf2f(xc[base + 2048 + g * 128 + c - 64]);
      else Cs[tt * 128 + c - 192] = bf2f(xc[base + 3072 + g * 128 + c - 192]);
    }
    if (tid < 16) dts[tid] = dtb[(size_t)(tok0 + tb + tid) * 64 + d * 32 + h];
    __syncthreads();
    for (int i2 = 0; i2 < 16; ++i2) {
      const int tt = d == 0 ? i2 : 15 - i2;
      const float dt = dts[tt], dA = expf(dt * a), xdt = xs[tt * 64 + pp] * dt;
      float acc = 0.f;
      const float* Bp = Bs + tt * 128 + nq * 32;
      const float* Cp = Cs + tt * 128 + nq * 32;
#pragma unroll
      for (int i = 0; i < 32; ++i) { S[i] = dA * S[i] + xdt * Bp[i]; acc += S[i] * Cp[i]; }
      acc += __shfl_xor(acc, 1); acc += __shfl_xor(acc, 2);
      if (nq == 0) ydir[(size_t)(tok0 + tb + tt) * 2048 + h * 64 + pp] = acc;
    }
  }
  if (s < 32) {
    float* o = p.out + OUT_SSM + ((((size_t)s * 4 + l) * 2 + d) * 32 + h) * 8192 + pp * 128 + nq * 32;
#pragma unroll
    for (int i = 0; i < 32; ++i) o[i] = S[i];
  }
}

__device__ __forceinline__ void hgrn_naive_item(const Params& p, int l, int item, float* sm) {
  const int d = item & 1, hd = (item >> 1) & 7, s = item >> 4;
  int tok0, L;
  if (s < 32) { tok0 = s * 256; L = 256; } else { tok0 = TCTX + (s - 32) * 2048; L = 2048; }
  const int tid = tid_opaque(), vv = tid >> 1, kh = tid & 1;
  float S[64];
  if (s < 32) {
#pragma unroll
    for (int i = 0; i < 64; ++i) S[i] = 0.f;
  } else {
    const float* st = p.state_hgrn + ((((size_t)(s - 32) * 4 + l) * 2 + d) * 8 + hd) * 16384 + (size_t)(kh * 64) * 128 + vv;
#pragma unroll
    for (int i = 0; i < 64; ++i) S[i] = st[(size_t)i * 128];
  }
  float* qs = sm; float* fs = sm + 2048; float* ks = sm + 4096; float* vs = sm + 6144;
  const bf16_t* proj = (const bf16_t*)(p.ws + OFF_PROJ);
  const float* lb = (const float*)(p.ws + OFF_LB) + (size_t)l * 2048 + d * 1024 + hd * 128;
  float* odir = (float*)(p.ws + (d == 0 ? OFF_OF : OFF_OB));
  for (int bt = 0; bt < L / 16; ++bt) {
    const int tb = d == 0 ? bt * 16 : L - 16 - bt * 16;
    __syncthreads();
    for (int e = tid; e < 16 * 128; e += 256) {
      const int tt = e >> 7, c = e & 127;
      const size_t base = (size_t)(tok0 + tb + tt) * NPROJ_PAD;
      const float q = bf2f(proj[base + C_HQ + hd * 128 + c]);
      const float u = bf2f(proj[base + C_HF + d * 1024 + hd * 128 + c]);
      const float lbv = lb[c];
      const float sg = sigmoidf_(u);
      qs[e] = siluf_(q);
      fs[e] = lbv + (1.f - lbv) * sg;
      ks[e] = (1.f - lbv) * (1.f - sg);
      vs[e] = bf2f(proj[base + C_HI + hd * 128 + c]);
    }
    __syncthreads();
    for (int i2 = 0; i2 < 16; ++i2) {
      const int tt = d == 0 ? i2 : 15 - i2;
      const float vval = vs[tt * 128 + vv];
      const float* fp = fs + tt * 128 + kh * 64;
      const float* kp = ks + tt * 128 + kh * 64;
      const float* qp = qs + tt * 128 + kh * 64;
      float acc = 0.f;
#pragma unroll
      for (int i = 0; i < 64; ++i) { S[i] = fp[i] * S[i] + kp[i] * vval; acc += S[i] * qp[i]; }
      acc += __shfl_xor(acc, 1);
      if (kh == 0) odir[(size_t)(tok0 + tb + tt) * 1024 + hd * 128 + vv] = acc;
    }
  }
  if (s < 32) {
    float* o = p.out + OUT_HGRN + ((((size_t)s * 4 + l) * 2 + d) * 8 + hd) * 16384 + (size_t)(kh * 64) * 128 + vv;
#pragma unroll
    for (int i = 0; i < 64; ++i) o[(size_t)i * 128] = S[i];
  }
}

__device__ __forceinline__ void phase_scan_naive(const Params& p, int l, char* smem) {
  const int n_ssd = 36 * 64, n_hg = 36 * 16;
  for (int it = blockIdx.x; it < n_ssd + n_hg; it += gridDim.x) {
    if (it < 256) ssd_naive_item(p, l, 32 * 64 + it, (float*)smem);
    else if (it < 320) hgrn_naive_item(p, l, 32 * 16 + (it - 256), (float*)smem);
    else if (it < 320 + 2048) ssd_naive_item(p, l, it - 320, (float*)smem);
    else hgrn_naive_item(p, l, it - 320 - 2048, (float*)smem);
  }
}

__device__ __forceinline__ void phase_post(const Params& p, int l) {
  const int tid = tid_opaque();
  const bf16_t* proj = (const bf16_t*)(p.ws + OFF_PROJ);
  const bf16_t* xc = (const bf16_t*)(p.ws + OFF_XC);
  const float* yf = (const float*)(p.ws + OFF_YF);
  const float* yb = (const float*)(p.ws + OFF_YB);
  const float* of = (const float*)(p.ws + OFF_OF);
  const float* ob = (const float*)(p.ws + OFF_OB);
  bf16_t* ybuf = (bf16_t*)(p.ws + OFF_YBUF);
  bf16_t* obuf = (bf16_t*)(p.ws + OFF_OBUF);
  for (int tok = blockIdx.x; tok < T; tok += gridDim.x) {
    {
      const int ch = tid * 8, hh = ch >> 6;
      const float dsk = p.ssd_d[l * 32 + hh];
      const float* a = yf + (size_t)tok * 2048 + ch;
      const float* b = yb + (size_t)tok * 2048 + ch;
      uint4 xv = *(const uint4*)(xc + (size_t)tok * 4096 + ch);
      uint4 zv = *(const uint4*)(proj + (size_t)tok * NPROJ_PAD + C_Z + ch);
      const unsigned xw[4] = {xv.x, xv.y, xv.z, xv.w};
      const unsigned zw[4] = {zv.x, zv.y, zv.z, zv.w};
      float v[8];
      float ss = 0.f;
#pragma unroll
      for (int j = 0; j < 8; ++j) {
        const float xs = bf2f((bf16_t)((j & 1) ? (xw[j >> 1] >> 16) : (xw[j >> 1] & 0xffff)));
        const float z = bf2f((bf16_t)((j & 1) ? (zw[j >> 1] >> 16) : (zw[j >> 1] & 0xffff)));
        v[j] = (a[j] + b[j] + dsk * xs) * siluf_(z);
        ss += v[j] * v[j];
      }
#pragma unroll
      for (int o = 16; o >= 1; o >>= 1) ss += __shfl_xor(ss, o);
      const float rstd = rsqrtf(ss * (1.f / 256.f) + 1e-6f);
      const float* nw = p.ssd_norm_w + l * 2048 + ch;
      uint4 o4;
      o4.x = pack2(v[0] * rstd * nw[0], v[1] * rstd * nw[1]); o4.y = pack2(v[2] * rstd * nw[2], v[3] * rstd * nw[3]);
      o4.z = pack2(v[4] * rstd * nw[4], v[5] * rstd * nw[5]); o4.w = pack2(v[6] * rstd * nw[6], v[7] * rstd * nw[7]);
      *(uint4*)(ybuf + (size_t)tok * 2048 + ch) = o4;
    }
    {
      const int ch = tid * 4;
      const float* a = of + (size_t)tok * 1024 + ch;
      const float* b = ob + (size_t)tok * 1024 + ch;
      uint2 gv = *(const uint2*)(proj + (size_t)tok * NPROJ_PAD + C_HG + ch);
      const unsigned gw[2] = {gv.x, gv.y};
      float v[4];
      float ss = 0.f;
#pragma unroll
      for (int j = 0; j < 4; ++j) { v[j] = a[j] + b[j]; ss += v[j] * v[j]; }
#pragma unroll
      for (int o = 16; o >= 1; o >>= 1) ss += __shfl_xor(ss, o);
      const float rstd = rsqrtf(ss * (1.f / 128.f) + 1e-6f);
      const float* nw = p.hgrn_norm_w + l * 1024 + ch;
      float r[4];
#pragma unroll
      for (int j = 0; j < 4; ++j) {
        const float gz = bf2f((bf16_t)((j & 1) ? (gw[j >> 1] >> 16) : (gw[j >> 1] & 0xffff)));
        r[j] = v[j] * rstd * nw[j] * siluf_(gz);
      }
      uint2 o2; o2.x = pack2(r[0], r[1]); o2.y = pack2(r[2], r[3]);
      *(uint2*)(obuf + (size_t)tok * 1024 + ch) = o2;
    }
  }
}

enum { PH_SETUP = 0, PH_NORM1, PH_PROJ, PH_CONV, PH_SCAN, PH_POST, PH_MERGE, PH_OUT, PH_NORM2, PH_FFN1, PH_FFN2, PH_FINAL };

__device__ __forceinline__ void run_phase(const Params& p, int ph, int l, char* smem) {
  switch (ph) {
    case PH_SETUP: phase_setup(p, smem); break;
    case PH_NORM1: phase_norm(p, l, 0); break;
    case PH_PROJ: phase_gemm<G_PROJ>(p, l, smem); break;
    case PH_CONV: phase_conv(p, l); break;
    case PH_SCAN: phase_scan_naive(p, l, smem); break;
    case PH_POST: phase_post(p, l); break;
    case PH_MERGE: phase_gemm<G_MERGE>(p, l, smem); break;
    case PH_OUT: phase_gemm<G_OUT>(p, l, smem); break;
    case PH_NORM2: phase_norm(p, l, 1); break;
    case PH_FFN1: phase_gemm<G_FFN1>(p, l, smem); break;
    case PH_FFN2: phase_gemm<G_FFN2>(p, l, smem); break;
    case PH_FINAL: phase_final_norm(p); break;
  }
}

extern __shared__ __attribute__((aligned(16))) char dyn_smem[];

#if !MEGA
__global__ void __launch_bounds__(256, 2) phase_kernel(Params p, int ph, int l) { run_phase(p, ph, l, dyn_smem); }
#endif

#if MEGA
__global__ void __launch_bounds__(256, 2) mega_kernel(Params p) {
  cg::grid_group grid = cg::this_grid();
  phase_setup(p, dyn_smem);
  grid.sync();
  for (int l = 0; l < DEPTH; ++l) {
    phase_norm(p, l, 0); grid.sync();
    phase_gemm<G_PROJ>(p, l, dyn_smem); grid.sync();
    phase_conv(p, l); grid.sync();
    phase_scan_naive(p, l, dyn_smem); grid.sync();
    phase_post(p, l); grid.sync();
    phase_gemm<G_MERGE>(p, l, dyn_smem); grid.sync();
    phase_gemm<G_OUT>(p, l, dyn_smem); grid.sync();
    phase_norm(p, l, 1); grid.sync();
    phase_gemm<G_FFN1>(p, l, dyn_smem); grid.sync();
    phase_gemm<G_FFN2>(p, l, dyn_smem); grid.sync();
  }
  phase_final_norm(p);
}
#endif

extern "C" void kernel_launch(void* const* d_in, const int* in_sizes, int n_in, void* d_out, int out_size, void* d_ws, size_t ws_size,
                              hipStream_t stream) {
  static int grid_blocks = 0;
  if (!grid_blocks) {
    int dev = 0, cus = 0, per_cu = 0;
    (void)hipGetDevice(&dev);
    (void)hipDeviceGetAttribute(&cus, hipDeviceAttributeMultiprocessorCount, dev);
#if MEGA
    (void)hipFuncSetAttribute((const void*)mega_kernel, hipFuncAttributeMaxDynamicSharedMemorySize, SMEM_BYTES);
#endif
#if !MEGA
    (void)hipFuncSetAttribute((const void*)phase_kernel, hipFuncAttributeMaxDynamicSharedMemorySize, SMEM_BYTES);
#endif
#if MEGA
    (void)hipOccupancyMaxActiveBlocksPerMultiprocessor(&per_cu, mega_kernel, 256, SMEM_BYTES);
#else
    (void)hipOccupancyMaxActiveBlocksPerMultiprocessor(&per_cu, phase_kernel, 256, SMEM_BYTES);
#endif
    if (per_cu > 2) per_cu = 2;
    if (per_cu < 1) per_cu = 1;
    grid_blocks = cus * per_cu;
  }
  Params p{};
  const float** pf = (const float**)&p;
  for (int i = 0; i < 26; ++i) pf[i] = (const float*)d_in[i];
  p.out = (float*)d_out;
  p.ws = (char*)d_ws;
#if MEGA
  void* args[] = {&p};
  hipError_t e = hipLaunchCooperativeKernel((void*)mega_kernel, dim3(grid_blocks), dim3(256), args, SMEM_BYTES, stream);
  if (e != hipSuccess) fprintf(stderr, "coop launch failed: %s\n", hipGetErrorString(e));
#else
  const int G = grid_blocks;
  phase_kernel<<<G, 256, SMEM_BYTES, stream>>>(p, PH_SETUP, 0);
  for (int l = 0; l < DEPTH; ++l)
    for (int ph = PH_NORM1; ph <= PH_FFN2; ++ph) phase_kernel<<<G, 256, SMEM_BYTES, stream>>>(p, ph, l);
  phase_kernel<<<G, 256, SMEM_BYTES, stream>>>(p, PH_FINAL, 0);
#endif
}
```

```cpp
#include <hip/hip_runtime.h>
#include <hip/hip_cooperative_groups.h>
#include <cstdio>
#include <cstdint>
namespace cg = cooperative_groups;

#ifndef MEGA
#define MEGA 1
#endif

typedef unsigned short bf16_t;
typedef short bf16x8 __attribute__((ext_vector_type(8)));
typedef float f32x4 __attribute__((ext_vector_type(4)));
typedef unsigned u32x4 __attribute__((ext_vector_type(4)));
typedef short s16x4 __attribute__((ext_vector_type(4)));
typedef unsigned u32x2 __attribute__((ext_vector_type(2)));

constexpr int D = 1024, T = 16384, TCTX = 8192, DEPTH = 4;
constexpr int NPROJ = 13376, NPROJ_PAD = 13440;
constexpr int FFN = 2816;
constexpr int C_Z = 4096, C_DT = 6144, C_HQ = 6208, C_HF = 7232, C_HI = 9280, C_HG = 10304, C_GATE = 11328;
constexpr size_t WT_IN = 0;
constexpr size_t WT_SSO = WT_IN + (size_t)NPROJ_PAD * 1024;
constexpr size_t WT_HGO = WT_SSO + (size_t)1024 * 2048;
constexpr size_t WT_OUT = WT_HGO + (size_t)1024 * 1024;
constexpr size_t WT_W13 = WT_OUT + (size_t)1024 * 1024;
constexpr size_t WT_W2 = WT_W13 + (size_t)5632 * 1024;
constexpr size_t WT_LAYER = WT_W2 + (size_t)1024 * 2816;
constexpr size_t OFF_WT = 0;
constexpr size_t OFF_H = OFF_WT + WT_LAYER * 2 * DEPTH;
constexpr size_t OFF_PROJ = OFF_H + (size_t)T * 1024 * 2;
constexpr size_t OFF_XC = OFF_PROJ + (size_t)T * NPROJ_PAD * 2;
constexpr size_t OFF_DTRAW = OFF_XC + (size_t)T * 4096 * 2;
constexpr size_t OFF_DT = OFF_DTRAW + (size_t)T * 64 * 4;
constexpr size_t OFF_YF = OFF_DT + (size_t)T * 64 * 4;
constexpr size_t OFF_YB = OFF_YF + (size_t)T * 2048 * 4;
constexpr size_t OFF_OF = OFF_YB + (size_t)T * 2048 * 4;
constexpr size_t OFF_OB = OFF_OF + (size_t)T * 1024 * 4;
constexpr size_t OFF_YBUF = OFF_OB + (size_t)T * 1024 * 4;
constexpr size_t OFF_OBUF = OFF_YBUF + (size_t)T * 2048 * 2;
constexpr size_t OFF_MBUF = OFF_OBUF + (size_t)T * 1024 * 2;
constexpr size_t OFF_MOD = OFF_MBUF + (size_t)T * 1024 * 2;
constexpr size_t OFF_LB = OFF_MOD + (size_t)DEPTH * 5 * 6144 * 4;
constexpr size_t OFF_END = OFF_LB + (size_t)DEPTH * 2 * 1024 * 4;
constexpr size_t OUT_SSM = (size_t)T * 1024;
constexpr size_t OUT_HGRN = OUT_SSM + (size_t)32 * 4 * 2 * 32 * 64 * 128;

constexpr int SMEM_BYTES = 73728;
constexpr int LDS_ROW = 144;
constexpr int LDS_TILE = 128 * LDS_ROW;

struct Params {
  const float *x_prompt, *x_sample, *c, *state_ssm, *state_hgrn, *c_ctx, *norm_mix_w, *norm_ffn_w, *ada_w, *ada_b, *w_in,
      *ssd_conv_w, *ssd_conv_b, *ssd_dt_bias, *ssd_a_log, *ssd_d, *ssd_norm_w, *hgrn_lb, *hgrn_norm_w, *w_ssd_out, *w_hgrn_out,
      *w_out, *ffn_w1, *ffn_w3, *ffn_w2, *norm_final_w;
  float* out;
  char* ws;
};

__device__ __forceinline__ bf16_t f2bf(float f) {
  unsigned u = __float_as_uint(f);
  u += 0x7fffu + ((u >> 16) & 1u);
  return (bf16_t)(u >> 16);
}
__device__ __forceinline__ float bf2f(bf16_t b) { return __uint_as_float(((unsigned)b) << 16); }
typedef __bf16 bf16x2_t __attribute__((ext_vector_type(2)));
__device__ __forceinline__ unsigned pack2(float a, float b) { bf16x2_t v = {(__bf16)a, (__bf16)b}; return __builtin_bit_cast(unsigned, v); }
__device__ __forceinline__ float sigmoidf_(float x) { return 1.0f / (1.0f + __expf(-x)); }
__device__ __forceinline__ float siluf_(float x) { return x / (1.0f + __expf(-x)); }
__device__ __forceinline__ int tid_opaque() { int t = threadIdx.x; asm volatile("" : "+v"(t)); return t; }
__device__ __forceinline__ float clamp30(float x) { return fminf(fmaxf(x, -30.f), 30.f); }
__device__ __forceinline__ float gate_ratio(float g1, float g2) { return (1.0f + __expf(-clamp30(g2))) / (1.0f + __expf(-clamp30(g1))); }
__device__ __forceinline__ int mod_row(int tok) { return tok < TCTX ? 0 : 1 + ((tok - TCTX) >> 11); }

__device__ __forceinline__ void phase_setup(const Params& p, char* smem) {
  const int tid = tid_opaque(), bid = blockIdx.x, G = gridDim.x;
  {
    const size_t n4 = (size_t)T * 1024 / 4, half4 = (size_t)TCTX * 1024 / 4;
    float4* dst = (float4*)p.out;
    const float4* s0 = (const float4*)p.x_prompt;
    const float4* s1 = (const float4*)p.x_sample;
    for (size_t i = (size_t)bid * 256 + tid; i < n4; i += (size_t)G * 256) dst[i] = i < half4 ? s0[i] : s1[i - half4];
  }
  {
    float* lb = (float*)(p.ws + OFF_LB);
    for (int i = bid * 256 + tid; i < 2048; i += G * 256) {
      float v0 = p.hgrn_lb[i], v1 = p.hgrn_lb[2048 + i], v2 = p.hgrn_lb[4096 + i], v3 = p.hgrn_lb[6144 + i];
      float m = fmaxf(fmaxf(v0, v1), fmaxf(v2, v3));
      float e0 = expf(v0 - m), e1 = expf(v1 - m), e2 = expf(v2 - m), e3 = expf(v3 - m);
      float inv = 1.0f / (e0 + e1 + e2 + e3);
      lb[i] = 0.f;
      lb[2048 + i] = e1 * inv;
      lb[4096 + i] = (e1 + e2) * inv;
      lb[6144 + i] = (e1 + e2 + e3) * inv;
    }
  }
  {
    float* sm = (float*)smem;
    float* modb = (float*)(p.ws + OFF_MOD);
    __syncthreads();
    for (int i = tid; i < 5 * 1024; i += 256) {
      int v = i >> 10, k = i & 1023;
      float cv = v == 0 ? p.c_ctx[k] : p.c[(v - 1) * 1024 + k];
      sm[i] = siluf_(cv);
    }
    __syncthreads();
    float* part = sm + 5 * 1024;
    for (int item = bid; item < DEPTH * 96; item += G) {
      int l = item / 96, cg_ = item % 96;
      int col = cg_ * 64 + (tid & 63), kg = tid >> 6;
      const float* w = p.ada_w + (size_t)l * 1024 * 6144 + col;
      float a0 = 0, a1 = 0, a2 = 0, a3 = 0, a4 = 0;
      for (int k = kg * 256; k < kg * 256 + 256; ++k) {
        float wv = w[(size_t)k * 6144];
        a0 += sm[k] * wv; a1 += sm[1024 + k] * wv; a2 += sm[2048 + k] * wv; a3 += sm[3072 + k] * wv; a4 += sm[4096 + k] * wv;
      }
      __syncthreads();
      part[(kg * 5 + 0) * 64 + (tid & 63)] = a0; part[(kg * 5 + 1) * 64 + (tid & 63)] = a1; part[(kg * 5 + 2) * 64 + (tid & 63)] = a2;
      part[(kg * 5 + 3) * 64 + (tid & 63)] = a3; part[(kg * 5 + 4) * 64 + (tid & 63)] = a4;
      __syncthreads();
      for (int i = tid; i < 320; i += 256) {
        int v = i >> 6, cc = i & 63;
        float s = part[(0 * 5 + v) * 64 + cc] + part[(1 * 5 + v) * 64 + cc] + part[(2 * 5 + v) * 64 + cc] + part[(3 * 5 + v) * 64 + cc];
        int colo = cg_ * 64 + cc;
        modb[((size_t)l * 5 + v) * 6144 + colo] = s + p.ada_b[l * 6144 + colo];
      }
    }
    __syncthreads();
  }
  {
    float* tile = (float*)smem;
    const int n_in = 210 * 16, n_sso = 16 * 32, n_hgo = 16 * 16, n_out = 16 * 16, n_w13 = 88 * 16, n_w2 = 16 * 44;
    const int per_layer = n_in + n_sso + n_hgo + n_out + n_w13 + n_w2;
    for (int it = bid; it < per_layer * DEPTH; it += G) {
      int l = it / per_layer, r = it % per_layer;
      bf16_t* wt = (bf16_t*)(p.ws + OFF_WT) + (size_t)l * WT_LAYER;
      const float *src0 = nullptr, *src1 = nullptr;
      int K, Nsrc, nt, kt;
      bf16_t* dst;
      bool zero = false;
      if (r < n_in) {
        nt = r / 16; kt = r % 16; K = 1024; Nsrc = NPROJ;
        dst = wt + WT_IN;
        if (nt >= 209) zero = true;
        src0 = p.w_in + (size_t)l * 1024 * NPROJ + nt * 64; src1 = src0 + 32;
      } else if ((r -= n_in) < n_sso) {
        nt = r / 32; kt = r % 32; K = 2048; Nsrc = 1024; dst = wt + WT_SSO;
        src0 = p.w_ssd_out + (size_t)l * 2048 * 1024 + nt * 64; src1 = src0 + 32;
      } else if ((r -= n_sso) < n_hgo) {
        nt = r / 16; kt = r % 16; K = 1024; Nsrc = 1024; dst = wt + WT_HGO;
        src0 = p.w_hgrn_out + (size_t)l * 1024 * 1024 + nt * 64; src1 = src0 + 32;
      } else if ((r -= n_hgo) < n_out) {
        nt = r / 16; kt = r % 16; K = 1024; Nsrc = 1024; dst = wt + WT_OUT;
        src0 = p.w_out + (size_t)l * 1024 * 1024 + nt * 64; src1 = src0 + 32;
      } else if ((r -= n_out) < n_w13) {
        nt = r / 16; kt = r % 16; K = 1024; Nsrc = FFN; dst = wt + WT_W13;
        src0 = p.ffn_w1 + (size_t)l * 1024 * FFN + nt * 32; src1 = p.ffn_w3 + (size_t)l * 1024 * FFN + nt * 32;
      } else {
        r -= n_w13;
        nt = r / 44; kt = r % 44; K = 2816; Nsrc = 1024; dst = wt + WT_W2;
        src0 = p.ffn_w2 + (size_t)l * 2816 * 1024 + nt * 64; src1 = src0 + 32;
      }
      __syncthreads();
      {
        int c4 = (tid & 15) * 4;
        const float* s = c4 < 32 ? src0 + c4 : src1 + (c4 - 32);
#pragma unroll
        for (int i = 0; i < 4; ++i) {
          int kr = (tid >> 4) + i * 16;
          float4 v = zero ? make_float4(0.f, 0.f, 0.f, 0.f) : *(const float4*)(s + (size_t)(kt * 64 + kr) * Nsrc);
          tile[kr * 65 + c4 + 0] = v.x; tile[kr * 65 + c4 + 1] = v.y; tile[kr * 65 + c4 + 2] = v.z; tile[kr * 65 + c4 + 3] = v.w;
        }
      }
      __syncthreads();
#pragma unroll
      for (int i = 0; i < 2; ++i) {
        int cidx = tid + i * 256, n = cidx >> 3, kc = cidx & 7;
        uint4 o;
        o.x = pack2(tile[(kc * 8 + 0) * 65 + n], tile[(kc * 8 + 1) * 65 + n]);
        o.y = pack2(tile[(kc * 8 + 2) * 65 + n], tile[(kc * 8 + 3) * 65 + n]);
        o.z = pack2(tile[(kc * 8 + 4) * 65 + n], tile[(kc * 8 + 5) * 65 + n]);
        o.w = pack2(tile[(kc * 8 + 6) * 65 + n], tile[(kc * 8 + 7) * 65 + n]);
        *(uint4*)(dst + (size_t)(nt * 64 + n) * K + kt * 64 + kc * 8) = o;
      }
    }
    __syncthreads();
  }
}

__device__ __forceinline__ void phase_norm(const Params& p, int l, int which) {
  const int lane = tid_opaque() & 63, wv = tid_opaque() >> 6;
  const float* nw = (which == 0 ? p.norm_mix_w : p.norm_ffn_w) + l * 1024;
  const float* modb = (const float*)(p.ws + OFF_MOD) + (size_t)l * 5 * 6144;
  bf16_t* h = (bf16_t*)(p.ws + OFF_H);
  for (int row = blockIdx.x * 4 + wv; row < T; row += gridDim.x * 4) {
    const float* x = p.out + (size_t)row * 1024;
    const float* md = modb + (size_t)mod_row(row) * 6144 + (which == 0 ? 0 : 3072);
    float4 v[4];
    float ss = 0.f;
#pragma unroll
    for (int i = 0; i < 4; ++i) {
      v[i] = *(const float4*)(x + i * 256 + lane * 4);
      ss += v[i].x * v[i].x + v[i].y * v[i].y + v[i].z * v[i].z + v[i].w * v[i].w;
    }
#pragma unroll
    for (int o = 32; o >= 1; o >>= 1) ss += __shfl_xor(ss, o);
    float rstd = rsqrtf(ss * (1.0f / 1024.f) + 1e-6f);
#pragma unroll
    for (int i = 0; i < 4; ++i) {
      int c = i * 256 + lane * 4;
      float4 w = *(const float4*)(nw + c), sh = *(const float4*)(md + c), sc = *(const float4*)(md + 1024 + c);
      float a0 = v[i].x * rstd * w.x * (1.f + sc.x) + sh.x, a1 = v[i].y * rstd * w.y * (1.f + sc.y) + sh.y;
      float a2 = v[i].z * rstd * w.z * (1.f + sc.z) + sh.z, a3 = v[i].w * rstd * w.w * (1.f + sc.w) + sh.w;
      uint2 o2; o2.x = pack2(a0, a1); o2.y = pack2(a2, a3);
      *(uint2*)(h + (size_t)row * 1024 + c) = o2;
    }
  }
}

__device__ __forceinline__ void phase_final_norm(const Params& p) {
  const int lane = tid_opaque() & 63, wv = tid_opaque() >> 6;
  for (int row = blockIdx.x * 4 + wv; row < T; row += gridDim.x * 4) {
    float* x = p.out + (size_t)row * 1024;
    float4 v[4];
    float ss = 0.f;
#pragma unroll
    for (int i = 0; i < 4; ++i) {
      v[i] = *(const float4*)(x + i * 256 + lane * 4);
      ss += v[i].x * v[i].x + v[i].y * v[i].y + v[i].z * v[i].z + v[i].w * v[i].w;
    }
#pragma unroll
    for (int o = 32; o >= 1; o >>= 1) ss += __shfl_xor(ss, o);
    float rstd = rsqrtf(ss * (1.0f / 1024.f) + 1e-6f);
#pragma unroll
    for (int i = 0; i < 4; ++i) {
      int c = i * 256 + lane * 4;
      float4 w = *(const float4*)(p.norm_final_w + c);
      float4 o4 = make_float4(v[i].x * rstd * w.x, v[i].y * rstd * w.y, v[i].z * rstd * w.z, v[i].w * rstd * w.w);
      *(float4*)(x + c) = o4;
    }
  }
}

template <bool HASMID>
__device__ __forceinline__ void gemm_kloop2(f32x4 (&acc)[4][4], const bf16_t* __restrict__ Ag, int lda, const bf16_t* __restrict__ Bg,
                                            int ldb, int K, const bf16_t* __restrict__ Ag2, int lda2, const bf16_t* __restrict__ Bg2,
                                            int ldb2, int K2, char* smem, const bf16_t* __restrict__ gate0) {
  const int tid = tid_opaque(), lane = tid & 63, wid = tid >> 6;
  const int wr = wid >> 1, wc = wid & 1, fr = lane & 15, fq = lane >> 4;
  const int srow = tid >> 3, skc = tid & 7;
  const bf16_t* ap = Ag + (size_t)srow * lda + skc * 8;
  const bf16_t* bp = Bg + (size_t)srow * ldb + skc * 8;
  u32x4 ra[4], rb[4];
  const int nk1 = K >> 6;
  const int nk = nk1 + (K2 >> 6);
#pragma unroll
  for (int i = 0; i < 4; ++i) {
    ra[i] = *(const u32x4*)(ap + (size_t)i * 32 * lda);
    rb[i] = *(const u32x4*)(bp + (size_t)i * 32 * ldb);
  }
#pragma unroll
  for (int i = 0; i < 4; ++i) {
    *(u32x4*)(smem + (srow + i * 32) * LDS_ROW + skc * 16) = ra[i];
    *(u32x4*)(smem + 2 * LDS_TILE + (srow + i * 32) * LDS_ROW + skc * 16) = rb[i];
  }
  __syncthreads();
  for (int kt = 0; kt < nk; ++kt) {
    const int cur = kt & 1;
    if (kt + 1 < nk) {
      if (kt + 1 == nk1) {
        ap = Ag2 + (size_t)srow * lda2 + skc * 8 - (size_t)nk1 * 64;
        bp = Bg2 + (size_t)srow * ldb2 + skc * 8 - (size_t)nk1 * 64;
        lda = lda2; ldb = ldb2;
      }
#pragma unroll
      for (int i = 0; i < 4; ++i) {
        ra[i] = *(const u32x4*)(ap + (size_t)i * 32 * lda + (kt + 1) * 64);
        rb[i] = *(const u32x4*)(bp + (size_t)i * 32 * ldb + (kt + 1) * 64);
      }
    }
    if (HASMID && kt == nk1) {
#pragma unroll
      for (int m = 0; m < 4; ++m)
#pragma unroll
        for (int n = 0; n < 4; ++n) {
          uint2 g1 = *(const uint2*)(gate0 + (size_t)(m * 16) * NPROJ_PAD + n * 16);
          uint2 g2 = *(const uint2*)(gate0 + (size_t)(m * 16) * NPROJ_PAD + 1024 + n * 16);
          acc[m][n][0] *= gate_ratio(bf2f((bf16_t)(g1.x & 0xffff)), bf2f((bf16_t)(g2.x & 0xffff)));
          acc[m][n][1] *= gate_ratio(bf2f((bf16_t)(g1.x >> 16)), bf2f((bf16_t)(g2.x >> 16)));
          acc[m][n][2] *= gate_ratio(bf2f((bf16_t)(g1.y & 0xffff)), bf2f((bf16_t)(g2.y & 0xffff)));
          acc[m][n][3] *= gate_ratio(bf2f((bf16_t)(g1.y >> 16)), bf2f((bf16_t)(g2.y >> 16)));
        }
    }
    const char* sa = smem + cur * LDS_TILE + (wr * 64 + fr) * LDS_ROW + fq * 16;
    const char* sb = smem + (2 + cur) * LDS_TILE + (wc * 64 + fr) * LDS_ROW + fq * 16;
#pragma unroll
    for (int kk = 0; kk < 2; ++kk) {
      bf16x8 af[4], bfv[4];
#pragma unroll
      for (int m = 0; m < 4; ++m) af[m] = *(const bf16x8*)(sa + m * 16 * LDS_ROW + kk * 64);
#pragma unroll
      for (int n = 0; n < 4; ++n) bfv[n] = *(const bf16x8*)(sb + n * 16 * LDS_ROW + kk * 64);
#pragma unroll
      for (int m = 0; m < 4; ++m)
#pragma unroll
        for (int n = 0; n < 4; ++n) acc[m][n] = __builtin_amdgcn_mfma_f32_16x16x32_bf16(bfv[n], af[m], acc[m][n], 0, 0, 0);
    }
    if (kt + 1 < nk) {
#pragma unroll
      for (int i = 0; i < 4; ++i) {
        *(u32x4*)(smem + (cur ^ 1) * LDS_TILE + (srow + i * 32) * LDS_ROW + skc * 16) = ra[i];
        *(u32x4*)(smem + (2 + (cur ^ 1)) * LDS_TILE + (srow + i * 32) * LDS_ROW + skc * 16) = rb[i];
      }
    }
    __syncthreads();
  }
}

__device__ __forceinline__ void gemm_kloop(f32x4 (&acc)[4][4], const bf16_t* __restrict__ Ag, int lda, const bf16_t* __restrict__ Bg,
                                           int ldb, int K, char* smem) {
  gemm_kloop2<false>(acc, Ag, lda, Bg, ldb, K, Ag, lda, Bg, ldb, 0, smem, Ag);
}
enum { G_PROJ = 0, G_MERGE = 1, G_OUT = 2, G_FFN1 = 3, G_FFN2 = 4 };

template <int MODE>
__device__ __forceinline__ void phase_gemm(const Params& p, int l, char* smem) {
  const int tid = tid_opaque(), lane = tid & 63, wid = tid >> 6;
  const int wr = wid >> 1, wc = wid & 1, fr = lane & 15, fq = lane >> 4;
  const bf16_t* wt = (const bf16_t*)(p.ws + OFF_WT) + (size_t)l * WT_LAYER;
  const bf16_t* hbuf = (const bf16_t*)(p.ws + OFF_H);
  bf16_t* proj = (bf16_t*)(p.ws + OFF_PROJ);
  bf16_t* hidden = (bf16_t*)(p.ws + OFF_PROJ);
  const float* modb = (const float*)(p.ws + OFF_MOD) + (size_t)l * 5 * 6144;
  constexpr int nM = T / 128;
  constexpr int nN = MODE == G_PROJ ? NPROJ_PAD / 128 : (MODE == G_FFN1 ? 5632 / 128 : 1024 / 128);
  for (int t = blockIdx.x; t < nM * nN; t += gridDim.x) {
    const int pm = t % nM, pn = t / nM;
    const int row0 = pm * 128, col0 = pn * 128;
    f32x4 acc[4][4];
#pragma unroll
    for (int m = 0; m < 4; ++m)
#pragma unroll
      for (int n = 0; n < 4; ++n) acc[m][n] = (f32x4){0.f, 0.f, 0.f, 0.f};
    if (MODE == G_PROJ) {
      gemm_kloop(acc, hbuf + (size_t)row0 * 1024, 1024, wt + WT_IN + (size_t)col0 * 1024, 1024, 1024, smem);
      float* dtraw = (float*)(p.ws + OFF_DTRAW);
#pragma unroll
      for (int m = 0; m < 4; ++m) {
        const int row = row0 + wr * 64 + m * 16 + fr;
#pragma unroll
        for (int n = 0; n < 4; ++n) {
          const int col = col0 + wc * 64 + n * 16 + fq * 4;
          uint2 o; o.x = pack2(acc[m][n][0], acc[m][n][1]); o.y = pack2(acc[m][n][2], acc[m][n][3]);
          *(uint2*)(proj + (size_t)row * NPROJ_PAD + col) = o;
          if (col >= C_DT && col < C_DT + 64) *(f32x4*)(dtraw + (size_t)row * 64 + (col - C_DT)) = acc[m][n];
        }
      }
    } else if (MODE == G_MERGE) {
      const bf16_t* ybuf = (const bf16_t*)(p.ws + OFF_YBUF);
      const bf16_t* obuf = (const bf16_t*)(p.ws + OFF_OBUF);
      bf16_t* mbuf = (bf16_t*)(p.ws + OFF_MBUF);
      gemm_kloop2<true>(acc, ybuf + (size_t)row0 * 2048, 2048, wt + WT_SSO + (size_t)col0 * 2048, 2048, 2048,
                        obuf + (size_t)row0 * 1024, 1024, wt + WT_HGO + (size_t)col0 * 1024, 1024, 1024, smem,
                        proj + (size_t)(row0 + wr * 64 + fr) * NPROJ_PAD + C_GATE + col0 + wc * 64 + fq * 4);
#pragma unroll
      for (int m = 0; m < 4; ++m) {
        const int row = row0 + wr * 64 + m * 16 + fr;
#pragma unroll
        for (int n = 0; n < 4; ++n) {
          const int col = col0 + wc * 64 + n * 16 + fq * 4;
          uint2 g = *(const uint2*)(proj + (size_t)row * NPROJ_PAD + C_GATE + 1024 + col);
          float r0 = acc[m][n][0] * sigmoidf_(clamp30(bf2f((bf16_t)(g.x & 0xffff))));
          float r1 = acc[m][n][1] * sigmoidf_(clamp30(bf2f((bf16_t)(g.x >> 16))));
          float r2 = acc[m][n][2] * sigmoidf_(clamp30(bf2f((bf16_t)(g.y & 0xffff))));
          float r3 = acc[m][n][3] * sigmoidf_(clamp30(bf2f((bf16_t)(g.y >> 16))));
          uint2 o; o.x = pack2(r0, r1); o.y = pack2(r2, r3);
          *(uint2*)(mbuf + (size_t)row * 1024 + col) = o;
        }
      }
    } else if (MODE == G_OUT || MODE == G_FFN2) {
      if (MODE == G_OUT) {
        const bf16_t* mbuf = (const bf16_t*)(p.ws + OFF_MBUF);
        gemm_kloop(acc, mbuf + (size_t)row0 * 1024, 1024, wt + WT_OUT + (size_t)col0 * 1024, 1024, 1024, smem);
      } else {
        gemm_kloop(acc, hidden + (size_t)row0 * FFN, FFN, wt + WT_W2 + (size_t)col0 * FFN, FFN, FFN, smem);
      }
      const float* gate = modb + (size_t)mod_row(row0) * 6144 + (MODE == G_OUT ? 2048 : 5120);
#pragma unroll
      for (int m = 0; m < 4; ++m) {
        const int row = row0 + wr * 64 + m * 16 + fr;
#pragma unroll
        for (int n = 0; n < 4; ++n) {
          const int col = col0 + wc * 64 + n * 16 + fq * 4;
          f32x4 g = *(const f32x4*)(gate + col);
          f32x4* xp = (f32x4*)(p.out + (size_t)row * 1024 + col);
          f32x4 xv = *xp;
          xv += g * acc[m][n];
          *xp = xv;
        }
      }
    } else {
      gemm_kloop(acc, hbuf + (size_t)row0 * 1024, 1024, wt + WT_W13 + (size_t)col0 * 1024, 1024, 1024, smem);
#pragma unroll
      for (int m = 0; m < 4; ++m) {
        const int row = row0 + wr * 64 + m * 16 + fr;
#pragma unroll
        for (int n = 0; n < 2; ++n) {
          const int hcol = (pn * 2 + wc) * 32 + n * 16 + fq * 4;
          float r[4];
#pragma unroll
          for (int j = 0; j < 4; ++j) r[j] = siluf_(acc[m][n][j]) * acc[m][n + 2][j];
          uint2 o; o.x = pack2(r[0], r[1]); o.y = pack2(r[2], r[3]);
          *(uint2*)(hidden + (size_t)row * FFN + hcol) = o;
        }
      }
    }
  }
}

__device__ __forceinline__ void phase_conv(const Params& p, int l) {
  const bf16_t* proj = (const bf16_t*)(p.ws + OFF_PROJ);
  bf16_t* xc = (bf16_t*)(p.ws + OFF_XC);
  const float* cw = p.ssd_conv_w + (size_t)l * 5 * 4096;
  const float* cb = p.ssd_conv_b + (size_t)l * 4096;
  const size_t total = (size_t)T * 512;
  for (size_t i = (size_t)blockIdx.x * 256 + tid_opaque(); i < total; i += (size_t)gridDim.x * 256) {
    const int tok = (int)(i >> 9), ch = (int)(i & 511) * 8;
    int pos, len;
    if (tok < TCTX) { pos = tok & 255; len = 256; } else { pos = (tok - TCTX) & 63; len = 64; }
    float a[8];
#pragma unroll
    for (int j = 0; j < 8; ++j) a[j] = cb[ch + j];
#pragma unroll
    for (int k = 0; k < 5; ++k) {
      const int q = pos + k - 2;
      if (q >= 0 && q < len) {
        uint4 v = *(const uint4*)(proj + (size_t)(tok + k - 2) * NPROJ_PAD + ch);
        const float* w = cw + k * 4096 + ch;
        a[0] += w[0] * bf2f((bf16_t)(v.x & 0xffff)); a[1] += w[1] * bf2f((bf16_t)(v.x >> 16));
        a[2] += w[2] * bf2f((bf16_t)(v.y & 0xffff)); a[3] += w[3] * bf2f((bf16_t)(v.y >> 16));
        a[4] += w[4] * bf2f((bf16_t)(v.z & 0xffff)); a[5] += w[5] * bf2f((bf16_t)(v.z >> 16));
        a[6] += w[6] * bf2f((bf16_t)(v.w & 0xffff)); a[7] += w[7] * bf2f((bf16_t)(v.w >> 16));
      }
    }
    uint4 o;
    o.x = pack2(siluf_(a[0]), siluf_(a[1])); o.y = pack2(siluf_(a[2]), siluf_(a[3]));
    o.z = pack2(siluf_(a[4]), siluf_(a[5])); o.w = pack2(siluf_(a[6]), siluf_(a[7]));
    *(uint4*)(xc + (size_t)tok * 4096 + ch) = o;
  }
  const float* dtraw = (const float*)(p.ws + OFF_DTRAW);
  float* dt = (float*)(p.ws + OFF_DT);
  for (size_t i = (size_t)blockIdx.x * 256 + tid_opaque(); i < (size_t)T * 64; i += (size_t)gridDim.x * 256) {
    float v = dtraw[i] + p.ssd_dt_bias[l * 64 + (int)(i & 63)];
    dt[i] = v > 20.f ? v : log1pf(expf(v));
  }
}

__device__ __forceinline__ void ssd_naive_item(const Params& p, int l, int item, float* sm) {
  const int d = item & 1, h = (item >> 1) & 31, s = item >> 6;
  int tok0, L;
  if (s < 32) { tok0 = s * 256; L = 256; } else { tok0 = TCTX + (s - 32) * 2048; L = 2048; }
  const int tid = tid_opaque(), pp = tid >> 2, nq = tid & 3, g = h >> 2;
  float S[32];
  if (s < 32) {
#pragma unroll
    for (int i = 0; i < 32; ++i) S[i] = 0.f;
  } else {
    const float* st = p.state_ssm + ((((size_t)(s - 32) * 4 + l) * 2 + d) * 32 + h) * 8192 + pp * 128 + nq * 32;
#pragma unroll
    for (int i = 0; i < 32; ++i) S[i] = st[i];
  }
  const float a = -expf(p.ssd_a_log[l * 64 + d * 32 + h]);
  float* xs = sm; float* Bs = sm + 1024; float* Cs = Bs + 2048; float* dts = Cs + 2048;
  const bf16_t* xc = (const bf16_t*)(p.ws + OFF_XC);
  const float* dtb = (const float*)(p.ws + OFF_DT);
  float* ydir = (float*)(p.ws + (d == 0 ? OFF_YF : OFF_YB));
  for (int bt = 0; bt < L / 16; ++bt) {
    const int tb = d == 0 ? bt * 16 : L - 16 - bt * 16;
    __syncthreads();
    for (int e = tid; e < 16 * 320; e += 256) {
      const int tt = e / 320, c = e % 320;
      const size_t base = (size_t)(tok0 + tb + tt) * 4096;
      if (c < 64) xs[tt * 64 + c] = bf2f(xc[base + h * 64 + c]);
      else if (c < 192) Bs[tt * 128 + c - 64] = bf2f(xc[base + 2048 + g * 128 + c - 64]);
      else Cs[tt * 128 + c - 192] = bf2f(xc[base + 3072 + g * 128 + c - 192]);
    }
    if (tid < 16) dts[tid] = dtb[(size_t)(tok0 + tb + tid) * 64 + d * 32 + h];
    __syncthreads();
    for (int i2 = 0; i2 < 16; ++i2) {
      const int tt = d == 0 ? i2 : 15 - i2;
      const float dt = dts[tt], dA = expf(dt * a), xdt = xs[tt * 64 + pp] * dt;
      float acc = 0.f;
      const float* Bp = Bs + tt * 128 + nq * 32;
      const float* Cp = Cs + tt * 128 + nq * 32;
#pragma unroll
      for (int i = 0; i < 32; ++i) { S[i] = dA * S[i] + xdt * Bp[i]; acc += S[i] * Cp[i]; }
      acc += __shfl_xor(acc, 1); acc += __shfl_xor(acc, 2);
      if (nq == 0) ydir[(size_t)(tok0 + tb + tt) * 2048 + h * 64 + pp] = acc;
    }
  }
  if (s < 32) {
    float* o = p.out + OUT_SSM + ((((size_t)s * 4 + l) * 2 + d) * 32 + h) * 8192 + pp * 128 + nq * 32;
#pragma unroll
    for (int i = 0; i < 32; ++i) o[i] = S[i];
  }
}

__device__ __forceinline__ void hgrn_naive_item(const Params& p, int l, int item, float* sm) {
  const int d = item & 1, hd = (item >> 1) & 7, s = item >> 4;
  int tok0, L;
  if (s < 32) { tok0 = s * 256; L = 256; } else { tok0 = TCTX + (s - 32) * 2048; L = 2048; }
  const int tid = tid_opaque(), vv = tid >> 1, kh = tid & 1;
  float S[64];
  if (s < 32) {
#pragma unroll
    for (int i = 0; i < 64; ++i) S[i] = 0.f;
  } else {
    const float* st = p.state_hgrn + ((((size_t)(s - 32) * 4 + l) * 2 + d) * 8 + hd) * 16384 + (size_t)(kh * 64) * 128 + vv;
#pragma unroll
    for (int i = 0; i < 64; ++i) S[i] = st[(size_t)i * 128];
  }
  float* qs = sm; float* fs = sm + 2048; float* ks = sm + 4096; float* vs = sm + 6144;
  const bf16_t* proj = (const bf16_t*)(p.ws + OFF_PROJ);
  const float* lb = (const float*)(p.ws + OFF_LB) + (size_t)l * 2048 + d * 1024 + hd * 128;
  float* odir = (float*)(p.ws + (d == 0 ? OFF_OF : OFF_OB));
  for (int bt = 0; bt < L / 16; ++bt) {
    const int tb = d == 0 ? bt * 16 : L - 16 - bt * 16;
    __syncthreads();
    for (int e = tid; e < 16 * 128; e += 256) {
      const int tt = e >> 7, c = e & 127;
      const size_t base = (size_t)(tok0 + tb + tt) * NPROJ_PAD;
      const float q = bf2f(proj[base + C_HQ + hd * 128 + c]);
      const float u = bf2f(proj[base + C_HF + d * 1024 + hd * 128 + c]);
      const float lbv = lb[c];
      const float sg = sigmoidf_(u);
      qs[e] = siluf_(q);
      fs[e] = lbv + (1.f - lbv) * sg;
      ks[e] = (1.f - lbv) * (1.f - sg);
      vs[e] = bf2f(proj[base + C_HI + hd * 128 + c]);
    }
    __syncthreads();
    for (int i2 = 0; i2 < 16; ++i2) {
      const int tt = d == 0 ? i2 : 15 - i2;
      const float vval = vs[tt * 128 + vv];
      const float* fp = fs + tt * 128 + kh * 64;
      const float* kp = ks + tt * 128 + kh * 64;
      const float* qp = qs + tt * 128 + kh * 64;
      float acc = 0.f;
#pragma unroll
      for (int i = 0; i < 64; ++i) { S[i] = fp[i] * S[i] + kp[i] * vval; acc += S[i] * qp[i]; }
      acc += __shfl_xor(acc, 1);
      if (kh == 0) odir[(size_t)(tok0 + tb + tt) * 1024 + hd * 128 + vv] = acc;
    }
  }
  if (s < 32) {
    float* o = p.out + OUT_HGRN + ((((size_t)s * 4 + l) * 2 + d) * 8 + hd) * 16384 + (size_t)(kh * 64) * 128 + vv;
#pragma unroll
    for (int i = 0; i < 64; ++i) o[(size_t)i * 128] = S[i];
  }
}


constexpr int HG_ROW = 272;
constexpr int HG_IMG = 16 * HG_ROW;
constexpr int HG_BUF = 4 * HG_IMG + 512;
__device__ __forceinline__ void hgrn_chunk_item(const Params& p, int l, int item, char* smem) {
  const int d = item & 1, hd = (item >> 1) & 7, s = item >> 4;
  int tok0, L;
  if (s < 32) { tok0 = s * 256; L = 256; } else { tok0 = TCTX + (s - 32) * 2048; L = 2048; }
  const int tid = tid_opaque(), lane = tid & 63, w = tid >> 6, fr = lane & 15, fq = lane >> 4;
  const int ch = tid & 127, half = tid >> 7;
  f32x4 S[8][2];
  if (s < 32) {
#pragma unroll
    for (int kt = 0; kt < 8; ++kt) { S[kt][0] = (f32x4){0.f, 0.f, 0.f, 0.f}; S[kt][1] = (f32x4){0.f, 0.f, 0.f, 0.f}; }
  } else {
    const float* st = p.state_hgrn + ((((size_t)(s - 32) * 4 + l) * 2 + d) * 8 + hd) * 16384;
#pragma unroll
    for (int kt = 0; kt < 8; ++kt)
#pragma unroll
      for (int vt = 0; vt < 2; ++vt)
#pragma unroll
        for (int jj = 0; jj < 4; ++jj) S[kt][vt][jj] = st[(size_t)(16 * kt + fq * 4 + jj) * 128 + 32 * w + 16 * vt + fr];
  }
  const float lbv = ((const float*)(p.ws + OFF_LB))[(size_t)l * 2048 + d * 1024 + hd * 128 + ch];
  const bf16_t* proj = (const bf16_t*)(p.ws + OFF_PROJ);
  float* odir = (float*)(p.ws + (d == 0 ? OFF_OF : OFF_OB));
  float* xch = (float*)(smem + 2 * HG_BUF);
  const int nch = L >> 4;
  bf16_t rq[8], ru[8], rv[8];
  __syncthreads();
  {
#pragma unroll
    for (int i = 0; i < 8; ++i) {
      const int pos = 8 * half + i;
      const size_t tk = (size_t)(d == 0 ? tok0 + pos : tok0 + L - 1 - pos) * NPROJ_PAD;
      rq[i] = proj[tk + C_HQ + hd * 128 + ch];
      ru[i] = proj[tk + C_HF + d * 1024 + hd * 128 + ch];
      rv[i] = proj[tk + C_HI + hd * 128 + ch];
    }
  }
  for (int c = 0; c < nch; ++c) {
    char* buf = smem + (c & 1) * HG_BUF;
    float* xc_ = xch + (c & 1) * 256;
    float fv[8], kk[8], qs[8];
    float loc = 1.f;
#pragma unroll
    for (int i = 0; i < 8; ++i) {
      const float u = bf2f(ru[i]);
      const float sg = sigmoidf_(u);
      fv[i] = lbv + (1.f - lbv) * sg;
      kk[i] = (1.f - lbv) * (1.f - sg);
      qs[i] = siluf_(bf2f(rq[i]));
      loc *= fv[i];
      *(bf16_t*)(buf + 3 * HG_IMG + (8 * half + i) * HG_ROW + ch * 2) = rv[i];
    }
    xc_[half * 128 + ch] = loc;
    if (c + 1 < nch) {
#pragma unroll
      for (int i = 0; i < 8; ++i) {
        const int pos = (c + 1) * 16 + 8 * half + i;
        const size_t tk = (size_t)(d == 0 ? tok0 + pos : tok0 + L - 1 - pos) * NPROJ_PAD;
        rq[i] = proj[tk + C_HQ + hd * 128 + ch];
        ru[i] = proj[tk + C_HF + d * 1024 + hd * 128 + ch];
        rv[i] = proj[tk + C_HI + hd * 128 + ch];
      }
    }
    __syncthreads();
    {
      const float other = xc_[(half ^ 1) * 128 + ch];
      float P = half ? other : 1.f;
      float sfx = half ? 1.f : other;
      float suf[8];
#pragma unroll
      for (int i = 7; i >= 0; --i) { suf[i] = sfx; sfx *= fv[i]; }
#pragma unroll
      for (int i = 0; i < 8; ++i) {
        P *= fv[i];
        const int off = (8 * half + i) * HG_ROW + ch * 2;
        *(bf16_t*)(buf + off) = f2bf(qs[i] * P);
        *(bf16_t*)(buf + HG_IMG + off) = f2bf(kk[i] / fmaxf(P, 1e-30f));
        *(bf16_t*)(buf + 2 * HG_IMG + off) = f2bf(kk[i] * suf[i]);
      }
      if (half) ((float*)(buf + 4 * HG_IMG))[ch] = P;
    }
    __syncthreads();
    const char* qtI = buf;
    const char* ktI = buf + HG_IMG;
    const float* dec = (const float*)(buf + 4 * HG_IMG);
    f32x4 at = (f32x4){0.f, 0.f, 0.f, 0.f};
#pragma unroll
    for (int ks = 0; ks < 4; ++ks) {
      bf16x8 a = *(const bf16x8*)(ktI + fr * HG_ROW + (32 * ks + fq * 8) * 2);
      bf16x8 b = *(const bf16x8*)(qtI + fr * HG_ROW + (32 * ks + fq * 8) * 2);
      at = __builtin_amdgcn_mfma_f32_16x16x32_bf16(a, b, at, 0, 0, 0);
    }
    s16x4 Pm;
    {
      u32x2 pk;
      pk[0] = pack2((fq * 4 + 0 <= fr) ? at[0] : 0.f, (fq * 4 + 1 <= fr) ? at[1] : 0.f);
      pk[1] = pack2((fq * 4 + 2 <= fr) ? at[2] : 0.f, (fq * 4 + 3 <= fr) ? at[3] : 0.f);
      Pm = __builtin_bit_cast(s16x4, pk);
    }
    const unsigned ldsb = (unsigned)(size_t)buf;
    const unsigned vaddr = ldsb + 3 * HG_IMG + (4 * fq + (fr >> 2)) * HG_ROW + (32 * w + 4 * (fr & 3)) * 2;
    const unsigned kaddr = ldsb + 2 * HG_IMG + (4 * fq + (fr >> 2)) * HG_ROW + (4 * (fr & 3)) * 2;
    s16x4 vf0, vf1, kf0, kf1, kf2, kf3, kf4, kf5, kf6, kf7;
    asm volatile(
        "ds_read_b64_tr_b16 %0, %10\n\t"
        "ds_read_b64_tr_b16 %1, %10 offset:32\n\t"
        "ds_read_b64_tr_b16 %2, %11\n\t"
        "ds_read_b64_tr_b16 %3, %11 offset:32\n\t"
        "ds_read_b64_tr_b16 %4, %11 offset:64\n\t"
        "ds_read_b64_tr_b16 %5, %11 offset:96\n\t"
        "ds_read_b64_tr_b16 %6, %11 offset:128\n\t"
        "ds_read_b64_tr_b16 %7, %11 offset:160\n\t"
        "ds_read_b64_tr_b16 %8, %11 offset:192\n\t"
        "ds_read_b64_tr_b16 %9, %11 offset:224\n\t"
        "s_waitcnt lgkmcnt(0)"
        : "=&v"(vf0), "=&v"(vf1), "=&v"(kf0), "=&v"(kf1), "=&v"(kf2), "=&v"(kf3), "=&v"(kf4), "=&v"(kf5), "=&v"(kf6), "=&v"(kf7)
        : "v"(vaddr), "v"(kaddr)
        : "memory");
    f32x4 o0 = __builtin_amdgcn_mfma_f32_16x16x16bf16_1k(Pm, vf0, (f32x4){0.f, 0.f, 0.f, 0.f}, 0, 0, 0);
    f32x4 o1 = __builtin_amdgcn_mfma_f32_16x16x16bf16_1k(Pm, vf1, (f32x4){0.f, 0.f, 0.f, 0.f}, 0, 0, 0);
#pragma unroll
    for (int ks = 0; ks < 4; ++ks) {
      u32x2 qa = *(const u32x2*)(qtI + fr * HG_ROW + (32 * ks + 4 * fq) * 2);
      u32x2 qb = *(const u32x2*)(qtI + fr * HG_ROW + (32 * ks + 16 + 4 * fq) * 2);
      u32x4 aa; aa[0] = qa[0]; aa[1] = qa[1]; aa[2] = qb[0]; aa[3] = qb[1];
      const bf16x8 A = __builtin_bit_cast(bf16x8, aa);
      u32x4 b0, b1;
      b0[0] = pack2(S[2 * ks][0][0], S[2 * ks][0][1]); b0[1] = pack2(S[2 * ks][0][2], S[2 * ks][0][3]);
      b0[2] = pack2(S[2 * ks + 1][0][0], S[2 * ks + 1][0][1]); b0[3] = pack2(S[2 * ks + 1][0][2], S[2 * ks + 1][0][3]);
      b1[0] = pack2(S[2 * ks][1][0], S[2 * ks][1][1]); b1[1] = pack2(S[2 * ks][1][2], S[2 * ks][1][3]);
      b1[2] = pack2(S[2 * ks + 1][1][0], S[2 * ks + 1][1][1]); b1[3] = pack2(S[2 * ks + 1][1][2], S[2 * ks + 1][1][3]);
      o0 = __builtin_amdgcn_mfma_f32_16x16x32_bf16(A, __builtin_bit_cast(bf16x8, b0), o0, 0, 0, 0);
      o1 = __builtin_amdgcn_mfma_f32_16x16x32_bf16(A, __builtin_bit_cast(bf16x8, b1), o1, 0, 0, 0);
    }
#pragma unroll
    for (int jj = 0; jj < 4; ++jj) {
      const int pos = c * 16 + fq * 4 + jj;
      const size_t tk = (size_t)(d == 0 ? tok0 + pos : tok0 + L - 1 - pos);
      odir[tk * 1024 + hd * 128 + 32 * w + fr] = o0[jj];
      odir[tk * 1024 + hd * 128 + 32 * w + 16 + fr] = o1[jj];
    }
    const s16x4 kfs[8] = {kf0, kf1, kf2, kf3, kf4, kf5, kf6, kf7};
#pragma unroll
    for (int kt = 0; kt < 8; ++kt) {
      const f32x4 dv = *(const f32x4*)(dec + 16 * kt + fq * 4);
      S[kt][0] = __builtin_amdgcn_mfma_f32_16x16x16bf16_1k(kfs[kt], vf0, S[kt][0] * dv, 0, 0, 0);
      S[kt][1] = __builtin_amdgcn_mfma_f32_16x16x16bf16_1k(kfs[kt], vf1, S[kt][1] * dv, 0, 0, 0);
    }
  }
  if (s < 32) {
    float* o = p.out + OUT_HGRN + ((((size_t)s * 4 + l) * 2 + d) * 8 + hd) * 16384;
#pragma unroll
    for (int kt = 0; kt < 8; ++kt)
#pragma unroll
      for (int vt = 0; vt < 2; ++vt)
#pragma unroll
        for (int jj = 0; jj < 4; ++jj) o[(size_t)(16 * kt + fq * 4 + jj) * 128 + 32 * w + 16 * vt + fr] = S[kt][vt][jj];
  }
}

__device__ __forceinline__ void phase_scan_naive(const Params& p, int l, char* smem) {
  const int n_ssd = 36 * 64, n_hg = 36 * 16;
  for (int it = blockIdx.x; it < n_ssd + n_hg; it += gridDim.x) {
    if (it < 256) ssd_naive_item(p, l, 32 * 64 + it, (float*)smem);
    else if (it < 320) hgrn_chunk_item(p, l, 32 * 16 + (it - 256), smem);
    else if (it < 320 + 2048) ssd_naive_item(p, l, it - 320, (float*)smem);
    else hgrn_chunk_item(p, l, it - 320 - 2048, smem);
  }
}

__device__ __forceinline__ void phase_post(const Params& p, int l) {
  const int tid = tid_opaque();
  const bf16_t* proj = (const bf16_t*)(p.ws + OFF_PROJ);
  const bf16_t* xc = (const bf16_t*)(p.ws + OFF_XC);
  const float* yf = (const float*)(p.ws + OFF_YF);
  const float* yb = (const float*)(p.ws + OFF_YB);
  const float* of = (const float*)(p.ws + OFF_OF);
  const float* ob = (const float*)(p.ws + OFF_OB);
  bf16_t* ybuf = (bf16_t*)(p.ws + OFF_YBUF);
  bf16_t* obuf = (bf16_t*)(p.ws + OFF_OBUF);
  for (int tok = blockIdx.x; tok < T; tok += gridDim.x) {
    {
      const int ch = tid * 8, hh = ch >> 6;
      const float dsk = p.ssd_d[l * 32 + hh];
      const float* a = yf + (size_t)tok * 2048 + ch;
      const float* b = yb + (size_t)tok * 2048 + ch;
      uint4 xv = *(const uint4*)(xc + (size_t)tok * 4096 + ch);
      uint4 zv = *(const uint4*)(proj + (size_t)tok * NPROJ_PAD + C_Z + ch);
      const unsigned xw[4] = {xv.x, xv.y, xv.z, xv.w};
      const unsigned zw[4] = {zv.x, zv.y, zv.z, zv.w};
      float v[8];
      float ss = 0.f;
#pragma unroll
      for (int j = 0; j < 8; ++j) {
        const float xs = bf2f((bf16_t)((j & 1) ? (xw[j >> 1] >> 16) : (xw[j >> 1] & 0xffff)));
        const float z = bf2f((bf16_t)((j & 1) ? (zw[j >> 1] >> 16) : (zw[j >> 1] & 0xffff)));
        v[j] = (a[j] + b[j] + dsk * xs) * siluf_(z);
        ss += v[j] * v[j];
      }
#pragma unroll
      for (int o = 16; o >= 1; o >>= 1) ss += __shfl_xor(ss, o);
      const float rstd = rsqrtf(ss * (1.f / 256.f) + 1e-6f);
      const float* nw = p.ssd_norm_w + l * 2048 + ch;
      uint4 o4;
      o4.x = pack2(v[0] * rstd * nw[0], v[1] * rstd * nw[1]); o4.y = pack2(v[2] * rstd * nw[2], v[3] * rstd * nw[3]);
      o4.z = pack2(v[4] * rstd * nw[4], v[5] * rstd * nw[5]); o4.w = pack2(v[6] * rstd * nw[6], v[7] * rstd * nw[7]);
      *(uint4*)(ybuf + (size_t)tok * 2048 + ch) = o4;
    }
    {
      const int ch = tid * 4;
      const float* a = of + (size_t)tok * 1024 + ch;
      const float* b = ob + (size_t)tok * 1024 + ch;
      uint2 gv = *(const uint2*)(proj + (size_t)tok * NPROJ_PAD + C_HG + ch);
      const unsigned gw[2] = {gv.x, gv.y};
      float v[4];
      float ss = 0.f;
#pragma unroll
      for (int j = 0; j < 4; ++j) { v[j] = a[j] + b[j]; ss += v[j] * v[j]; }
#pragma unroll
      for (int o = 16; o >= 1; o >>= 1) ss += __shfl_xor(ss, o);
      const float rstd = rsqrtf(ss * (1.f / 128.f) + 1e-6f);
      const float* nw = p.hgrn_norm_w + l * 1024 + ch;
      float r[4];
#pragma unroll
      for (int j = 0; j < 4; ++j) {
        const float gz = bf2f((bf16_t)((j & 1) ? (gw[j >> 1] >> 16) : (gw[j >> 1] & 0xffff)));
        r[j] = v[j] * rstd * nw[j] * siluf_(gz);
      }
      uint2 o2; o2.x = pack2(r[0], r[1]); o2.y = pack2(r[2], r[3]);
      *(uint2*)(obuf + (size_t)tok * 1024 + ch) = o2;
    }
  }
}

enum { PH_SETUP = 0, PH_NORM1, PH_PROJ, PH_CONV, PH_SCAN, PH_POST, PH_MERGE, PH_OUT, PH_NORM2, PH_FFN1, PH_FFN2, PH_FINAL };

__device__ __forceinline__ void run_phase(const Params& p, int ph, int l, char* smem) {
  switch (ph) {
    case PH_SETUP: phase_setup(p, smem); break;
    case PH_NORM1: phase_norm(p, l, 0); break;
    case PH_PROJ: phase_gemm<G_PROJ>(p, l, smem); break;
    case PH_CONV: phase_conv(p, l); break;
    case PH_SCAN: phase_scan_naive(p, l, smem); break;
    case PH_POST: phase_post(p, l); break;
    case PH_MERGE: phase_gemm<G_MERGE>(p, l, smem); break;
    case PH_OUT: phase_gemm<G_OUT>(p, l, smem); break;
    case PH_NORM2: phase_norm(p, l, 1); break;
    case PH_FFN1: phase_gemm<G_FFN1>(p, l, smem); break;
    case PH_FFN2: phase_gemm<G_FFN2>(p, l, smem); break;
    case PH_FINAL: phase_final_norm(p); break;
  }
}

extern __shared__ __attribute__((aligned(16))) char dyn_smem[];

#if !MEGA
__global__ void __launch_bounds__(256, 2) phase_kernel(Params p, int ph, int l) { run_phase(p, ph, l, dyn_smem); }
#endif

#if MEGA
__global__ void __launch_bounds__(256, 2) mega_kernel(Params p) {
  cg::grid_group grid = cg::this_grid();
  phase_setup(p, dyn_smem);
  grid.sync();
  for (int l = 0; l < DEPTH; ++l) {
    phase_norm(p, l, 0); grid.sync();
    phase_gemm<G_PROJ>(p, l, dyn_smem); grid.sync();
    phase_conv(p, l); grid.sync();
    phase_scan_naive(p, l, dyn_smem); grid.sync();
    phase_post(p, l); grid.sync();
    phase_gemm<G_MERGE>(p, l, dyn_smem); grid.sync();
    phase_gemm<G_OUT>(p, l, dyn_smem); grid.sync();
    phase_norm(p, l, 1); grid.sync();
    phase_gemm<G_FFN1>(p, l, dyn_smem); grid.sync();
    phase_gemm<G_FFN2>(p, l, dyn_smem); grid.sync();
  }
  phase_final_norm(p);
}
#endif

extern "C" void kernel_launch(void* const* d_in, const int* in_sizes, int n_in, void* d_out, int out_size, void* d_ws, size_t ws_size,
                              hipStream_t stream) {
  static int grid_blocks = 0;
  if (!grid_blocks) {
    int dev = 0, cus = 0, per_cu = 0;
    (void)hipGetDevice(&dev);
    (void)hipDeviceGetAttribute(&cus, hipDeviceAttributeMultiprocessorCount, dev);
#if MEGA
    (void)hipFuncSetAttribute((const void*)mega_kernel, hipFuncAttributeMaxDynamicSharedMemorySize, SMEM_BYTES);
#endif
#if !MEGA
    (void)hipFuncSetAttribute((const void*)phase_kernel, hipFuncAttributeMaxDynamicSharedMemorySize, SMEM_BYTES);
#endif
#if MEGA
    (void)hipOccupancyMaxActiveBlocksPerMultiprocessor(&per_cu, mega_kernel, 256, SMEM_BYTES);
#else
    (void)hipOccupancyMaxActiveBlocksPerMultiprocessor(&per_cu, phase_kernel, 256, SMEM_BYTES);
#endif
    if (per_cu > 2) per_cu = 2;
    if (per_cu < 1) per_cu = 1;
    grid_blocks = cus * per_cu;
  }
  Params p{};
  const float** pf = (const float**)&p;
  for (int i = 0; i < 26; ++i) pf[i] = (const float*)d_in[i];
  p.out = (float*)d_out;
  p.ws = (char*)d_ws;
#if MEGA
  void* args[] = {&p};
  hipError_t e = hipLaunchCooperativeKernel((void*)mega_kernel, dim3(grid_blocks), dim3(256), args, SMEM_BYTES, stream);
  if (e != hipSuccess) fprintf(stderr, "coop launch failed: %s\n", hipGetErrorString(e));
#else
  const int G = grid_blocks;
  phase_kernel<<<G, 256, SMEM_BYTES, stream>>>(p, PH_SETUP, 0);
  for (int l = 0; l < DEPTH; ++l)
    for (int ph = PH_NORM1; ph <= PH_FFN2; ++ph) phase_kernel<<<G, 256, SMEM_BYTES, stream>>>(p, ph, l);
  phase_kernel<<<G, 256, SMEM_BYTES, stream>>>(p, PH_FINAL, 0);
#endif
}
```

```cpp
#include <hip/hip_runtime.h>
#include <hip/hip_cooperative_groups.h>
#include <cstdio>
#include <cstdint>
namespace cg = cooperative_groups;

#ifndef MEGA
#define MEGA 1
#endif

typedef unsigned short bf16_t;
typedef short bf16x8 __attribute__((ext_vector_type(8)));
typedef float f32x4 __attribute__((ext_vector_type(4)));
typedef unsigned u32x4 __attribute__((ext_vector_type(4)));
typedef short s16x4 __attribute__((ext_vector_type(4)));
typedef unsigned u32x2 __attribute__((ext_vector_type(2)));

constexpr int D = 1024, T = 16384, TCTX = 8192, DEPTH = 4;
constexpr int NPROJ = 13376, NPROJ_PAD = 13440;
constexpr int FFN = 2816;
constexpr int C_Z = 4096, C_DT = 6144, C_HQ = 6208, C_HF = 7232, C_HI = 9280, C_HG = 10304, C_GATE = 11328;
constexpr size_t WT_IN = 0;
constexpr size_t WT_SSO = WT_IN + (size_t)NPROJ_PAD * 1024;
constexpr size_t WT_HGO = WT_SSO + (size_t)1024 * 2048;
constexpr size_t WT_OUT = WT_HGO + (size_t)1024 * 1024;
constexpr size_t WT_W13 = WT_OUT + (size_t)1024 * 1024;
constexpr size_t WT_W2 = WT_W13 + (size_t)5632 * 1024;
constexpr size_t WT_LAYER = WT_W2 + (size_t)1024 * 2816;
constexpr size_t OFF_WT = 0;
constexpr size_t OFF_H = OFF_WT + WT_LAYER * 2 * DEPTH;
constexpr size_t OFF_PROJ = OFF_H + (size_t)T * 1024 * 2;
constexpr size_t OFF_XC = OFF_PROJ + (size_t)T * NPROJ_PAD * 2;
constexpr size_t OFF_DTRAW = OFF_XC + (size_t)T * 4096 * 2;
constexpr size_t OFF_DT = OFF_DTRAW + (size_t)T * 64 * 4;
constexpr size_t OFF_YF = OFF_DT + (size_t)T * 64 * 4;
constexpr size_t OFF_YB = OFF_YF + (size_t)T * 2048 * 4;
constexpr size_t OFF_OF = OFF_YB + (size_t)T * 2048 * 4;
constexpr size_t OFF_OB = OFF_OF + (size_t)T * 1024 * 4;
constexpr size_t OFF_YBUF = OFF_OB + (size_t)T * 1024 * 4;
constexpr size_t OFF_OBUF = OFF_YBUF + (size_t)T * 2048 * 2;
constexpr size_t OFF_MBUF = OFF_OBUF + (size_t)T * 1024 * 2;
constexpr size_t OFF_MOD = OFF_MBUF + (size_t)T * 1024 * 2;
constexpr size_t OFF_LB = OFF_MOD + (size_t)DEPTH * 5 * 6144 * 4;
constexpr size_t OFF_END = OFF_LB + (size_t)DEPTH * 2 * 1024 * 4;
constexpr size_t OUT_SSM = (size_t)T * 1024;
constexpr size_t OUT_HGRN = OUT_SSM + (size_t)32 * 4 * 2 * 32 * 64 * 128;

constexpr int SMEM_BYTES = 73728;
constexpr int LDS_ROW = 144;
constexpr int LDS_TILE = 128 * LDS_ROW;

struct Params {
  const float *x_prompt, *x_sample, *c, *state_ssm, *state_hgrn, *c_ctx, *norm_mix_w, *norm_ffn_w, *ada_w, *ada_b, *w_in,
      *ssd_conv_w, *ssd_conv_b, *ssd_dt_bias, *ssd_a_log, *ssd_d, *ssd_norm_w, *hgrn_lb, *hgrn_norm_w, *w_ssd_out, *w_hgrn_out,
      *w_out, *ffn_w1, *ffn_w3, *ffn_w2, *norm_final_w;
  float* out;
  char* ws;
};

__device__ __forceinline__ bf16_t f2bf(float f) {
  unsigned u = __float_as_uint(f);
  u += 0x7fffu + ((u >> 16) & 1u);
  return (bf16_t)(u >> 16);
}
__device__ __forceinline__ float bf2f(bf16_t b) { return __uint_as_float(((unsigned)b) << 16); }
typedef __bf16 bf16x2_t __attribute__((ext_vector_type(2)));
__device__ __forceinline__ unsigned pack2(float a, float b) { bf16x2_t v = {(__bf16)a, (__bf16)b}; return __builtin_bit_cast(unsigned, v); }
__device__ __forceinline__ float sigmoidf_(float x) { return 1.0f / (1.0f + __expf(-x)); }
__device__ __forceinline__ float siluf_(float x) { return x / (1.0f + __expf(-x)); }
__device__ __forceinline__ int tid_opaque() { int t = threadIdx.x; asm volatile("" : "+v"(t)); return t; }
__device__ __forceinline__ float clamp30(float x) { return fminf(fmaxf(x, -30.f), 30.f); }
__device__ __forceinline__ float gate_ratio(float g1, float g2) { return (1.0f + __expf(-clamp30(g2))) / (1.0f + __expf(-clamp30(g1))); }
__device__ __forceinline__ int mod_row(int tok) { return tok < TCTX ? 0 : 1 + ((tok - TCTX) >> 11); }

__device__ __forceinline__ void phase_setup(const Params& p, char* smem) {
  const int tid = tid_opaque(), bid = blockIdx.x, G = gridDim.x;
  {
    const size_t n4 = (size_t)T * 1024 / 4, half4 = (size_t)TCTX * 1024 / 4;
    float4* dst = (float4*)p.out;
    const float4* s0 = (const float4*)p.x_prompt;
    const float4* s1 = (const float4*)p.x_sample;
    for (size_t i = (size_t)bid * 256 + tid; i < n4; i += (size_t)G * 256) dst[i] = i < half4 ? s0[i] : s1[i - half4];
  }
  {
    float* lb = (float*)(p.ws + OFF_LB);
    for (int i = bid * 256 + tid; i < 2048; i += G * 256) {
      float v0 = p.hgrn_lb[i], v1 = p.hgrn_lb[2048 + i], v2 = p.hgrn_lb[4096 + i], v3 = p.hgrn_lb[6144 + i];
      float m = fmaxf(fmaxf(v0, v1), fmaxf(v2, v3));
      float e0 = expf(v0 - m), e1 = expf(v1 - m), e2 = expf(v2 - m), e3 = expf(v3 - m);
      float inv = 1.0f / (e0 + e1 + e2 + e3);
      lb[i] = 0.f;
      lb[2048 + i] = e1 * inv;
      lb[4096 + i] = (e1 + e2) * inv;
      lb[6144 + i] = (e1 + e2 + e3) * inv;
    }
  }
  {
    float* sm = (float*)smem;
    float* modb = (float*)(p.ws + OFF_MOD);
    __syncthreads();
    for (int i = tid; i < 5 * 1024; i += 256) {
      int v = i >> 10, k = i & 1023;
      float cv = v == 0 ? p.c_ctx[k] : p.c[(v - 1) * 1024 + k];
      sm[i] = siluf_(cv);
    }
    __syncthreads();
    float* part = sm + 5 * 1024;
    for (int item = bid; item < DEPTH * 96; item += G) {
      int l = item / 96, cg_ = item % 96;
      int col = cg_ * 64 + (tid & 63), kg = tid >> 6;
      const float* w = p.ada_w + (size_t)l * 1024 * 6144 + col;
      float a0 = 0, a1 = 0, a2 = 0, a3 = 0, a4 = 0;
      for (int k = kg * 256; k < kg * 256 + 256; ++k) {
        float wv = w[(size_t)k * 6144];
        a0 += sm[k] * wv; a1 += sm[1024 + k] * wv; a2 += sm[2048 + k] * wv; a3 += sm[3072 + k] * wv; a4 += sm[4096 + k] * wv;
      }
      __syncthreads();
      part[(kg * 5 + 0) * 64 + (tid & 63)] = a0; part[(kg * 5 + 1) * 64 + (tid & 63)] = a1; part[(kg * 5 + 2) * 64 + (tid & 63)] = a2;
      part[(kg * 5 + 3) * 64 + (tid & 63)] = a3; part[(kg * 5 + 4) * 64 + (tid & 63)] = a4;
      __syncthreads();
      for (int i = tid; i < 320; i += 256) {
        int v = i >> 6, cc = i & 63;
        float s = part[(0 * 5 + v) * 64 + cc] + part[(1 * 5 + v) * 64 + cc] + part[(2 * 5 + v) * 64 + cc] + part[(3 * 5 + v) * 64 + cc];
        int colo = cg_ * 64 + cc;
        modb[((size_t)l * 5 + v) * 6144 + colo] = s + p.ada_b[l * 6144 + colo];
      }
    }
    __syncthreads();
  }
  {
    float* tile = (float*)smem;
    const int n_in = 210 * 16, n_sso = 16 * 32, n_hgo = 16 * 16, n_out = 16 * 16, n_w13 = 88 * 16, n_w2 = 16 * 44;
    const int per_layer = n_in + n_sso + n_hgo + n_out + n_w13 + n_w2;
    for (int it = bid; it < per_layer * DEPTH; it += G) {
      int l = it / per_layer, r = it % per_layer;
      bf16_t* wt = (bf16_t*)(p.ws + OFF_WT) + (size_t)l * WT_LAYER;
      const float *src0 = nullptr, *src1 = nullptr;
      int K, Nsrc, nt, kt;
      bf16_t* dst;
      bool zero = false;
      if (r < n_in) {
        nt = r / 16; kt = r % 16; K = 1024; Nsrc = NPROJ;
        dst = wt + WT_IN;
        if (nt >= 209) zero = true;
        src0 = p.w_in + (size_t)l * 1024 * NPROJ + nt * 64; src1 = src0 + 32;
      } else if ((r -= n_in) < n_sso) {
        nt = r / 32; kt = r % 32; K = 2048; Nsrc = 1024; dst = wt + WT_SSO;
        src0 = p.w_ssd_out + (size_t)l * 2048 * 1024 + nt * 64; src1 = src0 + 32;
      } else if ((r -= n_sso) < n_hgo) {
        nt = r / 16; kt = r % 16; K = 1024; Nsrc = 1024; dst = wt + WT_HGO;
        src0 = p.w_hgrn_out + (size_t)l * 1024 * 1024 + nt * 64; src1 = src0 + 32;
      } else if ((r -= n_hgo) < n_out) {
        nt = r / 16; kt = r % 16; K = 1024; Nsrc = 1024; dst = wt + WT_OUT;
        src0 = p.w_out + (size_t)l * 1024 * 1024 + nt * 64; src1 = src0 + 32;
      } else if ((r -= n_out) < n_w13) {
        nt = r / 16; kt = r % 16; K = 1024; Nsrc = FFN; dst = wt + WT_W13;
        src0 = p.ffn_w1 + (size_t)l * 1024 * FFN + nt * 32; src1 = p.ffn_w3 + (size_t)l * 1024 * FFN + nt * 32;
      } else {
        r -= n_w13;
        nt = r / 44; kt = r % 44; K = 2816; Nsrc = 1024; dst = wt + WT_W2;
        src0 = p.ffn_w2 + (size_t)l * 2816 * 1024 + nt * 64; src1 = src0 + 32;
      }
      __syncthreads();
      {
        int c4 = (tid & 15) * 4;
        const float* s = c4 < 32 ? src0 + c4 : src1 + (c4 - 32);
#pragma unroll
        for (int i = 0; i < 4; ++i) {
          int kr = (tid >> 4) + i * 16;
          float4 v = zero ? make_float4(0.f, 0.f, 0.f, 0.f) : *(const float4*)(s + (size_t)(kt * 64 + kr) * Nsrc);
          tile[kr * 65 + c4 + 0] = v.x; tile[kr * 65 + c4 + 1] = v.y; tile[kr * 65 + c4 + 2] = v.z; tile[kr * 65 + c4 + 3] = v.w;
        }
      }
      __syncthreads();
#pragma unroll
      for (int i = 0; i < 2; ++i) {
        int cidx = tid + i * 256, n = cidx >> 3, kc = cidx & 7;
        uint4 o;
        o.x = pack2(tile[(kc * 8 + 0) * 65 + n], tile[(kc * 8 + 1) * 65 + n]);
        o.y = pack2(tile[(kc * 8 + 2) * 65 + n], tile[(kc * 8 + 3) * 65 + n]);
        o.z = pack2(tile[(kc * 8 + 4) * 65 + n], tile[(kc * 8 + 5) * 65 + n]);
        o.w = pack2(tile[(kc * 8 + 6) * 65 + n], tile[(kc * 8 + 7) * 65 + n]);
        *(uint4*)(dst + (size_t)(nt * 64 + n) * K + kt * 64 + kc * 8) = o;
      }
    }
    __syncthreads();
  }
}

__device__ __forceinline__ void phase_norm(const Params& p, int l, int which) {
  const int lane = tid_opaque() & 63, wv = tid_opaque() >> 6;
  const float* nw = (which == 0 ? p.norm_mix_w : p.norm_ffn_w) + l * 1024;
  const float* modb = (const float*)(p.ws + OFF_MOD) + (size_t)l * 5 * 6144;
  bf16_t* h = (bf16_t*)(p.ws + OFF_H);
  for (int row = blockIdx.x * 4 + wv; row < T; row += gridDim.x * 4) {
    const float* x = p.out + (size_t)row * 1024;
    const float* md = modb + (size_t)mod_row(row) * 6144 + (which == 0 ? 0 : 3072);
    float4 v[4];
    float ss = 0.f;
#pragma unroll
    for (int i = 0; i < 4; ++i) {
      v[i] = *(const float4*)(x + i * 256 + lane * 4);
      ss += v[i].x * v[i].x + v[i].y * v[i].y + v[i].z * v[i].z + v[i].w * v[i].w;
    }
#pragma unroll
    for (int o = 32; o >= 1; o >>= 1) ss += __shfl_xor(ss, o);
    float rstd = rsqrtf(ss * (1.0f / 1024.f) + 1e-6f);
#pragma unroll
    for (int i = 0; i < 4; ++i) {
      int c = i * 256 + lane * 4;
      float4 w = *(const float4*)(nw + c), sh = *(const float4*)(md + c), sc = *(const float4*)(md + 1024 + c);
      float a0 = v[i].x * rstd * w.x * (1.f + sc.x) + sh.x, a1 = v[i].y * rstd * w.y * (1.f + sc.y) + sh.y;
      float a2 = v[i].z * rstd * w.z * (1.f + sc.z) + sh.z, a3 = v[i].w * rstd * w.w * (1.f + sc.w) + sh.w;
      uint2 o2; o2.x = pack2(a0, a1); o2.y = pack2(a2, a3);
      *(uint2*)(h + (size_t)row * 1024 + c) = o2;
    }
  }
}

__device__ __forceinline__ void phase_final_norm(const Params& p) {
  const int lane = tid_opaque() & 63, wv = tid_opaque() >> 6;
  for (int row = blockIdx.x * 4 + wv; row < T; row += gridDim.x * 4) {
    float* x = p.out + (size_t)row * 1024;
    float4 v[4];
    float ss = 0.f;
#pragma unroll
    for (int i = 0; i < 4; ++i) {
      v[i] = *(const float4*)(x + i * 256 + lane * 4);
      ss += v[i].x * v[i].x + v[i].y * v[i].y + v[i].z * v[i].z + v[i].w * v[i].w;
    }
#pragma unroll
    for (int o = 32; o >= 1; o >>= 1) ss += __shfl_xor(ss, o);
    float rstd = rsqrtf(ss * (1.0f / 1024.f) + 1e-6f);
#pragma unroll
    for (int i = 0; i < 4; ++i) {
      int c = i * 256 + lane * 4;
      float4 w = *(const float4*)(p.norm_final_w + c);
      float4 o4 = make_float4(v[i].x * rstd * w.x, v[i].y * rstd * w.y, v[i].z * rstd * w.z, v[i].w * rstd * w.w);
      *(float4*)(x + c) = o4;
    }
  }
}

template <bool HASMID>
__device__ __forceinline__ void gemm_kloop2(f32x4 (&acc)[4][4], const bf16_t* __restrict__ Ag, int lda, const bf16_t* __restrict__ Bg,
                                            int ldb, int K, const bf16_t* __restrict__ Ag2, int lda2, const bf16_t* __restrict__ Bg2,
                                            int ldb2, int K2, char* smem, const bf16_t* __restrict__ gate0) {
  const int tid = tid_opaque(), lane = tid & 63, wid = tid >> 6;
  const int wr = wid >> 1, wc = wid & 1, fr = lane & 15, fq = lane >> 4;
  const int srow = tid >> 3, skc = tid & 7;
  const bf16_t* ap = Ag + (size_t)srow * lda + skc * 8;
  const bf16_t* bp = Bg + (size_t)srow * ldb + skc * 8;
  u32x4 ra[4], rb[4];
  const int nk1 = K >> 6;
  const int nk = nk1 + (K2 >> 6);
#pragma unroll
  for (int i = 0; i < 4; ++i) {
    ra[i] = *(const u32x4*)(ap + (size_t)i * 32 * lda);
    rb[i] = *(const u32x4*)(bp + (size_t)i * 32 * ldb);
  }
#pragma unroll
  for (int i = 0; i < 4; ++i) {
    *(u32x4*)(smem + (srow + i * 32) * LDS_ROW + skc * 16) = ra[i];
    *(u32x4*)(smem + 2 * LDS_TILE + (srow + i * 32) * LDS_ROW + skc * 16) = rb[i];
  }
  __syncthreads();
  for (int kt = 0; kt < nk; ++kt) {
    const int cur = kt & 1;
    if (kt + 1 < nk) {
      if (kt + 1 == nk1) {
        ap = Ag2 + (size_t)srow * lda2 + skc * 8 - (size_t)nk1 * 64;
        bp = Bg2 + (size_t)srow * ldb2 + skc * 8 - (size_t)nk1 * 64;
        lda = lda2; ldb = ldb2;
      }
#pragma unroll
      for (int i = 0; i < 4; ++i) {
        ra[i] = *(const u32x4*)(ap + (size_t)i * 32 * lda + (kt + 1) * 64);
        rb[i] = *(const u32x4*)(bp + (size_t)i * 32 * ldb + (kt + 1) * 64);
      }
    }
    if (HASMID && kt == nk1) {
#pragma unroll
      for (int m = 0; m < 4; ++m)
#pragma unroll
        for (int n = 0; n < 4; ++n) {
          uint2 g1 = *(const uint2*)(gate0 + (size_t)(m * 16) * NPROJ_PAD + n * 16);
          uint2 g2 = *(const uint2*)(gate0 + (size_t)(m * 16) * NPROJ_PAD + 1024 + n * 16);
          acc[m][n][0] *= gate_ratio(bf2f((bf16_t)(g1.x & 0xffff)), bf2f((bf16_t)(g2.x & 0xffff)));
          acc[m][n][1] *= gate_ratio(bf2f((bf16_t)(g1.x >> 16)), bf2f((bf16_t)(g2.x >> 16)));
          acc[m][n][2] *= gate_ratio(bf2f((bf16_t)(g1.y & 0xffff)), bf2f((bf16_t)(g2.y & 0xffff)));
          acc[m][n][3] *= gate_ratio(bf2f((bf16_t)(g1.y >> 16)), bf2f((bf16_t)(g2.y >> 16)));
        }
    }
    const char* sa = smem + cur * LDS_TILE + (wr * 64 + fr) * LDS_ROW + fq * 16;
    const char* sb = smem + (2 + cur) * LDS_TILE + (wc * 64 + fr) * LDS_ROW + fq * 16;
#pragma unroll
    for (int kk = 0; kk < 2; ++kk) {
      bf16x8 af[4], bfv[4];
#pragma unroll
      for (int m = 0; m < 4; ++m) af[m] = *(const bf16x8*)(sa + m * 16 * LDS_ROW + kk * 64);
#pragma unroll
      for (int n = 0; n < 4; ++n) bfv[n] = *(const bf16x8*)(sb + n * 16 * LDS_ROW + kk * 64);
#pragma unroll
      for (int m = 0; m < 4; ++m)
#pragma unroll
        for (int n = 0; n < 4; ++n) acc[m][n] = __builtin_amdgcn_mfma_f32_16x16x32_bf16(bfv[n], af[m], acc[m][n], 0, 0, 0);
    }
    if (kt + 1 < nk) {
#pragma unroll
      for (int i = 0; i < 4; ++i) {
        *(u32x4*)(smem + (cur ^ 1) * LDS_TILE + (srow + i * 32) * LDS_ROW + skc * 16) = ra[i];
        *(u32x4*)(smem + (2 + (cur ^ 1)) * LDS_TILE + (srow + i * 32) * LDS_ROW + skc * 16) = rb[i];
      }
    }
    __syncthreads();
  }
}

__device__ __forceinline__ void gemm_kloop(f32x4 (&acc)[4][4], const bf16_t* __restrict__ Ag, int lda, const bf16_t* __restrict__ Bg,
                                           int ldb, int K, char* smem) {
  gemm_kloop2<false>(acc, Ag, lda, Bg, ldb, K, Ag, lda, Bg, ldb, 0, smem, Ag);
}
enum { G_PROJ = 0, G_MERGE = 1, G_OUT = 2, G_FFN1 = 3, G_FFN2 = 4 };

template <int MODE>
__device__ __forceinline__ void phase_gemm(const Params& p, int l, char* smem) {
  const int tid = tid_opaque(), lane = tid & 63, wid = tid >> 6;
  const int wr = wid >> 1, wc = wid & 1, fr = lane & 15, fq = lane >> 4;
  const bf16_t* wt = (const bf16_t*)(p.ws + OFF_WT) + (size_t)l * WT_LAYER;
  const bf16_t* hbuf = (const bf16_t*)(p.ws + OFF_H);
  bf16_t* proj = (bf16_t*)(p.ws + OFF_PROJ);
  bf16_t* hidden = (bf16_t*)(p.ws + OFF_PROJ);
  const float* modb = (const float*)(p.ws + OFF_MOD) + (size_t)l * 5 * 6144;
  constexpr int nM = T / 128;
  constexpr int nN = MODE == G_PROJ ? NPROJ_PAD / 128 : (MODE == G_FFN1 ? 5632 / 128 : 1024 / 128);
  for (int t = blockIdx.x; t < nM * nN; t += gridDim.x) {
    const int pm = t % nM, pn = t / nM;
    const int row0 = pm * 128, col0 = pn * 128;
    f32x4 acc[4][4];
#pragma unroll
    for (int m = 0; m < 4; ++m)
#pragma unroll
      for (int n = 0; n < 4; ++n) acc[m][n] = (f32x4){0.f, 0.f, 0.f, 0.f};
    if (MODE == G_PROJ) {
      gemm_kloop(acc, hbuf + (size_t)row0 * 1024, 1024, wt + WT_IN + (size_t)col0 * 1024, 1024, 1024, smem);
      float* dtraw = (float*)(p.ws + OFF_DTRAW);
#pragma unroll
      for (int m = 0; m < 4; ++m) {
        const int row = row0 + wr * 64 + m * 16 + fr;
#pragma unroll
        for (int n = 0; n < 4; ++n) {
          const int col = col0 + wc * 64 + n * 16 + fq * 4;
          uint2 o; o.x = pack2(acc[m][n][0], acc[m][n][1]); o.y = pack2(acc[m][n][2], acc[m][n][3]);
          *(uint2*)(proj + (size_t)row * NPROJ_PAD + col) = o;
          if (col >= C_DT && col < C_DT + 64) *(f32x4*)(dtraw + (size_t)row * 64 + (col - C_DT)) = acc[m][n];
        }
      }
    } else if (MODE == G_MERGE) {
      const bf16_t* ybuf = (const bf16_t*)(p.ws + OFF_YBUF);
      const bf16_t* obuf = (const bf16_t*)(p.ws + OFF_OBUF);
      bf16_t* mbuf = (bf16_t*)(p.ws + OFF_MBUF);
      gemm_kloop2<true>(acc, ybuf + (size_t)row0 * 2048, 2048, wt + WT_SSO + (size_t)col0 * 2048, 2048, 2048,
                        obuf + (size_t)row0 * 1024, 1024, wt + WT_HGO + (size_t)col0 * 1024, 1024, 1024, smem,
                        proj + (size_t)(row0 + wr * 64 + fr) * NPROJ_PAD + C_GATE + col0 + wc * 64 + fq * 4);
#pragma unroll
      for (int m = 0; m < 4; ++m) {
        const int row = row0 + wr * 64 + m * 16 + fr;
#pragma unroll
        for (int n = 0; n < 4; ++n) {
          const int col = col0 + wc * 64 + n * 16 + fq * 4;
          uint2 g = *(const uint2*)(proj + (size_t)row * NPROJ_PAD + C_GATE + 1024 + col);
          float r0 = acc[m][n][0] * sigmoidf_(clamp30(bf2f((bf16_t)(g.x & 0xffff))));
          float r1 = acc[m][n][1] * sigmoidf_(clamp30(bf2f((bf16_t)(g.x >> 16))));
          float r2 = acc[m][n][2] * sigmoidf_(clamp30(bf2f((bf16_t)(g.y & 0xffff))));
          float r3 = acc[m][n][3] * sigmoidf_(clamp30(bf2f((bf16_t)(g.y >> 16))));
          uint2 o; o.x = pack2(r0, r1); o.y = pack2(r2, r3);
          *(uint2*)(mbuf + (size_t)row * 1024 + col) = o;
        }
      }
    } else if (MODE == G_OUT || MODE == G_FFN2) {
      if (MODE == G_OUT) {
        const bf16_t* mbuf = (const bf16_t*)(p.ws + OFF_MBUF);
        gemm_kloop(acc, mbuf + (size_t)row0 * 1024, 1024, wt + WT_OUT + (size_t)col0 * 1024, 1024, 1024, smem);
      } else {
        gemm_kloop(acc, hidden + (size_t)row0 * FFN, FFN, wt + WT_W2 + (size_t)col0 * FFN, FFN, FFN, smem);
      }
      const float* gate = modb + (size_t)mod_row(row0) * 6144 + (MODE == G_OUT ? 2048 : 5120);
#pragma unroll
      for (int m = 0; m < 4; ++m) {
        const int row = row0 + wr * 64 + m * 16 + fr;
#pragma unroll
        for (int n = 0; n < 4; ++n) {
          const int col = col0 + wc * 64 + n * 16 + fq * 4;
          f32x4 g = *(const f32x4*)(gate + col);
          f32x4* xp = (f32x4*)(p.out + (size_t)row * 1024 + col);
          f32x4 xv = *xp;
          xv += g * acc[m][n];
          *xp = xv;
        }
      }
    } else {
      gemm_kloop(acc, hbuf + (size_t)row0 * 1024, 1024, wt + WT_W13 + (size_t)col0 * 1024, 1024, 1024, smem);
#pragma unroll
      for (int m = 0; m < 4; ++m) {
        const int row = row0 + wr * 64 + m * 16 + fr;
#pragma unroll
        for (int n = 0; n < 2; ++n) {
          const int hcol = (pn * 2 + wc) * 32 + n * 16 + fq * 4;
          float r[4];
#pragma unroll
          for (int j = 0; j < 4; ++j) r[j] = siluf_(acc[m][n][j]) * acc[m][n + 2][j];
          uint2 o; o.x = pack2(r[0], r[1]); o.y = pack2(r[2], r[3]);
          *(uint2*)(hidden + (size_t)row * FFN + hcol) = o;
        }
      }
    }
  }
}

__device__ __forceinline__ void phase_conv(const Params& p, int l) {
  const bf16_t* proj = (const bf16_t*)(p.ws + OFF_PROJ);
  bf16_t* xc = (bf16_t*)(p.ws + OFF_XC);
  const float* cw = p.ssd_conv_w + (size_t)l * 5 * 4096;
  const float* cb = p.ssd_conv_b + (size_t)l * 4096;
  const size_t total = (size_t)T * 512;
  for (size_t i = (size_t)blockIdx.x * 256 + tid_opaque(); i < total; i += (size_t)gridDim.x * 256) {
    const int tok = (int)(i >> 9), ch = (int)(i & 511) * 8;
    int pos, len;
    if (tok < TCTX) { pos = tok & 255; len = 256; } else { pos = (tok - TCTX) & 63; len = 64; }
    float a[8];
#pragma unroll
    for (int j = 0; j < 8; ++j) a[j] = cb[ch + j];
#pragma unroll
    for (int k = 0; k < 5; ++k) {
      const int q = pos + k - 2;
      if (q >= 0 && q < len) {
        uint4 v = *(const uint4*)(proj + (size_t)(tok + k - 2) * NPROJ_PAD + ch);
        const float* w = cw + k * 4096 + ch;
        a[0] += w[0] * bf2f((bf16_t)(v.x & 0xffff)); a[1] += w[1] * bf2f((bf16_t)(v.x >> 16));
        a[2] += w[2] * bf2f((bf16_t)(v.y & 0xffff)); a[3] += w[3] * bf2f((bf16_t)(v.y >> 16));
        a[4] += w[4] * bf2f((bf16_t)(v.z & 0xffff)); a[5] += w[5] * bf2f((bf16_t)(v.z >> 16));
        a[6] += w[6] * bf2f((bf16_t)(v.w & 0xffff)); a[7] += w[7] * bf2f((bf16_t)(v.w >> 16));
      }
    }
    uint4 o;
    o.x = pack2(siluf_(a[0]), siluf_(a[1])); o.y = pack2(siluf_(a[2]), siluf_(a[3]));
    o.z = pack2(siluf_(a[4]), siluf_(a[5])); o.w = pack2(siluf_(a[6]), siluf_(a[7]));
    *(uint4*)(xc + (size_t)tok * 4096 + ch) = o;
  }
  const float* dtraw = (const float*)(p.ws + OFF_DTRAW);
  float* dt = (float*)(p.ws + OFF_DT);
  for (size_t i = (size_t)blockIdx.x * 256 + tid_opaque(); i < (size_t)T * 64; i += (size_t)gridDim.x * 256) {
    float v = dtraw[i] + p.ssd_dt_bias[l * 64 + (int)(i & 63)];
    dt[i] = v > 20.f ? v : log1pf(expf(v));
  }
}

__device__ __forceinline__ void ssd_naive_item(const Params& p, int l, int item, float* sm) {
  const int d = item & 1, h = (item >> 1) & 31, s = item >> 6;
  int tok0, L;
  if (s < 32) { tok0 = s * 256; L = 256; } else { tok0 = TCTX + (s - 32) * 2048; L = 2048; }
  const int tid = tid_opaque(), pp = tid >> 2, nq = tid & 3, g = h >> 2;
  float S[32];
  if (s < 32) {
#pragma unroll
    for (int i = 0; i < 32; ++i) S[i] = 0.f;
  } else {
    const float* st = p.state_ssm + ((((size_t)(s - 32) * 4 + l) * 2 + d) * 32 + h) * 8192 + pp * 128 + nq * 32;
#pragma unroll
    for (int i = 0; i < 32; ++i) S[i] = st[i];
  }
  const float a = -expf(p.ssd_a_log[l * 64 + d * 32 + h]);
  float* xs = sm; float* Bs = sm + 1024; float* Cs = Bs + 2048; float* dts = Cs + 2048;
  const bf16_t* xc = (const bf16_t*)(p.ws + OFF_XC);
  const float* dtb = (const float*)(p.ws + OFF_DT);
  float* ydir = (float*)(p.ws + (d == 0 ? OFF_YF : OFF_YB));
  for (int bt = 0; bt < L / 16; ++bt) {
    const int tb = d == 0 ? bt * 16 : L - 16 - bt * 16;
    __syncthreads();
    for (int e = tid; e < 16 * 320; e += 256) {
      const int tt = e / 320, c = e % 320;
      const size_t base = (size_t)(tok0 + tb + tt) * 4096;
      if (c < 64) xs[tt * 64 + c] = bf2f(xc[base + h * 64 + c]);
      else if (c < 192) Bs[tt * 128 + c - 64] = bf2f(xc[base + 2048 + g * 128 + c - 64]);
      else Cs[tt * 128 + c - 192] = bf2f(xc[base + 3072 + g * 128 + c - 192]);
    }
    if (tid < 16) dts[tid] = dtb[(size_t)(tok0 + tb + tid) * 64 + d * 32 + h];
    __syncthreads();
    for (int i2 = 0; i2 < 16; ++i2) {
      const int tt = d == 0 ? i2 : 15 - i2;
      const float dt = dts[tt], dA = expf(dt * a), xdt = xs[tt * 64 + pp] * dt;
      float acc = 0.f;
      const float* Bp = Bs + tt * 128 + nq * 32;
      const float* Cp = Cs + tt * 128 + nq * 32;
#pragma unroll
      for (int i = 0; i < 32; ++i) { S[i] = dA * S[i] + xdt * Bp[i]; acc += S[i] * Cp[i]; }
      acc += __shfl_xor(acc, 1); acc += __shfl_xor(acc, 2);
      if (nq == 0) ydir[(size_t)(tok0 + tb + tt) * 2048 + h * 64 + pp] = acc;
    }
  }
  if (s < 32) {
    float* o = p.out + OUT_SSM + ((((size_t)s * 4 + l) * 2 + d) * 32 + h) * 8192 + pp * 128 + nq * 32;
#pragma unroll
    for (int i = 0; i < 32; ++i) o[i] = S[i];
  }
}

__device__ __forceinline__ void hgrn_naive_item(const Params& p, int l, int item, float* sm) {
  const int d = item & 1, hd = (item >> 1) & 7, s = item >> 4;
  int tok0, L;
  if (s < 32) { tok0 = s * 256; L = 256; } else { tok0 = TCTX + (s - 32) * 2048; L = 2048; }
  const int tid = tid_opaque(), vv = tid >> 1, kh = tid & 1;
  float S[64];
  if (s < 32) {
#pragma unroll
    for (int i = 0; i < 64; ++i) S[i] = 0.f;
  } else {
    const float* st = p.state_hgrn + ((((size_t)(s - 32) * 4 + l) * 2 + d) * 8 + hd) * 16384 + (size_t)(kh * 64) * 128 + vv;
#pragma unroll
    for (int i = 0; i < 64; ++i) S[i] = st[(size_t)i * 128];
  }
  float* qs = sm; float* fs = sm + 2048; float* ks = sm + 4096; float* vs = sm + 6144;
  const bf16_t* proj = (const bf16_t*)(p.ws + OFF_PROJ);
  const float* lb = (const float*)(p.ws + OFF_LB) + (size_t)l * 2048 + d * 1024 + hd * 128;
  float* odir = (float*)(p.ws + (d == 0 ? OFF_OF : OFF_OB));
  for (int bt = 0; bt < L / 16; ++bt) {
    const int tb = d == 0 ? bt * 16 : L - 16 - bt * 16;
    __syncthreads();
    for (int e = tid; e < 16 * 128; e += 256) {
      const int tt = e >> 7, c = e & 127;
      const size_t base = (size_t)(tok0 + tb + tt) * NPROJ_PAD;
      const float q = bf2f(proj[base + C_HQ + hd * 128 + c]);
      const float u = bf2f(proj[base + C_HF + d * 1024 + hd * 128 + c]);
      const float lbv = lb[c];
      const float sg = sigmoidf_(u);
      qs[e] = siluf_(q);
      fs[e] = lbv + (1.f - lbv) * sg;
      ks[e] = (1.f - lbv) * (1.f - sg);
      vs[e] = bf2f(proj[base + C_HI + hd * 128 + c]);
    }
    __syncthreads();
    for (int i2 = 0; i2 < 16; ++i2) {
      const int tt = d == 0 ? i2 : 15 - i2;
      const float vval = vs[tt * 128 + vv];
      const float* fp = fs + tt * 128 + kh * 64;
      const float* kp = ks + tt * 128 + kh * 64;
      const float* qp = qs + tt * 128 + kh * 64;
      float acc = 0.f;
#pragma unroll
      for (int i = 0; i < 64; ++i) { S[i] = fp[i] * S[i] + kp[i] * vval; acc += S[i] * qp[i]; }
      acc += __shfl_xor(acc, 1);
      if (kh == 0) odir[(size_t)(tok0 + tb + tt) * 1024 + hd * 128 + vv] = acc;
    }
  }
  if (s < 32) {
    float* o = p.out + OUT_HGRN + ((((size_t)s * 4 + l) * 2 + d) * 8 + hd) * 16384 + (size_t)(kh * 64) * 128 + vv;
#pragma unroll
    for (int i = 0; i < 64; ++i) o[(size_t)i * 128] = S[i];
  }
}


constexpr int HG_ROW = 272;
constexpr int HG_IMG = 16 * HG_ROW;
constexpr int HG_BUF = 4 * HG_IMG + 512;
__device__ __forceinline__ void hgrn_chunk_item(const Params& p, int l, int item, char* smem) {
  const int d = item & 1, hd = (item >> 1) & 7, s = item >> 4;
  int tok0, L;
  if (s < 32) { tok0 = s * 256; L = 256; } else { tok0 = TCTX + (s - 32) * 2048; L = 2048; }
  const int tid = tid_opaque(), lane = tid & 63, w = tid >> 6, fr = lane & 15, fq = lane >> 4;
  const int ch = tid & 127, half = tid >> 7;
  f32x4 S[8][2];
  if (s < 32) {
#pragma unroll
    for (int kt = 0; kt < 8; ++kt) { S[kt][0] = (f32x4){0.f, 0.f, 0.f, 0.f}; S[kt][1] = (f32x4){0.f, 0.f, 0.f, 0.f}; }
  } else {
    const float* st = p.state_hgrn + ((((size_t)(s - 32) * 4 + l) * 2 + d) * 8 + hd) * 16384;
#pragma unroll
    for (int kt = 0; kt < 8; ++kt)
#pragma unroll
      for (int vt = 0; vt < 2; ++vt)
#pragma unroll
        for (int jj = 0; jj < 4; ++jj) S[kt][vt][jj] = st[(size_t)(16 * kt + fq * 4 + jj) * 128 + 32 * w + 16 * vt + fr];
  }
  const float lbv = ((const float*)(p.ws + OFF_LB))[(size_t)l * 2048 + d * 1024 + hd * 128 + ch];
  const bf16_t* proj = (const bf16_t*)(p.ws + OFF_PROJ);
  float* odir = (float*)(p.ws + (d == 0 ? OFF_OF : OFF_OB));
  float* xch = (float*)(smem + 2 * HG_BUF);
  const int nch = L >> 4;
  bf16_t rq[8], ru[8], rv[8];
  __syncthreads();
  {
#pragma unroll
    for (int i = 0; i < 8; ++i) {
      const int pos = 8 * half + i;
      const size_t tk = (size_t)(d == 0 ? tok0 + pos : tok0 + L - 1 - pos) * NPROJ_PAD;
      rq[i] = proj[tk + C_HQ + hd * 128 + ch];
      ru[i] = proj[tk + C_HF + d * 1024 + hd * 128 + ch];
      rv[i] = proj[tk + C_HI + hd * 128 + ch];
    }
  }
  for (int c = 0; c < nch; ++c) {
    char* buf = smem + (c & 1) * HG_BUF;
    float* xc_ = xch + (c & 1) * 256;
    float fv[8], kk[8], qs[8];
    float loc = 1.f;
#pragma unroll
    for (int i = 0; i < 8; ++i) {
      const float u = bf2f(ru[i]);
      const float sg = sigmoidf_(u);
      fv[i] = lbv + (1.f - lbv) * sg;
      kk[i] = (1.f - lbv) * (1.f - sg);
      qs[i] = siluf_(bf2f(rq[i]));
      loc *= fv[i];
      *(bf16_t*)(buf + 3 * HG_IMG + (8 * half + i) * HG_ROW + ch * 2) = rv[i];
    }
    xc_[half * 128 + ch] = loc;
    if (c + 1 < nch) {
#pragma unroll
      for (int i = 0; i < 8; ++i) {
        const int pos = (c + 1) * 16 + 8 * half + i;
        const size_t tk = (size_t)(d == 0 ? tok0 + pos : tok0 + L - 1 - pos) * NPROJ_PAD;
        rq[i] = proj[tk + C_HQ + hd * 128 + ch];
        ru[i] = proj[tk + C_HF + d * 1024 + hd * 128 + ch];
        rv[i] = proj[tk + C_HI + hd * 128 + ch];
      }
    }
    __syncthreads();
    {
      const float other = xc_[(half ^ 1) * 128 + ch];
      float P = half ? other : 1.f;
      float sfx = half ? 1.f : other;
      float suf[8];
#pragma unroll
      for (int i = 7; i >= 0; --i) { suf[i] = sfx; sfx *= fv[i]; }
#pragma unroll
      for (int i = 0; i < 8; ++i) {
        P *= fv[i];
        const int off = (8 * half + i) * HG_ROW + ch * 2;
        *(bf16_t*)(buf + off) = f2bf(qs[i] * P);
        *(bf16_t*)(buf + HG_IMG + off) = f2bf(kk[i] / fmaxf(P, 1e-30f));
        *(bf16_t*)(buf + 2 * HG_IMG + off) = f2bf(kk[i] * suf[i]);
      }
      if (half) ((float*)(buf + 4 * HG_IMG))[ch] = P;
    }
    __syncthreads();
    const char* qtI = buf;
    const char* ktI = buf + HG_IMG;
    const float* dec = (const float*)(buf + 4 * HG_IMG);
    f32x4 at = (f32x4){0.f, 0.f, 0.f, 0.f};
#pragma unroll
    for (int ks = 0; ks < 4; ++ks) {
      bf16x8 a = *(const bf16x8*)(ktI + fr * HG_ROW + (32 * ks + fq * 8) * 2);
      bf16x8 b = *(const bf16x8*)(qtI + fr * HG_ROW + (32 * ks + fq * 8) * 2);
      at = __builtin_amdgcn_mfma_f32_16x16x32_bf16(a, b, at, 0, 0, 0);
    }
    s16x4 Pm;
    {
      u32x2 pk;
      pk[0] = pack2((fq * 4 + 0 <= fr) ? at[0] : 0.f, (fq * 4 + 1 <= fr) ? at[1] : 0.f);
      pk[1] = pack2((fq * 4 + 2 <= fr) ? at[2] : 0.f, (fq * 4 + 3 <= fr) ? at[3] : 0.f);
      Pm = __builtin_bit_cast(s16x4, pk);
    }
    const unsigned ldsb = (unsigned)(size_t)buf;
    const unsigned vaddr = ldsb + 3 * HG_IMG + (4 * fq + (fr >> 2)) * HG_ROW + (32 * w + 4 * (fr & 3)) * 2;
    const unsigned kaddr = ldsb + 2 * HG_IMG + (4 * fq + (fr >> 2)) * HG_ROW + (4 * (fr & 3)) * 2;
    s16x4 vf0, vf1, kf0, kf1, kf2, kf3, kf4, kf5, kf6, kf7;
    asm volatile(
        "ds_read_b64_tr_b16 %0, %10\n\t"
        "ds_read_b64_tr_b16 %1, %10 offset:32\n\t"
        "ds_read_b64_tr_b16 %2, %11\n\t"
        "ds_read_b64_tr_b16 %3, %11 offset:32\n\t"
        "ds_read_b64_tr_b16 %4, %11 offset:64\n\t"
        "ds_read_b64_tr_b16 %5, %11 offset:96\n\t"
        "ds_read_b64_tr_b16 %6, %11 offset:128\n\t"
        "ds_read_b64_tr_b16 %7, %11 offset:160\n\t"
        "ds_read_b64_tr_b16 %8, %11 offset:192\n\t"
        "ds_read_b64_tr_b16 %9, %11 offset:224\n\t"
        "s_waitcnt lgkmcnt(0)"
        : "=&v"(vf0), "=&v"(vf1), "=&v"(kf0), "=&v"(kf1), "=&v"(kf2), "=&v"(kf3), "=&v"(kf4), "=&v"(kf5), "=&v"(kf6), "=&v"(kf7)
        : "v"(vaddr), "v"(kaddr)
        : "memory");
    f32x4 o0 = __builtin_amdgcn_mfma_f32_16x16x16bf16_1k(Pm, vf0, (f32x4){0.f, 0.f, 0.f, 0.f}, 0, 0, 0);
    f32x4 o1 = __builtin_amdgcn_mfma_f32_16x16x16bf16_1k(Pm, vf1, (f32x4){0.f, 0.f, 0.f, 0.f}, 0, 0, 0);
#pragma unroll
    for (int ks = 0; ks < 4; ++ks) {
      u32x2 qa = *(const u32x2*)(qtI + fr * HG_ROW + (32 * ks + 4 * fq) * 2);
      u32x2 qb = *(const u32x2*)(qtI + fr * HG_ROW + (32 * ks + 16 + 4 * fq) * 2);
      u32x4 aa; aa[0] = qa[0]; aa[1] = qa[1]; aa[2] = qb[0]; aa[3] = qb[1];
      const bf16x8 A = __builtin_bit_cast(bf16x8, aa);
      u32x4 b0, b1;
      b0[0] = pack2(S[2 * ks][0][0], S[2 * ks][0][1]); b0[1] = pack2(S[2 * ks][0][2], S[2 * ks][0][3]);
      b0[2] = pack2(S[2 * ks + 1][0][0], S[2 * ks + 1][0][1]); b0[3] = pack2(S[2 * ks + 1][0][2], S[2 * ks + 1][0][3]);
      b1[0] = pack2(S[2 * ks][1][0], S[2 * ks][1][1]); b1[1] = pack2(S[2 * ks][1][2], S[2 * ks][1][3]);
      b1[2] = pack2(S[2 * ks + 1][1][0], S[2 * ks + 1][1][1]); b1[3] = pack2(S[2 * ks + 1][1][2], S[2 * ks + 1][1][3]);
      o0 = __builtin_amdgcn_mfma_f32_16x16x32_bf16(A, __builtin_bit_cast(bf16x8, b0), o0, 0, 0, 0);
      o1 = __builtin_amdgcn_mfma_f32_16x16x32_bf16(A, __builtin_bit_cast(bf16x8, b1), o1, 0, 0, 0);
    }
#pragma unroll
    for (int jj = 0; jj < 4; ++jj) {
      const int pos = c * 16 + fq * 4 + jj;
      const size_t tk = (size_t)(d == 0 ? tok0 + pos : tok0 + L - 1 - pos);
      odir[tk * 1024 + hd * 128 + 32 * w + fr] = o0[jj];
      odir[tk * 1024 + hd * 128 + 32 * w + 16 + fr] = o1[jj];
    }
    const s16x4 kfs[8] = {kf0, kf1, kf2, kf3, kf4, kf5, kf6, kf7};
#pragma unroll
    for (int kt = 0; kt < 8; ++kt) {
      const f32x4 dv = *(const f32x4*)(dec + 16 * kt + fq * 4);
      S[kt][0] = __builtin_amdgcn_mfma_f32_16x16x16bf16_1k(kfs[kt], vf0, S[kt][0] * dv, 0, 0, 0);
      S[kt][1] = __builtin_amdgcn_mfma_f32_16x16x16bf16_1k(kfs[kt], vf1, S[kt][1] * dv, 0, 0, 0);
    }
  }
  if (s < 32) {
    float* o = p.out + OUT_HGRN + ((((size_t)s * 4 + l) * 2 + d) * 8 + hd) * 16384;
#pragma unroll
    for (int kt = 0; kt < 8; ++kt)
#pragma unroll
      for (int vt = 0; vt < 2; ++vt)
#pragma unroll
        for (int jj = 0; jj < 4; ++jj) o[(size_t)(16 * kt + fq * 4 + jj) * 128 + 32 * w + 16 * vt + fr] = S[kt][vt][jj];
  }
}


constexpr size_t OFF_SST = OFF_YF;
constexpr size_t OFF_CS = OFF_YB;
constexpr int SS_BROW = 272, SS_XROW = 144;
constexpr int SS_R0 = 128 * SS_BROW;
constexpr int SS_R1 = 128 * SS_XROW;

template <int OFF>
__device__ __forceinline__ s16x4 tr_read(unsigned addr) {
  s16x4 r;
  asm volatile("ds_read_b64_tr_b16 %0, %1 offset:%2" : "=v"(r) : "v"(addr), "i"(OFF) : "memory");
  return r;
}
__device__ __forceinline__ bf16x8 cat8(s16x4 a, s16x4 b) {
  bf16x8 r;
  r[0] = a[0]; r[1] = a[1]; r[2] = a[2]; r[3] = a[3]; r[4] = b[0]; r[5] = b[1]; r[6] = b[2]; r[7] = b[3];
  return r;
}
#define TR_WAIT12(a, b, c, d, e, f, g, h, i, j, k, l_)                                                                            \
  asm volatile("s_waitcnt lgkmcnt(0)" : "+v"(a), "+v"(b), "+v"(c), "+v"(d), "+v"(e), "+v"(f), "+v"(g), "+v"(h), "+v"(i), "+v"(j), \
               "+v"(k), "+v"(l_)::"memory")
#define TR_WAIT8(a, b, c, d, e, f, g, h) \
  asm volatile("s_waitcnt lgkmcnt(0)" : "+v"(a), "+v"(b), "+v"(c), "+v"(d), "+v"(e), "+v"(f), "+v"(g), "+v"(h)::"memory")

template <int KS>
__device__ __forceinline__ void ssd_p1_kstep(f32x4 (&acc)[2][4], unsigned abase, unsigned xbase) {
  s16x4 a00 = tr_read<KS * 32 * SS_BROW>(abase), a01 = tr_read<KS * 32 * SS_BROW + 4 * SS_BROW>(abase);
  s16x4 a10 = tr_read<KS * 32 * SS_BROW + 32>(abase), a11 = tr_read<KS * 32 * SS_BROW + 4 * SS_BROW + 32>(abase);
  s16x4 b00 = tr_read<KS * 32 * SS_XROW>(xbase), b01 = tr_read<KS * 32 * SS_XROW + 4 * SS_XROW>(xbase);
  s16x4 b10 = tr_read<KS * 32 * SS_XROW + 32>(xbase), b11 = tr_read<KS * 32 * SS_XROW + 4 * SS_XROW + 32>(xbase);
  s16x4 b20 = tr_read<KS * 32 * SS_XROW + 64>(xbase), b21 = tr_read<KS * 32 * SS_XROW + 4 * SS_XROW + 64>(xbase);
  s16x4 b30 = tr_read<KS * 32 * SS_XROW + 96>(xbase), b31 = tr_read<KS * 32 * SS_XROW + 4 * SS_XROW + 96>(xbase);
  TR_WAIT12(a00, a01, a10, a11, b00, b01, b10, b11, b20, b21, b30, b31);
  const bf16x8 A0 = cat8(a00, a01), A1 = cat8(a10, a11);
  const bf16x8 B0 = cat8(b00, b01), B1 = cat8(b10, b11), B2 = cat8(b20, b21), B3 = cat8(b30, b31);
  acc[0][0] = __builtin_amdgcn_mfma_f32_16x16x32_bf16(A0, B0, acc[0][0], 0, 0, 0);
  acc[0][1] = __builtin_amdgcn_mfma_f32_16x16x32_bf16(A0, B1, acc[0][1], 0, 0, 0);
  acc[0][2] = __builtin_amdgcn_mfma_f32_16x16x32_bf16(A0, B2, acc[0][2], 0, 0, 0);
  acc[0][3] = __builtin_amdgcn_mfma_f32_16x16x32_bf16(A0, B3, acc[0][3], 0, 0, 0);
  acc[1][0] = __builtin_amdgcn_mfma_f32_16x16x32_bf16(A1, B0, acc[1][0], 0, 0, 0);
  acc[1][1] = __builtin_amdgcn_mfma_f32_16x16x32_bf16(A1, B1, acc[1][1], 0, 0, 0);
  acc[1][2] = __builtin_amdgcn_mfma_f32_16x16x32_bf16(A1, B2, acc[1][2], 0, 0, 0);
  acc[1][3] = __builtin_amdgcn_mfma_f32_16x16x32_bf16(A1, B3, acc[1][3], 0, 0, 0);
}

__device__ __forceinline__ void ssd_pass1_item(const Params& p, int l, int item, char* smem) {
  const int d = item & 1, h = (item >> 1) & 31, s = item >> 6, g = h >> 2;
  const int nc = s < 32 ? 2 : 16, cg0 = s < 32 ? 2 * s : 64 + 16 * (s - 32);
  const int tid = tid_opaque(), lane = tid & 63, w = tid >> 6, fr = lane & 15, fq = lane >> 4;
  const float a = -expf(p.ssd_a_log[l * 64 + d * 32 + h]);
  f32x4 acc[2][4];
  if (s < 32) {
#pragma unroll
    for (int i = 0; i < 2; ++i)
#pragma unroll
      for (int j = 0; j < 4; ++j) acc[i][j] = (f32x4){0.f, 0.f, 0.f, 0.f};
  } else {
    const float* st = p.state_ssm + ((((size_t)(s - 32) * 4 + l) * 2 + d) * 32 + h) * 8192;
#pragma unroll
    for (int i = 0; i < 2; ++i)
#pragma unroll
      for (int j = 0; j < 4; ++j) acc[i][j] = *(const f32x4*)(st + (size_t)(16 * j + fr) * 128 + 32 * w + 16 * i + 4 * fq);
  }
  const bf16_t* xc = (const bf16_t*)(p.ws + OFF_XC);
  const float* dtb = (const float*)(p.ws + OFF_DT);
  float* csb = (float*)(p.ws + OFF_CS);
  bf16_t* sst = (bf16_t*)(p.ws + OFF_SST);
  float* wgt = (float*)(smem + SS_R0 + SS_R1);
  u32x4 pb[8], px[4];
  float dt0, dt1;
  {
    const int c = d == 0 ? 0 : nc - 1;
    const size_t tb = (size_t)(cg0 + c) * 128;
#pragma unroll
    for (int i = 0; i < 8; ++i) { const int q = tid + 256 * i; pb[i] = *(const u32x4*)(xc + (tb + (q >> 4)) * 4096 + 2048 + g * 128 + (q & 15) * 8); }
#pragma unroll
    for (int i = 0; i < 4; ++i) { const int q = tid + 256 * i; px[i] = *(const u32x4*)(xc + (tb + (q >> 3)) * 4096 + h * 64 + (q & 7) * 8); }
    dt0 = dtb[(tb + 2 * lane) * 64 + d * 32 + h];
    dt1 = dtb[(tb + 2 * lane + 1) * 64 + d * 32 + h];
  }
  const unsigned ldsb = (unsigned)(size_t)smem;
  const unsigned abase = ldsb + (8 * fq + (fr >> 2)) * SS_BROW + (32 * w + 4 * (fr & 3)) * 2;
  const unsigned xbase = ldsb + SS_R0 + (8 * fq + (fr >> 2)) * SS_XROW + (4 * (fr & 3)) * 2;
  for (int cc = 0; cc < nc; ++cc) {
    const int c = d == 0 ? cc : nc - 1 - cc, par = cc & 1;
    const size_t cgl = cg0 + c, tb = cgl * 128;
    {
      bf16_t* so = sst + ((cgl * 32 + h) * 2 + d) * 8192;
#pragma unroll
      for (int i = 0; i < 2; ++i)
#pragma unroll
        for (int j = 0; j < 4; ++j) {
          u32x2 o; o[0] = pack2(acc[i][j][0], acc[i][j][1]); o[1] = pack2(acc[i][j][2], acc[i][j][3]);
          *(u32x2*)(so + (size_t)(16 * j + fr) * 128 + 32 * w + 16 * i + 4 * fq) = o;
        }
    }
    if (w == 0) {
      const float v0 = dt0 * a, v1 = dt1 * a, sloc = v0 + v1;
      float incl = sloc;
#pragma unroll
      for (int off = 1; off < 64; off <<= 1) { const float t = __shfl_up(incl, off); if (lane >= off) incl += t; }
      const float excl = incl - sloc, c0 = excl + v0, tot = __shfl(incl, 63);
      float cs0, cs1, wg0, wg1;
      if (d == 0) { cs0 = c0; cs1 = incl; wg0 = dt0 * __expf(tot - c0); wg1 = dt1 * __expf(tot - incl); }
      else { cs0 = tot - excl; cs1 = tot - c0; wg0 = dt0 * __expf(excl); wg1 = dt1 * __expf(c0); }
      csb[(tb + 2 * lane) * 64 + d * 32 + h] = cs0;
      csb[(tb + 2 * lane + 1) * 64 + d * 32 + h] = cs1;
      wgt[par * 128 + 2 * lane] = wg0;
      wgt[par * 128 + 2 * lane + 1] = wg1;
      if (lane == 0) wgt[256 + par] = __expf(tot);
    }
    __syncthreads();
#pragma unroll
    for (int i = 0; i < 8; ++i) { const int q = tid + 256 * i; *(u32x4*)(smem + (q >> 4) * SS_BROW + (q & 15) * 16) = pb[i]; }
#pragma unroll
    for (int i = 0; i < 4; ++i) {
      const int q = tid + 256 * i, row = q >> 3;
      const float wv = wgt[par * 128 + row];
      u32x4 o;
#pragma unroll
      for (int e = 0; e < 4; ++e) o[e] = pack2(bf2f((bf16_t)(px[i][e] & 0xffff)) * wv, bf2f((bf16_t)(px[i][e] >> 16)) * wv);
      *(u32x4*)(smem + SS_R0 + row * SS_XROW + (q & 7) * 16) = o;
    }
    if (cc + 1 < nc) {
      const int cn = d == 0 ? cc + 1 : nc - 2 - cc;
      const size_t tbn = (size_t)(cg0 + cn) * 128;
#pragma unroll
      for (int i = 0; i < 8; ++i) { const int q = tid + 256 * i; pb[i] = *(const u32x4*)(xc + (tbn + (q >> 4)) * 4096 + 2048 + g * 128 + (q & 15) * 8); }
#pragma unroll
      for (int i = 0; i < 4; ++i) { const int q = tid + 256 * i; px[i] = *(const u32x4*)(xc + (tbn + (q >> 3)) * 4096 + h * 64 + (q & 7) * 8); }
      dt0 = dtb[(tbn + 2 * lane) * 64 + d * 32 + h];
      dt1 = dtb[(tbn + 2 * lane + 1) * 64 + d * 32 + h];
    }
    __syncthreads();
    const float dec = wgt[256 + par];
#pragma unroll
    for (int i = 0; i < 2; ++i)
#pragma unroll
      for (int j = 0; j < 4; ++j) acc[i][j] *= dec;
    ssd_p1_kstep<0>(acc, abase, xbase);
    ssd_p1_kstep<1>(acc, abase, xbase);
    ssd_p1_kstep<2>(acc, abase, xbase);
    ssd_p1_kstep<3>(acc, abase, xbase);
  }
  if (s < 32) {
    float* o = p.out + OUT_SSM + ((((size_t)s * 4 + l) * 2 + d) * 32 + h) * 8192;
#pragma unroll
    for (int i = 0; i < 2; ++i)
#pragma unroll
      for (int j = 0; j < 4; ++j) *(f32x4*)(o + (size_t)(16 * j + fr) * 128 + 32 * w + 16 * i + 4 * fq) = acc[i][j];
  }
  __syncthreads();
}

template <int KS>
__device__ __forceinline__ void ssd_p2_wx_kstep(f32x4 (&y)[4], const char* wrow, unsigned xbase) {
  s16x4 b00 = tr_read<KS * 32 * SS_XROW>(xbase), b01 = tr_read<KS * 32 * SS_XROW + 4 * SS_XROW>(xbase);
  s16x4 b10 = tr_read<KS * 32 * SS_XROW + 32>(xbase), b11 = tr_read<KS * 32 * SS_XROW + 4 * SS_XROW + 32>(xbase);
  s16x4 b20 = tr_read<KS * 32 * SS_XROW + 64>(xbase), b21 = tr_read<KS * 32 * SS_XROW + 4 * SS_XROW + 64>(xbase);
  s16x4 b30 = tr_read<KS * 32 * SS_XROW + 96>(xbase), b31 = tr_read<KS * 32 * SS_XROW + 4 * SS_XROW + 96>(xbase);
  const bf16x8 A = *(const bf16x8*)(wrow + KS * 64);
  TR_WAIT8(b00, b01, b10, b11, b20, b21, b30, b31);
  y[0] = __builtin_amdgcn_mfma_f32_16x16x32_bf16(A, cat8(b00, b01), y[0], 0, 0, 0);
  y[1] = __builtin_amdgcn_mfma_f32_16x16x32_bf16(A, cat8(b10, b11), y[1], 0, 0, 0);
  y[2] = __builtin_amdgcn_mfma_f32_16x16x32_bf16(A, cat8(b20, b21), y[2], 0, 0, 0);
  y[3] = __builtin_amdgcn_mfma_f32_16x16x32_bf16(A, cat8(b30, b31), y[3], 0, 0, 0);
}

__device__ __forceinline__ void ssd_pass2_item(const Params& p, int l, int item, char* smem) {
  const int hf = item & 1, g = (item >> 1) & 7, cg = item >> 4;
  const size_t tb = (size_t)cg * 128;
  const int tid = tid_opaque(), lane = tid & 63, w = tid >> 6, fr = lane & 15, fq = lane >> 4;
  const int i0 = 64 * hf + 16 * w;
  const bf16_t* xc = (const bf16_t*)(p.ws + OFF_XC);
  const bf16_t* proj = (const bf16_t*)(p.ws + OFF_PROJ);
  const float* dtb = (const float*)(p.ws + OFF_DT);
  const float* csb = (const float*)(p.ws + OFF_CS);
  const bf16_t* sst = (const bf16_t*)(p.ws + OFF_SST);
  bf16_t* ybuf = (bf16_t*)(p.ws + OFF_YBUF);
  float* arr = (float*)(smem + SS_R0 + SS_R1);
  __syncthreads();
  bf16x8 cfr[4];
#pragma unroll
  for (int ks = 0; ks < 4; ++ks) cfr[ks] = *(const bf16x8*)(xc + (tb + i0 + fr) * 4096 + 3072 + g * 128 + 32 * ks + 8 * fq);
#pragma unroll
  for (int i = 0; i < 8; ++i) {
    const int idx = tid + 256 * i, hh = idx >> 9, a = (idx >> 7) & 3, j = idx & 127;
    const float* src = (a < 2 ? csb : dtb) + (tb + j) * 64 + (a & 1) * 32 + 4 * g + hh;
    arr[idx] = *src;
  }
#pragma unroll
  for (int i = 0; i < 8; ++i) {
    const int q = tid + 256 * i;
    *(u32x4*)(smem + (q >> 4) * SS_BROW + (q & 15) * 16) = *(const u32x4*)(xc + (tb + (q >> 4)) * 4096 + 2048 + g * 128 + (q & 15) * 8);
  }
  __syncthreads();
  f32x4 cb[8];
#pragma unroll
  for (int jt = 0; jt < 8; ++jt) cb[jt] = (f32x4){0.f, 0.f, 0.f, 0.f};
#pragma unroll
  for (int ks = 0; ks < 4; ++ks)
#pragma unroll
    for (int jt = 0; jt < 8; ++jt) {
      const bf16x8 A = *(const bf16x8*)(smem + (16 * jt + fr) * SS_BROW + (32 * ks + 8 * fq) * 2);
      cb[jt] = __builtin_amdgcn_mfma_f32_16x16x32_bf16(A, cfr[ks], cb[jt], 0, 0, 0);
    }
  __syncthreads();
  float ss[4] = {0.f, 0.f, 0.f, 0.f};
  const unsigned ldsb = (unsigned)(size_t)smem;
  const unsigned xbase = ldsb + SS_R0 + (8 * fq + (fr >> 2)) * SS_XROW + (4 * (fr & 3)) * 2;
  const char* wrow = smem + (16 * w + fr) * SS_BROW + (8 * fq) * 2;
  const int il = i0 + fr;
#pragma unroll 1
  for (int hh = 0; hh < 4; ++hh) {
    const int h = 4 * g + hh;
    u32x4 pre[4];
#pragma unroll
    for (int i = 0; i < 4; ++i) { const int q = tid + 256 * i; pre[i] = *(const u32x4*)(xc + (tb + (q >> 3)) * 4096 + h * 64 + (q & 7) * 8); }
    const float* csf = arr + hh * 512;
    const float* csr = csf + 128;
    const float* dtf = csf + 256;
    const float* dtr = csf + 384;
    {
      const float cfi = csf[il], cbi = csr[il];
#pragma unroll
      for (int jt = 0; jt < 8; ++jt) {
        const f32x4 cfj = *(const f32x4*)(csf + 16 * jt + 4 * fq), cbj = *(const f32x4*)(csr + 16 * jt + 4 * fq);
        const f32x4 dfj = *(const f32x4*)(dtf + 16 * jt + 4 * fq), dbj = *(const f32x4*)(dtr + 16 * jt + 4 * fq);
        float wv[4];
#pragma unroll
        for (int jj = 0; jj < 4; ++jj) {
          const int j = 16 * jt + 4 * fq + jj;
          const float lf = (j <= il) ? __expf(cfi - cfj[jj]) * dfj[jj] : 0.f;
          const float lr = (j >= il) ? __expf(cbi - cbj[jj]) * dbj[jj] : 0.f;
          wv[jj] = cb[jt][jj] * (lf + lr);
        }
        u32x2 o; o[0] = pack2(wv[0], wv[1]); o[1] = pack2(wv[2], wv[3]);
        *(u32x2*)(smem + (16 * w + fr) * SS_BROW + (16 * jt + 4 * fq) * 2) = o;
      }
    }
#pragma unroll
    for (int i = 0; i < 4; ++i) { const int q = tid + 256 * i; *(u32x4*)(smem + SS_R0 + (q >> 3) * SS_XROW + (q & 7) * 16) = pre[i]; }
#pragma unroll
    for (int i = 0; i < 4; ++i) { const int q = tid + 256 * i; pre[i] = *(const u32x4*)(sst + (((size_t)cg * 32 + h) * 2 + 0) * 8192 + (q >> 4) * 128 + (q & 15) * 8); }
    __syncthreads();
    f32x4 y[4];
#pragma unroll
    for (int pt = 0; pt < 4; ++pt) y[pt] = (f32x4){0.f, 0.f, 0.f, 0.f};
    ssd_p2_wx_kstep<0>(y, wrow, xbase);
    ssd_p2_wx_kstep<1>(y, wrow, xbase);
    ssd_p2_wx_kstep<2>(y, wrow, xbase);
    ssd_p2_wx_kstep<3>(y, wrow, xbase);
    float xsk[4][4];
#pragma unroll
    for (int pt = 0; pt < 4; ++pt)
#pragma unroll
      for (int jj = 0; jj < 4; ++jj) xsk[pt][jj] = bf2f(*(const bf16_t*)(smem + SS_R0 + (i0 + 4 * fq + jj) * SS_XROW + (16 * pt + fr) * 2));
    __syncthreads();
#pragma unroll
    for (int i = 0; i < 4; ++i) { const int q = tid + 256 * i; *(u32x4*)(smem + SS_R0 + (q >> 4) * SS_BROW + (q & 15) * 16) = pre[i]; }
#pragma unroll
    for (int i = 0; i < 4; ++i) { const int q = tid + 256 * i; pre[i] = *(const u32x4*)(sst + (((size_t)cg * 32 + h) * 2 + 1) * 8192 + (q >> 4) * 128 + (q & 15) * 8); }
    __syncthreads();
    f32x4 zf[4], zb[4];
#pragma unroll
    for (int pt = 0; pt < 4; ++pt) { zf[pt] = (f32x4){0.f, 0.f, 0.f, 0.f}; zb[pt] = (f32x4){0.f, 0.f, 0.f, 0.f}; }
#pragma unroll
    for (int ks = 0; ks < 4; ++ks)
#pragma unroll
      for (int pt = 0; pt < 4; ++pt) {
        const bf16x8 B = *(const bf16x8*)(smem + SS_R0 + (16 * pt + fr) * SS_BROW + (32 * ks + 8 * fq) * 2);
        zf[pt] = __builtin_amdgcn_mfma_f32_16x16x32_bf16(cfr[ks], B, zf[pt], 0, 0, 0);
      }
    __syncthreads();
#pragma unroll
    for (int i = 0; i < 4; ++i) { const int q = tid + 256 * i; *(u32x4*)(smem + SS_R0 + (q >> 4) * SS_BROW + (q & 15) * 16) = pre[i]; }
    __syncthreads();
#pragma unroll
    for (int ks = 0; ks < 4; ++ks)
#pragma unroll
      for (int pt = 0; pt < 4; ++pt) {
        const bf16x8 B = *(const bf16x8*)(smem + SS_R0 + (16 * pt + fr) * SS_BROW + (32 * ks + 8 * fq) * 2);
        zb[pt] = __builtin_amdgcn_mfma_f32_16x16x32_bf16(cfr[ks], B, zb[pt], 0, 0, 0);
      }
    const float dsk = p.ssd_d[l * 32 + h];
#pragma unroll
    for (int jj = 0; jj < 4; ++jj) {
      const int i2 = i0 + 4 * fq + jj;
      const float ef = __expf(csf[i2]), eb = __expf(csr[i2]);
#pragma unroll
      for (int pt = 0; pt < 4; ++pt) {
        const float z = bf2f(proj[(tb + i2) * NPROJ_PAD + C_Z + h * 64 + 16 * pt + fr]);
        float val = y[pt][jj] + ef * zf[pt][jj] + eb * zb[pt][jj] + dsk * xsk[pt][jj];
        val *= siluf_(z);
        ybuf[(tb + i2) * 2048 + h * 64 + 16 * pt + fr] = f2bf(val);
        ss[jj] += val * val;
      }
    }
    __syncthreads();
  }
#pragma unroll
  for (int jj = 0; jj < 4; ++jj) {
    float t = ss[jj];
    t += __shfl_xor(t, 1); t += __shfl_xor(t, 2); t += __shfl_xor(t, 4); t += __shfl_xor(t, 8);
    ss[jj] = rsqrtf(t * (1.f / 256.f) + 1e-6f);
  }
#pragma unroll
  for (int hh = 0; hh < 4; ++hh)
#pragma unroll
    for (int pt = 0; pt < 4; ++pt) {
      const int chn = (4 * g + hh) * 64 + 16 * pt + fr;
      const float nw = p.ssd_norm_w[l * 2048 + chn];
#pragma unroll
      for (int jj = 0; jj < 4; ++jj) {
        bf16_t* yp = ybuf + (tb + i0 + 4 * fq + jj) * 2048 + chn;
        *yp = f2bf(bf2f(*yp) * ss[jj] * nw);
      }
    }
}

__device__ __forceinline__ void phase_scan1(const Params& p, int l, char* smem) {
  const int G = gridDim.x, bid = blockIdx.x;
  if (bid < 64) { hgrn_chunk_item(p, l, 32 * 16 + bid, smem); return; }
  for (int it = bid - 64; it < 256 + 512 + 2048; it += G - 64) {
    if (it < 256) ssd_pass1_item(p, l, 32 * 64 + it, smem);
    else if (it < 768) hgrn_chunk_item(p, l, it - 256, smem);
    else ssd_pass1_item(p, l, it - 768, smem);
  }
}
__device__ __forceinline__ void phase_scan2(const Params& p, int l, char* smem) {
  for (int it = blockIdx.x; it < 2048; it += gridDim.x) ssd_pass2_item(p, l, it, smem);
}

__device__ __forceinline__ void phase_scan_naive(const Params& p, int l, char* smem) {
  const int n_ssd = 36 * 64, n_hg = 36 * 16;
  for (int it = blockIdx.x; it < n_ssd + n_hg; it += gridDim.x) {
    if (it < 256) ssd_naive_item(p, l, 32 * 64 + it, (float*)smem);
    else if (it < 320) hgrn_chunk_item(p, l, 32 * 16 + (it - 256), smem);
    else if (it < 320 + 2048) ssd_naive_item(p, l, it - 320, (float*)smem);
    else hgrn_chunk_item(p, l, it - 320 - 2048, smem);
  }
}

__device__ __forceinline__ void phase_post(const Params& p, int l) {
  const int tid = tid_opaque();
  const bf16_t* proj = (const bf16_t*)(p.ws + OFF_PROJ);
  const bf16_t* xc = (const bf16_t*)(p.ws + OFF_XC);
  const float* yf = (const float*)(p.ws + OFF_YF);
  const float* yb = (const float*)(p.ws + OFF_YB);
  const float* of = (const float*)(p.ws + OFF_OF);
  const float* ob = (const float*)(p.ws + OFF_OB);
  bf16_t* ybuf = (bf16_t*)(p.ws + OFF_YBUF);
  bf16_t* obuf = (bf16_t*)(p.ws + OFF_OBUF);
  for (int tok = blockIdx.x; tok < T; tok += gridDim.x) {
    {
      const int ch = tid * 4;
      const float* a = of + (size_t)tok * 1024 + ch;
      const float* b = ob + (size_t)tok * 1024 + ch;
      uint2 gv = *(const uint2*)(proj + (size_t)tok * NPROJ_PAD + C_HG + ch);
      const unsigned gw[2] = {gv.x, gv.y};
      float v[4];
      float ss = 0.f;
#pragma unroll
      for (int j = 0; j < 4; ++j) { v[j] = a[j] + b[j]; ss += v[j] * v[j]; }
#pragma unroll
      for (int o = 16; o >= 1; o >>= 1) ss += __shfl_xor(ss, o);
      const float rstd = rsqrtf(ss * (1.f / 128.f) + 1e-6f);
      const float* nw = p.hgrn_norm_w + l * 1024 + ch;
      float r[4];
#pragma unroll
      for (int j = 0; j < 4; ++j) {
        const float gz = bf2f((bf16_t)((j & 1) ? (gw[j >> 1] >> 16) : (gw[j >> 1] & 0xffff)));
        r[j] = v[j] * rstd * nw[j] * siluf_(gz);
      }
      uint2 o2; o2.x = pack2(r[0], r[1]); o2.y = pack2(r[2], r[3]);
      *(uint2*)(obuf + (size_t)tok * 1024 + ch) = o2;
    }
  }
}

enum { PH_SETUP = 0, PH_NORM1, PH_PROJ, PH_CONV, PH_SCAN, PH_POST, PH_MERGE, PH_OUT, PH_NORM2, PH_FFN1, PH_FFN2, PH_FINAL };

__device__ __forceinline__ void run_phase(const Params& p, int ph, int l, char* smem) {
  switch (ph) {
    case PH_SETUP: phase_setup(p, smem); break;
    case PH_NORM1: phase_norm(p, l, 0); break;
    case PH_PROJ: phase_gemm<G_PROJ>(p, l, smem); break;
    case PH_CONV: phase_conv(p, l); break;
    case PH_SCAN: phase_scan_naive(p, l, smem); break;
    case PH_POST: phase_post(p, l); break;
    case PH_MERGE: phase_gemm<G_MERGE>(p, l, smem); break;
    case PH_OUT: phase_gemm<G_OUT>(p, l, smem); break;
    case PH_NORM2: phase_norm(p, l, 1); break;
    case PH_FFN1: phase_gemm<G_FFN1>(p, l, smem); break;
    case PH_FFN2: phase_gemm<G_FFN2>(p, l, smem); break;
    case PH_FINAL: phase_final_norm(p); break;
  }
}

extern __shared__ __attribute__((aligned(16))) char dyn_smem[];

#if !MEGA
__global__ void __launch_bounds__(256, 2) phase_kernel(Params p, int ph, int l) { run_phase(p, ph, l, dyn_smem); }
#endif

#if MEGA
__global__ void __launch_bounds__(256, 2) mega_kernel(Params p) {
  cg::grid_group grid = cg::this_grid();
  phase_setup(p, dyn_smem);
  grid.sync();
  for (int l = 0; l < DEPTH; ++l) {
    phase_norm(p, l, 0); grid.sync();
    phase_gemm<G_PROJ>(p, l, dyn_smem); grid.sync();
    phase_conv(p, l); grid.sync();
    phase_scan1(p, l, dyn_smem); grid.sync();
    phase_scan2(p, l, dyn_smem);
    phase_post(p, l); grid.sync();
    phase_gemm<G_MERGE>(p, l, dyn_smem); grid.sync();
    phase_gemm<G_OUT>(p, l, dyn_smem); grid.sync();
    phase_norm(p, l, 1); grid.sync();
    phase_gemm<G_FFN1>(p, l, dyn_smem); grid.sync();
    phase_gemm<G_FFN2>(p, l, dyn_smem); grid.sync();
  }
  phase_final_norm(p);
}
#endif

extern "C" void kernel_launch(void* const* d_in, const int* in_sizes, int n_in, void* d_out, int out_size, void* d_ws, size_t ws_size,
                              hipStream_t stream) {
  static int grid_blocks = 0;
  if (!grid_blocks) {
    int dev = 0, cus = 0, per_cu = 0;
    (void)hipGetDevice(&dev);
    (void)hipDeviceGetAttribute(&cus, hipDeviceAttributeMultiprocessorCount, dev);
#if MEGA
    (void)hipFuncSetAttribute((const void*)mega_kernel, hipFuncAttributeMaxDynamicSharedMemorySize, SMEM_BYTES);
#endif
#if !MEGA
    (void)hipFuncSetAttribute((const void*)phase_kernel, hipFuncAttributeMaxDynamicSharedMemorySize, SMEM_BYTES);
#endif
#if MEGA
    (void)hipOccupancyMaxActiveBlocksPerMultiprocessor(&per_cu, mega_kernel, 256, SMEM_BYTES);
#else
    (void)hipOccupancyMaxActiveBlocksPerMultiprocessor(&per_cu, phase_kernel, 256, SMEM_BYTES);
#endif
    if (per_cu > 2) per_cu = 2;
    if (per_cu < 1) per_cu = 1;
    grid_blocks = cus * per_cu;
  }
  Params p{};
  const float** pf = (const float**)&p;
  for (int i = 0; i < 26; ++i) pf[i] = (const float*)d_in[i];
  p.out = (float*)d_out;
  p.ws = (char*)d_ws;
#if MEGA
  void* args[] = {&p};
  hipError_t e = hipLaunchCooperativeKernel((void*)mega_kernel, dim3(grid_blocks), dim3(256), args, SMEM_BYTES, stream);
  if (e != hipSuccess) fprintf(stderr, "coop launch failed: %s\n", hipGetErrorString(e));
#else
  const int G = grid_blocks;
  phase_kernel<<<G, 256, SMEM_BYTES, stream>>>(p, PH_SETUP, 0);
  for (int l = 0; l < DEPTH; ++l)
    for (int ph = PH_NORM1; ph <= PH_FFN2; ++ph) phase_kernel<<<G, 256, SMEM_BYTES, stream>>>(p, ph, l);
  phase_kernel<<<G, 256, SMEM_BYTES, stream>>>(p, PH_FINAL, 0);
#endif
}
```

```cpp
#include <hip/hip_runtime.h>
#include <hip/hip_cooperative_groups.h>
#include <cstdio>
#include <cstdint>
namespace cg = cooperative_groups;

#ifndef MEGA
#define MEGA 1
#endif

typedef unsigned short bf16_t;
typedef short bf16x8 __attribute__((ext_vector_type(8)));
typedef float f32x4 __attribute__((ext_vector_type(4)));
typedef unsigned u32x4 __attribute__((ext_vector_type(4)));
typedef short s16x4 __attribute__((ext_vector_type(4)));
typedef unsigned u32x2 __attribute__((ext_vector_type(2)));

constexpr int D = 1024, T = 16384, TCTX = 8192, DEPTH = 4;
constexpr int NPROJ = 13376, NPROJ_PAD = 13440;
constexpr int FFN = 2816;
constexpr int C_Z = 4096, C_DT = 6144, C_HQ = 6208, C_HF = 7232, C_HI = 9280, C_HG = 10304, C_GATE = 11328;
constexpr size_t WT_IN = 0;
constexpr size_t WT_SSO = WT_IN + (size_t)NPROJ_PAD * 1024;
constexpr size_t WT_HGO = WT_SSO + (size_t)1024 * 2048;
constexpr size_t WT_OUT = WT_HGO + (size_t)1024 * 1024;
constexpr size_t WT_W13 = WT_OUT + (size_t)1024 * 1024;
constexpr size_t WT_W2 = WT_W13 + (size_t)5632 * 1024;
constexpr size_t WT_LAYER = WT_W2 + (size_t)1024 * 2816;
constexpr size_t OFF_WT = 0;
constexpr size_t OFF_H = OFF_WT + WT_LAYER * 2 * DEPTH;
constexpr size_t OFF_PROJ = OFF_H + (size_t)T * 1024 * 2;
constexpr size_t OFF_XC = OFF_PROJ + (size_t)T * NPROJ_PAD * 2;
constexpr size_t OFF_DTRAW = OFF_XC + (size_t)T * 4096 * 2;
constexpr size_t OFF_DT = OFF_DTRAW + (size_t)T * 64 * 4;
constexpr size_t OFF_YF = OFF_DT + (size_t)T * 64 * 4;
constexpr size_t OFF_YB = OFF_YF + (size_t)T * 2048 * 4;
constexpr size_t OFF_OF = OFF_YB + (size_t)T * 2048 * 4;
constexpr size_t OFF_OB = OFF_OF + (size_t)T * 1024 * 4;
constexpr size_t OFF_YBUF = OFF_OB + (size_t)T * 1024 * 4;
constexpr size_t OFF_OBUF = OFF_YBUF + (size_t)T * 2048 * 2;
constexpr size_t OFF_MBUF = OFF_OBUF + (size_t)T * 1024 * 2;
constexpr size_t OFF_MOD = OFF_MBUF + (size_t)T * 1024 * 2;
constexpr size_t OFF_LB = OFF_MOD + (size_t)DEPTH * 5 * 6144 * 4;
constexpr size_t OFF_BAR = OFF_LB + (size_t)DEPTH * 2 * 1024 * 4;
constexpr size_t OFF_END = OFF_BAR + 16384;
constexpr size_t OUT_SSM = (size_t)T * 1024;
constexpr size_t OUT_HGRN = OUT_SSM + (size_t)32 * 4 * 2 * 32 * 64 * 128;

constexpr int SMEM_BYTES = 73728;
constexpr int LDS_ROW = 144;
constexpr int LDS_TILE = 128 * LDS_ROW;

struct Params {
  const float *x_prompt, *x_sample, *c, *state_ssm, *state_hgrn, *c_ctx, *norm_mix_w, *norm_ffn_w, *ada_w, *ada_b, *w_in,
      *ssd_conv_w, *ssd_conv_b, *ssd_dt_bias, *ssd_a_log, *ssd_d, *ssd_norm_w, *hgrn_lb, *hgrn_norm_w, *w_ssd_out, *w_hgrn_out,
      *w_out, *ffn_w1, *ffn_w3, *ffn_w2, *norm_final_w;
  float* out;
  char* ws;
};

__device__ __forceinline__ bf16_t f2bf(float f) {
  unsigned u = __float_as_uint(f);
  u += 0x7fffu + ((u >> 16) & 1u);
  return (bf16_t)(u >> 16);
}
__device__ __forceinline__ float bf2f(bf16_t b) { return __uint_as_float(((unsigned)b) << 16); }
typedef __bf16 bf16x2_t __attribute__((ext_vector_type(2)));
__device__ __forceinline__ unsigned pack2(float a, float b) { bf16x2_t v = {(__bf16)a, (__bf16)b}; return __builtin_bit_cast(unsigned, v); }
__device__ __forceinline__ float sigmoidf_(float x) { return 1.0f / (1.0f + __expf(-x)); }
__device__ __forceinline__ float siluf_(float x) { return x / (1.0f + __expf(-x)); }
__device__ __forceinline__ int tid_opaque() { int t = threadIdx.x; asm volatile("" : "+v"(t)); return t; }
__device__ __forceinline__ float clamp30(float x) { return fminf(fmaxf(x, -30.f), 30.f); }
__device__ __forceinline__ float gate_ratio(float g1, float g2) { return (1.0f + __expf(-clamp30(g2))) / (1.0f + __expf(-clamp30(g1))); }
__device__ __forceinline__ int mod_row(int tok) { return tok < TCTX ? 0 : 1 + ((tok - TCTX) >> 11); }

__device__ __forceinline__ void phase_setup(const Params& p, char* smem) {
  const int tid = tid_opaque(), bid = blockIdx.x, G = gridDim.x;
  {
    const size_t n4 = (size_t)T * 1024 / 4, half4 = (size_t)TCTX * 1024 / 4;
    float4* dst = (float4*)p.out;
    const float4* s0 = (const float4*)p.x_prompt;
    const float4* s1 = (const float4*)p.x_sample;
    for (size_t i = (size_t)bid * 256 + tid; i < n4; i += (size_t)G * 256) dst[i] = i < half4 ? s0[i] : s1[i - half4];
  }
  {
    float* lb = (float*)(p.ws + OFF_LB);
    for (int i = bid * 256 + tid; i < 2048; i += G * 256) {
      float v0 = p.hgrn_lb[i], v1 = p.hgrn_lb[2048 + i], v2 = p.hgrn_lb[4096 + i], v3 = p.hgrn_lb[6144 + i];
      float m = fmaxf(fmaxf(v0, v1), fmaxf(v2, v3));
      float e0 = expf(v0 - m), e1 = expf(v1 - m), e2 = expf(v2 - m), e3 = expf(v3 - m);
      float inv = 1.0f / (e0 + e1 + e2 + e3);
      lb[i] = 0.f;
      lb[2048 + i] = e1 * inv;
      lb[4096 + i] = (e1 + e2) * inv;
      lb[6144 + i] = (e1 + e2 + e3) * inv;
    }
  }
  {
    float* sm = (float*)smem;
    float* modb = (float*)(p.ws + OFF_MOD);
    __syncthreads();
    for (int i = tid; i < 5 * 1024; i += 256) {
      int v = i >> 10, k = i & 1023;
      float cv = v == 0 ? p.c_ctx[k] : p.c[(v - 1) * 1024 + k];
      sm[i] = siluf_(cv);
    }
    __syncthreads();
    float* part = sm + 5 * 1024;
    for (int item = bid; item < DEPTH * 96; item += G) {
      int l = item / 96, cg_ = item % 96;
      int col = cg_ * 64 + (tid & 63), kg = tid >> 6;
      const float* w = p.ada_w + (size_t)l * 1024 * 6144 + col;
      float a0 = 0, a1 = 0, a2 = 0, a3 = 0, a4 = 0;
      for (int k = kg * 256; k < kg * 256 + 256; ++k) {
        float wv = w[(size_t)k * 6144];
        a0 += sm[k] * wv; a1 += sm[1024 + k] * wv; a2 += sm[2048 + k] * wv; a3 += sm[3072 + k] * wv; a4 += sm[4096 + k] * wv;
      }
      __syncthreads();
      part[(kg * 5 + 0) * 64 + (tid & 63)] = a0; part[(kg * 5 + 1) * 64 + (tid & 63)] = a1; part[(kg * 5 + 2) * 64 + (tid & 63)] = a2;
      part[(kg * 5 + 3) * 64 + (tid & 63)] = a3; part[(kg * 5 + 4) * 64 + (tid & 63)] = a4;
      __syncthreads();
      for (int i = tid; i < 320; i += 256) {
        int v = i >> 6, cc = i & 63;
        float s = part[(0 * 5 + v) * 64 + cc] + part[(1 * 5 + v) * 64 + cc] + part[(2 * 5 + v) * 64 + cc] + part[(3 * 5 + v) * 64 + cc];
        int colo = cg_ * 64 + cc;
        modb[((size_t)l * 5 + v) * 6144 + colo] = s + p.ada_b[l * 6144 + colo];
      }
    }
    __syncthreads();
  }
  {
    float* tile = (float*)smem;
    const int n_in = 210 * 16, n_sso = 16 * 32, n_hgo = 16 * 16, n_out = 16 * 16, n_w13 = 88 * 16, n_w2 = 16 * 44;
    const int per_layer = n_in + n_sso + n_hgo + n_out + n_w13 + n_w2;
    for (int it = bid; it < per_layer * DEPTH; it += G) {
      int l = it / per_layer, r = it % per_layer;
      bf16_t* wt = (bf16_t*)(p.ws + OFF_WT) + (size_t)l * WT_LAYER;
      const float *src0 = nullptr, *src1 = nullptr;
      int K, Nsrc, nt, kt;
      bf16_t* dst;
      bool zero = false;
      if (r < n_in) {
        nt = r / 16; kt = r % 16; K = 1024; Nsrc = NPROJ;
        dst = wt + WT_IN;
        if (nt >= 209) zero = true;
        src0 = p.w_in + (size_t)l * 1024 * NPROJ + nt * 64; src1 = src0 + 32;
      } else if ((r -= n_in) < n_sso) {
        nt = r / 32; kt = r % 32; K = 2048; Nsrc = 1024; dst = wt + WT_SSO;
        src0 = p.w_ssd_out + (size_t)l * 2048 * 1024 + nt * 64; src1 = src0 + 32;
      } else if ((r -= n_sso) < n_hgo) {
        nt = r / 16; kt = r % 16; K = 1024; Nsrc = 1024; dst = wt + WT_HGO;
        src0 = p.w_hgrn_out + (size_t)l * 1024 * 1024 + nt * 64; src1 = src0 + 32;
      } else if ((r -= n_hgo) < n_out) {
        nt = r / 16; kt = r % 16; K = 1024; Nsrc = 1024; dst = wt + WT_OUT;
        src0 = p.w_out + (size_t)l * 1024 * 1024 + nt * 64; src1 = src0 + 32;
      } else if ((r -= n_out) < n_w13) {
        nt = r / 16; kt = r % 16; K = 1024; Nsrc = FFN; dst = wt + WT_W13;
        src0 = p.ffn_w1 + (size_t)l * 1024 * FFN + nt * 32; src1 = p.ffn_w3 + (size_t)l * 1024 * FFN + nt * 32;
      } else {
        r -= n_w13;
        nt = r / 44; kt = r % 44; K = 2816; Nsrc = 1024; dst = wt + WT_W2;
        src0 = p.ffn_w2 + (size_t)l * 2816 * 1024 + nt * 64; src1 = src0 + 32;
      }
      __syncthreads();
      {
        int c4 = (tid & 15) * 4;
        const float* s = c4 < 32 ? src0 + c4 : src1 + (c4 - 32);
#pragma unroll
        for (int i = 0; i < 4; ++i) {
          int kr = (tid >> 4) + i * 16;
          float4 v = zero ? make_float4(0.f, 0.f, 0.f, 0.f) : *(const float4*)(s + (size_t)(kt * 64 + kr) * Nsrc);
          tile[kr * 65 + c4 + 0] = v.x; tile[kr * 65 + c4 + 1] = v.y; tile[kr * 65 + c4 + 2] = v.z; tile[kr * 65 + c4 + 3] = v.w;
        }
      }
      __syncthreads();
#pragma unroll
      for (int i = 0; i < 2; ++i) {
        int cidx = tid + i * 256, n = cidx >> 3, kc = cidx & 7;
        uint4 o;
        o.x = pack2(tile[(kc * 8 + 0) * 65 + n], tile[(kc * 8 + 1) * 65 + n]);
        o.y = pack2(tile[(kc * 8 + 2) * 65 + n], tile[(kc * 8 + 3) * 65 + n]);
        o.z = pack2(tile[(kc * 8 + 4) * 65 + n], tile[(kc * 8 + 5) * 65 + n]);
        o.w = pack2(tile[(kc * 8 + 6) * 65 + n], tile[(kc * 8 + 7) * 65 + n]);
        *(uint4*)(dst + (size_t)(nt * 64 + n) * K + kt * 64 + kc * 8) = o;
      }
    }
    __syncthreads();
  }
}

__device__ __forceinline__ void phase_norm(const Params& p, int l, int which) {
  const int lane = tid_opaque() & 63, wv = tid_opaque() >> 6;
  const float* nw = (which == 0 ? p.norm_mix_w : p.norm_ffn_w) + l * 1024;
  const float* modb = (const float*)(p.ws + OFF_MOD) + (size_t)l * 5 * 6144;
  bf16_t* h = (bf16_t*)(p.ws + OFF_H);
  for (int row = blockIdx.x * 4 + wv; row < T; row += gridDim.x * 4) {
    const float* x = p.out + (size_t)row * 1024;
    const float* md = modb + (size_t)mod_row(row) * 6144 + (which == 0 ? 0 : 3072);
    float4 v[4];
    float ss = 0.f;
#pragma unroll
    for (int i = 0; i < 4; ++i) {
      v[i] = *(const float4*)(x + i * 256 + lane * 4);
      ss += v[i].x * v[i].x + v[i].y * v[i].y + v[i].z * v[i].z + v[i].w * v[i].w;
    }
#pragma unroll
    for (int o = 32; o >= 1; o >>= 1) ss += __shfl_xor(ss, o);
    float rstd = rsqrtf(ss * (1.0f / 1024.f) + 1e-6f);
#pragma unroll
    for (int i = 0; i < 4; ++i) {
      int c = i * 256 + lane * 4;
      float4 w = *(const float4*)(nw + c), sh = *(const float4*)(md + c), sc = *(const float4*)(md + 1024 + c);
      float a0 = v[i].x * rstd * w.x * (1.f + sc.x) + sh.x, a1 = v[i].y * rstd * w.y * (1.f + sc.y) + sh.y;
      float a2 = v[i].z * rstd * w.z * (1.f + sc.z) + sh.z, a3 = v[i].w * rstd * w.w * (1.f + sc.w) + sh.w;
      uint2 o2; o2.x = pack2(a0, a1); o2.y = pack2(a2, a3);
      *(uint2*)(h + (size_t)row * 1024 + c) = o2;
    }
  }
}

__device__ __forceinline__ void phase_final_norm(const Params& p) {
  const int lane = tid_opaque() & 63, wv = tid_opaque() >> 6;
  for (int row = blockIdx.x * 4 + wv; row < T; row += gridDim.x * 4) {
    float* x = p.out + (size_t)row * 1024;
    float4 v[4];
    float ss = 0.f;
#pragma unroll
    for (int i = 0; i < 4; ++i) {
      v[i] = *(const float4*)(x + i * 256 + lane * 4);
      ss += v[i].x * v[i].x + v[i].y * v[i].y + v[i].z * v[i].z + v[i].w * v[i].w;
    }
#pragma unroll
    for (int o = 32; o >= 1; o >>= 1) ss += __shfl_xor(ss, o);
    float rstd = rsqrtf(ss * (1.0f / 1024.f) + 1e-6f);
#pragma unroll
    for (int i = 0; i < 4; ++i) {
      int c = i * 256 + lane * 4;
      float4 w = *(const float4*)(p.norm_final_w + c);
      float4 o4 = make_float4(v[i].x * rstd * w.x, v[i].y * rstd * w.y, v[i].z * rstd * w.z, v[i].w * rstd * w.w);
      *(float4*)(x + c) = o4;
    }
  }
}

template <bool HASMID>
__device__ __forceinline__ void gemm_kloop2(f32x4 (&acc)[4][4], const bf16_t* __restrict__ Ag, int lda, const bf16_t* __restrict__ Bg,
                                            int ldb, int K, const bf16_t* __restrict__ Ag2, int lda2, const bf16_t* __restrict__ Bg2,
                                            int ldb2, int K2, char* smem, const bf16_t* __restrict__ gate0) {
  const int tid = tid_opaque(), lane = tid & 63, wid = tid >> 6;
  const int wr = wid >> 1, wc = wid & 1, fr = lane & 15, fq = lane >> 4;
  const int srow = tid >> 3, skc = tid & 7;
  const bf16_t* ap = Ag + (size_t)srow * lda + skc * 8;
  const bf16_t* bp = Bg + (size_t)srow * ldb + skc * 8;
  u32x4 ra[4], rb[4];
  const int nk1 = K >> 6;
  const int nk = nk1 + (K2 >> 6);
#pragma unroll
  for (int i = 0; i < 4; ++i) {
    ra[i] = *(const u32x4*)(ap + (size_t)i * 32 * lda);
    rb[i] = *(const u32x4*)(bp + (size_t)i * 32 * ldb);
  }
#pragma unroll
  for (int i = 0; i < 4; ++i) {
    *(u32x4*)(smem + (srow + i * 32) * LDS_ROW + skc * 16) = ra[i];
    *(u32x4*)(smem + 2 * LDS_TILE + (srow + i * 32) * LDS_ROW + skc * 16) = rb[i];
  }
  __syncthreads();
  for (int kt = 0; kt < nk; ++kt) {
    const int cur = kt & 1;
    if (kt + 1 < nk) {
      if (kt + 1 == nk1) {
        ap = Ag2 + (size_t)srow * lda2 + skc * 8 - (size_t)nk1 * 64;
        bp = Bg2 + (size_t)srow * ldb2 + skc * 8 - (size_t)nk1 * 64;
        lda = lda2; ldb = ldb2;
      }
#pragma unroll
      for (int i = 0; i < 4; ++i) {
        ra[i] = *(const u32x4*)(ap + (size_t)i * 32 * lda + (kt + 1) * 64);
        rb[i] = *(const u32x4*)(bp + (size_t)i * 32 * ldb + (kt + 1) * 64);
      }
    }
    if (HASMID && kt == nk1) {
#pragma unroll
      for (int m = 0; m < 4; ++m)
#pragma unroll
        for (int n = 0; n < 4; ++n) {
          uint2 g1 = *(const uint2*)(gate0 + (size_t)(m * 16) * NPROJ_PAD + n * 16);
          uint2 g2 = *(const uint2*)(gate0 + (size_t)(m * 16) * NPROJ_PAD + 1024 + n * 16);
          acc[m][n][0] *= gate_ratio(bf2f((bf16_t)(g1.x & 0xffff)), bf2f((bf16_t)(g2.x & 0xffff)));
          acc[m][n][1] *= gate_ratio(bf2f((bf16_t)(g1.x >> 16)), bf2f((bf16_t)(g2.x >> 16)));
          acc[m][n][2] *= gate_ratio(bf2f((bf16_t)(g1.y & 0xffff)), bf2f((bf16_t)(g2.y & 0xffff)));
          acc[m][n][3] *= gate_ratio(bf2f((bf16_t)(g1.y >> 16)), bf2f((bf16_t)(g2.y >> 16)));
        }
    }
    const char* sa = smem + cur * LDS_TILE + (wr * 64 + fr) * LDS_ROW + fq * 16;
    const char* sb = smem + (2 + cur) * LDS_TILE + (wc * 64 + fr) * LDS_ROW + fq * 16;
#pragma unroll
    for (int kk = 0; kk < 2; ++kk) {
      bf16x8 af[4], bfv[4];
#pragma unroll
      for (int m = 0; m < 4; ++m) af[m] = *(const bf16x8*)(sa + m * 16 * LDS_ROW + kk * 64);
#pragma unroll
      for (int n = 0; n < 4; ++n) bfv[n] = *(const bf16x8*)(sb + n * 16 * LDS_ROW + kk * 64);
#pragma unroll
      for (int m = 0; m < 4; ++m)
#pragma unroll
        for (int n = 0; n < 4; ++n) acc[m][n] = __builtin_amdgcn_mfma_f32_16x16x32_bf16(bfv[n], af[m], acc[m][n], 0, 0, 0);
    }
    if (kt + 1 < nk) {
#pragma unroll
      for (int i = 0; i < 4; ++i) {
        *(u32x4*)(smem + (cur ^ 1) * LDS_TILE + (srow + i * 32) * LDS_ROW + skc * 16) = ra[i];
        *(u32x4*)(smem + (2 + (cur ^ 1)) * LDS_TILE + (srow + i * 32) * LDS_ROW + skc * 16) = rb[i];
      }
    }
    __syncthreads();
  }
}

__device__ __forceinline__ void gemm_kloop(f32x4 (&acc)[4][4], const bf16_t* __restrict__ Ag, int lda, const bf16_t* __restrict__ Bg,
                                           int ldb, int K, char* smem) {
  gemm_kloop2<false>(acc, Ag, lda, Bg, ldb, K, Ag, lda, Bg, ldb, 0, smem, Ag);
}
enum { G_PROJ = 0, G_MERGE = 1, G_OUT = 2, G_FFN1 = 3, G_FFN2 = 4 };

template <int MODE>
__device__ __forceinline__ void phase_gemm(const Params& p, int l, char* smem) {
  const int tid = tid_opaque(), lane = tid & 63, wid = tid >> 6;
  const int wr = wid >> 1, wc = wid & 1, fr = lane & 15, fq = lane >> 4;
  const bf16_t* wt = (const bf16_t*)(p.ws + OFF_WT) + (size_t)l * WT_LAYER;
  const bf16_t* hbuf = (const bf16_t*)(p.ws + OFF_H);
  bf16_t* proj = (bf16_t*)(p.ws + OFF_PROJ);
  bf16_t* hidden = (bf16_t*)(p.ws + OFF_PROJ);
  const float* modb = (const float*)(p.ws + OFF_MOD) + (size_t)l * 5 * 6144;
  constexpr int nM = T / 128;
  constexpr int nN = MODE == G_PROJ ? NPROJ_PAD / 128 : (MODE == G_FFN1 ? 5632 / 128 : 1024 / 128);
  for (int t = blockIdx.x; t < nM * nN; t += gridDim.x) {
    const int pm = t % nM, pn = t / nM;
    const int row0 = pm * 128, col0 = pn * 128;
    f32x4 acc[4][4];
#pragma unroll
    for (int m = 0; m < 4; ++m)
#pragma unroll
      for (int n = 0; n < 4; ++n) acc[m][n] = (f32x4){0.f, 0.f, 0.f, 0.f};
    if (MODE == G_PROJ) {
      gemm_kloop(acc, hbuf + (size_t)row0 * 1024, 1024, wt + WT_IN + (size_t)col0 * 1024, 1024, 1024, smem);
      float* dtraw = (float*)(p.ws + OFF_DTRAW);
#pragma unroll
      for (int m = 0; m < 4; ++m) {
        const int row = row0 + wr * 64 + m * 16 + fr;
#pragma unroll
        for (int n = 0; n < 4; ++n) {
          const int col = col0 + wc * 64 + n * 16 + fq * 4;
          uint2 o; o.x = pack2(acc[m][n][0], acc[m][n][1]); o.y = pack2(acc[m][n][2], acc[m][n][3]);
          *(uint2*)(proj + (size_t)row * NPROJ_PAD + col) = o;
          if (col >= C_DT && col < C_DT + 64) *(f32x4*)(dtraw + (size_t)row * 64 + (col - C_DT)) = acc[m][n];
        }
      }
    } else if (MODE == G_MERGE) {
      const bf16_t* ybuf = (const bf16_t*)(p.ws + OFF_YBUF);
      const bf16_t* obuf = (const bf16_t*)(p.ws + OFF_OBUF);
      bf16_t* mbuf = (bf16_t*)(p.ws + OFF_MBUF);
      gemm_kloop2<true>(acc, ybuf + (size_t)row0 * 2048, 2048, wt + WT_SSO + (size_t)col0 * 2048, 2048, 2048,
                        obuf + (size_t)row0 * 1024, 1024, wt + WT_HGO + (size_t)col0 * 1024, 1024, 1024, smem,
                        proj + (size_t)(row0 + wr * 64 + fr) * NPROJ_PAD + C_GATE + col0 + wc * 64 + fq * 4);
#pragma unroll
      for (int m = 0; m < 4; ++m) {
        const int row = row0 + wr * 64 + m * 16 + fr;
#pragma unroll
        for (int n = 0; n < 4; ++n) {
          const int col = col0 + wc * 64 + n * 16 + fq * 4;
          uint2 g = *(const uint2*)(proj + (size_t)row * NPROJ_PAD + C_GATE + 1024 + col);
          float r0 = acc[m][n][0] * sigmoidf_(clamp30(bf2f((bf16_t)(g.x & 0xffff))));
          float r1 = acc[m][n][1] * sigmoidf_(clamp30(bf2f((bf16_t)(g.x >> 16))));
          float r2 = acc[m][n][2] * sigmoidf_(clamp30(bf2f((bf16_t)(g.y & 0xffff))));
          float r3 = acc[m][n][3] * sigmoidf_(clamp30(bf2f((bf16_t)(g.y >> 16))));
          uint2 o; o.x = pack2(r0, r1); o.y = pack2(r2, r3);
          *(uint2*)(mbuf + (size_t)row * 1024 + col) = o;
        }
      }
    } else if (MODE == G_OUT || MODE == G_FFN2) {
      if (MODE == G_OUT) {
        const bf16_t* mbuf = (const bf16_t*)(p.ws + OFF_MBUF);
        gemm_kloop(acc, mbuf + (size_t)row0 * 1024, 1024, wt + WT_OUT + (size_t)col0 * 1024, 1024, 1024, smem);
      } else {
        gemm_kloop(acc, hidden + (size_t)row0 * FFN, FFN, wt + WT_W2 + (size_t)col0 * FFN, FFN, FFN, smem);
      }
      const float* gate = modb + (size_t)mod_row(row0) * 6144 + (MODE == G_OUT ? 2048 : 5120);
#pragma unroll
      for (int m = 0; m < 4; ++m) {
        const int row = row0 + wr * 64 + m * 16 + fr;
#pragma unroll
        for (int n = 0; n < 4; ++n) {
          const int col = col0 + wc * 64 + n * 16 + fq * 4;
          f32x4 g = *(const f32x4*)(gate + col);
          f32x4* xp = (f32x4*)(p.out + (size_t)row * 1024 + col);
          f32x4 xv = *xp;
          xv += g * acc[m][n];
          *xp = xv;
        }
      }
    } else {
      gemm_kloop(acc, hbuf + (size_t)row0 * 1024, 1024, wt + WT_W13 + (size_t)col0 * 1024, 1024, 1024, smem);
#pragma unroll
      for (int m = 0; m < 4; ++m) {
        const int row = row0 + wr * 64 + m * 16 + fr;
#pragma unroll
        for (int n = 0; n < 2; ++n) {
          const int hcol = (pn * 2 + wc) * 32 + n * 16 + fq * 4;
          float r[4];
#pragma unroll
          for (int j = 0; j < 4; ++j) r[j] = siluf_(acc[m][n][j]) * acc[m][n + 2][j];
          uint2 o; o.x = pack2(r[0], r[1]); o.y = pack2(r[2], r[3]);
          *(uint2*)(hidden + (size_t)row * FFN + hcol) = o;
        }
      }
    }
  }
}

__device__ __forceinline__ void phase_conv(const Params& p, int l) {
  const bf16_t* proj = (const bf16_t*)(p.ws + OFF_PROJ);
  bf16_t* xc = (bf16_t*)(p.ws + OFF_XC);
  const float* cw = p.ssd_conv_w + (size_t)l * 5 * 4096;
  const float* cb = p.ssd_conv_b + (size_t)l * 4096;
  const size_t total = (size_t)T * 512;
  for (size_t i = (size_t)blockIdx.x * 256 + tid_opaque(); i < total; i += (size_t)gridDim.x * 256) {
    const int tok = (int)(i >> 9), ch = (int)(i & 511) * 8;
    int pos, len;
    if (tok < TCTX) { pos = tok & 255; len = 256; } else { pos = (tok - TCTX) & 63; len = 64; }
    float a[8];
#pragma unroll
    for (int j = 0; j < 8; ++j) a[j] = cb[ch + j];
#pragma unroll
    for (int k = 0; k < 5; ++k) {
      const int q = pos + k - 2;
      if (q >= 0 && q < len) {
        uint4 v = *(const uint4*)(proj + (size_t)(tok + k - 2) * NPROJ_PAD + ch);
        const float* w = cw + k * 4096 + ch;
        a[0] += w[0] * bf2f((bf16_t)(v.x & 0xffff)); a[1] += w[1] * bf2f((bf16_t)(v.x >> 16));
        a[2] += w[2] * bf2f((bf16_t)(v.y & 0xffff)); a[3] += w[3] * bf2f((bf16_t)(v.y >> 16));
        a[4] += w[4] * bf2f((bf16_t)(v.z & 0xffff)); a[5] += w[5] * bf2f((bf16_t)(v.z >> 16));
        a[6] += w[6] * bf2f((bf16_t)(v.w & 0xffff)); a[7] += w[7] * bf2f((bf16_t)(v.w >> 16));
      }
    }
    uint4 o;
    o.x = pack2(siluf_(a[0]), siluf_(a[1])); o.y = pack2(siluf_(a[2]), siluf_(a[3]));
    o.z = pack2(siluf_(a[4]), siluf_(a[5])); o.w = pack2(siluf_(a[6]), siluf_(a[7]));
    *(uint4*)(xc + (size_t)tok * 4096 + ch) = o;
  }
  const float* dtraw = (const float*)(p.ws + OFF_DTRAW);
  float* dt = (float*)(p.ws + OFF_DT);
  for (size_t i = (size_t)blockIdx.x * 256 + tid_opaque(); i < (size_t)T * 64; i += (size_t)gridDim.x * 256) {
    float v = dtraw[i] + p.ssd_dt_bias[l * 64 + (int)(i & 63)];
    dt[i] = v > 20.f ? v : log1pf(expf(v));
  }
}

__device__ __forceinline__ void ssd_naive_item(const Params& p, int l, int item, float* sm) {
  const int d = item & 1, h = (item >> 1) & 31, s = item >> 6;
  int tok0, L;
  if (s < 32) { tok0 = s * 256; L = 256; } else { tok0 = TCTX + (s - 32) * 2048; L = 2048; }
  const int tid = tid_opaque(), pp = tid >> 2, nq = tid & 3, g = h >> 2;
  float S[32];
  if (s < 32) {
#pragma unroll
    for (int i = 0; i < 32; ++i) S[i] = 0.f;
  } else {
    const float* st = p.state_ssm + ((((size_t)(s - 32) * 4 + l) * 2 + d) * 32 + h) * 8192 + pp * 128 + nq * 32;
#pragma unroll
    for (int i = 0; i < 32; ++i) S[i] = st[i];
  }
  const float a = -expf(p.ssd_a_log[l * 64 + d * 32 + h]);
  float* xs = sm; float* Bs = sm + 1024; float* Cs = Bs + 2048; float* dts = Cs + 2048;
  const bf16_t* xc = (const bf16_t*)(p.ws + OFF_XC);
  const float* dtb = (const float*)(p.ws + OFF_DT);
  float* ydir = (float*)(p.ws + (d == 0 ? OFF_YF : OFF_YB));
  for (int bt = 0; bt < L / 16; ++bt) {
    const int tb = d == 0 ? bt * 16 : L - 16 - bt * 16;
    __syncthreads();
    for (int e = tid; e < 16 * 320; e += 256) {
      const int tt = e / 320, c = e % 320;
      const size_t base = (size_t)(tok0 + tb + tt) * 4096;
      if (c < 64) xs[tt * 64 + c] = bf2f(xc[base + h * 64 + c]);
      else if (c < 192) Bs[tt * 128 + c - 64] = bf2f(xc[base + 2048 + g * 128 + c - 64]);
      else Cs[tt * 128 + c - 192] = bf2f(xc[base + 3072 + g * 128 + c - 192]);
    }
    if (tid < 16) dts[tid] = dtb[(size_t)(tok0 + tb + tid) * 64 + d * 32 + h];
    __syncthreads();
    for (int i2 = 0; i2 < 16; ++i2) {
      const int tt = d == 0 ? i2 : 15 - i2;
      const float dt = dts[tt], dA = expf(dt * a), xdt = xs[tt * 64 + pp] * dt;
      float acc = 0.f;
      const float* Bp = Bs + tt * 128 + nq * 32;
      const float* Cp = Cs + tt * 128 + nq * 32;
#pragma unroll
      for (int i = 0; i < 32; ++i) { S[i] = dA * S[i] + xdt * Bp[i]; acc += S[i] * Cp[i]; }
      acc += __shfl_xor(acc, 1); acc += __shfl_xor(acc, 2);
      if (nq == 0) ydir[(size_t)(tok0 + tb + tt) * 2048 + h * 64 + pp] = acc;
    }
  }
  if (s < 32) {
    float* o = p.out + OUT_SSM + ((((size_t)s * 4 + l) * 2 + d) * 32 + h) * 8192 + pp * 128 + nq * 32;
#pragma unroll
    for (int i = 0; i < 32; ++i) o[i] = S[i];
  }
}

__device__ __forceinline__ void hgrn_naive_item(const Params& p, int l, int item, float* sm) {
  const int d = item & 1, hd = (item >> 1) & 7, s = item >> 4;
  int tok0, L;
  if (s < 32) { tok0 = s * 256; L = 256; } else { tok0 = TCTX + (s - 32) * 2048; L = 2048; }
  const int tid = tid_opaque(), vv = tid >> 1, kh = tid & 1;
  float S[64];
  if (s < 32) {
#pragma unroll
    for (int i = 0; i < 64; ++i) S[i] = 0.f;
  } else {
    const float* st = p.state_hgrn + ((((size_t)(s - 32) * 4 + l) * 2 + d) * 8 + hd) * 16384 + (size_t)(kh * 64) * 128 + vv;
#pragma unroll
    for (int i = 0; i < 64; ++i) S[i] = st[(size_t)i * 128];
  }
  float* qs = sm; float* fs = sm + 2048; float* ks = sm + 4096; float* vs = sm + 6144;
  const bf16_t* proj = (const bf16_t*)(p.ws + OFF_PROJ);
  const float* lb = (const float*)(p.ws + OFF_LB) + (size_t)l * 2048 + d * 1024 + hd * 128;
  float* odir = (float*)(p.ws + (d == 0 ? OFF_OF : OFF_OB));
  for (int bt = 0; bt < L / 16; ++bt) {
    const int tb = d == 0 ? bt * 16 : L - 16 - bt * 16;
    __syncthreads();
    for (int e = tid; e < 16 * 128; e += 256) {
      const int tt = e >> 7, c = e & 127;
      const size_t base = (size_t)(tok0 + tb + tt) * NPROJ_PAD;
      const float q = bf2f(proj[base + C_HQ + hd * 128 + c]);
      const float u = bf2f(proj[base + C_HF + d * 1024 + hd * 128 + c]);
      const float lbv = lb[c];
      const float sg = sigmoidf_(u);
      qs[e] = siluf_(q);
      fs[e] = lbv + (1.f - lbv) * sg;
      ks[e] = (1.f - lbv) * (1.f - sg);
      vs[e] = bf2f(proj[base + C_HI + hd * 128 + c]);
    }
    __syncthreads();
    for (int i2 = 0; i2 < 16; ++i2) {
      const int tt = d == 0 ? i2 : 15 - i2;
      const float vval = vs[tt * 128 + vv];
      const float* fp = fs + tt * 128 + kh * 64;
      const float* kp = ks + tt * 128 + kh * 64;
      const float* qp = qs + tt * 128 + kh * 64;
      float acc = 0.f;
#pragma unroll
      for (int i = 0; i < 64; ++i) { S[i] = fp[i] * S[i] + kp[i] * vval; acc += S[i] * qp[i]; }
      acc += __shfl_xor(acc, 1);
      if (kh == 0) odir[(size_t)(tok0 + tb + tt) * 1024 + hd * 128 + vv] = acc;
    }
  }
  if (s < 32) {
    float* o = p.out + OUT_HGRN + ((((size_t)s * 4 + l) * 2 + d) * 8 + hd) * 16384 + (size_t)(kh * 64) * 128 + vv;
#pragma unroll
    for (int i = 0; i < 64; ++i) o[(size_t)i * 128] = S[i];
  }
}


constexpr int HG_ROW = 272;
constexpr int HG_IMG = 16 * HG_ROW;
constexpr int HG_BUF = 4 * HG_IMG + 512;
__device__ __forceinline__ void hgrn_chunk_item(const Params& p, int l, int item, char* smem) {
  const int d = item & 1, hd = (item >> 1) & 7, s = item >> 4;
  int tok0, L;
  if (s < 32) { tok0 = s * 256; L = 256; } else { tok0 = TCTX + (s - 32) * 2048; L = 2048; }
  const int tid = tid_opaque(), lane = tid & 63, w = tid >> 6, fr = lane & 15, fq = lane >> 4;
  const int ch = tid & 127, half = tid >> 7;
  f32x4 S[8][2];
  if (s < 32) {
#pragma unroll
    for (int kt = 0; kt < 8; ++kt) { S[kt][0] = (f32x4){0.f, 0.f, 0.f, 0.f}; S[kt][1] = (f32x4){0.f, 0.f, 0.f, 0.f}; }
  } else {
    const float* st = p.state_hgrn + ((((size_t)(s - 32) * 4 + l) * 2 + d) * 8 + hd) * 16384;
#pragma unroll
    for (int kt = 0; kt < 8; ++kt)
#pragma unroll
      for (int vt = 0; vt < 2; ++vt)
#pragma unroll
        for (int jj = 0; jj < 4; ++jj) S[kt][vt][jj] = st[(size_t)(16 * kt + fq * 4 + jj) * 128 + 32 * w + 16 * vt + fr];
  }
  const float lbv = ((const float*)(p.ws + OFF_LB))[(size_t)l * 2048 + d * 1024 + hd * 128 + ch];
  const bf16_t* proj = (const bf16_t*)(p.ws + OFF_PROJ);
  float* odir = (float*)(p.ws + (d == 0 ? OFF_OF : OFF_OB));
  float* xch = (float*)(smem + 2 * HG_BUF);
  const int nch = L >> 4;
  bf16_t rq[8], ru[8], rv[8];
  __syncthreads();
  {
#pragma unroll
    for (int i = 0; i < 8; ++i) {
      const int pos = 8 * half + i;
      const size_t tk = (size_t)(d == 0 ? tok0 + pos : tok0 + L - 1 - pos) * NPROJ_PAD;
      rq[i] = proj[tk + C_HQ + hd * 128 + ch];
      ru[i] = proj[tk + C_HF + d * 1024 + hd * 128 + ch];
      rv[i] = proj[tk + C_HI + hd * 128 + ch];
    }
  }
  for (int c = 0; c < nch; ++c) {
    char* buf = smem + (c & 1) * HG_BUF;
    float* xc_ = xch + (c & 1) * 256;
    float fv[8], kk[8], qs[8];
    float loc = 1.f;
#pragma unroll
    for (int i = 0; i < 8; ++i) {
      const float u = bf2f(ru[i]);
      const float sg = sigmoidf_(u);
      fv[i] = lbv + (1.f - lbv) * sg;
      kk[i] = (1.f - lbv) * (1.f - sg);
      qs[i] = siluf_(bf2f(rq[i]));
      loc *= fv[i];
      *(bf16_t*)(buf + 3 * HG_IMG + (8 * half + i) * HG_ROW + ch * 2) = rv[i];
    }
    xc_[half * 128 + ch] = loc;
    if (c + 1 < nch) {
#pragma unroll
      for (int i = 0; i < 8; ++i) {
        const int pos = (c + 1) * 16 + 8 * half + i;
        const size_t tk = (size_t)(d == 0 ? tok0 + pos : tok0 + L - 1 - pos) * NPROJ_PAD;
        rq[i] = proj[tk + C_HQ + hd * 128 + ch];
        ru[i] = proj[tk + C_HF + d * 1024 + hd * 128 + ch];
        rv[i] = proj[tk + C_HI + hd * 128 + ch];
      }
    }
    __syncthreads();
    {
      const float other = xc_[(half ^ 1) * 128 + ch];
      float P = half ? other : 1.f;
      float sfx = half ? 1.f : other;
      float suf[8];
#pragma unroll
      for (int i = 7; i >= 0; --i) { suf[i] = sfx; sfx *= fv[i]; }
#pragma unroll
      for (int i = 0; i < 8; ++i) {
        P *= fv[i];
        const int off = (8 * half + i) * HG_ROW + ch * 2;
        *(bf16_t*)(buf + off) = f2bf(qs[i] * P);
        *(bf16_t*)(buf + HG_IMG + off) = f2bf(kk[i] / fmaxf(P, 1e-30f));
        *(bf16_t*)(buf + 2 * HG_IMG + off) = f2bf(kk[i] * suf[i]);
      }
      if (half) ((float*)(buf + 4 * HG_IMG))[ch] = P;
    }
    __syncthreads();
    const char* qtI = buf;
    const char* ktI = buf + HG_IMG;
    const float* dec = (const float*)(buf + 4 * HG_IMG);
    f32x4 at = (f32x4){0.f, 0.f, 0.f, 0.f};
#pragma unroll
    for (int ks = 0; ks < 4; ++ks) {
      bf16x8 a = *(const bf16x8*)(ktI + fr * HG_ROW + (32 * ks + fq * 8) * 2);
      bf16x8 b = *(const bf16x8*)(qtI + fr * HG_ROW + (32 * ks + fq * 8) * 2);
      at = __builtin_amdgcn_mfma_f32_16x16x32_bf16(a, b, at, 0, 0, 0);
    }
    s16x4 Pm;
    {
      u32x2 pk;
      pk[0] = pack2((fq * 4 + 0 <= fr) ? at[0] : 0.f, (fq * 4 + 1 <= fr) ? at[1] : 0.f);
      pk[1] = pack2((fq * 4 + 2 <= fr) ? at[2] : 0.f, (fq * 4 + 3 <= fr) ? at[3] : 0.f);
      Pm = __builtin_bit_cast(s16x4, pk);
    }
    const unsigned ldsb = (unsigned)(size_t)buf;
    const unsigned vaddr = ldsb + 3 * HG_IMG + (4 * fq + (fr >> 2)) * HG_ROW + (32 * w + 4 * (fr & 3)) * 2;
    const unsigned kaddr = ldsb + 2 * HG_IMG + (4 * fq + (fr >> 2)) * HG_ROW + (4 * (fr & 3)) * 2;
    s16x4 vf0, vf1, kf0, kf1, kf2, kf3, kf4, kf5, kf6, kf7;
    asm volatile(
        "ds_read_b64_tr_b16 %0, %10\n\t"
        "ds_read_b64_tr_b16 %1, %10 offset:32\n\t"
        "ds_read_b64_tr_b16 %2, %11\n\t"
        "ds_read_b64_tr_b16 %3, %11 offset:32\n\t"
        "ds_read_b64_tr_b16 %4, %11 offset:64\n\t"
        "ds_read_b64_tr_b16 %5, %11 offset:96\n\t"
        "ds_read_b64_tr_b16 %6, %11 offset:128\n\t"
        "ds_read_b64_tr_b16 %7, %11 offset:160\n\t"
        "ds_read_b64_tr_b16 %8, %11 offset:192\n\t"
        "ds_read_b64_tr_b16 %9, %11 offset:224\n\t"
        "s_waitcnt lgkmcnt(0)"
        : "=&v"(vf0), "=&v"(vf1), "=&v"(kf0), "=&v"(kf1), "=&v"(kf2), "=&v"(kf3), "=&v"(kf4), "=&v"(kf5), "=&v"(kf6), "=&v"(kf7)
        : "v"(vaddr), "v"(kaddr)
        : "memory");
    f32x4 o0 = __builtin_amdgcn_mfma_f32_16x16x16bf16_1k(Pm, vf0, (f32x4){0.f, 0.f, 0.f, 0.f}, 0, 0, 0);
    f32x4 o1 = __builtin_amdgcn_mfma_f32_16x16x16bf16_1k(Pm, vf1, (f32x4){0.f, 0.f, 0.f, 0.f}, 0, 0, 0);
#pragma unroll
    for (int ks = 0; ks < 4; ++ks) {
      u32x2 qa = *(const u32x2*)(qtI + fr * HG_ROW + (32 * ks + 4 * fq) * 2);
      u32x2 qb = *(const u32x2*)(qtI + fr * HG_ROW + (32 * ks + 16 + 4 * fq) * 2);
      u32x4 aa; aa[0] = qa[0]; aa[1] = qa[1]; aa[2] = qb[0]; aa[3] = qb[1];
      const bf16x8 A = __builtin_bit_cast(bf16x8, aa);
      u32x4 b0, b1;
      b0[0] = pack2(S[2 * ks][0][0], S[2 * ks][0][1]); b0[1] = pack2(S[2 * ks][0][2], S[2 * ks][0][3]);
      b0[2] = pack2(S[2 * ks + 1][0][0], S[2 * ks + 1][0][1]); b0[3] = pack2(S[2 * ks + 1][0][2], S[2 * ks + 1][0][3]);
      b1[0] = pack2(S[2 * ks][1][0], S[2 * ks][1][1]); b1[1] = pack2(S[2 * ks][1][2], S[2 * ks][1][3]);
      b1[2] = pack2(S[2 * ks + 1][1][0], S[2 * ks + 1][1][1]); b1[3] = pack2(S[2 * ks + 1][1][2], S[2 * ks + 1][1][3]);
      o0 = __builtin_amdgcn_mfma_f32_16x16x32_bf16(A, __builtin_bit_cast(bf16x8, b0), o0, 0, 0, 0);
      o1 = __builtin_amdgcn_mfma_f32_16x16x32_bf16(A, __builtin_bit_cast(bf16x8, b1), o1, 0, 0, 0);
    }
#pragma unroll
    for (int jj = 0; jj < 4; ++jj) {
      const int pos = c * 16 + fq * 4 + jj;
      const size_t tk = (size_t)(d == 0 ? tok0 + pos : tok0 + L - 1 - pos);
      odir[tk * 1024 + hd * 128 + 32 * w + fr] = o0[jj];
      odir[tk * 1024 + hd * 128 + 32 * w + 16 + fr] = o1[jj];
    }
    const s16x4 kfs[8] = {kf0, kf1, kf2, kf3, kf4, kf5, kf6, kf7};
#pragma unroll
    for (int kt = 0; kt < 8; ++kt) {
      const f32x4 dv = *(const f32x4*)(dec + 16 * kt + fq * 4);
      S[kt][0] = __builtin_amdgcn_mfma_f32_16x16x16bf16_1k(kfs[kt], vf0, S[kt][0] * dv, 0, 0, 0);
      S[kt][1] = __builtin_amdgcn_mfma_f32_16x16x16bf16_1k(kfs[kt], vf1, S[kt][1] * dv, 0, 0, 0);
    }
  }
  if (s < 32) {
    float* o = p.out + OUT_HGRN + ((((size_t)s * 4 + l) * 2 + d) * 8 + hd) * 16384;
#pragma unroll
    for (int kt = 0; kt < 8; ++kt)
#pragma unroll
      for (int vt = 0; vt < 2; ++vt)
#pragma unroll
        for (int jj = 0; jj < 4; ++jj) o[(size_t)(16 * kt + fq * 4 + jj) * 128 + 32 * w + 16 * vt + fr] = S[kt][vt][jj];
  }
}


constexpr size_t OFF_SST = OFF_YF;
constexpr size_t OFF_CS = OFF_YB;
constexpr int SS_BROW = 272, SS_XROW = 144;
constexpr int SS_R0 = 128 * SS_BROW;
constexpr int SS_R1 = 128 * SS_XROW;

template <int OFF>
__device__ __forceinline__ s16x4 tr_read(unsigned addr) {
  s16x4 r;
  asm volatile("ds_read_b64_tr_b16 %0, %1 offset:%2" : "=v"(r) : "v"(addr), "i"(OFF) : "memory");
  return r;
}
__device__ __forceinline__ bf16x8 cat8(s16x4 a, s16x4 b) {
  bf16x8 r;
  r[0] = a[0]; r[1] = a[1]; r[2] = a[2]; r[3] = a[3]; r[4] = b[0]; r[5] = b[1]; r[6] = b[2]; r[7] = b[3];
  return r;
}
#define TR_WAIT12(a, b, c, d, e, f, g, h, i, j, k, l_)                                                                            \
  asm volatile("s_waitcnt lgkmcnt(0)" : "+v"(a), "+v"(b), "+v"(c), "+v"(d), "+v"(e), "+v"(f), "+v"(g), "+v"(h), "+v"(i), "+v"(j), \
               "+v"(k), "+v"(l_)::"memory")
#define TR_WAIT8(a, b, c, d, e, f, g, h) \
  asm volatile("s_waitcnt lgkmcnt(0)" : "+v"(a), "+v"(b), "+v"(c), "+v"(d), "+v"(e), "+v"(f), "+v"(g), "+v"(h)::"memory")

template <int KS>
__device__ __forceinline__ void ssd_p1_kstep(f32x4 (&acc)[2][4], unsigned abase, unsigned xbase) {
  s16x4 a00 = tr_read<KS * 32 * SS_BROW>(abase), a01 = tr_read<KS * 32 * SS_BROW + 4 * SS_BROW>(abase);
  s16x4 a10 = tr_read<KS * 32 * SS_BROW + 32>(abase), a11 = tr_read<KS * 32 * SS_BROW + 4 * SS_BROW + 32>(abase);
  s16x4 b00 = tr_read<KS * 32 * SS_XROW>(xbase), b01 = tr_read<KS * 32 * SS_XROW + 4 * SS_XROW>(xbase);
  s16x4 b10 = tr_read<KS * 32 * SS_XROW + 32>(xbase), b11 = tr_read<KS * 32 * SS_XROW + 4 * SS_XROW + 32>(xbase);
  s16x4 b20 = tr_read<KS * 32 * SS_XROW + 64>(xbase), b21 = tr_read<KS * 32 * SS_XROW + 4 * SS_XROW + 64>(xbase);
  s16x4 b30 = tr_read<KS * 32 * SS_XROW + 96>(xbase), b31 = tr_read<KS * 32 * SS_XROW + 4 * SS_XROW + 96>(xbase);
  TR_WAIT12(a00, a01, a10, a11, b00, b01, b10, b11, b20, b21, b30, b31);
  const bf16x8 A0 = cat8(a00, a01), A1 = cat8(a10, a11);
  const bf16x8 B0 = cat8(b00, b01), B1 = cat8(b10, b11), B2 = cat8(b20, b21), B3 = cat8(b30, b31);
  acc[0][0] = __builtin_amdgcn_mfma_f32_16x16x32_bf16(A0, B0, acc[0][0], 0, 0, 0);
  acc[0][1] = __builtin_amdgcn_mfma_f32_16x16x32_bf16(A0, B1, acc[0][1], 0, 0, 0);
  acc[0][2] = __builtin_amdgcn_mfma_f32_16x16x32_bf16(A0, B2, acc[0][2], 0, 0, 0);
  acc[0][3] = __builtin_amdgcn_mfma_f32_16x16x32_bf16(A0, B3, acc[0][3], 0, 0, 0);
  acc[1][0] = __builtin_amdgcn_mfma_f32_16x16x32_bf16(A1, B0, acc[1][0], 0, 0, 0);
  acc[1][1] = __builtin_amdgcn_mfma_f32_16x16x32_bf16(A1, B1, acc[1][1], 0, 0, 0);
  acc[1][2] = __builtin_amdgcn_mfma_f32_16x16x32_bf16(A1, B2, acc[1][2], 0, 0, 0);
  acc[1][3] = __builtin_amdgcn_mfma_f32_16x16x32_bf16(A1, B3, acc[1][3], 0, 0, 0);
}

__device__ __forceinline__ void ssd_pass1_item(const Params& p, int l, int item, char* smem) {
  const int d = item & 1, h = (item >> 1) & 31, s = item >> 6, g = h >> 2;
  const int nc = s < 32 ? 2 : 16, cg0 = s < 32 ? 2 * s : 64 + 16 * (s - 32);
  const int tid = tid_opaque(), lane = tid & 63, w = tid >> 6, fr = lane & 15, fq = lane >> 4;
  const float a = -expf(p.ssd_a_log[l * 64 + d * 32 + h]);
  f32x4 acc[2][4];
  if (s < 32) {
#pragma unroll
    for (int i = 0; i < 2; ++i)
#pragma unroll
      for (int j = 0; j < 4; ++j) acc[i][j] = (f32x4){0.f, 0.f, 0.f, 0.f};
  } else {
    const float* st = p.state_ssm + ((((size_t)(s - 32) * 4 + l) * 2 + d) * 32 + h) * 8192;
#pragma unroll
    for (int i = 0; i < 2; ++i)
#pragma unroll
      for (int j = 0; j < 4; ++j) acc[i][j] = *(const f32x4*)(st + (size_t)(16 * j + fr) * 128 + 32 * w + 16 * i + 4 * fq);
  }
  const bf16_t* xc = (const bf16_t*)(p.ws + OFF_XC);
  const float* dtb = (const float*)(p.ws + OFF_DT);
  float* csb = (float*)(p.ws + OFF_CS);
  bf16_t* sst = (bf16_t*)(p.ws + OFF_SST);
  float* wgt = (float*)(smem + SS_R0 + SS_R1);
  u32x4 pb[8], px[4];
  float dt0, dt1;
  {
    const int c = d == 0 ? 0 : nc - 1;
    const size_t tb = (size_t)(cg0 + c) * 128;
#pragma unroll
    for (int i = 0; i < 8; ++i) { const int q = tid + 256 * i; pb[i] = *(const u32x4*)(xc + (tb + (q >> 4)) * 4096 + 2048 + g * 128 + (q & 15) * 8); }
#pragma unroll
    for (int i = 0; i < 4; ++i) { const int q = tid + 256 * i; px[i] = *(const u32x4*)(xc + (tb + (q >> 3)) * 4096 + h * 64 + (q & 7) * 8); }
    dt0 = dtb[(tb + 2 * lane) * 64 + d * 32 + h];
    dt1 = dtb[(tb + 2 * lane + 1) * 64 + d * 32 + h];
  }
  const unsigned ldsb = (unsigned)(size_t)smem;
  const unsigned abase = ldsb + (8 * fq + (fr >> 2)) * SS_BROW + (32 * w + 4 * (fr & 3)) * 2;
  const unsigned xbase = ldsb + SS_R0 + (8 * fq + (fr >> 2)) * SS_XROW + (4 * (fr & 3)) * 2;
  for (int cc = 0; cc < nc; ++cc) {
    const int c = d == 0 ? cc : nc - 1 - cc, par = cc & 1;
    const size_t cgl = cg0 + c, tb = cgl * 128;
    {
      bf16_t* so = sst + ((cgl * 32 + h) * 2 + d) * 8192;
#pragma unroll
      for (int i = 0; i < 2; ++i)
#pragma unroll
        for (int j = 0; j < 4; ++j) {
          u32x2 o; o[0] = pack2(acc[i][j][0], acc[i][j][1]); o[1] = pack2(acc[i][j][2], acc[i][j][3]);
          *(u32x2*)(so + (size_t)(16 * j + fr) * 128 + 32 * w + 16 * i + 4 * fq) = o;
        }
    }
    if (w == 0) {
      const float v0 = dt0 * a, v1 = dt1 * a, sloc = v0 + v1;
      float incl = sloc;
#pragma unroll
      for (int off = 1; off < 64; off <<= 1) { const float t = __shfl_up(incl, off); if (lane >= off) incl += t; }
      const float excl = incl - sloc, c0 = excl + v0, tot = __shfl(incl, 63);
      float cs0, cs1, wg0, wg1;
      if (d == 0) { cs0 = c0; cs1 = incl; wg0 = dt0 * __expf(tot - c0); wg1 = dt1 * __expf(tot - incl); }
      else { cs0 = tot - excl; cs1 = tot - c0; wg0 = dt0 * __expf(excl); wg1 = dt1 * __expf(c0); }
      csb[(tb + 2 * lane) * 64 + d * 32 + h] = cs0;
      csb[(tb + 2 * lane + 1) * 64 + d * 32 + h] = cs1;
      wgt[par * 128 + 2 * lane] = wg0;
      wgt[par * 128 + 2 * lane + 1] = wg1;
      if (lane == 0) wgt[256 + par] = __expf(tot);
    }
    __syncthreads();
#pragma unroll
    for (int i = 0; i < 8; ++i) { const int q = tid + 256 * i; *(u32x4*)(smem + (q >> 4) * SS_BROW + (q & 15) * 16) = pb[i]; }
#pragma unroll
    for (int i = 0; i < 4; ++i) {
      const int q = tid + 256 * i, row = q >> 3;
      const float wv = wgt[par * 128 + row];
      u32x4 o;
#pragma unroll
      for (int e = 0; e < 4; ++e) o[e] = pack2(bf2f((bf16_t)(px[i][e] & 0xffff)) * wv, bf2f((bf16_t)(px[i][e] >> 16)) * wv);
      *(u32x4*)(smem + SS_R0 + row * SS_XROW + (q & 7) * 16) = o;
    }
    if (cc + 1 < nc) {
      const int cn = d == 0 ? cc + 1 : nc - 2 - cc;
      const size_t tbn = (size_t)(cg0 + cn) * 128;
#pragma unroll
      for (int i = 0; i < 8; ++i) { const int q = tid + 256 * i; pb[i] = *(const u32x4*)(xc + (tbn + (q >> 4)) * 4096 + 2048 + g * 128 + (q & 15) * 8); }
#pragma unroll
      for (int i = 0; i < 4; ++i) { const int q = tid + 256 * i; px[i] = *(const u32x4*)(xc + (tbn + (q >> 3)) * 4096 + h * 64 + (q & 7) * 8); }
      dt0 = dtb[(tbn + 2 * lane) * 64 + d * 32 + h];
      dt1 = dtb[(tbn + 2 * lane + 1) * 64 + d * 32 + h];
    }
    __syncthreads();
    const float dec = wgt[256 + par];
#pragma unroll
    for (int i = 0; i < 2; ++i)
#pragma unroll
      for (int j = 0; j < 4; ++j) acc[i][j] *= dec;
    ssd_p1_kstep<0>(acc, abase, xbase);
    ssd_p1_kstep<1>(acc, abase, xbase);
    ssd_p1_kstep<2>(acc, abase, xbase);
    ssd_p1_kstep<3>(acc, abase, xbase);
  }
  if (s < 32) {
    float* o = p.out + OUT_SSM + ((((size_t)s * 4 + l) * 2 + d) * 32 + h) * 8192;
#pragma unroll
    for (int i = 0; i < 2; ++i)
#pragma unroll
      for (int j = 0; j < 4; ++j) *(f32x4*)(o + (size_t)(16 * j + fr) * 128 + 32 * w + 16 * i + 4 * fq) = acc[i][j];
  }
  __syncthreads();
}

template <int KS>
__device__ __forceinline__ void ssd_p2_wx_kstep(f32x4 (&y)[4], const char* wrow, unsigned xbase) {
  s16x4 b00 = tr_read<KS * 32 * SS_XROW>(xbase), b01 = tr_read<KS * 32 * SS_XROW + 4 * SS_XROW>(xbase);
  s16x4 b10 = tr_read<KS * 32 * SS_XROW + 32>(xbase), b11 = tr_read<KS * 32 * SS_XROW + 4 * SS_XROW + 32>(xbase);
  s16x4 b20 = tr_read<KS * 32 * SS_XROW + 64>(xbase), b21 = tr_read<KS * 32 * SS_XROW + 4 * SS_XROW + 64>(xbase);
  s16x4 b30 = tr_read<KS * 32 * SS_XROW + 96>(xbase), b31 = tr_read<KS * 32 * SS_XROW + 4 * SS_XROW + 96>(xbase);
  const bf16x8 A = *(const bf16x8*)(wrow + KS * 64);
  TR_WAIT8(b00, b01, b10, b11, b20, b21, b30, b31);
  y[0] = __builtin_amdgcn_mfma_f32_16x16x32_bf16(A, cat8(b00, b01), y[0], 0, 0, 0);
  y[1] = __builtin_amdgcn_mfma_f32_16x16x32_bf16(A, cat8(b10, b11), y[1], 0, 0, 0);
  y[2] = __builtin_amdgcn_mfma_f32_16x16x32_bf16(A, cat8(b20, b21), y[2], 0, 0, 0);
  y[3] = __builtin_amdgcn_mfma_f32_16x16x32_bf16(A, cat8(b30, b31), y[3], 0, 0, 0);
}

__device__ __forceinline__ void ssd_pass2_item(const Params& p, int l, int item, char* smem) {
  const int hf = item & 1, g = (item >> 1) & 7, cg = item >> 4;
  const size_t tb = (size_t)cg * 128;
  const int tid = tid_opaque(), lane = tid & 63, w = tid >> 6, fr = lane & 15, fq = lane >> 4;
  const int i0 = 64 * hf + 16 * w;
  const bf16_t* xc = (const bf16_t*)(p.ws + OFF_XC);
  const bf16_t* proj = (const bf16_t*)(p.ws + OFF_PROJ);
  const float* dtb = (const float*)(p.ws + OFF_DT);
  const float* csb = (const float*)(p.ws + OFF_CS);
  const bf16_t* sst = (const bf16_t*)(p.ws + OFF_SST);
  bf16_t* ybuf = (bf16_t*)(p.ws + OFF_YBUF);
  float* arr = (float*)(smem + SS_R0 + SS_R1);
  __syncthreads();
  bf16x8 cfr[4];
#pragma unroll
  for (int ks = 0; ks < 4; ++ks) cfr[ks] = *(const bf16x8*)(xc + (tb + i0 + fr) * 4096 + 3072 + g * 128 + 32 * ks + 8 * fq);
#pragma unroll
  for (int i = 0; i < 8; ++i) {
    const int idx = tid + 256 * i, hh = idx >> 9, a = (idx >> 7) & 3, j = idx & 127;
    const float* src = (a < 2 ? csb : dtb) + (tb + j) * 64 + (a & 1) * 32 + 4 * g + hh;
    arr[idx] = *src;
  }
#pragma unroll
  for (int i = 0; i < 8; ++i) {
    const int q = tid + 256 * i;
    *(u32x4*)(smem + (q >> 4) * SS_BROW + (q & 15) * 16) = *(const u32x4*)(xc + (tb + (q >> 4)) * 4096 + 2048 + g * 128 + (q & 15) * 8);
  }
  __syncthreads();
  f32x4 cb[8];
#pragma unroll
  for (int jt = 0; jt < 8; ++jt) cb[jt] = (f32x4){0.f, 0.f, 0.f, 0.f};
#pragma unroll
  for (int ks = 0; ks < 4; ++ks)
#pragma unroll
    for (int jt = 0; jt < 8; ++jt) {
      const bf16x8 A = *(const bf16x8*)(smem + (16 * jt + fr) * SS_BROW + (32 * ks + 8 * fq) * 2);
      cb[jt] = __builtin_amdgcn_mfma_f32_16x16x32_bf16(A, cfr[ks], cb[jt], 0, 0, 0);
    }
  __syncthreads();
  float ss[4] = {0.f, 0.f, 0.f, 0.f};
  const unsigned ldsb = (unsigned)(size_t)smem;
  const unsigned xbase = ldsb + SS_R0 + (8 * fq + (fr >> 2)) * SS_XROW + (4 * (fr & 3)) * 2;
  const char* wrow = smem + (16 * w + fr) * SS_BROW + (8 * fq) * 2;
  const int il = i0 + fr;
#pragma unroll 1
  for (int hh = 0; hh < 4; ++hh) {
    const int h = 4 * g + hh;
    u32x4 pre[4];
#pragma unroll
    for (int i = 0; i < 4; ++i) { const int q = tid + 256 * i; pre[i] = *(const u32x4*)(xc + (tb + (q >> 3)) * 4096 + h * 64 + (q & 7) * 8); }
    const float* csf = arr + hh * 512;
    const float* csr = csf + 128;
    const float* dtf = csf + 256;
    const float* dtr = csf + 384;
    {
      const float cfi = csf[il], cbi = csr[il];
#pragma unroll
      for (int jt = 0; jt < 8; ++jt) {
        const f32x4 cfj = *(const f32x4*)(csf + 16 * jt + 4 * fq), cbj = *(const f32x4*)(csr + 16 * jt + 4 * fq);
        const f32x4 dfj = *(const f32x4*)(dtf + 16 * jt + 4 * fq), dbj = *(const f32x4*)(dtr + 16 * jt + 4 * fq);
        float wv[4];
#pragma unroll
        for (int jj = 0; jj < 4; ++jj) {
          const int j = 16 * jt + 4 * fq + jj;
          const float lf = (j <= il) ? __expf(cfi - cfj[jj]) * dfj[jj] : 0.f;
          const float lr = (j >= il) ? __expf(cbi - cbj[jj]) * dbj[jj] : 0.f;
          wv[jj] = cb[jt][jj] * (lf + lr);
        }
        u32x2 o; o[0] = pack2(wv[0], wv[1]); o[1] = pack2(wv[2], wv[3]);
        *(u32x2*)(smem + (16 * w + fr) * SS_BROW + (16 * jt + 4 * fq) * 2) = o;
      }
    }
#pragma unroll
    for (int i = 0; i < 4; ++i) { const int q = tid + 256 * i; *(u32x4*)(smem + SS_R0 + (q >> 3) * SS_XROW + (q & 7) * 16) = pre[i]; }
#pragma unroll
    for (int i = 0; i < 4; ++i) { const int q = tid + 256 * i; pre[i] = *(const u32x4*)(sst + (((size_t)cg * 32 + h) * 2 + 0) * 8192 + (q >> 4) * 128 + (q & 15) * 8); }
    __syncthreads();
    f32x4 y[4];
#pragma unroll
    for (int pt = 0; pt < 4; ++pt) y[pt] = (f32x4){0.f, 0.f, 0.f, 0.f};
    ssd_p2_wx_kstep<0>(y, wrow, xbase);
    ssd_p2_wx_kstep<1>(y, wrow, xbase);
    ssd_p2_wx_kstep<2>(y, wrow, xbase);
    ssd_p2_wx_kstep<3>(y, wrow, xbase);
    float xsk[4][4];
#pragma unroll
    for (int pt = 0; pt < 4; ++pt)
#pragma unroll
      for (int jj = 0; jj < 4; ++jj) xsk[pt][jj] = bf2f(*(const bf16_t*)(smem + SS_R0 + (i0 + 4 * fq + jj) * SS_XROW + (16 * pt + fr) * 2));
    __syncthreads();
#pragma unroll
    for (int i = 0; i < 4; ++i) { const int q = tid + 256 * i; *(u32x4*)(smem + SS_R0 + (q >> 4) * SS_BROW + (q & 15) * 16) = pre[i]; }
#pragma unroll
    for (int i = 0; i < 4; ++i) { const int q = tid + 256 * i; pre[i] = *(const u32x4*)(sst + (((size_t)cg * 32 + h) * 2 + 1) * 8192 + (q >> 4) * 128 + (q & 15) * 8); }
    __syncthreads();
    f32x4 zf[4], zb[4];
#pragma unroll
    for (int pt = 0; pt < 4; ++pt) { zf[pt] = (f32x4){0.f, 0.f, 0.f, 0.f}; zb[pt] = (f32x4){0.f, 0.f, 0.f, 0.f}; }
#pragma unroll
    for (int ks = 0; ks < 4; ++ks)
#pragma unroll
      for (int pt = 0; pt < 4; ++pt) {
        const bf16x8 B = *(const bf16x8*)(smem + SS_R0 + (16 * pt + fr) * SS_BROW + (32 * ks + 8 * fq) * 2);
        zf[pt] = __builtin_amdgcn_mfma_f32_16x16x32_bf16(cfr[ks], B, zf[pt], 0, 0, 0);
      }
    __syncthreads();
#pragma unroll
    for (int i = 0; i < 4; ++i) { const int q = tid + 256 * i; *(u32x4*)(smem + SS_R0 + (q >> 4) * SS_BROW + (q & 15) * 16) = pre[i]; }
    __syncthreads();
#pragma unroll
    for (int ks = 0; ks < 4; ++ks)
#pragma unroll
      for (int pt = 0; pt < 4; ++pt) {
        const bf16x8 B = *(const bf16x8*)(smem + SS_R0 + (16 * pt + fr) * SS_BROW + (32 * ks + 8 * fq) * 2);
        zb[pt] = __builtin_amdgcn_mfma_f32_16x16x32_bf16(cfr[ks], B, zb[pt], 0, 0, 0);
      }
    const float dsk = p.ssd_d[l * 32 + h];
#pragma unroll
    for (int jj = 0; jj < 4; ++jj) {
      const int i2 = i0 + 4 * fq + jj;
      const float ef = __expf(csf[i2]), eb = __expf(csr[i2]);
#pragma unroll
      for (int pt = 0; pt < 4; ++pt) {
        const float z = bf2f(proj[(tb + i2) * NPROJ_PAD + C_Z + h * 64 + 16 * pt + fr]);
        float val = y[pt][jj] + ef * zf[pt][jj] + eb * zb[pt][jj] + dsk * xsk[pt][jj];
        val *= siluf_(z);
        ybuf[(tb + i2) * 2048 + h * 64 + 16 * pt + fr] = f2bf(val);
        ss[jj] += val * val;
      }
    }
    __syncthreads();
  }
#pragma unroll
  for (int jj = 0; jj < 4; ++jj) {
    float t = ss[jj];
    t += __shfl_xor(t, 1); t += __shfl_xor(t, 2); t += __shfl_xor(t, 4); t += __shfl_xor(t, 8);
    ss[jj] = rsqrtf(t * (1.f / 256.f) + 1e-6f);
  }
#pragma unroll
  for (int hh = 0; hh < 4; ++hh)
#pragma unroll
    for (int pt = 0; pt < 4; ++pt) {
      const int chn = (4 * g + hh) * 64 + 16 * pt + fr;
      const float nw = p.ssd_norm_w[l * 2048 + chn];
#pragma unroll
      for (int jj = 0; jj < 4; ++jj) {
        bf16_t* yp = ybuf + (tb + i0 + 4 * fq + jj) * 2048 + chn;
        *yp = f2bf(bf2f(*yp) * ss[jj] * nw);
      }
    }
}

__device__ __forceinline__ void phase_scan1(const Params& p, int l, char* smem) {
  const int G = gridDim.x, bid = blockIdx.x;
  if (bid < 64) { hgrn_chunk_item(p, l, 32 * 16 + bid, smem); return; }
  for (int it = bid - 64; it < 256 + 512 + 2048; it += G - 64) {
    if (it < 256) ssd_pass1_item(p, l, 32 * 64 + it, smem);
    else if (it < 768) hgrn_chunk_item(p, l, it - 256, smem);
    else ssd_pass1_item(p, l, it - 768, smem);
  }
}
__device__ __forceinline__ void phase_scan2(const Params& p, int l, char* smem) {
  for (int it = blockIdx.x; it < 2048; it += gridDim.x) ssd_pass2_item(p, l, it, smem);
}

__device__ __forceinline__ void phase_scan_naive(const Params& p, int l, char* smem) {
  const int n_ssd = 36 * 64, n_hg = 36 * 16;
  for (int it = blockIdx.x; it < n_ssd + n_hg; it += gridDim.x) {
    if (it < 256) ssd_naive_item(p, l, 32 * 64 + it, (float*)smem);
    else if (it < 320) hgrn_chunk_item(p, l, 32 * 16 + (it - 256), smem);
    else if (it < 320 + 2048) ssd_naive_item(p, l, it - 320, (float*)smem);
    else hgrn_chunk_item(p, l, it - 320 - 2048, smem);
  }
}

__device__ __forceinline__ void phase_post(const Params& p, int l) {
  const int tid = tid_opaque();
  const bf16_t* proj = (const bf16_t*)(p.ws + OFF_PROJ);
  const bf16_t* xc = (const bf16_t*)(p.ws + OFF_XC);
  const float* yf = (const float*)(p.ws + OFF_YF);
  const float* yb = (const float*)(p.ws + OFF_YB);
  const float* of = (const float*)(p.ws + OFF_OF);
  const float* ob = (const float*)(p.ws + OFF_OB);
  bf16_t* ybuf = (bf16_t*)(p.ws + OFF_YBUF);
  bf16_t* obuf = (bf16_t*)(p.ws + OFF_OBUF);
  for (int tok = blockIdx.x; tok < T; tok += gridDim.x) {
    {
      const int ch = tid * 4;
      const float* a = of + (size_t)tok * 1024 + ch;
      const float* b = ob + (size_t)tok * 1024 + ch;
      uint2 gv = *(const uint2*)(proj + (size_t)tok * NPROJ_PAD + C_HG + ch);
      const unsigned gw[2] = {gv.x, gv.y};
      float v[4];
      float ss = 0.f;
#pragma unroll
      for (int j = 0; j < 4; ++j) { v[j] = a[j] + b[j]; ss += v[j] * v[j]; }
#pragma unroll
      for (int o = 16; o >= 1; o >>= 1) ss += __shfl_xor(ss, o);
      const float rstd = rsqrtf(ss * (1.f / 128.f) + 1e-6f);
      const float* nw = p.hgrn_norm_w + l * 1024 + ch;
      float r[4];
#pragma unroll
      for (int j = 0; j < 4; ++j) {
        const float gz = bf2f((bf16_t)((j & 1) ? (gw[j >> 1] >> 16) : (gw[j >> 1] & 0xffff)));
        r[j] = v[j] * rstd * nw[j] * siluf_(gz);
      }
      uint2 o2; o2.x = pack2(r[0], r[1]); o2.y = pack2(r[2], r[3]);
      *(uint2*)(obuf + (size_t)tok * 1024 + ch) = o2;
    }
  }
}


#define XB_TMO 128
#define XB_XCNT(j) (256 + 64 * (j))
#define XB_XSUB(j) (1280 + 64 * (j))
#define XB_XGEN(j) (2304 + 64 * (j))
#define XB_TOP 3328
#define XB_TOPGEN 3392
#define XCD_BAR_WORDS 3456
#define XB_SPIN_CAP (1u << 22)
#define LAS __attribute__((address_space(3)))
__device__ __forceinline__ unsigned xb_ld(unsigned* p) { return __hip_atomic_load(p, __ATOMIC_RELAXED, __HIP_MEMORY_SCOPE_AGENT); }
__device__ __forceinline__ unsigned xb_add(unsigned* p, unsigned v) { return __hip_atomic_fetch_add(p, v, __ATOMIC_RELAXED, __HIP_MEMORY_SCOPE_AGENT); }
__device__ __forceinline__ unsigned xb_xcc_id() { return (unsigned)__builtin_amdgcn_s_getreg((3 << 11) | 20) & 0xFu; }
#define XB_SPIN(cond, bar)                                                                    \
  do {                                                                                        \
    unsigned _sp = 0;                                                                         \
    while (cond) {                                                                            \
      __builtin_amdgcn_s_sleep(1);                                                            \
      if ((++_sp & 255u) == 0u) {                                                             \
        if (xb_ld(&(bar)[XB_TMO])) break;                                                     \
        if (_sp > XB_SPIN_CAP) { atomicAdd(&(bar)[XB_TMO], 1u); break; }                      \
      }                                                                                       \
    }                                                                                         \
  } while (0)
struct XcdBarrier { unsigned* bar; unsigned x; volatile LAS unsigned* st; };
__device__ __forceinline__ XcdBarrier xcd_barrier_post(unsigned* bar, volatile LAS unsigned* st) {
  XcdBarrier b; b.bar = bar; b.x = xb_xcc_id(); b.st = st;
  if (threadIdx.x == 0) (void)xb_add(&bar[XB_XCNT(b.x)], 1u);
  return b;
}
__device__ __forceinline__ void xcd_barrier_complete(unsigned* bar, unsigned x, unsigned& nloc, unsigned& nx) {
  const unsigned G = gridDim.x * gridDim.y * gridDim.z;
  unsigned sum, cnt, mine, sp = 0u;
  for (;;) {
    sum = 0u; cnt = 0u; mine = 0u;
#pragma unroll
    for (unsigned j = 0; j < 16; ++j) { const unsigned c = xb_ld(&bar[XB_XCNT(j)]); sum += c; cnt += (c > 0u) ? 1u : 0u; mine = (j == x) ? c : mine; }
    if (sum == G) break;
    __builtin_amdgcn_s_sleep(1);
    if ((++sp & 255u) == 0u) { if (xb_ld(&bar[XB_TMO])) break; if (sp > XB_SPIN_CAP) { atomicAdd(&bar[XB_TMO], 1u); break; } }
  }
  nloc = mine > 0u ? mine : 1u; nx = cnt > 0u ? cnt : 1u;
}
__device__ __forceinline__ void xcd_barrier(const XcdBarrier& b) {
  asm volatile("s_waitcnt vmcnt(0)" ::: "memory");
  __syncthreads();
  if (threadIdx.x == 0) {
    unsigned* bar = b.bar;
    __builtin_amdgcn_s_waitcnt(0);
    unsigned nloc = b.st[0], nx = b.st[1];
    if (nloc == 0u) { xcd_barrier_complete(bar, b.x, nloc, nx); b.st[0] = nloc; b.st[1] = nx; }
    const unsigned old = xb_add(&bar[XB_XSUB(b.x)], 1u);
    const unsigned gen = old / nloc;
    if (old + 1u == (gen + 1u) * nloc) {
      __builtin_amdgcn_fence(__ATOMIC_RELEASE, "agent");
      asm volatile("s_waitcnt vmcnt(0)" ::: "memory");
      const unsigned og = xb_add(&bar[XB_TOP], 1u);
      const unsigned tg = og / nx;
      if (og + 1u == (tg + 1u) * nx) xb_add(&bar[XB_TOPGEN], 1u);
      else XB_SPIN(xb_ld(&bar[XB_TOPGEN]) == tg, bar);
      __builtin_amdgcn_fence(__ATOMIC_ACQUIRE, "agent");
      xb_add(&bar[XB_XGEN(b.x)], 1u);
      asm volatile("s_waitcnt vmcnt(0)" ::: "memory");
    } else {
      XB_SPIN(xb_ld(&bar[XB_XGEN(b.x)]) == gen, bar);
      __builtin_amdgcn_fence(__ATOMIC_ACQUIRE, "agent");
      asm volatile("s_waitcnt vmcnt(0)" ::: "memory");
    }
  }
  __syncthreads();
}

enum { PH_SETUP = 0, PH_NORM1, PH_PROJ, PH_CONV, PH_SCAN, PH_POST, PH_MERGE, PH_OUT, PH_NORM2, PH_FFN1, PH_FFN2, PH_FINAL };

__device__ __forceinline__ void run_phase(const Params& p, int ph, int l, char* smem) {
  switch (ph) {
    case PH_SETUP: phase_setup(p, smem); break;
    case PH_NORM1: phase_norm(p, l, 0); break;
    case PH_PROJ: phase_gemm<G_PROJ>(p, l, smem); break;
    case PH_CONV: phase_conv(p, l); break;
    case PH_SCAN: phase_scan_naive(p, l, smem); break;
    case PH_POST: phase_post(p, l); break;
    case PH_MERGE: phase_gemm<G_MERGE>(p, l, smem); break;
    case PH_OUT: phase_gemm<G_OUT>(p, l, smem); break;
    case PH_NORM2: phase_norm(p, l, 1); break;
    case PH_FFN1: phase_gemm<G_FFN1>(p, l, smem); break;
    case PH_FFN2: phase_gemm<G_FFN2>(p, l, smem); break;
    case PH_FINAL: phase_final_norm(p); break;
  }
}

extern __shared__ __attribute__((aligned(16))) char dyn_smem[];

#if !MEGA
__global__ void __launch_bounds__(256, 2) phase_kernel(Params p, int ph, int l) { run_phase(p, ph, l, dyn_smem); }
#endif

#if MEGA
__global__ void __launch_bounds__(256, 2) mega_kernel(Params p) {
  cg::grid_group grid = cg::this_grid();
  __shared__ uint4 xb_words;
  if (threadIdx.x == 0) xb_words = make_uint4(0u, 0u, 0u, 0u);
  __syncthreads();
  XcdBarrier xb = xcd_barrier_post((unsigned*)(p.ws + OFF_BAR), (volatile LAS unsigned*)&xb_words);
  phase_setup(p, dyn_smem);
  grid.sync();
  for (int l = 0; l < DEPTH; ++l) {
    phase_norm(p, l, 0); xcd_barrier(xb);
    phase_gemm<G_PROJ>(p, l, dyn_smem); xcd_barrier(xb);
    phase_conv(p, l); xcd_barrier(xb);
    phase_scan1(p, l, dyn_smem); xcd_barrier(xb);
    phase_scan2(p, l, dyn_smem);
    phase_post(p, l); xcd_barrier(xb);
    phase_gemm<G_MERGE>(p, l, dyn_smem); xcd_barrier(xb);
    phase_gemm<G_OUT>(p, l, dyn_smem); xcd_barrier(xb);
    phase_norm(p, l, 1); xcd_barrier(xb);
    phase_gemm<G_FFN1>(p, l, dyn_smem); xcd_barrier(xb);
    phase_gemm<G_FFN2>(p, l, dyn_smem); xcd_barrier(xb);
  }
  phase_final_norm(p);
}
#endif

extern "C" void kernel_launch(void* const* d_in, const int* in_sizes, int n_in, void* d_out, int out_size, void* d_ws, size_t ws_size,
                              hipStream_t stream) {
  static int grid_blocks = 0;
  if (!grid_blocks) {
    int dev = 0, cus = 0, per_cu = 0;
    (void)hipGetDevice(&dev);
    (void)hipDeviceGetAttribute(&cus, hipDeviceAttributeMultiprocessorCount, dev);
#if MEGA
    (void)hipFuncSetAttribute((const void*)mega_kernel, hipFuncAttributeMaxDynamicSharedMemorySize, SMEM_BYTES);
#endif
#if !MEGA
    (void)hipFuncSetAttribute((const void*)phase_kernel, hipFuncAttributeMaxDynamicSharedMemorySize, SMEM_BYTES);
#endif
#if MEGA
    (void)hipOccupancyMaxActiveBlocksPerMultiprocessor(&per_cu, mega_kernel, 256, SMEM_BYTES);
#else
    (void)hipOccupancyMaxActiveBlocksPerMultiprocessor(&per_cu, phase_kernel, 256, SMEM_BYTES);
#endif
    if (per_cu > 2) per_cu = 2;
    if (per_cu < 1) per_cu = 1;
    grid_blocks = cus * per_cu;
  }
  Params p{};
  const float** pf = (const float**)&p;
  for (int i = 0; i < 26; ++i) pf[i] = (const float*)d_in[i];
  p.out = (float*)d_out;
  p.ws = (char*)d_ws;
#if MEGA
  (void)hipMemsetAsync((char*)d_ws + OFF_BAR, 0, XCD_BAR_WORDS * 4, stream);
  void* args[] = {&p};
  hipError_t e = hipLaunchCooperativeKernel((void*)mega_kernel, dim3(grid_blocks), dim3(256), args, SMEM_BYTES, stream);
  if (e != hipSuccess) fprintf(stderr, "coop launch failed: %s\n", hipGetErrorString(e));
#else
  const int G = grid_blocks;
  phase_kernel<<<G, 256, SMEM_BYTES, stream>>>(p, PH_SETUP, 0);
  for (int l = 0; l < DEPTH; ++l)
    for (int ph = PH_NORM1; ph <= PH_FFN2; ++ph) phase_kernel<<<G, 256, SMEM_BYTES, stream>>>(p, ph, l);
  phase_kernel<<<G, 256, SMEM_BYTES, stream>>>(p, PH_FINAL, 0);
#endif
}
```

```cpp
#include <hip/hip_runtime.h>
#include <hip/hip_cooperative_groups.h>
#include <cstdio>
#include <cstdint>
namespace cg = cooperative_groups;

#ifndef MEGA
#define MEGA 1
#endif

typedef unsigned short bf16_t;
typedef short bf16x8 __attribute__((ext_vector_type(8)));
typedef float f32x4 __attribute__((ext_vector_type(4)));
typedef unsigned u32x4 __attribute__((ext_vector_type(4)));
typedef short s16x4 __attribute__((ext_vector_type(4)));
typedef unsigned u32x2 __attribute__((ext_vector_type(2)));

constexpr int D = 1024, T = 16384, TCTX = 8192, DEPTH = 4;
constexpr int NPROJ = 13376, NPROJ_PAD = 13440;
constexpr int FFN = 2816;
constexpr int C_Z = 4096, C_DT = 6144, C_HQ = 6208, C_HF = 7232, C_HI = 9280, C_HG = 10304, C_GATE = 11328;
constexpr size_t WT_IN = 0;
constexpr size_t WT_SSO = WT_IN + (size_t)NPROJ_PAD * 1024;
constexpr size_t WT_HGO = WT_SSO + (size_t)1024 * 2048;
constexpr size_t WT_OUT = WT_HGO + (size_t)1024 * 1024;
constexpr size_t WT_W13 = WT_OUT + (size_t)1024 * 1024;
constexpr size_t WT_W2 = WT_W13 + (size_t)5632 * 1024;
constexpr size_t WT_LAYER = WT_W2 + (size_t)1024 * 2816;
constexpr size_t OFF_WT = 0;
constexpr size_t OFF_H = OFF_WT + WT_LAYER * 2 * DEPTH;
constexpr size_t OFF_PROJ = OFF_H + (size_t)T * 1024 * 2;
constexpr size_t OFF_XC = OFF_PROJ + (size_t)T * NPROJ_PAD * 2;
constexpr size_t OFF_DTRAW = OFF_XC + (size_t)T * 4096 * 2;
constexpr size_t OFF_DT = OFF_DTRAW + (size_t)T * 64 * 4;
constexpr size_t OFF_YF = OFF_DT + (size_t)T * 64 * 4;
constexpr size_t OFF_YB = OFF_YF + (size_t)T * 2048 * 4;
constexpr size_t OFF_OF = OFF_YB + (size_t)T * 2048 * 4;
constexpr size_t OFF_OB = OFF_OF + (size_t)T * 1024 * 4;
constexpr size_t OFF_YBUF = OFF_OB + (size_t)T * 1024 * 4;
constexpr size_t OFF_OBUF = OFF_YBUF + (size_t)T * 2048 * 2;
constexpr size_t OFF_MBUF = OFF_OBUF + (size_t)T * 1024 * 2;
constexpr size_t OFF_MOD = OFF_MBUF + (size_t)T * 1024 * 2;
constexpr size_t OFF_LB = OFF_MOD + (size_t)DEPTH * 5 * 6144 * 4;
constexpr size_t OFF_BAR = OFF_LB + (size_t)DEPTH * 2 * 1024 * 4;
constexpr size_t OFF_END = OFF_BAR + 16384;
constexpr size_t OUT_SSM = (size_t)T * 1024;
constexpr size_t OUT_HGRN = OUT_SSM + (size_t)32 * 4 * 2 * 32 * 64 * 128;

constexpr int SMEM_BYTES = 73728;
constexpr int LDS_ROW = 128;
constexpr int LDS_TILE = 128 * LDS_ROW;

struct Params {
  const float *x_prompt, *x_sample, *c, *state_ssm, *state_hgrn, *c_ctx, *norm_mix_w, *norm_ffn_w, *ada_w, *ada_b, *w_in,
      *ssd_conv_w, *ssd_conv_b, *ssd_dt_bias, *ssd_a_log, *ssd_d, *ssd_norm_w, *hgrn_lb, *hgrn_norm_w, *w_ssd_out, *w_hgrn_out,
      *w_out, *ffn_w1, *ffn_w3, *ffn_w2, *norm_final_w;
  float* out;
  char* ws;
};

__device__ __forceinline__ bf16_t f2bf(float f) {
  unsigned u = __float_as_uint(f);
  u += 0x7fffu + ((u >> 16) & 1u);
  return (bf16_t)(u >> 16);
}
__device__ __forceinline__ float bf2f(bf16_t b) { return __uint_as_float(((unsigned)b) << 16); }
typedef __bf16 bf16x2_t __attribute__((ext_vector_type(2)));
__device__ __forceinline__ unsigned pack2(float a, float b) { bf16x2_t v = {(__bf16)a, (__bf16)b}; return __builtin_bit_cast(unsigned, v); }
__device__ __forceinline__ float sigmoidf_(float x) { return 1.0f / (1.0f + __expf(-x)); }
__device__ __forceinline__ float siluf_(float x) { return x / (1.0f + __expf(-x)); }
__device__ __forceinline__ int tid_opaque() { int t = threadIdx.x; asm volatile("" : "+v"(t)); return t; }
__device__ __forceinline__ float clamp30(float x) { return fminf(fmaxf(x, -30.f), 30.f); }
__device__ __forceinline__ float gate_ratio(float g1, float g2) { return (1.0f + __expf(-clamp30(g2))) / (1.0f + __expf(-clamp30(g1))); }
__device__ __forceinline__ int mod_row(int tok) { return tok < TCTX ? 0 : 1 + ((tok - TCTX) >> 11); }

__device__ __forceinline__ void phase_setup(const Params& p, char* smem) {
  const int tid = tid_opaque(), bid = blockIdx.x, G = gridDim.x;
  {
    const size_t n4 = (size_t)T * 1024 / 4, half4 = (size_t)TCTX * 1024 / 4;
    float4* dst = (float4*)p.out;
    const float4* s0 = (const float4*)p.x_prompt;
    const float4* s1 = (const float4*)p.x_sample;
    for (size_t i = (size_t)bid * 256 + tid; i < n4; i += (size_t)G * 256) dst[i] = i < half4 ? s0[i] : s1[i - half4];
  }
  {
    float* lb = (float*)(p.ws + OFF_LB);
    for (int i = bid * 256 + tid; i < 2048; i += G * 256) {
      float v0 = p.hgrn_lb[i], v1 = p.hgrn_lb[2048 + i], v2 = p.hgrn_lb[4096 + i], v3 = p.hgrn_lb[6144 + i];
      float m = fmaxf(fmaxf(v0, v1), fmaxf(v2, v3));
      float e0 = expf(v0 - m), e1 = expf(v1 - m), e2 = expf(v2 - m), e3 = expf(v3 - m);
      float inv = 1.0f / (e0 + e1 + e2 + e3);
      lb[i] = 0.f;
      lb[2048 + i] = e1 * inv;
      lb[4096 + i] = (e1 + e2) * inv;
      lb[6144 + i] = (e1 + e2 + e3) * inv;
    }
  }
  {
    float* sm = (float*)smem;
    float* modb = (float*)(p.ws + OFF_MOD);
    __syncthreads();
    for (int i = tid; i < 5 * 1024; i += 256) {
      int v = i >> 10, k = i & 1023;
      float cv = v == 0 ? p.c_ctx[k] : p.c[(v - 1) * 1024 + k];
      sm[i] = siluf_(cv);
    }
    __syncthreads();
    float* part = sm + 5 * 1024;
    for (int item = bid; item < DEPTH * 96; item += G) {
      int l = item / 96, cg_ = item % 96;
      int col = cg_ * 64 + (tid & 63), kg = tid >> 6;
      const float* w = p.ada_w + (size_t)l * 1024 * 6144 + col;
      float a0 = 0, a1 = 0, a2 = 0, a3 = 0, a4 = 0;
      for (int k = kg * 256; k < kg * 256 + 256; ++k) {
        float wv = w[(size_t)k * 6144];
        a0 += sm[k] * wv; a1 += sm[1024 + k] * wv; a2 += sm[2048 + k] * wv; a3 += sm[3072 + k] * wv; a4 += sm[4096 + k] * wv;
      }
      __syncthreads();
      part[(kg * 5 + 0) * 64 + (tid & 63)] = a0; part[(kg * 5 + 1) * 64 + (tid & 63)] = a1; part[(kg * 5 + 2) * 64 + (tid & 63)] = a2;
      part[(kg * 5 + 3) * 64 + (tid & 63)] = a3; part[(kg * 5 + 4) * 64 + (tid & 63)] = a4;
      __syncthreads();
      for (int i = tid; i < 320; i += 256) {
        int v = i >> 6, cc = i & 63;
        float s = part[(0 * 5 + v) * 64 + cc] + part[(1 * 5 + v) * 64 + cc] + part[(2 * 5 + v) * 64 + cc] + part[(3 * 5 + v) * 64 + cc];
        int colo = cg_ * 64 + cc;
        modb[((size_t)l * 5 + v) * 6144 + colo] = s + p.ada_b[l * 6144 + colo];
      }
    }
    __syncthreads();
  }
  {
    float* tile = (float*)smem;
    const int n_in = 210 * 16, n_sso = 16 * 32, n_hgo = 16 * 16, n_out = 16 * 16, n_w13 = 88 * 16, n_w2 = 16 * 44;
    const int per_layer = n_in + n_sso + n_hgo + n_out + n_w13 + n_w2;
    for (int it = bid; it < per_layer * DEPTH; it += G) {
      int l = it / per_layer, r = it % per_layer;
      bf16_t* wt = (bf16_t*)(p.ws + OFF_WT) + (size_t)l * WT_LAYER;
      const float *src0 = nullptr, *src1 = nullptr;
      int K, Nsrc, nt, kt;
      bf16_t* dst;
      bool zero = false;
      if (r < n_in) {
        nt = r / 16; kt = r % 16; K = 1024; Nsrc = NPROJ;
        dst = wt + WT_IN;
        if (nt >= 209) zero = true;
        src0 = p.w_in + (size_t)l * 1024 * NPROJ + nt * 64; src1 = src0 + 32;
      } else if ((r -= n_in) < n_sso) {
        nt = r / 32; kt = r % 32; K = 2048; Nsrc = 1024; dst = wt + WT_SSO;
        src0 = p.w_ssd_out + (size_t)l * 2048 * 1024 + nt * 64; src1 = src0 + 32;
      } else if ((r -= n_sso) < n_hgo) {
        nt = r / 16; kt = r % 16; K = 1024; Nsrc = 1024; dst = wt + WT_HGO;
        src0 = p.w_hgrn_out + (size_t)l * 1024 * 1024 + nt * 64; src1 = src0 + 32;
      } else if ((r -= n_hgo) < n_out) {
        nt = r / 16; kt = r % 16; K = 1024; Nsrc = 1024; dst = wt + WT_OUT;
        src0 = p.w_out + (size_t)l * 1024 * 1024 + nt * 64; src1 = src0 + 32;
      } else if ((r -= n_out) < n_w13) {
        nt = r / 16; kt = r % 16; K = 1024; Nsrc = FFN; dst = wt + WT_W13;
        src0 = p.ffn_w1 + (size_t)l * 1024 * FFN + nt * 32; src1 = p.ffn_w3 + (size_t)l * 1024 * FFN + nt * 32;
      } else {
        r -= n_w13;
        nt = r / 44; kt = r % 44; K = 2816; Nsrc = 1024; dst = wt + WT_W2;
        src0 = p.ffn_w2 + (size_t)l * 2816 * 1024 + nt * 64; src1 = src0 + 32;
      }
      __syncthreads();
      {
        int c4 = (tid & 15) * 4;
        const float* s = c4 < 32 ? src0 + c4 : src1 + (c4 - 32);
#pragma unroll
        for (int i = 0; i < 4; ++i) {
          int kr = (tid >> 4) + i * 16;
          float4 v = zero ? make_float4(0.f, 0.f, 0.f, 0.f) : *(const float4*)(s + (size_t)(kt * 64 + kr) * Nsrc);
          tile[kr * 65 + c4 + 0] = v.x; tile[kr * 65 + c4 + 1] = v.y; tile[kr * 65 + c4 + 2] = v.z; tile[kr * 65 + c4 + 3] = v.w;
        }
      }
      __syncthreads();
#pragma unroll
      for (int i = 0; i < 2; ++i) {
        int cidx = tid + i * 256, n = cidx >> 3, kc = cidx & 7;
        uint4 o;
        o.x = pack2(tile[(kc * 8 + 0) * 65 + n], tile[(kc * 8 + 1) * 65 + n]);
        o.y = pack2(tile[(kc * 8 + 2) * 65 + n], tile[(kc * 8 + 3) * 65 + n]);
        o.z = pack2(tile[(kc * 8 + 4) * 65 + n], tile[(kc * 8 + 5) * 65 + n]);
        o.w = pack2(tile[(kc * 8 + 6) * 65 + n], tile[(kc * 8 + 7) * 65 + n]);
        *(uint4*)(dst + (size_t)(nt * 64 + n) * K + kt * 64 + kc * 8) = o;
      }
    }
    __syncthreads();
  }
}

__device__ __forceinline__ void phase_norm(const Params& p, int l, int which) {
  const int lane = tid_opaque() & 63, wv = tid_opaque() >> 6;
  const float* nw = (which == 0 ? p.norm_mix_w : p.norm_ffn_w) + l * 1024;
  const float* modb = (const float*)(p.ws + OFF_MOD) + (size_t)l * 5 * 6144;
  bf16_t* h = (bf16_t*)(p.ws + OFF_H);
  for (int row = blockIdx.x * 4 + wv; row < T; row += gridDim.x * 4) {
    const float* x = p.out + (size_t)row * 1024;
    const float* md = modb + (size_t)mod_row(row) * 6144 + (which == 0 ? 0 : 3072);
    float4 v[4];
    float ss = 0.f;
#pragma unroll
    for (int i = 0; i < 4; ++i) {
      v[i] = *(const float4*)(x + i * 256 + lane * 4);
      ss += v[i].x * v[i].x + v[i].y * v[i].y + v[i].z * v[i].z + v[i].w * v[i].w;
    }
#pragma unroll
    for (int o = 32; o >= 1; o >>= 1) ss += __shfl_xor(ss, o);
    float rstd = rsqrtf(ss * (1.0f / 1024.f) + 1e-6f);
#pragma unroll
    for (int i = 0; i < 4; ++i) {
      int c = i * 256 + lane * 4;
      float4 w = *(const float4*)(nw + c), sh = *(const float4*)(md + c), sc = *(const float4*)(md + 1024 + c);
      float a0 = v[i].x * rstd * w.x * (1.f + sc.x) + sh.x, a1 = v[i].y * rstd * w.y * (1.f + sc.y) + sh.y;
      float a2 = v[i].z * rstd * w.z * (1.f + sc.z) + sh.z, a3 = v[i].w * rstd * w.w * (1.f + sc.w) + sh.w;
      uint2 o2; o2.x = pack2(a0, a1); o2.y = pack2(a2, a3);
      *(uint2*)(h + (size_t)row * 1024 + c) = o2;
    }
  }
}

__device__ __forceinline__ void phase_final_norm(const Params& p) {
  const int lane = tid_opaque() & 63, wv = tid_opaque() >> 6;
  for (int row = blockIdx.x * 4 + wv; row < T; row += gridDim.x * 4) {
    float* x = p.out + (size_t)row * 1024;
    float4 v[4];
    float ss = 0.f;
#pragma unroll
    for (int i = 0; i < 4; ++i) {
      v[i] = *(const float4*)(x + i * 256 + lane * 4);
      ss += v[i].x * v[i].x + v[i].y * v[i].y + v[i].z * v[i].z + v[i].w * v[i].w;
    }
#pragma unroll
    for (int o = 32; o >= 1; o >>= 1) ss += __shfl_xor(ss, o);
    float rstd = rsqrtf(ss * (1.0f / 1024.f) + 1e-6f);
#pragma unroll
    for (int i = 0; i < 4; ++i) {
      int c = i * 256 + lane * 4;
      float4 w = *(const float4*)(p.norm_final_w + c);
      float4 o4 = make_float4(v[i].x * rstd * w.x, v[i].y * rstd * w.y, v[i].z * rstd * w.z, v[i].w * rstd * w.w);
      *(float4*)(x + c) = o4;
    }
  }
}

template <bool HASMID>
__device__ __forceinline__ void gemm_kloop2(f32x4 (&acc)[4][4], const bf16_t* __restrict__ Ag, int lda, const bf16_t* __restrict__ Bg,
                                            int ldb, int K, const bf16_t* __restrict__ Ag2, int lda2, const bf16_t* __restrict__ Bg2,
                                            int ldb2, int K2, char* smem, const bf16_t* __restrict__ gate0) {
  const int tid = tid_opaque(), lane = tid & 63, wid = tid >> 6;
  const int wr = wid >> 1, wc = wid & 1, fr = lane & 15, fq = lane >> 4;
  const int srow = tid >> 3, schunk = (tid & 7) ^ ((tid >> 4) & 7);
  const int rofs0 = (fq ^ ((fr >> 1) & 7)) * 16;
  const bf16_t* ap = Ag + (size_t)srow * lda + schunk * 8;
  const bf16_t* bp = Bg + (size_t)srow * ldb + schunk * 8;
  const int nk1 = K >> 6;
  const int nk = nk1 + (K2 >> 6);
  char* const sdst = smem + tid * 16;
#define GK_DMA(buf, t)                                                                                                   \
  {                                                                                                                      \
    _Pragma("unroll") for (int i = 0; i < 4; ++i) {                                                                      \
      __builtin_amdgcn_global_load_lds((const unsigned*)(ap + (size_t)i * 32 * lda + (size_t)(t) * 64),                  \
                                       (unsigned*)(sdst + (buf) * LDS_TILE + i * 4096), 16, 0, 0);                       \
      __builtin_amdgcn_global_load_lds((const unsigned*)(bp + (size_t)i * 32 * ldb + (size_t)(t) * 64),                  \
                                       (unsigned*)(sdst + (2 + (buf)) * LDS_TILE + i * 4096), 16, 0, 0);                 \
    }                                                                                                                    \
  }
  GK_DMA(0, 0);
  __syncthreads();
  for (int kt = 0; kt < nk; ++kt) {
    const int cur = kt & 1;
    if (kt + 1 < nk) {
      if (kt + 1 == nk1) {
        ap = Ag2 + (size_t)srow * lda2 + schunk * 8 - (size_t)nk1 * 64;
        bp = Bg2 + (size_t)srow * ldb2 + schunk * 8 - (size_t)nk1 * 64;
        lda = lda2; ldb = ldb2;
      }
      GK_DMA(cur ^ 1, kt + 1);
    }
    if (HASMID && kt == nk1) {
#pragma unroll
      for (int m = 0; m < 4; ++m)
#pragma unroll
        for (int n = 0; n < 4; ++n) {
          uint2 g1 = *(const uint2*)(gate0 + (size_t)(m * 16) * NPROJ_PAD + n * 16);
          uint2 g2 = *(const uint2*)(gate0 + (size_t)(m * 16) * NPROJ_PAD + 1024 + n * 16);
          acc[m][n][0] *= gate_ratio(bf2f((bf16_t)(g1.x & 0xffff)), bf2f((bf16_t)(g2.x & 0xffff)));
          acc[m][n][1] *= gate_ratio(bf2f((bf16_t)(g1.x >> 16)), bf2f((bf16_t)(g2.x >> 16)));
          acc[m][n][2] *= gate_ratio(bf2f((bf16_t)(g1.y & 0xffff)), bf2f((bf16_t)(g2.y & 0xffff)));
          acc[m][n][3] *= gate_ratio(bf2f((bf16_t)(g1.y >> 16)), bf2f((bf16_t)(g2.y >> 16)));
        }
    }
    const char* sa = smem + cur * LDS_TILE + (wr * 64 + fr) * LDS_ROW;
    const char* sb = smem + (2 + cur) * LDS_TILE + (wc * 64 + fr) * LDS_ROW;
#pragma unroll
    for (int kk = 0; kk < 2; ++kk) {
      bf16x8 af[4], bfv[4];
      __builtin_amdgcn_sched_barrier(0);
#pragma unroll
      for (int m = 0; m < 4; ++m) af[m] = *(const bf16x8*)(sa + m * 16 * LDS_ROW + (rofs0 ^ (kk * 64)));
#pragma unroll
      for (int n = 0; n < 4; ++n) bfv[n] = *(const bf16x8*)(sb + n * 16 * LDS_ROW + (rofs0 ^ (kk * 64)));
      __builtin_amdgcn_sched_barrier(0);
#pragma unroll
      for (int m = 0; m < 4; ++m)
#pragma unroll
        for (int n = 0; n < 4; ++n) acc[m][n] = __builtin_amdgcn_mfma_f32_16x16x32_bf16(bfv[n], af[m], acc[m][n], 0, 0, 0);
    }
    __builtin_amdgcn_sched_barrier(0);
    __syncthreads();
  }
#undef GK_DMA
}

__device__ __forceinline__ void gemm_kloop(f32x4 (&acc)[4][4], const bf16_t* __restrict__ Ag, int lda, const bf16_t* __restrict__ Bg,
                                           int ldb, int K, char* smem) {
  gemm_kloop2<false>(acc, Ag, lda, Bg, ldb, K, Ag, lda, Bg, ldb, 0, smem, Ag);
}
enum { G_PROJ = 0, G_MERGE = 1, G_OUT = 2, G_FFN1 = 3, G_FFN2 = 4 };

template <int MODE>
__device__ __forceinline__ void phase_gemm(const Params& p, int l, char* smem) {
  const int tid = tid_opaque(), lane = tid & 63, wid = tid >> 6;
  const int wr = wid >> 1, wc = wid & 1, fr = lane & 15, fq = lane >> 4;
  const bf16_t* wt = (const bf16_t*)(p.ws + OFF_WT) + (size_t)l * WT_LAYER;
  const bf16_t* hbuf = (const bf16_t*)(p.ws + OFF_H);
  bf16_t* proj = (bf16_t*)(p.ws + OFF_PROJ);
  bf16_t* hidden = (bf16_t*)(p.ws + OFF_PROJ);
  const float* modb = (const float*)(p.ws + OFF_MOD) + (size_t)l * 5 * 6144;
  constexpr int nM = T / 128;
  constexpr int nN = MODE == G_PROJ ? NPROJ_PAD / 128 : (MODE == G_FFN1 ? 5632 / 128 : 1024 / 128);
  for (int t = blockIdx.x; t < nM * nN; t += gridDim.x) {
    const int pm = t % nM, pn = t / nM;
    const int row0 = pm * 128, col0 = pn * 128;
    f32x4 acc[4][4];
#pragma unroll
    for (int m = 0; m < 4; ++m)
#pragma unroll
      for (int n = 0; n < 4; ++n) acc[m][n] = (f32x4){0.f, 0.f, 0.f, 0.f};
    if (MODE == G_PROJ) {
      gemm_kloop(acc, hbuf + (size_t)row0 * 1024, 1024, wt + WT_IN + (size_t)col0 * 1024, 1024, 1024, smem);
      float* dtraw = (float*)(p.ws + OFF_DTRAW);
#pragma unroll
      for (int m = 0; m < 4; ++m) {
        const int row = row0 + wr * 64 + m * 16 + fr;
#pragma unroll
        for (int n = 0; n < 4; ++n) {
          const int col = col0 + wc * 64 + n * 16 + fq * 4;
          uint2 o; o.x = pack2(acc[m][n][0], acc[m][n][1]); o.y = pack2(acc[m][n][2], acc[m][n][3]);
          *(uint2*)(proj + (size_t)row * NPROJ_PAD + col) = o;
          if (col >= C_DT && col < C_DT + 64) *(f32x4*)(dtraw + (size_t)row * 64 + (col - C_DT)) = acc[m][n];
        }
      }
    } else if (MODE == G_MERGE) {
      const bf16_t* ybuf = (const bf16_t*)(p.ws + OFF_YBUF);
      const bf16_t* obuf = (const bf16_t*)(p.ws + OFF_OBUF);
      bf16_t* mbuf = (bf16_t*)(p.ws + OFF_MBUF);
      gemm_kloop2<true>(acc, ybuf + (size_t)row0 * 2048, 2048, wt + WT_SSO + (size_t)col0 * 2048, 2048, 2048,
                        obuf + (size_t)row0 * 1024, 1024, wt + WT_HGO + (size_t)col0 * 1024, 1024, 1024, smem,
                        proj + (size_t)(row0 + wr * 64 + fr) * NPROJ_PAD + C_GATE + col0 + wc * 64 + fq * 4);
#pragma unroll
      for (int m = 0; m < 4; ++m) {
        const int row = row0 + wr * 64 + m * 16 + fr;
#pragma unroll
        for (int n = 0; n < 4; ++n) {
          const int col = col0 + wc * 64 + n * 16 + fq * 4;
          uint2 g = *(const uint2*)(proj + (size_t)row * NPROJ_PAD + C_GATE + 1024 + col);
          float r0 = acc[m][n][0] * sigmoidf_(clamp30(bf2f((bf16_t)(g.x & 0xffff))));
          float r1 = acc[m][n][1] * sigmoidf_(clamp30(bf2f((bf16_t)(g.x >> 16))));
          float r2 = acc[m][n][2] * sigmoidf_(clamp30(bf2f((bf16_t)(g.y & 0xffff))));
          float r3 = acc[m][n][3] * sigmoidf_(clamp30(bf2f((bf16_t)(g.y >> 16))));
          uint2 o; o.x = pack2(r0, r1); o.y = pack2(r2, r3);
          *(uint2*)(mbuf + (size_t)row * 1024 + col) = o;
        }
      }
    } else if (MODE == G_OUT || MODE == G_FFN2) {
      if (MODE == G_OUT) {
        const bf16_t* mbuf = (const bf16_t*)(p.ws + OFF_MBUF);
        gemm_kloop(acc, mbuf + (size_t)row0 * 1024, 1024, wt + WT_OUT + (size_t)col0 * 1024, 1024, 1024, smem);
      } else {
        gemm_kloop(acc, hidden + (size_t)row0 * FFN, FFN, wt + WT_W2 + (size_t)col0 * FFN, FFN, FFN, smem);
      }
      const float* gate = modb + (size_t)mod_row(row0) * 6144 + (MODE == G_OUT ? 2048 : 5120);
#pragma unroll
      for (int m = 0; m < 4; ++m) {
        const int row = row0 + wr * 64 + m * 16 + fr;
#pragma unroll
        for (int n = 0; n < 4; ++n) {
          const int col = col0 + wc * 64 + n * 16 + fq * 4;
          f32x4 g = *(const f32x4*)(gate + col);
          f32x4* xp = (f32x4*)(p.out + (size_t)row * 1024 + col);
          f32x4 xv = *xp;
          xv += g * acc[m][n];
          *xp = xv;
        }
      }
    } else {
      gemm_kloop(acc, hbuf + (size_t)row0 * 1024, 1024, wt + WT_W13 + (size_t)col0 * 1024, 1024, 1024, smem);
#pragma unroll
      for (int m = 0; m < 4; ++m) {
        const int row = row0 + wr * 64 + m * 16 + fr;
#pragma unroll
        for (int n = 0; n < 2; ++n) {
          const int hcol = (pn * 2 + wc) * 32 + n * 16 + fq * 4;
          float r[4];
#pragma unroll
          for (int j = 0; j < 4; ++j) r[j] = siluf_(acc[m][n][j]) * acc[m][n + 2][j];
          uint2 o; o.x = pack2(r[0], r[1]); o.y = pack2(r[2], r[3]);
          *(uint2*)(hidden + (size_t)row * FFN + hcol) = o;
        }
      }
    }
  }
}

__device__ __forceinline__ void phase_conv(const Params& p, int l) {
  const bf16_t* proj = (const bf16_t*)(p.ws + OFF_PROJ);
  bf16_t* xc = (bf16_t*)(p.ws + OFF_XC);
  const float* cw = p.ssd_conv_w + (size_t)l * 5 * 4096;
  const float* cb = p.ssd_conv_b + (size_t)l * 4096;
  const size_t total = (size_t)T * 512;
  for (size_t i = (size_t)blockIdx.x * 256 + tid_opaque(); i < total; i += (size_t)gridDim.x * 256) {
    const int tok = (int)(i >> 9), ch = (int)(i & 511) * 8;
    int pos, len;
    if (tok < TCTX) { pos = tok & 255; len = 256; } else { pos = (tok - TCTX) & 63; len = 64; }
    float a[8];
#pragma unroll
    for (int j = 0; j < 8; ++j) a[j] = cb[ch + j];
#pragma unroll
    for (int k = 0; k < 5; ++k) {
      const int q = pos + k - 2;
      if (q >= 0 && q < len) {
        uint4 v = *(const uint4*)(proj + (size_t)(tok + k - 2) * NPROJ_PAD + ch);
        const float* w = cw + k * 4096 + ch;
        a[0] += w[0] * bf2f((bf16_t)(v.x & 0xffff)); a[1] += w[1] * bf2f((bf16_t)(v.x >> 16));
        a[2] += w[2] * bf2f((bf16_t)(v.y & 0xffff)); a[3] += w[3] * bf2f((bf16_t)(v.y >> 16));
        a[4] += w[4] * bf2f((bf16_t)(v.z & 0xffff)); a[5] += w[5] * bf2f((bf16_t)(v.z >> 16));
        a[6] += w[6] * bf2f((bf16_t)(v.w & 0xffff)); a[7] += w[7] * bf2f((bf16_t)(v.w >> 16));
      }
    }
    uint4 o;
    o.x = pack2(siluf_(a[0]), siluf_(a[1])); o.y = pack2(siluf_(a[2]), siluf_(a[3]));
    o.z = pack2(siluf_(a[4]), siluf_(a[5])); o.w = pack2(siluf_(a[6]), siluf_(a[7]));
    *(uint4*)(xc + (size_t)tok * 4096 + ch) = o;
  }
  const float* dtraw = (const float*)(p.ws + OFF_DTRAW);
  float* dt = (float*)(p.ws + OFF_DT);
  for (size_t i = (size_t)blockIdx.x * 256 + tid_opaque(); i < (size_t)T * 64; i += (size_t)gridDim.x * 256) {
    float v = dtraw[i] + p.ssd_dt_bias[l * 64 + (int)(i & 63)];
    dt[i] = v > 20.f ? v : log1pf(expf(v));
  }
}

__device__ __forceinline__ void ssd_naive_item(const Params& p, int l, int item, float* sm) {
  const int d = item & 1, h = (item >> 1) & 31, s = item >> 6;
  int tok0, L;
  if (s < 32) { tok0 = s * 256; L = 256; } else { tok0 = TCTX + (s - 32) * 2048; L = 2048; }
  const int tid = tid_opaque(), pp = tid >> 2, nq = tid & 3, g = h >> 2;
  float S[32];
  if (s < 32) {
#pragma unroll
    for (int i = 0; i < 32; ++i) S[i] = 0.f;
  } else {
    const float* st = p.state_ssm + ((((size_t)(s - 32) * 4 + l) * 2 + d) * 32 + h) * 8192 + pp * 128 + nq * 32;
#pragma unroll
    for (int i = 0; i < 32; ++i) S[i] = st[i];
  }
  const float a = -expf(p.ssd_a_log[l * 64 + d * 32 + h]);
  float* xs = sm; float* Bs = sm + 1024; float* Cs = Bs + 2048; float* dts = Cs + 2048;
  const bf16_t* xc = (const bf16_t*)(p.ws + OFF_XC);
  const float* dtb = (const float*)(p.ws + OFF_DT);
  float* ydir = (float*)(p.ws + (d == 0 ? OFF_YF : OFF_YB));
  for (int bt = 0; bt < L / 16; ++bt) {
    const int tb = d == 0 ? bt * 16 : L - 16 - bt * 16;
    __syncthreads();
    for (int e = tid; e < 16 * 320; e += 256) {
      const int tt = e / 320, c = e % 320;
      const size_t base = (size_t)(tok0 + tb + tt) * 4096;
      if (c < 64) xs[tt * 64 + c] = bf2f(xc[base + h * 64 + c]);
      else if (c < 192) Bs[tt * 128 + c - 64] = bf2f(xc[base + 2048 + g * 128 + c - 64]);
      else Cs[tt * 128 + c - 192] = bf2f(xc[base + 3072 + g * 128 + c - 192]);
    }
    if (tid < 16) dts[tid] = dtb[(size_t)(tok0 + tb + tid) * 64 + d * 32 + h];
    __syncthreads();
    for (int i2 = 0; i2 < 16; ++i2) {
      const int tt = d == 0 ? i2 : 15 - i2;
      const float dt = dts[tt], dA = expf(dt * a), xdt = xs[tt * 64 + pp] * dt;
      float acc = 0.f;
      const float* Bp = Bs + tt * 128 + nq * 32;
      const float* Cp = Cs + tt * 128 + nq * 32;
#pragma unroll
      for (int i = 0; i < 32; ++i) { S[i] = dA * S[i] + xdt * Bp[i]; acc += S[i] * Cp[i]; }
      acc += __shfl_xor(acc, 1); acc += __shfl_xor(acc, 2);
      if (nq == 0) ydir[(size_t)(tok0 + tb + tt) * 2048 + h * 64 + pp] = acc;
    }
  }
  if (s < 32) {
    float* o = p.out + OUT_SSM + ((((size_t)s * 4 + l) * 2 + d) * 32 + h) * 8192 + pp * 128 + nq * 32;
#pragma unroll
    for (int i = 0; i < 32; ++i) o[i] = S[i];
  }
}

__device__ __forceinline__ void hgrn_naive_item(const Params& p, int l, int item, float* sm) {
  const int d = item & 1, hd = (item >> 1) & 7, s = item >> 4;
  int tok0, L;
  if (s < 32) { tok0 = s * 256; L = 256; } else { tok0 = TCTX + (s - 32) * 2048; L = 2048; }
  const int tid = tid_opaque(), vv = tid >> 1, kh = tid & 1;
  float S[64];
  if (s < 32) {
#pragma unroll
    for (int i = 0; i < 64; ++i) S[i] = 0.f;
  } else {
    const float* st = p.state_hgrn + ((((size_t)(s - 32) * 4 + l) * 2 + d) * 8 + hd) * 16384 + (size_t)(kh * 64) * 128 + vv;
#pragma unroll
    for (int i = 0; i < 64; ++i) S[i] = st[(size_t)i * 128];
  }
  float* qs = sm; float* fs = sm + 2048; float* ks = sm + 4096; float* vs = sm + 6144;
  const bf16_t* proj = (const bf16_t*)(p.ws + OFF_PROJ);
  const float* lb = (const float*)(p.ws + OFF_LB) + (size_t)l * 2048 + d * 1024 + hd * 128;
  float* odir = (float*)(p.ws + (d == 0 ? OFF_OF : OFF_OB));
  for (int bt = 0; bt < L / 16; ++bt) {
    const int tb = d == 0 ? bt * 16 : L - 16 - bt * 16;
    __syncthreads();
    for (int e = tid; e < 16 * 128; e += 256) {
      const int tt = e >> 7, c = e & 127;
      const size_t base = (size_t)(tok0 + tb + tt) * NPROJ_PAD;
      const float q = bf2f(proj[base + C_HQ + hd * 128 + c]);
      const float u = bf2f(proj[base + C_HF + d * 1024 + hd * 128 + c]);
      const float lbv = lb[c];
      const float sg = sigmoidf_(u);
      qs[e] = siluf_(q);
      fs[e] = lbv + (1.f - lbv) * sg;
      ks[e] = (1.f - lbv) * (1.f - sg);
      vs[e] = bf2f(proj[base + C_HI + hd * 128 + c]);
    }
    __syncthreads();
    for (int i2 = 0; i2 < 16; ++i2) {
      const int tt = d == 0 ? i2 : 15 - i2;
      const float vval = vs[tt * 128 + vv];
      const float* fp = fs + tt * 128 + kh * 64;
      const float* kp = ks + tt * 128 + kh * 64;
      const float* qp = qs + tt * 128 + kh * 64;
      float acc = 0.f;
#pragma unroll
      for (int i = 0; i < 64; ++i) { S[i] = fp[i] * S[i] + kp[i] * vval; acc += S[i] * qp[i]; }
      acc += __shfl_xor(acc, 1);
      if (kh == 0) odir[(size_t)(tok0 + tb + tt) * 1024 + hd * 128 + vv] = acc;
    }
  }
  if (s < 32) {
    float* o = p.out + OUT_HGRN + ((((size_t)s * 4 + l) * 2 + d) * 8 + hd) * 16384 + (size_t)(kh * 64) * 128 + vv;
#pragma unroll
    for (int i = 0; i < 64; ++i) o[(size_t)i * 128] = S[i];
  }
}


constexpr int HG_ROW = 272;
constexpr int HG_IMG = 16 * HG_ROW;
constexpr int HG_BUF = 4 * HG_IMG + 512;
__device__ __forceinline__ void hgrn_chunk_item(const Params& p, int l, int item, char* smem) {
  const int d = item & 1, hd = (item >> 1) & 7, s = item >> 4;
  int tok0, L;
  if (s < 32) { tok0 = s * 256; L = 256; } else { tok0 = TCTX + (s - 32) * 2048; L = 2048; }
  const int tid = tid_opaque(), lane = tid & 63, w = tid >> 6, fr = lane & 15, fq = lane >> 4;
  const int ch = tid & 127, half = tid >> 7;
  f32x4 S[8][2];
  if (s < 32) {
#pragma unroll
    for (int kt = 0; kt < 8; ++kt) { S[kt][0] = (f32x4){0.f, 0.f, 0.f, 0.f}; S[kt][1] = (f32x4){0.f, 0.f, 0.f, 0.f}; }
  } else {
    const float* st = p.state_hgrn + ((((size_t)(s - 32) * 4 + l) * 2 + d) * 8 + hd) * 16384;
#pragma unroll
    for (int kt = 0; kt < 8; ++kt)
#pragma unroll
      for (int vt = 0; vt < 2; ++vt)
#pragma unroll
        for (int jj = 0; jj < 4; ++jj) S[kt][vt][jj] = st[(size_t)(16 * kt + fq * 4 + jj) * 128 + 32 * w + 16 * vt + fr];
  }
  const float lbv = ((const float*)(p.ws + OFF_LB))[(size_t)l * 2048 + d * 1024 + hd * 128 + ch];
  const bf16_t* proj = (const bf16_t*)(p.ws + OFF_PROJ);
  float* odir = (float*)(p.ws + (d == 0 ? OFF_OF : OFF_OB));
  float* xch = (float*)(smem + 2 * HG_BUF);
  const int nch = L >> 4;
  bf16_t rq[8], ru[8], rv[8];
  __syncthreads();
  {
#pragma unroll
    for (int i = 0; i < 8; ++i) {
      const int pos = 8 * half + i;
      const size_t tk = (size_t)(d == 0 ? tok0 + pos : tok0 + L - 1 - pos) * NPROJ_PAD;
      rq[i] = proj[tk + C_HQ + hd * 128 + ch];
      ru[i] = proj[tk + C_HF + d * 1024 + hd * 128 + ch];
      rv[i] = proj[tk + C_HI + hd * 128 + ch];
    }
  }
  for (int c = 0; c < nch; ++c) {
    char* buf = smem + (c & 1) * HG_BUF;
    float* xc_ = xch + (c & 1) * 256;
    float fv[8], kk[8], qs[8];
    float loc = 1.f;
#pragma unroll
    for (int i = 0; i < 8; ++i) {
      const float u = bf2f(ru[i]);
      const float sg = sigmoidf_(u);
      fv[i] = lbv + (1.f - lbv) * sg;
      kk[i] = (1.f - lbv) * (1.f - sg);
      qs[i] = siluf_(bf2f(rq[i]));
      loc *= fv[i];
      *(bf16_t*)(buf + 3 * HG_IMG + (8 * half + i) * HG_ROW + ch * 2) = rv[i];
    }
    xc_[half * 128 + ch] = loc;
    if (c + 1 < nch) {
#pragma unroll
      for (int i = 0; i < 8; ++i) {
        const int pos = (c + 1) * 16 + 8 * half + i;
        const size_t tk = (size_t)(d == 0 ? tok0 + pos : tok0 + L - 1 - pos) * NPROJ_PAD;
        rq[i] = proj[tk + C_HQ + hd * 128 + ch];
        ru[i] = proj[tk + C_HF + d * 1024 + hd * 128 + ch];
        rv[i] = proj[tk + C_HI + hd * 128 + ch];
      }
    }
    __syncthreads();
    {
      const float other = xc_[(half ^ 1) * 128 + ch];
      float P = half ? other : 1.f;
      float sfx = half ? 1.f : other;
      float suf[8];
#pragma unroll
      for (int i = 7; i >= 0; --i) { suf[i] = sfx; sfx *= fv[i]; }
#pragma unroll
      for (int i = 0; i < 8; ++i) {
        P *= fv[i];
        const int off = (8 * half + i) * HG_ROW + ch * 2;
        *(bf16_t*)(buf + off) = f2bf(qs[i] * P);
        *(bf16_t*)(buf + HG_IMG + off) = f2bf(kk[i] / fmaxf(P, 1e-30f));
        *(bf16_t*)(buf + 2 * HG_IMG + off) = f2bf(kk[i] * suf[i]);
      }
      if (half) ((float*)(buf + 4 * HG_IMG))[ch] = P;
    }
    __syncthreads();
    const char* qtI = buf;
    const char* ktI = buf + HG_IMG;
    const float* dec = (const float*)(buf + 4 * HG_IMG);
    f32x4 at = (f32x4){0.f, 0.f, 0.f, 0.f};
#pragma unroll
    for (int ks = 0; ks < 4; ++ks) {
      bf16x8 a = *(const bf16x8*)(ktI + fr * HG_ROW + (32 * ks + fq * 8) * 2);
      bf16x8 b = *(const bf16x8*)(qtI + fr * HG_ROW + (32 * ks + fq * 8) * 2);
      at = __builtin_amdgcn_mfma_f32_16x16x32_bf16(a, b, at, 0, 0, 0);
    }
    s16x4 Pm;
    {
      u32x2 pk;
      pk[0] = pack2((fq * 4 + 0 <= fr) ? at[0] : 0.f, (fq * 4 + 1 <= fr) ? at[1] : 0.f);
      pk[1] = pack2((fq * 4 + 2 <= fr) ? at[2] : 0.f, (fq * 4 + 3 <= fr) ? at[3] : 0.f);
      Pm = __builtin_bit_cast(s16x4, pk);
    }
    const unsigned ldsb = (unsigned)(size_t)buf;
    const unsigned vaddr = ldsb + 3 * HG_IMG + (4 * fq + (fr >> 2)) * HG_ROW + (32 * w + 4 * (fr & 3)) * 2;
    const unsigned kaddr = ldsb + 2 * HG_IMG + (4 * fq + (fr >> 2)) * HG_ROW + (4 * (fr & 3)) * 2;
    s16x4 vf0, vf1, kf0, kf1, kf2, kf3, kf4, kf5, kf6, kf7;
    asm volatile(
        "ds_read_b64_tr_b16 %0, %10\n\t"
        "ds_read_b64_tr_b16 %1, %10 offset:32\n\t"
        "ds_read_b64_tr_b16 %2, %11\n\t"
        "ds_read_b64_tr_b16 %3, %11 offset:32\n\t"
        "ds_read_b64_tr_b16 %4, %11 offset:64\n\t"
        "ds_read_b64_tr_b16 %5, %11 offset:96\n\t"
        "ds_read_b64_tr_b16 %6, %11 offset:128\n\t"
        "ds_read_b64_tr_b16 %7, %11 offset:160\n\t"
        "ds_read_b64_tr_b16 %8, %11 offset:192\n\t"
        "ds_read_b64_tr_b16 %9, %11 offset:224\n\t"
        "s_waitcnt lgkmcnt(0)"
        : "=&v"(vf0), "=&v"(vf1), "=&v"(kf0), "=&v"(kf1), "=&v"(kf2), "=&v"(kf3), "=&v"(kf4), "=&v"(kf5), "=&v"(kf6), "=&v"(kf7)
        : "v"(vaddr), "v"(kaddr)
        : "memory");
    f32x4 o0 = __builtin_amdgcn_mfma_f32_16x16x16bf16_1k(Pm, vf0, (f32x4){0.f, 0.f, 0.f, 0.f}, 0, 0, 0);
    f32x4 o1 = __builtin_amdgcn_mfma_f32_16x16x16bf16_1k(Pm, vf1, (f32x4){0.f, 0.f, 0.f, 0.f}, 0, 0, 0);
#pragma unroll
    for (int ks = 0; ks < 4; ++ks) {
      u32x2 qa = *(const u32x2*)(qtI + fr * HG_ROW + (32 * ks + 4 * fq) * 2);
      u32x2 qb = *(const u32x2*)(qtI + fr * HG_ROW + (32 * ks + 16 + 4 * fq) * 2);
      u32x4 aa; aa[0] = qa[0]; aa[1] = qa[1]; aa[2] = qb[0]; aa[3] = qb[1];
      const bf16x8 A = __builtin_bit_cast(bf16x8, aa);
      u32x4 b0, b1;
      b0[0] = pack2(S[2 * ks][0][0], S[2 * ks][0][1]); b0[1] = pack2(S[2 * ks][0][2], S[2 * ks][0][3]);
      b0[2] = pack2(S[2 * ks + 1][0][0], S[2 * ks + 1][0][1]); b0[3] = pack2(S[2 * ks + 1][0][2], S[2 * ks + 1][0][3]);
      b1[0] = pack2(S[2 * ks][1][0], S[2 * ks][1][1]); b1[1] = pack2(S[2 * ks][1][2], S[2 * ks][1][3]);
      b1[2] = pack2(S[2 * ks + 1][1][0], S[2 * ks + 1][1][1]); b1[3] = pack2(S[2 * ks + 1][1][2], S[2 * ks + 1][1][3]);
      o0 = __builtin_amdgcn_mfma_f32_16x16x32_bf16(A, __builtin_bit_cast(bf16x8, b0), o0, 0, 0, 0);
      o1 = __builtin_amdgcn_mfma_f32_16x16x32_bf16(A, __builtin_bit_cast(bf16x8, b1), o1, 0, 0, 0);
    }
#pragma unroll
    for (int jj = 0; jj < 4; ++jj) {
      const int pos = c * 16 + fq * 4 + jj;
      const size_t tk = (size_t)(d == 0 ? tok0 + pos : tok0 + L - 1 - pos);
      odir[tk * 1024 + hd * 128 + 32 * w + fr] = o0[jj];
      odir[tk * 1024 + hd * 128 + 32 * w + 16 + fr] = o1[jj];
    }
    const s16x4 kfs[8] = {kf0, kf1, kf2, kf3, kf4, kf5, kf6, kf7};
#pragma unroll
    for (int kt = 0; kt < 8; ++kt) {
      const f32x4 dv = *(const f32x4*)(dec + 16 * kt + fq * 4);
      S[kt][0] = __builtin_amdgcn_mfma_f32_16x16x16bf16_1k(kfs[kt], vf0, S[kt][0] * dv, 0, 0, 0);
      S[kt][1] = __builtin_amdgcn_mfma_f32_16x16x16bf16_1k(kfs[kt], vf1, S[kt][1] * dv, 0, 0, 0);
    }
  }
  if (s < 32) {
    float* o = p.out + OUT_HGRN + ((((size_t)s * 4 + l) * 2 + d) * 8 + hd) * 16384;
#pragma unroll
    for (int kt = 0; kt < 8; ++kt)
#pragma unroll
      for (int vt = 0; vt < 2; ++vt)
#pragma unroll
        for (int jj = 0; jj < 4; ++jj) o[(size_t)(16 * kt + fq * 4 + jj) * 128 + 32 * w + 16 * vt + fr] = S[kt][vt][jj];
  }
}


constexpr size_t OFF_SST = OFF_YF;
constexpr size_t OFF_CS = OFF_YB;
constexpr int SS_BROW = 272, SS_XROW = 144;
constexpr int SS_R0 = 128 * SS_BROW;
constexpr int SS_R1 = 128 * SS_XROW;

template <int OFF>
__device__ __forceinline__ s16x4 tr_read(unsigned addr) {
  s16x4 r;
  asm volatile("ds_read_b64_tr_b16 %0, %1 offset:%2" : "=v"(r) : "v"(addr), "i"(OFF) : "memory");
  return r;
}
__device__ __forceinline__ bf16x8 cat8(s16x4 a, s16x4 b) {
  bf16x8 r;
  r[0] = a[0]; r[1] = a[1]; r[2] = a[2]; r[3] = a[3]; r[4] = b[0]; r[5] = b[1]; r[6] = b[2]; r[7] = b[3];
  return r;
}
#define TR_WAIT12(a, b, c, d, e, f, g, h, i, j, k, l_)                                                                            \
  asm volatile("s_waitcnt lgkmcnt(0)" : "+v"(a), "+v"(b), "+v"(c), "+v"(d), "+v"(e), "+v"(f), "+v"(g), "+v"(h), "+v"(i), "+v"(j), \
               "+v"(k), "+v"(l_)::"memory")
#define TR_WAIT8(a, b, c, d, e, f, g, h) \
  asm volatile("s_waitcnt lgkmcnt(0)" : "+v"(a), "+v"(b), "+v"(c), "+v"(d), "+v"(e), "+v"(f), "+v"(g), "+v"(h)::"memory")

template <int KS>
__device__ __forceinline__ void ssd_p1_kstep(f32x4 (&acc)[2][4], unsigned abase, unsigned xbase) {
  s16x4 a00 = tr_read<KS * 32 * SS_BROW>(abase), a01 = tr_read<KS * 32 * SS_BROW + 4 * SS_BROW>(abase);
  s16x4 a10 = tr_read<KS * 32 * SS_BROW + 32>(abase), a11 = tr_read<KS * 32 * SS_BROW + 4 * SS_BROW + 32>(abase);
  s16x4 b00 = tr_read<KS * 32 * SS_XROW>(xbase), b01 = tr_read<KS * 32 * SS_XROW + 4 * SS_XROW>(xbase);
  s16x4 b10 = tr_read<KS * 32 * SS_XROW + 32>(xbase), b11 = tr_read<KS * 32 * SS_XROW + 4 * SS_XROW + 32>(xbase);
  s16x4 b20 = tr_read<KS * 32 * SS_XROW + 64>(xbase), b21 = tr_read<KS * 32 * SS_XROW + 4 * SS_XROW + 64>(xbase);
  s16x4 b30 = tr_read<KS * 32 * SS_XROW + 96>(xbase), b31 = tr_read<KS * 32 * SS_XROW + 4 * SS_XROW + 96>(xbase);
  TR_WAIT12(a00, a01, a10, a11, b00, b01, b10, b11, b20, b21, b30, b31);
  const bf16x8 A0 = cat8(a00, a01), A1 = cat8(a10, a11);
  const bf16x8 B0 = cat8(b00, b01), B1 = cat8(b10, b11), B2 = cat8(b20, b21), B3 = cat8(b30, b31);
  acc[0][0] = __builtin_amdgcn_mfma_f32_16x16x32_bf16(A0, B0, acc[0][0], 0, 0, 0);
  acc[0][1] = __builtin_amdgcn_mfma_f32_16x16x32_bf16(A0, B1, acc[0][1], 0, 0, 0);
  acc[0][2] = __builtin_amdgcn_mfma_f32_16x16x32_bf16(A0, B2, acc[0][2], 0, 0, 0);
  acc[0][3] = __builtin_amdgcn_mfma_f32_16x16x32_bf16(A0, B3, acc[0][3], 0, 0, 0);
  acc[1][0] = __builtin_amdgcn_mfma_f32_16x16x32_bf16(A1, B0, acc[1][0], 0, 0, 0);
  acc[1][1] = __builtin_amdgcn_mfma_f32_16x16x32_bf16(A1, B1, acc[1][1], 0, 0, 0);
  acc[1][2] = __builtin_amdgcn_mfma_f32_16x16x32_bf16(A1, B2, acc[1][2], 0, 0, 0);
  acc[1][3] = __builtin_amdgcn_mfma_f32_16x16x32_bf16(A1, B3, acc[1][3], 0, 0, 0);
}

__device__ __forceinline__ void ssd_pass1_item(const Params& p, int l, int item, char* smem) {
  const int d = item & 1, h = (item >> 1) & 31, s = item >> 6, g = h >> 2;
  const int nc = s < 32 ? 2 : 16, cg0 = s < 32 ? 2 * s : 64 + 16 * (s - 32);
  const int tid = tid_opaque(), lane = tid & 63, w = tid >> 6, fr = lane & 15, fq = lane >> 4;
  const float a = -expf(p.ssd_a_log[l * 64 + d * 32 + h]);
  f32x4 acc[2][4];
  if (s < 32) {
#pragma unroll
    for (int i = 0; i < 2; ++i)
#pragma unroll
      for (int j = 0; j < 4; ++j) acc[i][j] = (f32x4){0.f, 0.f, 0.f, 0.f};
  } else {
    const float* st = p.state_ssm + ((((size_t)(s - 32) * 4 + l) * 2 + d) * 32 + h) * 8192;
#pragma unroll
    for (int i = 0; i < 2; ++i)
#pragma unroll
      for (int j = 0; j < 4; ++j) acc[i][j] = *(const f32x4*)(st + (size_t)(16 * j + fr) * 128 + 32 * w + 16 * i + 4 * fq);
  }
  const bf16_t* xc = (const bf16_t*)(p.ws + OFF_XC);
  const float* dtb = (const float*)(p.ws + OFF_DT);
  float* csb = (float*)(p.ws + OFF_CS);
  bf16_t* sst = (bf16_t*)(p.ws + OFF_SST);
  float* wgt = (float*)(smem + SS_R0 + SS_R1);
  u32x4 pb[8], px[4];
  float dt0, dt1;
  {
    const int c = d == 0 ? 0 : nc - 1;
    const size_t tb = (size_t)(cg0 + c) * 128;
#pragma unroll
    for (int i = 0; i < 8; ++i) { const int q = tid + 256 * i; pb[i] = *(const u32x4*)(xc + (tb + (q >> 4)) * 4096 + 2048 + g * 128 + (q & 15) * 8); }
#pragma unroll
    for (int i = 0; i < 4; ++i) { const int q = tid + 256 * i; px[i] = *(const u32x4*)(xc + (tb + (q >> 3)) * 4096 + h * 64 + (q & 7) * 8); }
    dt0 = dtb[(tb + 2 * lane) * 64 + d * 32 + h];
    dt1 = dtb[(tb + 2 * lane + 1) * 64 + d * 32 + h];
  }
  const unsigned ldsb = (unsigned)(size_t)smem;
  const unsigned abase = ldsb + (8 * fq + (fr >> 2)) * SS_BROW + (32 * w + 4 * (fr & 3)) * 2;
  const unsigned xbase = ldsb + SS_R0 + (8 * fq + (fr >> 2)) * SS_XROW + (4 * (fr & 3)) * 2;
  for (int cc = 0; cc < nc; ++cc) {
    const int c = d == 0 ? cc : nc - 1 - cc, par = cc & 1;
    const size_t cgl = cg0 + c, tb = cgl * 128;
    {
      bf16_t* so = sst + ((cgl * 32 + h) * 2 + d) * 8192;
#pragma unroll
      for (int i = 0; i < 2; ++i)
#pragma unroll
        for (int j = 0; j < 4; ++j) {
          u32x2 o; o[0] = pack2(acc[i][j][0], acc[i][j][1]); o[1] = pack2(acc[i][j][2], acc[i][j][3]);
          *(u32x2*)(so + (size_t)(16 * j + fr) * 128 + 32 * w + 16 * i + 4 * fq) = o;
        }
    }
    if (w == 0) {
      const float v0 = dt0 * a, v1 = dt1 * a, sloc = v0 + v1;
      float incl = sloc;
#pragma unroll
      for (int off = 1; off < 64; off <<= 1) { const float t = __shfl_up(incl, off); if (lane >= off) incl += t; }
      const float excl = incl - sloc, c0 = excl + v0, tot = __shfl(incl, 63);
      float cs0, cs1, wg0, wg1;
      if (d == 0) { cs0 = c0; cs1 = incl; wg0 = dt0 * __expf(tot - c0); wg1 = dt1 * __expf(tot - incl); }
      else { cs0 = tot - excl; cs1 = tot - c0; wg0 = dt0 * __expf(excl); wg1 = dt1 * __expf(c0); }
      csb[(tb + 2 * lane) * 64 + d * 32 + h] = cs0;
      csb[(tb + 2 * lane + 1) * 64 + d * 32 + h] = cs1;
      wgt[par * 128 + 2 * lane] = wg0;
      wgt[par * 128 + 2 * lane + 1] = wg1;
      if (lane == 0) wgt[256 + par] = __expf(tot);
    }
    __syncthreads();
#pragma unroll
    for (int i = 0; i < 8; ++i) { const int q = tid + 256 * i; *(u32x4*)(smem + (q >> 4) * SS_BROW + (q & 15) * 16) = pb[i]; }
#pragma unroll
    for (int i = 0; i < 4; ++i) {
      const int q = tid + 256 * i, row = q >> 3;
      const float wv = wgt[par * 128 + row];
      u32x4 o;
#pragma unroll
      for (int e = 0; e < 4; ++e) o[e] = pack2(bf2f((bf16_t)(px[i][e] & 0xffff)) * wv, bf2f((bf16_t)(px[i][e] >> 16)) * wv);
      *(u32x4*)(smem + SS_R0 + row * SS_XROW + (q & 7) * 16) = o;
    }
    if (cc + 1 < nc) {
      const int cn = d == 0 ? cc + 1 : nc - 2 - cc;
      const size_t tbn = (size_t)(cg0 + cn) * 128;
#pragma unroll
      for (int i = 0; i < 8; ++i) { const int q = tid + 256 * i; pb[i] = *(const u32x4*)(xc + (tbn + (q >> 4)) * 4096 + 2048 + g * 128 + (q & 15) * 8); }
#pragma unroll
      for (int i = 0; i < 4; ++i) { const int q = tid + 256 * i; px[i] = *(const u32x4*)(xc + (tbn + (q >> 3)) * 4096 + h * 64 + (q & 7) * 8); }
      dt0 = dtb[(tbn + 2 * lane) * 64 + d * 32 + h];
      dt1 = dtb[(tbn + 2 * lane + 1) * 64 + d * 32 + h];
    }
    __syncthreads();
    const float dec = wgt[256 + par];
#pragma unroll
    for (int i = 0; i < 2; ++i)
#pragma unroll
      for (int j = 0; j < 4; ++j) acc[i][j] *= dec;
    ssd_p1_kstep<0>(acc, abase, xbase);
    ssd_p1_kstep<1>(acc, abase, xbase);
    ssd_p1_kstep<2>(acc, abase, xbase);
    ssd_p1_kstep<3>(acc, abase, xbase);
  }
  if (s < 32) {
    float* o = p.out + OUT_SSM + ((((size_t)s * 4 + l) * 2 + d) * 32 + h) * 8192;
#pragma unroll
    for (int i = 0; i < 2; ++i)
#pragma unroll
      for (int j = 0; j < 4; ++j) *(f32x4*)(o + (size_t)(16 * j + fr) * 128 + 32 * w + 16 * i + 4 * fq) = acc[i][j];
  }
  __syncthreads();
}

template <int KS>
__device__ __forceinline__ void ssd_p2_wx_kstep(f32x4 (&y)[4], const char* wrow, unsigned xbase) {
  s16x4 b00 = tr_read<KS * 32 * SS_XROW>(xbase), b01 = tr_read<KS * 32 * SS_XROW + 4 * SS_XROW>(xbase);
  s16x4 b10 = tr_read<KS * 32 * SS_XROW + 32>(xbase), b11 = tr_read<KS * 32 * SS_XROW + 4 * SS_XROW + 32>(xbase);
  s16x4 b20 = tr_read<KS * 32 * SS_XROW + 64>(xbase), b21 = tr_read<KS * 32 * SS_XROW + 4 * SS_XROW + 64>(xbase);
  s16x4 b30 = tr_read<KS * 32 * SS_XROW + 96>(xbase), b31 = tr_read<KS * 32 * SS_XROW + 4 * SS_XROW + 96>(xbase);
  const bf16x8 A = *(const bf16x8*)(wrow + KS * 64);
  TR_WAIT8(b00, b01, b10, b11, b20, b21, b30, b31);
  y[0] = __builtin_amdgcn_mfma_f32_16x16x32_bf16(A, cat8(b00, b01), y[0], 0, 0, 0);
  y[1] = __builtin_amdgcn_mfma_f32_16x16x32_bf16(A, cat8(b10, b11), y[1], 0, 0, 0);
  y[2] = __builtin_amdgcn_mfma_f32_16x16x32_bf16(A, cat8(b20, b21), y[2], 0, 0, 0);
  y[3] = __builtin_amdgcn_mfma_f32_16x16x32_bf16(A, cat8(b30, b31), y[3], 0, 0, 0);
}

__device__ __forceinline__ void ssd_pass2_item(const Params& p, int l, int item, char* smem) {
  const int hf = item & 1, g = (item >> 1) & 7, cg = item >> 4;
  const size_t tb = (size_t)cg * 128;
  const int tid = tid_opaque(), lane = tid & 63, w = tid >> 6, fr = lane & 15, fq = lane >> 4;
  const int i0 = 64 * hf + 16 * w;
  const bf16_t* xc = (const bf16_t*)(p.ws + OFF_XC);
  const bf16_t* proj = (const bf16_t*)(p.ws + OFF_PROJ);
  const float* dtb = (const float*)(p.ws + OFF_DT);
  const float* csb = (const float*)(p.ws + OFF_CS);
  const bf16_t* sst = (const bf16_t*)(p.ws + OFF_SST);
  bf16_t* ybuf = (bf16_t*)(p.ws + OFF_YBUF);
  float* arr = (float*)(smem + SS_R0 + SS_R1);
  __syncthreads();
  bf16x8 cfr[4];
#pragma unroll
  for (int ks = 0; ks < 4; ++ks) cfr[ks] = *(const bf16x8*)(xc + (tb + i0 + fr) * 4096 + 3072 + g * 128 + 32 * ks + 8 * fq);
#pragma unroll
  for (int i = 0; i < 8; ++i) {
    const int idx = tid + 256 * i, hh = idx >> 9, a = (idx >> 7) & 3, j = idx & 127;
    const float* src = (a < 2 ? csb : dtb) + (tb + j) * 64 + (a & 1) * 32 + 4 * g + hh;
    arr[idx] = *src;
  }
#pragma unroll
  for (int i = 0; i < 8; ++i) {
    const int q = tid + 256 * i;
    *(u32x4*)(smem + (q >> 4) * SS_BROW + (q & 15) * 16) = *(const u32x4*)(xc + (tb + (q >> 4)) * 4096 + 2048 + g * 128 + (q & 15) * 8);
  }
  __syncthreads();
  f32x4 cb[8];
#pragma unroll
  for (int jt = 0; jt < 8; ++jt) cb[jt] = (f32x4){0.f, 0.f, 0.f, 0.f};
#pragma unroll
  for (int ks = 0; ks < 4; ++ks)
#pragma unroll
    for (int jt = 0; jt < 8; ++jt) {
      const bf16x8 A = *(const bf16x8*)(smem + (16 * jt + fr) * SS_BROW + (32 * ks + 8 * fq) * 2);
      cb[jt] = __builtin_amdgcn_mfma_f32_16x16x32_bf16(A, cfr[ks], cb[jt], 0, 0, 0);
    }
  __syncthreads();
  float ss[4] = {0.f, 0.f, 0.f, 0.f};
  const unsigned ldsb = (unsigned)(size_t)smem;
  const unsigned xbase = ldsb + SS_R0 + (8 * fq + (fr >> 2)) * SS_XROW + (4 * (fr & 3)) * 2;
  const char* wrow = smem + (16 * w + fr) * SS_BROW + (8 * fq) * 2;
  const int il = i0 + fr;
#pragma unroll 1
  for (int hh = 0; hh < 4; ++hh) {
    const int h = 4 * g + hh;
    u32x4 pre[4];
#pragma unroll
    for (int i = 0; i < 4; ++i) { const int q = tid + 256 * i; pre[i] = *(const u32x4*)(xc + (tb + (q >> 3)) * 4096 + h * 64 + (q & 7) * 8); }
    const float* csf = arr + hh * 512;
    const float* csr = csf + 128;
    const float* dtf = csf + 256;
    const float* dtr = csf + 384;
    {
      const float cfi = csf[il], cbi = csr[il];
#pragma unroll
      for (int jt = 0; jt < 8; ++jt) {
        const f32x4 cfj = *(const f32x4*)(csf + 16 * jt + 4 * fq), cbj = *(const f32x4*)(csr + 16 * jt + 4 * fq);
        const f32x4 dfj = *(const f32x4*)(dtf + 16 * jt + 4 * fq), dbj = *(const f32x4*)(dtr + 16 * jt + 4 * fq);
        float wv[4];
#pragma unroll
        for (int jj = 0; jj < 4; ++jj) {
          const int j = 16 * jt + 4 * fq + jj;
          const float lf = (j <= il) ? __expf(cfi - cfj[jj]) * dfj[jj] : 0.f;
          const float lr = (j >= il) ? __expf(cbi - cbj[jj]) * dbj[jj] : 0.f;
          wv[jj] = cb[jt][jj] * (lf + lr);
        }
        u32x2 o; o[0] = pack2(wv[0], wv[1]); o[1] = pack2(wv[2], wv[3]);
        *(u32x2*)(smem + (16 * w + fr) * SS_BROW + (16 * jt + 4 * fq) * 2) = o;
      }
    }
#pragma unroll
    for (int i = 0; i < 4; ++i) { const int q = tid + 256 * i; *(u32x4*)(smem + SS_R0 + (q >> 3) * SS_XROW + (q & 7) * 16) = pre[i]; }
#pragma unroll
    for (int i = 0; i < 4; ++i) { const int q = tid + 256 * i; pre[i] = *(const u32x4*)(sst + (((size_t)cg * 32 + h) * 2 + 0) * 8192 + (q >> 4) * 128 + (q & 15) * 8); }
    __syncthreads();
    f32x4 y[4];
#pragma unroll
    for (int pt = 0; pt < 4; ++pt) y[pt] = (f32x4){0.f, 0.f, 0.f, 0.f};
    ssd_p2_wx_kstep<0>(y, wrow, xbase);
    ssd_p2_wx_kstep<1>(y, wrow, xbase);
    ssd_p2_wx_kstep<2>(y, wrow, xbase);
    ssd_p2_wx_kstep<3>(y, wrow, xbase);
    float xsk[4][4];
#pragma unroll
    for (int pt = 0; pt < 4; ++pt)
#pragma unroll
      for (int jj = 0; jj < 4; ++jj) xsk[pt][jj] = bf2f(*(const bf16_t*)(smem + SS_R0 + (i0 + 4 * fq + jj) * SS_XROW + (16 * pt + fr) * 2));
    __syncthreads();
#pragma unroll
    for (int i = 0; i < 4; ++i) { const int q = tid + 256 * i; *(u32x4*)(smem + SS_R0 + (q >> 4) * SS_BROW + (q & 15) * 16) = pre[i]; }
#pragma unroll
    for (int i = 0; i < 4; ++i) { const int q = tid + 256 * i; pre[i] = *(const u32x4*)(sst + (((size_t)cg * 32 + h) * 2 + 1) * 8192 + (q >> 4) * 128 + (q & 15) * 8); }
    __syncthreads();
    f32x4 zf[4], zb[4];
#pragma unroll
    for (int pt = 0; pt < 4; ++pt) { zf[pt] = (f32x4){0.f, 0.f, 0.f, 0.f}; zb[pt] = (f32x4){0.f, 0.f, 0.f, 0.f}; }
#pragma unroll
    for (int ks = 0; ks < 4; ++ks)
#pragma unroll
      for (int pt = 0; pt < 4; ++pt) {
        const bf16x8 B = *(const bf16x8*)(smem + SS_R0 + (16 * pt + fr) * SS_BROW + (32 * ks + 8 * fq) * 2);
        zf[pt] = __builtin_amdgcn_mfma_f32_16x16x32_bf16(cfr[ks], B, zf[pt], 0, 0, 0);
      }
    __syncthreads();
#pragma unroll
    for (int i = 0; i < 4; ++i) { const int q = tid + 256 * i; *(u32x4*)(smem + SS_R0 + (q >> 4) * SS_BROW + (q & 15) * 16) = pre[i]; }
    __syncthreads();
#pragma unroll
    for (int ks = 0; ks < 4; ++ks)
#pragma unroll
      for (int pt = 0; pt < 4; ++pt) {
        const bf16x8 B = *(const bf16x8*)(smem + SS_R0 + (16 * pt + fr) * SS_BROW + (32 * ks + 8 * fq) * 2);
        zb[pt] = __builtin_amdgcn_mfma_f32_16x16x32_bf16(cfr[ks], B, zb[pt], 0, 0, 0);
      }
    const float dsk = p.ssd_d[l * 32 + h];
#pragma unroll
    for (int jj = 0; jj < 4; ++jj) {
      const int i2 = i0 + 4 * fq + jj;
      const float ef = __expf(csf[i2]), eb = __expf(csr[i2]);
#pragma unroll
      for (int pt = 0; pt < 4; ++pt) {
        const float z = bf2f(proj[(tb + i2) * NPROJ_PAD + C_Z + h * 64 + 16 * pt + fr]);
        float val = y[pt][jj] + ef * zf[pt][jj] + eb * zb[pt][jj] + dsk * xsk[pt][jj];
        val *= siluf_(z);
        ybuf[(tb + i2) * 2048 + h * 64 + 16 * pt + fr] = f2bf(val);
        ss[jj] += val * val;
      }
    }
    __syncthreads();
  }
#pragma unroll
  for (int jj = 0; jj < 4; ++jj) {
    float t = ss[jj];
    t += __shfl_xor(t, 1); t += __shfl_xor(t, 2); t += __shfl_xor(t, 4); t += __shfl_xor(t, 8);
    ss[jj] = rsqrtf(t * (1.f / 256.f) + 1e-6f);
  }
#pragma unroll
  for (int hh = 0; hh < 4; ++hh)
#pragma unroll
    for (int pt = 0; pt < 4; ++pt) {
      const int chn = (4 * g + hh) * 64 + 16 * pt + fr;
      const float nw = p.ssd_norm_w[l * 2048 + chn];
#pragma unroll
      for (int jj = 0; jj < 4; ++jj) {
        bf16_t* yp = ybuf + (tb + i0 + 4 * fq + jj) * 2048 + chn;
        *yp = f2bf(bf2f(*yp) * ss[jj] * nw);
      }
    }
}

__device__ __forceinline__ void phase_scan1(const Params& p, int l, char* smem) {
  const int G = gridDim.x, bid = blockIdx.x;
  if (bid < 64) { hgrn_chunk_item(p, l, 32 * 16 + bid, smem); return; }
  for (int it = bid - 64; it < 256 + 512 + 2048; it += G - 64) {
    if (it < 256) ssd_pass1_item(p, l, 32 * 64 + it, smem);
    else if (it < 768) hgrn_chunk_item(p, l, it - 256, smem);
    else ssd_pass1_item(p, l, it - 768, smem);
  }
}
__device__ __forceinline__ void phase_scan2(const Params& p, int l, char* smem) {
  for (int it = blockIdx.x; it < 2048; it += gridDim.x) ssd_pass2_item(p, l, it, smem);
}

__device__ __forceinline__ void phase_scan_naive(const Params& p, int l, char* smem) {
  const int n_ssd = 36 * 64, n_hg = 36 * 16;
  for (int it = blockIdx.x; it < n_ssd + n_hg; it += gridDim.x) {
    if (it < 256) ssd_naive_item(p, l, 32 * 64 + it, (float*)smem);
    else if (it < 320) hgrn_chunk_item(p, l, 32 * 16 + (it - 256), smem);
    else if (it < 320 + 2048) ssd_naive_item(p, l, it - 320, (float*)smem);
    else hgrn_chunk_item(p, l, it - 320 - 2048, smem);
  }
}

__device__ __forceinline__ void phase_post(const Params& p, int l) {
  const int tid = tid_opaque();
  const bf16_t* proj = (const bf16_t*)(p.ws + OFF_PROJ);
  const bf16_t* xc = (const bf16_t*)(p.ws + OFF_XC);
  const float* yf = (const float*)(p.ws + OFF_YF);
  const float* yb = (const float*)(p.ws + OFF_YB);
  const float* of = (const float*)(p.ws + OFF_OF);
  const float* ob = (const float*)(p.ws + OFF_OB);
  bf16_t* ybuf = (bf16_t*)(p.ws + OFF_YBUF);
  bf16_t* obuf = (bf16_t*)(p.ws + OFF_OBUF);
  for (int tok = blockIdx.x; tok < T; tok += gridDim.x) {
    {
      const int ch = tid * 4;
      const float* a = of + (size_t)tok * 1024 + ch;
      const float* b = ob + (size_t)tok * 1024 + ch;
      uint2 gv = *(const uint2*)(proj + (size_t)tok * NPROJ_PAD + C_HG + ch);
      const unsigned gw[2] = {gv.x, gv.y};
      float v[4];
      float ss = 0.f;
#pragma unroll
      for (int j = 0; j < 4; ++j) { v[j] = a[j] + b[j]; ss += v[j] * v[j]; }
#pragma unroll
      for (int o = 16; o >= 1; o >>= 1) ss += __shfl_xor(ss, o);
      const float rstd = rsqrtf(ss * (1.f / 128.f) + 1e-6f);
      const float* nw = p.hgrn_norm_w + l * 1024 + ch;
      float r[4];
#pragma unroll
      for (int j = 0; j < 4; ++j) {
        const float gz = bf2f((bf16_t)((j & 1) ? (gw[j >> 1] >> 16) : (gw[j >> 1] & 0xffff)));
        r[j] = v[j] * rstd * nw[j] * siluf_(gz);
      }
      uint2 o2; o2.x = pack2(r[0], r[1]); o2.y = pack2(r[2], r[3]);
      *(uint2*)(obuf + (size_t)tok * 1024 + ch) = o2;
    }
  }
}


#define XB_TMO 128
#define XB_XCNT(j) (256 + 64 * (j))
#define XB_XSUB(j) (1280 + 64 * (j))
#define XB_XGEN(j) (2304 + 64 * (j))
#define XB_TOP 3328
#define XB_TOPGEN 3392
#define XCD_BAR_WORDS 3456
#define XB_SPIN_CAP (1u << 22)
#define LAS __attribute__((address_space(3)))
__device__ __forceinline__ unsigned xb_ld(unsigned* p) { return __hip_atomic_load(p, __ATOMIC_RELAXED, __HIP_MEMORY_SCOPE_AGENT); }
__device__ __forceinline__ unsigned xb_add(unsigned* p, unsigned v) { return __hip_atomic_fetch_add(p, v, __ATOMIC_RELAXED, __HIP_MEMORY_SCOPE_AGENT); }
__device__ __forceinline__ unsigned xb_xcc_id() { return (unsigned)__builtin_amdgcn_s_getreg((3 << 11) | 20) & 0xFu; }
#define XB_SPIN(cond, bar)                                                                    \
  do {                                                                                        \
    unsigned _sp = 0;                                                                         \
    while (cond) {                                                                            \
      __builtin_amdgcn_s_sleep(1);                                                            \
      if ((++_sp & 255u) == 0u) {                                                             \
        if (xb_ld(&(bar)[XB_TMO])) break;                                                     \
        if (_sp > XB_SPIN_CAP) { atomicAdd(&(bar)[XB_TMO], 1u); break; }                      \
      }                                                                                       \
    }                                                                                         \
  } while (0)
struct XcdBarrier { unsigned* bar; unsigned x; volatile LAS unsigned* st; };
__device__ __forceinline__ XcdBarrier xcd_barrier_post(unsigned* bar, volatile LAS unsigned* st) {
  XcdBarrier b; b.bar = bar; b.x = xb_xcc_id(); b.st = st;
  if (threadIdx.x == 0) (void)xb_add(&bar[XB_XCNT(b.x)], 1u);
  return b;
}
__device__ __forceinline__ void xcd_barrier_complete(unsigned* bar, unsigned x, unsigned& nloc, unsigned& nx) {
  const unsigned G = gridDim.x * gridDim.y * gridDim.z;
  unsigned sum, cnt, mine, sp = 0u;
  for (;;) {
    sum = 0u; cnt = 0u; mine = 0u;
#pragma unroll
    for (unsigned j = 0; j < 16; ++j) { const unsigned c = xb_ld(&bar[XB_XCNT(j)]); sum += c; cnt += (c > 0u) ? 1u : 0u; mine = (j == x) ? c : mine; }
    if (sum == G) break;
    __builtin_amdgcn_s_sleep(1);
    if ((++sp & 255u) == 0u) { if (xb_ld(&bar[XB_TMO])) break; if (sp > XB_SPIN_CAP) { atomicAdd(&bar[XB_TMO], 1u); break; } }
  }
  nloc = mine > 0u ? mine : 1u; nx = cnt > 0u ? cnt : 1u;
}
__device__ __forceinline__ void xcd_barrier(const XcdBarrier& b) {
  asm volatile("s_waitcnt vmcnt(0)" ::: "memory");
  __syncthreads();
  if (threadIdx.x == 0) {
    unsigned* bar = b.bar;
    __builtin_amdgcn_s_waitcnt(0);
    unsigned nloc = b.st[0], nx = b.st[1];
    if (nloc == 0u) { xcd_barrier_complete(bar, b.x, nloc, nx); b.st[0] = nloc; b.st[1] = nx; }
    const unsigned old = xb_add(&bar[XB_XSUB(b.x)], 1u);
    const unsigned gen = old / nloc;
    if (old + 1u == (gen + 1u) * nloc) {
      __builtin_amdgcn_fence(__ATOMIC_RELEASE, "agent");
      asm volatile("s_waitcnt vmcnt(0)" ::: "memory");
      const unsigned og = xb_add(&bar[XB_TOP], 1u);
      const unsigned tg = og / nx;
      if (og + 1u == (tg + 1u) * nx) xb_add(&bar[XB_TOPGEN], 1u);
      else XB_SPIN(xb_ld(&bar[XB_TOPGEN]) == tg, bar);
      __builtin_amdgcn_fence(__ATOMIC_ACQUIRE, "agent");
      xb_add(&bar[XB_XGEN(b.x)], 1u);
      asm volatile("s_waitcnt vmcnt(0)" ::: "memory");
    } else {
      XB_SPIN(xb_ld(&bar[XB_XGEN(b.x)]) == gen, bar);
      __builtin_amdgcn_fence(__ATOMIC_ACQUIRE, "agent");
      asm volatile("s_waitcnt vmcnt(0)" ::: "memory");
    }
  }
  __syncthreads();
}

enum { PH_SETUP = 0, PH_NORM1, PH_PROJ, PH_CONV, PH_SCAN, PH_POST, PH_MERGE, PH_OUT, PH_NORM2, PH_FFN1, PH_FFN2, PH_FINAL };

__device__ __forceinline__ void run_phase(const Params& p, int ph, int l, char* smem) {
  switch (ph) {
    case PH_SETUP: phase_setup(p, smem); break;
    case PH_NORM1: phase_norm(p, l, 0); break;
    case PH_PROJ: phase_gemm<G_PROJ>(p, l, smem); break;
    case PH_CONV: phase_conv(p, l); break;
    case PH_SCAN: phase_scan_naive(p, l, smem); break;
    case PH_POST: phase_post(p, l); break;
    case PH_MERGE: phase_gemm<G_MERGE>(p, l, smem); break;
    case PH_OUT: phase_gemm<G_OUT>(p, l, smem); break;
    case PH_NORM2: phase_norm(p, l, 1); break;
    case PH_FFN1: phase_gemm<G_FFN1>(p, l, smem); break;
    case PH_FFN2: phase_gemm<G_FFN2>(p, l, smem); break;
    case PH_FINAL: phase_final_norm(p); break;
  }
}

extern __shared__ __attribute__((aligned(16))) char dyn_smem[];

#if !MEGA
__global__ void __launch_bounds__(256, 2) phase_kernel(Params p, int ph, int l) { run_phase(p, ph, l, dyn_smem); }
#endif

#if MEGA
__global__ void __launch_bounds__(256, 2) mega_kernel(Params p) {
  cg::grid_group grid = cg::this_grid();
  __shared__ uint4 xb_words;
  if (threadIdx.x == 0) xb_words = make_uint4(0u, 0u, 0u, 0u);
  __syncthreads();
  XcdBarrier xb = xcd_barrier_post((unsigned*)(p.ws + OFF_BAR), (volatile LAS unsigned*)&xb_words);
  phase_setup(p, dyn_smem);
  grid.sync();
  for (int l = 0; l < DEPTH; ++l) {
#pragma unroll 1
    for (int ph = 0; ph < 10; ++ph) {
      switch (ph) {
        case 0: phase_norm(p, l, 0); break;
        case 1: phase_gemm<G_PROJ>(p, l, dyn_smem); break;
        case 2: phase_conv(p, l); break;
        case 3: phase_scan1(p, l, dyn_smem); break;
        case 4: phase_scan2(p, l, dyn_smem); phase_post(p, l); break;
        case 5: phase_gemm<G_MERGE>(p, l, dyn_smem); break;
        case 6: phase_gemm<G_OUT>(p, l, dyn_smem); break;
        case 7: phase_norm(p, l, 1); break;
        case 8: phase_gemm<G_FFN1>(p, l, dyn_smem); break;
        default: phase_gemm<G_FFN2>(p, l, dyn_smem); break;
      }
      xcd_barrier(xb);
    }
  }
  phase_final_norm(p);
}
#endif

extern "C" void kernel_launch(void* const* d_in, const int* in_sizes, int n_in, void* d_out, int out_size, void* d_ws, size_t ws_size,
                              hipStream_t stream) {
  static int grid_blocks = 0;
  if (!grid_blocks) {
    int dev = 0, cus = 0, per_cu = 0;
    (void)hipGetDevice(&dev);
    (void)hipDeviceGetAttribute(&cus, hipDeviceAttributeMultiprocessorCount, dev);
#if MEGA
    (void)hipFuncSetAttribute((const void*)mega_kernel, hipFuncAttributeMaxDynamicSharedMemorySize, SMEM_BYTES);
#endif
#if !MEGA
    (void)hipFuncSetAttribute((const void*)phase_kernel, hipFuncAttributeMaxDynamicSharedMemorySize, SMEM_BYTES);
#endif
#if MEGA
    (void)hipOccupancyMaxActiveBlocksPerMultiprocessor(&per_cu, mega_kernel, 256, SMEM_BYTES);
#else
    (void)hipOccupancyMaxActiveBlocksPerMultiprocessor(&per_cu, phase_kernel, 256, SMEM_BYTES);
#endif
    per_cu = 2;
    grid_blocks = cus * per_cu;
  }
  Params p{};
  const float** pf = (const float**)&p;
  for (int i = 0; i < 26; ++i) pf[i] = (const float*)d_in[i];
  p.out = (float*)d_out;
  p.ws = (char*)d_ws;
#if MEGA
  (void)hipMemsetAsync((char*)d_ws + OFF_BAR, 0, XCD_BAR_WORDS * 4, stream);
  void* args[] = {&p};
  hipError_t e = hipLaunchCooperativeKernel((void*)mega_kernel, dim3(grid_blocks), dim3(256), args, SMEM_BYTES, stream);
  if (e != hipSuccess) fprintf(stderr, "coop launch failed: %s\n", hipGetErrorString(e));
#else
  const int G = grid_blocks;
  phase_kernel<<<G, 256, SMEM_BYTES, stream>>>(p, PH_SETUP, 0);
  for (int l = 0; l < DEPTH; ++l)
    for (int ph = PH_NORM1; ph <= PH_FFN2; ++ph) phase_kernel<<<G, 256, SMEM_BYTES, stream>>>(p, ph, l);
  phase_kernel<<<G, 256, SMEM_BYTES, stream>>>(p, PH_FINAL, 0);
#endif
}
```

```cpp
#include <hip/hip_runtime.h>
#include <hip/hip_cooperative_groups.h>
#include <cstdio>
#include <cstdint>
namespace cg = cooperative_groups;

#ifndef MEGA
#define MEGA 1
#endif

typedef unsigned short bf16_t;
typedef short bf16x8 __attribute__((ext_vector_type(8)));
typedef float f32x4 __attribute__((ext_vector_type(4)));
typedef unsigned u32x4 __attribute__((ext_vector_type(4)));
typedef short s16x4 __attribute__((ext_vector_type(4)));
typedef unsigned u32x2 __attribute__((ext_vector_type(2)));

constexpr int D = 1024, T = 16384, TCTX = 8192, DEPTH = 4;
constexpr int NPROJ = 13376, NPROJ_PAD = 13440;
constexpr int FFN = 2816;
constexpr int C_Z = 4096, C_DT = 6144, C_HQ = 6208, C_HF = 7232, C_HI = 9280, C_HG = 10304, C_GATE = 11328;
constexpr size_t WT_IN = 0;
constexpr size_t WT_SSO = WT_IN + (size_t)NPROJ_PAD * 1024;
constexpr size_t WT_HGO = WT_SSO + (size_t)1024 * 2048;
constexpr size_t WT_OUT = WT_HGO + (size_t)1024 * 1024;
constexpr size_t WT_W13 = WT_OUT + (size_t)1024 * 1024;
constexpr size_t WT_W2 = WT_W13 + (size_t)5632 * 1024;
constexpr size_t WT_LAYER = WT_W2 + (size_t)1024 * 2816;
constexpr size_t OFF_WT = 0;
constexpr size_t OFF_H = OFF_WT + WT_LAYER * 2 * DEPTH;
constexpr size_t OFF_PROJ = OFF_H + (size_t)T * 1024 * 2;
constexpr size_t OFF_XC = OFF_PROJ + (size_t)T * NPROJ_PAD * 2;
constexpr size_t OFF_DTRAW = OFF_XC + (size_t)T * 4096 * 2;
constexpr size_t OFF_DT = OFF_DTRAW + (size_t)T * 64 * 4;
constexpr size_t OFF_YF = OFF_DT + (size_t)T * 64 * 4;
constexpr size_t OFF_YB = OFF_YF + (size_t)T * 2048 * 4;
constexpr size_t OFF_OF = OFF_YB + (size_t)T * 2048 * 4;
constexpr size_t OFF_OB = OFF_OF + (size_t)T * 1024 * 4;
constexpr size_t OFF_YBUF = OFF_OB + (size_t)T * 1024 * 4;
constexpr size_t OFF_OBUF = OFF_YBUF + (size_t)T * 2048 * 2;
constexpr size_t OFF_MBUF = OFF_OBUF + (size_t)T * 1024 * 2;
constexpr size_t OFF_MOD = OFF_MBUF + (size_t)T * 1024 * 2;
constexpr size_t OFF_LB = OFF_MOD + (size_t)DEPTH * 5 * 6144 * 4;
constexpr size_t OFF_BAR = OFF_LB + (size_t)DEPTH * 2 * 1024 * 4;
constexpr size_t OFF_END = OFF_BAR + 16384;
constexpr size_t OUT_SSM = (size_t)T * 1024;
constexpr size_t OUT_HGRN = OUT_SSM + (size_t)32 * 4 * 2 * 32 * 64 * 128;

constexpr int SMEM_BYTES = 73728;
constexpr int LDS_ROW = 128;
constexpr int LDS_TILE = 128 * LDS_ROW;

struct Params {
  const float *x_prompt, *x_sample, *c, *state_ssm, *state_hgrn, *c_ctx, *norm_mix_w, *norm_ffn_w, *ada_w, *ada_b, *w_in,
      *ssd_conv_w, *ssd_conv_b, *ssd_dt_bias, *ssd_a_log, *ssd_d, *ssd_norm_w, *hgrn_lb, *hgrn_norm_w, *w_ssd_out, *w_hgrn_out,
      *w_out, *ffn_w1, *ffn_w3, *ffn_w2, *norm_final_w;
  float* out;
  char* ws;
};

__device__ __forceinline__ bf16_t f2bf(float f) {
  unsigned u = __float_as_uint(f);
  u += 0x7fffu + ((u >> 16) & 1u);
  return (bf16_t)(u >> 16);
}
__device__ __forceinline__ float bf2f(bf16_t b) { return __uint_as_float(((unsigned)b) << 16); }
typedef __bf16 bf16x2_t __attribute__((ext_vector_type(2)));
__device__ __forceinline__ unsigned pack2(float a, float b) { bf16x2_t v = {(__bf16)a, (__bf16)b}; return __builtin_bit_cast(unsigned, v); }
__device__ __forceinline__ float sigmoidf_(float x) { return __builtin_amdgcn_rcpf(1.0f + __expf(-x)); }
__device__ __forceinline__ float siluf_(float x) { return x * __builtin_amdgcn_rcpf(1.0f + __expf(-x)); }
__device__ __forceinline__ int tid_opaque() { int t = threadIdx.x; asm volatile("" : "+v"(t)); return t; }
__device__ __forceinline__ float clamp30(float x) { return fminf(fmaxf(x, -30.f), 30.f); }
__device__ __forceinline__ float gate_ratio(float g1, float g2) { return (1.0f + __expf(-clamp30(g2))) * __builtin_amdgcn_rcpf(1.0f + __expf(-clamp30(g1))); }
__device__ __forceinline__ int mod_row(int tok) { return tok < TCTX ? 0 : 1 + ((tok - TCTX) >> 11); }

__device__ __forceinline__ void phase_setup(const Params& p, char* smem) {
  const int tid = tid_opaque(), bid = blockIdx.x, G = gridDim.x;
  {
    const size_t n4 = (size_t)T * 1024 / 4, half4 = (size_t)TCTX * 1024 / 4;
    float4* dst = (float4*)p.out;
    const float4* s0 = (const float4*)p.x_prompt;
    const float4* s1 = (const float4*)p.x_sample;
    for (size_t i = (size_t)bid * 256 + tid; i < n4; i += (size_t)G * 256) dst[i] = i < half4 ? s0[i] : s1[i - half4];
  }
  {
    float* lb = (float*)(p.ws + OFF_LB);
    for (int i = bid * 256 + tid; i < 2048; i += G * 256) {
      float v0 = p.hgrn_lb[i], v1 = p.hgrn_lb[2048 + i], v2 = p.hgrn_lb[4096 + i], v3 = p.hgrn_lb[6144 + i];
      float m = fmaxf(fmaxf(v0, v1), fmaxf(v2, v3));
      float e0 = expf(v0 - m), e1 = expf(v1 - m), e2 = expf(v2 - m), e3 = expf(v3 - m);
      float inv = 1.0f / (e0 + e1 + e2 + e3);
      lb[i] = 0.f;
      lb[2048 + i] = e1 * inv;
      lb[4096 + i] = (e1 + e2) * inv;
      lb[6144 + i] = (e1 + e2 + e3) * inv;
    }
  }
  {
    float* sm = (float*)smem;
    float* modb = (float*)(p.ws + OFF_MOD);
    __syncthreads();
    for (int i = tid; i < 5 * 1024; i += 256) {
      int v = i >> 10, k = i & 1023;
      float cv = v == 0 ? p.c_ctx[k] : p.c[(v - 1) * 1024 + k];
      sm[i] = siluf_(cv);
    }
    __syncthreads();
    float* part = sm + 5 * 1024;
    for (int item = bid; item < DEPTH * 96; item += G) {
      int l = item / 96, cg_ = item % 96;
      int col = cg_ * 64 + (tid & 63), kg = tid >> 6;
      const float* w = p.ada_w + (size_t)l * 1024 * 6144 + col;
      float a0 = 0, a1 = 0, a2 = 0, a3 = 0, a4 = 0;
      for (int k = kg * 256; k < kg * 256 + 256; ++k) {
        float wv = w[(size_t)k * 6144];
        a0 += sm[k] * wv; a1 += sm[1024 + k] * wv; a2 += sm[2048 + k] * wv; a3 += sm[3072 + k] * wv; a4 += sm[4096 + k] * wv;
      }
      __syncthreads();
      part[(kg * 5 + 0) * 64 + (tid & 63)] = a0; part[(kg * 5 + 1) * 64 + (tid & 63)] = a1; part[(kg * 5 + 2) * 64 + (tid & 63)] = a2;
      part[(kg * 5 + 3) * 64 + (tid & 63)] = a3; part[(kg * 5 + 4) * 64 + (tid & 63)] = a4;
      __syncthreads();
      for (int i = tid; i < 320; i += 256) {
        int v = i >> 6, cc = i & 63;
        float s = part[(0 * 5 + v) * 64 + cc] + part[(1 * 5 + v) * 64 + cc] + part[(2 * 5 + v) * 64 + cc] + part[(3 * 5 + v) * 64 + cc];
        int colo = cg_ * 64 + cc;
        modb[((size_t)l * 5 + v) * 6144 + colo] = s + p.ada_b[l * 6144 + colo];
      }
    }
    __syncthreads();
  }
  {
    float* tile = (float*)smem;
    const int n_in = 210 * 16, n_sso = 16 * 32, n_hgo = 16 * 16, n_out = 16 * 16, n_w13 = 88 * 16, n_w2 = 16 * 44;
    const int per_layer = n_in + n_sso + n_hgo + n_out + n_w13 + n_w2;
    for (int it = bid; it < per_layer * DEPTH; it += G) {
      int l = it / per_layer, r = it % per_layer;
      bf16_t* wt = (bf16_t*)(p.ws + OFF_WT) + (size_t)l * WT_LAYER;
      const float *src0 = nullptr, *src1 = nullptr;
      int K, Nsrc, nt, kt;
      bf16_t* dst;
      bool zero = false;
      if (r < n_in) {
        nt = r / 16; kt = r % 16; K = 1024; Nsrc = NPROJ;
        dst = wt + WT_IN;
        if (nt >= 209) zero = true;
        src0 = p.w_in + (size_t)l * 1024 * NPROJ + nt * 64; src1 = src0 + 32;
      } else if ((r -= n_in) < n_sso) {
        nt = r / 32; kt = r % 32; K = 2048; Nsrc = 1024; dst = wt + WT_SSO;
        src0 = p.w_ssd_out + (size_t)l * 2048 * 1024 + nt * 64; src1 = src0 + 32;
      } else if ((r -= n_sso) < n_hgo) {
        nt = r / 16; kt = r % 16; K = 1024; Nsrc = 1024; dst = wt + WT_HGO;
        src0 = p.w_hgrn_out + (size_t)l * 1024 * 1024 + nt * 64; src1 = src0 + 32;
      } else if ((r -= n_hgo) < n_out) {
        nt = r / 16; kt = r % 16; K = 1024; Nsrc = 1024; dst = wt + WT_OUT;
        src0 = p.w_out + (size_t)l * 1024 * 1024 + nt * 64; src1 = src0 + 32;
      } else if ((r -= n_out) < n_w13) {
        nt = r / 16; kt = r % 16; K = 1024; Nsrc = FFN; dst = wt + WT_W13;
        src0 = p.ffn_w1 + (size_t)l * 1024 * FFN + nt * 32; src1 = p.ffn_w3 + (size_t)l * 1024 * FFN + nt * 32;
      } else {
        r -= n_w13;
        nt = r / 44; kt = r % 44; K = 2816; Nsrc = 1024; dst = wt + WT_W2;
        src0 = p.ffn_w2 + (size_t)l * 2816 * 1024 + nt * 64; src1 = src0 + 32;
      }
      __syncthreads();
      {
        int c4 = (tid & 15) * 4;
        const float* s = c4 < 32 ? src0 + c4 : src1 + (c4 - 32);
#pragma unroll
        for (int i = 0; i < 4; ++i) {
          int kr = (tid >> 4) + i * 16;
          float4 v = zero ? make_float4(0.f, 0.f, 0.f, 0.f) : *(const float4*)(s + (size_t)(kt * 64 + kr) * Nsrc);
          tile[kr * 65 + c4 + 0] = v.x; tile[kr * 65 + c4 + 1] = v.y; tile[kr * 65 + c4 + 2] = v.z; tile[kr * 65 + c4 + 3] = v.w;
        }
      }
      __syncthreads();
#pragma unroll
      for (int i = 0; i < 2; ++i) {
        int cidx = tid + i * 256, n = cidx >> 3, kc = cidx & 7;
        uint4 o;
        o.x = pack2(tile[(kc * 8 + 0) * 65 + n], tile[(kc * 8 + 1) * 65 + n]);
        o.y = pack2(tile[(kc * 8 + 2) * 65 + n], tile[(kc * 8 + 3) * 65 + n]);
        o.z = pack2(tile[(kc * 8 + 4) * 65 + n], tile[(kc * 8 + 5) * 65 + n]);
        o.w = pack2(tile[(kc * 8 + 6) * 65 + n], tile[(kc * 8 + 7) * 65 + n]);
        *(uint4*)(dst + (size_t)(nt * 64 + n) * K + kt * 64 + kc * 8) = o;
      }
    }
    __syncthreads();
  }
}

__device__ __forceinline__ void phase_norm(const Params& p, int l, int which) {
  const int lane = tid_opaque() & 63, wv = tid_opaque() >> 6;
  const float* nw = (which == 0 ? p.norm_mix_w : p.norm_ffn_w) + l * 1024;
  const float* modb = (const float*)(p.ws + OFF_MOD) + (size_t)l * 5 * 6144;
  bf16_t* h = (bf16_t*)(p.ws + OFF_H);
  for (int row = blockIdx.x * 4 + wv; row < T; row += gridDim.x * 4) {
    const float* x = p.out + (size_t)row * 1024;
    const float* md = modb + (size_t)mod_row(row) * 6144 + (which == 0 ? 0 : 3072);
    float4 v[4];
    float ss = 0.f;
#pragma unroll
    for (int i = 0; i < 4; ++i) {
      v[i] = *(const float4*)(x + i * 256 + lane * 4);
      ss += v[i].x * v[i].x + v[i].y * v[i].y + v[i].z * v[i].z + v[i].w * v[i].w;
    }
#pragma unroll
    for (int o = 32; o >= 1; o >>= 1) ss += __shfl_xor(ss, o);
    float rstd = rsqrtf(ss * (1.0f / 1024.f) + 1e-6f);
#pragma unroll
    for (int i = 0; i < 4; ++i) {
      int c = i * 256 + lane * 4;
      float4 w = *(const float4*)(nw + c), sh = *(const float4*)(md + c), sc = *(const float4*)(md + 1024 + c);
      float a0 = v[i].x * rstd * w.x * (1.f + sc.x) + sh.x, a1 = v[i].y * rstd * w.y * (1.f + sc.y) + sh.y;
      float a2 = v[i].z * rstd * w.z * (1.f + sc.z) + sh.z, a3 = v[i].w * rstd * w.w * (1.f + sc.w) + sh.w;
      uint2 o2; o2.x = pack2(a0, a1); o2.y = pack2(a2, a3);
      *(uint2*)(h + (size_t)row * 1024 + c) = o2;
    }
  }
}

__device__ __forceinline__ void phase_final_norm(const Params& p) {
  const int lane = tid_opaque() & 63, wv = tid_opaque() >> 6;
  for (int row = blockIdx.x * 4 + wv; row < T; row += gridDim.x * 4) {
    float* x = p.out + (size_t)row * 1024;
    float4 v[4];
    float ss = 0.f;
#pragma unroll
    for (int i = 0; i < 4; ++i) {
      v[i] = *(const float4*)(x + i * 256 + lane * 4);
      ss += v[i].x * v[i].x + v[i].y * v[i].y + v[i].z * v[i].z + v[i].w * v[i].w;
    }
#pragma unroll
    for (int o = 32; o >= 1; o >>= 1) ss += __shfl_xor(ss, o);
    float rstd = rsqrtf(ss * (1.0f / 1024.f) + 1e-6f);
#pragma unroll
    for (int i = 0; i < 4; ++i) {
      int c = i * 256 + lane * 4;
      float4 w = *(const float4*)(p.norm_final_w + c);
      float4 o4 = make_float4(v[i].x * rstd * w.x, v[i].y * rstd * w.y, v[i].z * rstd * w.z, v[i].w * rstd * w.w);
      *(float4*)(x + c) = o4;
    }
  }
}

template <bool HASMID>
__device__ __forceinline__ void gemm_kloop2(f32x4 (&acc)[4][4], const bf16_t* __restrict__ Ag, int lda, const bf16_t* __restrict__ Bg,
                                            int ldb, int K, const bf16_t* __restrict__ Ag2, int lda2, const bf16_t* __restrict__ Bg2,
                                            int ldb2, int K2, char* smem, const bf16_t* __restrict__ gate0) {
  const int tid = tid_opaque(), lane = tid & 63, wid = tid >> 6;
  const int wr = wid >> 1, wc = wid & 1, fr = lane & 15, fq = lane >> 4;
  const int srow = tid >> 3, schunk = (tid & 7) ^ ((tid >> 4) & 7);
  const int rofs0 = (fq ^ ((fr >> 1) & 7)) * 16;
  const bf16_t* ap = Ag + (size_t)srow * lda + schunk * 8;
  const bf16_t* bp = Bg + (size_t)srow * ldb + schunk * 8;
  const int nk1 = K >> 6;
  const int nk = nk1 + (K2 >> 6);
  char* const sdst = smem + tid * 16;
#define GK_DMA(buf, t)                                                                                                   \
  {                                                                                                                      \
    _Pragma("unroll") for (int i = 0; i < 4; ++i) {                                                                      \
      __builtin_amdgcn_global_load_lds((const unsigned*)(ap + (size_t)i * 32 * lda + (size_t)(t) * 64),                  \
                                       (unsigned*)(sdst + (buf) * LDS_TILE + i * 4096), 16, 0, 0);                       \
      __builtin_amdgcn_global_load_lds((const unsigned*)(bp + (size_t)i * 32 * ldb + (size_t)(t) * 64),                  \
                                       (unsigned*)(sdst + (2 + (buf)) * LDS_TILE + i * 4096), 16, 0, 0);                 \
    }                                                                                                                    \
  }
  GK_DMA(0, 0);
  __syncthreads();
  for (int kt = 0; kt < nk; ++kt) {
    const int cur = kt & 1;
    if (kt + 1 < nk) {
      if (kt + 1 == nk1) {
        ap = Ag2 + (size_t)srow * lda2 + schunk * 8 - (size_t)nk1 * 64;
        bp = Bg2 + (size_t)srow * ldb2 + schunk * 8 - (size_t)nk1 * 64;
        lda = lda2; ldb = ldb2;
      }
      GK_DMA(cur ^ 1, kt + 1);
    }
    if (HASMID && kt == nk1) {
#pragma unroll
      for (int m = 0; m < 4; ++m)
#pragma unroll
        for (int n = 0; n < 4; ++n) {
          uint2 g1 = *(const uint2*)(gate0 + (size_t)(m * 16) * NPROJ_PAD + n * 16);
          uint2 g2 = *(const uint2*)(gate0 + (size_t)(m * 16) * NPROJ_PAD + 1024 + n * 16);
          acc[m][n][0] *= gate_ratio(bf2f((bf16_t)(g1.x & 0xffff)), bf2f((bf16_t)(g2.x & 0xffff)));
          acc[m][n][1] *= gate_ratio(bf2f((bf16_t)(g1.x >> 16)), bf2f((bf16_t)(g2.x >> 16)));
          acc[m][n][2] *= gate_ratio(bf2f((bf16_t)(g1.y & 0xffff)), bf2f((bf16_t)(g2.y & 0xffff)));
          acc[m][n][3] *= gate_ratio(bf2f((bf16_t)(g1.y >> 16)), bf2f((bf16_t)(g2.y >> 16)));
        }
    }
    const char* sa = smem + cur * LDS_TILE + (wr * 64 + fr) * LDS_ROW;
    const char* sb = smem + (2 + cur) * LDS_TILE + (wc * 64 + fr) * LDS_ROW;
#pragma unroll
    for (int kk = 0; kk < 2; ++kk) {
      bf16x8 af[4], bfv[4];
      __builtin_amdgcn_sched_barrier(0);
#pragma unroll
      for (int m = 0; m < 4; ++m) af[m] = *(const bf16x8*)(sa + m * 16 * LDS_ROW + (rofs0 ^ (kk * 64)));
#pragma unroll
      for (int n = 0; n < 4; ++n) bfv[n] = *(const bf16x8*)(sb + n * 16 * LDS_ROW + (rofs0 ^ (kk * 64)));
      __builtin_amdgcn_sched_barrier(0);
#pragma unroll
      for (int m = 0; m < 4; ++m)
#pragma unroll
        for (int n = 0; n < 4; ++n) acc[m][n] = __builtin_amdgcn_mfma_f32_16x16x32_bf16(bfv[n], af[m], acc[m][n], 0, 0, 0);
    }
    __builtin_amdgcn_sched_barrier(0);
    __syncthreads();
  }
#undef GK_DMA
}

__device__ __forceinline__ void gemm_kloop(f32x4 (&acc)[4][4], const bf16_t* __restrict__ Ag, int lda, const bf16_t* __restrict__ Bg,
                                           int ldb, int K, char* smem) {
  gemm_kloop2<false>(acc, Ag, lda, Bg, ldb, K, Ag, lda, Bg, ldb, 0, smem, Ag);
}
enum { G_PROJ = 0, G_MERGE = 1, G_OUT = 2, G_FFN1 = 3, G_FFN2 = 4 };

template <int MODE>
__device__ __forceinline__ void phase_gemm(const Params& p, int l, char* smem) {
  const int tid = tid_opaque(), lane = tid & 63, wid = tid >> 6;
  const int wr = wid >> 1, wc = wid & 1, fr = lane & 15, fq = lane >> 4;
  const bf16_t* wt = (const bf16_t*)(p.ws + OFF_WT) + (size_t)l * WT_LAYER;
  const bf16_t* hbuf = (const bf16_t*)(p.ws + OFF_H);
  bf16_t* proj = (bf16_t*)(p.ws + OFF_PROJ);
  bf16_t* hidden = (bf16_t*)(p.ws + OFF_PROJ);
  const float* modb = (const float*)(p.ws + OFF_MOD) + (size_t)l * 5 * 6144;
  constexpr int nM = T / 128;
  constexpr int nN = MODE == G_PROJ ? NPROJ_PAD / 128 : (MODE == G_FFN1 ? 5632 / 128 : 1024 / 128);
  for (int t = blockIdx.x; t < nM * nN; t += gridDim.x) {
    const int pm = t % nM, pn = t / nM;
    const int row0 = pm * 128, col0 = pn * 128;
    f32x4 acc[4][4];
#pragma unroll
    for (int m = 0; m < 4; ++m)
#pragma unroll
      for (int n = 0; n < 4; ++n) acc[m][n] = (f32x4){0.f, 0.f, 0.f, 0.f};
    if (MODE == G_PROJ) {
      gemm_kloop(acc, hbuf + (size_t)row0 * 1024, 1024, wt + WT_IN + (size_t)col0 * 1024, 1024, 1024, smem);
      float* dtraw = (float*)(p.ws + OFF_DTRAW);
#pragma unroll
      for (int m = 0; m < 4; ++m) {
        const int row = row0 + wr * 64 + m * 16 + fr;
#pragma unroll
        for (int n = 0; n < 4; ++n) {
          const int col = col0 + wc * 64 + n * 16 + fq * 4;
          uint2 o; o.x = pack2(acc[m][n][0], acc[m][n][1]); o.y = pack2(acc[m][n][2], acc[m][n][3]);
          *(uint2*)(proj + (size_t)row * NPROJ_PAD + col) = o;
          if (col >= C_DT && col < C_DT + 64) *(f32x4*)(dtraw + (size_t)row * 64 + (col - C_DT)) = acc[m][n];
        }
      }
    } else if (MODE == G_MERGE) {
      const bf16_t* ybuf = (const bf16_t*)(p.ws + OFF_YBUF);
      const bf16_t* obuf = (const bf16_t*)(p.ws + OFF_OBUF);
      bf16_t* mbuf = (bf16_t*)(p.ws + OFF_MBUF);
      gemm_kloop2<true>(acc, ybuf + (size_t)row0 * 2048, 2048, wt + WT_SSO + (size_t)col0 * 2048, 2048, 2048,
                        obuf + (size_t)row0 * 1024, 1024, wt + WT_HGO + (size_t)col0 * 1024, 1024, 1024, smem,
                        proj + (size_t)(row0 + wr * 64 + fr) * NPROJ_PAD + C_GATE + col0 + wc * 64 + fq * 4);
#pragma unroll
      for (int m = 0; m < 4; ++m) {
        const int row = row0 + wr * 64 + m * 16 + fr;
#pragma unroll
        for (int n = 0; n < 4; ++n) {
          const int col = col0 + wc * 64 + n * 16 + fq * 4;
          uint2 g = *(const uint2*)(proj + (size_t)row * NPROJ_PAD + C_GATE + 1024 + col);
          float r0 = acc[m][n][0] * sigmoidf_(clamp30(bf2f((bf16_t)(g.x & 0xffff))));
          float r1 = acc[m][n][1] * sigmoidf_(clamp30(bf2f((bf16_t)(g.x >> 16))));
          float r2 = acc[m][n][2] * sigmoidf_(clamp30(bf2f((bf16_t)(g.y & 0xffff))));
          float r3 = acc[m][n][3] * sigmoidf_(clamp30(bf2f((bf16_t)(g.y >> 16))));
          uint2 o; o.x = pack2(r0, r1); o.y = pack2(r2, r3);
          *(uint2*)(mbuf + (size_t)row * 1024 + col) = o;
        }
      }
    } else if (MODE == G_OUT || MODE == G_FFN2) {
      if (MODE == G_OUT) {
        const bf16_t* mbuf = (const bf16_t*)(p.ws + OFF_MBUF);
        gemm_kloop(acc, mbuf + (size_t)row0 * 1024, 1024, wt + WT_OUT + (size_t)col0 * 1024, 1024, 1024, smem);
      } else {
        gemm_kloop(acc, hidden + (size_t)row0 * FFN, FFN, wt + WT_W2 + (size_t)col0 * FFN, FFN, FFN, smem);
      }
      const float* gate = modb + (size_t)mod_row(row0) * 6144 + (MODE == G_OUT ? 2048 : 5120);
#pragma unroll
      for (int m = 0; m < 4; ++m) {
        const int row = row0 + wr * 64 + m * 16 + fr;
#pragma unroll
        for (int n = 0; n < 4; ++n) {
          const int col = col0 + wc * 64 + n * 16 + fq * 4;
          f32x4 g = *(const f32x4*)(gate + col);
          f32x4* xp = (f32x4*)(p.out + (size_t)row * 1024 + col);
          f32x4 xv = *xp;
          xv += g * acc[m][n];
          *xp = xv;
        }
      }
    } else {
      gemm_kloop(acc, hbuf + (size_t)row0 * 1024, 1024, wt + WT_W13 + (size_t)col0 * 1024, 1024, 1024, smem);
#pragma unroll
      for (int m = 0; m < 4; ++m) {
        const int row = row0 + wr * 64 + m * 16 + fr;
#pragma unroll
        for (int n = 0; n < 2; ++n) {
          const int hcol = (pn * 2 + wc) * 32 + n * 16 + fq * 4;
          float r[4];
#pragma unroll
          for (int j = 0; j < 4; ++j) r[j] = siluf_(acc[m][n][j]) * acc[m][n + 2][j];
          uint2 o; o.x = pack2(r[0], r[1]); o.y = pack2(r[2], r[3]);
          *(uint2*)(hidden + (size_t)row * FFN + hcol) = o;
        }
      }
    }
  }
}

__device__ __forceinline__ void phase_conv(const Params& p, int l) {
  const bf16_t* proj = (const bf16_t*)(p.ws + OFF_PROJ);
  bf16_t* xc = (bf16_t*)(p.ws + OFF_XC);
  const float* cw = p.ssd_conv_w + (size_t)l * 5 * 4096;
  const float* cb = p.ssd_conv_b + (size_t)l * 4096;
  const size_t total = (size_t)T * 512;
  for (size_t i = (size_t)blockIdx.x * 256 + tid_opaque(); i < total; i += (size_t)gridDim.x * 256) {
    const int tok = (int)(i >> 9), ch = (int)(i & 511) * 8;
    int pos, len;
    if (tok < TCTX) { pos = tok & 255; len = 256; } else { pos = (tok - TCTX) & 63; len = 64; }
    float a[8];
#pragma unroll
    for (int j = 0; j < 8; ++j) a[j] = cb[ch + j];
#pragma unroll
    for (int k = 0; k < 5; ++k) {
      const int q = pos + k - 2;
      if (q >= 0 && q < len) {
        uint4 v = *(const uint4*)(proj + (size_t)(tok + k - 2) * NPROJ_PAD + ch);
        const float* w = cw + k * 4096 + ch;
        a[0] += w[0] * bf2f((bf16_t)(v.x & 0xffff)); a[1] += w[1] * bf2f((bf16_t)(v.x >> 16));
        a[2] += w[2] * bf2f((bf16_t)(v.y & 0xffff)); a[3] += w[3] * bf2f((bf16_t)(v.y >> 16));
        a[4] += w[4] * bf2f((bf16_t)(v.z & 0xffff)); a[5] += w[5] * bf2f((bf16_t)(v.z >> 16));
        a[6] += w[6] * bf2f((bf16_t)(v.w & 0xffff)); a[7] += w[7] * bf2f((bf16_t)(v.w >> 16));
      }
    }
    uint4 o;
    o.x = pack2(siluf_(a[0]), siluf_(a[1])); o.y = pack2(siluf_(a[2]), siluf_(a[3]));
    o.z = pack2(siluf_(a[4]), siluf_(a[5])); o.w = pack2(siluf_(a[6]), siluf_(a[7]));
    *(uint4*)(xc + (size_t)tok * 4096 + ch) = o;
  }
  const float* dtraw = (const float*)(p.ws + OFF_DTRAW);
  float* dt = (float*)(p.ws + OFF_DT);
  for (size_t i = (size_t)blockIdx.x * 256 + tid_opaque(); i < (size_t)T * 64; i += (size_t)gridDim.x * 256) {
    float v = dtraw[i] + p.ssd_dt_bias[l * 64 + (int)(i & 63)];
    dt[i] = v > 20.f ? v : log1pf(expf(v));
  }
}

__device__ __forceinline__ void ssd_naive_item(const Params& p, int l, int item, float* sm) {
  const int d = item & 1, h = (item >> 1) & 31, s = item >> 6;
  int tok0, L;
  if (s < 32) { tok0 = s * 256; L = 256; } else { tok0 = TCTX + (s - 32) * 2048; L = 2048; }
  const int tid = tid_opaque(), pp = tid >> 2, nq = tid & 3, g = h >> 2;
  float S[32];
  if (s < 32) {
#pragma unroll
    for (int i = 0; i < 32; ++i) S[i] = 0.f;
  } else {
    const float* st = p.state_ssm + ((((size_t)(s - 32) * 4 + l) * 2 + d) * 32 + h) * 8192 + pp * 128 + nq * 32;
#pragma unroll
    for (int i = 0; i < 32; ++i) S[i] = st[i];
  }
  const float a = -expf(p.ssd_a_log[l * 64 + d * 32 + h]);
  float* xs = sm; float* Bs = sm + 1024; float* Cs = Bs + 2048; float* dts = Cs + 2048;
  const bf16_t* xc = (const bf16_t*)(p.ws + OFF_XC);
  const float* dtb = (const float*)(p.ws + OFF_DT);
  float* ydir = (float*)(p.ws + (d == 0 ? OFF_YF : OFF_YB));
  for (int bt = 0; bt < L / 16; ++bt) {
    const int tb = d == 0 ? bt * 16 : L - 16 - bt * 16;
    __syncthreads();
    for (int e = tid; e < 16 * 320; e += 256) {
      const int tt = e / 320, c = e % 320;
      const size_t base = (size_t)(tok0 + tb + tt) * 4096;
      if (c < 64) xs[tt * 64 + c] = bf2f(xc[base + h * 64 + c]);
      else if (c < 192) Bs[tt * 128 + c - 64] = bf2f(xc[base + 2048 + g * 128 + c - 64]);
      else Cs[tt * 128 + c - 192] = bf2f(xc[base + 3072 + g * 128 + c - 192]);
    }
    if (tid < 16) dts[tid] = dtb[(size_t)(tok0 + tb + tid) * 64 + d * 32 + h];
    __syncthreads();
    for (int i2 = 0; i2 < 16; ++i2) {
      const int tt = d == 0 ? i2 : 15 - i2;
      const float dt = dts[tt], dA = expf(dt * a), xdt = xs[tt * 64 + pp] * dt;
      float acc = 0.f;
      const float* Bp = Bs + tt * 128 + nq * 32;
      const float* Cp = Cs + tt * 128 + nq * 32;
#pragma unroll
      for (int i = 0; i < 32; ++i) { S[i] = dA * S[i] + xdt * Bp[i]; acc += S[i] * Cp[i]; }
      acc += __shfl_xor(acc, 1); acc += __shfl_xor(acc, 2);
      if (nq == 0) ydir[(size_t)(tok0 + tb + tt) * 2048 + h * 64 + pp] = acc;
    }
  }
  if (s < 32) {
    float* o = p.out + OUT_SSM + ((((size_t)s * 4 + l) * 2 + d) * 32 + h) * 8192 + pp * 128 + nq * 32;
#pragma unroll
    for (int i = 0; i < 32; ++i) o[i] = S[i];
  }
}

__device__ __forceinline__ void hgrn_naive_item(const Params& p, int l, int item, float* sm) {
  const int d = item & 1, hd = (item >> 1) & 7, s = item >> 4;
  int tok0, L;
  if (s < 32) { tok0 = s * 256; L = 256; } else { tok0 = TCTX + (s - 32) * 2048; L = 2048; }
  const int tid = tid_opaque(), vv = tid >> 1, kh = tid & 1;
  float S[64];
  if (s < 32) {
#pragma unroll
    for (int i = 0; i < 64; ++i) S[i] = 0.f;
  } else {
    const float* st = p.state_hgrn + ((((size_t)(s - 32) * 4 + l) * 2 + d) * 8 + hd) * 16384 + (size_t)(kh * 64) * 128 + vv;
#pragma unroll
    for (int i = 0; i < 64; ++i) S[i] = st[(size_t)i * 128];
  }
  float* qs = sm; float* fs = sm + 2048; float* ks = sm + 4096; float* vs = sm + 6144;
  const bf16_t* proj = (const bf16_t*)(p.ws + OFF_PROJ);
  const float* lb = (const float*)(p.ws + OFF_LB) + (size_t)l * 2048 + d * 1024 + hd * 128;
  float* odir = (float*)(p.ws + (d == 0 ? OFF_OF : OFF_OB));
  for (int bt = 0; bt < L / 16; ++bt) {
    const int tb = d == 0 ? bt * 16 : L - 16 - bt * 16;
    __syncthreads();
    for (int e = tid; e < 16 * 128; e += 256) {
      const int tt = e >> 7, c = e & 127;
      const size_t base = (size_t)(tok0 + tb + tt) * NPROJ_PAD;
      const float q = bf2f(proj[base + C_HQ + hd * 128 + c]);
      const float u = bf2f(proj[base + C_HF + d * 1024 + hd * 128 + c]);
      const float lbv = lb[c];
      const float sg = sigmoidf_(u);
      qs[e] = siluf_(q);
      fs[e] = lbv + (1.f - lbv) * sg;
      ks[e] = (1.f - lbv) * (1.f - sg);
      vs[e] = bf2f(proj[base + C_HI + hd * 128 + c]);
    }
    __syncthreads();
    for (int i2 = 0; i2 < 16; ++i2) {
      const int tt = d == 0 ? i2 : 15 - i2;
      const float vval = vs[tt * 128 + vv];
      const float* fp = fs + tt * 128 + kh * 64;
      const float* kp = ks + tt * 128 + kh * 64;
      const float* qp = qs + tt * 128 + kh * 64;
      float acc = 0.f;
#pragma unroll
      for (int i = 0; i < 64; ++i) { S[i] = fp[i] * S[i] + kp[i] * vval; acc += S[i] * qp[i]; }
      acc += __shfl_xor(acc, 1);
      if (kh == 0) odir[(size_t)(tok0 + tb + tt) * 1024 + hd * 128 + vv] = acc;
    }
  }
  if (s < 32) {
    float* o = p.out + OUT_HGRN + ((((size_t)s * 4 + l) * 2 + d) * 8 + hd) * 16384 + (size_t)(kh * 64) * 128 + vv;
#pragma unroll
    for (int i = 0; i < 64; ++i) o[(size_t)i * 128] = S[i];
  }
}


constexpr int HG_ROW = 272;
constexpr int HG_IMG = 16 * HG_ROW;
constexpr int HG_BUF = 4 * HG_IMG + 512;
__device__ __forceinline__ void hgrn_chunk_item(const Params& p, int l, int item, char* smem) {
  const int d = item & 1, hd = (item >> 1) & 7, s = item >> 4;
  int tok0, L;
  if (s < 32) { tok0 = s * 256; L = 256; } else { tok0 = TCTX + (s - 32) * 2048; L = 2048; }
  const int tid = tid_opaque(), lane = tid & 63, w = tid >> 6, fr = lane & 15, fq = lane >> 4;
  const int ch = tid & 127, half = tid >> 7;
  f32x4 S[8][2];
  if (s < 32) {
#pragma unroll
    for (int kt = 0; kt < 8; ++kt) { S[kt][0] = (f32x4){0.f, 0.f, 0.f, 0.f}; S[kt][1] = (f32x4){0.f, 0.f, 0.f, 0.f}; }
  } else {
    const float* st = p.state_hgrn + ((((size_t)(s - 32) * 4 + l) * 2 + d) * 8 + hd) * 16384;
#pragma unroll
    for (int kt = 0; kt < 8; ++kt)
#pragma unroll
      for (int vt = 0; vt < 2; ++vt)
#pragma unroll
        for (int jj = 0; jj < 4; ++jj) S[kt][vt][jj] = st[(size_t)(16 * kt + fq * 4 + jj) * 128 + 32 * w + 16 * vt + fr];
  }
  const float lbv = ((const float*)(p.ws + OFF_LB))[(size_t)l * 2048 + d * 1024 + hd * 128 + ch];
  const bf16_t* proj = (const bf16_t*)(p.ws + OFF_PROJ);
  float* odir = (float*)(p.ws + (d == 0 ? OFF_OF : OFF_OB));
  float* xch = (float*)(smem + 2 * HG_BUF);
  const int nch = L >> 4;
  bf16_t rq[8], ru[8], rv[8];
  __syncthreads();
  {
#pragma unroll
    for (int i = 0; i < 8; ++i) {
      const int pos = 8 * half + i;
      const size_t tk = (size_t)(d == 0 ? tok0 + pos : tok0 + L - 1 - pos) * NPROJ_PAD;
      rq[i] = proj[tk + C_HQ + hd * 128 + ch];
      ru[i] = proj[tk + C_HF + d * 1024 + hd * 128 + ch];
      rv[i] = proj[tk + C_HI + hd * 128 + ch];
    }
  }
  for (int c = 0; c < nch; ++c) {
    char* buf = smem + (c & 1) * HG_BUF;
    float* xc_ = xch + (c & 1) * 256;
    float fv[8], kk[8], qs[8];
    float loc = 1.f;
#pragma unroll
    for (int i = 0; i < 8; ++i) {
      const float u = bf2f(ru[i]);
      const float sg = sigmoidf_(u);
      fv[i] = lbv + (1.f - lbv) * sg;
      kk[i] = (1.f - lbv) * (1.f - sg);
      qs[i] = siluf_(bf2f(rq[i]));
      loc *= fv[i];
      *(bf16_t*)(buf + 3 * HG_IMG + (8 * half + i) * HG_ROW + ch * 2) = rv[i];
    }
    xc_[half * 128 + ch] = loc;
    if (c + 1 < nch) {
#pragma unroll
      for (int i = 0; i < 8; ++i) {
        const int pos = (c + 1) * 16 + 8 * half + i;
        const size_t tk = (size_t)(d == 0 ? tok0 + pos : tok0 + L - 1 - pos) * NPROJ_PAD;
        rq[i] = proj[tk + C_HQ + hd * 128 + ch];
        ru[i] = proj[tk + C_HF + d * 1024 + hd * 128 + ch];
        rv[i] = proj[tk + C_HI + hd * 128 + ch];
      }
    }
    __syncthreads();
    {
      const float other = xc_[(half ^ 1) * 128 + ch];
      float P = half ? other : 1.f;
      float sfx = half ? 1.f : other;
      float suf[8];
#pragma unroll
      for (int i = 7; i >= 0; --i) { suf[i] = sfx; sfx *= fv[i]; }
#pragma unroll
      for (int i = 0; i < 8; ++i) {
        P *= fv[i];
        const int off = (8 * half + i) * HG_ROW + ch * 2;
        *(bf16_t*)(buf + off) = f2bf(qs[i] * P);
        *(bf16_t*)(buf + HG_IMG + off) = f2bf(kk[i] * __builtin_amdgcn_rcpf(fmaxf(P, 1e-30f)));
        *(bf16_t*)(buf + 2 * HG_IMG + off) = f2bf(kk[i] * suf[i]);
      }
      if (half) ((float*)(buf + 4 * HG_IMG))[ch] = P;
    }
    __syncthreads();
    const char* qtI = buf;
    const char* ktI = buf + HG_IMG;
    const float* dec = (const float*)(buf + 4 * HG_IMG);
    f32x4 at = (f32x4){0.f, 0.f, 0.f, 0.f};
#pragma unroll
    for (int ks = 0; ks < 4; ++ks) {
      bf16x8 a = *(const bf16x8*)(ktI + fr * HG_ROW + (32 * ks + fq * 8) * 2);
      bf16x8 b = *(const bf16x8*)(qtI + fr * HG_ROW + (32 * ks + fq * 8) * 2);
      at = __builtin_amdgcn_mfma_f32_16x16x32_bf16(a, b, at, 0, 0, 0);
    }
    s16x4 Pm;
    {
      u32x2 pk;
      pk[0] = pack2((fq * 4 + 0 <= fr) ? at[0] : 0.f, (fq * 4 + 1 <= fr) ? at[1] : 0.f);
      pk[1] = pack2((fq * 4 + 2 <= fr) ? at[2] : 0.f, (fq * 4 + 3 <= fr) ? at[3] : 0.f);
      Pm = __builtin_bit_cast(s16x4, pk);
    }
    const unsigned ldsb = (unsigned)(size_t)buf;
    const unsigned vaddr = ldsb + 3 * HG_IMG + (4 * fq + (fr >> 2)) * HG_ROW + (32 * w + 4 * (fr & 3)) * 2;
    const unsigned kaddr = ldsb + 2 * HG_IMG + (4 * fq + (fr >> 2)) * HG_ROW + (4 * (fr & 3)) * 2;
    s16x4 vf0, vf1, kf0, kf1, kf2, kf3, kf4, kf5, kf6, kf7;
    asm volatile(
        "ds_read_b64_tr_b16 %0, %10\n\t"
        "ds_read_b64_tr_b16 %1, %10 offset:32\n\t"
        "ds_read_b64_tr_b16 %2, %11\n\t"
        "ds_read_b64_tr_b16 %3, %11 offset:32\n\t"
        "ds_read_b64_tr_b16 %4, %11 offset:64\n\t"
        "ds_read_b64_tr_b16 %5, %11 offset:96\n\t"
        "ds_read_b64_tr_b16 %6, %11 offset:128\n\t"
        "ds_read_b64_tr_b16 %7, %11 offset:160\n\t"
        "ds_read_b64_tr_b16 %8, %11 offset:192\n\t"
        "ds_read_b64_tr_b16 %9, %11 offset:224\n\t"
        "s_waitcnt lgkmcnt(0)"
        : "=&v"(vf0), "=&v"(vf1), "=&v"(kf0), "=&v"(kf1), "=&v"(kf2), "=&v"(kf3), "=&v"(kf4), "=&v"(kf5), "=&v"(kf6), "=&v"(kf7)
        : "v"(vaddr), "v"(kaddr)
        : "memory");
    f32x4 o0 = __builtin_amdgcn_mfma_f32_16x16x16bf16_1k(Pm, vf0, (f32x4){0.f, 0.f, 0.f, 0.f}, 0, 0, 0);
    f32x4 o1 = __builtin_amdgcn_mfma_f32_16x16x16bf16_1k(Pm, vf1, (f32x4){0.f, 0.f, 0.f, 0.f}, 0, 0, 0);
#pragma unroll
    for (int ks = 0; ks < 4; ++ks) {
      u32x2 qa = *(const u32x2*)(qtI + fr * HG_ROW + (32 * ks + 4 * fq) * 2);
      u32x2 qb = *(const u32x2*)(qtI + fr * HG_ROW + (32 * ks + 16 + 4 * fq) * 2);
      u32x4 aa; aa[0] = qa[0]; aa[1] = qa[1]; aa[2] = qb[0]; aa[3] = qb[1];
      const bf16x8 A = __builtin_bit_cast(bf16x8, aa);
      u32x4 b0, b1;
      b0[0] = pack2(S[2 * ks][0][0], S[2 * ks][0][1]); b0[1] = pack2(S[2 * ks][0][2], S[2 * ks][0][3]);
      b0[2] = pack2(S[2 * ks + 1][0][0], S[2 * ks + 1][0][1]); b0[3] = pack2(S[2 * ks + 1][0][2], S[2 * ks + 1][0][3]);
      b1[0] = pack2(S[2 * ks][1][0], S[2 * ks][1][1]); b1[1] = pack2(S[2 * ks][1][2], S[2 * ks][1][3]);
      b1[2] = pack2(S[2 * ks + 1][1][0], S[2 * ks + 1][1][1]); b1[3] = pack2(S[2 * ks + 1][1][2], S[2 * ks + 1][1][3]);
      o0 = __builtin_amdgcn_mfma_f32_16x16x32_bf16(A, __builtin_bit_cast(bf16x8, b0), o0, 0, 0, 0);
      o1 = __builtin_amdgcn_mfma_f32_16x16x32_bf16(A, __builtin_bit_cast(bf16x8, b1), o1, 0, 0, 0);
    }
#pragma unroll
    for (int jj = 0; jj < 4; ++jj) {
      const int pos = c * 16 + fq * 4 + jj;
      const size_t tk = (size_t)(d == 0 ? tok0 + pos : tok0 + L - 1 - pos);
      odir[tk * 1024 + hd * 128 + 32 * w + fr] = o0[jj];
      odir[tk * 1024 + hd * 128 + 32 * w + 16 + fr] = o1[jj];
    }
    const s16x4 kfs[8] = {kf0, kf1, kf2, kf3, kf4, kf5, kf6, kf7};
#pragma unroll
    for (int kt = 0; kt < 8; ++kt) {
      const f32x4 dv = *(const f32x4*)(dec + 16 * kt + fq * 4);
      S[kt][0] = __builtin_amdgcn_mfma_f32_16x16x16bf16_1k(kfs[kt], vf0, S[kt][0] * dv, 0, 0, 0);
      S[kt][1] = __builtin_amdgcn_mfma_f32_16x16x16bf16_1k(kfs[kt], vf1, S[kt][1] * dv, 0, 0, 0);
    }
  }
  if (s < 32) {
    float* o = p.out + OUT_HGRN + ((((size_t)s * 4 + l) * 2 + d) * 8 + hd) * 16384;
#pragma unroll
    for (int kt = 0; kt < 8; ++kt)
#pragma unroll
      for (int vt = 0; vt < 2; ++vt)
#pragma unroll
        for (int jj = 0; jj < 4; ++jj) o[(size_t)(16 * kt + fq * 4 + jj) * 128 + 32 * w + 16 * vt + fr] = S[kt][vt][jj];
  }
}


constexpr size_t OFF_SST = OFF_YF;
constexpr size_t OFF_CS = OFF_YB;
constexpr int SS_BROW = 272, SS_XROW = 144;
constexpr int SS_R0 = 128 * SS_BROW;
constexpr int SS_R1 = 128 * SS_XROW;

template <int OFF>
__device__ __forceinline__ s16x4 tr_read(unsigned addr) {
  s16x4 r;
  asm volatile("ds_read_b64_tr_b16 %0, %1 offset:%2" : "=v"(r) : "v"(addr), "i"(OFF) : "memory");
  return r;
}
__device__ __forceinline__ bf16x8 cat8(s16x4 a, s16x4 b) {
  bf16x8 r;
  r[0] = a[0]; r[1] = a[1]; r[2] = a[2]; r[3] = a[3]; r[4] = b[0]; r[5] = b[1]; r[6] = b[2]; r[7] = b[3];
  return r;
}
#define TR_WAIT12(a, b, c, d, e, f, g, h, i, j, k, l_)                                                                            \
  asm volatile("s_waitcnt lgkmcnt(0)" : "+v"(a), "+v"(b), "+v"(c), "+v"(d), "+v"(e), "+v"(f), "+v"(g), "+v"(h), "+v"(i), "+v"(j), \
               "+v"(k), "+v"(l_)::"memory")
#define TR_WAIT8(a, b, c, d, e, f, g, h) \
  asm volatile("s_waitcnt lgkmcnt(0)" : "+v"(a), "+v"(b), "+v"(c), "+v"(d), "+v"(e), "+v"(f), "+v"(g), "+v"(h)::"memory")

template <int KS>
__device__ __forceinline__ void ssd_p1_kstep(f32x4 (&acc)[2][4], unsigned abase, unsigned xbase) {
  s16x4 a00 = tr_read<KS * 32 * SS_BROW>(abase), a01 = tr_read<KS * 32 * SS_BROW + 4 * SS_BROW>(abase);
  s16x4 a10 = tr_read<KS * 32 * SS_BROW + 32>(abase), a11 = tr_read<KS * 32 * SS_BROW + 4 * SS_BROW + 32>(abase);
  s16x4 b00 = tr_read<KS * 32 * SS_XROW>(xbase), b01 = tr_read<KS * 32 * SS_XROW + 4 * SS_XROW>(xbase);
  s16x4 b10 = tr_read<KS * 32 * SS_XROW + 32>(xbase), b11 = tr_read<KS * 32 * SS_XROW + 4 * SS_XROW + 32>(xbase);
  s16x4 b20 = tr_read<KS * 32 * SS_XROW + 64>(xbase), b21 = tr_read<KS * 32 * SS_XROW + 4 * SS_XROW + 64>(xbase);
  s16x4 b30 = tr_read<KS * 32 * SS_XROW + 96>(xbase), b31 = tr_read<KS * 32 * SS_XROW + 4 * SS_XROW + 96>(xbase);
  TR_WAIT12(a00, a01, a10, a11, b00, b01, b10, b11, b20, b21, b30, b31);
  const bf16x8 A0 = cat8(a00, a01), A1 = cat8(a10, a11);
  const bf16x8 B0 = cat8(b00, b01), B1 = cat8(b10, b11), B2 = cat8(b20, b21), B3 = cat8(b30, b31);
  acc[0][0] = __builtin_amdgcn_mfma_f32_16x16x32_bf16(A0, B0, acc[0][0], 0, 0, 0);
  acc[0][1] = __builtin_amdgcn_mfma_f32_16x16x32_bf16(A0, B1, acc[0][1], 0, 0, 0);
  acc[0][2] = __builtin_amdgcn_mfma_f32_16x16x32_bf16(A0, B2, acc[0][2], 0, 0, 0);
  acc[0][3] = __builtin_amdgcn_mfma_f32_16x16x32_bf16(A0, B3, acc[0][3], 0, 0, 0);
  acc[1][0] = __builtin_amdgcn_mfma_f32_16x16x32_bf16(A1, B0, acc[1][0], 0, 0, 0);
  acc[1][1] = __builtin_amdgcn_mfma_f32_16x16x32_bf16(A1, B1, acc[1][1], 0, 0, 0);
  acc[1][2] = __builtin_amdgcn_mfma_f32_16x16x32_bf16(A1, B2, acc[1][2], 0, 0, 0);
  acc[1][3] = __builtin_amdgcn_mfma_f32_16x16x32_bf16(A1, B3, acc[1][3], 0, 0, 0);
}

__device__ __forceinline__ void ssd_pass1_item(const Params& p, int l, int item, char* smem) {
  const int d = item & 1, h = (item >> 1) & 31, s = item >> 6, g = h >> 2;
  const int nc = s < 32 ? 2 : 16, cg0 = s < 32 ? 2 * s : 64 + 16 * (s - 32);
  const int tid = tid_opaque(), lane = tid & 63, w = tid >> 6, fr = lane & 15, fq = lane >> 4;
  const float a = -expf(p.ssd_a_log[l * 64 + d * 32 + h]);
  f32x4 acc[2][4];
  if (s < 32) {
#pragma unroll
    for (int i = 0; i < 2; ++i)
#pragma unroll
      for (int j = 0; j < 4; ++j) acc[i][j] = (f32x4){0.f, 0.f, 0.f, 0.f};
  } else {
    const float* st = p.state_ssm + ((((size_t)(s - 32) * 4 + l) * 2 + d) * 32 + h) * 8192;
#pragma unroll
    for (int i = 0; i < 2; ++i)
#pragma unroll
      for (int j = 0; j < 4; ++j) acc[i][j] = *(const f32x4*)(st + (size_t)(16 * j + fr) * 128 + 32 * w + 16 * i + 4 * fq);
  }
  const bf16_t* xc = (const bf16_t*)(p.ws + OFF_XC);
  const float* dtb = (const float*)(p.ws + OFF_DT);
  float* csb = (float*)(p.ws + OFF_CS);
  bf16_t* sst = (bf16_t*)(p.ws + OFF_SST);
  float* wgt = (float*)(smem + SS_R0 + SS_R1);
  u32x4 pb[8], px[4];
  float dt0, dt1;
  {
    const int c = d == 0 ? 0 : nc - 1;
    const size_t tb = (size_t)(cg0 + c) * 128;
#pragma unroll
    for (int i = 0; i < 8; ++i) { const int q = tid + 256 * i; pb[i] = *(const u32x4*)(xc + (tb + (q >> 4)) * 4096 + 2048 + g * 128 + (q & 15) * 8); }
#pragma unroll
    for (int i = 0; i < 4; ++i) { const int q = tid + 256 * i; px[i] = *(const u32x4*)(xc + (tb + (q >> 3)) * 4096 + h * 64 + (q & 7) * 8); }
    dt0 = dtb[(tb + 2 * lane) * 64 + d * 32 + h];
    dt1 = dtb[(tb + 2 * lane + 1) * 64 + d * 32 + h];
  }
  const unsigned ldsb = (unsigned)(size_t)smem;
  const unsigned abase = ldsb + (8 * fq + (fr >> 2)) * SS_BROW + (32 * w + 4 * (fr & 3)) * 2;
  const unsigned xbase = ldsb + SS_R0 + (8 * fq + (fr >> 2)) * SS_XROW + (4 * (fr & 3)) * 2;
  for (int cc = 0; cc < nc; ++cc) {
    const int c = d == 0 ? cc : nc - 1 - cc, par = cc & 1;
    const size_t cgl = cg0 + c, tb = cgl * 128;
    {
      bf16_t* so = sst + ((cgl * 32 + h) * 2 + d) * 8192;
#pragma unroll
      for (int i = 0; i < 2; ++i)
#pragma unroll
        for (int j = 0; j < 4; ++j) {
          u32x2 o; o[0] = pack2(acc[i][j][0], acc[i][j][1]); o[1] = pack2(acc[i][j][2], acc[i][j][3]);
          *(u32x2*)(so + (size_t)(16 * j + fr) * 128 + 32 * w + 16 * i + 4 * fq) = o;
        }
    }
    if (w == 0) {
      const float v0 = dt0 * a, v1 = dt1 * a, sloc = v0 + v1;
      float incl = sloc;
#pragma unroll
      for (int off = 1; off < 64; off <<= 1) { const float t = __shfl_up(incl, off); if (lane >= off) incl += t; }
      const float excl = incl - sloc, c0 = excl + v0, tot = __shfl(incl, 63);
      float cs0, cs1, wg0, wg1;
      if (d == 0) { cs0 = c0; cs1 = incl; wg0 = dt0 * __expf(tot - c0); wg1 = dt1 * __expf(tot - incl); }
      else { cs0 = tot - excl; cs1 = tot - c0; wg0 = dt0 * __expf(excl); wg1 = dt1 * __expf(c0); }
      csb[(tb + 2 * lane) * 64 + d * 32 + h] = cs0;
      csb[(tb + 2 * lane + 1) * 64 + d * 32 + h] = cs1;
      wgt[par * 128 + 2 * lane] = wg0;
      wgt[par * 128 + 2 * lane + 1] = wg1;
      if (lane == 0) wgt[256 + par] = __expf(tot);
    }
    __syncthreads();
#pragma unroll
    for (int i = 0; i < 8; ++i) { const int q = tid + 256 * i; *(u32x4*)(smem + (q >> 4) * SS_BROW + (q & 15) * 16) = pb[i]; }
#pragma unroll
    for (int i = 0; i < 4; ++i) {
      const int q = tid + 256 * i, row = q >> 3;
      const float wv = wgt[par * 128 + row];
      u32x4 o;
#pragma unroll
      for (int e = 0; e < 4; ++e) o[e] = pack2(bf2f((bf16_t)(px[i][e] & 0xffff)) * wv, bf2f((bf16_t)(px[i][e] >> 16)) * wv);
      *(u32x4*)(smem + SS_R0 + row * SS_XROW + (q & 7) * 16) = o;
    }
    if (cc + 1 < nc) {
      const int cn = d == 0 ? cc + 1 : nc - 2 - cc;
      const size_t tbn = (size_t)(cg0 + cn) * 128;
#pragma unroll
      for (int i = 0; i < 8; ++i) { const int q = tid + 256 * i; pb[i] = *(const u32x4*)(xc + (tbn + (q >> 4)) * 4096 + 2048 + g * 128 + (q & 15) * 8); }
#pragma unroll
      for (int i = 0; i < 4; ++i) { const int q = tid + 256 * i; px[i] = *(const u32x4*)(xc + (tbn + (q >> 3)) * 4096 + h * 64 + (q & 7) * 8); }
      dt0 = dtb[(tbn + 2 * lane) * 64 + d * 32 + h];
      dt1 = dtb[(tbn + 2 * lane + 1) * 64 + d * 32 + h];
    }
    __syncthreads();
    const float dec = wgt[256 + par];
#pragma unroll
    for (int i = 0; i < 2; ++i)
#pragma unroll
      for (int j = 0; j < 4; ++j) acc[i][j] *= dec;
    ssd_p1_kstep<0>(acc, abase, xbase);
    ssd_p1_kstep<1>(acc, abase, xbase);
    ssd_p1_kstep<2>(acc, abase, xbase);
    ssd_p1_kstep<3>(acc, abase, xbase);
  }
  if (s < 32) {
    float* o = p.out + OUT_SSM + ((((size_t)s * 4 + l) * 2 + d) * 32 + h) * 8192;
#pragma unroll
    for (int i = 0; i < 2; ++i)
#pragma unroll
      for (int j = 0; j < 4; ++j) *(f32x4*)(o + (size_t)(16 * j + fr) * 128 + 32 * w + 16 * i + 4 * fq) = acc[i][j];
  }
  __syncthreads();
}

template <int KS>
__device__ __forceinline__ void ssd_p2_wx_kstep(f32x4 (&y)[4], const char* wrow, unsigned xbase) {
  s16x4 b00 = tr_read<KS * 32 * SS_XROW>(xbase), b01 = tr_read<KS * 32 * SS_XROW + 4 * SS_XROW>(xbase);
  s16x4 b10 = tr_read<KS * 32 * SS_XROW + 32>(xbase), b11 = tr_read<KS * 32 * SS_XROW + 4 * SS_XROW + 32>(xbase);
  s16x4 b20 = tr_read<KS * 32 * SS_XROW + 64>(xbase), b21 = tr_read<KS * 32 * SS_XROW + 4 * SS_XROW + 64>(xbase);
  s16x4 b30 = tr_read<KS * 32 * SS_XROW + 96>(xbase), b31 = tr_read<KS * 32 * SS_XROW + 4 * SS_XROW + 96>(xbase);
  const bf16x8 A = *(const bf16x8*)(wrow + KS * 64);
  TR_WAIT8(b00, b01, b10, b11, b20, b21, b30, b31);
  y[0] = __builtin_amdgcn_mfma_f32_16x16x32_bf16(A, cat8(b00, b01), y[0], 0, 0, 0);
  y[1] = __builtin_amdgcn_mfma_f32_16x16x32_bf16(A, cat8(b10, b11), y[1], 0, 0, 0);
  y[2] = __builtin_amdgcn_mfma_f32_16x16x32_bf16(A, cat8(b20, b21), y[2], 0, 0, 0);
  y[3] = __builtin_amdgcn_mfma_f32_16x16x32_bf16(A, cat8(b30, b31), y[3], 0, 0, 0);
}

__device__ __forceinline__ void ssd_pass2_item(const Params& p, int l, int item, char* smem) {
  const int hf = item & 1, g = (item >> 1) & 7, cg = item >> 4;
  const size_t tb = (size_t)cg * 128;
  const int tid = tid_opaque(), lane = tid & 63, w = tid >> 6, fr = lane & 15, fq = lane >> 4;
  const int i0 = 64 * hf + 16 * w;
  const bf16_t* xc = (const bf16_t*)(p.ws + OFF_XC);
  const bf16_t* proj = (const bf16_t*)(p.ws + OFF_PROJ);
  const float* dtb = (const float*)(p.ws + OFF_DT);
  const float* csb = (const float*)(p.ws + OFF_CS);
  const bf16_t* sst = (const bf16_t*)(p.ws + OFF_SST);
  bf16_t* ybuf = (bf16_t*)(p.ws + OFF_YBUF);
  float* arr = (float*)(smem + SS_R0 + SS_R1);
  __syncthreads();
  bf16x8 cfr[4];
#pragma unroll
  for (int ks = 0; ks < 4; ++ks) cfr[ks] = *(const bf16x8*)(xc + (tb + i0 + fr) * 4096 + 3072 + g * 128 + 32 * ks + 8 * fq);
#pragma unroll
  for (int i = 0; i < 8; ++i) {
    const int idx = tid + 256 * i, hh = idx >> 9, a = (idx >> 7) & 3, j = idx & 127;
    const float* src = (a < 2 ? csb : dtb) + (tb + j) * 64 + (a & 1) * 32 + 4 * g + hh;
    arr[idx] = *src;
  }
#pragma unroll
  for (int i = 0; i < 8; ++i) {
    const int q = tid + 256 * i;
    *(u32x4*)(smem + (q >> 4) * SS_BROW + (q & 15) * 16) = *(const u32x4*)(xc + (tb + (q >> 4)) * 4096 + 2048 + g * 128 + (q & 15) * 8);
  }
  __syncthreads();
  f32x4 cb[8];
#pragma unroll
  for (int jt = 0; jt < 8; ++jt) cb[jt] = (f32x4){0.f, 0.f, 0.f, 0.f};
#pragma unroll
  for (int ks = 0; ks < 4; ++ks)
#pragma unroll
    for (int jt = 0; jt < 8; ++jt) {
      const bf16x8 A = *(const bf16x8*)(smem + (16 * jt + fr) * SS_BROW + (32 * ks + 8 * fq) * 2);
      cb[jt] = __builtin_amdgcn_mfma_f32_16x16x32_bf16(A, cfr[ks], cb[jt], 0, 0, 0);
    }
  __syncthreads();
  float ss[4] = {0.f, 0.f, 0.f, 0.f};
  const unsigned ldsb = (unsigned)(size_t)smem;
  const unsigned xbase = ldsb + SS_R0 + (8 * fq + (fr >> 2)) * SS_XROW + (4 * (fr & 3)) * 2;
  const char* wrow = smem + (16 * w + fr) * SS_BROW + (8 * fq) * 2;
  const int il = i0 + fr;
#pragma unroll 1
  for (int hh = 0; hh < 4; ++hh) {
    const int h = 4 * g + hh;
    u32x4 pre[4];
#pragma unroll
    for (int i = 0; i < 4; ++i) { const int q = tid + 256 * i; pre[i] = *(const u32x4*)(xc + (tb + (q >> 3)) * 4096 + h * 64 + (q & 7) * 8); }
    const float* csf = arr + hh * 512;
    const float* csr = csf + 128;
    const float* dtf = csf + 256;
    const float* dtr = csf + 384;
    {
      const float cfi = csf[il], cbi = csr[il];
#pragma unroll
      for (int jt = 0; jt < 8; ++jt) {
        const f32x4 cfj = *(const f32x4*)(csf + 16 * jt + 4 * fq), cbj = *(const f32x4*)(csr + 16 * jt + 4 * fq);
        const f32x4 dfj = *(const f32x4*)(dtf + 16 * jt + 4 * fq), dbj = *(const f32x4*)(dtr + 16 * jt + 4 * fq);
        float wv[4];
#pragma unroll
        for (int jj = 0; jj < 4; ++jj) {
          const int j = 16 * jt + 4 * fq + jj;
          const float lf = (j <= il) ? __expf(cfi - cfj[jj]) * dfj[jj] : 0.f;
          const float lr = (j >= il) ? __expf(cbi - cbj[jj]) * dbj[jj] : 0.f;
          wv[jj] = cb[jt][jj] * (lf + lr);
        }
        u32x2 o; o[0] = pack2(wv[0], wv[1]); o[1] = pack2(wv[2], wv[3]);
        *(u32x2*)(smem + (16 * w + fr) * SS_BROW + (16 * jt + 4 * fq) * 2) = o;
      }
    }
#pragma unroll
    for (int i = 0; i < 4; ++i) { const int q = tid + 256 * i; *(u32x4*)(smem + SS_R0 + (q >> 3) * SS_XROW + (q & 7) * 16) = pre[i]; }
#pragma unroll
    for (int i = 0; i < 4; ++i) { const int q = tid + 256 * i; pre[i] = *(const u32x4*)(sst + (((size_t)cg * 32 + h) * 2 + 0) * 8192 + (q >> 4) * 128 + (q & 15) * 8); }
    __syncthreads();
    f32x4 y[4];
#pragma unroll
    for (int pt = 0; pt < 4; ++pt) y[pt] = (f32x4){0.f, 0.f, 0.f, 0.f};
    ssd_p2_wx_kstep<0>(y, wrow, xbase);
    ssd_p2_wx_kstep<1>(y, wrow, xbase);
    ssd_p2_wx_kstep<2>(y, wrow, xbase);
    ssd_p2_wx_kstep<3>(y, wrow, xbase);
    float xsk[4][4];
#pragma unroll
    for (int pt = 0; pt < 4; ++pt)
#pragma unroll
      for (int jj = 0; jj < 4; ++jj) xsk[pt][jj] = bf2f(*(const bf16_t*)(smem + SS_R0 + (i0 + 4 * fq + jj) * SS_XROW + (16 * pt + fr) * 2));
    __syncthreads();
#pragma unroll
    for (int i = 0; i < 4; ++i) { const int q = tid + 256 * i; *(u32x4*)(smem + SS_R0 + (q >> 4) * SS_BROW + (q & 15) * 16) = pre[i]; }
#pragma unroll
    for (int i = 0; i < 4; ++i) { const int q = tid + 256 * i; pre[i] = *(const u32x4*)(sst + (((size_t)cg * 32 + h) * 2 + 1) * 8192 + (q >> 4) * 128 + (q & 15) * 8); }
    __syncthreads();
    f32x4 zf[4], zb[4];
#pragma unroll
    for (int pt = 0; pt < 4; ++pt) { zf[pt] = (f32x4){0.f, 0.f, 0.f, 0.f}; zb[pt] = (f32x4){0.f, 0.f, 0.f, 0.f}; }
#pragma unroll
    for (int ks = 0; ks < 4; ++ks)
#pragma unroll
      for (int pt = 0; pt < 4; ++pt) {
        const bf16x8 B = *(const bf16x8*)(smem + SS_R0 + (16 * pt + fr) * SS_BROW + (32 * ks + 8 * fq) * 2);
        zf[pt] = __builtin_amdgcn_mfma_f32_16x16x32_bf16(cfr[ks], B, zf[pt], 0, 0, 0);
      }
    __syncthreads();
#pragma unroll
    for (int i = 0; i < 4; ++i) { const int q = tid + 256 * i; *(u32x4*)(smem + SS_R0 + (q >> 4) * SS_BROW + (q & 15) * 16) = pre[i]; }
    __syncthreads();
#pragma unroll
    for (int ks = 0; ks < 4; ++ks)
#pragma unroll
      for (int pt = 0; pt < 4; ++pt) {
        const bf16x8 B = *(const bf16x8*)(smem + SS_R0 + (16 * pt + fr) * SS_BROW + (32 * ks + 8 * fq) * 2);
        zb[pt] = __builtin_amdgcn_mfma_f32_16x16x32_bf16(cfr[ks], B, zb[pt], 0, 0, 0);
      }
    const float dsk = p.ssd_d[l * 32 + h];
#pragma unroll
    for (int jj = 0; jj < 4; ++jj) {
      const int i2 = i0 + 4 * fq + jj;
      const float ef = __expf(csf[i2]), eb = __expf(csr[i2]);
#pragma unroll
      for (int pt = 0; pt < 4; ++pt) {
        const float z = bf2f(proj[(tb + i2) * NPROJ_PAD + C_Z + h * 64 + 16 * pt + fr]);
        float val = y[pt][jj] + ef * zf[pt][jj] + eb * zb[pt][jj] + dsk * xsk[pt][jj];
        val *= siluf_(z);
        ybuf[(tb + i2) * 2048 + h * 64 + 16 * pt + fr] = f2bf(val);
        ss[jj] += val * val;
      }
    }
    __syncthreads();
  }
#pragma unroll
  for (int jj = 0; jj < 4; ++jj) {
    float t = ss[jj];
    t += __shfl_xor(t, 1); t += __shfl_xor(t, 2); t += __shfl_xor(t, 4); t += __shfl_xor(t, 8);
    ss[jj] = rsqrtf(t * (1.f / 256.f) + 1e-6f);
  }
#pragma unroll
  for (int hh = 0; hh < 4; ++hh)
#pragma unroll
    for (int pt = 0; pt < 4; ++pt) {
      const int chn = (4 * g + hh) * 64 + 16 * pt + fr;
      const float nw = p.ssd_norm_w[l * 2048 + chn];
#pragma unroll
      for (int jj = 0; jj < 4; ++jj) {
        bf16_t* yp = ybuf + (tb + i0 + 4 * fq + jj) * 2048 + chn;
        *yp = f2bf(bf2f(*yp) * ss[jj] * nw);
      }
    }
}

__device__ __forceinline__ void phase_scan1(const Params& p, int l, char* smem) {
  const int G = gridDim.x, bid = blockIdx.x;
  if (bid < 64) { hgrn_chunk_item(p, l, 32 * 16 + bid, smem); return; }
  for (int it = bid - 64; it < 256 + 512 + 2048; it += G - 64) {
    if (it < 256) ssd_pass1_item(p, l, 32 * 64 + it, smem);
    else if (it < 768) hgrn_chunk_item(p, l, it - 256, smem);
    else ssd_pass1_item(p, l, it - 768, smem);
  }
}
__device__ __forceinline__ void phase_scan2(const Params& p, int l, char* smem) {
  for (int it = blockIdx.x; it < 2048; it += gridDim.x) ssd_pass2_item(p, l, it, smem);
}

__device__ __forceinline__ void phase_scan_naive(const Params& p, int l, char* smem) {
  const int n_ssd = 36 * 64, n_hg = 36 * 16;
  for (int it = blockIdx.x; it < n_ssd + n_hg; it += gridDim.x) {
    if (it < 256) ssd_naive_item(p, l, 32 * 64 + it, (float*)smem);
    else if (it < 320) hgrn_chunk_item(p, l, 32 * 16 + (it - 256), smem);
    else if (it < 320 + 2048) ssd_naive_item(p, l, it - 320, (float*)smem);
    else hgrn_chunk_item(p, l, it - 320 - 2048, smem);
  }
}

__device__ __forceinline__ void phase_post(const Params& p, int l) {
  const int tid = tid_opaque();
  const bf16_t* proj = (const bf16_t*)(p.ws + OFF_PROJ);
  const bf16_t* xc = (const bf16_t*)(p.ws + OFF_XC);
  const float* yf = (const float*)(p.ws + OFF_YF);
  const float* yb = (const float*)(p.ws + OFF_YB);
  const float* of = (const float*)(p.ws + OFF_OF);
  const float* ob = (const float*)(p.ws + OFF_OB);
  bf16_t* ybuf = (bf16_t*)(p.ws + OFF_YBUF);
  bf16_t* obuf = (bf16_t*)(p.ws + OFF_OBUF);
  for (int tok = blockIdx.x; tok < T; tok += gridDim.x) {
    {
      const int ch = tid * 4;
      const float* a = of + (size_t)tok * 1024 + ch;
      const float* b = ob + (size_t)tok * 1024 + ch;
      uint2 gv = *(const uint2*)(proj + (size_t)tok * NPROJ_PAD + C_HG + ch);
      const unsigned gw[2] = {gv.x, gv.y};
      float v[4];
      float ss = 0.f;
#pragma unroll
      for (int j = 0; j < 4; ++j) { v[j] = a[j] + b[j]; ss += v[j] * v[j]; }
#pragma unroll
      for (int o = 16; o >= 1; o >>= 1) ss += __shfl_xor(ss, o);
      const float rstd = rsqrtf(ss * (1.f / 128.f) + 1e-6f);
      const float* nw = p.hgrn_norm_w + l * 1024 + ch;
      float r[4];
#pragma unroll
      for (int j = 0; j < 4; ++j) {
        const float gz = bf2f((bf16_t)((j & 1) ? (gw[j >> 1] >> 16) : (gw[j >> 1] & 0xffff)));
        r[j] = v[j] * rstd * nw[j] * siluf_(gz);
      }
      uint2 o2; o2.x = pack2(r[0], r[1]); o2.y = pack2(r[2], r[3]);
      *(uint2*)(obuf + (size_t)tok * 1024 + ch) = o2;
    }
  }
}


#define XB_TMO 128
#define XB_XCNT(j) (256 + 64 * (j))
#define XB_XSUB(j) (1280 + 64 * (j))
#define XB_XGEN(j) (2304 + 64 * (j))
#define XB_TOP 3328
#define XB_TOPGEN 3392
#define XCD_BAR_WORDS 3456
#define XB_SPIN_CAP (1u << 22)
#define LAS __attribute__((address_space(3)))
__device__ __forceinline__ unsigned xb_ld(unsigned* p) { return __hip_atomic_load(p, __ATOMIC_RELAXED, __HIP_MEMORY_SCOPE_AGENT); }
__device__ __forceinline__ unsigned xb_add(unsigned* p, unsigned v) { return __hip_atomic_fetch_add(p, v, __ATOMIC_RELAXED, __HIP_MEMORY_SCOPE_AGENT); }
__device__ __forceinline__ unsigned xb_xcc_id() { return (unsigned)__builtin_amdgcn_s_getreg((3 << 11) | 20) & 0xFu; }
#define XB_SPIN(cond, bar)                                                                    \
  do {                                                                                        \
    unsigned _sp = 0;                                                                         \
    while (cond) {                                                                            \
      __builtin_amdgcn_s_sleep(1);                                                            \
      if ((++_sp & 255u) == 0u) {                                                             \
        if (xb_ld(&(bar)[XB_TMO])) break;                                                     \
        if (_sp > XB_SPIN_CAP) { atomicAdd(&(bar)[XB_TMO], 1u); break; }                      \
      }                                                                                       \
    }                                                                                         \
  } while (0)
struct XcdBarrier { unsigned* bar; unsigned x; volatile LAS unsigned* st; };
__device__ __forceinline__ XcdBarrier xcd_barrier_post(unsigned* bar, volatile LAS unsigned* st) {
  XcdBarrier b; b.bar = bar; b.x = xb_xcc_id(); b.st = st;
  if (threadIdx.x == 0) (void)xb_add(&bar[XB_XCNT(b.x)], 1u);
  return b;
}
__device__ __forceinline__ void xcd_barrier_complete(unsigned* bar, unsigned x, unsigned& nloc, unsigned& nx) {
  const unsigned G = gridDim.x * gridDim.y * gridDim.z;
  unsigned sum, cnt, mine, sp = 0u;
  for (;;) {
    sum = 0u; cnt = 0u; mine = 0u;
#pragma unroll
    for (unsigned j = 0; j < 16; ++j) { const unsigned c = xb_ld(&bar[XB_XCNT(j)]); sum += c; cnt += (c > 0u) ? 1u : 0u; mine = (j == x) ? c : mine; }
    if (sum == G) break;
    __builtin_amdgcn_s_sleep(1);
    if ((++sp & 255u) == 0u) { if (xb_ld(&bar[XB_TMO])) break; if (sp > XB_SPIN_CAP) { atomicAdd(&bar[XB_TMO], 1u); break; } }
  }
  nloc = mine > 0u ? mine : 1u; nx = cnt > 0u ? cnt : 1u;
}
__device__ __forceinline__ void xcd_barrier(const XcdBarrier& b) {
  asm volatile("s_waitcnt vmcnt(0)" ::: "memory");
  __syncthreads();
  if (threadIdx.x == 0) {
    unsigned* bar = b.bar;
    __builtin_amdgcn_s_waitcnt(0);
    unsigned nloc = b.st[0], nx = b.st[1];
    if (nloc == 0u) { xcd_barrier_complete(bar, b.x, nloc, nx); b.st[0] = nloc; b.st[1] = nx; }
    const unsigned old = xb_add(&bar[XB_XSUB(b.x)], 1u);
    const unsigned gen = old / nloc;
    if (old + 1u == (gen + 1u) * nloc) {
      __builtin_amdgcn_fence(__ATOMIC_RELEASE, "agent");
      asm volatile("s_waitcnt vmcnt(0)" ::: "memory");
      const unsigned og = xb_add(&bar[XB_TOP], 1u);
      const unsigned tg = og / nx;
      if (og + 1u == (tg + 1u) * nx) xb_add(&bar[XB_TOPGEN], 1u);
      else XB_SPIN(xb_ld(&bar[XB_TOPGEN]) == tg, bar);
      __builtin_amdgcn_fence(__ATOMIC_ACQUIRE, "agent");
      xb_add(&bar[XB_XGEN(b.x)], 1u);
      asm volatile("s_waitcnt vmcnt(0)" ::: "memory");
    } else {
      XB_SPIN(xb_ld(&bar[XB_XGEN(b.x)]) == gen, bar);
      __builtin_amdgcn_fence(__ATOMIC_ACQUIRE, "agent");
      asm volatile("s_waitcnt vmcnt(0)" ::: "memory");
    }
  }
  __syncthreads();
}

enum { PH_SETUP = 0, PH_NORM1, PH_PROJ, PH_CONV, PH_SCAN, PH_POST, PH_MERGE, PH_OUT, PH_NORM2, PH_FFN1, PH_FFN2, PH_FINAL };

__device__ __forceinline__ void run_phase(const Params& p, int ph, int l, char* smem) {
  switch (ph) {
    case PH_SETUP: phase_setup(p, smem); break;
    case PH_NORM1: phase_norm(p, l, 0); break;
    case PH_PROJ: phase_gemm<G_PROJ>(p, l, smem); break;
    case PH_CONV: phase_conv(p, l); break;
    case PH_SCAN: phase_scan_naive(p, l, smem); break;
    case PH_POST: phase_post(p, l); break;
    case PH_MERGE: phase_gemm<G_MERGE>(p, l, smem); break;
    case PH_OUT: phase_gemm<G_OUT>(p, l, smem); break;
    case PH_NORM2: phase_norm(p, l, 1); break;
    case PH_FFN1: phase_gemm<G_FFN1>(p, l, smem); break;
    case PH_FFN2: phase_gemm<G_FFN2>(p, l, smem); break;
    case PH_FINAL: phase_final_norm(p); break;
  }
}

extern __shared__ __attribute__((aligned(16))) char dyn_smem[];

#if !MEGA
__global__ void __launch_bounds__(256, 2) phase_kernel(Params p, int ph, int l) { run_phase(p, ph, l, dyn_smem); }
#endif

#if MEGA
__global__ void __launch_bounds__(256, 2) mega_kernel(Params p) {
  cg::grid_group grid = cg::this_grid();
  __shared__ uint4 xb_words;
  if (threadIdx.x == 0) xb_words = make_uint4(0u, 0u, 0u, 0u);
  __syncthreads();
  XcdBarrier xb = xcd_barrier_post((unsigned*)(p.ws + OFF_BAR), (volatile LAS unsigned*)&xb_words);
  phase_setup(p, dyn_smem);
  grid.sync();
  for (int l = 0; l < DEPTH; ++l) {
#pragma unroll 1
    for (int ph = 0; ph < 10; ++ph) {
      switch (ph) {
        case 0: phase_norm(p, l, 0); break;
        case 1: phase_gemm<G_PROJ>(p, l, dyn_smem); break;
        case 2: phase_conv(p, l); break;
        case 3: phase_scan1(p, l, dyn_smem); break;
        case 4: phase_scan2(p, l, dyn_smem); phase_post(p, l); break;
        case 5: phase_gemm<G_MERGE>(p, l, dyn_smem); break;
        case 6: phase_gemm<G_OUT>(p, l, dyn_smem); break;
        case 7: phase_norm(p, l, 1); break;
        case 8: phase_gemm<G_FFN1>(p, l, dyn_smem); break;
        default: phase_gemm<G_FFN2>(p, l, dyn_smem); break;
      }
      xcd_barrier(xb);
    }
  }
  phase_final_norm(p);
}
#endif

extern "C" void kernel_launch(void* const* d_in, const int* in_sizes, int n_in, void* d_out, int out_size, void* d_ws, size_t ws_size,
                              hipStream_t stream) {
  static int grid_blocks = 0;
  if (!grid_blocks) {
    int dev = 0, cus = 0, per_cu = 0;
    (void)hipGetDevice(&dev);
    (void)hipDeviceGetAttribute(&cus, hipDeviceAttributeMultiprocessorCount, dev);
#if MEGA
    (void)hipFuncSetAttribute((const void*)mega_kernel, hipFuncAttributeMaxDynamicSharedMemorySize, SMEM_BYTES);
#endif
#if !MEGA
    (void)hipFuncSetAttribute((const void*)phase_kernel, hipFuncAttributeMaxDynamicSharedMemorySize, SMEM_BYTES);
#endif
#if MEGA
    (void)hipOccupancyMaxActiveBlocksPerMultiprocessor(&per_cu, mega_kernel, 256, SMEM_BYTES);
#else
    (void)hipOccupancyMaxActiveBlocksPerMultiprocessor(&per_cu, phase_kernel, 256, SMEM_BYTES);
#endif
    per_cu = 2;
    grid_blocks = cus * per_cu;
  }
  Params p{};
  const float** pf = (const float**)&p;
  for (int i = 0; i < 26; ++i) pf[i] = (const float*)d_in[i];
  p.out = (float*)d_out;
  p.ws = (char*)d_ws;
#if MEGA
  (void)hipMemsetAsync((char*)d_ws + OFF_BAR, 0, XCD_BAR_WORDS * 4, stream);
  void* args[] = {&p};
  hipError_t e = hipLaunchCooperativeKernel((void*)mega_kernel, dim3(grid_blocks), dim3(256), args, SMEM_BYTES, stream);
  if (e != hipSuccess) fprintf(stderr, "coop launch failed: %s\n", hipGetErrorString(e));
#else
  const int G = grid_blocks;
  phase_kernel<<<G, 256, SMEM_BYTES, stream>>>(p, PH_SETUP, 0);
  for (int l = 0; l < DEPTH; ++l)
    for (int ph = PH_NORM1; ph <= PH_FFN2; ++ph) phase_kernel<<<G, 256, SMEM_BYTES, stream>>>(p, ph, l);
  phase_kernel<<<G, 256, SMEM_BYTES, stream>>>(p, PH_FINAL, 0);
#endif
}
```

```cpp
#include <hip/hip_runtime.h>
#include <hip/hip_cooperative_groups.h>
#include <cstdio>
#include <cstdint>
namespace cg = cooperative_groups;

#ifndef MEGA
#define MEGA 1
#endif

typedef unsigned short bf16_t;
typedef short bf16x8 __attribute__((ext_vector_type(8)));
typedef float f32x4 __attribute__((ext_vector_type(4)));
typedef unsigned u32x4 __attribute__((ext_vector_type(4)));
typedef short s16x4 __attribute__((ext_vector_type(4)));
typedef unsigned u32x2 __attribute__((ext_vector_type(2)));

constexpr int D = 1024, T = 16384, TCTX = 8192, DEPTH = 4;
constexpr int NPROJ = 13376, NPROJ_PAD = 13440;
constexpr int FFN = 2816;
constexpr int C_Z = 4096, C_DT = 6144, C_HQ = 6208, C_HF = 7232, C_HI = 9280, C_HG = 10304, C_GATE = 11328;
constexpr size_t WT_IN = 0;
constexpr size_t WT_SSO = WT_IN + (size_t)NPROJ_PAD * 1024;
constexpr size_t WT_HGO = WT_SSO + (size_t)1024 * 2048;
constexpr size_t WT_OUT = WT_HGO + (size_t)1024 * 1024;
constexpr size_t WT_W13 = WT_OUT + (size_t)1024 * 1024;
constexpr size_t WT_W2 = WT_W13 + (size_t)5632 * 1024;
constexpr size_t WT_LAYER = WT_W2 + (size_t)1024 * 2816;
constexpr size_t OFF_WT = 0;
constexpr size_t OFF_H = OFF_WT + WT_LAYER * 2 * DEPTH;
constexpr size_t OFF_PROJ = OFF_H + (size_t)T * 1024 * 2;
constexpr size_t OFF_XC = OFF_PROJ + (size_t)T * NPROJ_PAD * 2;
constexpr size_t OFF_DTRAW = OFF_XC + (size_t)T * 4096 * 2;
constexpr size_t OFF_DT = OFF_DTRAW + (size_t)T * 64 * 4;
constexpr size_t OFF_YF = OFF_DT + (size_t)T * 64 * 4;
constexpr size_t OFF_YB = OFF_YF + (size_t)T * 2048 * 4;
constexpr size_t OFF_OF = OFF_YB + (size_t)T * 2048 * 4;
constexpr size_t OFF_OB = OFF_OF + (size_t)T * 1024 * 4;
constexpr size_t OFF_YBUF = OFF_OB + (size_t)T * 1024 * 4;
constexpr size_t OFF_OBUF = OFF_YBUF + (size_t)T * 2048 * 2;
constexpr size_t OFF_MBUF = OFF_OBUF + (size_t)T * 1024 * 2;
constexpr size_t OFF_MOD = OFF_MBUF + (size_t)T * 1024 * 2;
constexpr size_t OFF_LB = OFF_MOD + (size_t)DEPTH * 5 * 6144 * 4;
constexpr size_t OFF_BAR = OFF_LB + (size_t)DEPTH * 2 * 1024 * 4;
constexpr size_t OFF_END = OFF_BAR + 16384;
constexpr size_t OUT_SSM = (size_t)T * 1024;
constexpr size_t OUT_HGRN = OUT_SSM + (size_t)32 * 4 * 2 * 32 * 64 * 128;

constexpr int SMEM_BYTES = 73728;
constexpr int LDS_ROW = 128;
constexpr int LDS_TILE = 128 * LDS_ROW;

struct Params {
  const float *x_prompt, *x_sample, *c, *state_ssm, *state_hgrn, *c_ctx, *norm_mix_w, *norm_ffn_w, *ada_w, *ada_b, *w_in,
      *ssd_conv_w, *ssd_conv_b, *ssd_dt_bias, *ssd_a_log, *ssd_d, *ssd_norm_w, *hgrn_lb, *hgrn_norm_w, *w_ssd_out, *w_hgrn_out,
      *w_out, *ffn_w1, *ffn_w3, *ffn_w2, *norm_final_w;
  float* out;
  char* ws;
};

__device__ __forceinline__ bf16_t f2bf(float f) {
  unsigned u = __float_as_uint(f);
  u += 0x7fffu + ((u >> 16) & 1u);
  return (bf16_t)(u >> 16);
}
__device__ __forceinline__ float bf2f(bf16_t b) { return __uint_as_float(((unsigned)b) << 16); }
typedef __bf16 bf16x2_t __attribute__((ext_vector_type(2)));
__device__ __forceinline__ unsigned pack2(float a, float b) { bf16x2_t v = {(__bf16)a, (__bf16)b}; return __builtin_bit_cast(unsigned, v); }
__device__ __forceinline__ float sigmoidf_(float x) { return __builtin_amdgcn_rcpf(1.0f + __expf(-x)); }
__device__ __forceinline__ float siluf_(float x) { return x * __builtin_amdgcn_rcpf(1.0f + __expf(-x)); }
__device__ __forceinline__ int tid_opaque() { int t = threadIdx.x; asm volatile("" : "+v"(t)); return t; }
__device__ __forceinline__ float clamp30(float x) { return fminf(fmaxf(x, -30.f), 30.f); }
__device__ __forceinline__ float gate_ratio(float g1, float g2) { return (1.0f + __expf(-clamp30(g2))) * __builtin_amdgcn_rcpf(1.0f + __expf(-clamp30(g1))); }
__device__ __forceinline__ int mod_row(int tok) { return tok < TCTX ? 0 : 1 + ((tok - TCTX) >> 11); }

__device__ __forceinline__ void phase_setup(const Params& p, char* smem) {
  const int tid = tid_opaque(), bid = blockIdx.x, G = gridDim.x;
  {
    const size_t n4 = (size_t)T * 1024 / 4, half4 = (size_t)TCTX * 1024 / 4;
    float4* dst = (float4*)p.out;
    const float4* s0 = (const float4*)p.x_prompt;
    const float4* s1 = (const float4*)p.x_sample;
    for (size_t i = (size_t)bid * 256 + tid; i < n4; i += (size_t)G * 256) dst[i] = i < half4 ? s0[i] : s1[i - half4];
  }
  {
    float* lb = (float*)(p.ws + OFF_LB);
    for (int i = bid * 256 + tid; i < 2048; i += G * 256) {
      float v0 = p.hgrn_lb[i], v1 = p.hgrn_lb[2048 + i], v2 = p.hgrn_lb[4096 + i], v3 = p.hgrn_lb[6144 + i];
      float m = fmaxf(fmaxf(v0, v1), fmaxf(v2, v3));
      float e0 = expf(v0 - m), e1 = expf(v1 - m), e2 = expf(v2 - m), e3 = expf(v3 - m);
      float inv = 1.0f / (e0 + e1 + e2 + e3);
      lb[i] = 0.f;
      lb[2048 + i] = e1 * inv;
      lb[4096 + i] = (e1 + e2) * inv;
      lb[6144 + i] = (e1 + e2 + e3) * inv;
    }
  }
  {
    float* sm = (float*)smem;
    float* modb = (float*)(p.ws + OFF_MOD);
    __syncthreads();
    for (int i = tid; i < 5 * 1024; i += 256) {
      int v = i >> 10, k = i & 1023;
      float cv = v == 0 ? p.c_ctx[k] : p.c[(v - 1) * 1024 + k];
      sm[i] = siluf_(cv);
    }
    __syncthreads();
    float* part = sm + 5 * 1024;
    for (int item = bid; item < DEPTH * 96; item += G) {
      int l = item / 96, cg_ = item % 96;
      int col = cg_ * 64 + (tid & 63), kg = tid >> 6;
      const float* w = p.ada_w + (size_t)l * 1024 * 6144 + col;
      float a0 = 0, a1 = 0, a2 = 0, a3 = 0, a4 = 0;
      for (int k = kg * 256; k < kg * 256 + 256; ++k) {
        float wv = w[(size_t)k * 6144];
        a0 += sm[k] * wv; a1 += sm[1024 + k] * wv; a2 += sm[2048 + k] * wv; a3 += sm[3072 + k] * wv; a4 += sm[4096 + k] * wv;
      }
      __syncthreads();
      part[(kg * 5 + 0) * 64 + (tid & 63)] = a0; part[(kg * 5 + 1) * 64 + (tid & 63)] = a1; part[(kg * 5 + 2) * 64 + (tid & 63)] = a2;
      part[(kg * 5 + 3) * 64 + (tid & 63)] = a3; part[(kg * 5 + 4) * 64 + (tid & 63)] = a4;
      __syncthreads();
      for (int i = tid; i < 320; i += 256) {
        int v = i >> 6, cc = i & 63;
        float s = part[(0 * 5 + v) * 64 + cc] + part[(1 * 5 + v) * 64 + cc] + part[(2 * 5 + v) * 64 + cc] + part[(3 * 5 + v) * 64 + cc];
        int colo = cg_ * 64 + cc;
        modb[((size_t)l * 5 + v) * 6144 + colo] = s + p.ada_b[l * 6144 + colo];
      }
    }
    __syncthreads();
  }
  {
    float* tile = (float*)smem;
    const int n_in = 210 * 16, n_sso = 16 * 32, n_hgo = 16 * 16, n_out = 16 * 16, n_w13 = 88 * 16, n_w2 = 16 * 44;
    const int per_layer = n_in + n_sso + n_hgo + n_out + n_w13 + n_w2;
    for (int it = bid; it < per_layer * DEPTH; it += G) {
      int l = it / per_layer, r = it % per_layer;
      bf16_t* wt = (bf16_t*)(p.ws + OFF_WT) + (size_t)l * WT_LAYER;
      const float *src0 = nullptr, *src1 = nullptr;
      int K, Nsrc, nt, kt;
      bf16_t* dst;
      bool zero = false;
      if (r < n_in) {
        nt = r / 16; kt = r % 16; K = 1024; Nsrc = NPROJ;
        dst = wt + WT_IN;
        if (nt >= 209) zero = true;
        src0 = p.w_in + (size_t)l * 1024 * NPROJ + nt * 64; src1 = src0 + 32;
      } else if ((r -= n_in) < n_sso) {
        nt = r / 32; kt = r % 32; K = 2048; Nsrc = 1024; dst = wt + WT_SSO;
        src0 = p.w_ssd_out + (size_t)l * 2048 * 1024 + nt * 64; src1 = src0 + 32;
      } else if ((r -= n_sso) < n_hgo) {
        nt = r / 16; kt = r % 16; K = 1024; Nsrc = 1024; dst = wt + WT_HGO;
        src0 = p.w_hgrn_out + (size_t)l * 1024 * 1024 + nt * 64; src1 = src0 + 32;
      } else if ((r -= n_hgo) < n_out) {
        nt = r / 16; kt = r % 16; K = 1024; Nsrc = 1024; dst = wt + WT_OUT;
        src0 = p.w_out + (size_t)l * 1024 * 1024 + nt * 64; src1 = src0 + 32;
      } else if ((r -= n_out) < n_w13) {
        nt = r / 16; kt = r % 16; K = 1024; Nsrc = FFN; dst = wt + WT_W13;
        src0 = p.ffn_w1 + (size_t)l * 1024 * FFN + nt * 32; src1 = p.ffn_w3 + (size_t)l * 1024 * FFN + nt * 32;
      } else {
        r -= n_w13;
        nt = r / 44; kt = r % 44; K = 2816; Nsrc = 1024; dst = wt + WT_W2;
        src0 = p.ffn_w2 + (size_t)l * 2816 * 1024 + nt * 64; src1 = src0 + 32;
      }
      __syncthreads();
      {
        int c4 = (tid & 15) * 4;
        const float* s = c4 < 32 ? src0 + c4 : src1 + (c4 - 32);
#pragma unroll
        for (int i = 0; i < 4; ++i) {
          int kr = (tid >> 4) + i * 16;
          float4 v = zero ? make_float4(0.f, 0.f, 0.f, 0.f) : *(const float4*)(s + (size_t)(kt * 64 + kr) * Nsrc);
          tile[kr * 65 + c4 + 0] = v.x; tile[kr * 65 + c4 + 1] = v.y; tile[kr * 65 + c4 + 2] = v.z; tile[kr * 65 + c4 + 3] = v.w;
        }
      }
      __syncthreads();
#pragma unroll
      for (int i = 0; i < 2; ++i) {
        int cidx = tid + i * 256, n = cidx >> 3, kc = cidx & 7;
        uint4 o;
        o.x = pack2(tile[(kc * 8 + 0) * 65 + n], tile[(kc * 8 + 1) * 65 + n]);
        o.y = pack2(tile[(kc * 8 + 2) * 65 + n], tile[(kc * 8 + 3) * 65 + n]);
        o.z = pack2(tile[(kc * 8 + 4) * 65 + n], tile[(kc * 8 + 5) * 65 + n]);
        o.w = pack2(tile[(kc * 8 + 6) * 65 + n], tile[(kc * 8 + 7) * 65 + n]);
        *(uint4*)(dst + (size_t)(nt * 64 + n) * K + kt * 64 + kc * 8) = o;
      }
    }
    __syncthreads();
  }
}

__device__ __forceinline__ void phase_norm(const Params& p, int l, int which) {
  const int lane = tid_opaque() & 63, wv = tid_opaque() >> 6;
  const float* nw = (which == 0 ? p.norm_mix_w : p.norm_ffn_w) + l * 1024;
  const float* modb = (const float*)(p.ws + OFF_MOD) + (size_t)l * 5 * 6144;
  bf16_t* h = (bf16_t*)(p.ws + OFF_H);
  for (int row = blockIdx.x * 4 + wv; row < T; row += gridDim.x * 4) {
    const float* x = p.out + (size_t)row * 1024;
    const float* md = modb + (size_t)mod_row(row) * 6144 + (which == 0 ? 0 : 3072);
    float4 v[4];
    float ss = 0.f;
#pragma unroll
    for (int i = 0; i < 4; ++i) {
      v[i] = *(const float4*)(x + i * 256 + lane * 4);
      ss += v[i].x * v[i].x + v[i].y * v[i].y + v[i].z * v[i].z + v[i].w * v[i].w;
    }
#pragma unroll
    for (int o = 32; o >= 1; o >>= 1) ss += __shfl_xor(ss, o);
    float rstd = rsqrtf(ss * (1.0f / 1024.f) + 1e-6f);
#pragma unroll
    for (int i = 0; i < 4; ++i) {
      int c = i * 256 + lane * 4;
      float4 w = *(const float4*)(nw + c), sh = *(const float4*)(md + c), sc = *(const float4*)(md + 1024 + c);
      float a0 = v[i].x * rstd * w.x * (1.f + sc.x) + sh.x, a1 = v[i].y * rstd * w.y * (1.f + sc.y) + sh.y;
      float a2 = v[i].z * rstd * w.z * (1.f + sc.z) + sh.z, a3 = v[i].w * rstd * w.w * (1.f + sc.w) + sh.w;
      uint2 o2; o2.x = pack2(a0, a1); o2.y = pack2(a2, a3);
      *(uint2*)(h + (size_t)row * 1024 + c) = o2;
    }
  }
}

__device__ __forceinline__ void phase_final_norm(const Params& p) {
  const int lane = tid_opaque() & 63, wv = tid_opaque() >> 6;
  for (int row = blockIdx.x * 4 + wv; row < T; row += gridDim.x * 4) {
    float* x = p.out + (size_t)row * 1024;
    float4 v[4];
    float ss = 0.f;
#pragma unroll
    for (int i = 0; i < 4; ++i) {
      v[i] = *(const float4*)(x + i * 256 + lane * 4);
      ss += v[i].x * v[i].x + v[i].y * v[i].y + v[i].z * v[i].z + v[i].w * v[i].w;
    }
#pragma unroll
    for (int o = 32; o >= 1; o >>= 1) ss += __shfl_xor(ss, o);
    float rstd = rsqrtf(ss * (1.0f / 1024.f) + 1e-6f);
#pragma unroll
    for (int i = 0; i < 4; ++i) {
      int c = i * 256 + lane * 4;
      float4 w = *(const float4*)(p.norm_final_w + c);
      float4 o4 = make_float4(v[i].x * rstd * w.x, v[i].y * rstd * w.y, v[i].z * rstd * w.z, v[i].w * rstd * w.w);
      *(float4*)(x + c) = o4;
    }
  }
}

template <bool HASMID>
__device__ __forceinline__ void gemm_kloop2(f32x4 (&acc)[4][4], const bf16_t* __restrict__ Ag, int lda, const bf16_t* __restrict__ Bg,
                                            int ldb, int K, const bf16_t* __restrict__ Ag2, int lda2, const bf16_t* __restrict__ Bg2,
                                            int ldb2, int K2, char* smem, const bf16_t* __restrict__ gate0) {
  const int tid = tid_opaque(), lane = tid & 63, wid = tid >> 6;
  const int wr = wid >> 1, wc = wid & 1, fr = lane & 15, fq = lane >> 4;
  const int srow = tid >> 3, schunk = (tid & 7) ^ ((tid >> 4) & 7);
  const int rofs0 = (fq ^ ((fr >> 1) & 7)) * 16;
  const bf16_t* ap = Ag + (size_t)srow * lda + schunk * 8;
  const bf16_t* bp = Bg + (size_t)srow * ldb + schunk * 8;
  const int nk1 = K >> 6;
  const int nk = nk1 + (K2 >> 6);
  char* const sdst = smem + tid * 16;
#define GK_DMA(buf, t)                                                                                                   \
  {                                                                                                                      \
    _Pragma("unroll") for (int i = 0; i < 4; ++i) {                                                                      \
      __builtin_amdgcn_global_load_lds((const unsigned*)(ap + (size_t)i * 32 * lda + (size_t)(t) * 64),                  \
                                       (unsigned*)(sdst + (buf) * LDS_TILE + i * 4096), 16, 0, 0);                       \
      __builtin_amdgcn_global_load_lds((const unsigned*)(bp + (size_t)i * 32 * ldb + (size_t)(t) * 64),                  \
                                       (unsigned*)(sdst + (2 + (buf)) * LDS_TILE + i * 4096), 16, 0, 0);                 \
    }                                                                                                                    \
  }
  GK_DMA(0, 0);
  __syncthreads();
  for (int kt = 0; kt < nk; ++kt) {
    const int cur = kt & 1;
    if (kt + 1 < nk) {
      if (kt + 1 == nk1) {
        ap = Ag2 + (size_t)srow * lda2 + schunk * 8 - (size_t)nk1 * 64;
        bp = Bg2 + (size_t)srow * ldb2 + schunk * 8 - (size_t)nk1 * 64;
        lda = lda2; ldb = ldb2;
      }
      GK_DMA(cur ^ 1, kt + 1);
    }
    if (HASMID && kt == nk1) {
#pragma unroll
      for (int m = 0; m < 4; ++m)
#pragma unroll
        for (int n = 0; n < 4; ++n) {
          uint2 g1 = *(const uint2*)(gate0 + (size_t)(m * 16) * NPROJ_PAD + n * 16);
          uint2 g2 = *(const uint2*)(gate0 + (size_t)(m * 16) * NPROJ_PAD + 1024 + n * 16);
          acc[m][n][0] *= gate_ratio(bf2f((bf16_t)(g1.x & 0xffff)), bf2f((bf16_t)(g2.x & 0xffff)));
          acc[m][n][1] *= gate_ratio(bf2f((bf16_t)(g1.x >> 16)), bf2f((bf16_t)(g2.x >> 16)));
          acc[m][n][2] *= gate_ratio(bf2f((bf16_t)(g1.y & 0xffff)), bf2f((bf16_t)(g2.y & 0xffff)));
          acc[m][n][3] *= gate_ratio(bf2f((bf16_t)(g1.y >> 16)), bf2f((bf16_t)(g2.y >> 16)));
        }
    }
    const char* sa = smem + cur * LDS_TILE + (wr * 64 + fr) * LDS_ROW;
    const char* sb = smem + (2 + cur) * LDS_TILE + (wc * 64 + fr) * LDS_ROW;
#pragma unroll
    for (int kk = 0; kk < 2; ++kk) {
      bf16x8 af[4], bfv[4];
      __builtin_amdgcn_sched_barrier(0);
#pragma unroll
      for (int m = 0; m < 4; ++m) af[m] = *(const bf16x8*)(sa + m * 16 * LDS_ROW + (rofs0 ^ (kk * 64)));
#pragma unroll
      for (int n = 0; n < 4; ++n) bfv[n] = *(const bf16x8*)(sb + n * 16 * LDS_ROW + (rofs0 ^ (kk * 64)));
      __builtin_amdgcn_sched_barrier(0);
#pragma unroll
      for (int m = 0; m < 4; ++m)
#pragma unroll
        for (int n = 0; n < 4; ++n) acc[m][n] = __builtin_amdgcn_mfma_f32_16x16x32_bf16(bfv[n], af[m], acc[m][n], 0, 0, 0);
    }
    __builtin_amdgcn_sched_barrier(0);
    __syncthreads();
  }
#undef GK_DMA
}

__device__ __forceinline__ void gemm_kloop(f32x4 (&acc)[4][4], const bf16_t* __restrict__ Ag, int lda, const bf16_t* __restrict__ Bg,
                                           int ldb, int K, char* smem) {
  gemm_kloop2<false>(acc, Ag, lda, Bg, ldb, K, Ag, lda, Bg, ldb, 0, smem, Ag);
}

constexpr int BG_STAGE = 24576;
__device__ __forceinline__ int swz4(int x) { return (0x78 >> (2 * x)) & 3; }
template <bool HASMID>
__device__ __forceinline__ void gemm_kloop_big(f32x4 (&acc)[8][4], const bf16_t* __restrict__ Ag, int lda, const bf16_t* __restrict__ Bg,
                                               int ldb, int K, const bf16_t* __restrict__ Ag2, int lda2,
                                               const bf16_t* __restrict__ Bg2, int ldb2, int K2, char* smem,
                                               const bf16_t* __restrict__ gate0) {
  const int tid = tid_opaque(), lane = tid & 63, wid = tid >> 6;
  const int wr = wid >> 1, wc = wid & 1, fr = lane & 15, fq = lane >> 4;
  const int srow = tid >> 2, schunk = (tid & 3) ^ swz4((tid >> 4) & 3);
  const int rofs = (fq ^ swz4((fr >> 2) & 3)) * 16;
  const int nks1 = K >> 5;
  const int nks = nks1 + (K2 >> 5);
  const bf16_t* ap1 = Ag + (size_t)srow * lda + schunk * 8;
  const bf16_t* bp1 = Bg + (size_t)srow * ldb + schunk * 8;
  const bf16_t* ap2 = Ag2 + (size_t)srow * lda2 + schunk * 8 - (size_t)nks1 * 32;
  const bf16_t* bp2 = Bg2 + (size_t)srow * ldb2 + schunk * 8 - (size_t)nks1 * 32;
  char* const sdst = smem + tid * 16;
#define BG_DMA(slot, kk_)                                                                                                  \
  {                                                                                                                        \
    const int t_ = (kk_) < nks ? (kk_) : nks - 1;                                                                          \
    const bool s2_ = t_ >= nks1;                                                                                           \
    const bf16_t* ap_ = (s2_ ? ap2 : ap1) + (size_t)t_ * 32;                                                               \
    const bf16_t* bp_ = (s2_ ? bp2 : bp1) + (size_t)t_ * 32;                                                               \
    const size_t la_ = (size_t)64 * (s2_ ? lda2 : lda), lb_ = (size_t)64 * (s2_ ? ldb2 : ldb);                             \
    _Pragma("unroll") for (int i = 0; i < 4; ++i)                                                                          \
        __builtin_amdgcn_global_load_lds((const unsigned*)(ap_ + i * la_), (unsigned*)(sdst + (slot) * BG_STAGE + i * 4096), 16, 0, 0); \
    _Pragma("unroll") for (int i = 0; i < 2; ++i)                                                                          \
        __builtin_amdgcn_global_load_lds((const unsigned*)(bp_ + i * lb_), (unsigned*)(sdst + (slot) * BG_STAGE + 16384 + i * 4096), 16, 0, 0); \
  }
  BG_DMA(0, 0);
  BG_DMA(1, 1);
  int slot = 0;
  for (int ks = 0; ks < nks; ++ks) {
    asm volatile("s_waitcnt vmcnt(6)" ::: "memory");
    __builtin_amdgcn_s_barrier();
    asm volatile("" ::: "memory");
    const int nslot = slot == 0 ? 2 : slot - 1;
    BG_DMA(nslot, ks + 2);
    if (HASMID && ks == nks1) {
      int zofs = 0;
      asm volatile("" : "+v"(zofs));
      const bf16_t* gz = gate0 + zofs;
#pragma unroll
      for (int m = 0; m < 8; ++m)
#pragma unroll
        for (int n = 0; n < 4; ++n) {
          uint2 g1 = *(const uint2*)(gz + (size_t)(m * 16) * NPROJ_PAD + n * 16);
          uint2 g2 = *(const uint2*)(gz + (size_t)(m * 16) * NPROJ_PAD + 1024 + n * 16);
          acc[m][n][0] *= gate_ratio(bf2f((bf16_t)(g1.x & 0xffff)), bf2f((bf16_t)(g2.x & 0xffff)));
          acc[m][n][1] *= gate_ratio(bf2f((bf16_t)(g1.x >> 16)), bf2f((bf16_t)(g2.x >> 16)));
          acc[m][n][2] *= gate_ratio(bf2f((bf16_t)(g1.y & 0xffff)), bf2f((bf16_t)(g2.y & 0xffff)));
          acc[m][n][3] *= gate_ratio(bf2f((bf16_t)(g1.y >> 16)), bf2f((bf16_t)(g2.y >> 16)));
        }
    }
    const char* sa = smem + slot * BG_STAGE + (wr * 128 + fr) * 64 + rofs;
    const char* sb = smem + slot * BG_STAGE + 16384 + (wc * 64 + fr) * 64 + rofs;
    bf16x8 af[8], bfv[4];
    __builtin_amdgcn_sched_barrier(0);
#pragma unroll
    for (int n = 0; n < 4; ++n) bfv[n] = *(const bf16x8*)(sb + n * 16 * 64);
#pragma unroll
    for (int m = 0; m < 8; ++m) af[m] = *(const bf16x8*)(sa + m * 16 * 64);
    __builtin_amdgcn_sched_barrier(0);
    __builtin_amdgcn_s_setprio(1);
#pragma unroll
    for (int m = 0; m < 8; ++m)
#pragma unroll
      for (int n = 0; n < 4; ++n) acc[m][n] = __builtin_amdgcn_mfma_f32_16x16x32_bf16(bfv[n], af[m], acc[m][n], 0, 0, 0);
    __builtin_amdgcn_s_setprio(0);
    __builtin_amdgcn_sched_barrier(0);
    slot = slot == 2 ? 0 : slot + 1;
  }
  asm volatile("s_waitcnt vmcnt(0)" ::: "memory");
  __builtin_amdgcn_s_barrier();
  asm volatile("" ::: "memory");
#undef BG_DMA
}
__device__ __forceinline__ void gemm_kloop_big1(f32x4 (&acc)[8][4], const bf16_t* __restrict__ Ag, int lda, const bf16_t* __restrict__ Bg,
                                                int ldb, int K, char* smem) {
  gemm_kloop_big<false>(acc, Ag, lda, Bg, ldb, K, Ag, lda, Bg, ldb, 0, smem, Ag);
}
enum { G_PROJ = 0, G_MERGE = 1, G_OUT = 2, G_FFN1 = 3, G_FFN2 = 4 };

template <int MODE>
__device__ __forceinline__ void phase_gemm(const Params& p, int l, char* smem) {
  const int tid = tid_opaque(), lane = tid & 63, wid = tid >> 6;
  const int wr = wid >> 1, wc = wid & 1, fr = lane & 15, fq = lane >> 4;
  const bf16_t* wt = (const bf16_t*)(p.ws + OFF_WT) + (size_t)l * WT_LAYER;
  const bf16_t* hbuf = (const bf16_t*)(p.ws + OFF_H);
  bf16_t* proj = (bf16_t*)(p.ws + OFF_PROJ);
  bf16_t* hidden = (bf16_t*)(p.ws + OFF_PROJ);
  const float* modb = (const float*)(p.ws + OFF_MOD) + (size_t)l * 5 * 6144;
  constexpr int nM = T / 256;
  constexpr int nN = MODE == G_PROJ ? NPROJ_PAD / 128 : (MODE == G_FFN1 ? 5632 / 128 : 1024 / 128);
  for (int t = blockIdx.x; t < nM * nN; t += gridDim.x) {
    const int pm = t % nM, pn = t / nM;
    const int row0 = pm * 256, col0 = pn * 128;
    f32x4 acc[8][4];
#pragma unroll
    for (int m = 0; m < 8; ++m)
#pragma unroll
      for (int n = 0; n < 4; ++n) acc[m][n] = (f32x4){0.f, 0.f, 0.f, 0.f};
    if (MODE == G_PROJ) {
      gemm_kloop_big1(acc, hbuf + (size_t)row0 * 1024, 1024, wt + WT_IN + (size_t)col0 * 1024, 1024, 1024, smem);
      float* dtraw = (float*)(p.ws + OFF_DTRAW);
#pragma unroll
      for (int m = 0; m < 8; ++m) {
        const int row = row0 + wr * 128 + m * 16 + fr;
#pragma unroll
        for (int n = 0; n < 4; ++n) {
          const int col = col0 + wc * 64 + n * 16 + fq * 4;
          uint2 o; o.x = pack2(acc[m][n][0], acc[m][n][1]); o.y = pack2(acc[m][n][2], acc[m][n][3]);
          *(uint2*)(proj + (size_t)row * NPROJ_PAD + col) = o;
          if (col >= C_DT && col < C_DT + 64) *(f32x4*)(dtraw + (size_t)row * 64 + (col - C_DT)) = acc[m][n];
        }
      }
    } else if (MODE == G_MERGE) {
      const bf16_t* ybuf = (const bf16_t*)(p.ws + OFF_YBUF);
      const bf16_t* obuf = (const bf16_t*)(p.ws + OFF_OBUF);
      bf16_t* mbuf = (bf16_t*)(p.ws + OFF_MBUF);
      gemm_kloop_big<true>(acc, ybuf + (size_t)row0 * 2048, 2048, wt + WT_SSO + (size_t)col0 * 2048, 2048, 2048,
                        obuf + (size_t)row0 * 1024, 1024, wt + WT_HGO + (size_t)col0 * 1024, 1024, 1024, smem,
                        proj + (size_t)(row0 + wr * 128 + fr) * NPROJ_PAD + C_GATE + col0 + wc * 64 + fq * 4);
#pragma unroll
      for (int m = 0; m < 8; ++m) {
        const int row = row0 + wr * 128 + m * 16 + fr;
#pragma unroll
        for (int n = 0; n < 4; ++n) {
          const int col = col0 + wc * 64 + n * 16 + fq * 4;
          uint2 g = *(const uint2*)(proj + (size_t)row * NPROJ_PAD + C_GATE + 1024 + col);
          float r0 = acc[m][n][0] * sigmoidf_(clamp30(bf2f((bf16_t)(g.x & 0xffff))));
          float r1 = acc[m][n][1] * sigmoidf_(clamp30(bf2f((bf16_t)(g.x >> 16))));
          float r2 = acc[m][n][2] * sigmoidf_(clamp30(bf2f((bf16_t)(g.y & 0xffff))));
          float r3 = acc[m][n][3] * sigmoidf_(clamp30(bf2f((bf16_t)(g.y >> 16))));
          uint2 o; o.x = pack2(r0, r1); o.y = pack2(r2, r3);
          *(uint2*)(mbuf + (size_t)row * 1024 + col) = o;
        }
      }
    } else if (MODE == G_OUT || MODE == G_FFN2) {
      if (MODE == G_OUT) {
        const bf16_t* mbuf = (const bf16_t*)(p.ws + OFF_MBUF);
        gemm_kloop_big1(acc, mbuf + (size_t)row0 * 1024, 1024, wt + WT_OUT + (size_t)col0 * 1024, 1024, 1024, smem);
      } else {
        gemm_kloop_big1(acc, hidden + (size_t)row0 * FFN, FFN, wt + WT_W2 + (size_t)col0 * FFN, FFN, FFN, smem);
      }
      const float* gate = modb + (size_t)mod_row(row0) * 6144 + (MODE == G_OUT ? 2048 : 5120);
#pragma unroll
      for (int m = 0; m < 8; ++m) {
        const int row = row0 + wr * 128 + m * 16 + fr;
#pragma unroll
        for (int n = 0; n < 4; ++n) {
          const int col = col0 + wc * 64 + n * 16 + fq * 4;
          f32x4 g = *(const f32x4*)(gate + col);
          f32x4* xp = (f32x4*)(p.out + (size_t)row * 1024 + col);
          f32x4 xv = *xp;
          xv += g * acc[m][n];
          *xp = xv;
        }
      }
    } else {
      gemm_kloop_big1(acc, hbuf + (size_t)row0 * 1024, 1024, wt + WT_W13 + (size_t)col0 * 1024, 1024, 1024, smem);
#pragma unroll
      for (int m = 0; m < 8; ++m) {
        const int row = row0 + wr * 128 + m * 16 + fr;
#pragma unroll
        for (int n = 0; n < 2; ++n) {
          const int hcol = (pn * 2 + wc) * 32 + n * 16 + fq * 4;
          float r[4];
#pragma unroll
          for (int j = 0; j < 4; ++j) r[j] = siluf_(acc[m][n][j]) * acc[m][n + 2][j];
          uint2 o; o.x = pack2(r[0], r[1]); o.y = pack2(r[2], r[3]);
          *(uint2*)(hidden + (size_t)row * FFN + hcol) = o;
        }
      }
    }
  }
}

__device__ __forceinline__ void phase_conv(const Params& p, int l) {
  const bf16_t* proj = (const bf16_t*)(p.ws + OFF_PROJ);
  bf16_t* xc = (bf16_t*)(p.ws + OFF_XC);
  const float* cw = p.ssd_conv_w + (size_t)l * 5 * 4096;
  const float* cb = p.ssd_conv_b + (size_t)l * 4096;
  const size_t total = (size_t)T * 512;
  for (size_t i = (size_t)blockIdx.x * 256 + tid_opaque(); i < total; i += (size_t)gridDim.x * 256) {
    const int tok = (int)(i >> 9), ch = (int)(i & 511) * 8;
    int pos, len;
    if (tok < TCTX) { pos = tok & 255; len = 256; } else { pos = (tok - TCTX) & 63; len = 64; }
    float a[8];
#pragma unroll
    for (int j = 0; j < 8; ++j) a[j] = cb[ch + j];
#pragma unroll
    for (int k = 0; k < 5; ++k) {
      const int q = pos + k - 2;
      if (q >= 0 && q < len) {
        uint4 v = *(const uint4*)(proj + (size_t)(tok + k - 2) * NPROJ_PAD + ch);
        const float* w = cw + k * 4096 + ch;
        a[0] += w[0] * bf2f((bf16_t)(v.x & 0xffff)); a[1] += w[1] * bf2f((bf16_t)(v.x >> 16));
        a[2] += w[2] * bf2f((bf16_t)(v.y & 0xffff)); a[3] += w[3] * bf2f((bf16_t)(v.y >> 16));
        a[4] += w[4] * bf2f((bf16_t)(v.z & 0xffff)); a[5] += w[5] * bf2f((bf16_t)(v.z >> 16));
        a[6] += w[6] * bf2f((bf16_t)(v.w & 0xffff)); a[7] += w[7] * bf2f((bf16_t)(v.w >> 16));
      }
    }
    uint4 o;
    o.x = pack2(siluf_(a[0]), siluf_(a[1])); o.y = pack2(siluf_(a[2]), siluf_(a[3]));
    o.z = pack2(siluf_(a[4]), siluf_(a[5])); o.w = pack2(siluf_(a[6]), siluf_(a[7]));
    *(uint4*)(xc + (size_t)tok * 4096 + ch) = o;
  }
  const float* dtraw = (const float*)(p.ws + OFF_DTRAW);
  float* dt = (float*)(p.ws + OFF_DT);
  for (size_t i = (size_t)blockIdx.x * 256 + tid_opaque(); i < (size_t)T * 64; i += (size_t)gridDim.x * 256) {
    float v = dtraw[i] + p.ssd_dt_bias[l * 64 + (int)(i & 63)];
    dt[i] = v > 20.f ? v : log1pf(expf(v));
  }
}

__device__ __forceinline__ void ssd_naive_item(const Params& p, int l, int item, float* sm) {
  const int d = item & 1, h = (item >> 1) & 31, s = item >> 6;
  int tok0, L;
  if (s < 32) { tok0 = s * 256; L = 256; } else { tok0 = TCTX + (s - 32) * 2048; L = 2048; }
  const int tid = tid_opaque(), pp = tid >> 2, nq = tid & 3, g = h >> 2;
  float S[32];
  if (s < 32) {
#pragma unroll
    for (int i = 0; i < 32; ++i) S[i] = 0.f;
  } else {
    const float* st = p.state_ssm + ((((size_t)(s - 32) * 4 + l) * 2 + d) * 32 + h) * 8192 + pp * 128 + nq * 32;
#pragma unroll
    for (int i = 0; i < 32; ++i) S[i] = st[i];
  }
  const float a = -expf(p.ssd_a_log[l * 64 + d * 32 + h]);
  float* xs = sm; float* Bs = sm + 1024; float* Cs = Bs + 2048; float* dts = Cs + 2048;
  const bf16_t* xc = (const bf16_t*)(p.ws + OFF_XC);
  const float* dtb = (const float*)(p.ws + OFF_DT);
  float* ydir = (float*)(p.ws + (d == 0 ? OFF_YF : OFF_YB));
  for (int bt = 0; bt < L / 16; ++bt) {
    const int tb = d == 0 ? bt * 16 : L - 16 - bt * 16;
    __syncthreads();
    for (int e = tid; e < 16 * 320; e += 256) {
      const int tt = e / 320, c = e % 320;
      const size_t base = (size_t)(tok0 + tb + tt) * 4096;
      if (c < 64) xs[tt * 64 + c] = bf2f(xc[base + h * 64 + c]);
      else if (c < 192) Bs[tt * 128 + c - 64] = bf2f(xc[base + 2048 + g * 128 + c - 64]);
      else Cs[tt * 128 + c - 192] = bf2f(xc[base + 3072 + g * 128 + c - 192]);
    }
    if (tid < 16) dts[tid] = dtb[(size_t)(tok0 + tb + tid) * 64 + d * 32 + h];
    __syncthreads();
    for (int i2 = 0; i2 < 16; ++i2) {
      const int tt = d == 0 ? i2 : 15 - i2;
      const float dt = dts[tt], dA = expf(dt * a), xdt = xs[tt * 64 + pp] * dt;
      float acc = 0.f;
      const float* Bp = Bs + tt * 128 + nq * 32;
      const float* Cp = Cs + tt * 128 + nq * 32;
#pragma unroll
      for (int i = 0; i < 32; ++i) { S[i] = dA * S[i] + xdt * Bp[i]; acc += S[i] * Cp[i]; }
      acc += __shfl_xor(acc, 1); acc += __shfl_xor(acc, 2);
      if (nq == 0) ydir[(size_t)(tok0 + tb + tt) * 2048 + h * 64 + pp] = acc;
    }
  }
  if (s < 32) {
    float* o = p.out + OUT_SSM + ((((size_t)s * 4 + l) * 2 + d) * 32 + h) * 8192 + pp * 128 + nq * 32;
#pragma unroll
    for (int i = 0; i < 32; ++i) o[i] = S[i];
  }
}

__device__ __forceinline__ void hgrn_naive_item(const Params& p, int l, int item, float* sm) {
  const int d = item & 1, hd = (item >> 1) & 7, s = item >> 4;
  int tok0, L;
  if (s < 32) { tok0 = s * 256; L = 256; } else { tok0 = TCTX + (s - 32) * 2048; L = 2048; }
  const int tid = tid_opaque(), vv = tid >> 1, kh = tid & 1;
  float S[64];
  if (s < 32) {
#pragma unroll
    for (int i = 0; i < 64; ++i) S[i] = 0.f;
  } else {
    const float* st = p.state_hgrn + ((((size_t)(s - 32) * 4 + l) * 2 + d) * 8 + hd) * 16384 + (size_t)(kh * 64) * 128 + vv;
#pragma unroll
    for (int i = 0; i < 64; ++i) S[i] = st[(size_t)i * 128];
  }
  float* qs = sm; float* fs = sm + 2048; float* ks = sm + 4096; float* vs = sm + 6144;
  const bf16_t* proj = (const bf16_t*)(p.ws + OFF_PROJ);
  const float* lb = (const float*)(p.ws + OFF_LB) + (size_t)l * 2048 + d * 1024 + hd * 128;
  float* odir = (float*)(p.ws + (d == 0 ? OFF_OF : OFF_OB));
  for (int bt = 0; bt < L / 16; ++bt) {
    const int tb = d == 0 ? bt * 16 : L - 16 - bt * 16;
    __syncthreads();
    for (int e = tid; e < 16 * 128; e += 256) {
      const int tt = e >> 7, c = e & 127;
      const size_t base = (size_t)(tok0 + tb + tt) * NPROJ_PAD;
      const float q = bf2f(proj[base + C_HQ + hd * 128 + c]);
      const float u = bf2f(proj[base + C_HF + d * 1024 + hd * 128 + c]);
      const float lbv = lb[c];
      const float sg = sigmoidf_(u);
      qs[e] = siluf_(q);
      fs[e] = lbv + (1.f - lbv) * sg;
      ks[e] = (1.f - lbv) * (1.f - sg);
      vs[e] = bf2f(proj[base + C_HI + hd * 128 + c]);
    }
    __syncthreads();
    for (int i2 = 0; i2 < 16; ++i2) {
      const int tt = d == 0 ? i2 : 15 - i2;
      const float vval = vs[tt * 128 + vv];
      const float* fp = fs + tt * 128 + kh * 64;
      const float* kp = ks + tt * 128 + kh * 64;
      const float* qp = qs + tt * 128 + kh * 64;
      float acc = 0.f;
#pragma unroll
      for (int i = 0; i < 64; ++i) { S[i] = fp[i] * S[i] + kp[i] * vval; acc += S[i] * qp[i]; }
      acc += __shfl_xor(acc, 1);
      if (kh == 0) odir[(size_t)(tok0 + tb + tt) * 1024 + hd * 128 + vv] = acc;
    }
  }
  if (s < 32) {
    float* o = p.out + OUT_HGRN + ((((size_t)s * 4 + l) * 2 + d) * 8 + hd) * 16384 + (size_t)(kh * 64) * 128 + vv;
#pragma unroll
    for (int i = 0; i < 64; ++i) o[(size_t)i * 128] = S[i];
  }
}


constexpr int HG_ROW = 272;
constexpr int HG_IMG = 16 * HG_ROW;
constexpr int HG_BUF = 4 * HG_IMG + 512;
__device__ __forceinline__ void hgrn_chunk_item(const Params& p, int l, int item, char* smem) {
  const int d = item & 1, hd = (item >> 1) & 7, s = item >> 4;
  int tok0, L;
  if (s < 32) { tok0 = s * 256; L = 256; } else { tok0 = TCTX + (s - 32) * 2048; L = 2048; }
  const int tid = tid_opaque(), lane = tid & 63, w = tid >> 6, fr = lane & 15, fq = lane >> 4;
  const int ch = tid & 127, half = tid >> 7;
  f32x4 S[8][2];
  if (s < 32) {
#pragma unroll
    for (int kt = 0; kt < 8; ++kt) { S[kt][0] = (f32x4){0.f, 0.f, 0.f, 0.f}; S[kt][1] = (f32x4){0.f, 0.f, 0.f, 0.f}; }
  } else {
    const float* st = p.state_hgrn + ((((size_t)(s - 32) * 4 + l) * 2 + d) * 8 + hd) * 16384;
#pragma unroll
    for (int kt = 0; kt < 8; ++kt)
#pragma unroll
      for (int vt = 0; vt < 2; ++vt)
#pragma unroll
        for (int jj = 0; jj < 4; ++jj) S[kt][vt][jj] = st[(size_t)(16 * kt + fq * 4 + jj) * 128 + 32 * w + 16 * vt + fr];
  }
  const float lbv = ((const float*)(p.ws + OFF_LB))[(size_t)l * 2048 + d * 1024 + hd * 128 + ch];
  const bf16_t* proj = (const bf16_t*)(p.ws + OFF_PROJ);
  float* odir = (float*)(p.ws + (d == 0 ? OFF_OF : OFF_OB));
  float* xch = (float*)(smem + 2 * HG_BUF);
  const int nch = L >> 4;
  bf16_t rq[8], ru[8], rv[8];
  __syncthreads();
  {
#pragma unroll
    for (int i = 0; i < 8; ++i) {
      const int pos = 8 * half + i;
      const size_t tk = (size_t)(d == 0 ? tok0 + pos : tok0 + L - 1 - pos) * NPROJ_PAD;
      rq[i] = proj[tk + C_HQ + hd * 128 + ch];
      ru[i] = proj[tk + C_HF + d * 1024 + hd * 128 + ch];
      rv[i] = proj[tk + C_HI + hd * 128 + ch];
    }
  }
  for (int c = 0; c < nch; ++c) {
    char* buf = smem + (c & 1) * HG_BUF;
    float* xc_ = xch + (c & 1) * 256;
    float fv[8], kk[8], qs[8];
    float loc = 1.f;
#pragma unroll
    for (int i = 0; i < 8; ++i) {
      const float u = bf2f(ru[i]);
      const float sg = sigmoidf_(u);
      fv[i] = lbv + (1.f - lbv) * sg;
      kk[i] = (1.f - lbv) * (1.f - sg);
      qs[i] = siluf_(bf2f(rq[i]));
      loc *= fv[i];
      *(bf16_t*)(buf + 3 * HG_IMG + (8 * half + i) * HG_ROW + ch * 2) = rv[i];
    }
    xc_[half * 128 + ch] = loc;
    if (c + 1 < nch) {
#pragma unroll
      for (int i = 0; i < 8; ++i) {
        const int pos = (c + 1) * 16 + 8 * half + i;
        const size_t tk = (size_t)(d == 0 ? tok0 + pos : tok0 + L - 1 - pos) * NPROJ_PAD;
        rq[i] = proj[tk + C_HQ + hd * 128 + ch];
        ru[i] = proj[tk + C_HF + d * 1024 + hd * 128 + ch];
        rv[i] = proj[tk + C_HI + hd * 128 + ch];
      }
    }
    __syncthreads();
    {
      const float other = xc_[(half ^ 1) * 128 + ch];
      float P = half ? other : 1.f;
      float sfx = half ? 1.f : other;
      float suf[8];
#pragma unroll
      for (int i = 7; i >= 0; --i) { suf[i] = sfx; sfx *= fv[i]; }
#pragma unroll
      for (int i = 0; i < 8; ++i) {
        P *= fv[i];
        const int off = (8 * half + i) * HG_ROW + ch * 2;
        *(bf16_t*)(buf + off) = f2bf(qs[i] * P);
        *(bf16_t*)(buf + HG_IMG + off) = f2bf(kk[i] * __builtin_amdgcn_rcpf(fmaxf(P, 1e-30f)));
        *(bf16_t*)(buf + 2 * HG_IMG + off) = f2bf(kk[i] * suf[i]);
      }
      if (half) ((float*)(buf + 4 * HG_IMG))[ch] = P;
    }
    __syncthreads();
    const char* qtI = buf;
    const char* ktI = buf + HG_IMG;
    const float* dec = (const float*)(buf + 4 * HG_IMG);
    f32x4 at = (f32x4){0.f, 0.f, 0.f, 0.f};
#pragma unroll
    for (int ks = 0; ks < 4; ++ks) {
      bf16x8 a = *(const bf16x8*)(ktI + fr * HG_ROW + (32 * ks + fq * 8) * 2);
      bf16x8 b = *(const bf16x8*)(qtI + fr * HG_ROW + (32 * ks + fq * 8) * 2);
      at = __builtin_amdgcn_mfma_f32_16x16x32_bf16(a, b, at, 0, 0, 0);
    }
    s16x4 Pm;
    {
      u32x2 pk;
      pk[0] = pack2((fq * 4 + 0 <= fr) ? at[0] : 0.f, (fq * 4 + 1 <= fr) ? at[1] : 0.f);
      pk[1] = pack2((fq * 4 + 2 <= fr) ? at[2] : 0.f, (fq * 4 + 3 <= fr) ? at[3] : 0.f);
      Pm = __builtin_bit_cast(s16x4, pk);
    }
    const unsigned ldsb = (unsigned)(size_t)buf;
    const unsigned vaddr = ldsb + 3 * HG_IMG + (4 * fq + (fr >> 2)) * HG_ROW + (32 * w + 4 * (fr & 3)) * 2;
    const unsigned kaddr = ldsb + 2 * HG_IMG + (4 * fq + (fr >> 2)) * HG_ROW + (4 * (fr & 3)) * 2;
    s16x4 vf0, vf1, kf0, kf1, kf2, kf3, kf4, kf5, kf6, kf7;
    asm volatile(
        "ds_read_b64_tr_b16 %0, %10\n\t"
        "ds_read_b64_tr_b16 %1, %10 offset:32\n\t"
        "ds_read_b64_tr_b16 %2, %11\n\t"
        "ds_read_b64_tr_b16 %3, %11 offset:32\n\t"
        "ds_read_b64_tr_b16 %4, %11 offset:64\n\t"
        "ds_read_b64_tr_b16 %5, %11 offset:96\n\t"
        "ds_read_b64_tr_b16 %6, %11 offset:128\n\t"
        "ds_read_b64_tr_b16 %7, %11 offset:160\n\t"
        "ds_read_b64_tr_b16 %8, %11 offset:192\n\t"
        "ds_read_b64_tr_b16 %9, %11 offset:224\n\t"
        "s_waitcnt lgkmcnt(0)"
        : "=&v"(vf0), "=&v"(vf1), "=&v"(kf0), "=&v"(kf1), "=&v"(kf2), "=&v"(kf3), "=&v"(kf4), "=&v"(kf5), "=&v"(kf6), "=&v"(kf7)
        : "v"(vaddr), "v"(kaddr)
        : "memory");
    f32x4 o0 = __builtin_amdgcn_mfma_f32_16x16x16bf16_1k(Pm, vf0, (f32x4){0.f, 0.f, 0.f, 0.f}, 0, 0, 0);
    f32x4 o1 = __builtin_amdgcn_mfma_f32_16x16x16bf16_1k(Pm, vf1, (f32x4){0.f, 0.f, 0.f, 0.f}, 0, 0, 0);
#pragma unroll
    for (int ks = 0; ks < 4; ++ks) {
      u32x2 qa = *(const u32x2*)(qtI + fr * HG_ROW + (32 * ks + 4 * fq) * 2);
      u32x2 qb = *(const u32x2*)(qtI + fr * HG_ROW + (32 * ks + 16 + 4 * fq) * 2);
      u32x4 aa; aa[0] = qa[0]; aa[1] = qa[1]; aa[2] = qb[0]; aa[3] = qb[1];
      const bf16x8 A = __builtin_bit_cast(bf16x8, aa);
      u32x4 b0, b1;
      b0[0] = pack2(S[2 * ks][0][0], S[2 * ks][0][1]); b0[1] = pack2(S[2 * ks][0][2], S[2 * ks][0][3]);
      b0[2] = pack2(S[2 * ks + 1][0][0], S[2 * ks + 1][0][1]); b0[3] = pack2(S[2 * ks + 1][0][2], S[2 * ks + 1][0][3]);
      b1[0] = pack2(S[2 * ks][1][0], S[2 * ks][1][1]); b1[1] = pack2(S[2 * ks][1][2], S[2 * ks][1][3]);
      b1[2] = pack2(S[2 * ks + 1][1][0], S[2 * ks + 1][1][1]); b1[3] = pack2(S[2 * ks + 1][1][2], S[2 * ks + 1][1][3]);
      o0 = __builtin_amdgcn_mfma_f32_16x16x32_bf16(A, __builtin_bit_cast(bf16x8, b0), o0, 0, 0, 0);
      o1 = __builtin_amdgcn_mfma_f32_16x16x32_bf16(A, __builtin_bit_cast(bf16x8, b1), o1, 0, 0, 0);
    }
#pragma unroll
    for (int jj = 0; jj < 4; ++jj) {
      const int pos = c * 16 + fq * 4 + jj;
      const size_t tk = (size_t)(d == 0 ? tok0 + pos : tok0 + L - 1 - pos);
      odir[tk * 1024 + hd * 128 + 32 * w + fr] = o0[jj];
      odir[tk * 1024 + hd * 128 + 32 * w + 16 + fr] = o1[jj];
    }
    const s16x4 kfs[8] = {kf0, kf1, kf2, kf3, kf4, kf5, kf6, kf7};
#pragma unroll
    for (int kt = 0; kt < 8; ++kt) {
      const f32x4 dv = *(const f32x4*)(dec + 16 * kt + fq * 4);
      S[kt][0] = __builtin_amdgcn_mfma_f32_16x16x16bf16_1k(kfs[kt], vf0, S[kt][0] * dv, 0, 0, 0);
      S[kt][1] = __builtin_amdgcn_mfma_f32_16x16x16bf16_1k(kfs[kt], vf1, S[kt][1] * dv, 0, 0, 0);
    }
  }
  if (s < 32) {
    float* o = p.out + OUT_HGRN + ((((size_t)s * 4 + l) * 2 + d) * 8 + hd) * 16384;
#pragma unroll
    for (int kt = 0; kt < 8; ++kt)
#pragma unroll
      for (int vt = 0; vt < 2; ++vt)
#pragma unroll
        for (int jj = 0; jj < 4; ++jj) o[(size_t)(16 * kt + fq * 4 + jj) * 128 + 32 * w + 16 * vt + fr] = S[kt][vt][jj];
  }
}


constexpr size_t OFF_SST = OFF_YF;
constexpr size_t OFF_CS = OFF_YB;
constexpr int SS_BROW = 272, SS_XROW = 144;
constexpr int SS_R0 = 128 * SS_BROW;
constexpr int SS_R1 = 128 * SS_XROW;

template <int OFF>
__device__ __forceinline__ s16x4 tr_read(unsigned addr) {
  s16x4 r;
  asm volatile("ds_read_b64_tr_b16 %0, %1 offset:%2" : "=v"(r) : "v"(addr), "i"(OFF) : "memory");
  return r;
}
__device__ __forceinline__ bf16x8 cat8(s16x4 a, s16x4 b) {
  bf16x8 r;
  r[0] = a[0]; r[1] = a[1]; r[2] = a[2]; r[3] = a[3]; r[4] = b[0]; r[5] = b[1]; r[6] = b[2]; r[7] = b[3];
  return r;
}
#define TR_WAIT12(a, b, c, d, e, f, g, h, i, j, k, l_)                                                                            \
  asm volatile("s_waitcnt lgkmcnt(0)" : "+v"(a), "+v"(b), "+v"(c), "+v"(d), "+v"(e), "+v"(f), "+v"(g), "+v"(h), "+v"(i), "+v"(j), \
               "+v"(k), "+v"(l_)::"memory")
#define TR_WAIT8(a, b, c, d, e, f, g, h) \
  asm volatile("s_waitcnt lgkmcnt(0)" : "+v"(a), "+v"(b), "+v"(c), "+v"(d), "+v"(e), "+v"(f), "+v"(g), "+v"(h)::"memory")

template <int KS>
__device__ __forceinline__ void ssd_p1_kstep(f32x4 (&acc)[2][4], unsigned abase, unsigned xbase) {
  s16x4 a00 = tr_read<KS * 32 * SS_BROW>(abase), a01 = tr_read<KS * 32 * SS_BROW + 4 * SS_BROW>(abase);
  s16x4 a10 = tr_read<KS * 32 * SS_BROW + 32>(abase), a11 = tr_read<KS * 32 * SS_BROW + 4 * SS_BROW + 32>(abase);
  s16x4 b00 = tr_read<KS * 32 * SS_XROW>(xbase), b01 = tr_read<KS * 32 * SS_XROW + 4 * SS_XROW>(xbase);
  s16x4 b10 = tr_read<KS * 32 * SS_XROW + 32>(xbase), b11 = tr_read<KS * 32 * SS_XROW + 4 * SS_XROW + 32>(xbase);
  s16x4 b20 = tr_read<KS * 32 * SS_XROW + 64>(xbase), b21 = tr_read<KS * 32 * SS_XROW + 4 * SS_XROW + 64>(xbase);
  s16x4 b30 = tr_read<KS * 32 * SS_XROW + 96>(xbase), b31 = tr_read<KS * 32 * SS_XROW + 4 * SS_XROW + 96>(xbase);
  TR_WAIT12(a00, a01, a10, a11, b00, b01, b10, b11, b20, b21, b30, b31);
  const bf16x8 A0 = cat8(a00, a01), A1 = cat8(a10, a11);
  const bf16x8 B0 = cat8(b00, b01), B1 = cat8(b10, b11), B2 = cat8(b20, b21), B3 = cat8(b30, b31);
  acc[0][0] = __builtin_amdgcn_mfma_f32_16x16x32_bf16(A0, B0, acc[0][0], 0, 0, 0);
  acc[0][1] = __builtin_amdgcn_mfma_f32_16x16x32_bf16(A0, B1, acc[0][1], 0, 0, 0);
  acc[0][2] = __builtin_amdgcn_mfma_f32_16x16x32_bf16(A0, B2, acc[0][2], 0, 0, 0);
  acc[0][3] = __builtin_amdgcn_mfma_f32_16x16x32_bf16(A0, B3, acc[0][3], 0, 0, 0);
  acc[1][0] = __builtin_amdgcn_mfma_f32_16x16x32_bf16(A1, B0, acc[1][0], 0, 0, 0);
  acc[1][1] = __builtin_amdgcn_mfma_f32_16x16x32_bf16(A1, B1, acc[1][1], 0, 0, 0);
  acc[1][2] = __builtin_amdgcn_mfma_f32_16x16x32_bf16(A1, B2, acc[1][2], 0, 0, 0);
  acc[1][3] = __builtin_amdgcn_mfma_f32_16x16x32_bf16(A1, B3, acc[1][3], 0, 0, 0);
}

__device__ __forceinline__ void ssd_pass1_item(const Params& p, int l, int item, char* smem) {
  const int d = item & 1, h = (item >> 1) & 31, s = item >> 6, g = h >> 2;
  const int nc = s < 32 ? 2 : 16, cg0 = s < 32 ? 2 * s : 64 + 16 * (s - 32);
  const int tid = tid_opaque(), lane = tid & 63, w = tid >> 6, fr = lane & 15, fq = lane >> 4;
  const float a = -expf(p.ssd_a_log[l * 64 + d * 32 + h]);
  f32x4 acc[2][4];
  if (s < 32) {
#pragma unroll
    for (int i = 0; i < 2; ++i)
#pragma unroll
      for (int j = 0; j < 4; ++j) acc[i][j] = (f32x4){0.f, 0.f, 0.f, 0.f};
  } else {
    const float* st = p.state_ssm + ((((size_t)(s - 32) * 4 + l) * 2 + d) * 32 + h) * 8192;
#pragma unroll
    for (int i = 0; i < 2; ++i)
#pragma unroll
      for (int j = 0; j < 4; ++j) acc[i][j] = *(const f32x4*)(st + (size_t)(16 * j + fr) * 128 + 32 * w + 16 * i + 4 * fq);
  }
  const bf16_t* xc = (const bf16_t*)(p.ws + OFF_XC);
  const float* dtb = (const float*)(p.ws + OFF_DT);
  float* csb = (float*)(p.ws + OFF_CS);
  bf16_t* sst = (bf16_t*)(p.ws + OFF_SST);
  float* wgt = (float*)(smem + SS_R0 + SS_R1);
  u32x4 pb[8], px[4];
  float dt0, dt1;
  {
    const int c = d == 0 ? 0 : nc - 1;
    const size_t tb = (size_t)(cg0 + c) * 128;
#pragma unroll
    for (int i = 0; i < 8; ++i) { const int q = tid + 256 * i; pb[i] = *(const u32x4*)(xc + (tb + (q >> 4)) * 4096 + 2048 + g * 128 + (q & 15) * 8); }
#pragma unroll
    for (int i = 0; i < 4; ++i) { const int q = tid + 256 * i; px[i] = *(const u32x4*)(xc + (tb + (q >> 3)) * 4096 + h * 64 + (q & 7) * 8); }
    dt0 = dtb[(tb + 2 * lane) * 64 + d * 32 + h];
    dt1 = dtb[(tb + 2 * lane + 1) * 64 + d * 32 + h];
  }
  const unsigned ldsb = (unsigned)(size_t)smem;
  const unsigned abase = ldsb + (8 * fq + (fr >> 2)) * SS_BROW + (32 * w + 4 * (fr & 3)) * 2;
  const unsigned xbase = ldsb + SS_R0 + (8 * fq + (fr >> 2)) * SS_XROW + (4 * (fr & 3)) * 2;
  for (int cc = 0; cc < nc; ++cc) {
    const int c = d == 0 ? cc : nc - 1 - cc, par = cc & 1;
    const size_t cgl = cg0 + c, tb = cgl * 128;
    {
      bf16_t* so = sst + ((cgl * 32 + h) * 2 + d) * 8192;
#pragma unroll
      for (int i = 0; i < 2; ++i)
#pragma unroll
        for (int j = 0; j < 4; ++j) {
          u32x2 o; o[0] = pack2(acc[i][j][0], acc[i][j][1]); o[1] = pack2(acc[i][j][2], acc[i][j][3]);
          *(u32x2*)(so + (size_t)(16 * j + fr) * 128 + 32 * w + 16 * i + 4 * fq) = o;
        }
    }
    if (w == 0) {
      const float v0 = dt0 * a, v1 = dt1 * a, sloc = v0 + v1;
      float incl = sloc;
#pragma unroll
      for (int off = 1; off < 64; off <<= 1) { const float t = __shfl_up(incl, off); if (lane >= off) incl += t; }
      const float excl = incl - sloc, c0 = excl + v0, tot = __shfl(incl, 63);
      float cs0, cs1, wg0, wg1;
      if (d == 0) { cs0 = c0; cs1 = incl; wg0 = dt0 * __expf(tot - c0); wg1 = dt1 * __expf(tot - incl); }
      else { cs0 = tot - excl; cs1 = tot - c0; wg0 = dt0 * __expf(excl); wg1 = dt1 * __expf(c0); }
      csb[(tb + 2 * lane) * 64 + d * 32 + h] = cs0;
      csb[(tb + 2 * lane + 1) * 64 + d * 32 + h] = cs1;
      wgt[par * 128 + 2 * lane] = wg0;
      wgt[par * 128 + 2 * lane + 1] = wg1;
      if (lane == 0) wgt[256 + par] = __expf(tot);
    }
    __syncthreads();
#pragma unroll
    for (int i = 0; i < 8; ++i) { const int q = tid + 256 * i; *(u32x4*)(smem + (q >> 4) * SS_BROW + (q & 15) * 16) = pb[i]; }
#pragma unroll
    for (int i = 0; i < 4; ++i) {
      const int q = tid + 256 * i, row = q >> 3;
      const float wv = wgt[par * 128 + row];
      u32x4 o;
#pragma unroll
      for (int e = 0; e < 4; ++e) o[e] = pack2(bf2f((bf16_t)(px[i][e] & 0xffff)) * wv, bf2f((bf16_t)(px[i][e] >> 16)) * wv);
      *(u32x4*)(smem + SS_R0 + row * SS_XROW + (q & 7) * 16) = o;
    }
    if (cc + 1 < nc) {
      const int cn = d == 0 ? cc + 1 : nc - 2 - cc;
      const size_t tbn = (size_t)(cg0 + cn) * 128;
#pragma unroll
      for (int i = 0; i < 8; ++i) { const int q = tid + 256 * i; pb[i] = *(const u32x4*)(xc + (tbn + (q >> 4)) * 4096 + 2048 + g * 128 + (q & 15) * 8); }
#pragma unroll
      for (int i = 0; i < 4; ++i) { const int q = tid + 256 * i; px[i] = *(const u32x4*)(xc + (tbn + (q >> 3)) * 4096 + h * 64 + (q & 7) * 8); }
      dt0 = dtb[(tbn + 2 * lane) * 64 + d * 32 + h];
      dt1 = dtb[(tbn + 2 * lane + 1) * 64 + d * 32 + h];
    }
    __syncthreads();
    const float dec = wgt[256 + par];
#pragma unroll
    for (int i = 0; i < 2; ++i)
#pragma unroll
      for (int j = 0; j < 4; ++j) acc[i][j] *= dec;
    ssd_p1_kstep<0>(acc, abase, xbase);
    ssd_p1_kstep<1>(acc, abase, xbase);
    ssd_p1_kstep<2>(acc, abase, xbase);
    ssd_p1_kstep<3>(acc, abase, xbase);
  }
  if (s < 32) {
    float* o = p.out + OUT_SSM + ((((size_t)s * 4 + l) * 2 + d) * 32 + h) * 8192;
#pragma unroll
    for (int i = 0; i < 2; ++i)
#pragma unroll
      for (int j = 0; j < 4; ++j) *(f32x4*)(o + (size_t)(16 * j + fr) * 128 + 32 * w + 16 * i + 4 * fq) = acc[i][j];
  }
  __syncthreads();
}

template <int KS>
__device__ __forceinline__ void ssd_p2_wx_kstep(f32x4 (&y)[4], const char* wrow, unsigned xbase) {
  s16x4 b00 = tr_read<KS * 32 * SS_XROW>(xbase), b01 = tr_read<KS * 32 * SS_XROW + 4 * SS_XROW>(xbase);
  s16x4 b10 = tr_read<KS * 32 * SS_XROW + 32>(xbase), b11 = tr_read<KS * 32 * SS_XROW + 4 * SS_XROW + 32>(xbase);
  s16x4 b20 = tr_read<KS * 32 * SS_XROW + 64>(xbase), b21 = tr_read<KS * 32 * SS_XROW + 4 * SS_XROW + 64>(xbase);
  s16x4 b30 = tr_read<KS * 32 * SS_XROW + 96>(xbase), b31 = tr_read<KS * 32 * SS_XROW + 4 * SS_XROW + 96>(xbase);
  const bf16x8 A = *(const bf16x8*)(wrow + KS * 64);
  TR_WAIT8(b00, b01, b10, b11, b20, b21, b30, b31);
  y[0] = __builtin_amdgcn_mfma_f32_16x16x32_bf16(A, cat8(b00, b01), y[0], 0, 0, 0);
  y[1] = __builtin_amdgcn_mfma_f32_16x16x32_bf16(A, cat8(b10, b11), y[1], 0, 0, 0);
  y[2] = __builtin_amdgcn_mfma_f32_16x16x32_bf16(A, cat8(b20, b21), y[2], 0, 0, 0);
  y[3] = __builtin_amdgcn_mfma_f32_16x16x32_bf16(A, cat8(b30, b31), y[3], 0, 0, 0);
}

__device__ __forceinline__ void ssd_pass2_item(const Params& p, int l, int item, char* smem) {
  const int hf = item & 1, g = (item >> 1) & 7, cg = item >> 4;
  const size_t tb = (size_t)cg * 128;
  const int tid = tid_opaque(), lane = tid & 63, w = tid >> 6, fr = lane & 15, fq = lane >> 4;
  const int i0 = 64 * hf + 16 * w;
  const bf16_t* xc = (const bf16_t*)(p.ws + OFF_XC);
  const bf16_t* proj = (const bf16_t*)(p.ws + OFF_PROJ);
  const float* dtb = (const float*)(p.ws + OFF_DT);
  const float* csb = (const float*)(p.ws + OFF_CS);
  const bf16_t* sst = (const bf16_t*)(p.ws + OFF_SST);
  bf16_t* ybuf = (bf16_t*)(p.ws + OFF_YBUF);
  float* arr = (float*)(smem + SS_R0 + SS_R1);
  __syncthreads();
  bf16x8 cfr[4];
#pragma unroll
  for (int ks = 0; ks < 4; ++ks) cfr[ks] = *(const bf16x8*)(xc + (tb + i0 + fr) * 4096 + 3072 + g * 128 + 32 * ks + 8 * fq);
#pragma unroll
  for (int i = 0; i < 8; ++i) {
    const int idx = tid + 256 * i, hh = idx >> 9, a = (idx >> 7) & 3, j = idx & 127;
    const float* src = (a < 2 ? csb : dtb) + (tb + j) * 64 + (a & 1) * 32 + 4 * g + hh;
    arr[idx] = *src;
  }
#pragma unroll
  for (int i = 0; i < 8; ++i) {
    const int q = tid + 256 * i;
    *(u32x4*)(smem + (q >> 4) * SS_BROW + (q & 15) * 16) = *(const u32x4*)(xc + (tb + (q >> 4)) * 4096 + 2048 + g * 128 + (q & 15) * 8);
  }
  __syncthreads();
  f32x4 cb[8];
#pragma unroll
  for (int jt = 0; jt < 8; ++jt) cb[jt] = (f32x4){0.f, 0.f, 0.f, 0.f};
#pragma unroll
  for (int ks = 0; ks < 4; ++ks)
#pragma unroll
    for (int jt = 0; jt < 8; ++jt) {
      const bf16x8 A = *(const bf16x8*)(smem + (16 * jt + fr) * SS_BROW + (32 * ks + 8 * fq) * 2);
      cb[jt] = __builtin_amdgcn_mfma_f32_16x16x32_bf16(A, cfr[ks], cb[jt], 0, 0, 0);
    }
  __syncthreads();
  float ss[4] = {0.f, 0.f, 0.f, 0.f};
  const unsigned ldsb = (unsigned)(size_t)smem;
  const unsigned xbase = ldsb + SS_R0 + (8 * fq + (fr >> 2)) * SS_XROW + (4 * (fr & 3)) * 2;
  const char* wrow = smem + (16 * w + fr) * SS_BROW + (8 * fq) * 2;
  const int il = i0 + fr;
#pragma unroll 1
  for (int hh = 0; hh < 4; ++hh) {
    const int h = 4 * g + hh;
    u32x4 pre[4];
#pragma unroll
    for (int i = 0; i < 4; ++i) { const int q = tid + 256 * i; pre[i] = *(const u32x4*)(xc + (tb + (q >> 3)) * 4096 + h * 64 + (q & 7) * 8); }
    const float* csf = arr + hh * 512;
    const float* csr = csf + 128;
    const float* dtf = csf + 256;
    const float* dtr = csf + 384;
    {
      const float cfi = csf[il], cbi = csr[il];
#pragma unroll
      for (int jt = 0; jt < 8; ++jt) {
        const f32x4 cfj = *(const f32x4*)(csf + 16 * jt + 4 * fq), cbj = *(const f32x4*)(csr + 16 * jt + 4 * fq);
        const f32x4 dfj = *(const f32x4*)(dtf + 16 * jt + 4 * fq), dbj = *(const f32x4*)(dtr + 16 * jt + 4 * fq);
        float wv[4];
#pragma unroll
        for (int jj = 0; jj < 4; ++jj) {
          const int j = 16 * jt + 4 * fq + jj;
          const float lf = (j <= il) ? __expf(cfi - cfj[jj]) * dfj[jj] : 0.f;
          const float lr = (j >= il) ? __expf(cbi - cbj[jj]) * dbj[jj] : 0.f;
          wv[jj] = cb[jt][jj] * (lf + lr);
        }
        u32x2 o; o[0] = pack2(wv[0], wv[1]); o[1] = pack2(wv[2], wv[3]);
        *(u32x2*)(smem + (16 * w + fr) * SS_BROW + (16 * jt + 4 * fq) * 2) = o;
      }
    }
#pragma unroll
    for (int i = 0; i < 4; ++i) { const int q = tid + 256 * i; *(u32x4*)(smem + SS_R0 + (q >> 3) * SS_XROW + (q & 7) * 16) = pre[i]; }
#pragma unroll
    for (int i = 0; i < 4; ++i) { const int q = tid + 256 * i; pre[i] = *(const u32x4*)(sst + (((size_t)cg * 32 + h) * 2 + 0) * 8192 + (q >> 4) * 128 + (q & 15) * 8); }
    __syncthreads();
    f32x4 y[4];
#pragma unroll
    for (int pt = 0; pt < 4; ++pt) y[pt] = (f32x4){0.f, 0.f, 0.f, 0.f};
    ssd_p2_wx_kstep<0>(y, wrow, xbase);
    ssd_p2_wx_kstep<1>(y, wrow, xbase);
    ssd_p2_wx_kstep<2>(y, wrow, xbase);
    ssd_p2_wx_kstep<3>(y, wrow, xbase);
    float xsk[4][4];
#pragma unroll
    for (int pt = 0; pt < 4; ++pt)
#pragma unroll
      for (int jj = 0; jj < 4; ++jj) xsk[pt][jj] = bf2f(*(const bf16_t*)(smem + SS_R0 + (i0 + 4 * fq + jj) * SS_XROW + (16 * pt + fr) * 2));
    __syncthreads();
#pragma unroll
    for (int i = 0; i < 4; ++i) { const int q = tid + 256 * i; *(u32x4*)(smem + SS_R0 + (q >> 4) * SS_BROW + (q & 15) * 16) = pre[i]; }
#pragma unroll
    for (int i = 0; i < 4; ++i) { const int q = tid + 256 * i; pre[i] = *(const u32x4*)(sst + (((size_t)cg * 32 + h) * 2 + 1) * 8192 + (q >> 4) * 128 + (q & 15) * 8); }
    __syncthreads();
    f32x4 zf[4], zb[4];
#pragma unroll
    for (int pt = 0; pt < 4; ++pt) { zf[pt] = (f32x4){0.f, 0.f, 0.f, 0.f}; zb[pt] = (f32x4){0.f, 0.f, 0.f, 0.f}; }
#pragma unroll
    for (int ks = 0; ks < 4; ++ks)
#pragma unroll
      for (int pt = 0; pt < 4; ++pt) {
        const bf16x8 B = *(const bf16x8*)(smem + SS_R0 + (16 * pt + fr) * SS_BROW + (32 * ks + 8 * fq) * 2);
        zf[pt] = __builtin_amdgcn_mfma_f32_16x16x32_bf16(cfr[ks], B, zf[pt], 0, 0, 0);
      }
    __syncthreads();
#pragma unroll
    for (int i = 0; i < 4; ++i) { const int q = tid + 256 * i; *(u32x4*)(smem + SS_R0 + (q >> 4) * SS_BROW + (q & 15) * 16) = pre[i]; }
    __syncthreads();
#pragma unroll
    for (int ks = 0; ks < 4; ++ks)
#pragma unroll
      for (int pt = 0; pt < 4; ++pt) {
        const bf16x8 B = *(const bf16x8*)(smem + SS_R0 + (16 * pt + fr) * SS_BROW + (32 * ks + 8 * fq) * 2);
        zb[pt] = __builtin_amdgcn_mfma_f32_16x16x32_bf16(cfr[ks], B, zb[pt], 0, 0, 0);
      }
    const float dsk = p.ssd_d[l * 32 + h];
#pragma unroll
    for (int jj = 0; jj < 4; ++jj) {
      const int i2 = i0 + 4 * fq + jj;
      const float ef = __expf(csf[i2]), eb = __expf(csr[i2]);
#pragma unroll
      for (int pt = 0; pt < 4; ++pt) {
        const float z = bf2f(proj[(tb + i2) * NPROJ_PAD + C_Z + h * 64 + 16 * pt + fr]);
        float val = y[pt][jj] + ef * zf[pt][jj] + eb * zb[pt][jj] + dsk * xsk[pt][jj];
        val *= siluf_(z);
        ybuf[(tb + i2) * 2048 + h * 64 + 16 * pt + fr] = f2bf(val);
        ss[jj] += val * val;
      }
    }
    __syncthreads();
  }
#pragma unroll
  for (int jj = 0; jj < 4; ++jj) {
    float t = ss[jj];
    t += __shfl_xor(t, 1); t += __shfl_xor(t, 2); t += __shfl_xor(t, 4); t += __shfl_xor(t, 8);
    ss[jj] = rsqrtf(t * (1.f / 256.f) + 1e-6f);
  }
#pragma unroll
  for (int hh = 0; hh < 4; ++hh)
#pragma unroll
    for (int pt = 0; pt < 4; ++pt) {
      const int chn = (4 * g + hh) * 64 + 16 * pt + fr;
      const float nw = p.ssd_norm_w[l * 2048 + chn];
#pragma unroll
      for (int jj = 0; jj < 4; ++jj) {
        bf16_t* yp = ybuf + (tb + i0 + 4 * fq + jj) * 2048 + chn;
        *yp = f2bf(bf2f(*yp) * ss[jj] * nw);
      }
    }
}

__device__ __forceinline__ void phase_scan1(const Params& p, int l, char* smem) {
  const int G = gridDim.x, bid = blockIdx.x;
  if (bid < 64) { hgrn_chunk_item(p, l, 32 * 16 + bid, smem); return; }
  for (int it = bid - 64; it < 256 + 512 + 2048; it += G - 64) {
    if (it < 256) ssd_pass1_item(p, l, 32 * 64 + it, smem);
    else if (it < 768) hgrn_chunk_item(p, l, it - 256, smem);
    else ssd_pass1_item(p, l, it - 768, smem);
  }
}
__device__ __forceinline__ void phase_scan2(const Params& p, int l, char* smem) {
  for (int it = blockIdx.x; it < 2048; it += gridDim.x) ssd_pass2_item(p, l, it, smem);
}

__device__ __forceinline__ void phase_scan_naive(const Params& p, int l, char* smem) {
  const int n_ssd = 36 * 64, n_hg = 36 * 16;
  for (int it = blockIdx.x; it < n_ssd + n_hg; it += gridDim.x) {
    if (it < 256) ssd_naive_item(p, l, 32 * 64 + it, (float*)smem);
    else if (it < 320) hgrn_chunk_item(p, l, 32 * 16 + (it - 256), smem);
    else if (it < 320 + 2048) ssd_naive_item(p, l, it - 320, (float*)smem);
    else hgrn_chunk_item(p, l, it - 320 - 2048, smem);
  }
}

__device__ __forceinline__ void phase_post(const Params& p, int l) {
  const int tid = tid_opaque();
  const bf16_t* proj = (const bf16_t*)(p.ws + OFF_PROJ);
  const bf16_t* xc = (const bf16_t*)(p.ws + OFF_XC);
  const float* yf = (const float*)(p.ws + OFF_YF);
  const float* yb = (const float*)(p.ws + OFF_YB);
  const float* of = (const float*)(p.ws + OFF_OF);
  const float* ob = (const float*)(p.ws + OFF_OB);
  bf16_t* ybuf = (bf16_t*)(p.ws + OFF_YBUF);
  bf16_t* obuf = (bf16_t*)(p.ws + OFF_OBUF);
  for (int tok = blockIdx.x; tok < T; tok += gridDim.x) {
    {
      const int ch = tid * 4;
      const float* a = of + (size_t)tok * 1024 + ch;
      const float* b = ob + (size_t)tok * 1024 + ch;
      uint2 gv = *(const uint2*)(proj + (size_t)tok * NPROJ_PAD + C_HG + ch);
      const unsigned gw[2] = {gv.x, gv.y};
      float v[4];
      float ss = 0.f;
#pragma unroll
      for (int j = 0; j < 4; ++j) { v[j] = a[j] + b[j]; ss += v[j] * v[j]; }
#pragma unroll
      for (int o = 16; o >= 1; o >>= 1) ss += __shfl_xor(ss, o);
      const float rstd = rsqrtf(ss * (1.f / 128.f) + 1e-6f);
      const float* nw = p.hgrn_norm_w + l * 1024 + ch;
      float r[4];
#pragma unroll
      for (int j = 0; j < 4; ++j) {
        const float gz = bf2f((bf16_t)((j & 1) ? (gw[j >> 1] >> 16) : (gw[j >> 1] & 0xffff)));
        r[j] = v[j] * rstd * nw[j] * siluf_(gz);
      }
      uint2 o2; o2.x = pack2(r[0], r[1]); o2.y = pack2(r[2], r[3]);
      *(uint2*)(obuf + (size_t)tok * 1024 + ch) = o2;
    }
  }
}


#define XB_TMO 128
#define XB_XCNT(j) (256 + 64 * (j))
#define XB_XSUB(j) (1280 + 64 * (j))
#define XB_XGEN(j) (2304 + 64 * (j))
#define XB_TOP 3328
#define XB_TOPGEN 3392
#define XCD_BAR_WORDS 3456
#define XB_SPIN_CAP (1u << 22)
#define LAS __attribute__((address_space(3)))
__device__ __forceinline__ unsigned xb_ld(unsigned* p) { return __hip_atomic_load(p, __ATOMIC_RELAXED, __HIP_MEMORY_SCOPE_AGENT); }
__device__ __forceinline__ unsigned xb_add(unsigned* p, unsigned v) { return __hip_atomic_fetch_add(p, v, __ATOMIC_RELAXED, __HIP_MEMORY_SCOPE_AGENT); }
__device__ __forceinline__ unsigned xb_xcc_id() { return (unsigned)__builtin_amdgcn_s_getreg((3 << 11) | 20) & 0xFu; }
#define XB_SPIN(cond, bar)                                                                    \
  do {                                                                                        \
    unsigned _sp = 0;                                                                         \
    while (cond) {                                                                            \
      __builtin_amdgcn_s_sleep(1);                                                            \
      if ((++_sp & 255u) == 0u) {                                                             \
        if (xb_ld(&(bar)[XB_TMO])) break;                                                     \
        if (_sp > XB_SPIN_CAP) { atomicAdd(&(bar)[XB_TMO], 1u); break; }                      \
      }                                                                                       \
    }                                                                                         \
  } while (0)
struct XcdBarrier { unsigned* bar; unsigned x; volatile LAS unsigned* st; };
__device__ __forceinline__ XcdBarrier xcd_barrier_post(unsigned* bar, volatile LAS unsigned* st) {
  XcdBarrier b; b.bar = bar; b.x = xb_xcc_id(); b.st = st;
  if (threadIdx.x == 0) (void)xb_add(&bar[XB_XCNT(b.x)], 1u);
  return b;
}
__device__ __forceinline__ void xcd_barrier_complete(unsigned* bar, unsigned x, unsigned& nloc, unsigned& nx) {
  const unsigned G = gridDim.x * gridDim.y * gridDim.z;
  unsigned sum, cnt, mine, sp = 0u;
  for (;;) {
    sum = 0u; cnt = 0u; mine = 0u;
#pragma unroll
    for (unsigned j = 0; j < 16; ++j) { const unsigned c = xb_ld(&bar[XB_XCNT(j)]); sum += c; cnt += (c > 0u) ? 1u : 0u; mine = (j == x) ? c : mine; }
    if (sum == G) break;
    __builtin_amdgcn_s_sleep(1);
    if ((++sp & 255u) == 0u) { if (xb_ld(&bar[XB_TMO])) break; if (sp > XB_SPIN_CAP) { atomicAdd(&bar[XB_TMO], 1u); break; } }
  }
  nloc = mine > 0u ? mine : 1u; nx = cnt > 0u ? cnt : 1u;
}
__device__ __forceinline__ void xcd_barrier(const XcdBarrier& b) {
  asm volatile("s_waitcnt vmcnt(0)" ::: "memory");
  __syncthreads();
  if (threadIdx.x == 0) {
    unsigned* bar = b.bar;
    __builtin_amdgcn_s_waitcnt(0);
    unsigned nloc = b.st[0], nx = b.st[1];
    if (nloc == 0u) { xcd_barrier_complete(bar, b.x, nloc, nx); b.st[0] = nloc; b.st[1] = nx; }
    const unsigned old = xb_add(&bar[XB_XSUB(b.x)], 1u);
    const unsigned gen = old / nloc;
    if (old + 1u == (gen + 1u) * nloc) {
      __builtin_amdgcn_fence(__ATOMIC_RELEASE, "agent");
      asm volatile("s_waitcnt vmcnt(0)" ::: "memory");
      const unsigned og = xb_add(&bar[XB_TOP], 1u);
      const unsigned tg = og / nx;
      if (og + 1u == (tg + 1u) * nx) xb_add(&bar[XB_TOPGEN], 1u);
      else XB_SPIN(xb_ld(&bar[XB_TOPGEN]) == tg, bar);
      __builtin_amdgcn_fence(__ATOMIC_ACQUIRE, "agent");
      xb_add(&bar[XB_XGEN(b.x)], 1u);
      asm volatile("s_waitcnt vmcnt(0)" ::: "memory");
    } else {
      XB_SPIN(xb_ld(&bar[XB_XGEN(b.x)]) == gen, bar);
      __builtin_amdgcn_fence(__ATOMIC_ACQUIRE, "agent");
      asm volatile("s_waitcnt vmcnt(0)" ::: "memory");
    }
  }
  __syncthreads();
}

enum { PH_SETUP = 0, PH_NORM1, PH_PROJ, PH_CONV, PH_SCAN, PH_POST, PH_MERGE, PH_OUT, PH_NORM2, PH_FFN1, PH_FFN2, PH_FINAL };

__device__ __forceinline__ void run_phase(const Params& p, int ph, int l, char* smem) {
  switch (ph) {
    case PH_SETUP: phase_setup(p, smem); break;
    case PH_NORM1: phase_norm(p, l, 0); break;
    case PH_PROJ: phase_gemm<G_PROJ>(p, l, smem); break;
    case PH_CONV: phase_conv(p, l); break;
    case PH_SCAN: phase_scan_naive(p, l, smem); break;
    case PH_POST: phase_post(p, l); break;
    case PH_MERGE: phase_gemm<G_MERGE>(p, l, smem); break;
    case PH_OUT: phase_gemm<G_OUT>(p, l, smem); break;
    case PH_NORM2: phase_norm(p, l, 1); break;
    case PH_FFN1: phase_gemm<G_FFN1>(p, l, smem); break;
    case PH_FFN2: phase_gemm<G_FFN2>(p, l, smem); break;
    case PH_FINAL: phase_final_norm(p); break;
  }
}

extern __shared__ __attribute__((aligned(16))) char dyn_smem[];

#if !MEGA
__global__ void __launch_bounds__(256, 2) phase_kernel(Params p, int ph, int l) { run_phase(p, ph, l, dyn_smem); }
#endif

#if MEGA
__global__ void __launch_bounds__(256, 2) mega_kernel(Params p) {
  cg::grid_group grid = cg::this_grid();
  __shared__ uint4 xb_words;
  if (threadIdx.x == 0) xb_words = make_uint4(0u, 0u, 0u, 0u);
  __syncthreads();
  XcdBarrier xb = xcd_barrier_post((unsigned*)(p.ws + OFF_BAR), (volatile LAS unsigned*)&xb_words);
  phase_setup(p, dyn_smem);
  grid.sync();
  for (int l = 0; l < DEPTH; ++l) {
#pragma unroll 1
    for (int ph = 0; ph < 10; ++ph) {
      switch (ph) {
        case 0: phase_norm(p, l, 0); break;
        case 1: phase_gemm<G_PROJ>(p, l, dyn_smem); break;
        case 2: phase_conv(p, l); break;
        case 3: phase_scan1(p, l, dyn_smem); break;
        case 4: phase_scan2(p, l, dyn_smem); phase_post(p, l); break;
        case 5: phase_gemm<G_MERGE>(p, l, dyn_smem); break;
        case 6: phase_gemm<G_OUT>(p, l, dyn_smem); break;
        case 7: phase_norm(p, l, 1); break;
        case 8: phase_gemm<G_FFN1>(p, l, dyn_smem); break;
        default: phase_gemm<G_FFN2>(p, l, dyn_smem); break;
      }
      xcd_barrier(xb);
    }
  }
  phase_final_norm(p);
}
#endif

extern "C" void kernel_launch(void* const* d_in, const int* in_sizes, int n_in, void* d_out, int out_size, void* d_ws, size_t ws_size,
                              hipStream_t stream) {
  static int grid_blocks = 0;
  if (!grid_blocks) {
    int dev = 0, cus = 0, per_cu = 0;
    (void)hipGetDevice(&dev);
    (void)hipDeviceGetAttribute(&cus, hipDeviceAttributeMultiprocessorCount, dev);
#if MEGA
    (void)hipFuncSetAttribute((const void*)mega_kernel, hipFuncAttributeMaxDynamicSharedMemorySize, SMEM_BYTES);
#endif
#if !MEGA
    (void)hipFuncSetAttribute((const void*)phase_kernel, hipFuncAttributeMaxDynamicSharedMemorySize, SMEM_BYTES);
#endif
#if MEGA
    (void)hipOccupancyMaxActiveBlocksPerMultiprocessor(&per_cu, mega_kernel, 256, SMEM_BYTES);
#else
    (void)hipOccupancyMaxActiveBlocksPerMultiprocessor(&per_cu, phase_kernel, 256, SMEM_BYTES);
#endif
    per_cu = 2;
    grid_blocks = cus * per_cu;
  }
  Params p{};
  const float** pf = (const float**)&p;
  for (int i = 0; i < 26; ++i) pf[i] = (const float*)d_in[i];
  p.out = (float*)d_out;
  p.ws = (char*)d_ws;
#if MEGA
  (void)hipMemsetAsync((char*)d_ws + OFF_BAR, 0, XCD_BAR_WORDS * 4, stream);
  void* args[] = {&p};
  hipError_t e = hipLaunchCooperativeKernel((void*)mega_kernel, dim3(grid_blocks), dim3(256), args, SMEM_BYTES, stream);
  if (e != hipSuccess) fprintf(stderr, "coop launch failed: %s\n", hipGetErrorString(e));
#else
  const int G = grid_blocks;
  phase_kernel<<<G, 256, SMEM_BYTES, stream>>>(p, PH_SETUP, 0);
  for (int l = 0; l < DEPTH; ++l)
    for (int ph = PH_NORM1; ph <= PH_FFN2; ++ph) phase_kernel<<<G, 256, SMEM_BYTES, stream>>>(p, ph, l);
  phase_kernel<<<G, 256, SMEM_BYTES, stream>>>(p, PH_FINAL, 0);
#endif
}
```

```cpp
#include <hip/hip_runtime.h>
#include <hip/hip_cooperative_groups.h>
#include <cstdio>
#include <cstdint>
namespace cg = cooperative_groups;

#ifndef MEGA
#define MEGA 1
#endif

typedef unsigned short bf16_t;
typedef short bf16x8 __attribute__((ext_vector_type(8)));
typedef float f32x4 __attribute__((ext_vector_type(4)));
typedef unsigned u32x4 __attribute__((ext_vector_type(4)));
typedef short s16x4 __attribute__((ext_vector_type(4)));
typedef unsigned u32x2 __attribute__((ext_vector_type(2)));

constexpr int D = 1024, T = 16384, TCTX = 8192, DEPTH = 4;
constexpr int NPROJ = 13376, NPROJ_PAD = 13440;
constexpr int FFN = 2816;
constexpr int C_Z = 4096, C_DT = 6144, C_HQ = 6208, C_HF = 7232, C_HI = 9280, C_HG = 10304, C_GATE = 11328;
constexpr size_t WT_IN = 0;
constexpr size_t WT_SSO = WT_IN + (size_t)NPROJ_PAD * 1024;
constexpr size_t WT_HGO = WT_SSO + (size_t)1024 * 2048;
constexpr size_t WT_OUT = WT_HGO + (size_t)1024 * 1024;
constexpr size_t WT_W13 = WT_OUT + (size_t)1024 * 1024;
constexpr size_t WT_W2 = WT_W13 + (size_t)5632 * 1024;
constexpr size_t WT_LAYER = WT_W2 + (size_t)1024 * 2816;
constexpr size_t OFF_WT = 0;
constexpr size_t OFF_H = OFF_WT + WT_LAYER * 2 * DEPTH;
constexpr size_t OFF_PROJ = OFF_H + (size_t)T * 1024 * 2;
constexpr size_t OFF_XC = OFF_PROJ + (size_t)T * NPROJ_PAD * 2;
constexpr size_t OFF_DTRAW = OFF_XC + (size_t)T * 4096 * 2;
constexpr size_t OFF_DT = OFF_DTRAW + (size_t)T * 64 * 4;
constexpr size_t OFF_YF = OFF_DT + (size_t)T * 64 * 4;
constexpr size_t OFF_YB = OFF_YF + (size_t)T * 2048 * 4;
constexpr size_t OFF_OF = OFF_YB + (size_t)T * 2048 * 4;
constexpr size_t OFF_OB = OFF_OF + (size_t)T * 1024 * 4;
constexpr size_t OFF_YBUF = OFF_OB + (size_t)T * 1024 * 4;
constexpr size_t OFF_OBUF = OFF_YBUF + (size_t)T * 2048 * 2;
constexpr size_t OFF_MBUF = OFF_OBUF + (size_t)T * 1024 * 2;
constexpr size_t OFF_MOD = OFF_MBUF + (size_t)T * 1024 * 2;
constexpr size_t OFF_LB = OFF_MOD + (size_t)DEPTH * 5 * 6144 * 4;
constexpr size_t OFF_BAR = OFF_LB + (size_t)DEPTH * 2 * 1024 * 4;
constexpr size_t OFF_END = OFF_BAR + 16384;
constexpr size_t OUT_SSM = (size_t)T * 1024;
constexpr size_t OUT_HGRN = OUT_SSM + (size_t)32 * 4 * 2 * 32 * 64 * 128;

constexpr int SMEM_BYTES = 73728;
constexpr int LDS_ROW = 128;
constexpr int LDS_TILE = 128 * LDS_ROW;

struct Params {
  const float *x_prompt, *x_sample, *c, *state_ssm, *state_hgrn, *c_ctx, *norm_mix_w, *norm_ffn_w, *ada_w, *ada_b, *w_in,
      *ssd_conv_w, *ssd_conv_b, *ssd_dt_bias, *ssd_a_log, *ssd_d, *ssd_norm_w, *hgrn_lb, *hgrn_norm_w, *w_ssd_out, *w_hgrn_out,
      *w_out, *ffn_w1, *ffn_w3, *ffn_w2, *norm_final_w;
  float* out;
  char* ws;
};

__device__ __forceinline__ bf16_t f2bf(float f) {
  unsigned u = __float_as_uint(f);
  u += 0x7fffu + ((u >> 16) & 1u);
  return (bf16_t)(u >> 16);
}
__device__ __forceinline__ float bf2f(bf16_t b) { return __uint_as_float(((unsigned)b) << 16); }
typedef __bf16 bf16x2_t __attribute__((ext_vector_type(2)));
__device__ __forceinline__ unsigned pack2(float a, float b) { bf16x2_t v = {(__bf16)a, (__bf16)b}; return __builtin_bit_cast(unsigned, v); }
__device__ __forceinline__ float sigmoidf_(float x) { return __builtin_amdgcn_rcpf(1.0f + __expf(-x)); }
__device__ __forceinline__ float siluf_(float x) { return x * __builtin_amdgcn_rcpf(1.0f + __expf(-x)); }
__device__ __forceinline__ int tid_opaque() { int t = threadIdx.x; asm volatile("" : "+v"(t)); return t; }
__device__ __forceinline__ float clamp30(float x) { return fminf(fmaxf(x, -30.f), 30.f); }
__device__ __forceinline__ float gate_ratio(float g1, float g2) { return (1.0f + __expf(-clamp30(g2))) * __builtin_amdgcn_rcpf(1.0f + __expf(-clamp30(g1))); }
__device__ __forceinline__ int mod_row(int tok) { return tok < TCTX ? 0 : 1 + ((tok - TCTX) >> 11); }

__device__ __forceinline__ void phase_setup(const Params& p, char* smem) {
  const int tid = tid_opaque(), bid = blockIdx.x, G = gridDim.x;
  {
    const size_t n4 = (size_t)T * 1024 / 4, half4 = (size_t)TCTX * 1024 / 4;
    float4* dst = (float4*)p.out;
    const float4* s0 = (const float4*)p.x_prompt;
    const float4* s1 = (const float4*)p.x_sample;
    for (size_t i = (size_t)bid * 256 + tid; i < n4; i += (size_t)G * 256) dst[i] = i < half4 ? s0[i] : s1[i - half4];
  }
  {
    float* lb = (float*)(p.ws + OFF_LB);
    for (int i = bid * 256 + tid; i < 2048; i += G * 256) {
      float v0 = p.hgrn_lb[i], v1 = p.hgrn_lb[2048 + i], v2 = p.hgrn_lb[4096 + i], v3 = p.hgrn_lb[6144 + i];
      float m = fmaxf(fmaxf(v0, v1), fmaxf(v2, v3));
      float e0 = expf(v0 - m), e1 = expf(v1 - m), e2 = expf(v2 - m), e3 = expf(v3 - m);
      float inv = 1.0f / (e0 + e1 + e2 + e3);
      lb[i] = 0.f;
      lb[2048 + i] = e1 * inv;
      lb[4096 + i] = (e1 + e2) * inv;
      lb[6144 + i] = (e1 + e2 + e3) * inv;
    }
  }
  {
    float* sm = (float*)smem;
    float* modb = (float*)(p.ws + OFF_MOD);
    __syncthreads();
    for (int i = tid; i < 5 * 1024; i += 256) {
      int v = i >> 10, k = i & 1023;
      float cv = v == 0 ? p.c_ctx[k] : p.c[(v - 1) * 1024 + k];
      sm[i] = siluf_(cv);
    }
    __syncthreads();
    float* part = sm + 5 * 1024;
    for (int item = bid; item < DEPTH * 96; item += G) {
      int l = item / 96, cg_ = item % 96;
      int col = cg_ * 64 + (tid & 63), kg = tid >> 6;
      const float* w = p.ada_w + (size_t)l * 1024 * 6144 + col;
      float a0 = 0, a1 = 0, a2 = 0, a3 = 0, a4 = 0;
      for (int k = kg * 256; k < kg * 256 + 256; ++k) {
        float wv = w[(size_t)k * 6144];
        a0 += sm[k] * wv; a1 += sm[1024 + k] * wv; a2 += sm[2048 + k] * wv; a3 += sm[3072 + k] * wv; a4 += sm[4096 + k] * wv;
      }
      __syncthreads();
      part[(kg * 5 + 0) * 64 + (tid & 63)] = a0; part[(kg * 5 + 1) * 64 + (tid & 63)] = a1; part[(kg * 5 + 2) * 64 + (tid & 63)] = a2;
      part[(kg * 5 + 3) * 64 + (tid & 63)] = a3; part[(kg * 5 + 4) * 64 + (tid & 63)] = a4;
      __syncthreads();
      for (int i = tid; i < 320; i += 256) {
        int v = i >> 6, cc = i & 63;
        float s = part[(0 * 5 + v) * 64 + cc] + part[(1 * 5 + v) * 64 + cc] + part[(2 * 5 + v) * 64 + cc] + part[(3 * 5 + v) * 64 + cc];
        int colo = cg_ * 64 + cc;
        modb[((size_t)l * 5 + v) * 6144 + colo] = s + p.ada_b[l * 6144 + colo];
      }
    }
    __syncthreads();
  }
  {
    float* tile = (float*)smem;
    const int n_in = 210 * 16, n_sso = 16 * 32, n_hgo = 16 * 16, n_out = 16 * 16, n_w13 = 88 * 16, n_w2 = 16 * 44;
    const int per_layer = n_in + n_sso + n_hgo + n_out + n_w13 + n_w2;
    for (int it = bid; it < per_layer * DEPTH; it += G) {
      int l = it / per_layer, r = it % per_layer;
      bf16_t* wt = (bf16_t*)(p.ws + OFF_WT) + (size_t)l * WT_LAYER;
      const float *src0 = nullptr, *src1 = nullptr;
      int K, Nsrc, nt, kt;
      bf16_t* dst;
      bool zero = false;
      if (r < n_in) {
        nt = r / 16; kt = r % 16; K = 1024; Nsrc = NPROJ;
        dst = wt + WT_IN;
        if (nt >= 209) zero = true;
        src0 = p.w_in + (size_t)l * 1024 * NPROJ + nt * 64; src1 = src0 + 32;
      } else if ((r -= n_in) < n_sso) {
        nt = r / 32; kt = r % 32; K = 2048; Nsrc = 1024; dst = wt + WT_SSO;
        src0 = p.w_ssd_out + (size_t)l * 2048 * 1024 + nt * 64; src1 = src0 + 32;
      } else if ((r -= n_sso) < n_hgo) {
        nt = r / 16; kt = r % 16; K = 1024; Nsrc = 1024; dst = wt + WT_HGO;
        src0 = p.w_hgrn_out + (size_t)l * 1024 * 1024 + nt * 64; src1 = src0 + 32;
      } else if ((r -= n_hgo) < n_out) {
        nt = r / 16; kt = r % 16; K = 1024; Nsrc = 1024; dst = wt + WT_OUT;
        src0 = p.w_out + (size_t)l * 1024 * 1024 + nt * 64; src1 = src0 + 32;
      } else if ((r -= n_out) < n_w13) {
        nt = r / 16; kt = r % 16; K = 1024; Nsrc = FFN; dst = wt + WT_W13;
        src0 = p.ffn_w1 + (size_t)l * 1024 * FFN + nt * 32; src1 = p.ffn_w3 + (size_t)l * 1024 * FFN + nt * 32;
      } else {
        r -= n_w13;
        nt = r / 44; kt = r % 44; K = 2816; Nsrc = 1024; dst = wt + WT_W2;
        src0 = p.ffn_w2 + (size_t)l * 2816 * 1024 + nt * 64; src1 = src0 + 32;
      }
      __syncthreads();
      {
        int c4 = (tid & 15) * 4;
        const float* s = c4 < 32 ? src0 + c4 : src1 + (c4 - 32);
#pragma unroll
        for (int i = 0; i < 4; ++i) {
          int kr = (tid >> 4) + i * 16;
          float4 v = zero ? make_float4(0.f, 0.f, 0.f, 0.f) : *(const float4*)(s + (size_t)(kt * 64 + kr) * Nsrc);
          tile[kr * 65 + c4 + 0] = v.x; tile[kr * 65 + c4 + 1] = v.y; tile[kr * 65 + c4 + 2] = v.z; tile[kr * 65 + c4 + 3] = v.w;
        }
      }
      __syncthreads();
#pragma unroll
      for (int i = 0; i < 2; ++i) {
        int cidx = tid + i * 256, n = cidx >> 3, kc = cidx & 7;
        uint4 o;
        o.x = pack2(tile[(kc * 8 + 0) * 65 + n], tile[(kc * 8 + 1) * 65 + n]);
        o.y = pack2(tile[(kc * 8 + 2) * 65 + n], tile[(kc * 8 + 3) * 65 + n]);
        o.z = pack2(tile[(kc * 8 + 4) * 65 + n], tile[(kc * 8 + 5) * 65 + n]);
        o.w = pack2(tile[(kc * 8 + 6) * 65 + n], tile[(kc * 8 + 7) * 65 + n]);
        *(uint4*)(dst + (size_t)(nt * 64 + n) * K + kt * 64 + kc * 8) = o;
      }
    }
    __syncthreads();
  }
}

__device__ __forceinline__ void phase_norm(const Params& p, int l, int which) {
  const int lane = tid_opaque() & 63, wv = tid_opaque() >> 6;
  const float* nw = (which == 0 ? p.norm_mix_w : p.norm_ffn_w) + l * 1024;
  const float* modb = (const float*)(p.ws + OFF_MOD) + (size_t)l * 5 * 6144;
  bf16_t* h = (bf16_t*)(p.ws + OFF_H);
  for (int row = blockIdx.x * 4 + wv; row < T; row += gridDim.x * 4) {
    const float* x = p.out + (size_t)row * 1024;
    const float* md = modb + (size_t)mod_row(row) * 6144 + (which == 0 ? 0 : 3072);
    float4 v[4];
    float ss = 0.f;
#pragma unroll
    for (int i = 0; i < 4; ++i) {
      v[i] = *(const float4*)(x + i * 256 + lane * 4);
      ss += v[i].x * v[i].x + v[i].y * v[i].y + v[i].z * v[i].z + v[i].w * v[i].w;
    }
#pragma unroll
    for (int o = 32; o >= 1; o >>= 1) ss += __shfl_xor(ss, o);
    float rstd = rsqrtf(ss * (1.0f / 1024.f) + 1e-6f);
#pragma unroll
    for (int i = 0; i < 4; ++i) {
      int c = i * 256 + lane * 4;
      float4 w = *(const float4*)(nw + c), sh = *(const float4*)(md + c), sc = *(const float4*)(md + 1024 + c);
      float a0 = v[i].x * rstd * w.x * (1.f + sc.x) + sh.x, a1 = v[i].y * rstd * w.y * (1.f + sc.y) + sh.y;
      float a2 = v[i].z * rstd * w.z * (1.f + sc.z) + sh.z, a3 = v[i].w * rstd * w.w * (1.f + sc.w) + sh.w;
      uint2 o2; o2.x = pack2(a0, a1); o2.y = pack2(a2, a3);
      *(uint2*)(h + (size_t)row * 1024 + c) = o2;
    }
  }
}

__device__ __forceinline__ void phase_final_norm(const Params& p) {
  const int lane = tid_opaque() & 63, wv = tid_opaque() >> 6;
  for (int row = blockIdx.x * 4 + wv; row < T; row += gridDim.x * 4) {
    float* x = p.out + (size_t)row * 1024;
    float4 v[4];
    float ss = 0.f;
#pragma unroll
    for (int i = 0; i < 4; ++i) {
      v[i] = *(const float4*)(x + i * 256 + lane * 4);
      ss += v[i].x * v[i].x + v[i].y * v[i].y + v[i].z * v[i].z + v[i].w * v[i].w;
    }
#pragma unroll
    for (int o = 32; o >= 1; o >>= 1) ss += __shfl_xor(ss, o);
    float rstd = rsqrtf(ss * (1.0f / 1024.f) + 1e-6f);
#pragma unroll
    for (int i = 0; i < 4; ++i) {
      int c = i * 256 + lane * 4;
      float4 w = *(const float4*)(p.norm_final_w + c);
      float4 o4 = make_float4(v[i].x * rstd * w.x, v[i].y * rstd * w.y, v[i].z * rstd * w.z, v[i].w * rstd * w.w);
      *(float4*)(x + c) = o4;
    }
  }
}

template <bool HASMID>
__device__ __forceinline__ void gemm_kloop2(f32x4 (&acc)[4][4], const bf16_t* __restrict__ Ag, int lda, const bf16_t* __restrict__ Bg,
                                            int ldb, int K, const bf16_t* __restrict__ Ag2, int lda2, const bf16_t* __restrict__ Bg2,
                                            int ldb2, int K2, char* smem, const bf16_t* __restrict__ gate0) {
  const int tid = tid_opaque(), lane = tid & 63, wid = tid >> 6;
  const int wr = wid >> 1, wc = wid & 1, fr = lane & 15, fq = lane >> 4;
  const int srow = tid >> 3, schunk = (tid & 7) ^ ((tid >> 4) & 7);
  const int rofs0 = (fq ^ ((fr >> 1) & 7)) * 16;
  const bf16_t* ap = Ag + (size_t)srow * lda + schunk * 8;
  const bf16_t* bp = Bg + (size_t)srow * ldb + schunk * 8;
  const int nk1 = K >> 6;
  const int nk = nk1 + (K2 >> 6);
  char* const sdst = smem + tid * 16;
#define GK_DMA(buf, t)                                                                                                   \
  {                                                                                                                      \
    _Pragma("unroll") for (int i = 0; i < 4; ++i) {                                                                      \
      __builtin_amdgcn_global_load_lds((const unsigned*)(ap + (size_t)i * 32 * lda + (size_t)(t) * 64),                  \
                                       (unsigned*)(sdst + (buf) * LDS_TILE + i * 4096), 16, 0, 0);                       \
      __builtin_amdgcn_global_load_lds((const unsigned*)(bp + (size_t)i * 32 * ldb + (size_t)(t) * 64),                  \
                                       (unsigned*)(sdst + (2 + (buf)) * LDS_TILE + i * 4096), 16, 0, 0);                 \
    }                                                                                                                    \
  }
  GK_DMA(0, 0);
  __syncthreads();
  for (int kt = 0; kt < nk; ++kt) {
    const int cur = kt & 1;
    if (kt + 1 < nk) {
      if (kt + 1 == nk1) {
        ap = Ag2 + (size_t)srow * lda2 + schunk * 8 - (size_t)nk1 * 64;
        bp = Bg2 + (size_t)srow * ldb2 + schunk * 8 - (size_t)nk1 * 64;
        lda = lda2; ldb = ldb2;
      }
      GK_DMA(cur ^ 1, kt + 1);
    }
    if (HASMID && kt == nk1) {
#pragma unroll
      for (int m = 0; m < 4; ++m)
#pragma unroll
        for (int n = 0; n < 4; ++n) {
          uint2 g1 = *(const uint2*)(gate0 + (size_t)(m * 16) * NPROJ_PAD + n * 16);
          uint2 g2 = *(const uint2*)(gate0 + (size_t)(m * 16) * NPROJ_PAD + 1024 + n * 16);
          acc[m][n][0] *= gate_ratio(bf2f((bf16_t)(g1.x & 0xffff)), bf2f((bf16_t)(g2.x & 0xffff)));
          acc[m][n][1] *= gate_ratio(bf2f((bf16_t)(g1.x >> 16)), bf2f((bf16_t)(g2.x >> 16)));
          acc[m][n][2] *= gate_ratio(bf2f((bf16_t)(g1.y & 0xffff)), bf2f((bf16_t)(g2.y & 0xffff)));
          acc[m][n][3] *= gate_ratio(bf2f((bf16_t)(g1.y >> 16)), bf2f((bf16_t)(g2.y >> 16)));
        }
    }
    const char* sa = smem + cur * LDS_TILE + (wr * 64 + fr) * LDS_ROW;
    const char* sb = smem + (2 + cur) * LDS_TILE + (wc * 64 + fr) * LDS_ROW;
#pragma unroll
    for (int kk = 0; kk < 2; ++kk) {
      bf16x8 af[4], bfv[4];
      __builtin_amdgcn_sched_barrier(0);
#pragma unroll
      for (int m = 0; m < 4; ++m) af[m] = *(const bf16x8*)(sa + m * 16 * LDS_ROW + (rofs0 ^ (kk * 64)));
#pragma unroll
      for (int n = 0; n < 4; ++n) bfv[n] = *(const bf16x8*)(sb + n * 16 * LDS_ROW + (rofs0 ^ (kk * 64)));
      __builtin_amdgcn_sched_barrier(0);
#pragma unroll
      for (int m = 0; m < 4; ++m)
#pragma unroll
        for (int n = 0; n < 4; ++n) acc[m][n] = __builtin_amdgcn_mfma_f32_16x16x32_bf16(bfv[n], af[m], acc[m][n], 0, 0, 0);
    }
    __builtin_amdgcn_sched_barrier(0);
    __syncthreads();
  }
#undef GK_DMA
}

__device__ __forceinline__ void gemm_kloop(f32x4 (&acc)[4][4], const bf16_t* __restrict__ Ag, int lda, const bf16_t* __restrict__ Bg,
                                           int ldb, int K, char* smem) {
  gemm_kloop2<false>(acc, Ag, lda, Bg, ldb, K, Ag, lda, Bg, ldb, 0, smem, Ag);
}

constexpr int BG_STAGE = 24576;
__device__ __forceinline__ int swz4(int x) { return (0x78 >> (2 * x)) & 3; }
template <bool HASMID>
__device__ __forceinline__ void gemm_kloop_big(f32x4 (&acc)[8][4], const bf16_t* __restrict__ Ag, int lda, const bf16_t* __restrict__ Bg,
                                               int ldb, int K, const bf16_t* __restrict__ Ag2, int lda2,
                                               const bf16_t* __restrict__ Bg2, int ldb2, int K2, char* smem,
                                               const bf16_t* __restrict__ gate0) {
  const int tid = tid_opaque(), lane = tid & 63, wid = tid >> 6;
  const int wr = wid >> 1, wc = wid & 1, fr = lane & 15, fq = lane >> 4;
  const int srow = tid >> 2, schunk = (tid & 3) ^ swz4((tid >> 4) & 3);
  const int rofs = (fq ^ swz4((fr >> 2) & 3)) * 16;
  const int nks1 = K >> 5;
  const int nks = nks1 + (K2 >> 5);
  const bf16_t* ap1 = Ag + (size_t)srow * lda + schunk * 8;
  const bf16_t* bp1 = Bg + (size_t)srow * ldb + schunk * 8;
  const bf16_t* ap2 = Ag2 + (size_t)srow * lda2 + schunk * 8 - (size_t)nks1 * 32;
  const bf16_t* bp2 = Bg2 + (size_t)srow * ldb2 + schunk * 8 - (size_t)nks1 * 32;
  char* const sdst = smem + tid * 16;
#define BG_DMA(slot, kk_)                                                                                                  \
  {                                                                                                                        \
    const int t_ = (kk_) < nks ? (kk_) : nks - 1;                                                                          \
    const bool s2_ = t_ >= nks1;                                                                                           \
    const bf16_t* ap_ = (s2_ ? ap2 : ap1) + (size_t)t_ * 32;                                                               \
    const bf16_t* bp_ = (s2_ ? bp2 : bp1) + (size_t)t_ * 32;                                                               \
    const size_t la_ = (size_t)64 * (s2_ ? lda2 : lda), lb_ = (size_t)64 * (s2_ ? ldb2 : ldb);                             \
    _Pragma("unroll") for (int i = 0; i < 4; ++i)                                                                          \
        __builtin_amdgcn_global_load_lds((const unsigned*)(ap_ + i * la_), (unsigned*)(sdst + (slot) * BG_STAGE + i * 4096), 16, 0, 0); \
    _Pragma("unroll") for (int i = 0; i < 2; ++i)                                                                          \
        __builtin_amdgcn_global_load_lds((const unsigned*)(bp_ + i * lb_), (unsigned*)(sdst + (slot) * BG_STAGE + 16384 + i * 4096), 16, 0, 0); \
  }
  BG_DMA(0, 0);
  BG_DMA(1, 1);
  int slot = 0;
  for (int ks = 0; ks < nks; ++ks) {
    asm volatile("s_waitcnt vmcnt(6)" ::: "memory");
    __builtin_amdgcn_s_barrier();
    asm volatile("" ::: "memory");
    const int nslot = slot == 0 ? 2 : slot - 1;
    BG_DMA(nslot, ks + 2);
    if (HASMID && ks == nks1) {
      int zofs = 0;
      asm volatile("" : "+v"(zofs));
      const bf16_t* gz = gate0 + zofs;
#pragma unroll
      for (int m = 0; m < 8; ++m)
#pragma unroll
        for (int n = 0; n < 4; ++n) {
          uint2 g1 = *(const uint2*)(gz + (size_t)(m * 16) * NPROJ_PAD + n * 16);
          uint2 g2 = *(const uint2*)(gz + (size_t)(m * 16) * NPROJ_PAD + 1024 + n * 16);
          acc[m][n][0] *= gate_ratio(bf2f((bf16_t)(g1.x & 0xffff)), bf2f((bf16_t)(g2.x & 0xffff)));
          acc[m][n][1] *= gate_ratio(bf2f((bf16_t)(g1.x >> 16)), bf2f((bf16_t)(g2.x >> 16)));
          acc[m][n][2] *= gate_ratio(bf2f((bf16_t)(g1.y & 0xffff)), bf2f((bf16_t)(g2.y & 0xffff)));
          acc[m][n][3] *= gate_ratio(bf2f((bf16_t)(g1.y >> 16)), bf2f((bf16_t)(g2.y >> 16)));
        }
    }
    const char* sa = smem + slot * BG_STAGE + (wr * 128 + fr) * 64 + rofs;
    const char* sb = smem + slot * BG_STAGE + 16384 + (wc * 64 + fr) * 64 + rofs;
    bf16x8 af[8], bfv[4];
    __builtin_amdgcn_sched_barrier(0);
#pragma unroll
    for (int n = 0; n < 4; ++n) bfv[n] = *(const bf16x8*)(sb + n * 16 * 64);
#pragma unroll
    for (int m = 0; m < 8; ++m) af[m] = *(const bf16x8*)(sa + m * 16 * 64);
    __builtin_amdgcn_sched_barrier(0);
    __builtin_amdgcn_s_setprio(1);
#pragma unroll
    for (int m = 0; m < 8; ++m)
#pragma unroll
      for (int n = 0; n < 4; ++n) acc[m][n] = __builtin_amdgcn_mfma_f32_16x16x32_bf16(bfv[n], af[m], acc[m][n], 0, 0, 0);
    __builtin_amdgcn_s_setprio(0);
    __builtin_amdgcn_sched_barrier(0);
    slot = slot == 2 ? 0 : slot + 1;
  }
  asm volatile("s_waitcnt vmcnt(0)" ::: "memory");
  __builtin_amdgcn_s_barrier();
  asm volatile("" ::: "memory");
#undef BG_DMA
}
__device__ __forceinline__ void gemm_kloop_big1(f32x4 (&acc)[8][4], const bf16_t* __restrict__ Ag, int lda, const bf16_t* __restrict__ Bg,
                                                int ldb, int K, char* smem) {
  gemm_kloop_big<false>(acc, Ag, lda, Bg, ldb, K, Ag, lda, Bg, ldb, 0, smem, Ag);
}
enum { G_PROJ = 0, G_MERGE = 1, G_OUT = 2, G_FFN1 = 3, G_FFN2 = 4 };

template <int MODE>
__device__ __forceinline__ void phase_gemm(const Params& p, int l, char* smem) {
  const int tid = tid_opaque(), lane = tid & 63, wid = tid >> 6;
  const int wr = wid >> 1, wc = wid & 1, fr = lane & 15, fq = lane >> 4;
  const bf16_t* wt = (const bf16_t*)(p.ws + OFF_WT) + (size_t)l * WT_LAYER;
  const bf16_t* hbuf = (const bf16_t*)(p.ws + OFF_H);
  bf16_t* proj = (bf16_t*)(p.ws + OFF_PROJ);
  bf16_t* hidden = (bf16_t*)(p.ws + OFF_PROJ);
  const float* modb = (const float*)(p.ws + OFF_MOD) + (size_t)l * 5 * 6144;
  constexpr int nM = T / 256;
  constexpr int nN = MODE == G_PROJ ? NPROJ_PAD / 128 : (MODE == G_FFN1 ? 5632 / 128 : 1024 / 128);
  for (int t = blockIdx.x; t < nM * nN; t += gridDim.x) {
    const int pm = t % nM, pn = t / nM;
    const int row0 = pm * 256, col0 = pn * 128;
    f32x4 acc[8][4];
#pragma unroll
    for (int m = 0; m < 8; ++m)
#pragma unroll
      for (int n = 0; n < 4; ++n) acc[m][n] = (f32x4){0.f, 0.f, 0.f, 0.f};
    if (MODE == G_PROJ) {
      gemm_kloop_big1(acc, hbuf + (size_t)row0 * 1024, 1024, wt + WT_IN + (size_t)col0 * 1024, 1024, 1024, smem);
      float* dtraw = (float*)(p.ws + OFF_DTRAW);
#pragma unroll
      for (int m = 0; m < 8; ++m) {
        const int row = row0 + wr * 128 + m * 16 + fr;
#pragma unroll
        for (int n = 0; n < 4; ++n) {
          const int col = col0 + wc * 64 + n * 16 + fq * 4;
          uint2 o; o.x = pack2(acc[m][n][0], acc[m][n][1]); o.y = pack2(acc[m][n][2], acc[m][n][3]);
          *(uint2*)(proj + (size_t)row * NPROJ_PAD + col) = o;
          if (col >= C_DT && col < C_DT + 64) *(f32x4*)(dtraw + (size_t)row * 64 + (col - C_DT)) = acc[m][n];
        }
      }
    } else if (MODE == G_MERGE) {
      const bf16_t* ybuf = (const bf16_t*)(p.ws + OFF_YBUF);
      const bf16_t* obuf = (const bf16_t*)(p.ws + OFF_OBUF);
      bf16_t* mbuf = (bf16_t*)(p.ws + OFF_MBUF);
      gemm_kloop_big<true>(acc, ybuf + (size_t)row0 * 2048, 2048, wt + WT_SSO + (size_t)col0 * 2048, 2048, 2048,
                        obuf + (size_t)row0 * 1024, 1024, wt + WT_HGO + (size_t)col0 * 1024, 1024, 1024, smem,
                        proj + (size_t)(row0 + wr * 128 + fr) * NPROJ_PAD + C_GATE + col0 + wc * 64 + fq * 4);
#pragma unroll
      for (int m = 0; m < 8; ++m) {
        const int row = row0 + wr * 128 + m * 16 + fr;
#pragma unroll
        for (int n = 0; n < 4; ++n) {
          const int col = col0 + wc * 64 + n * 16 + fq * 4;
          uint2 g = *(const uint2*)(proj + (size_t)row * NPROJ_PAD + C_GATE + 1024 + col);
          float r0 = acc[m][n][0] * sigmoidf_(clamp30(bf2f((bf16_t)(g.x & 0xffff))));
          float r1 = acc[m][n][1] * sigmoidf_(clamp30(bf2f((bf16_t)(g.x >> 16))));
          float r2 = acc[m][n][2] * sigmoidf_(clamp30(bf2f((bf16_t)(g.y & 0xffff))));
          float r3 = acc[m][n][3] * sigmoidf_(clamp30(bf2f((bf16_t)(g.y >> 16))));
          uint2 o; o.x = pack2(r0, r1); o.y = pack2(r2, r3);
          *(uint2*)(mbuf + (size_t)row * 1024 + col) = o;
        }
      }
    } else if (MODE == G_OUT || MODE == G_FFN2) {
      if (MODE == G_OUT) {
        const bf16_t* mbuf = (const bf16_t*)(p.ws + OFF_MBUF);
        gemm_kloop_big1(acc, mbuf + (size_t)row0 * 1024, 1024, wt + WT_OUT + (size_t)col0 * 1024, 1024, 1024, smem);
      } else {
        gemm_kloop_big1(acc, hidden + (size_t)row0 * FFN, FFN, wt + WT_W2 + (size_t)col0 * FFN, FFN, FFN, smem);
      }
      const float* gate = modb + (size_t)mod_row(row0) * 6144 + (MODE == G_OUT ? 2048 : 5120);
#pragma unroll
      for (int m = 0; m < 8; ++m) {
        const int row = row0 + wr * 128 + m * 16 + fr;
#pragma unroll
        for (int n = 0; n < 4; ++n) {
          const int col = col0 + wc * 64 + n * 16 + fq * 4;
          f32x4 g = *(const f32x4*)(gate + col);
          f32x4* xp = (f32x4*)(p.out + (size_t)row * 1024 + col);
          f32x4 xv = *xp;
          xv += g * acc[m][n];
          *xp = xv;
        }
      }
    } else {
      gemm_kloop_big1(acc, hbuf + (size_t)row0 * 1024, 1024, wt + WT_W13 + (size_t)col0 * 1024, 1024, 1024, smem);
#pragma unroll
      for (int m = 0; m < 8; ++m) {
        const int row = row0 + wr * 128 + m * 16 + fr;
#pragma unroll
        for (int n = 0; n < 2; ++n) {
          const int hcol = (pn * 2 + wc) * 32 + n * 16 + fq * 4;
          float r[4];
#pragma unroll
          for (int j = 0; j < 4; ++j) r[j] = siluf_(acc[m][n][j]) * acc[m][n + 2][j];
          uint2 o; o.x = pack2(r[0], r[1]); o.y = pack2(r[2], r[3]);
          *(uint2*)(hidden + (size_t)row * FFN + hcol) = o;
        }
      }
    }
  }
}

__device__ __forceinline__ void phase_conv(const Params& p, int l) {
  const bf16_t* proj = (const bf16_t*)(p.ws + OFF_PROJ);
  bf16_t* xc = (bf16_t*)(p.ws + OFF_XC);
  const float* cw = p.ssd_conv_w + (size_t)l * 5 * 4096;
  const float* cb = p.ssd_conv_b + (size_t)l * 4096;
  for (int unit = blockIdx.x * 256 + tid_opaque(); unit < 512 * 256; unit += gridDim.x * 256) {
    const int ch = (unit & 511) * 8, sg = unit >> 9;
    const int t0 = sg * 64;
    int lo, hi;
    if (t0 < TCTX) { lo = t0 & ~255; hi = lo + 256; } else { lo = t0; hi = t0 + 64; }
    float w[5][8], bias[8];
#pragma unroll
    for (int k = 0; k < 5; ++k) {
      const f32x4 a = *(const f32x4*)(cw + k * 4096 + ch), b = *(const f32x4*)(cw + k * 4096 + ch + 4);
      w[k][0] = a[0]; w[k][1] = a[1]; w[k][2] = a[2]; w[k][3] = a[3]; w[k][4] = b[0]; w[k][5] = b[1]; w[k][6] = b[2]; w[k][7] = b[3];
    }
    {
      const f32x4 a = *(const f32x4*)(cb + ch), b = *(const f32x4*)(cb + ch + 4);
      bias[0] = a[0]; bias[1] = a[1]; bias[2] = a[2]; bias[3] = a[3]; bias[4] = b[0]; bias[5] = b[1]; bias[6] = b[2]; bias[7] = b[3];
    }
    const u32x4 zero4 = (u32x4){0u, 0u, 0u, 0u};
    u32x4 r0, r1, r2, r3, r4;
#define CV_LD(tt) (((tt) >= lo && (tt) < hi) ? *(const u32x4*)(proj + (size_t)(tt) * NPROJ_PAD + ch) : zero4)
    r0 = CV_LD(t0 - 2); r1 = CV_LD(t0 - 1); r2 = CV_LD(t0); r3 = CV_LD(t0 + 1);
#pragma unroll 4
    for (int t = t0; t < t0 + 64; ++t) {
      r4 = CV_LD(t + 2);
      float a[8];
#pragma unroll
      for (int j = 0; j < 8; ++j) a[j] = bias[j];
#define CV_ACC(R, k)                                                                                                     \
  _Pragma("unroll") for (int e = 0; e < 4; ++e) {                                                                        \
    a[2 * e] += w[k][2 * e] * bf2f((bf16_t)(R[e] & 0xffff));                                                             \
    a[2 * e + 1] += w[k][2 * e + 1] * bf2f((bf16_t)(R[e] >> 16));                                                        \
  }
      CV_ACC(r0, 0) CV_ACC(r1, 1) CV_ACC(r2, 2) CV_ACC(r3, 3) CV_ACC(r4, 4)
      u32x4 o;
      o[0] = pack2(siluf_(a[0]), siluf_(a[1])); o[1] = pack2(siluf_(a[2]), siluf_(a[3]));
      o[2] = pack2(siluf_(a[4]), siluf_(a[5])); o[3] = pack2(siluf_(a[6]), siluf_(a[7]));
      *(u32x4*)(xc + (size_t)t * 4096 + ch) = o;
      r0 = r1; r1 = r2; r2 = r3; r3 = r4;
    }
#undef CV_LD
#undef CV_ACC
  }
  const float* dtraw = (const float*)(p.ws + OFF_DTRAW);
  float* dt = (float*)(p.ws + OFF_DT);
  for (size_t i = (size_t)blockIdx.x * 256 + tid_opaque(); i < (size_t)T * 64; i += (size_t)gridDim.x * 256) {
    float v = dtraw[i] + p.ssd_dt_bias[l * 64 + (int)(i & 63)];
    dt[i] = v > 20.f ? v : log1pf(expf(v));
  }
}

__device__ __forceinline__ void ssd_naive_item(const Params& p, int l, int item, float* sm) {
  const int d = item & 1, h = (item >> 1) & 31, s = item >> 6;
  int tok0, L;
  if (s < 32) { tok0 = s * 256; L = 256; } else { tok0 = TCTX + (s - 32) * 2048; L = 2048; }
  const int tid = tid_opaque(), pp = tid >> 2, nq = tid & 3, g = h >> 2;
  float S[32];
  if (s < 32) {
#pragma unroll
    for (int i = 0; i < 32; ++i) S[i] = 0.f;
  } else {
    const float* st = p.state_ssm + ((((size_t)(s - 32) * 4 + l) * 2 + d) * 32 + h) * 8192 + pp * 128 + nq * 32;
#pragma unroll
    for (int i = 0; i < 32; ++i) S[i] = st[i];
  }
  const float a = -expf(p.ssd_a_log[l * 64 + d * 32 + h]);
  float* xs = sm; float* Bs = sm + 1024; float* Cs = Bs + 2048; float* dts = Cs + 2048;
  const bf16_t* xc = (const bf16_t*)(p.ws + OFF_XC);
  const float* dtb = (const float*)(p.ws + OFF_DT);
  float* ydir = (float*)(p.ws + (d == 0 ? OFF_YF : OFF_YB));
  for (int bt = 0; bt < L / 16; ++bt) {
    const int tb = d == 0 ? bt * 16 : L - 16 - bt * 16;
    __syncthreads();
    for (int e = tid; e < 16 * 320; e += 256) {
      const int tt = e / 320, c = e % 320;
      const size_t base = (size_t)(tok0 + tb + tt) * 4096;
      if (c < 64) xs[tt * 64 + c] = bf2f(xc[base + h * 64 + c]);
      else if (c < 192) Bs[tt * 128 + c - 64] = bf2f(xc[base + 2048 + g * 128 + c - 64]);
      else Cs[tt * 128 + c - 192] = bf2f(xc[base + 3072 + g * 128 + c - 192]);
    }
    if (tid < 16) dts[tid] = dtb[(size_t)(tok0 + tb + tid) * 64 + d * 32 + h];
    __syncthreads();
    for (int i2 = 0; i2 < 16; ++i2) {
      const int tt = d == 0 ? i2 : 15 - i2;
      const float dt = dts[tt], dA = expf(dt * a), xdt = xs[tt * 64 + pp] * dt;
      float acc = 0.f;
      const float* Bp = Bs + tt * 128 + nq * 32;
      const float* Cp = Cs + tt * 128 + nq * 32;
#pragma unroll
      for (int i = 0; i < 32; ++i) { S[i] = dA * S[i] + xdt * Bp[i]; acc += S[i] * Cp[i]; }
      acc += __shfl_xor(acc, 1); acc += __shfl_xor(acc, 2);
      if (nq == 0) ydir[(size_t)(tok0 + tb + tt) * 2048 + h * 64 + pp] = acc;
    }
  }
  if (s < 32) {
    float* o = p.out + OUT_SSM + ((((size_t)s * 4 + l) * 2 + d) * 32 + h) * 8192 + pp * 128 + nq * 32;
#pragma unroll
    for (int i = 0; i < 32; ++i) o[i] = S[i];
  }
}

__device__ __forceinline__ void hgrn_naive_item(const Params& p, int l, int item, float* sm) {
  const int d = item & 1, hd = (item >> 1) & 7, s = item >> 4;
  int tok0, L;
  if (s < 32) { tok0 = s * 256; L = 256; } else { tok0 = TCTX + (s - 32) * 2048; L = 2048; }
  const int tid = tid_opaque(), vv = tid >> 1, kh = tid & 1;
  float S[64];
  if (s < 32) {
#pragma unroll
    for (int i = 0; i < 64; ++i) S[i] = 0.f;
  } else {
    const float* st = p.state_hgrn + ((((size_t)(s - 32) * 4 + l) * 2 + d) * 8 + hd) * 16384 + (size_t)(kh * 64) * 128 + vv;
#pragma unroll
    for (int i = 0; i < 64; ++i) S[i] = st[(size_t)i * 128];
  }
  float* qs = sm; float* fs = sm + 2048; float* ks = sm + 4096; float* vs = sm + 6144;
  const bf16_t* proj = (const bf16_t*)(p.ws + OFF_PROJ);
  const float* lb = (const float*)(p.ws + OFF_LB) + (size_t)l * 2048 + d * 1024 + hd * 128;
  float* odir = (float*)(p.ws + (d == 0 ? OFF_OF : OFF_OB));
  for (int bt = 0; bt < L / 16; ++bt) {
    const int tb = d == 0 ? bt * 16 : L - 16 - bt * 16;
    __syncthreads();
    for (int e = tid; e < 16 * 128; e += 256) {
      const int tt = e >> 7, c = e & 127;
      const size_t base = (size_t)(tok0 + tb + tt) * NPROJ_PAD;
      const float q = bf2f(proj[base + C_HQ + hd * 128 + c]);
      const float u = bf2f(proj[base + C_HF + d * 1024 + hd * 128 + c]);
      const float lbv = lb[c];
      const float sg = sigmoidf_(u);
      qs[e] = siluf_(q);
      fs[e] = lbv + (1.f - lbv) * sg;
      ks[e] = (1.f - lbv) * (1.f - sg);
      vs[e] = bf2f(proj[base + C_HI + hd * 128 + c]);
    }
    __syncthreads();
    for (int i2 = 0; i2 < 16; ++i2) {
      const int tt = d == 0 ? i2 : 15 - i2;
      const float vval = vs[tt * 128 + vv];
      const float* fp = fs + tt * 128 + kh * 64;
      const float* kp = ks + tt * 128 + kh * 64;
      const float* qp = qs + tt * 128 + kh * 64;
      float acc = 0.f;
#pragma unroll
      for (int i = 0; i < 64; ++i) { S[i] = fp[i] * S[i] + kp[i] * vval; acc += S[i] * qp[i]; }
      acc += __shfl_xor(acc, 1);
      if (kh == 0) odir[(size_t)(tok0 + tb + tt) * 1024 + hd * 128 + vv] = acc;
    }
  }
  if (s < 32) {
    float* o = p.out + OUT_HGRN + ((((size_t)s * 4 + l) * 2 + d) * 8 + hd) * 16384 + (size_t)(kh * 64) * 128 + vv;
#pragma unroll
    for (int i = 0; i < 64; ++i) o[(size_t)i * 128] = S[i];
  }
}


constexpr int HG_ROW = 272;
constexpr int HG_IMG = 16 * HG_ROW;
constexpr int HG_BUF = 4 * HG_IMG + 512;
__device__ __forceinline__ void hgrn_chunk_item(const Params& p, int l, int item, char* smem) {
  const int d = item & 1, hd = (item >> 1) & 7, s = item >> 4;
  int tok0, L;
  if (s < 32) { tok0 = s * 256; L = 256; } else { tok0 = TCTX + (s - 32) * 2048; L = 2048; }
  const int tid = tid_opaque(), lane = tid & 63, w = tid >> 6, fr = lane & 15, fq = lane >> 4;
  const int ch = tid & 127, half = tid >> 7;
  f32x4 S[8][2];
  if (s < 32) {
#pragma unroll
    for (int kt = 0; kt < 8; ++kt) { S[kt][0] = (f32x4){0.f, 0.f, 0.f, 0.f}; S[kt][1] = (f32x4){0.f, 0.f, 0.f, 0.f}; }
  } else {
    const float* st = p.state_hgrn + ((((size_t)(s - 32) * 4 + l) * 2 + d) * 8 + hd) * 16384;
#pragma unroll
    for (int kt = 0; kt < 8; ++kt)
#pragma unroll
      for (int vt = 0; vt < 2; ++vt)
#pragma unroll
        for (int jj = 0; jj < 4; ++jj) S[kt][vt][jj] = st[(size_t)(16 * kt + fq * 4 + jj) * 128 + 32 * w + 16 * vt + fr];
  }
  const float lbv = ((const float*)(p.ws + OFF_LB))[(size_t)l * 2048 + d * 1024 + hd * 128 + ch];
  const bf16_t* proj = (const bf16_t*)(p.ws + OFF_PROJ);
  float* odir = (float*)(p.ws + (d == 0 ? OFF_OF : OFF_OB));
  float* xch = (float*)(smem + 2 * HG_BUF);
  const int nch = L >> 4;
  bf16_t rq[8], ru[8], rv[8];
  __syncthreads();
  {
#pragma unroll
    for (int i = 0; i < 8; ++i) {
      const int pos = 8 * half + i;
      const size_t tk = (size_t)(d == 0 ? tok0 + pos : tok0 + L - 1 - pos) * NPROJ_PAD;
      rq[i] = proj[tk + C_HQ + hd * 128 + ch];
      ru[i] = proj[tk + C_HF + d * 1024 + hd * 128 + ch];
      rv[i] = proj[tk + C_HI + hd * 128 + ch];
    }
  }
  for (int c = 0; c < nch; ++c) {
    char* buf = smem + (c & 1) * HG_BUF;
    float* xc_ = xch + (c & 1) * 256;
    float fv[8], kk[8], qs[8];
    float loc = 1.f;
#pragma unroll
    for (int i = 0; i < 8; ++i) {
      const float u = bf2f(ru[i]);
      const float sg = sigmoidf_(u);
      fv[i] = lbv + (1.f - lbv) * sg;
      kk[i] = (1.f - lbv) * (1.f - sg);
      qs[i] = siluf_(bf2f(rq[i]));
      loc *= fv[i];
      *(bf16_t*)(buf + 3 * HG_IMG + (8 * half + i) * HG_ROW + ch * 2) = rv[i];
    }
    xc_[half * 128 + ch] = loc;
    if (c + 1 < nch) {
#pragma unroll
      for (int i = 0; i < 8; ++i) {
        const int pos = (c + 1) * 16 + 8 * half + i;
        const size_t tk = (size_t)(d == 0 ? tok0 + pos : tok0 + L - 1 - pos) * NPROJ_PAD;
        rq[i] = proj[tk + C_HQ + hd * 128 + ch];
        ru[i] = proj[tk + C_HF + d * 1024 + hd * 128 + ch];
        rv[i] = proj[tk + C_HI + hd * 128 + ch];
      }
    }
    __syncthreads();
    {
      const float other = xc_[(half ^ 1) * 128 + ch];
      float P = half ? other : 1.f;
      float sfx = half ? 1.f : other;
      float suf[8];
#pragma unroll
      for (int i = 7; i >= 0; --i) { suf[i] = sfx; sfx *= fv[i]; }
#pragma unroll
      for (int i = 0; i < 8; ++i) {
        P *= fv[i];
        const int off = (8 * half + i) * HG_ROW + ch * 2;
        *(bf16_t*)(buf + off) = f2bf(qs[i] * P);
        *(bf16_t*)(buf + HG_IMG + off) = f2bf(kk[i] * __builtin_amdgcn_rcpf(fmaxf(P, 1e-30f)));
        *(bf16_t*)(buf + 2 * HG_IMG + off) = f2bf(kk[i] * suf[i]);
      }
      if (half) ((float*)(buf + 4 * HG_IMG))[ch] = P;
    }
    __syncthreads();
    const char* qtI = buf;
    const char* ktI = buf + HG_IMG;
    const float* dec = (const float*)(buf + 4 * HG_IMG);
    f32x4 at = (f32x4){0.f, 0.f, 0.f, 0.f};
#pragma unroll
    for (int ks = 0; ks < 4; ++ks) {
      bf16x8 a = *(const bf16x8*)(ktI + fr * HG_ROW + (32 * ks + fq * 8) * 2);
      bf16x8 b = *(const bf16x8*)(qtI + fr * HG_ROW + (32 * ks + fq * 8) * 2);
      at = __builtin_amdgcn_mfma_f32_16x16x32_bf16(a, b, at, 0, 0, 0);
    }
    s16x4 Pm;
    {
      u32x2 pk;
      pk[0] = pack2((fq * 4 + 0 <= fr) ? at[0] : 0.f, (fq * 4 + 1 <= fr) ? at[1] : 0.f);
      pk[1] = pack2((fq * 4 + 2 <= fr) ? at[2] : 0.f, (fq * 4 + 3 <= fr) ? at[3] : 0.f);
      Pm = __builtin_bit_cast(s16x4, pk);
    }
    const unsigned ldsb = (unsigned)(size_t)buf;
    const unsigned vaddr = ldsb + 3 * HG_IMG + (4 * fq + (fr >> 2)) * HG_ROW + (32 * w + 4 * (fr & 3)) * 2;
    const unsigned kaddr = ldsb + 2 * HG_IMG + (4 * fq + (fr >> 2)) * HG_ROW + (4 * (fr & 3)) * 2;
    s16x4 vf0, vf1, kf0, kf1, kf2, kf3, kf4, kf5, kf6, kf7;
    asm volatile(
        "ds_read_b64_tr_b16 %0, %10\n\t"
        "ds_read_b64_tr_b16 %1, %10 offset:32\n\t"
        "ds_read_b64_tr_b16 %2, %11\n\t"
        "ds_read_b64_tr_b16 %3, %11 offset:32\n\t"
        "ds_read_b64_tr_b16 %4, %11 offset:64\n\t"
        "ds_read_b64_tr_b16 %5, %11 offset:96\n\t"
        "ds_read_b64_tr_b16 %6, %11 offset:128\n\t"
        "ds_read_b64_tr_b16 %7, %11 offset:160\n\t"
        "ds_read_b64_tr_b16 %8, %11 offset:192\n\t"
        "ds_read_b64_tr_b16 %9, %11 offset:224\n\t"
        "s_waitcnt lgkmcnt(0)"
        : "=&v"(vf0), "=&v"(vf1), "=&v"(kf0), "=&v"(kf1), "=&v"(kf2), "=&v"(kf3), "=&v"(kf4), "=&v"(kf5), "=&v"(kf6), "=&v"(kf7)
        : "v"(vaddr), "v"(kaddr)
        : "memory");
    f32x4 o0 = __builtin_amdgcn_mfma_f32_16x16x16bf16_1k(Pm, vf0, (f32x4){0.f, 0.f, 0.f, 0.f}, 0, 0, 0);
    f32x4 o1 = __builtin_amdgcn_mfma_f32_16x16x16bf16_1k(Pm, vf1, (f32x4){0.f, 0.f, 0.f, 0.f}, 0, 0, 0);
#pragma unroll
    for (int ks = 0; ks < 4; ++ks) {
      u32x2 qa = *(const u32x2*)(qtI + fr * HG_ROW + (32 * ks + 4 * fq) * 2);
      u32x2 qb = *(const u32x2*)(qtI + fr * HG_ROW + (32 * ks + 16 + 4 * fq) * 2);
      u32x4 aa; aa[0] = qa[0]; aa[1] = qa[1]; aa[2] = qb[0]; aa[3] = qb[1];
      const bf16x8 A = __builtin_bit_cast(bf16x8, aa);
      u32x4 b0, b1;
      b0[0] = pack2(S[2 * ks][0][0], S[2 * ks][0][1]); b0[1] = pack2(S[2 * ks][0][2], S[2 * ks][0][3]);
      b0[2] = pack2(S[2 * ks + 1][0][0], S[2 * ks + 1][0][1]); b0[3] = pack2(S[2 * ks + 1][0][2], S[2 * ks + 1][0][3]);
      b1[0] = pack2(S[2 * ks][1][0], S[2 * ks][1][1]); b1[1] = pack2(S[2 * ks][1][2], S[2 * ks][1][3]);
      b1[2] = pack2(S[2 * ks + 1][1][0], S[2 * ks + 1][1][1]); b1[3] = pack2(S[2 * ks + 1][1][2], S[2 * ks + 1][1][3]);
      o0 = __builtin_amdgcn_mfma_f32_16x16x32_bf16(A, __builtin_bit_cast(bf16x8, b0), o0, 0, 0, 0);
      o1 = __builtin_amdgcn_mfma_f32_16x16x32_bf16(A, __builtin_bit_cast(bf16x8, b1), o1, 0, 0, 0);
    }
#pragma unroll
    for (int jj = 0; jj < 4; ++jj) {
      const int pos = c * 16 + fq * 4 + jj;
      const size_t tk = (size_t)(d == 0 ? tok0 + pos : tok0 + L - 1 - pos);
      odir[tk * 1024 + hd * 128 + 32 * w + fr] = o0[jj];
      odir[tk * 1024 + hd * 128 + 32 * w + 16 + fr] = o1[jj];
    }
    const s16x4 kfs[8] = {kf0, kf1, kf2, kf3, kf4, kf5, kf6, kf7};
#pragma unroll
    for (int kt = 0; kt < 8; ++kt) {
      const f32x4 dv = *(const f32x4*)(dec + 16 * kt + fq * 4);
      S[kt][0] = __builtin_amdgcn_mfma_f32_16x16x16bf16_1k(kfs[kt], vf0, S[kt][0] * dv, 0, 0, 0);
      S[kt][1] = __builtin_amdgcn_mfma_f32_16x16x16bf16_1k(kfs[kt], vf1, S[kt][1] * dv, 0, 0, 0);
    }
  }
  if (s < 32) {
    float* o = p.out + OUT_HGRN + ((((size_t)s * 4 + l) * 2 + d) * 8 + hd) * 16384;
#pragma unroll
    for (int kt = 0; kt < 8; ++kt)
#pragma unroll
      for (int vt = 0; vt < 2; ++vt)
#pragma unroll
        for (int jj = 0; jj < 4; ++jj) o[(size_t)(16 * kt + fq * 4 + jj) * 128 + 32 * w + 16 * vt + fr] = S[kt][vt][jj];
  }
}


constexpr size_t OFF_SST = OFF_YF;
constexpr size_t OFF_CS = OFF_YB;
constexpr int SS_BROW = 272, SS_XROW = 144;
constexpr int SS_R0 = 128 * SS_BROW;
constexpr int SS_R1 = 128 * SS_XROW;

template <int OFF>
__device__ __forceinline__ s16x4 tr_read(unsigned addr) {
  s16x4 r;
  asm volatile("ds_read_b64_tr_b16 %0, %1 offset:%2" : "=v"(r) : "v"(addr), "i"(OFF) : "memory");
  return r;
}
__device__ __forceinline__ bf16x8 cat8(s16x4 a, s16x4 b) {
  bf16x8 r;
  r[0] = a[0]; r[1] = a[1]; r[2] = a[2]; r[3] = a[3]; r[4] = b[0]; r[5] = b[1]; r[6] = b[2]; r[7] = b[3];
  return r;
}
#define TR_WAIT12(a, b, c, d, e, f, g, h, i, j, k, l_)                                                                            \
  asm volatile("s_waitcnt lgkmcnt(0)" : "+v"(a), "+v"(b), "+v"(c), "+v"(d), "+v"(e), "+v"(f), "+v"(g), "+v"(h), "+v"(i), "+v"(j), \
               "+v"(k), "+v"(l_)::"memory")
#define TR_WAIT8(a, b, c, d, e, f, g, h) \
  asm volatile("s_waitcnt lgkmcnt(0)" : "+v"(a), "+v"(b), "+v"(c), "+v"(d), "+v"(e), "+v"(f), "+v"(g), "+v"(h)::"memory")

template <int KS>
__device__ __forceinline__ void ssd_p1_kstep(f32x4 (&acc)[2][4], unsigned abase, unsigned xbase) {
  s16x4 a00 = tr_read<KS * 32 * SS_BROW>(abase), a01 = tr_read<KS * 32 * SS_BROW + 4 * SS_BROW>(abase);
  s16x4 a10 = tr_read<KS * 32 * SS_BROW + 32>(abase), a11 = tr_read<KS * 32 * SS_BROW + 4 * SS_BROW + 32>(abase);
  s16x4 b00 = tr_read<KS * 32 * SS_XROW>(xbase), b01 = tr_read<KS * 32 * SS_XROW + 4 * SS_XROW>(xbase);
  s16x4 b10 = tr_read<KS * 32 * SS_XROW + 32>(xbase), b11 = tr_read<KS * 32 * SS_XROW + 4 * SS_XROW + 32>(xbase);
  s16x4 b20 = tr_read<KS * 32 * SS_XROW + 64>(xbase), b21 = tr_read<KS * 32 * SS_XROW + 4 * SS_XROW + 64>(xbase);
  s16x4 b30 = tr_read<KS * 32 * SS_XROW + 96>(xbase), b31 = tr_read<KS * 32 * SS_XROW + 4 * SS_XROW + 96>(xbase);
  TR_WAIT12(a00, a01, a10, a11, b00, b01, b10, b11, b20, b21, b30, b31);
  const bf16x8 A0 = cat8(a00, a01), A1 = cat8(a10, a11);
  const bf16x8 B0 = cat8(b00, b01), B1 = cat8(b10, b11), B2 = cat8(b20, b21), B3 = cat8(b30, b31);
  acc[0][0] = __builtin_amdgcn_mfma_f32_16x16x32_bf16(A0, B0, acc[0][0], 0, 0, 0);
  acc[0][1] = __builtin_amdgcn_mfma_f32_16x16x32_bf16(A0, B1, acc[0][1], 0, 0, 0);
  acc[0][2] = __builtin_amdgcn_mfma_f32_16x16x32_bf16(A0, B2, acc[0][2], 0, 0, 0);
  acc[0][3] = __builtin_amdgcn_mfma_f32_16x16x32_bf16(A0, B3, acc[0][3], 0, 0, 0);
  acc[1][0] = __builtin_amdgcn_mfma_f32_16x16x32_bf16(A1, B0, acc[1][0], 0, 0, 0);
  acc[1][1] = __builtin_amdgcn_mfma_f32_16x16x32_bf16(A1, B1, acc[1][1], 0, 0, 0);
  acc[1][2] = __builtin_amdgcn_mfma_f32_16x16x32_bf16(A1, B2, acc[1][2], 0, 0, 0);
  acc[1][3] = __builtin_amdgcn_mfma_f32_16x16x32_bf16(A1, B3, acc[1][3], 0, 0, 0);
}

__device__ __forceinline__ void ssd_pass1_item(const Params& p, int l, int item, char* smem) {
  const int d = item & 1, h = (item >> 1) & 31, s = item >> 6, g = h >> 2;
  const int nc = s < 32 ? 2 : 16, cg0 = s < 32 ? 2 * s : 64 + 16 * (s - 32);
  const int tid = tid_opaque(), lane = tid & 63, w = tid >> 6, fr = lane & 15, fq = lane >> 4;
  const float a = -expf(p.ssd_a_log[l * 64 + d * 32 + h]);
  f32x4 acc[2][4];
  if (s < 32) {
#pragma unroll
    for (int i = 0; i < 2; ++i)
#pragma unroll
      for (int j = 0; j < 4; ++j) acc[i][j] = (f32x4){0.f, 0.f, 0.f, 0.f};
  } else {
    const float* st = p.state_ssm + ((((size_t)(s - 32) * 4 + l) * 2 + d) * 32 + h) * 8192;
#pragma unroll
    for (int i = 0; i < 2; ++i)
#pragma unroll
      for (int j = 0; j < 4; ++j) acc[i][j] = *(const f32x4*)(st + (size_t)(16 * j + fr) * 128 + 32 * w + 16 * i + 4 * fq);
  }
  const bf16_t* xc = (const bf16_t*)(p.ws + OFF_XC);
  const float* dtb = (const float*)(p.ws + OFF_DT);
  float* csb = (float*)(p.ws + OFF_CS);
  bf16_t* sst = (bf16_t*)(p.ws + OFF_SST);
  float* wgt = (float*)(smem + SS_R0 + SS_R1);
  u32x4 pb[8], px[4];
  float dt0, dt1;
  {
    const int c = d == 0 ? 0 : nc - 1;
    const size_t tb = (size_t)(cg0 + c) * 128;
#pragma unroll
    for (int i = 0; i < 8; ++i) { const int q = tid + 256 * i; pb[i] = *(const u32x4*)(xc + (tb + (q >> 4)) * 4096 + 2048 + g * 128 + (q & 15) * 8); }
#pragma unroll
    for (int i = 0; i < 4; ++i) { const int q = tid + 256 * i; px[i] = *(const u32x4*)(xc + (tb + (q >> 3)) * 4096 + h * 64 + (q & 7) * 8); }
    dt0 = dtb[(tb + 2 * lane) * 64 + d * 32 + h];
    dt1 = dtb[(tb + 2 * lane + 1) * 64 + d * 32 + h];
  }
  const unsigned ldsb = (unsigned)(size_t)smem;
  const unsigned abase = ldsb + (8 * fq + (fr >> 2)) * SS_BROW + (32 * w + 4 * (fr & 3)) * 2;
  const unsigned xbase = ldsb + SS_R0 + (8 * fq + (fr >> 2)) * SS_XROW + (4 * (fr & 3)) * 2;
  for (int cc = 0; cc < nc; ++cc) {
    const int c = d == 0 ? cc : nc - 1 - cc, par = cc & 1;
    const size_t cgl = cg0 + c, tb = cgl * 128;
    {
      bf16_t* so = sst + ((cgl * 32 + h) * 2 + d) * 8192;
#pragma unroll
      for (int i = 0; i < 2; ++i)
#pragma unroll
        for (int j = 0; j < 4; ++j) {
          u32x2 o; o[0] = pack2(acc[i][j][0], acc[i][j][1]); o[1] = pack2(acc[i][j][2], acc[i][j][3]);
          *(u32x2*)(so + (size_t)(16 * j + fr) * 128 + 32 * w + 16 * i + 4 * fq) = o;
        }
    }
    if (w == 0) {
      const float v0 = dt0 * a, v1 = dt1 * a, sloc = v0 + v1;
      float incl = sloc;
#pragma unroll
      for (int off = 1; off < 64; off <<= 1) { const float t = __shfl_up(incl, off); if (lane >= off) incl += t; }
      const float excl = incl - sloc, c0 = excl + v0, tot = __shfl(incl, 63);
      float cs0, cs1, wg0, wg1;
      if (d == 0) { cs0 = c0; cs1 = incl; wg0 = dt0 * __expf(tot - c0); wg1 = dt1 * __expf(tot - incl); }
      else { cs0 = tot - excl; cs1 = tot - c0; wg0 = dt0 * __expf(excl); wg1 = dt1 * __expf(c0); }
      csb[(tb + 2 * lane) * 64 + d * 32 + h] = cs0;
      csb[(tb + 2 * lane + 1) * 64 + d * 32 + h] = cs1;
      wgt[par * 128 + 2 * lane] = wg0;
      wgt[par * 128 + 2 * lane + 1] = wg1;
      if (lane == 0) wgt[256 + par] = __expf(tot);
    }
    __syncthreads();
#pragma unroll
    for (int i = 0; i < 8; ++i) { const int q = tid + 256 * i; *(u32x4*)(smem + (q >> 4) * SS_BROW + (q & 15) * 16) = pb[i]; }
#pragma unroll
    for (int i = 0; i < 4; ++i) {
      const int q = tid + 256 * i, row = q >> 3;
      const float wv = wgt[par * 128 + row];
      u32x4 o;
#pragma unroll
      for (int e = 0; e < 4; ++e) o[e] = pack2(bf2f((bf16_t)(px[i][e] & 0xffff)) * wv, bf2f((bf16_t)(px[i][e] >> 16)) * wv);
      *(u32x4*)(smem + SS_R0 + row * SS_XROW + (q & 7) * 16) = o;
    }
    if (cc + 1 < nc) {
      const int cn = d == 0 ? cc + 1 : nc - 2 - cc;
      const size_t tbn = (size_t)(cg0 + cn) * 128;
#pragma unroll
      for (int i = 0; i < 8; ++i) { const int q = tid + 256 * i; pb[i] = *(const u32x4*)(xc + (tbn + (q >> 4)) * 4096 + 2048 + g * 128 + (q & 15) * 8); }
#pragma unroll
      for (int i = 0; i < 4; ++i) { const int q = tid + 256 * i; px[i] = *(const u32x4*)(xc + (tbn + (q >> 3)) * 4096 + h * 64 + (q & 7) * 8); }
      dt0 = dtb[(tbn + 2 * lane) * 64 + d * 32 + h];
      dt1 = dtb[(tbn + 2 * lane + 1) * 64 + d * 32 + h];
    }
    __syncthreads();
    const float dec = wgt[256 + par];
#pragma unroll
    for (int i = 0; i < 2; ++i)
#pragma unroll
      for (int j = 0; j < 4; ++j) acc[i][j] *= dec;
    ssd_p1_kstep<0>(acc, abase, xbase);
    ssd_p1_kstep<1>(acc, abase, xbase);
    ssd_p1_kstep<2>(acc, abase, xbase);
    ssd_p1_kstep<3>(acc, abase, xbase);
  }
  if (s < 32) {
    float* o = p.out + OUT_SSM + ((((size_t)s * 4 + l) * 2 + d) * 32 + h) * 8192;
#pragma unroll
    for (int i = 0; i < 2; ++i)
#pragma unroll
      for (int j = 0; j < 4; ++j) *(f32x4*)(o + (size_t)(16 * j + fr) * 128 + 32 * w + 16 * i + 4 * fq) = acc[i][j];
  }
  __syncthreads();
}

template <int KS>
__device__ __forceinline__ void ssd_p2_wx_kstep(f32x4 (&y)[4], const char* wrow, unsigned xbase) {
  s16x4 b00 = tr_read<KS * 32 * SS_XROW>(xbase), b01 = tr_read<KS * 32 * SS_XROW + 4 * SS_XROW>(xbase);
  s16x4 b10 = tr_read<KS * 32 * SS_XROW + 32>(xbase), b11 = tr_read<KS * 32 * SS_XROW + 4 * SS_XROW + 32>(xbase);
  s16x4 b20 = tr_read<KS * 32 * SS_XROW + 64>(xbase), b21 = tr_read<KS * 32 * SS_XROW + 4 * SS_XROW + 64>(xbase);
  s16x4 b30 = tr_read<KS * 32 * SS_XROW + 96>(xbase), b31 = tr_read<KS * 32 * SS_XROW + 4 * SS_XROW + 96>(xbase);
  const bf16x8 A = *(const bf16x8*)(wrow + KS * 64);
  TR_WAIT8(b00, b01, b10, b11, b20, b21, b30, b31);
  y[0] = __builtin_amdgcn_mfma_f32_16x16x32_bf16(A, cat8(b00, b01), y[0], 0, 0, 0);
  y[1] = __builtin_amdgcn_mfma_f32_16x16x32_bf16(A, cat8(b10, b11), y[1], 0, 0, 0);
  y[2] = __builtin_amdgcn_mfma_f32_16x16x32_bf16(A, cat8(b20, b21), y[2], 0, 0, 0);
  y[3] = __builtin_amdgcn_mfma_f32_16x16x32_bf16(A, cat8(b30, b31), y[3], 0, 0, 0);
}

__device__ __forceinline__ void ssd_pass2_item(const Params& p, int l, int item, char* smem) {
  const int hf = item & 1, g = (item >> 1) & 7, cg = item >> 4;
  const size_t tb = (size_t)cg * 128;
  const int tid = tid_opaque(), lane = tid & 63, w = tid >> 6, fr = lane & 15, fq = lane >> 4;
  const int i0 = 64 * hf + 16 * w;
  const bf16_t* xc = (const bf16_t*)(p.ws + OFF_XC);
  const bf16_t* proj = (const bf16_t*)(p.ws + OFF_PROJ);
  const float* dtb = (const float*)(p.ws + OFF_DT);
  const float* csb = (const float*)(p.ws + OFF_CS);
  const bf16_t* sst = (const bf16_t*)(p.ws + OFF_SST);
  bf16_t* ybuf = (bf16_t*)(p.ws + OFF_YBUF);
  float* arr = (float*)(smem + SS_R0 + SS_R1);
  __syncthreads();
  bf16x8 cfr[4];
#pragma unroll
  for (int ks = 0; ks < 4; ++ks) cfr[ks] = *(const bf16x8*)(xc + (tb + i0 + fr) * 4096 + 3072 + g * 128 + 32 * ks + 8 * fq);
#pragma unroll
  for (int i = 0; i < 8; ++i) {
    const int idx = tid + 256 * i, hh = idx >> 9, a = (idx >> 7) & 3, j = idx & 127;
    const float* src = (a < 2 ? csb : dtb) + (tb + j) * 64 + (a & 1) * 32 + 4 * g + hh;
    arr[idx] = *src;
  }
#pragma unroll
  for (int i = 0; i < 8; ++i) {
    const int q = tid + 256 * i;
    *(u32x4*)(smem + (q >> 4) * SS_BROW + (q & 15) * 16) = *(const u32x4*)(xc + (tb + (q >> 4)) * 4096 + 2048 + g * 128 + (q & 15) * 8);
  }
  __syncthreads();
  f32x4 cb[8];
#pragma unroll
  for (int jt = 0; jt < 8; ++jt) cb[jt] = (f32x4){0.f, 0.f, 0.f, 0.f};
#pragma unroll
  for (int ks = 0; ks < 4; ++ks)
#pragma unroll
    for (int jt = 0; jt < 8; ++jt) {
      const bf16x8 A = *(const bf16x8*)(smem + (16 * jt + fr) * SS_BROW + (32 * ks + 8 * fq) * 2);
      cb[jt] = __builtin_amdgcn_mfma_f32_16x16x32_bf16(A, cfr[ks], cb[jt], 0, 0, 0);
    }
  __syncthreads();
  float ss[4] = {0.f, 0.f, 0.f, 0.f};
  const unsigned ldsb = (unsigned)(size_t)smem;
  const unsigned xbase = ldsb + SS_R0 + (8 * fq + (fr >> 2)) * SS_XROW + (4 * (fr & 3)) * 2;
  const char* wrow = smem + (16 * w + fr) * SS_BROW + (8 * fq) * 2;
  const int il = i0 + fr;
#pragma unroll 1
  for (int hh = 0; hh < 4; ++hh) {
    const int h = 4 * g + hh;
    u32x4 pre[4];
#pragma unroll
    for (int i = 0; i < 4; ++i) { const int q = tid + 256 * i; pre[i] = *(const u32x4*)(xc + (tb + (q >> 3)) * 4096 + h * 64 + (q & 7) * 8); }
    const float* csf = arr + hh * 512;
    const float* csr = csf + 128;
    const float* dtf = csf + 256;
    const float* dtr = csf + 384;
    {
      const float cfi = csf[il], cbi = csr[il];
#pragma unroll
      for (int jt = 0; jt < 8; ++jt) {
        const f32x4 cfj = *(const f32x4*)(csf + 16 * jt + 4 * fq), cbj = *(const f32x4*)(csr + 16 * jt + 4 * fq);
        const f32x4 dfj = *(const f32x4*)(dtf + 16 * jt + 4 * fq), dbj = *(const f32x4*)(dtr + 16 * jt + 4 * fq);
        float wv[4];
#pragma unroll
        for (int jj = 0; jj < 4; ++jj) {
          const int j = 16 * jt + 4 * fq + jj;
          const float lf = (j <= il) ? __expf(cfi - cfj[jj]) * dfj[jj] : 0.f;
          const float lr = (j >= il) ? __expf(cbi - cbj[jj]) * dbj[jj] : 0.f;
          wv[jj] = cb[jt][jj] * (lf + lr);
        }
        u32x2 o; o[0] = pack2(wv[0], wv[1]); o[1] = pack2(wv[2], wv[3]);
        *(u32x2*)(smem + (16 * w + fr) * SS_BROW + (16 * jt + 4 * fq) * 2) = o;
      }
    }
#pragma unroll
    for (int i = 0; i < 4; ++i) { const int q = tid + 256 * i; *(u32x4*)(smem + SS_R0 + (q >> 3) * SS_XROW + (q & 7) * 16) = pre[i]; }
#pragma unroll
    for (int i = 0; i < 4; ++i) { const int q = tid + 256 * i; pre[i] = *(const u32x4*)(sst + (((size_t)cg * 32 + h) * 2 + 0) * 8192 + (q >> 4) * 128 + (q & 15) * 8); }
    __syncthreads();
    f32x4 y[4];
#pragma unroll
    for (int pt = 0; pt < 4; ++pt) y[pt] = (f32x4){0.f, 0.f, 0.f, 0.f};
    ssd_p2_wx_kstep<0>(y, wrow, xbase);
    ssd_p2_wx_kstep<1>(y, wrow, xbase);
    ssd_p2_wx_kstep<2>(y, wrow, xbase);
    ssd_p2_wx_kstep<3>(y, wrow, xbase);
    float xsk[4][4];
#pragma unroll
    for (int pt = 0; pt < 4; ++pt)
#pragma unroll
      for (int jj = 0; jj < 4; ++jj) xsk[pt][jj] = bf2f(*(const bf16_t*)(smem + SS_R0 + (i0 + 4 * fq + jj) * SS_XROW + (16 * pt + fr) * 2));
    __syncthreads();
#pragma unroll
    for (int i = 0; i < 4; ++i) { const int q = tid + 256 * i; *(u32x4*)(smem + SS_R0 + (q >> 4) * SS_BROW + (q & 15) * 16) = pre[i]; }
#pragma unroll
    for (int i = 0; i < 4; ++i) { const int q = tid + 256 * i; pre[i] = *(const u32x4*)(sst + (((size_t)cg * 32 + h) * 2 + 1) * 8192 + (q >> 4) * 128 + (q & 15) * 8); }
    __syncthreads();
    f32x4 zf[4], zb[4];
#pragma unroll
    for (int pt = 0; pt < 4; ++pt) { zf[pt] = (f32x4){0.f, 0.f, 0.f, 0.f}; zb[pt] = (f32x4){0.f, 0.f, 0.f, 0.f}; }
#pragma unroll
    for (int ks = 0; ks < 4; ++ks)
#pragma unroll
      for (int pt = 0; pt < 4; ++pt) {
        const bf16x8 B = *(const bf16x8*)(smem + SS_R0 + (16 * pt + fr) * SS_BROW + (32 * ks + 8 * fq) * 2);
        zf[pt] = __builtin_amdgcn_mfma_f32_16x16x32_bf16(cfr[ks], B, zf[pt], 0, 0, 0);
      }
    __syncthreads();
#pragma unroll
    for (int i = 0; i < 4; ++i) { const int q = tid + 256 * i; *(u32x4*)(smem + SS_R0 + (q >> 4) * SS_BROW + (q & 15) * 16) = pre[i]; }
    __syncthreads();
#pragma unroll
    for (int ks = 0; ks < 4; ++ks)
#pragma unroll
      for (int pt = 0; pt < 4; ++pt) {
        const bf16x8 B = *(const bf16x8*)(smem + SS_R0 + (16 * pt + fr) * SS_BROW + (32 * ks + 8 * fq) * 2);
        zb[pt] = __builtin_amdgcn_mfma_f32_16x16x32_bf16(cfr[ks], B, zb[pt], 0, 0, 0);
      }
    const float dsk = p.ssd_d[l * 32 + h];
#pragma unroll
    for (int jj = 0; jj < 4; ++jj) {
      const int i2 = i0 + 4 * fq + jj;
      const float ef = __expf(csf[i2]), eb = __expf(csr[i2]);
#pragma unroll
      for (int pt = 0; pt < 4; ++pt) {
        const float z = bf2f(proj[(tb + i2) * NPROJ_PAD + C_Z + h * 64 + 16 * pt + fr]);
        float val = y[pt][jj] + ef * zf[pt][jj] + eb * zb[pt][jj] + dsk * xsk[pt][jj];
        val *= siluf_(z);
        ybuf[(tb + i2) * 2048 + h * 64 + 16 * pt + fr] = f2bf(val);
        ss[jj] += val * val;
      }
    }
    __syncthreads();
  }
#pragma unroll
  for (int jj = 0; jj < 4; ++jj) {
    float t = ss[jj];
    t += __shfl_xor(t, 1); t += __shfl_xor(t, 2); t += __shfl_xor(t, 4); t += __shfl_xor(t, 8);
    ss[jj] = rsqrtf(t * (1.f / 256.f) + 1e-6f);
  }
#pragma unroll
  for (int hh = 0; hh < 4; ++hh)
#pragma unroll
    for (int pt = 0; pt < 4; ++pt) {
      const int chn = (4 * g + hh) * 64 + 16 * pt + fr;
      const float nw = p.ssd_norm_w[l * 2048 + chn];
#pragma unroll
      for (int jj = 0; jj < 4; ++jj) {
        bf16_t* yp = ybuf + (tb + i0 + 4 * fq + jj) * 2048 + chn;
        *yp = f2bf(bf2f(*yp) * ss[jj] * nw);
      }
    }
}

__device__ __forceinline__ void phase_scan1(const Params& p, int l, char* smem) {
  const int G = gridDim.x, bid = blockIdx.x;
  if (bid < 64) { hgrn_chunk_item(p, l, 32 * 16 + bid, smem); return; }
  for (int it = bid - 64; it < 256 + 512 + 2048; it += G - 64) {
    if (it < 256) ssd_pass1_item(p, l, 32 * 64 + it, smem);
    else if (it < 768) hgrn_chunk_item(p, l, it - 256, smem);
    else ssd_pass1_item(p, l, it - 768, smem);
  }
}
__device__ __forceinline__ void phase_scan2(const Params& p, int l, char* smem) {
  for (int it = blockIdx.x; it < 2048; it += gridDim.x) ssd_pass2_item(p, l, it, smem);
}

__device__ __forceinline__ void phase_scan_naive(const Params& p, int l, char* smem) {
  const int n_ssd = 36 * 64, n_hg = 36 * 16;
  for (int it = blockIdx.x; it < n_ssd + n_hg; it += gridDim.x) {
    if (it < 256) ssd_naive_item(p, l, 32 * 64 + it, (float*)smem);
    else if (it < 320) hgrn_chunk_item(p, l, 32 * 16 + (it - 256), smem);
    else if (it < 320 + 2048) ssd_naive_item(p, l, it - 320, (float*)smem);
    else hgrn_chunk_item(p, l, it - 320 - 2048, smem);
  }
}

__device__ __forceinline__ void phase_post(const Params& p, int l) {
  const int tid = tid_opaque();
  const bf16_t* proj = (const bf16_t*)(p.ws + OFF_PROJ);
  const bf16_t* xc = (const bf16_t*)(p.ws + OFF_XC);
  const float* yf = (const float*)(p.ws + OFF_YF);
  const float* yb = (const float*)(p.ws + OFF_YB);
  const float* of = (const float*)(p.ws + OFF_OF);
  const float* ob = (const float*)(p.ws + OFF_OB);
  bf16_t* ybuf = (bf16_t*)(p.ws + OFF_YBUF);
  bf16_t* obuf = (bf16_t*)(p.ws + OFF_OBUF);
  for (int tok = blockIdx.x; tok < T; tok += gridDim.x) {
    {
      const int ch = tid * 4;
      const float* a = of + (size_t)tok * 1024 + ch;
      const float* b = ob + (size_t)tok * 1024 + ch;
      uint2 gv = *(const uint2*)(proj + (size_t)tok * NPROJ_PAD + C_HG + ch);
      const unsigned gw[2] = {gv.x, gv.y};
      float v[4];
      float ss = 0.f;
#pragma unroll
      for (int j = 0; j < 4; ++j) { v[j] = a[j] + b[j]; ss += v[j] * v[j]; }
#pragma unroll
      for (int o = 16; o >= 1; o >>= 1) ss += __shfl_xor(ss, o);
      const float rstd = rsqrtf(ss * (1.f / 128.f) + 1e-6f);
      const float* nw = p.hgrn_norm_w + l * 1024 + ch;
      float r[4];
#pragma unroll
      for (int j = 0; j < 4; ++j) {
        const float gz = bf2f((bf16_t)((j & 1) ? (gw[j >> 1] >> 16) : (gw[j >> 1] & 0xffff)));
        r[j] = v[j] * rstd * nw[j] * siluf_(gz);
      }
      uint2 o2; o2.x = pack2(r[0], r[1]); o2.y = pack2(r[2], r[3]);
      *(uint2*)(obuf + (size_t)tok * 1024 + ch) = o2;
    }
  }
}


#define XB_TMO 128
#define XB_XCNT(j) (256 + 64 * (j))
#define XB_XSUB(j) (1280 + 64 * (j))
#define XB_XGEN(j) (2304 + 64 * (j))
#define XB_TOP 3328
#define XB_TOPGEN 3392
#define XCD_BAR_WORDS 3456
#define XB_SPIN_CAP (1u << 22)
#define LAS __attribute__((address_space(3)))
__device__ __forceinline__ unsigned xb_ld(unsigned* p) { return __hip_atomic_load(p, __ATOMIC_RELAXED, __HIP_MEMORY_SCOPE_AGENT); }
__device__ __forceinline__ unsigned xb_add(unsigned* p, unsigned v) { return __hip_atomic_fetch_add(p, v, __ATOMIC_RELAXED, __HIP_MEMORY_SCOPE_AGENT); }
__device__ __forceinline__ unsigned xb_xcc_id() { return (unsigned)__builtin_amdgcn_s_getreg((3 << 11) | 20) & 0xFu; }
#define XB_SPIN(cond, bar)                                                                    \
  do {                                                                                        \
    unsigned _sp = 0;                                                                         \
    while (cond) {                                                                            \
      __builtin_amdgcn_s_sleep(1);                                                            \
      if ((++_sp & 255u) == 0u) {                                                             \
        if (xb_ld(&(bar)[XB_TMO])) break;                                                     \
        if (_sp > XB_SPIN_CAP) { atomicAdd(&(bar)[XB_TMO], 1u); break; }                      \
      }                                                                                       \
    }                                                                                         \
  } while (0)
struct XcdBarrier { unsigned* bar; unsigned x; volatile LAS unsigned* st; };
__device__ __forceinline__ XcdBarrier xcd_barrier_post(unsigned* bar, volatile LAS unsigned* st) {
  XcdBarrier b; b.bar = bar; b.x = xb_xcc_id(); b.st = st;
  if (threadIdx.x == 0) (void)xb_add(&bar[XB_XCNT(b.x)], 1u);
  return b;
}
__device__ __forceinline__ void xcd_barrier_complete(unsigned* bar, unsigned x, unsigned& nloc, unsigned& nx) {
  const unsigned G = gridDim.x * gridDim.y * gridDim.z;
  unsigned sum, cnt, mine, sp = 0u;
  for (;;) {
    sum = 0u; cnt = 0u; mine = 0u;
#pragma unroll
    for (unsigned j = 0; j < 16; ++j) { const unsigned c = xb_ld(&bar[XB_XCNT(j)]); sum += c; cnt += (c > 0u) ? 1u : 0u; mine = (j == x) ? c : mine; }
    if (sum == G) break;
    __builtin_amdgcn_s_sleep(1);
    if ((++sp & 255u) == 0u) { if (xb_ld(&bar[XB_TMO])) break; if (sp > XB_SPIN_CAP) { atomicAdd(&bar[XB_TMO], 1u); break; } }
  }
  nloc = mine > 0u ? mine : 1u; nx = cnt > 0u ? cnt : 1u;
}
__device__ __forceinline__ void xcd_barrier(const XcdBarrier& b) {
  asm volatile("s_waitcnt vmcnt(0)" ::: "memory");
  __syncthreads();
  if (threadIdx.x == 0) {
    unsigned* bar = b.bar;
    __builtin_amdgcn_s_waitcnt(0);
    unsigned nloc = b.st[0], nx = b.st[1];
    if (nloc == 0u) { xcd_barrier_complete(bar, b.x, nloc, nx); b.st[0] = nloc; b.st[1] = nx; }
    const unsigned old = xb_add(&bar[XB_XSUB(b.x)], 1u);
    const unsigned gen = old / nloc;
    if (old + 1u == (gen + 1u) * nloc) {
      __builtin_amdgcn_fence(__ATOMIC_RELEASE, "agent");
      asm volatile("s_waitcnt vmcnt(0)" ::: "memory");
      const unsigned og = xb_add(&bar[XB_TOP], 1u);
      const unsigned tg = og / nx;
      if (og + 1u == (tg + 1u) * nx) xb_add(&bar[XB_TOPGEN], 1u);
      else XB_SPIN(xb_ld(&bar[XB_TOPGEN]) == tg, bar);
      __builtin_amdgcn_fence(__ATOMIC_ACQUIRE, "agent");
      xb_add(&bar[XB_XGEN(b.x)], 1u);
      asm volatile("s_waitcnt vmcnt(0)" ::: "memory");
    } else {
      XB_SPIN(xb_ld(&bar[XB_XGEN(b.x)]) == gen, bar);
      __builtin_amdgcn_fence(__ATOMIC_ACQUIRE, "agent");
      asm volatile("s_waitcnt vmcnt(0)" ::: "memory");
    }
  }
  __syncthreads();
}

enum { PH_SETUP = 0, PH_NORM1, PH_PROJ, PH_CONV, PH_SCAN, PH_POST, PH_MERGE, PH_OUT, PH_NORM2, PH_FFN1, PH_FFN2, PH_FINAL };

__device__ __forceinline__ void run_phase(const Params& p, int ph, int l, char* smem) {
  switch (ph) {
    case PH_SETUP: phase_setup(p, smem); break;
    case PH_NORM1: phase_norm(p, l, 0); break;
    case PH_PROJ: phase_gemm<G_PROJ>(p, l, smem); break;
    case PH_CONV: phase_conv(p, l); break;
    case PH_SCAN: phase_scan_naive(p, l, smem); break;
    case PH_POST: phase_post(p, l); break;
    case PH_MERGE: phase_gemm<G_MERGE>(p, l, smem); break;
    case PH_OUT: phase_gemm<G_OUT>(p, l, smem); break;
    case PH_NORM2: phase_norm(p, l, 1); break;
    case PH_FFN1: phase_gemm<G_FFN1>(p, l, smem); break;
    case PH_FFN2: phase_gemm<G_FFN2>(p, l, smem); break;
    case PH_FINAL: phase_final_norm(p); break;
  }
}

extern __shared__ __attribute__((aligned(16))) char dyn_smem[];

#if !MEGA
__global__ void __launch_bounds__(256, 2) phase_kernel(Params p, int ph, int l) { run_phase(p, ph, l, dyn_smem); }
#endif

#if MEGA
__global__ void __launch_bounds__(256, 2) mega_kernel(Params p) {
  cg::grid_group grid = cg::this_grid();
  __shared__ uint4 xb_words;
  if (threadIdx.x == 0) xb_words = make_uint4(0u, 0u, 0u, 0u);
  __syncthreads();
  XcdBarrier xb = xcd_barrier_post((unsigned*)(p.ws + OFF_BAR), (volatile LAS unsigned*)&xb_words);
  phase_setup(p, dyn_smem);
  grid.sync();
  for (int l = 0; l < DEPTH; ++l) {
#pragma unroll 1
    for (int ph = 0; ph < 10; ++ph) {
      switch (ph) {
        case 0: phase_norm(p, l, 0); break;
        case 1: phase_gemm<G_PROJ>(p, l, dyn_smem); break;
        case 2: phase_conv(p, l); break;
        case 3: phase_scan1(p, l, dyn_smem); break;
        case 4: phase_scan2(p, l, dyn_smem); phase_post(p, l); break;
        case 5: phase_gemm<G_MERGE>(p, l, dyn_smem); break;
        case 6: phase_gemm<G_OUT>(p, l, dyn_smem); break;
        case 7: phase_norm(p, l, 1); break;
        case 8: phase_gemm<G_FFN1>(p, l, dyn_smem); break;
        default: phase_gemm<G_FFN2>(p, l, dyn_smem); break;
      }
      xcd_barrier(xb);
    }
  }
  phase_final_norm(p);
}
#endif

extern "C" void kernel_launch(void* const* d_in, const int* in_sizes, int n_in, void* d_out, int out_size, void* d_ws, size_t ws_size,
                              hipStream_t stream) {
  static int grid_blocks = 0;
  if (!grid_blocks) {
    int dev = 0, cus = 0, per_cu = 0;
    (void)hipGetDevice(&dev);
    (void)hipDeviceGetAttribute(&cus, hipDeviceAttributeMultiprocessorCount, dev);
#if MEGA
    (void)hipFuncSetAttribute((const void*)mega_kernel, hipFuncAttributeMaxDynamicSharedMemorySize, SMEM_BYTES);
#endif
#if !MEGA
    (void)hipFuncSetAttribute((const void*)phase_kernel, hipFuncAttributeMaxDynamicSharedMemorySize, SMEM_BYTES);
#endif
#if MEGA
    (void)hipOccupancyMaxActiveBlocksPerMultiprocessor(&per_cu, mega_kernel, 256, SMEM_BYTES);
#else
    (void)hipOccupancyMaxActiveBlocksPerMultiprocessor(&per_cu, phase_kernel, 256, SMEM_BYTES);
#endif
    per_cu = 2;
    grid_blocks = cus * per_cu;
  }
  Params p{};
  const float** pf = (const float**)&p;
  for (int i = 0; i < 26; ++i) pf[i] = (const float*)d_in[i];
  p.out = (float*)d_out;
  p.ws = (char*)d_ws;
#if MEGA
  (void)hipMemsetAsync((char*)d_ws + OFF_BAR, 0, XCD_BAR_WORDS * 4, stream);
  void* args[] = {&p};
  hipError_t e = hipLaunchCooperativeKernel((void*)mega_kernel, dim3(grid_blocks), dim3(256), args, SMEM_BYTES, stream);
  if (e != hipSuccess) fprintf(stderr, "coop launch failed: %s\n", hipGetErrorString(e));
#else
  const int G = grid_blocks;
  phase_kernel<<<G, 256, SMEM_BYTES, stream>>>(p, PH_SETUP, 0);
  for (int l = 0; l < DEPTH; ++l)
    for (int ph = PH_NORM1; ph <= PH_FFN2; ++ph) phase_kernel<<<G, 256, SMEM_BYTES, stream>>>(p, ph, l);
  phase_kernel<<<G, 256, SMEM_BYTES, stream>>>(p, PH_FINAL, 0);
#endif
}
```

```cpp
#include <hip/hip_runtime.h>
#include <hip/hip_cooperative_groups.h>
#include <cstdio>
#include <cstdint>
namespace cg = cooperative_groups;

#ifndef MEGA
#define MEGA 1
#endif

typedef unsigned short bf16_t;
typedef short bf16x8 __attribute__((ext_vector_type(8)));
typedef float f32x4 __attribute__((ext_vector_type(4)));
typedef unsigned u32x4 __attribute__((ext_vector_type(4)));
typedef short s16x4 __attribute__((ext_vector_type(4)));
typedef unsigned u32x2 __attribute__((ext_vector_type(2)));

constexpr int D = 1024, T = 16384, TCTX = 8192, DEPTH = 4;
constexpr int NPROJ = 13376, NPROJ_PAD = 13440;
constexpr int FFN = 2816;
constexpr int C_Z = 4096, C_DT = 6144, C_HQ = 6208, C_HF = 7232, C_HI = 9280, C_HG = 10304, C_GATE = 11328;
constexpr size_t WT_IN = 0;
constexpr size_t WT_SSO = WT_IN + (size_t)NPROJ_PAD * 1024;
constexpr size_t WT_HGO = WT_SSO + (size_t)1024 * 2048;
constexpr size_t WT_OUT = WT_HGO + (size_t)1024 * 1024;
constexpr size_t WT_W13 = WT_OUT + (size_t)1024 * 1024;
constexpr size_t WT_W2 = WT_W13 + (size_t)5632 * 1024;
constexpr size_t WT_LAYER = WT_W2 + (size_t)1024 * 2816;
constexpr size_t OFF_WT = 0;
constexpr size_t OFF_H = OFF_WT + WT_LAYER * 2 * DEPTH;
constexpr size_t OFF_PROJ = OFF_H + (size_t)T * 1024 * 2;
constexpr size_t OFF_XC = OFF_PROJ + (size_t)T * NPROJ_PAD * 2;
constexpr size_t OFF_DTRAW = OFF_XC + (size_t)T * 4096 * 2;
constexpr size_t OFF_DT = OFF_DTRAW + (size_t)T * 64 * 4;
constexpr size_t OFF_YF = OFF_DT + (size_t)T * 64 * 4;
constexpr size_t OFF_YB = OFF_YF + (size_t)T * 2048 * 4;
constexpr size_t OFF_OF = OFF_YB + (size_t)T * 2048 * 4;
constexpr size_t OFF_OB = OFF_OF + (size_t)T * 1024 * 4;
constexpr size_t OFF_YBUF = OFF_OB + (size_t)T * 1024 * 4;
constexpr size_t OFF_OBUF = OFF_YBUF + (size_t)T * 2048 * 2;
constexpr size_t OFF_MBUF = OFF_OBUF + (size_t)T * 1024 * 2;
constexpr size_t OFF_MOD = OFF_MBUF + (size_t)T * 1024 * 2;
constexpr size_t OFF_LB = OFF_MOD + (size_t)DEPTH * 5 * 6144 * 4;
constexpr size_t OFF_BAR = OFF_LB + (size_t)DEPTH * 2 * 1024 * 4;
constexpr size_t OFF_END = OFF_BAR + 16384;
constexpr size_t OUT_SSM = (size_t)T * 1024;
constexpr size_t OUT_HGRN = OUT_SSM + (size_t)32 * 4 * 2 * 32 * 64 * 128;

constexpr int SMEM_BYTES = 73728;
constexpr int LDS_ROW = 128;
constexpr int LDS_TILE = 128 * LDS_ROW;

struct Params {
  const float *x_prompt, *x_sample, *c, *state_ssm, *state_hgrn, *c_ctx, *norm_mix_w, *norm_ffn_w, *ada_w, *ada_b, *w_in,
      *ssd_conv_w, *ssd_conv_b, *ssd_dt_bias, *ssd_a_log, *ssd_d, *ssd_norm_w, *hgrn_lb, *hgrn_norm_w, *w_ssd_out, *w_hgrn_out,
      *w_out, *ffn_w1, *ffn_w3, *ffn_w2, *norm_final_w;
  float* out;
  char* ws;
};

__device__ __forceinline__ bf16_t f2bf(float f) {
  unsigned u = __float_as_uint(f);
  u += 0x7fffu + ((u >> 16) & 1u);
  return (bf16_t)(u >> 16);
}
__device__ __forceinline__ float bf2f(bf16_t b) { return __uint_as_float(((unsigned)b) << 16); }
typedef __bf16 bf16x2_t __attribute__((ext_vector_type(2)));
__device__ __forceinline__ unsigned pack2(float a, float b) { bf16x2_t v = {(__bf16)a, (__bf16)b}; return __builtin_bit_cast(unsigned, v); }
__device__ __forceinline__ float sigmoidf_(float x) { return __builtin_amdgcn_rcpf(1.0f + __expf(-x)); }
__device__ __forceinline__ float siluf_(float x) { return x * __builtin_amdgcn_rcpf(1.0f + __expf(-x)); }
__device__ __forceinline__ int tid_opaque() { int t = threadIdx.x; asm volatile("" : "+v"(t)); return t; }
__device__ __forceinline__ float clamp30(float x) { return fminf(fmaxf(x, -30.f), 30.f); }
__device__ __forceinline__ float gate_ratio(float g1, float g2) { return (1.0f + __expf(-clamp30(g2))) * __builtin_amdgcn_rcpf(1.0f + __expf(-clamp30(g1))); }
__device__ __forceinline__ int mod_row(int tok) { return tok < TCTX ? 0 : 1 + ((tok - TCTX) >> 11); }

__device__ __forceinline__ void phase_setup(const Params& p, char* smem) {
  const int tid = tid_opaque(), bid = blockIdx.x, G = gridDim.x;
  {
    const size_t n4 = (size_t)T * 1024 / 4, half4 = (size_t)TCTX * 1024 / 4;
    float4* dst = (float4*)p.out;
    const float4* s0 = (const float4*)p.x_prompt;
    const float4* s1 = (const float4*)p.x_sample;
    for (size_t i = (size_t)bid * 256 + tid; i < n4; i += (size_t)G * 256) dst[i] = i < half4 ? s0[i] : s1[i - half4];
  }
  {
    float* lb = (float*)(p.ws + OFF_LB);
    for (int i = bid * 256 + tid; i < 2048; i += G * 256) {
      float v0 = p.hgrn_lb[i], v1 = p.hgrn_lb[2048 + i], v2 = p.hgrn_lb[4096 + i], v3 = p.hgrn_lb[6144 + i];
      float m = fmaxf(fmaxf(v0, v1), fmaxf(v2, v3));
      float e0 = expf(v0 - m), e1 = expf(v1 - m), e2 = expf(v2 - m), e3 = expf(v3 - m);
      float inv = 1.0f / (e0 + e1 + e2 + e3);
      lb[i] = 0.f;
      lb[2048 + i] = e1 * inv;
      lb[4096 + i] = (e1 + e2) * inv;
      lb[6144 + i] = (e1 + e2 + e3) * inv;
    }
  }
  {
    float* sm = (float*)smem;
    float* modb = (float*)(p.ws + OFF_MOD);
    __syncthreads();
    for (int i = tid; i < 5 * 1024; i += 256) {
      int v = i >> 10, k = i & 1023;
      float cv = v == 0 ? p.c_ctx[k] : p.c[(v - 1) * 1024 + k];
      sm[i] = siluf_(cv);
    }
    __syncthreads();
    float* part = sm + 5 * 1024;
    for (int item = bid; item < DEPTH * 96; item += G) {
      int l = item / 96, cg_ = item % 96;
      int col = cg_ * 64 + (tid & 63), kg = tid >> 6;
      const float* w = p.ada_w + (size_t)l * 1024 * 6144 + col;
      float a0 = 0, a1 = 0, a2 = 0, a3 = 0, a4 = 0;
      for (int k = kg * 256; k < kg * 256 + 256; ++k) {
        float wv = w[(size_t)k * 6144];
        a0 += sm[k] * wv; a1 += sm[1024 + k] * wv; a2 += sm[2048 + k] * wv; a3 += sm[3072 + k] * wv; a4 += sm[4096 + k] * wv;
      }
      __syncthreads();
      part[(kg * 5 + 0) * 64 + (tid & 63)] = a0; part[(kg * 5 + 1) * 64 + (tid & 63)] = a1; part[(kg * 5 + 2) * 64 + (tid & 63)] = a2;
      part[(kg * 5 + 3) * 64 + (tid & 63)] = a3; part[(kg * 5 + 4) * 64 + (tid & 63)] = a4;
      __syncthreads();
      for (int i = tid; i < 320; i += 256) {
        int v = i >> 6, cc = i & 63;
        float s = part[(0 * 5 + v) * 64 + cc] + part[(1 * 5 + v) * 64 + cc] + part[(2 * 5 + v) * 64 + cc] + part[(3 * 5 + v) * 64 + cc];
        int colo = cg_ * 64 + cc;
        modb[((size_t)l * 5 + v) * 6144 + colo] = s + p.ada_b[l * 6144 + colo];
      }
    }
    __syncthreads();
  }
  {
    float* tile = (float*)smem;
    const int n_in = 210 * 16, n_sso = 16 * 32, n_hgo = 16 * 16, n_out = 16 * 16, n_w13 = 88 * 16, n_w2 = 16 * 44;
    const int per_layer = n_in + n_sso + n_hgo + n_out + n_w13 + n_w2;
    for (int it = bid; it < per_layer * DEPTH; it += G) {
      int l = it / per_layer, r = it % per_layer;
      bf16_t* wt = (bf16_t*)(p.ws + OFF_WT) + (size_t)l * WT_LAYER;
      const float *src0 = nullptr, *src1 = nullptr;
      int K, Nsrc, nt, kt;
      bf16_t* dst;
      bool zero = false;
      if (r < n_in) {
        nt = r / 16; kt = r % 16; K = 1024; Nsrc = NPROJ;
        dst = wt + WT_IN;
        if (nt >= 209) zero = true;
        src0 = p.w_in + (size_t)l * 1024 * NPROJ + nt * 64; src1 = src0 + 32;
      } else if ((r -= n_in) < n_sso) {
        nt = r / 32; kt = r % 32; K = 2048; Nsrc = 1024; dst = wt + WT_SSO;
        src0 = p.w_ssd_out + (size_t)l * 2048 * 1024 + nt * 64; src1 = src0 + 32;
      } else if ((r -= n_sso) < n_hgo) {
        nt = r / 16; kt = r % 16; K = 1024; Nsrc = 1024; dst = wt + WT_HGO;
        src0 = p.w_hgrn_out + (size_t)l * 1024 * 1024 + nt * 64; src1 = src0 + 32;
      } else if ((r -= n_hgo) < n_out) {
        nt = r / 16; kt = r % 16; K = 1024; Nsrc = 1024; dst = wt + WT_OUT;
        src0 = p.w_out + (size_t)l * 1024 * 1024 + nt * 64; src1 = src0 + 32;
      } else if ((r -= n_out) < n_w13) {
        nt = r / 16; kt = r % 16; K = 1024; Nsrc = FFN; dst = wt + WT_W13;
        src0 = p.ffn_w1 + (size_t)l * 1024 * FFN + nt * 32; src1 = p.ffn_w3 + (size_t)l * 1024 * FFN + nt * 32;
      } else {
        r -= n_w13;
        nt = r / 44; kt = r % 44; K = 2816; Nsrc = 1024; dst = wt + WT_W2;
        src0 = p.ffn_w2 + (size_t)l * 2816 * 1024 + nt * 64; src1 = src0 + 32;
      }
      __syncthreads();
      {
        int c4 = (tid & 15) * 4;
        const float* s = c4 < 32 ? src0 + c4 : src1 + (c4 - 32);
#pragma unroll
        for (int i = 0; i < 4; ++i) {
          int kr = (tid >> 4) + i * 16;
          float4 v = zero ? make_float4(0.f, 0.f, 0.f, 0.f) : *(const float4*)(s + (size_t)(kt * 64 + kr) * Nsrc);
          tile[kr * 65 + c4 + 0] = v.x; tile[kr * 65 + c4 + 1] = v.y; tile[kr * 65 + c4 + 2] = v.z; tile[kr * 65 + c4 + 3] = v.w;
        }
      }
      __syncthreads();
#pragma unroll
      for (int i = 0; i < 2; ++i) {
        int cidx = tid + i * 256, n = cidx >> 3, kc = cidx & 7;
        uint4 o;
        o.x = pack2(tile[(kc * 8 + 0) * 65 + n], tile[(kc * 8 + 1) * 65 + n]);
        o.y = pack2(tile[(kc * 8 + 2) * 65 + n], tile[(kc * 8 + 3) * 65 + n]);
        o.z = pack2(tile[(kc * 8 + 4) * 65 + n], tile[(kc * 8 + 5) * 65 + n]);
        o.w = pack2(tile[(kc * 8 + 6) * 65 + n], tile[(kc * 8 + 7) * 65 + n]);
        *(uint4*)(dst + (size_t)(nt * 64 + n) * K + kt * 64 + kc * 8) = o;
      }
    }
    __syncthreads();
  }
}

__device__ __forceinline__ void phase_norm(const Params& p, int l, int which) {
  const int lane = tid_opaque() & 63, wv = tid_opaque() >> 6;
  const float* nw = (which == 0 ? p.norm_mix_w : p.norm_ffn_w) + l * 1024;
  const float* modb = (const float*)(p.ws + OFF_MOD) + (size_t)l * 5 * 6144;
  bf16_t* h = (bf16_t*)(p.ws + OFF_H);
  for (int row = blockIdx.x * 4 + wv; row < T; row += gridDim.x * 4) {
    const float* x = p.out + (size_t)row * 1024;
    const float* md = modb + (size_t)mod_row(row) * 6144 + (which == 0 ? 0 : 3072);
    float4 v[4];
    float ss = 0.f;
#pragma unroll
    for (int i = 0; i < 4; ++i) {
      v[i] = *(const float4*)(x + i * 256 + lane * 4);
      ss += v[i].x * v[i].x + v[i].y * v[i].y + v[i].z * v[i].z + v[i].w * v[i].w;
    }
#pragma unroll
    for (int o = 32; o >= 1; o >>= 1) ss += __shfl_xor(ss, o);
    float rstd = rsqrtf(ss * (1.0f / 1024.f) + 1e-6f);
#pragma unroll
    for (int i = 0; i < 4; ++i) {
      int c = i * 256 + lane * 4;
      float4 w = *(const float4*)(nw + c), sh = *(const float4*)(md + c), sc = *(const float4*)(md + 1024 + c);
      float a0 = v[i].x * rstd * w.x * (1.f + sc.x) + sh.x, a1 = v[i].y * rstd * w.y * (1.f + sc.y) + sh.y;
      float a2 = v[i].z * rstd * w.z * (1.f + sc.z) + sh.z, a3 = v[i].w * rstd * w.w * (1.f + sc.w) + sh.w;
      uint2 o2; o2.x = pack2(a0, a1); o2.y = pack2(a2, a3);
      *(uint2*)(h + (size_t)row * 1024 + c) = o2;
    }
  }
}

__device__ __forceinline__ void phase_final_norm(const Params& p) {
  const int lane = tid_opaque() & 63, wv = tid_opaque() >> 6;
  for (int row = blockIdx.x * 4 + wv; row < T; row += gridDim.x * 4) {
    float* x = p.out + (size_t)row * 1024;
    float4 v[4];
    float ss = 0.f;
#pragma unroll
    for (int i = 0; i < 4; ++i) {
      v[i] = *(const float4*)(x + i * 256 + lane * 4);
      ss += v[i].x * v[i].x + v[i].y * v[i].y + v[i].z * v[i].z + v[i].w * v[i].w;
    }
#pragma unroll
    for (int o = 32; o >= 1; o >>= 1) ss += __shfl_xor(ss, o);
    float rstd = rsqrtf(ss * (1.0f / 1024.f) + 1e-6f);
#pragma unroll
    for (int i = 0; i < 4; ++i) {
      int c = i * 256 + lane * 4;
      float4 w = *(const float4*)(p.norm_final_w + c);
      float4 o4 = make_float4(v[i].x * rstd * w.x, v[i].y * rstd * w.y, v[i].z * rstd * w.z, v[i].w * rstd * w.w);
      *(float4*)(x + c) = o4;
    }
  }
}

template <bool HASMID>
__device__ __forceinline__ void gemm_kloop2(f32x4 (&acc)[4][4], const bf16_t* __restrict__ Ag, int lda, const bf16_t* __restrict__ Bg,
                                            int ldb, int K, const bf16_t* __restrict__ Ag2, int lda2, const bf16_t* __restrict__ Bg2,
                                            int ldb2, int K2, char* smem, const bf16_t* __restrict__ gate0) {
  const int tid = tid_opaque(), lane = tid & 63, wid = tid >> 6;
  const int wr = wid >> 1, wc = wid & 1, fr = lane & 15, fq = lane >> 4;
  const int srow = tid >> 3, schunk = (tid & 7) ^ ((tid >> 4) & 7);
  const int rofs0 = (fq ^ ((fr >> 1) & 7)) * 16;
  const bf16_t* ap = Ag + (size_t)srow * lda + schunk * 8;
  const bf16_t* bp = Bg + (size_t)srow * ldb + schunk * 8;
  const int nk1 = K >> 6;
  const int nk = nk1 + (K2 >> 6);
  char* const sdst = smem + tid * 16;
#define GK_DMA(buf, t)                                                                                                   \
  {                                                                                                                      \
    _Pragma("unroll") for (int i = 0; i < 4; ++i) {                                                                      \
      __builtin_amdgcn_global_load_lds((const unsigned*)(ap + (size_t)i * 32 * lda + (size_t)(t) * 64),                  \
                                       (unsigned*)(sdst + (buf) * LDS_TILE + i * 4096), 16, 0, 0);                       \
      __builtin_amdgcn_global_load_lds((const unsigned*)(bp + (size_t)i * 32 * ldb + (size_t)(t) * 64),                  \
                                       (unsigned*)(sdst + (2 + (buf)) * LDS_TILE + i * 4096), 16, 0, 0);                 \
    }                                                                                                                    \
  }
  GK_DMA(0, 0);
  __syncthreads();
  for (int kt = 0; kt < nk; ++kt) {
    const int cur = kt & 1;
    if (kt + 1 < nk) {
      if (kt + 1 == nk1) {
        ap = Ag2 + (size_t)srow * lda2 + schunk * 8 - (size_t)nk1 * 64;
        bp = Bg2 + (size_t)srow * ldb2 + schunk * 8 - (size_t)nk1 * 64;
        lda = lda2; ldb = ldb2;
      }
      GK_DMA(cur ^ 1, kt + 1);
    }
    if (HASMID && kt == nk1) {
#pragma unroll
      for (int m = 0; m < 4; ++m)
#pragma unroll
        for (int n = 0; n < 4; ++n) {
          uint2 g1 = *(const uint2*)(gate0 + (size_t)(m * 16) * NPROJ_PAD + n * 16);
          uint2 g2 = *(const uint2*)(gate0 + (size_t)(m * 16) * NPROJ_PAD + 1024 + n * 16);
          acc[m][n][0] *= gate_ratio(bf2f((bf16_t)(g1.x & 0xffff)), bf2f((bf16_t)(g2.x & 0xffff)));
          acc[m][n][1] *= gate_ratio(bf2f((bf16_t)(g1.x >> 16)), bf2f((bf16_t)(g2.x >> 16)));
          acc[m][n][2] *= gate_ratio(bf2f((bf16_t)(g1.y & 0xffff)), bf2f((bf16_t)(g2.y & 0xffff)));
          acc[m][n][3] *= gate_ratio(bf2f((bf16_t)(g1.y >> 16)), bf2f((bf16_t)(g2.y >> 16)));
        }
    }
    const char* sa = smem + cur * LDS_TILE + (wr * 64 + fr) * LDS_ROW;
    const char* sb = smem + (2 + cur) * LDS_TILE + (wc * 64 + fr) * LDS_ROW;
#pragma unroll
    for (int kk = 0; kk < 2; ++kk) {
      bf16x8 af[4], bfv[4];
      __builtin_amdgcn_sched_barrier(0);
#pragma unroll
      for (int m = 0; m < 4; ++m) af[m] = *(const bf16x8*)(sa + m * 16 * LDS_ROW + (rofs0 ^ (kk * 64)));
#pragma unroll
      for (int n = 0; n < 4; ++n) bfv[n] = *(const bf16x8*)(sb + n * 16 * LDS_ROW + (rofs0 ^ (kk * 64)));
      __builtin_amdgcn_sched_barrier(0);
#pragma unroll
      for (int m = 0; m < 4; ++m)
#pragma unroll
        for (int n = 0; n < 4; ++n) acc[m][n] = __builtin_amdgcn_mfma_f32_16x16x32_bf16(bfv[n], af[m], acc[m][n], 0, 0, 0);
    }
    __builtin_amdgcn_sched_barrier(0);
    __syncthreads();
  }
#undef GK_DMA
}

__device__ __forceinline__ void gemm_kloop(f32x4 (&acc)[4][4], const bf16_t* __restrict__ Ag, int lda, const bf16_t* __restrict__ Bg,
                                           int ldb, int K, char* smem) {
  gemm_kloop2<false>(acc, Ag, lda, Bg, ldb, K, Ag, lda, Bg, ldb, 0, smem, Ag);
}

constexpr int BG_STAGE = 24576;
__device__ __forceinline__ int swz4(int x) { return (0x78 >> (2 * x)) & 3; }
template <bool HASMID>
__device__ __forceinline__ void gemm_kloop_big(f32x4 (&acc)[8][4], const bf16_t* __restrict__ Ag, int lda, const bf16_t* __restrict__ Bg,
                                               int ldb, int K, const bf16_t* __restrict__ Ag2, int lda2,
                                               const bf16_t* __restrict__ Bg2, int ldb2, int K2, char* smem,
                                               const bf16_t* __restrict__ gate0) {
  const int tid = tid_opaque(), lane = tid & 63, wid = tid >> 6;
  const int wr = wid >> 1, wc = wid & 1, fr = lane & 15, fq = lane >> 4;
  const int srow = tid >> 2, schunk = (tid & 3) ^ swz4((tid >> 4) & 3);
  const int rofs = (fq ^ swz4((fr >> 2) & 3)) * 16;
  const int nks1 = K >> 5;
  const int nks = nks1 + (K2 >> 5);
  const bf16_t* ap1 = Ag + (size_t)srow * lda + schunk * 8;
  const bf16_t* bp1 = Bg + (size_t)srow * ldb + schunk * 8;
  const bf16_t* ap2 = Ag2 + (size_t)srow * lda2 + schunk * 8 - (size_t)nks1 * 32;
  const bf16_t* bp2 = Bg2 + (size_t)srow * ldb2 + schunk * 8 - (size_t)nks1 * 32;
  char* const sdst = smem + tid * 16;
#define BG_DMA(slot, kk_)                                                                                                  \
  {                                                                                                                        \
    const int t_ = (kk_) < nks ? (kk_) : nks - 1;                                                                          \
    const bool s2_ = t_ >= nks1;                                                                                           \
    const bf16_t* ap_ = (s2_ ? ap2 : ap1) + (size_t)t_ * 32;                                                               \
    const bf16_t* bp_ = (s2_ ? bp2 : bp1) + (size_t)t_ * 32;                                                               \
    const size_t la_ = (size_t)64 * (s2_ ? lda2 : lda), lb_ = (size_t)64 * (s2_ ? ldb2 : ldb);                             \
    _Pragma("unroll") for (int i = 0; i < 4; ++i)                                                                          \
        __builtin_amdgcn_global_load_lds((const unsigned*)(ap_ + i * la_), (unsigned*)(sdst + (slot) * BG_STAGE + i * 4096), 16, 0, 0); \
    _Pragma("unroll") for (int i = 0; i < 2; ++i)                                                                          \
        __builtin_amdgcn_global_load_lds((const unsigned*)(bp_ + i * lb_), (unsigned*)(sdst + (slot) * BG_STAGE + 16384 + i * 4096), 16, 0, 0); \
  }
  BG_DMA(0, 0);
  BG_DMA(1, 1);
  int slot = 0;
  for (int ks = 0; ks < nks; ++ks) {
    asm volatile("s_waitcnt vmcnt(6)" ::: "memory");
    __builtin_amdgcn_s_barrier();
    asm volatile("" ::: "memory");
    const int nslot = slot == 0 ? 2 : slot - 1;
    BG_DMA(nslot, ks + 2);
    if (HASMID && ks == nks1) {
      int zofs = 0;
      asm volatile("" : "+v"(zofs));
      const bf16_t* gz = gate0 + zofs;
#pragma unroll
      for (int m = 0; m < 8; ++m)
#pragma unroll
        for (int n = 0; n < 4; ++n) {
          uint2 g1 = *(const uint2*)(gz + (size_t)(m * 16) * NPROJ_PAD + n * 16);
          uint2 g2 = *(const uint2*)(gz + (size_t)(m * 16) * NPROJ_PAD + 1024 + n * 16);
          acc[m][n][0] *= gate_ratio(bf2f((bf16_t)(g1.x & 0xffff)), bf2f((bf16_t)(g2.x & 0xffff)));
          acc[m][n][1] *= gate_ratio(bf2f((bf16_t)(g1.x >> 16)), bf2f((bf16_t)(g2.x >> 16)));
          acc[m][n][2] *= gate_ratio(bf2f((bf16_t)(g1.y & 0xffff)), bf2f((bf16_t)(g2.y & 0xffff)));
          acc[m][n][3] *= gate_ratio(bf2f((bf16_t)(g1.y >> 16)), bf2f((bf16_t)(g2.y >> 16)));
        }
    }
    const char* sa = smem + slot * BG_STAGE + (wr * 128 + fr) * 64 + rofs;
    const char* sb = smem + slot * BG_STAGE + 16384 + (wc * 64 + fr) * 64 + rofs;
    bf16x8 af[8], bfv[4];
    __builtin_amdgcn_sched_barrier(0);
#pragma unroll
    for (int n = 0; n < 4; ++n) bfv[n] = *(const bf16x8*)(sb + n * 16 * 64);
#pragma unroll
    for (int m = 0; m < 8; ++m) af[m] = *(const bf16x8*)(sa + m * 16 * 64);
    __builtin_amdgcn_sched_barrier(0);
    __builtin_amdgcn_s_setprio(1);
#pragma unroll
    for (int m = 0; m < 8; ++m)
#pragma unroll
      for (int n = 0; n < 4; ++n) acc[m][n] = __builtin_amdgcn_mfma_f32_16x16x32_bf16(bfv[n], af[m], acc[m][n], 0, 0, 0);
    __builtin_amdgcn_s_setprio(0);
    __builtin_amdgcn_sched_barrier(0);
    slot = slot == 2 ? 0 : slot + 1;
  }
  asm volatile("s_waitcnt vmcnt(0)" ::: "memory");
  __builtin_amdgcn_s_barrier();
  asm volatile("" ::: "memory");
#undef BG_DMA
}
__device__ __forceinline__ void gemm_kloop_big1(f32x4 (&acc)[8][4], const bf16_t* __restrict__ Ag, int lda, const bf16_t* __restrict__ Bg,
                                                int ldb, int K, char* smem) {
  gemm_kloop_big<false>(acc, Ag, lda, Bg, ldb, K, Ag, lda, Bg, ldb, 0, smem, Ag);
}
enum { G_PROJ = 0, G_MERGE = 1, G_OUT = 2, G_FFN1 = 3, G_FFN2 = 4 };

template <int MODE>
__device__ __forceinline__ void phase_gemm(const Params& p, int l, char* smem) {
  const int tid = tid_opaque(), lane = tid & 63, wid = tid >> 6;
  const int wr = wid >> 1, wc = wid & 1, fr = lane & 15, fq = lane >> 4;
  const bf16_t* wt = (const bf16_t*)(p.ws + OFF_WT) + (size_t)l * WT_LAYER;
  const bf16_t* hbuf = (const bf16_t*)(p.ws + OFF_H);
  bf16_t* proj = (bf16_t*)(p.ws + OFF_PROJ);
  bf16_t* hidden = (bf16_t*)(p.ws + OFF_PROJ);
  const float* modb = (const float*)(p.ws + OFF_MOD) + (size_t)l * 5 * 6144;
  constexpr int nM = T / 256;
  constexpr int nN = MODE == G_PROJ ? NPROJ_PAD / 128 : (MODE == G_FFN1 ? 5632 / 128 : 1024 / 128);
  for (int t = blockIdx.x; t < nM * nN; t += gridDim.x) {
    const int pm = t % nM, pn = t / nM;
    const int row0 = pm * 256, col0 = pn * 128;
    f32x4 acc[8][4];
#pragma unroll
    for (int m = 0; m < 8; ++m)
#pragma unroll
      for (int n = 0; n < 4; ++n) acc[m][n] = (f32x4){0.f, 0.f, 0.f, 0.f};
    if (MODE == G_PROJ) {
      gemm_kloop_big1(acc, hbuf + (size_t)row0 * 1024, 1024, wt + WT_IN + (size_t)col0 * 1024, 1024, 1024, smem);
      float* dtraw = (float*)(p.ws + OFF_DTRAW);
#pragma unroll
      for (int m = 0; m < 8; ++m) {
        const int row = row0 + wr * 128 + m * 16 + fr;
#pragma unroll
        for (int n = 0; n < 4; ++n) {
          const int col = col0 + wc * 64 + n * 16 + fq * 4;
          uint2 o; o.x = pack2(acc[m][n][0], acc[m][n][1]); o.y = pack2(acc[m][n][2], acc[m][n][3]);
          *(uint2*)(proj + (size_t)row * NPROJ_PAD + col) = o;
          if (col >= C_DT && col < C_DT + 64) *(f32x4*)(dtraw + (size_t)row * 64 + (col - C_DT)) = acc[m][n];
        }
      }
    } else if (MODE == G_MERGE) {
      const bf16_t* ybuf = (const bf16_t*)(p.ws + OFF_YBUF);
      const bf16_t* obuf = (const bf16_t*)(p.ws + OFF_OBUF);
      bf16_t* mbuf = (bf16_t*)(p.ws + OFF_MBUF);
      gemm_kloop_big<true>(acc, ybuf + (size_t)row0 * 2048, 2048, wt + WT_SSO + (size_t)col0 * 2048, 2048, 2048,
                        obuf + (size_t)row0 * 1024, 1024, wt + WT_HGO + (size_t)col0 * 1024, 1024, 1024, smem,
                        proj + (size_t)(row0 + wr * 128 + fr) * NPROJ_PAD + C_GATE + col0 + wc * 64 + fq * 4);
#pragma unroll
      for (int m = 0; m < 8; ++m) {
        const int row = row0 + wr * 128 + m * 16 + fr;
#pragma unroll
        for (int n = 0; n < 4; ++n) {
          const int col = col0 + wc * 64 + n * 16 + fq * 4;
          uint2 g = *(const uint2*)(proj + (size_t)row * NPROJ_PAD + C_GATE + 1024 + col);
          float r0 = acc[m][n][0] * sigmoidf_(clamp30(bf2f((bf16_t)(g.x & 0xffff))));
          float r1 = acc[m][n][1] * sigmoidf_(clamp30(bf2f((bf16_t)(g.x >> 16))));
          float r2 = acc[m][n][2] * sigmoidf_(clamp30(bf2f((bf16_t)(g.y & 0xffff))));
          float r3 = acc[m][n][3] * sigmoidf_(clamp30(bf2f((bf16_t)(g.y >> 16))));
          uint2 o; o.x = pack2(r0, r1); o.y = pack2(r2, r3);
          *(uint2*)(mbuf + (size_t)row * 1024 + col) = o;
        }
      }
    } else if (MODE == G_OUT || MODE == G_FFN2) {
      if (MODE == G_OUT) {
        const bf16_t* mbuf = (const bf16_t*)(p.ws + OFF_MBUF);
        gemm_kloop_big1(acc, mbuf + (size_t)row0 * 1024, 1024, wt + WT_OUT + (size_t)col0 * 1024, 1024, 1024, smem);
      } else {
        gemm_kloop_big1(acc, hidden + (size_t)row0 * FFN, FFN, wt + WT_W2 + (size_t)col0 * FFN, FFN, FFN, smem);
      }
      const float* gate = modb + (size_t)mod_row(row0) * 6144 + (MODE == G_OUT ? 2048 : 5120);
#pragma unroll
      for (int m = 0; m < 8; ++m) {
        const int row = row0 + wr * 128 + m * 16 + fr;
#pragma unroll
        for (int n = 0; n < 4; ++n) {
          const int col = col0 + wc * 64 + n * 16 + fq * 4;
          f32x4 g = *(const f32x4*)(gate + col);
          f32x4* xp = (f32x4*)(p.out + (size_t)row * 1024 + col);
          f32x4 xv = *xp;
          xv += g * acc[m][n];
          *xp = xv;
        }
      }
    } else {
      gemm_kloop_big1(acc, hbuf + (size_t)row0 * 1024, 1024, wt + WT_W13 + (size_t)col0 * 1024, 1024, 1024, smem);
#pragma unroll
      for (int m = 0; m < 8; ++m) {
        const int row = row0 + wr * 128 + m * 16 + fr;
#pragma unroll
        for (int n = 0; n < 2; ++n) {
          const int hcol = (pn * 2 + wc) * 32 + n * 16 + fq * 4;
          float r[4];
#pragma unroll
          for (int j = 0; j < 4; ++j) r[j] = siluf_(acc[m][n][j]) * acc[m][n + 2][j];
          uint2 o; o.x = pack2(r[0], r[1]); o.y = pack2(r[2], r[3]);
          *(uint2*)(hidden + (size_t)row * FFN + hcol) = o;
        }
      }
    }
  }
}

__device__ __forceinline__ void phase_conv(const Params& p, int l) {
  const bf16_t* proj = (const bf16_t*)(p.ws + OFF_PROJ);
  bf16_t* xc = (bf16_t*)(p.ws + OFF_XC);
  const float* cw = p.ssd_conv_w + (size_t)l * 5 * 4096;
  const float* cb = p.ssd_conv_b + (size_t)l * 4096;
  for (int unit = blockIdx.x * 256 + tid_opaque(); unit < 512 * 256; unit += gridDim.x * 256) {
    const int ch = (unit & 511) * 8, sg = unit >> 9;
    const int t0 = sg * 64;
    int lo, hi;
    if (t0 < TCTX) { lo = t0 & ~255; hi = lo + 256; } else { lo = t0; hi = t0 + 64; }
    float w[5][8], bias[8];
#pragma unroll
    for (int k = 0; k < 5; ++k) {
      const f32x4 a = *(const f32x4*)(cw + k * 4096 + ch), b = *(const f32x4*)(cw + k * 4096 + ch + 4);
      w[k][0] = a[0]; w[k][1] = a[1]; w[k][2] = a[2]; w[k][3] = a[3]; w[k][4] = b[0]; w[k][5] = b[1]; w[k][6] = b[2]; w[k][7] = b[3];
    }
    {
      const f32x4 a = *(const f32x4*)(cb + ch), b = *(const f32x4*)(cb + ch + 4);
      bias[0] = a[0]; bias[1] = a[1]; bias[2] = a[2]; bias[3] = a[3]; bias[4] = b[0]; bias[5] = b[1]; bias[6] = b[2]; bias[7] = b[3];
    }
    const u32x4 zero4 = (u32x4){0u, 0u, 0u, 0u};
    u32x4 r0, r1, r2, r3, r4;
#define CV_LD(tt) (((tt) >= lo && (tt) < hi) ? *(const u32x4*)(proj + (size_t)(tt) * NPROJ_PAD + ch) : zero4)
    r0 = CV_LD(t0 - 2); r1 = CV_LD(t0 - 1); r2 = CV_LD(t0); r3 = CV_LD(t0 + 1);
#pragma unroll 4
    for (int t = t0; t < t0 + 64; ++t) {
      r4 = CV_LD(t + 2);
      float a[8];
#pragma unroll
      for (int j = 0; j < 8; ++j) a[j] = bias[j];
#define CV_ACC(R, k)                                                                                                     \
  _Pragma("unroll") for (int e = 0; e < 4; ++e) {                                                                        \
    a[2 * e] += w[k][2 * e] * bf2f((bf16_t)(R[e] & 0xffff));                                                             \
    a[2 * e + 1] += w[k][2 * e + 1] * bf2f((bf16_t)(R[e] >> 16));                                                        \
  }
      CV_ACC(r0, 0) CV_ACC(r1, 1) CV_ACC(r2, 2) CV_ACC(r3, 3) CV_ACC(r4, 4)
      u32x4 o;
      o[0] = pack2(siluf_(a[0]), siluf_(a[1])); o[1] = pack2(siluf_(a[2]), siluf_(a[3]));
      o[2] = pack2(siluf_(a[4]), siluf_(a[5])); o[3] = pack2(siluf_(a[6]), siluf_(a[7]));
      *(u32x4*)(xc + (size_t)t * 4096 + ch) = o;
      r0 = r1; r1 = r2; r2 = r3; r3 = r4;
    }
#undef CV_LD
#undef CV_ACC
  }
  const float* dtraw = (const float*)(p.ws + OFF_DTRAW);
  float* dt = (float*)(p.ws + OFF_DT);
  for (size_t i = (size_t)blockIdx.x * 256 + tid_opaque(); i < (size_t)T * 64; i += (size_t)gridDim.x * 256) {
    float v = dtraw[i] + p.ssd_dt_bias[l * 64 + (int)(i & 63)];
    dt[i] = v > 20.f ? v : log1pf(expf(v));
  }
}

__device__ __forceinline__ void ssd_naive_item(const Params& p, int l, int item, float* sm) {
  const int d = item & 1, h = (item >> 1) & 31, s = item >> 6;
  int tok0, L;
  if (s < 32) { tok0 = s * 256; L = 256; } else { tok0 = TCTX + (s - 32) * 2048; L = 2048; }
  const int tid = tid_opaque(), pp = tid >> 2, nq = tid & 3, g = h >> 2;
  float S[32];
  if (s < 32) {
#pragma unroll
    for (int i = 0; i < 32; ++i) S[i] = 0.f;
  } else {
    const float* st = p.state_ssm + ((((size_t)(s - 32) * 4 + l) * 2 + d) * 32 + h) * 8192 + pp * 128 + nq * 32;
#pragma unroll
    for (int i = 0; i < 32; ++i) S[i] = st[i];
  }
  const float a = -expf(p.ssd_a_log[l * 64 + d * 32 + h]);
  float* xs = sm; float* Bs = sm + 1024; float* Cs = Bs + 2048; float* dts = Cs + 2048;
  const bf16_t* xc = (const bf16_t*)(p.ws + OFF_XC);
  const float* dtb = (const float*)(p.ws + OFF_DT);
  float* ydir = (float*)(p.ws + (d == 0 ? OFF_YF : OFF_YB));
  for (int bt = 0; bt < L / 16; ++bt) {
    const int tb = d == 0 ? bt * 16 : L - 16 - bt * 16;
    __syncthreads();
    for (int e = tid; e < 16 * 320; e += 256) {
      const int tt = e / 320, c = e % 320;
      const size_t base = (size_t)(tok0 + tb + tt) * 4096;
      if (c < 64) xs[tt * 64 + c] = bf2f(xc[base + h * 64 + c]);
      else if (c < 192) Bs[tt * 128 + c - 64] = bf2f(xc[base + 2048 + g * 128 + c - 64]);
      else Cs[tt * 128 + c - 192] = bf2f(xc[base + 3072 + g * 128 + c - 192]);
    }
    if (tid < 16) dts[tid] = dtb[(size_t)(tok0 + tb + tid) * 64 + d * 32 + h];
    __syncthreads();
    for (int i2 = 0; i2 < 16; ++i2) {
      const int tt = d == 0 ? i2 : 15 - i2;
      const float dt = dts[tt], dA = expf(dt * a), xdt = xs[tt * 64 + pp] * dt;
      float acc = 0.f;
      const float* Bp = Bs + tt * 128 + nq * 32;
      const float* Cp = Cs + tt * 128 + nq * 32;
#pragma unroll
      for (int i = 0; i < 32; ++i) { S[i] = dA * S[i] + xdt * Bp[i]; acc += S[i] * Cp[i]; }
      acc += __shfl_xor(acc, 1); acc += __shfl_xor(acc, 2);
      if (nq == 0) ydir[(size_t)(tok0 + tb + tt) * 2048 + h * 64 + pp] = acc;
    }
  }
  if (s < 32) {
    float* o = p.out + OUT_SSM + ((((size_t)s * 4 + l) * 2 + d) * 32 + h) * 8192 + pp * 128 + nq * 32;
#pragma unroll
    for (int i = 0; i < 32; ++i) o[i] = S[i];
  }
}

__device__ __forceinline__ void hgrn_naive_item(const Params& p, int l, int item, float* sm) {
  const int d = item & 1, hd = (item >> 1) & 7, s = item >> 4;
  int tok0, L;
  if (s < 32) { tok0 = s * 256; L = 256; } else { tok0 = TCTX + (s - 32) * 2048; L = 2048; }
  const int tid = tid_opaque(), vv = tid >> 1, kh = tid & 1;
  float S[64];
  if (s < 32) {
#pragma unroll
    for (int i = 0; i < 64; ++i) S[i] = 0.f;
  } else {
    const float* st = p.state_hgrn + ((((size_t)(s - 32) * 4 + l) * 2 + d) * 8 + hd) * 16384 + (size_t)(kh * 64) * 128 + vv;
#pragma unroll
    for (int i = 0; i < 64; ++i) S[i] = st[(size_t)i * 128];
  }
  float* qs = sm; float* fs = sm + 2048; float* ks = sm + 4096; float* vs = sm + 6144;
  const bf16_t* proj = (const bf16_t*)(p.ws + OFF_PROJ);
  const float* lb = (const float*)(p.ws + OFF_LB) + (size_t)l * 2048 + d * 1024 + hd * 128;
  float* odir = (float*)(p.ws + (d == 0 ? OFF_OF : OFF_OB));
  for (int bt = 0; bt < L / 16; ++bt) {
    const int tb = d == 0 ? bt * 16 : L - 16 - bt * 16;
    __syncthreads();
    for (int e = tid; e < 16 * 128; e += 256) {
      const int tt = e >> 7, c = e & 127;
      const size_t base = (size_t)(tok0 + tb + tt) * NPROJ_PAD;
      const float q = bf2f(proj[base + C_HQ + hd * 128 + c]);
      const float u = bf2f(proj[base + C_HF + d * 1024 + hd * 128 + c]);
      const float lbv = lb[c];
      const float sg = sigmoidf_(u);
      qs[e] = siluf_(q);
      fs[e] = lbv + (1.f - lbv) * sg;
      ks[e] = (1.f - lbv) * (1.f - sg);
      vs[e] = bf2f(proj[base + C_HI + hd * 128 + c]);
    }
    __syncthreads();
    for (int i2 = 0; i2 < 16; ++i2) {
      const int tt = d == 0 ? i2 : 15 - i2;
      const float vval = vs[tt * 128 + vv];
      const float* fp = fs + tt * 128 + kh * 64;
      const float* kp = ks + tt * 128 + kh * 64;
      const float* qp = qs + tt * 128 + kh * 64;
      float acc = 0.f;
#pragma unroll
      for (int i = 0; i < 64; ++i) { S[i] = fp[i] * S[i] + kp[i] * vval; acc += S[i] * qp[i]; }
      acc += __shfl_xor(acc, 1);
      if (kh == 0) odir[(size_t)(tok0 + tb + tt) * 1024 + hd * 128 + vv] = acc;
    }
  }
  if (s < 32) {
    float* o = p.out + OUT_HGRN + ((((size_t)s * 4 + l) * 2 + d) * 8 + hd) * 16384 + (size_t)(kh * 64) * 128 + vv;
#pragma unroll
    for (int i = 0; i < 64; ++i) o[(size_t)i * 128] = S[i];
  }
}


constexpr int HG_ROW = 272;
constexpr int HG_IMG = 16 * HG_ROW;
constexpr int HG_BUF = 4 * HG_IMG + 512;
__device__ __forceinline__ void hgrn_chunk_item(const Params& p, int l, int item, char* smem) {
  const int d = item & 1, hd = (item >> 1) & 7, s = item >> 4;
  int tok0, L;
  if (s < 32) { tok0 = s * 256; L = 256; } else { tok0 = TCTX + (s - 32) * 2048; L = 2048; }
  const int tid = tid_opaque(), lane = tid & 63, w = tid >> 6, fr = lane & 15, fq = lane >> 4;
  const int ch = tid & 127, half = tid >> 7;
  f32x4 S[8][2];
  if (s < 32) {
#pragma unroll
    for (int kt = 0; kt < 8; ++kt) { S[kt][0] = (f32x4){0.f, 0.f, 0.f, 0.f}; S[kt][1] = (f32x4){0.f, 0.f, 0.f, 0.f}; }
  } else {
    const float* st = p.state_hgrn + ((((size_t)(s - 32) * 4 + l) * 2 + d) * 8 + hd) * 16384;
#pragma unroll
    for (int kt = 0; kt < 8; ++kt)
#pragma unroll
      for (int vt = 0; vt < 2; ++vt)
#pragma unroll
        for (int jj = 0; jj < 4; ++jj) S[kt][vt][jj] = st[(size_t)(16 * kt + fq * 4 + jj) * 128 + 32 * w + 16 * vt + fr];
  }
  const float lbv = ((const float*)(p.ws + OFF_LB))[(size_t)l * 2048 + d * 1024 + hd * 128 + ch];
  const bf16_t* proj = (const bf16_t*)(p.ws + OFF_PROJ);
  float* odir = (float*)(p.ws + (d == 0 ? OFF_OF : OFF_OB));
  float* xch = (float*)(smem + 2 * HG_BUF);
  const int nch = L >> 4;
  bf16_t rq[8], ru[8], rv[8];
  __syncthreads();
  {
#pragma unroll
    for (int i = 0; i < 8; ++i) {
      const int pos = 8 * half + i;
      const size_t tk = (size_t)(d == 0 ? tok0 + pos : tok0 + L - 1 - pos) * NPROJ_PAD;
      rq[i] = proj[tk + C_HQ + hd * 128 + ch];
      ru[i] = proj[tk + C_HF + d * 1024 + hd * 128 + ch];
      rv[i] = proj[tk + C_HI + hd * 128 + ch];
    }
  }
  for (int c = 0; c < nch; ++c) {
    char* buf = smem + (c & 1) * HG_BUF;
    float* xc_ = xch + (c & 1) * 256;
    float fv[8], kk[8], qs[8];
    float loc = 1.f;
#pragma unroll
    for (int i = 0; i < 8; ++i) {
      const float u = bf2f(ru[i]);
      const float sg = sigmoidf_(u);
      fv[i] = lbv + (1.f - lbv) * sg;
      kk[i] = (1.f - lbv) * (1.f - sg);
      qs[i] = siluf_(bf2f(rq[i]));
      loc *= fv[i];
      *(bf16_t*)(buf + 3 * HG_IMG + (8 * half + i) * HG_ROW + ch * 2) = rv[i];
    }
    xc_[half * 128 + ch] = loc;
    if (c + 1 < nch) {
#pragma unroll
      for (int i = 0; i < 8; ++i) {
        const int pos = (c + 1) * 16 + 8 * half + i;
        const size_t tk = (size_t)(d == 0 ? tok0 + pos : tok0 + L - 1 - pos) * NPROJ_PAD;
        rq[i] = proj[tk + C_HQ + hd * 128 + ch];
        ru[i] = proj[tk + C_HF + d * 1024 + hd * 128 + ch];
        rv[i] = proj[tk + C_HI + hd * 128 + ch];
      }
    }
    __syncthreads();
    {
      const float other = xc_[(half ^ 1) * 128 + ch];
      float P = half ? other : 1.f;
      float sfx = half ? 1.f : other;
      float suf[8];
#pragma unroll
      for (int i = 7; i >= 0; --i) { suf[i] = sfx; sfx *= fv[i]; }
#pragma unroll
      for (int i = 0; i < 8; ++i) {
        P *= fv[i];
        const int off = (8 * half + i) * HG_ROW + ch * 2;
        *(bf16_t*)(buf + off) = f2bf(qs[i] * P);
        *(bf16_t*)(buf + HG_IMG + off) = f2bf(kk[i] * __builtin_amdgcn_rcpf(fmaxf(P, 1e-30f)));
        *(bf16_t*)(buf + 2 * HG_IMG + off) = f2bf(kk[i] * suf[i]);
      }
      if (half) ((float*)(buf + 4 * HG_IMG))[ch] = P;
    }
    __syncthreads();
    const char* qtI = buf;
    const char* ktI = buf + HG_IMG;
    const float* dec = (const float*)(buf + 4 * HG_IMG);
    f32x4 at = (f32x4){0.f, 0.f, 0.f, 0.f};
#pragma unroll
    for (int ks = 0; ks < 4; ++ks) {
      bf16x8 a = *(const bf16x8*)(ktI + fr * HG_ROW + (32 * ks + fq * 8) * 2);
      bf16x8 b = *(const bf16x8*)(qtI + fr * HG_ROW + (32 * ks + fq * 8) * 2);
      at = __builtin_amdgcn_mfma_f32_16x16x32_bf16(a, b, at, 0, 0, 0);
    }
    s16x4 Pm;
    {
      u32x2 pk;
      pk[0] = pack2((fq * 4 + 0 <= fr) ? at[0] : 0.f, (fq * 4 + 1 <= fr) ? at[1] : 0.f);
      pk[1] = pack2((fq * 4 + 2 <= fr) ? at[2] : 0.f, (fq * 4 + 3 <= fr) ? at[3] : 0.f);
      Pm = __builtin_bit_cast(s16x4, pk);
    }
    const unsigned ldsb = (unsigned)(size_t)buf;
    const unsigned vaddr = ldsb + 3 * HG_IMG + (4 * fq + (fr >> 2)) * HG_ROW + (32 * w + 4 * (fr & 3)) * 2;
    const unsigned kaddr = ldsb + 2 * HG_IMG + (4 * fq + (fr >> 2)) * HG_ROW + (4 * (fr & 3)) * 2;
    s16x4 vf0, vf1, kf0, kf1, kf2, kf3, kf4, kf5, kf6, kf7;
    asm volatile(
        "ds_read_b64_tr_b16 %0, %10\n\t"
        "ds_read_b64_tr_b16 %1, %10 offset:32\n\t"
        "ds_read_b64_tr_b16 %2, %11\n\t"
        "ds_read_b64_tr_b16 %3, %11 offset:32\n\t"
        "ds_read_b64_tr_b16 %4, %11 offset:64\n\t"
        "ds_read_b64_tr_b16 %5, %11 offset:96\n\t"
        "ds_read_b64_tr_b16 %6, %11 offset:128\n\t"
        "ds_read_b64_tr_b16 %7, %11 offset:160\n\t"
        "ds_read_b64_tr_b16 %8, %11 offset:192\n\t"
        "ds_read_b64_tr_b16 %9, %11 offset:224\n\t"
        "s_waitcnt lgkmcnt(0)"
        : "=&v"(vf0), "=&v"(vf1), "=&v"(kf0), "=&v"(kf1), "=&v"(kf2), "=&v"(kf3), "=&v"(kf4), "=&v"(kf5), "=&v"(kf6), "=&v"(kf7)
        : "v"(vaddr), "v"(kaddr)
        : "memory");
    f32x4 o0 = __builtin_amdgcn_mfma_f32_16x16x16bf16_1k(Pm, vf0, (f32x4){0.f, 0.f, 0.f, 0.f}, 0, 0, 0);
    f32x4 o1 = __builtin_amdgcn_mfma_f32_16x16x16bf16_1k(Pm, vf1, (f32x4){0.f, 0.f, 0.f, 0.f}, 0, 0, 0);
#pragma unroll
    for (int ks = 0; ks < 4; ++ks) {
      u32x2 qa = *(const u32x2*)(qtI + fr * HG_ROW + (32 * ks + 4 * fq) * 2);
      u32x2 qb = *(const u32x2*)(qtI + fr * HG_ROW + (32 * ks + 16 + 4 * fq) * 2);
      u32x4 aa; aa[0] = qa[0]; aa[1] = qa[1]; aa[2] = qb[0]; aa[3] = qb[1];
      const bf16x8 A = __builtin_bit_cast(bf16x8, aa);
      u32x4 b0, b1;
      b0[0] = pack2(S[2 * ks][0][0], S[2 * ks][0][1]); b0[1] = pack2(S[2 * ks][0][2], S[2 * ks][0][3]);
      b0[2] = pack2(S[2 * ks + 1][0][0], S[2 * ks + 1][0][1]); b0[3] = pack2(S[2 * ks + 1][0][2], S[2 * ks + 1][0][3]);
      b1[0] = pack2(S[2 * ks][1][0], S[2 * ks][1][1]); b1[1] = pack2(S[2 * ks][1][2], S[2 * ks][1][3]);
      b1[2] = pack2(S[2 * ks + 1][1][0], S[2 * ks + 1][1][1]); b1[3] = pack2(S[2 * ks + 1][1][2], S[2 * ks + 1][1][3]);
      o0 = __builtin_amdgcn_mfma_f32_16x16x32_bf16(A, __builtin_bit_cast(bf16x8, b0), o0, 0, 0, 0);
      o1 = __builtin_amdgcn_mfma_f32_16x16x32_bf16(A, __builtin_bit_cast(bf16x8, b1), o1, 0, 0, 0);
    }
#pragma unroll
    for (int jj = 0; jj < 4; ++jj) {
      const int pos = c * 16 + fq * 4 + jj;
      const size_t tk = (size_t)(d == 0 ? tok0 + pos : tok0 + L - 1 - pos);
      odir[tk * 1024 + hd * 128 + 32 * w + fr] = o0[jj];
      odir[tk * 1024 + hd * 128 + 32 * w + 16 + fr] = o1[jj];
    }
    const s16x4 kfs[8] = {kf0, kf1, kf2, kf3, kf4, kf5, kf6, kf7};
#pragma unroll
    for (int kt = 0; kt < 8; ++kt) {
      const f32x4 dv = *(const f32x4*)(dec + 16 * kt + fq * 4);
      S[kt][0] = __builtin_amdgcn_mfma_f32_16x16x16bf16_1k(kfs[kt], vf0, S[kt][0] * dv, 0, 0, 0);
      S[kt][1] = __builtin_amdgcn_mfma_f32_16x16x16bf16_1k(kfs[kt], vf1, S[kt][1] * dv, 0, 0, 0);
    }
  }
  if (s < 32) {
    float* o = p.out + OUT_HGRN + ((((size_t)s * 4 + l) * 2 + d) * 8 + hd) * 16384;
#pragma unroll
    for (int kt = 0; kt < 8; ++kt)
#pragma unroll
      for (int vt = 0; vt < 2; ++vt)
#pragma unroll
        for (int jj = 0; jj < 4; ++jj) o[(size_t)(16 * kt + fq * 4 + jj) * 128 + 32 * w + 16 * vt + fr] = S[kt][vt][jj];
  }
}


constexpr size_t OFF_SST = OFF_YF;
constexpr size_t OFF_CS = OFF_YB;
constexpr int SS_BROW = 272, SS_XROW = 144;
constexpr int SS_R0 = 128 * SS_BROW;
constexpr int SS_R1 = 128 * SS_XROW;

template <int OFF>
__device__ __forceinline__ s16x4 tr_read(unsigned addr) {
  s16x4 r;
  asm volatile("ds_read_b64_tr_b16 %0, %1 offset:%2" : "=v"(r) : "v"(addr), "i"(OFF) : "memory");
  return r;
}
__device__ __forceinline__ bf16x8 cat8(s16x4 a, s16x4 b) {
  bf16x8 r;
  r[0] = a[0]; r[1] = a[1]; r[2] = a[2]; r[3] = a[3]; r[4] = b[0]; r[5] = b[1]; r[6] = b[2]; r[7] = b[3];
  return r;
}
#define TR_WAIT12(a, b, c, d, e, f, g, h, i, j, k, l_)                                                                            \
  asm volatile("s_waitcnt lgkmcnt(0)" : "+v"(a), "+v"(b), "+v"(c), "+v"(d), "+v"(e), "+v"(f), "+v"(g), "+v"(h), "+v"(i), "+v"(j), \
               "+v"(k), "+v"(l_)::"memory")
#define TR_WAIT8(a, b, c, d, e, f, g, h) \
  asm volatile("s_waitcnt lgkmcnt(0)" : "+v"(a), "+v"(b), "+v"(c), "+v"(d), "+v"(e), "+v"(f), "+v"(g), "+v"(h)::"memory")

template <int KS>
__device__ __forceinline__ void ssd_p1_kstep(f32x4 (&acc)[2][4], unsigned abase, unsigned xbase) {
  s16x4 a00, a01, a10, a11, b00, b01, b10, b11, b20, b21, b30, b31;
  asm volatile(
      "ds_read_b64_tr_b16 %0, %12 offset:%14\n\t"
      "ds_read_b64_tr_b16 %1, %12 offset:%15\n\t"
      "ds_read_b64_tr_b16 %2, %12 offset:%16\n\t"
      "ds_read_b64_tr_b16 %3, %12 offset:%17\n\t"
      "ds_read_b64_tr_b16 %4, %13 offset:%18\n\t"
      "ds_read_b64_tr_b16 %5, %13 offset:%19\n\t"
      "ds_read_b64_tr_b16 %6, %13 offset:%20\n\t"
      "ds_read_b64_tr_b16 %7, %13 offset:%21\n\t"
      "ds_read_b64_tr_b16 %8, %13 offset:%22\n\t"
      "ds_read_b64_tr_b16 %9, %13 offset:%23\n\t"
      "ds_read_b64_tr_b16 %10, %13 offset:%24\n\t"
      "ds_read_b64_tr_b16 %11, %13 offset:%25\n\t"
      "s_waitcnt lgkmcnt(0)"
      : "=&v"(a00), "=&v"(a01), "=&v"(a10), "=&v"(a11), "=&v"(b00), "=&v"(b01), "=&v"(b10), "=&v"(b11), "=&v"(b20), "=&v"(b21),
        "=&v"(b30), "=&v"(b31)
      : "v"(abase), "v"(xbase), "i"(KS * 32 * SS_BROW), "i"(KS * 32 * SS_BROW + 4 * SS_BROW), "i"(KS * 32 * SS_BROW + 32),
        "i"(KS * 32 * SS_BROW + 4 * SS_BROW + 32), "i"(KS * 32 * SS_XROW), "i"(KS * 32 * SS_XROW + 4 * SS_XROW),
        "i"(KS * 32 * SS_XROW + 32), "i"(KS * 32 * SS_XROW + 4 * SS_XROW + 32), "i"(KS * 32 * SS_XROW + 64),
        "i"(KS * 32 * SS_XROW + 4 * SS_XROW + 64), "i"(KS * 32 * SS_XROW + 96), "i"(KS * 32 * SS_XROW + 4 * SS_XROW + 96)
      : "memory");
  const bf16x8 A0 = cat8(a00, a01), A1 = cat8(a10, a11);
  const bf16x8 B0 = cat8(b00, b01), B1 = cat8(b10, b11), B2 = cat8(b20, b21), B3 = cat8(b30, b31);
  acc[0][0] = __builtin_amdgcn_mfma_f32_16x16x32_bf16(A0, B0, acc[0][0], 0, 0, 0);
  acc[0][1] = __builtin_amdgcn_mfma_f32_16x16x32_bf16(A0, B1, acc[0][1], 0, 0, 0);
  acc[0][2] = __builtin_amdgcn_mfma_f32_16x16x32_bf16(A0, B2, acc[0][2], 0, 0, 0);
  acc[0][3] = __builtin_amdgcn_mfma_f32_16x16x32_bf16(A0, B3, acc[0][3], 0, 0, 0);
  acc[1][0] = __builtin_amdgcn_mfma_f32_16x16x32_bf16(A1, B0, acc[1][0], 0, 0, 0);
  acc[1][1] = __builtin_amdgcn_mfma_f32_16x16x32_bf16(A1, B1, acc[1][1], 0, 0, 0);
  acc[1][2] = __builtin_amdgcn_mfma_f32_16x16x32_bf16(A1, B2, acc[1][2], 0, 0, 0);
  acc[1][3] = __builtin_amdgcn_mfma_f32_16x16x32_bf16(A1, B3, acc[1][3], 0, 0, 0);
}

__device__ __forceinline__ void ssd_pass1_item(const Params& p, int l, int item, char* smem) {
  const int d = item & 1, h = (item >> 1) & 31, s = item >> 6, g = h >> 2;
  const int nc = s < 32 ? 2 : 16, cg0 = s < 32 ? 2 * s : 64 + 16 * (s - 32);
  const int tid = tid_opaque(), lane = tid & 63, w = tid >> 6, fr = lane & 15, fq = lane >> 4;
  const float a = -expf(p.ssd_a_log[l * 64 + d * 32 + h]);
  f32x4 acc[2][4];
  if (s < 32) {
#pragma unroll
    for (int i = 0; i < 2; ++i)
#pragma unroll
      for (int j = 0; j < 4; ++j) acc[i][j] = (f32x4){0.f, 0.f, 0.f, 0.f};
  } else {
    const float* st = p.state_ssm + ((((size_t)(s - 32) * 4 + l) * 2 + d) * 32 + h) * 8192;
#pragma unroll
    for (int i = 0; i < 2; ++i)
#pragma unroll
      for (int j = 0; j < 4; ++j) acc[i][j] = *(const f32x4*)(st + (size_t)(16 * j + fr) * 128 + 32 * w + 16 * i + 4 * fq);
  }
  const bf16_t* xc = (const bf16_t*)(p.ws + OFF_XC);
  const float* dtb = (const float*)(p.ws + OFF_DT);
  float* csb = (float*)(p.ws + OFF_CS);
  bf16_t* sst = (bf16_t*)(p.ws + OFF_SST);
  float* wgt = (float*)(smem + SS_R0 + SS_R1);
  u32x4 pb[8], px[4];
  float dt0, dt1;
  {
    const int c = d == 0 ? 0 : nc - 1;
    const size_t tb = (size_t)(cg0 + c) * 128;
#pragma unroll
    for (int i = 0; i < 8; ++i) { const int q = tid + 256 * i; pb[i] = *(const u32x4*)(xc + (tb + (q >> 4)) * 4096 + 2048 + g * 128 + (q & 15) * 8); }
#pragma unroll
    for (int i = 0; i < 4; ++i) { const int q = tid + 256 * i; px[i] = *(const u32x4*)(xc + (tb + (q >> 3)) * 4096 + h * 64 + (q & 7) * 8); }
    dt0 = dtb[(tb + 2 * lane) * 64 + d * 32 + h];
    dt1 = dtb[(tb + 2 * lane + 1) * 64 + d * 32 + h];
  }
  const unsigned ldsb = (unsigned)(size_t)smem;
  const unsigned abase = ldsb + (8 * fq + (fr >> 2)) * SS_BROW + (32 * w + 4 * (fr & 3)) * 2;
  const unsigned xbase = ldsb + SS_R0 + (8 * fq + (fr >> 2)) * SS_XROW + (4 * (fr & 3)) * 2;
  for (int cc = 0; cc < nc; ++cc) {
    const int c = d == 0 ? cc : nc - 1 - cc, par = cc & 1;
    const size_t cgl = cg0 + c, tb = cgl * 128;
    {
      bf16_t* so = sst + ((cgl * 32 + h) * 2 + d) * 8192;
#pragma unroll
      for (int i = 0; i < 2; ++i)
#pragma unroll
        for (int j = 0; j < 4; ++j) {
          u32x2 o; o[0] = pack2(acc[i][j][0], acc[i][j][1]); o[1] = pack2(acc[i][j][2], acc[i][j][3]);
          *(u32x2*)(so + (size_t)(16 * j + fr) * 128 + 32 * w + 16 * i + 4 * fq) = o;
        }
    }
    if (w == 0) {
      const float v0 = dt0 * a, v1 = dt1 * a, sloc = v0 + v1;
      float incl = sloc;
#pragma unroll
      for (int off = 1; off < 64; off <<= 1) { const float t = __shfl_up(incl, off); if (lane >= off) incl += t; }
      const float excl = incl - sloc, c0 = excl + v0, tot = __shfl(incl, 63);
      float cs0, cs1, wg0, wg1;
      if (d == 0) { cs0 = c0; cs1 = incl; wg0 = dt0 * __expf(tot - c0); wg1 = dt1 * __expf(tot - incl); }
      else { cs0 = tot - excl; cs1 = tot - c0; wg0 = dt0 * __expf(excl); wg1 = dt1 * __expf(c0); }
      csb[(tb + 2 * lane) * 64 + d * 32 + h] = cs0;
      csb[(tb + 2 * lane + 1) * 64 + d * 32 + h] = cs1;
      wgt[par * 128 + 2 * lane] = wg0;
      wgt[par * 128 + 2 * lane + 1] = wg1;
      if (lane == 0) wgt[256 + par] = __expf(tot);
    }
    __syncthreads();
#pragma unroll
    for (int i = 0; i < 8; ++i) { const int q = tid + 256 * i; *(u32x4*)(smem + (q >> 4) * SS_BROW + (q & 15) * 16) = pb[i]; }
#pragma unroll
    for (int i = 0; i < 4; ++i) {
      const int q = tid + 256 * i, row = q >> 3;
      const float wv = wgt[par * 128 + row];
      u32x4 o;
#pragma unroll
      for (int e = 0; e < 4; ++e) o[e] = pack2(bf2f((bf16_t)(px[i][e] & 0xffff)) * wv, bf2f((bf16_t)(px[i][e] >> 16)) * wv);
      *(u32x4*)(smem + SS_R0 + row * SS_XROW + (q & 7) * 16) = o;
    }
    if (cc + 1 < nc) {
      const int cn = d == 0 ? cc + 1 : nc - 2 - cc;
      const size_t tbn = (size_t)(cg0 + cn) * 128;
#pragma unroll
      for (int i = 0; i < 8; ++i) { const int q = tid + 256 * i; pb[i] = *(const u32x4*)(xc + (tbn + (q >> 4)) * 4096 + 2048 + g * 128 + (q & 15) * 8); }
#pragma unroll
      for (int i = 0; i < 4; ++i) { const int q = tid + 256 * i; px[i] = *(const u32x4*)(xc + (tbn + (q >> 3)) * 4096 + h * 64 + (q & 7) * 8); }
      dt0 = dtb[(tbn + 2 * lane) * 64 + d * 32 + h];
      dt1 = dtb[(tbn + 2 * lane + 1) * 64 + d * 32 + h];
    }
    __syncthreads();
    const float dec = wgt[256 + par];
#pragma unroll
    for (int i = 0; i < 2; ++i)
#pragma unroll
      for (int j = 0; j < 4; ++j) acc[i][j] *= dec;
    ssd_p1_kstep<0>(acc, abase, xbase);
    ssd_p1_kstep<1>(acc, abase, xbase);
    ssd_p1_kstep<2>(acc, abase, xbase);
    ssd_p1_kstep<3>(acc, abase, xbase);
  }
  if (s < 32) {
    float* o = p.out + OUT_SSM + ((((size_t)s * 4 + l) * 2 + d) * 32 + h) * 8192;
#pragma unroll
    for (int i = 0; i < 2; ++i)
#pragma unroll
      for (int j = 0; j < 4; ++j) *(f32x4*)(o + (size_t)(16 * j + fr) * 128 + 32 * w + 16 * i + 4 * fq) = acc[i][j];
  }
  __syncthreads();
}

template <int KS>
__device__ __forceinline__ void ssd_p2_wx_kstep(f32x4 (&y)[4], const char* wrow, unsigned xbase) {
  s16x4 b00, b01, b10, b11, b20, b21, b30, b31;
  const bf16x8 A = *(const bf16x8*)(wrow + KS * 64);
  asm volatile(
      "ds_read_b64_tr_b16 %0, %8 offset:%9\n\t"
      "ds_read_b64_tr_b16 %1, %8 offset:%10\n\t"
      "ds_read_b64_tr_b16 %2, %8 offset:%11\n\t"
      "ds_read_b64_tr_b16 %3, %8 offset:%12\n\t"
      "ds_read_b64_tr_b16 %4, %8 offset:%13\n\t"
      "ds_read_b64_tr_b16 %5, %8 offset:%14\n\t"
      "ds_read_b64_tr_b16 %6, %8 offset:%15\n\t"
      "ds_read_b64_tr_b16 %7, %8 offset:%16\n\t"
      "s_waitcnt lgkmcnt(0)"
      : "=&v"(b00), "=&v"(b01), "=&v"(b10), "=&v"(b11), "=&v"(b20), "=&v"(b21), "=&v"(b30), "=&v"(b31)
      : "v"(xbase), "i"(KS * 32 * SS_XROW), "i"(KS * 32 * SS_XROW + 4 * SS_XROW), "i"(KS * 32 * SS_XROW + 32),
        "i"(KS * 32 * SS_XROW + 4 * SS_XROW + 32), "i"(KS * 32 * SS_XROW + 64), "i"(KS * 32 * SS_XROW + 4 * SS_XROW + 64),
        "i"(KS * 32 * SS_XROW + 96), "i"(KS * 32 * SS_XROW + 4 * SS_XROW + 96)
      : "memory");
  y[0] = __builtin_amdgcn_mfma_f32_16x16x32_bf16(A, cat8(b00, b01), y[0], 0, 0, 0);
  y[1] = __builtin_amdgcn_mfma_f32_16x16x32_bf16(A, cat8(b10, b11), y[1], 0, 0, 0);
  y[2] = __builtin_amdgcn_mfma_f32_16x16x32_bf16(A, cat8(b20, b21), y[2], 0, 0, 0);
  y[3] = __builtin_amdgcn_mfma_f32_16x16x32_bf16(A, cat8(b30, b31), y[3], 0, 0, 0);
}

__device__ __forceinline__ void ssd_pass2_item(const Params& p, int l, int item, char* smem) {
  const int hf = item & 1, g = (item >> 1) & 7, cg = item >> 4;
  const size_t tb = (size_t)cg * 128;
  const int tid = tid_opaque(), lane = tid & 63, w = tid >> 6, fr = lane & 15, fq = lane >> 4;
  const int i0 = 64 * hf + 16 * w;
  const bf16_t* xc = (const bf16_t*)(p.ws + OFF_XC);
  const bf16_t* proj = (const bf16_t*)(p.ws + OFF_PROJ);
  const float* dtb = (const float*)(p.ws + OFF_DT);
  const float* csb = (const float*)(p.ws + OFF_CS);
  const bf16_t* sst = (const bf16_t*)(p.ws + OFF_SST);
  bf16_t* ybuf = (bf16_t*)(p.ws + OFF_YBUF);
  float* arr = (float*)(smem + SS_R0 + SS_R1);
  __syncthreads();
  bf16x8 cfr[4];
#pragma unroll
  for (int ks = 0; ks < 4; ++ks) cfr[ks] = *(const bf16x8*)(xc + (tb + i0 + fr) * 4096 + 3072 + g * 128 + 32 * ks + 8 * fq);
#pragma unroll
  for (int i = 0; i < 8; ++i) {
    const int idx = tid + 256 * i, hh = idx >> 9, a = (idx >> 7) & 3, j = idx & 127;
    const float* src = (a < 2 ? csb : dtb) + (tb + j) * 64 + (a & 1) * 32 + 4 * g + hh;
    arr[idx] = *src;
  }
#pragma unroll
  for (int i = 0; i < 8; ++i) {
    const int q = tid + 256 * i;
    *(u32x4*)(smem + (q >> 4) * SS_BROW + (q & 15) * 16) = *(const u32x4*)(xc + (tb + (q >> 4)) * 4096 + 2048 + g * 128 + (q & 15) * 8);
  }
  __syncthreads();
  f32x4 cb[8];
#pragma unroll
  for (int jt = 0; jt < 8; ++jt) cb[jt] = (f32x4){0.f, 0.f, 0.f, 0.f};
#pragma unroll
  for (int ks = 0; ks < 4; ++ks)
#pragma unroll
    for (int jt = 0; jt < 8; ++jt) {
      const bf16x8 A = *(const bf16x8*)(smem + (16 * jt + fr) * SS_BROW + (32 * ks + 8 * fq) * 2);
      cb[jt] = __builtin_amdgcn_mfma_f32_16x16x32_bf16(A, cfr[ks], cb[jt], 0, 0, 0);
    }
  __syncthreads();
  float ss[4] = {0.f, 0.f, 0.f, 0.f};
  const unsigned ldsb = (unsigned)(size_t)smem;
  const unsigned xbase = ldsb + SS_R0 + (8 * fq + (fr >> 2)) * SS_XROW + (4 * (fr & 3)) * 2;
  const char* wrow = smem + (16 * w + fr) * SS_BROW + (8 * fq) * 2;
  const int il = i0 + fr;
#pragma unroll 1
  for (int hh = 0; hh < 4; ++hh) {
    const int h = 4 * g + hh;
    u32x4 pre[4];
#pragma unroll
    for (int i = 0; i < 4; ++i) { const int q = tid + 256 * i; pre[i] = *(const u32x4*)(xc + (tb + (q >> 3)) * 4096 + h * 64 + (q & 7) * 8); }
    const float* csf = arr + hh * 512;
    const float* csr = csf + 128;
    const float* dtf = csf + 256;
    const float* dtr = csf + 384;
    {
      const float cfi = csf[il], cbi = csr[il];
#pragma unroll
      for (int jt = 0; jt < 8; ++jt) {
        const f32x4 cfj = *(const f32x4*)(csf + 16 * jt + 4 * fq), cbj = *(const f32x4*)(csr + 16 * jt + 4 * fq);
        const f32x4 dfj = *(const f32x4*)(dtf + 16 * jt + 4 * fq), dbj = *(const f32x4*)(dtr + 16 * jt + 4 * fq);
        float wv[4];
#pragma unroll
        for (int jj = 0; jj < 4; ++jj) {
          const int j = 16 * jt + 4 * fq + jj;
          const float lf = (j <= il) ? __expf(cfi - cfj[jj]) * dfj[jj] : 0.f;
          const float lr = (j >= il) ? __expf(cbi - cbj[jj]) * dbj[jj] : 0.f;
          wv[jj] = cb[jt][jj] * (lf + lr);
        }
        u32x2 o; o[0] = pack2(wv[0], wv[1]); o[1] = pack2(wv[2], wv[3]);
        *(u32x2*)(smem + (16 * w + fr) * SS_BROW + (16 * jt + 4 * fq) * 2) = o;
      }
    }
#pragma unroll
    for (int i = 0; i < 4; ++i) { const int q = tid + 256 * i; *(u32x4*)(smem + SS_R0 + (q >> 3) * SS_XROW + (q & 7) * 16) = pre[i]; }
#pragma unroll
    for (int i = 0; i < 4; ++i) { const int q = tid + 256 * i; pre[i] = *(const u32x4*)(sst + (((size_t)cg * 32 + h) * 2 + 0) * 8192 + (q >> 4) * 128 + (q & 15) * 8); }
    __syncthreads();
    f32x4 y[4];
#pragma unroll
    for (int pt = 0; pt < 4; ++pt) y[pt] = (f32x4){0.f, 0.f, 0.f, 0.f};
    ssd_p2_wx_kstep<0>(y, wrow, xbase);
    ssd_p2_wx_kstep<1>(y, wrow, xbase);
    ssd_p2_wx_kstep<2>(y, wrow, xbase);
    ssd_p2_wx_kstep<3>(y, wrow, xbase);
    float xsk[4][4];
#pragma unroll
    for (int pt = 0; pt < 4; ++pt)
#pragma unroll
      for (int jj = 0; jj < 4; ++jj) xsk[pt][jj] = bf2f(*(const bf16_t*)(smem + SS_R0 + (i0 + 4 * fq + jj) * SS_XROW + (16 * pt + fr) * 2));
    __syncthreads();
#pragma unroll
    for (int i = 0; i < 4; ++i) { const int q = tid + 256 * i; *(u32x4*)(smem + SS_R0 + (q >> 4) * SS_BROW + (q & 15) * 16) = pre[i]; }
#pragma unroll
    for (int i = 0; i < 4; ++i) { const int q = tid + 256 * i; pre[i] = *(const u32x4*)(sst + (((size_t)cg * 32 + h) * 2 + 1) * 8192 + (q >> 4) * 128 + (q & 15) * 8); }
    __syncthreads();
    f32x4 zf[4], zb[4];
#pragma unroll
    for (int pt = 0; pt < 4; ++pt) { zf[pt] = (f32x4){0.f, 0.f, 0.f, 0.f}; zb[pt] = (f32x4){0.f, 0.f, 0.f, 0.f}; }
#pragma unroll
    for (int ks = 0; ks < 4; ++ks)
#pragma unroll
      for (int pt = 0; pt < 4; ++pt) {
        const bf16x8 B = *(const bf16x8*)(smem + SS_R0 + (16 * pt + fr) * SS_BROW + (32 * ks + 8 * fq) * 2);
        zf[pt] = __builtin_amdgcn_mfma_f32_16x16x32_bf16(cfr[ks], B, zf[pt], 0, 0, 0);
      }
    __syncthreads();
#pragma unroll
    for (int i = 0; i < 4; ++i) { const int q = tid + 256 * i; *(u32x4*)(smem + SS_R0 + (q >> 4) * SS_BROW + (q & 15) * 16) = pre[i]; }
    __syncthreads();
#pragma unroll
    for (int ks = 0; ks < 4; ++ks)
#pragma unroll
      for (int pt = 0; pt < 4; ++pt) {
        const bf16x8 B = *(const bf16x8*)(smem + SS_R0 + (16 * pt + fr) * SS_BROW + (32 * ks + 8 * fq) * 2);
        zb[pt] = __builtin_amdgcn_mfma_f32_16x16x32_bf16(cfr[ks], B, zb[pt], 0, 0, 0);
      }
    const float dsk = p.ssd_d[l * 32 + h];
#pragma unroll
    for (int jj = 0; jj < 4; ++jj) {
      const int i2 = i0 + 4 * fq + jj;
      const float ef = __expf(csf[i2]), eb = __expf(csr[i2]);
#pragma unroll
      for (int pt = 0; pt < 4; ++pt) {
        const float z = bf2f(proj[(tb + i2) * NPROJ_PAD + C_Z + h * 64 + 16 * pt + fr]);
        float val = y[pt][jj] + ef * zf[pt][jj] + eb * zb[pt][jj] + dsk * xsk[pt][jj];
        val *= siluf_(z);
        ybuf[(tb + i2) * 2048 + h * 64 + 16 * pt + fr] = f2bf(val);
        ss[jj] += val * val;
      }
    }
    __syncthreads();
  }
#pragma unroll
  for (int jj = 0; jj < 4; ++jj) {
    float t = ss[jj];
    t += __shfl_xor(t, 1); t += __shfl_xor(t, 2); t += __shfl_xor(t, 4); t += __shfl_xor(t, 8);
    ss[jj] = rsqrtf(t * (1.f / 256.f) + 1e-6f);
  }
#pragma unroll
  for (int hh = 0; hh < 4; ++hh)
#pragma unroll
    for (int pt = 0; pt < 4; ++pt) {
      const int chn = (4 * g + hh) * 64 + 16 * pt + fr;
      const float nw = p.ssd_norm_w[l * 2048 + chn];
#pragma unroll
      for (int jj = 0; jj < 4; ++jj) {
        bf16_t* yp = ybuf + (tb + i0 + 4 * fq + jj) * 2048 + chn;
        *yp = f2bf(bf2f(*yp) * ss[jj] * nw);
      }
    }
}

__device__ __forceinline__ void phase_scan1(const Params& p, int l, char* smem) {
  const int bid = blockIdx.x;
  if (bid < 64) { hgrn_chunk_item(p, l, 32 * 16 + bid, smem); return; }
  if (bid >= 256 && bid < 320) return;
  const int wkr = bid < 256 ? bid - 64 : bid - 128;
  for (int it = wkr; it < 256 + 512 + 2048; it += 384) {
    if (it < 256) ssd_pass1_item(p, l, 32 * 64 + it, smem);
    else if (it < 768) hgrn_chunk_item(p, l, it - 256, smem);
    else ssd_pass1_item(p, l, it - 768, smem);
  }
}
__device__ __forceinline__ void phase_scan2(const Params& p, int l, char* smem) {
  for (int it = blockIdx.x; it < 2048; it += gridDim.x) ssd_pass2_item(p, l, it, smem);
}

__device__ __forceinline__ void phase_scan_naive(const Params& p, int l, char* smem) {
  const int n_ssd = 36 * 64, n_hg = 36 * 16;
  for (int it = blockIdx.x; it < n_ssd + n_hg; it += gridDim.x) {
    if (it < 256) ssd_naive_item(p, l, 32 * 64 + it, (float*)smem);
    else if (it < 320) hgrn_chunk_item(p, l, 32 * 16 + (it - 256), smem);
    else if (it < 320 + 2048) ssd_naive_item(p, l, it - 320, (float*)smem);
    else hgrn_chunk_item(p, l, it - 320 - 2048, smem);
  }
}

__device__ __forceinline__ void phase_post(const Params& p, int l) {
  const int tid = tid_opaque();
  const bf16_t* proj = (const bf16_t*)(p.ws + OFF_PROJ);
  const bf16_t* xc = (const bf16_t*)(p.ws + OFF_XC);
  const float* yf = (const float*)(p.ws + OFF_YF);
  const float* yb = (const float*)(p.ws + OFF_YB);
  const float* of = (const float*)(p.ws + OFF_OF);
  const float* ob = (const float*)(p.ws + OFF_OB);
  bf16_t* ybuf = (bf16_t*)(p.ws + OFF_YBUF);
  bf16_t* obuf = (bf16_t*)(p.ws + OFF_OBUF);
  for (int tok = blockIdx.x; tok < T; tok += gridDim.x) {
    {
      const int ch = tid * 4;
      const float* a = of + (size_t)tok * 1024 + ch;
      const float* b = ob + (size_t)tok * 1024 + ch;
      uint2 gv = *(const uint2*)(proj + (size_t)tok * NPROJ_PAD + C_HG + ch);
      const unsigned gw[2] = {gv.x, gv.y};
      float v[4];
      float ss = 0.f;
#pragma unroll
      for (int j = 0; j < 4; ++j) { v[j] = a[j] + b[j]; ss += v[j] * v[j]; }
#pragma unroll
      for (int o = 16; o >= 1; o >>= 1) ss += __shfl_xor(ss, o);
      const float rstd = rsqrtf(ss * (1.f / 128.f) + 1e-6f);
      const float* nw = p.hgrn_norm_w + l * 1024 + ch;
      float r[4];
#pragma unroll
      for (int j = 0; j < 4; ++j) {
        const float gz = bf2f((bf16_t)((j & 1) ? (gw[j >> 1] >> 16) : (gw[j >> 1] & 0xffff)));
        r[j] = v[j] * rstd * nw[j] * siluf_(gz);
      }
      uint2 o2; o2.x = pack2(r[0], r[1]); o2.y = pack2(r[2], r[3]);
      *(uint2*)(obuf + (size_t)tok * 1024 + ch) = o2;
    }
  }
}


#define XB_TMO 128
#define XB_XCNT(j) (256 + 64 * (j))
#define XB_XSUB(j) (1280 + 64 * (j))
#define XB_XGEN(j) (2304 + 64 * (j))
#define XB_TOP 3328
#define XB_TOPGEN 3392
#define XCD_BAR_WORDS 3456
#define XB_SPIN_CAP (1u << 22)
#define LAS __attribute__((address_space(3)))
__device__ __forceinline__ unsigned xb_ld(unsigned* p) { return __hip_atomic_load(p, __ATOMIC_RELAXED, __HIP_MEMORY_SCOPE_AGENT); }
__device__ __forceinline__ unsigned xb_add(unsigned* p, unsigned v) { return __hip_atomic_fetch_add(p, v, __ATOMIC_RELAXED, __HIP_MEMORY_SCOPE_AGENT); }
__device__ __forceinline__ unsigned xb_xcc_id() { return (unsigned)__builtin_amdgcn_s_getreg((3 << 11) | 20) & 0xFu; }
#define XB_SPIN(cond, bar)                                                                    \
  do {                                                                                        \
    unsigned _sp = 0;                                                                         \
    while (cond) {                                                                            \
      __builtin_amdgcn_s_sleep(1);                                                            \
      if ((++_sp & 255u) == 0u) {                                                             \
        if (xb_ld(&(bar)[XB_TMO])) break;                                                     \
        if (_sp > XB_SPIN_CAP) { atomicAdd(&(bar)[XB_TMO], 1u); break; }                      \
      }                                                                                       \
    }                                                                                         \
  } while (0)
struct XcdBarrier { unsigned* bar; unsigned x; volatile LAS unsigned* st; };
__device__ __forceinline__ XcdBarrier xcd_barrier_post(unsigned* bar, volatile LAS unsigned* st) {
  XcdBarrier b; b.bar = bar; b.x = xb_xcc_id(); b.st = st;
  if (threadIdx.x == 0) (void)xb_add(&bar[XB_XCNT(b.x)], 1u);
  return b;
}
__device__ __forceinline__ void xcd_barrier_complete(unsigned* bar, unsigned x, unsigned& nloc, unsigned& nx) {
  const unsigned G = gridDim.x * gridDim.y * gridDim.z;
  unsigned sum, cnt, mine, sp = 0u;
  for (;;) {
    sum = 0u; cnt = 0u; mine = 0u;
#pragma unroll
    for (unsigned j = 0; j < 16; ++j) { const unsigned c = xb_ld(&bar[XB_XCNT(j)]); sum += c; cnt += (c > 0u) ? 1u : 0u; mine = (j == x) ? c : mine; }
    if (sum == G) break;
    __builtin_amdgcn_s_sleep(1);
    if ((++sp & 255u) == 0u) { if (xb_ld(&bar[XB_TMO])) break; if (sp > XB_SPIN_CAP) { atomicAdd(&bar[XB_TMO], 1u); break; } }
  }
  nloc = mine > 0u ? mine : 1u; nx = cnt > 0u ? cnt : 1u;
}
__device__ __forceinline__ void xcd_barrier(const XcdBarrier& b) {
  asm volatile("s_waitcnt vmcnt(0)" ::: "memory");
  __syncthreads();
  if (threadIdx.x == 0) {
    unsigned* bar = b.bar;
    __builtin_amdgcn_s_waitcnt(0);
    unsigned nloc = b.st[0], nx = b.st[1];
    if (nloc == 0u) { xcd_barrier_complete(bar, b.x, nloc, nx); b.st[0] = nloc; b.st[1] = nx; }
    const unsigned old = xb_add(&bar[XB_XSUB(b.x)], 1u);
    const unsigned gen = old / nloc;
    if (old + 1u == (gen + 1u) * nloc) {
      __builtin_amdgcn_fence(__ATOMIC_RELEASE, "agent");
      asm volatile("s_waitcnt vmcnt(0)" ::: "memory");
      const unsigned og = xb_add(&bar[XB_TOP], 1u);
      const unsigned tg = og / nx;
      if (og + 1u == (tg + 1u) * nx) xb_add(&bar[XB_TOPGEN], 1u);
      else XB_SPIN(xb_ld(&bar[XB_TOPGEN]) == tg, bar);
      __builtin_amdgcn_fence(__ATOMIC_ACQUIRE, "agent");
      xb_add(&bar[XB_XGEN(b.x)], 1u);
      asm volatile("s_waitcnt vmcnt(0)" ::: "memory");
    } else {
      XB_SPIN(xb_ld(&bar[XB_XGEN(b.x)]) == gen, bar);
      __builtin_amdgcn_fence(__ATOMIC_ACQUIRE, "agent");
      asm volatile("s_waitcnt vmcnt(0)" ::: "memory");
    }
  }
  __syncthreads();
}

enum { PH_SETUP = 0, PH_NORM1, PH_PROJ, PH_CONV, PH_SCAN, PH_POST, PH_MERGE, PH_OUT, PH_NORM2, PH_FFN1, PH_FFN2, PH_FINAL };

__device__ __forceinline__ void run_phase(const Params& p, int ph, int l, char* smem) {
  switch (ph) {
    case PH_SETUP: phase_setup(p, smem); break;
    case PH_NORM1: phase_norm(p, l, 0); break;
    case PH_PROJ: phase_gemm<G_PROJ>(p, l, smem); break;
    case PH_CONV: phase_conv(p, l); break;
    case PH_SCAN: phase_scan_naive(p, l, smem); break;
    case PH_POST: phase_post(p, l); break;
    case PH_MERGE: phase_gemm<G_MERGE>(p, l, smem); break;
    case PH_OUT: phase_gemm<G_OUT>(p, l, smem); break;
    case PH_NORM2: phase_norm(p, l, 1); break;
    case PH_FFN1: phase_gemm<G_FFN1>(p, l, smem); break;
    case PH_FFN2: phase_gemm<G_FFN2>(p, l, smem); break;
    case PH_FINAL: phase_final_norm(p); break;
  }
}

extern __shared__ __attribute__((aligned(16))) char dyn_smem[];

#if !MEGA
__global__ void __launch_bounds__(256, 2) phase_kernel(Params p, int ph, int l) { run_phase(p, ph, l, dyn_smem); }
#endif

#if MEGA
__global__ void __launch_bounds__(256, 2) mega_kernel(Params p) {
  cg::grid_group grid = cg::this_grid();
  __shared__ uint4 xb_words;
  if (threadIdx.x == 0) xb_words = make_uint4(0u, 0u, 0u, 0u);
  __syncthreads();
  XcdBarrier xb = xcd_barrier_post((unsigned*)(p.ws + OFF_BAR), (volatile LAS unsigned*)&xb_words);
  phase_setup(p, dyn_smem);
  grid.sync();
  for (int l = 0; l < DEPTH; ++l) {
#pragma unroll 1
    for (int ph = 0; ph < 10; ++ph) {
      switch (ph) {
        case 0: phase_norm(p, l, 0); break;
        case 1: phase_gemm<G_PROJ>(p, l, dyn_smem); break;
        case 2: phase_conv(p, l); break;
        case 3: phase_scan1(p, l, dyn_smem); break;
        case 4: phase_scan2(p, l, dyn_smem); phase_post(p, l); break;
        case 5: phase_gemm<G_MERGE>(p, l, dyn_smem); break;
        case 6: phase_gemm<G_OUT>(p, l, dyn_smem); break;
        case 7: phase_norm(p, l, 1); break;
        case 8: phase_gemm<G_FFN1>(p, l, dyn_smem); break;
        default: phase_gemm<G_FFN2>(p, l, dyn_smem); break;
      }
      xcd_barrier(xb);
    }
  }
  phase_final_norm(p);
}
#endif

extern "C" void kernel_launch(void* const* d_in, const int* in_sizes, int n_in, void* d_out, int out_size, void* d_ws, size_t ws_size,
                              hipStream_t stream) {
  static int grid_blocks = 0;
  if (!grid_blocks) {
    int dev = 0, cus = 0, per_cu = 0;
    (void)hipGetDevice(&dev);
    (void)hipDeviceGetAttribute(&cus, hipDeviceAttributeMultiprocessorCount, dev);
#if MEGA
    (void)hipFuncSetAttribute((const void*)mega_kernel, hipFuncAttributeMaxDynamicSharedMemorySize, SMEM_BYTES);
#endif
#if !MEGA
    (void)hipFuncSetAttribute((const void*)phase_kernel, hipFuncAttributeMaxDynamicSharedMemorySize, SMEM_BYTES);
#endif
#if MEGA
    (void)hipOccupancyMaxActiveBlocksPerMultiprocessor(&per_cu, mega_kernel, 256, SMEM_BYTES);
#else
    (void)hipOccupancyMaxActiveBlocksPerMultiprocessor(&per_cu, phase_kernel, 256, SMEM_BYTES);
#endif
    per_cu = 2;
    grid_blocks = cus * per_cu;
  }
  Params p{};
  const float** pf = (const float**)&p;
  for (int i = 0; i < 26; ++i) pf[i] = (const float*)d_in[i];
  p.out = (float*)d_out;
  p.ws = (char*)d_ws;
#if MEGA
  (void)hipMemsetAsync((char*)d_ws + OFF_BAR, 0, XCD_BAR_WORDS * 4, stream);
  void* args[] = {&p};
  hipError_t e = hipLaunchCooperativeKernel((void*)mega_kernel, dim3(grid_blocks), dim3(256), args, SMEM_BYTES, stream);
  if (e != hipSuccess) fprintf(stderr, "coop launch failed: %s\n", hipGetErrorString(e));
#else
  const int G = grid_blocks;
  phase_kernel<<<G, 256, SMEM_BYTES, stream>>>(p, PH_SETUP, 0);
  for (int l = 0; l < DEPTH; ++l)
    for (int ph = PH_NORM1; ph <= PH_FFN2; ++ph) phase_kernel<<<G, 256, SMEM_BYTES, stream>>>(p, ph, l);
  phase_kernel<<<G, 256, SMEM_BYTES, stream>>>(p, PH_FINAL, 0);
#endif
}
```

```cpp
#include <hip/hip_runtime.h>
#include <hip/hip_cooperative_groups.h>
#include <cstdio>
#include <cstdint>
namespace cg = cooperative_groups;

#ifndef MEGA
#define MEGA 1
#endif

typedef unsigned short bf16_t;
typedef short bf16x8 __attribute__((ext_vector_type(8)));
typedef float f32x4 __attribute__((ext_vector_type(4)));
typedef unsigned u32x4 __attribute__((ext_vector_type(4)));
typedef short s16x4 __attribute__((ext_vector_type(4)));
typedef unsigned u32x2 __attribute__((ext_vector_type(2)));

constexpr int D = 1024, T = 16384, TCTX = 8192, DEPTH = 4;
constexpr int NPROJ = 13376, NPROJ_PAD = 13440;
constexpr int FFN = 2816;
constexpr int C_Z = 4096, C_DT = 6144, C_HQ = 6208, C_HF = 7232, C_HI = 9280, C_HG = 10304, C_GATE = 11328;
constexpr size_t WT_IN = 0;
constexpr size_t WT_SSO = WT_IN + (size_t)NPROJ_PAD * 1024;
constexpr size_t WT_HGO = WT_SSO + (size_t)1024 * 2048;
constexpr size_t WT_OUT = WT_HGO + (size_t)1024 * 1024;
constexpr size_t WT_W13 = WT_OUT + (size_t)1024 * 1024;
constexpr size_t WT_W2 = WT_W13 + (size_t)5632 * 1024;
constexpr size_t WT_LAYER = WT_W2 + (size_t)1024 * 2816;
constexpr size_t OFF_WT = 0;
constexpr size_t OFF_H = OFF_WT + WT_LAYER * 2 * DEPTH;
constexpr size_t OFF_PROJ = OFF_H + (size_t)T * 1024 * 2;
constexpr size_t OFF_XC = OFF_PROJ + (size_t)T * NPROJ_PAD * 2;
constexpr size_t OFF_DTRAW = OFF_XC + (size_t)T * 4096 * 2;
constexpr size_t OFF_DT = OFF_DTRAW + (size_t)T * 64 * 4;
constexpr size_t OFF_YF = OFF_DT + (size_t)T * 64 * 4;
constexpr size_t OFF_YB = OFF_YF + (size_t)T * 2048 * 4;
constexpr size_t OFF_OF = OFF_YB + (size_t)T * 2048 * 4;
constexpr size_t OFF_OB = OFF_OF + (size_t)T * 1024 * 4;
constexpr size_t OFF_YBUF = OFF_OB + (size_t)T * 1024 * 4;
constexpr size_t OFF_OBUF = OFF_YBUF + (size_t)T * 2048 * 2;
constexpr size_t OFF_MBUF = OFF_OBUF + (size_t)T * 1024 * 2;
constexpr size_t OFF_MOD = OFF_MBUF + (size_t)T * 1024 * 2;
constexpr size_t OFF_LB = OFF_MOD + (size_t)DEPTH * 5 * 6144 * 4;
constexpr size_t OFF_BAR = OFF_LB + (size_t)DEPTH * 2 * 1024 * 4;
constexpr size_t OFF_END = OFF_BAR + 16384;
constexpr size_t OUT_SSM = (size_t)T * 1024;
constexpr size_t OUT_HGRN = OUT_SSM + (size_t)32 * 4 * 2 * 32 * 64 * 128;

constexpr int SMEM_BYTES = 73728;
constexpr int LDS_ROW = 128;
constexpr int LDS_TILE = 128 * LDS_ROW;

struct Params {
  const float *x_prompt, *x_sample, *c, *state_ssm, *state_hgrn, *c_ctx, *norm_mix_w, *norm_ffn_w, *ada_w, *ada_b, *w_in,
      *ssd_conv_w, *ssd_conv_b, *ssd_dt_bias, *ssd_a_log, *ssd_d, *ssd_norm_w, *hgrn_lb, *hgrn_norm_w, *w_ssd_out, *w_hgrn_out,
      *w_out, *ffn_w1, *ffn_w3, *ffn_w2, *norm_final_w;
  float* out;
  char* ws;
};

__device__ __forceinline__ bf16_t f2bf(float f) {
  unsigned u = __float_as_uint(f);
  u += 0x7fffu + ((u >> 16) & 1u);
  return (bf16_t)(u >> 16);
}
__device__ __forceinline__ float bf2f(bf16_t b) { return __uint_as_float(((unsigned)b) << 16); }
typedef __bf16 bf16x2_t __attribute__((ext_vector_type(2)));
__device__ __forceinline__ unsigned pack2(float a, float b) { bf16x2_t v = {(__bf16)a, (__bf16)b}; return __builtin_bit_cast(unsigned, v); }
__device__ __forceinline__ float sigmoidf_(float x) { return __builtin_amdgcn_rcpf(1.0f + __expf(-x)); }
__device__ __forceinline__ float siluf_(float x) { return x * __builtin_amdgcn_rcpf(1.0f + __expf(-x)); }
__device__ __forceinline__ int tid_opaque() { int t = threadIdx.x; asm volatile("" : "+v"(t)); return t; }
__device__ __forceinline__ float clamp30(float x) { return fminf(fmaxf(x, -30.f), 30.f); }
__device__ __forceinline__ float gate_ratio(float g1, float g2) { return (1.0f + __expf(-clamp30(g2))) * __builtin_amdgcn_rcpf(1.0f + __expf(-clamp30(g1))); }
__device__ __forceinline__ int mod_row(int tok) { return tok < TCTX ? 0 : 1 + ((tok - TCTX) >> 11); }

__device__ __forceinline__ void phase_setup(const Params& p, char* smem) {
  const int tid = tid_opaque(), bid = blockIdx.x, G = gridDim.x;
  {
    const size_t n4 = (size_t)T * 1024 / 4, half4 = (size_t)TCTX * 1024 / 4;
    float4* dst = (float4*)p.out;
    const float4* s0 = (const float4*)p.x_prompt;
    const float4* s1 = (const float4*)p.x_sample;
    for (size_t i = (size_t)bid * 256 + tid; i < n4; i += (size_t)G * 256) dst[i] = i < half4 ? s0[i] : s1[i - half4];
  }
  {
    float* lb = (float*)(p.ws + OFF_LB);
    for (int i = bid * 256 + tid; i < 2048; i += G * 256) {
      float v0 = p.hgrn_lb[i], v1 = p.hgrn_lb[2048 + i], v2 = p.hgrn_lb[4096 + i], v3 = p.hgrn_lb[6144 + i];
      float m = fmaxf(fmaxf(v0, v1), fmaxf(v2, v3));
      float e0 = expf(v0 - m), e1 = expf(v1 - m), e2 = expf(v2 - m), e3 = expf(v3 - m);
      float inv = 1.0f / (e0 + e1 + e2 + e3);
      lb[i] = 0.f;
      lb[2048 + i] = e1 * inv;
      lb[4096 + i] = (e1 + e2) * inv;
      lb[6144 + i] = (e1 + e2 + e3) * inv;
    }
  }
  {
    float* sm = (float*)smem;
    float* modb = (float*)(p.ws + OFF_MOD);
    __syncthreads();
    for (int i = tid; i < 5 * 1024; i += 256) {
      int v = i >> 10, k = i & 1023;
      float cv = v == 0 ? p.c_ctx[k] : p.c[(v - 1) * 1024 + k];
      sm[i] = siluf_(cv);
    }
    __syncthreads();
    float* part = sm + 5 * 1024;
    for (int item = bid; item < DEPTH * 96; item += G) {
      int l = item / 96, cg_ = item % 96;
      int col = cg_ * 64 + (tid & 63), kg = tid >> 6;
      const float* w = p.ada_w + (size_t)l * 1024 * 6144 + col;
      float a0 = 0, a1 = 0, a2 = 0, a3 = 0, a4 = 0;
      for (int k = kg * 256; k < kg * 256 + 256; ++k) {
        float wv = w[(size_t)k * 6144];
        a0 += sm[k] * wv; a1 += sm[1024 + k] * wv; a2 += sm[2048 + k] * wv; a3 += sm[3072 + k] * wv; a4 += sm[4096 + k] * wv;
      }
      __syncthreads();
      part[(kg * 5 + 0) * 64 + (tid & 63)] = a0; part[(kg * 5 + 1) * 64 + (tid & 63)] = a1; part[(kg * 5 + 2) * 64 + (tid & 63)] = a2;
      part[(kg * 5 + 3) * 64 + (tid & 63)] = a3; part[(kg * 5 + 4) * 64 + (tid & 63)] = a4;
      __syncthreads();
      for (int i = tid; i < 320; i += 256) {
        int v = i >> 6, cc = i & 63;
        float s = part[(0 * 5 + v) * 64 + cc] + part[(1 * 5 + v) * 64 + cc] + part[(2 * 5 + v) * 64 + cc] + part[(3 * 5 + v) * 64 + cc];
        int colo = cg_ * 64 + cc;
        modb[((size_t)l * 5 + v) * 6144 + colo] = s + p.ada_b[l * 6144 + colo];
      }
    }
    __syncthreads();
  }
  {
    float* tile = (float*)smem;
    const int n_in = 210 * 16, n_sso = 16 * 32, n_hgo = 16 * 16, n_out = 16 * 16, n_w13 = 88 * 16, n_w2 = 16 * 44;
    const int per_layer = n_in + n_sso + n_hgo + n_out + n_w13 + n_w2;
    for (int it = bid; it < per_layer * DEPTH; it += G) {
      int l = it / per_layer, r = it % per_layer;
      bf16_t* wt = (bf16_t*)(p.ws + OFF_WT) + (size_t)l * WT_LAYER;
      const float *src0 = nullptr, *src1 = nullptr;
      int K, Nsrc, nt, kt;
      bf16_t* dst;
      bool zero = false;
      if (r < n_in) {
        nt = r / 16; kt = r % 16; K = 1024; Nsrc = NPROJ;
        dst = wt + WT_IN;
        if (nt >= 209) zero = true;
        src0 = p.w_in + (size_t)l * 1024 * NPROJ + nt * 64; src1 = src0 + 32;
      } else if ((r -= n_in) < n_sso) {
        nt = r / 32; kt = r % 32; K = 2048; Nsrc = 1024; dst = wt + WT_SSO;
        src0 = p.w_ssd_out + (size_t)l * 2048 * 1024 + nt * 64; src1 = src0 + 32;
      } else if ((r -= n_sso) < n_hgo) {
        nt = r / 16; kt = r % 16; K = 1024; Nsrc = 1024; dst = wt + WT_HGO;
        src0 = p.w_hgrn_out + (size_t)l * 1024 * 1024 + nt * 64; src1 = src0 + 32;
      } else if ((r -= n_hgo) < n_out) {
        nt = r / 16; kt = r % 16; K = 1024; Nsrc = 1024; dst = wt + WT_OUT;
        src0 = p.w_out + (size_t)l * 1024 * 1024 + nt * 64; src1 = src0 + 32;
      } else if ((r -= n_out) < n_w13) {
        nt = r / 16; kt = r % 16; K = 1024; Nsrc = FFN; dst = wt + WT_W13;
        src0 = p.ffn_w1 + (size_t)l * 1024 * FFN + nt * 32; src1 = p.ffn_w3 + (size_t)l * 1024 * FFN + nt * 32;
      } else {
        r -= n_w13;
        nt = r / 44; kt = r % 44; K = 2816; Nsrc = 1024; dst = wt + WT_W2;
        src0 = p.ffn_w2 + (size_t)l * 2816 * 1024 + nt * 64; src1 = src0 + 32;
      }
      __syncthreads();
      {
        int c4 = (tid & 15) * 4;
        const float* s = c4 < 32 ? src0 + c4 : src1 + (c4 - 32);
#pragma unroll
        for (int i = 0; i < 4; ++i) {
          int kr = (tid >> 4) + i * 16;
          float4 v = zero ? make_float4(0.f, 0.f, 0.f, 0.f) : *(const float4*)(s + (size_t)(kt * 64 + kr) * Nsrc);
          tile[kr * 65 + c4 + 0] = v.x; tile[kr * 65 + c4 + 1] = v.y; tile[kr * 65 + c4 + 2] = v.z; tile[kr * 65 + c4 + 3] = v.w;
        }
      }
      __syncthreads();
#pragma unroll
      for (int i = 0; i < 2; ++i) {
        int cidx = tid + i * 256, n = cidx >> 3, kc = cidx & 7;
        uint4 o;
        o.x = pack2(tile[(kc * 8 + 0) * 65 + n], tile[(kc * 8 + 1) * 65 + n]);
        o.y = pack2(tile[(kc * 8 + 2) * 65 + n], tile[(kc * 8 + 3) * 65 + n]);
        o.z = pack2(tile[(kc * 8 + 4) * 65 + n], tile[(kc * 8 + 5) * 65 + n]);
        o.w = pack2(tile[(kc * 8 + 6) * 65 + n], tile[(kc * 8 + 7) * 65 + n]);
        *(uint4*)(dst + (size_t)(nt * 64 + n) * K + kt * 64 + kc * 8) = o;
      }
    }
    __syncthreads();
  }
}

__device__ __forceinline__ void phase_norm(const Params& p, int l, int which) {
  const int lane = tid_opaque() & 63, wv = tid_opaque() >> 6;
  const float* nw = (which == 0 ? p.norm_mix_w : p.norm_ffn_w) + l * 1024;
  const float* modb = (const float*)(p.ws + OFF_MOD) + (size_t)l * 5 * 6144;
  bf16_t* h = (bf16_t*)(p.ws + OFF_H);
  for (int row = blockIdx.x * 4 + wv; row < T; row += gridDim.x * 4) {
    const float* x = p.out + (size_t)row * 1024;
    const float* md = modb + (size_t)mod_row(row) * 6144 + (which == 0 ? 0 : 3072);
    float4 v[4];
    float ss = 0.f;
#pragma unroll
    for (int i = 0; i < 4; ++i) {
      v[i] = *(const float4*)(x + i * 256 + lane * 4);
      ss += v[i].x * v[i].x + v[i].y * v[i].y + v[i].z * v[i].z + v[i].w * v[i].w;
    }
#pragma unroll
    for (int o = 32; o >= 1; o >>= 1) ss += __shfl_xor(ss, o);
    float rstd = rsqrtf(ss * (1.0f / 1024.f) + 1e-6f);
#pragma unroll
    for (int i = 0; i < 4; ++i) {
      int c = i * 256 + lane * 4;
      float4 w = *(const float4*)(nw + c), sh = *(const float4*)(md + c), sc = *(const float4*)(md + 1024 + c);
      float a0 = v[i].x * rstd * w.x * (1.f + sc.x) + sh.x, a1 = v[i].y * rstd * w.y * (1.f + sc.y) + sh.y;
      float a2 = v[i].z * rstd * w.z * (1.f + sc.z) + sh.z, a3 = v[i].w * rstd * w.w * (1.f + sc.w) + sh.w;
      uint2 o2; o2.x = pack2(a0, a1); o2.y = pack2(a2, a3);
      *(uint2*)(h + (size_t)row * 1024 + c) = o2;
    }
  }
}

__device__ __forceinline__ void phase_final_norm(const Params& p) {
  const int lane = tid_opaque() & 63, wv = tid_opaque() >> 6;
  for (int row = blockIdx.x * 4 + wv; row < T; row += gridDim.x * 4) {
    float* x = p.out + (size_t)row * 1024;
    float4 v[4];
    float ss = 0.f;
#pragma unroll
    for (int i = 0; i < 4; ++i) {
      v[i] = *(const float4*)(x + i * 256 + lane * 4);
      ss += v[i].x * v[i].x + v[i].y * v[i].y + v[i].z * v[i].z + v[i].w * v[i].w;
    }
#pragma unroll
    for (int o = 32; o >= 1; o >>= 1) ss += __shfl_xor(ss, o);
    float rstd = rsqrtf(ss * (1.0f / 1024.f) + 1e-6f);
#pragma unroll
    for (int i = 0; i < 4; ++i) {
      int c = i * 256 + lane * 4;
      float4 w = *(const float4*)(p.norm_final_w + c);
      float4 o4 = make_float4(v[i].x * rstd * w.x, v[i].y * rstd * w.y, v[i].z * rstd * w.z, v[i].w * rstd * w.w);
      *(float4*)(x + c) = o4;
    }
  }
}

template <bool HASMID>
__device__ __forceinline__ void gemm_kloop2(f32x4 (&acc)[4][4], const bf16_t* __restrict__ Ag, int lda, const bf16_t* __restrict__ Bg,
                                            int ldb, int K, const bf16_t* __restrict__ Ag2, int lda2, const bf16_t* __restrict__ Bg2,
                                            int ldb2, int K2, char* smem, const bf16_t* __restrict__ gate0) {
  const int tid = tid_opaque(), lane = tid & 63, wid = tid >> 6;
  const int wr = wid >> 1, wc = wid & 1, fr = lane & 15, fq = lane >> 4;
  const int srow = tid >> 3, schunk = (tid & 7) ^ ((tid >> 4) & 7);
  const int rofs0 = (fq ^ ((fr >> 1) & 7)) * 16;
  const bf16_t* ap = Ag + (size_t)srow * lda + schunk * 8;
  const bf16_t* bp = Bg + (size_t)srow * ldb + schunk * 8;
  const int nk1 = K >> 6;
  const int nk = nk1 + (K2 >> 6);
  char* const sdst = smem + tid * 16;
#define GK_DMA(buf, t)                                                                                                   \
  {                                                                                                                      \
    _Pragma("unroll") for (int i = 0; i < 4; ++i) {                                                                      \
      __builtin_amdgcn_global_load_lds((const unsigned*)(ap + (size_t)i * 32 * lda + (size_t)(t) * 64),                  \
                                       (unsigned*)(sdst + (buf) * LDS_TILE + i * 4096), 16, 0, 0);                       \
      __builtin_amdgcn_global_load_lds((const unsigned*)(bp + (size_t)i * 32 * ldb + (size_t)(t) * 64),                  \
                                       (unsigned*)(sdst + (2 + (buf)) * LDS_TILE + i * 4096), 16, 0, 0);                 \
    }                                                                                                                    \
  }
  GK_DMA(0, 0);
  __syncthreads();
  for (int kt = 0; kt < nk; ++kt) {
    const int cur = kt & 1;
    if (kt + 1 < nk) {
      if (kt + 1 == nk1) {
        ap = Ag2 + (size_t)srow * lda2 + schunk * 8 - (size_t)nk1 * 64;
        bp = Bg2 + (size_t)srow * ldb2 + schunk * 8 - (size_t)nk1 * 64;
        lda = lda2; ldb = ldb2;
      }
      GK_DMA(cur ^ 1, kt + 1);
    }
    if (HASMID && kt == nk1) {
#pragma unroll
      for (int m = 0; m < 4; ++m)
#pragma unroll
        for (int n = 0; n < 4; ++n) {
          uint2 g1 = *(const uint2*)(gate0 + (size_t)(m * 16) * NPROJ_PAD + n * 16);
          uint2 g2 = *(const uint2*)(gate0 + (size_t)(m * 16) * NPROJ_PAD + 1024 + n * 16);
          acc[m][n][0] *= gate_ratio(bf2f((bf16_t)(g1.x & 0xffff)), bf2f((bf16_t)(g2.x & 0xffff)));
          acc[m][n][1] *= gate_ratio(bf2f((bf16_t)(g1.x >> 16)), bf2f((bf16_t)(g2.x >> 16)));
          acc[m][n][2] *= gate_ratio(bf2f((bf16_t)(g1.y & 0xffff)), bf2f((bf16_t)(g2.y & 0xffff)));
          acc[m][n][3] *= gate_ratio(bf2f((bf16_t)(g1.y >> 16)), bf2f((bf16_t)(g2.y >> 16)));
        }
    }
    const char* sa = smem + cur * LDS_TILE + (wr * 64 + fr) * LDS_ROW;
    const char* sb = smem + (2 + cur) * LDS_TILE + (wc * 64 + fr) * LDS_ROW;
#pragma unroll
    for (int kk = 0; kk < 2; ++kk) {
      bf16x8 af[4], bfv[4];
      __builtin_amdgcn_sched_barrier(0);
#pragma unroll
      for (int m = 0; m < 4; ++m) af[m] = *(const bf16x8*)(sa + m * 16 * LDS_ROW + (rofs0 ^ (kk * 64)));
#pragma unroll
      for (int n = 0; n < 4; ++n) bfv[n] = *(const bf16x8*)(sb + n * 16 * LDS_ROW + (rofs0 ^ (kk * 64)));
      __builtin_amdgcn_sched_barrier(0);
#pragma unroll
      for (int m = 0; m < 4; ++m)
#pragma unroll
        for (int n = 0; n < 4; ++n) acc[m][n] = __builtin_amdgcn_mfma_f32_16x16x32_bf16(bfv[n], af[m], acc[m][n], 0, 0, 0);
    }
    __builtin_amdgcn_sched_barrier(0);
    __syncthreads();
  }
#undef GK_DMA
}

__device__ __forceinline__ void gemm_kloop(f32x4 (&acc)[4][4], const bf16_t* __restrict__ Ag, int lda, const bf16_t* __restrict__ Bg,
                                           int ldb, int K, char* smem) {
  gemm_kloop2<false>(acc, Ag, lda, Bg, ldb, K, Ag, lda, Bg, ldb, 0, smem, Ag);
}

constexpr int BG_STAGE = 24576;
__device__ __forceinline__ int swz4(int x) { return (0x78 >> (2 * x)) & 3; }
template <bool HASMID>
__device__ __forceinline__ void gemm_kloop_big(f32x4 (&acc)[8][4], const bf16_t* __restrict__ Ag, int lda, const bf16_t* __restrict__ Bg,
                                               int ldb, int K, const bf16_t* __restrict__ Ag2, int lda2,
                                               const bf16_t* __restrict__ Bg2, int ldb2, int K2, char* smem,
                                               const bf16_t* __restrict__ gate0) {
  const int tid = tid_opaque(), lane = tid & 63, wid = tid >> 6;
  const int wr = wid >> 1, wc = wid & 1, fr = lane & 15, fq = lane >> 4;
  const int srow = tid >> 2, schunk = (tid & 3) ^ swz4((tid >> 4) & 3);
  const int rofs = (fq ^ swz4((fr >> 2) & 3)) * 16;
  const int nks1 = K >> 5;
  const int nks = nks1 + (K2 >> 5);
  const bf16_t* ap1 = Ag + (size_t)srow * lda + schunk * 8;
  const bf16_t* bp1 = Bg + (size_t)srow * ldb + schunk * 8;
  const bf16_t* ap2 = Ag2 + (size_t)srow * lda2 + schunk * 8 - (size_t)nks1 * 32;
  const bf16_t* bp2 = Bg2 + (size_t)srow * ldb2 + schunk * 8 - (size_t)nks1 * 32;
  char* const sdst = smem + tid * 16;
#define BG_DMA(slot, kk_)                                                                                                  \
  {                                                                                                                        \
    const int t_ = (kk_) < nks ? (kk_) : nks - 1;                                                                          \
    const bool s2_ = t_ >= nks1;                                                                                           \
    const bf16_t* ap_ = (s2_ ? ap2 : ap1) + (size_t)t_ * 32;                                                               \
    const bf16_t* bp_ = (s2_ ? bp2 : bp1) + (size_t)t_ * 32;                                                               \
    const size_t la_ = (size_t)64 * (s2_ ? lda2 : lda), lb_ = (size_t)64 * (s2_ ? ldb2 : ldb);                             \
    _Pragma("unroll") for (int i = 0; i < 4; ++i)                                                                          \
        __builtin_amdgcn_global_load_lds((const unsigned*)(ap_ + i * la_), (unsigned*)(sdst + (slot) * BG_STAGE + i * 4096), 16, 0, 0); \
    _Pragma("unroll") for (int i = 0; i < 2; ++i)                                                                          \
        __builtin_amdgcn_global_load_lds((const unsigned*)(bp_ + i * lb_), (unsigned*)(sdst + (slot) * BG_STAGE + 16384 + i * 4096), 16, 0, 0); \
  }
  BG_DMA(0, 0);
  BG_DMA(1, 1);
  int slot = 0;
  for (int ks = 0; ks < nks; ++ks) {
    asm volatile("s_waitcnt vmcnt(6)" ::: "memory");
    __builtin_amdgcn_s_barrier();
    asm volatile("" ::: "memory");
    const int nslot = slot == 0 ? 2 : slot - 1;
    BG_DMA(nslot, ks + 2);
    if (HASMID && ks == nks1) {
      int zofs = 0;
      asm volatile("" : "+v"(zofs));
      const bf16_t* gz = gate0 + zofs;
#pragma unroll
      for (int m = 0; m < 8; ++m)
#pragma unroll
        for (int n = 0; n < 4; ++n) {
          uint2 g1 = *(const uint2*)(gz + (size_t)(m * 16) * NPROJ_PAD + n * 16);
          uint2 g2 = *(const uint2*)(gz + (size_t)(m * 16) * NPROJ_PAD + 1024 + n * 16);
          acc[m][n][0] *= gate_ratio(bf2f((bf16_t)(g1.x & 0xffff)), bf2f((bf16_t)(g2.x & 0xffff)));
          acc[m][n][1] *= gate_ratio(bf2f((bf16_t)(g1.x >> 16)), bf2f((bf16_t)(g2.x >> 16)));
          acc[m][n][2] *= gate_ratio(bf2f((bf16_t)(g1.y & 0xffff)), bf2f((bf16_t)(g2.y & 0xffff)));
          acc[m][n][3] *= gate_ratio(bf2f((bf16_t)(g1.y >> 16)), bf2f((bf16_t)(g2.y >> 16)));
        }
    }
    const char* sa = smem + slot * BG_STAGE + (wr * 128 + fr) * 64 + rofs;
    const char* sb = smem + slot * BG_STAGE + 16384 + (wc * 64 + fr) * 64 + rofs;
    bf16x8 af[8], bfv[4];
    __builtin_amdgcn_sched_barrier(0);
#pragma unroll
    for (int n = 0; n < 4; ++n) bfv[n] = *(const bf16x8*)(sb + n * 16 * 64);
#pragma unroll
    for (int m = 0; m < 8; ++m) af[m] = *(const bf16x8*)(sa + m * 16 * 64);
    __builtin_amdgcn_sched_barrier(0);
    __builtin_amdgcn_s_setprio(1);
#pragma unroll
    for (int m = 0; m < 8; ++m)
#pragma unroll
      for (int n = 0; n < 4; ++n) acc[m][n] = __builtin_amdgcn_mfma_f32_16x16x32_bf16(bfv[n], af[m], acc[m][n], 0, 0, 0);
    __builtin_amdgcn_s_setprio(0);
    __builtin_amdgcn_sched_barrier(0);
    slot = slot == 2 ? 0 : slot + 1;
  }
  asm volatile("s_waitcnt vmcnt(0)" ::: "memory");
  __builtin_amdgcn_s_barrier();
  asm volatile("" ::: "memory");
#undef BG_DMA
}
__device__ __forceinline__ void gemm_kloop_big1(f32x4 (&acc)[8][4], const bf16_t* __restrict__ Ag, int lda, const bf16_t* __restrict__ Bg,
                                                int ldb, int K, char* smem) {
  gemm_kloop_big<false>(acc, Ag, lda, Bg, ldb, K, Ag, lda, Bg, ldb, 0, smem, Ag);
}
enum { G_PROJ = 0, G_MERGE = 1, G_OUT = 2, G_FFN1 = 3, G_FFN2 = 4 };

template <int MODE>
__device__ __forceinline__ void phase_gemm(const Params& p, int l, char* smem) {
  const int tid = tid_opaque(), lane = tid & 63, wid = tid >> 6;
  const int wr = wid >> 1, wc = wid & 1, fr = lane & 15, fq = lane >> 4;
  const bf16_t* wt = (const bf16_t*)(p.ws + OFF_WT) + (size_t)l * WT_LAYER;
  const bf16_t* hbuf = (const bf16_t*)(p.ws + OFF_H);
  bf16_t* proj = (bf16_t*)(p.ws + OFF_PROJ);
  bf16_t* hidden = (bf16_t*)(p.ws + OFF_PROJ);
  const float* modb = (const float*)(p.ws + OFF_MOD) + (size_t)l * 5 * 6144;
  constexpr int nM = T / 256;
  constexpr int nN = MODE == G_PROJ ? NPROJ_PAD / 128 : (MODE == G_FFN1 ? 5632 / 128 : 1024 / 128);
  for (int t = blockIdx.x; t < nM * nN; t += gridDim.x) {
    const int pm = t % nM, pn = t / nM;
    const int row0 = pm * 256, col0 = pn * 128;
    f32x4 acc[8][4];
#pragma unroll
    for (int m = 0; m < 8; ++m)
#pragma unroll
      for (int n = 0; n < 4; ++n) acc[m][n] = (f32x4){0.f, 0.f, 0.f, 0.f};
    if (MODE == G_PROJ) {
      gemm_kloop_big1(acc, hbuf + (size_t)row0 * 1024, 1024, wt + WT_IN + (size_t)col0 * 1024, 1024, 1024, smem);
      float* dtraw = (float*)(p.ws + OFF_DTRAW);
      char* stg = smem + wid * 18432;
#pragma unroll
      for (int m = 0; m < 8; ++m) {
        const int row = row0 + wr * 128 + m * 16 + fr;
#pragma unroll
        for (int n = 0; n < 4; ++n) {
          const int col = col0 + wc * 64 + n * 16 + fq * 4;
          u32x2 o; o[0] = pack2(acc[m][n][0], acc[m][n][1]); o[1] = pack2(acc[m][n][2], acc[m][n][3]);
          *(u32x2*)(stg + (m * 16 + fr) * 144 + (n * 16 + fq * 4) * 2) = o;
          if (col >= C_DT && col < C_DT + 64) *(f32x4*)(dtraw + (size_t)row * 64 + (col - C_DT)) = acc[m][n];
        }
      }
      {
        bf16_t* dst = proj + (size_t)(row0 + wr * 128 + (lane >> 3)) * NPROJ_PAD + col0 + wc * 64 + (lane & 7) * 8;
        const char* src = stg + (lane >> 3) * 144 + (lane & 7) * 16;
#pragma unroll
        for (int i = 0; i < 16; ++i) *(u32x4*)(dst + (size_t)(8 * i) * NPROJ_PAD) = *(const u32x4*)(src + 8 * i * 144);
      }
      asm volatile("s_waitcnt lgkmcnt(0)" ::: "memory");
      __builtin_amdgcn_s_barrier();
      asm volatile("" ::: "memory");
    } else if (MODE == G_MERGE) {
      const bf16_t* ybuf = (const bf16_t*)(p.ws + OFF_YBUF);
      const bf16_t* obuf = (const bf16_t*)(p.ws + OFF_OBUF);
      bf16_t* mbuf = (bf16_t*)(p.ws + OFF_MBUF);
      gemm_kloop_big<true>(acc, ybuf + (size_t)row0 * 2048, 2048, wt + WT_SSO + (size_t)col0 * 2048, 2048, 2048,
                        obuf + (size_t)row0 * 1024, 1024, wt + WT_HGO + (size_t)col0 * 1024, 1024, 1024, smem,
                        proj + (size_t)(row0 + wr * 128 + fr) * NPROJ_PAD + C_GATE + col0 + wc * 64 + fq * 4);
#pragma unroll
      for (int m = 0; m < 8; ++m) {
        const int row = row0 + wr * 128 + m * 16 + fr;
#pragma unroll
        for (int n = 0; n < 4; ++n) {
          const int col = col0 + wc * 64 + n * 16 + fq * 4;
          uint2 g = *(const uint2*)(proj + (size_t)row * NPROJ_PAD + C_GATE + 1024 + col);
          float r0 = acc[m][n][0] * sigmoidf_(clamp30(bf2f((bf16_t)(g.x & 0xffff))));
          float r1 = acc[m][n][1] * sigmoidf_(clamp30(bf2f((bf16_t)(g.x >> 16))));
          float r2 = acc[m][n][2] * sigmoidf_(clamp30(bf2f((bf16_t)(g.y & 0xffff))));
          float r3 = acc[m][n][3] * sigmoidf_(clamp30(bf2f((bf16_t)(g.y >> 16))));
          uint2 o; o.x = pack2(r0, r1); o.y = pack2(r2, r3);
          *(uint2*)(mbuf + (size_t)row * 1024 + col) = o;
        }
      }
    } else if (MODE == G_OUT || MODE == G_FFN2) {
      if (MODE == G_OUT) {
        const bf16_t* mbuf = (const bf16_t*)(p.ws + OFF_MBUF);
        gemm_kloop_big1(acc, mbuf + (size_t)row0 * 1024, 1024, wt + WT_OUT + (size_t)col0 * 1024, 1024, 1024, smem);
      } else {
        gemm_kloop_big1(acc, hidden + (size_t)row0 * FFN, FFN, wt + WT_W2 + (size_t)col0 * FFN, FFN, FFN, smem);
      }
      const float* gate = modb + (size_t)mod_row(row0) * 6144 + (MODE == G_OUT ? 2048 : 5120);
#pragma unroll
      for (int m = 0; m < 8; ++m) {
        const int row = row0 + wr * 128 + m * 16 + fr;
#pragma unroll
        for (int n = 0; n < 4; ++n) {
          const int col = col0 + wc * 64 + n * 16 + fq * 4;
          f32x4 g = *(const f32x4*)(gate + col);
          f32x4* xp = (f32x4*)(p.out + (size_t)row * 1024 + col);
          f32x4 xv = *xp;
          xv += g * acc[m][n];
          *xp = xv;
        }
      }
    } else {
      gemm_kloop_big1(acc, hbuf + (size_t)row0 * 1024, 1024, wt + WT_W13 + (size_t)col0 * 1024, 1024, 1024, smem);
#pragma unroll
      for (int m = 0; m < 8; ++m) {
        const int row = row0 + wr * 128 + m * 16 + fr;
#pragma unroll
        for (int n = 0; n < 2; ++n) {
          const int hcol = (pn * 2 + wc) * 32 + n * 16 + fq * 4;
          float r[4];
#pragma unroll
          for (int j = 0; j < 4; ++j) r[j] = siluf_(acc[m][n][j]) * acc[m][n + 2][j];
          uint2 o; o.x = pack2(r[0], r[1]); o.y = pack2(r[2], r[3]);
          *(uint2*)(hidden + (size_t)row * FFN + hcol) = o;
        }
      }
    }
  }
}

__device__ __forceinline__ void phase_conv(const Params& p, int l) {
  const bf16_t* proj = (const bf16_t*)(p.ws + OFF_PROJ);
  bf16_t* xc = (bf16_t*)(p.ws + OFF_XC);
  const float* cw = p.ssd_conv_w + (size_t)l * 5 * 4096;
  const float* cb = p.ssd_conv_b + (size_t)l * 4096;
  for (int unit = blockIdx.x * 256 + tid_opaque(); unit < 512 * 256; unit += gridDim.x * 256) {
    const int ch = (unit & 511) * 8, sg = unit >> 9;
    const int t0 = sg * 64;
    int lo, hi;
    if (t0 < TCTX) { lo = t0 & ~255; hi = lo + 256; } else { lo = t0; hi = t0 + 64; }
    float w[5][8], bias[8];
#pragma unroll
    for (int k = 0; k < 5; ++k) {
      const f32x4 a = *(const f32x4*)(cw + k * 4096 + ch), b = *(const f32x4*)(cw + k * 4096 + ch + 4);
      w[k][0] = a[0]; w[k][1] = a[1]; w[k][2] = a[2]; w[k][3] = a[3]; w[k][4] = b[0]; w[k][5] = b[1]; w[k][6] = b[2]; w[k][7] = b[3];
    }
    {
      const f32x4 a = *(const f32x4*)(cb + ch), b = *(const f32x4*)(cb + ch + 4);
      bias[0] = a[0]; bias[1] = a[1]; bias[2] = a[2]; bias[3] = a[3]; bias[4] = b[0]; bias[5] = b[1]; bias[6] = b[2]; bias[7] = b[3];
    }
    const u32x4 zero4 = (u32x4){0u, 0u, 0u, 0u};
    u32x4 r0, r1, r2, r3, r4;
#define CV_LD(tt) (((tt) >= lo && (tt) < hi) ? *(const u32x4*)(proj + (size_t)(tt) * NPROJ_PAD + ch) : zero4)
    r0 = CV_LD(t0 - 2); r1 = CV_LD(t0 - 1); r2 = CV_LD(t0); r3 = CV_LD(t0 + 1);
#pragma unroll 4
    for (int t = t0; t < t0 + 64; ++t) {
      r4 = CV_LD(t + 2);
      float a[8];
#pragma unroll
      for (int j = 0; j < 8; ++j) a[j] = bias[j];
#define CV_ACC(R, k)                                                                                                     \
  _Pragma("unroll") for (int e = 0; e < 4; ++e) {                                                                        \
    a[2 * e] += w[k][2 * e] * bf2f((bf16_t)(R[e] & 0xffff));                                                             \
    a[2 * e + 1] += w[k][2 * e + 1] * bf2f((bf16_t)(R[e] >> 16));                                                        \
  }
      CV_ACC(r0, 0) CV_ACC(r1, 1) CV_ACC(r2, 2) CV_ACC(r3, 3) CV_ACC(r4, 4)
      u32x4 o;
      o[0] = pack2(siluf_(a[0]), siluf_(a[1])); o[1] = pack2(siluf_(a[2]), siluf_(a[3]));
      o[2] = pack2(siluf_(a[4]), siluf_(a[5])); o[3] = pack2(siluf_(a[6]), siluf_(a[7]));
      *(u32x4*)(xc + (size_t)t * 4096 + ch) = o;
      r0 = r1; r1 = r2; r2 = r3; r3 = r4;
    }
#undef CV_LD
#undef CV_ACC
  }
  const float* dtraw = (const float*)(p.ws + OFF_DTRAW);
  float* dt = (float*)(p.ws + OFF_DT);
  for (size_t i = (size_t)blockIdx.x * 256 + tid_opaque(); i < (size_t)T * 64; i += (size_t)gridDim.x * 256) {
    float v = dtraw[i] + p.ssd_dt_bias[l * 64 + (int)(i & 63)];
    dt[i] = v > 20.f ? v : log1pf(expf(v));
  }
}

__device__ __forceinline__ void ssd_naive_item(const Params& p, int l, int item, float* sm) {
  const int d = item & 1, h = (item >> 1) & 31, s = item >> 6;
  int tok0, L;
  if (s < 32) { tok0 = s * 256; L = 256; } else { tok0 = TCTX + (s - 32) * 2048; L = 2048; }
  const int tid = tid_opaque(), pp = tid >> 2, nq = tid & 3, g = h >> 2;
  float S[32];
  if (s < 32) {
#pragma unroll
    for (int i = 0; i < 32; ++i) S[i] = 0.f;
  } else {
    const float* st = p.state_ssm + ((((size_t)(s - 32) * 4 + l) * 2 + d) * 32 + h) * 8192 + pp * 128 + nq * 32;
#pragma unroll
    for (int i = 0; i < 32; ++i) S[i] = st[i];
  }
  const float a = -expf(p.ssd_a_log[l * 64 + d * 32 + h]);
  float* xs = sm; float* Bs = sm + 1024; float* Cs = Bs + 2048; float* dts = Cs + 2048;
  const bf16_t* xc = (const bf16_t*)(p.ws + OFF_XC);
  const float* dtb = (const float*)(p.ws + OFF_DT);
  float* ydir = (float*)(p.ws + (d == 0 ? OFF_YF : OFF_YB));
  for (int bt = 0; bt < L / 16; ++bt) {
    const int tb = d == 0 ? bt * 16 : L - 16 - bt * 16;
    __syncthreads();
    for (int e = tid; e < 16 * 320; e += 256) {
      const int tt = e / 320, c = e % 320;
      const size_t base = (size_t)(tok0 + tb + tt) * 4096;
      if (c < 64) xs[tt * 64 + c] = bf2f(xc[base + h * 64 + c]);
      else if (c < 192) Bs[tt * 128 + c - 64] = bf2f(xc[base + 2048 + g * 128 + c - 64]);
      else Cs[tt * 128 + c - 192] = bf2f(xc[base + 3072 + g * 128 + c - 192]);
    }
    if (tid < 16) dts[tid] = dtb[(size_t)(tok0 + tb + tid) * 64 + d * 32 + h];
    __syncthreads();
    for (int i2 = 0; i2 < 16; ++i2) {
      const int tt = d == 0 ? i2 : 15 - i2;
      const float dt = dts[tt], dA = expf(dt * a), xdt = xs[tt * 64 + pp] * dt;
      float acc = 0.f;
      const float* Bp = Bs + tt * 128 + nq * 32;
      const float* Cp = Cs + tt * 128 + nq * 32;
#pragma unroll
      for (int i = 0; i < 32; ++i) { S[i] = dA * S[i] + xdt * Bp[i]; acc += S[i] * Cp[i]; }
      acc += __shfl_xor(acc, 1); acc += __shfl_xor(acc, 2);
      if (nq == 0) ydir[(size_t)(tok0 + tb + tt) * 2048 + h * 64 + pp] = acc;
    }
  }
  if (s < 32) {
    float* o = p.out + OUT_SSM + ((((size_t)s * 4 + l) * 2 + d) * 32 + h) * 8192 + pp * 128 + nq * 32;
#pragma unroll
    for (int i = 0; i < 32; ++i) o[i] = S[i];
  }
}

__device__ __forceinline__ void hgrn_naive_item(const Params& p, int l, int item, float* sm) {
  const int d = item & 1, hd = (item >> 1) & 7, s = item >> 4;
  int tok0, L;
  if (s < 32) { tok0 = s * 256; L = 256; } else { tok0 = TCTX + (s - 32) * 2048; L = 2048; }
  const int tid = tid_opaque(), vv = tid >> 1, kh = tid & 1;
  float S[64];
  if (s < 32) {
#pragma unroll
    for (int i = 0; i < 64; ++i) S[i] = 0.f;
  } else {
    const float* st = p.state_hgrn + ((((size_t)(s - 32) * 4 + l) * 2 + d) * 8 + hd) * 16384 + (size_t)(kh * 64) * 128 + vv;
#pragma unroll
    for (int i = 0; i < 64; ++i) S[i] = st[(size_t)i * 128];
  }
  float* qs = sm; float* fs = sm + 2048; float* ks = sm + 4096; float* vs = sm + 6144;
  const bf16_t* proj = (const bf16_t*)(p.ws + OFF_PROJ);
  const float* lb = (const float*)(p.ws + OFF_LB) + (size_t)l * 2048 + d * 1024 + hd * 128;
  float* odir = (float*)(p.ws + (d == 0 ? OFF_OF : OFF_OB));
  for (int bt = 0; bt < L / 16; ++bt) {
    const int tb = d == 0 ? bt * 16 : L - 16 - bt * 16;
    __syncthreads();
    for (int e = tid; e < 16 * 128; e += 256) {
      const int tt = e >> 7, c = e & 127;
      const size_t base = (size_t)(tok0 + tb + tt) * NPROJ_PAD;
      const float q = bf2f(proj[base + C_HQ + hd * 128 + c]);
      const float u = bf2f(proj[base + C_HF + d * 1024 + hd * 128 + c]);
      const float lbv = lb[c];
      const float sg = sigmoidf_(u);
      qs[e] = siluf_(q);
      fs[e] = lbv + (1.f - lbv) * sg;
      ks[e] = (1.f - lbv) * (1.f - sg);
      vs[e] = bf2f(proj[base + C_HI + hd * 128 + c]);
    }
    __syncthreads();
    for (int i2 = 0; i2 < 16; ++i2) {
      const int tt = d == 0 ? i2 : 15 - i2;
      const float vval = vs[tt * 128 + vv];
      const float* fp = fs + tt * 128 + kh * 64;
      const float* kp = ks + tt * 128 + kh * 64;
      const float* qp = qs + tt * 128 + kh * 64;
      float acc = 0.f;
#pragma unroll
      for (int i = 0; i < 64; ++i) { S[i] = fp[i] * S[i] + kp[i] * vval; acc += S[i] * qp[i]; }
      acc += __shfl_xor(acc, 1);
      if (kh == 0) odir[(size_t)(tok0 + tb + tt) * 1024 + hd * 128 + vv] = acc;
    }
  }
  if (s < 32) {
    float* o = p.out + OUT_HGRN + ((((size_t)s * 4 + l) * 2 + d) * 8 + hd) * 16384 + (size_t)(kh * 64) * 128 + vv;
#pragma unroll
    for (int i = 0; i < 64; ++i) o[(size_t)i * 128] = S[i];
  }
}


constexpr int HG_ROW = 272;
constexpr int HG_IMG = 16 * HG_ROW;
constexpr int HG_BUF = 4 * HG_IMG + 512;
__device__ __forceinline__ void hgrn_chunk_item(const Params& p, int l, int item, char* smem) {
  const int d = item & 1, hd = (item >> 1) & 7, s = item >> 4;
  int tok0, L;
  if (s < 32) { tok0 = s * 256; L = 256; } else { tok0 = TCTX + (s - 32) * 2048; L = 2048; }
  const int tid = tid_opaque(), lane = tid & 63, w = tid >> 6, fr = lane & 15, fq = lane >> 4;
  const int ch = tid & 127, half = tid >> 7;
  f32x4 S[8][2];
  if (s < 32) {
#pragma unroll
    for (int kt = 0; kt < 8; ++kt) { S[kt][0] = (f32x4){0.f, 0.f, 0.f, 0.f}; S[kt][1] = (f32x4){0.f, 0.f, 0.f, 0.f}; }
  } else {
    const float* st = p.state_hgrn + ((((size_t)(s - 32) * 4 + l) * 2 + d) * 8 + hd) * 16384;
#pragma unroll
    for (int kt = 0; kt < 8; ++kt)
#pragma unroll
      for (int vt = 0; vt < 2; ++vt)
#pragma unroll
        for (int jj = 0; jj < 4; ++jj) S[kt][vt][jj] = st[(size_t)(16 * kt + fq * 4 + jj) * 128 + 32 * w + 16 * vt + fr];
  }
  const float lbv = ((const float*)(p.ws + OFF_LB))[(size_t)l * 2048 + d * 1024 + hd * 128 + ch];
  const bf16_t* proj = (const bf16_t*)(p.ws + OFF_PROJ);
  float* odir = (float*)(p.ws + (d == 0 ? OFF_OF : OFF_OB));
  float* xch = (float*)(smem + 2 * HG_BUF);
  const int nch = L >> 4;
  bf16_t rq[8], ru[8], rv[8];
  __syncthreads();
  {
#pragma unroll
    for (int i = 0; i < 8; ++i) {
      const int pos = 8 * half + i;
      const size_t tk = (size_t)(d == 0 ? tok0 + pos : tok0 + L - 1 - pos) * NPROJ_PAD;
      rq[i] = proj[tk + C_HQ + hd * 128 + ch];
      ru[i] = proj[tk + C_HF + d * 1024 + hd * 128 + ch];
      rv[i] = proj[tk + C_HI + hd * 128 + ch];
    }
  }
  for (int c = 0; c < nch; ++c) {
    char* buf = smem + (c & 1) * HG_BUF;
    float* xc_ = xch + (c & 1) * 256;
    float fv[8], kk[8], qs[8];
    float loc = 1.f;
#pragma unroll
    for (int i = 0; i < 8; ++i) {
      const float u = bf2f(ru[i]);
      const float sg = sigmoidf_(u);
      fv[i] = lbv + (1.f - lbv) * sg;
      kk[i] = (1.f - lbv) * (1.f - sg);
      qs[i] = siluf_(bf2f(rq[i]));
      loc *= fv[i];
      *(bf16_t*)(buf + 3 * HG_IMG + (8 * half + i) * HG_ROW + ch * 2) = rv[i];
    }
    xc_[half * 128 + ch] = loc;
    if (c + 1 < nch) {
#pragma unroll
      for (int i = 0; i < 8; ++i) {
        const int pos = (c + 1) * 16 + 8 * half + i;
        const size_t tk = (size_t)(d == 0 ? tok0 + pos : tok0 + L - 1 - pos) * NPROJ_PAD;
        rq[i] = proj[tk + C_HQ + hd * 128 + ch];
        ru[i] = proj[tk + C_HF + d * 1024 + hd * 128 + ch];
        rv[i] = proj[tk + C_HI + hd * 128 + ch];
      }
    }
    __syncthreads();
    {
      const float other = xc_[(half ^ 1) * 128 + ch];
      float P = half ? other : 1.f;
      float sfx = half ? 1.f : other;
      float suf[8];
#pragma unroll
      for (int i = 7; i >= 0; --i) { suf[i] = sfx; sfx *= fv[i]; }
#pragma unroll
      for (int i = 0; i < 8; ++i) {
        P *= fv[i];
        const int off = (8 * half + i) * HG_ROW + ch * 2;
        *(bf16_t*)(buf + off) = f2bf(qs[i] * P);
        *(bf16_t*)(buf + HG_IMG + off) = f2bf(kk[i] * __builtin_amdgcn_rcpf(fmaxf(P, 1e-30f)));
        *(bf16_t*)(buf + 2 * HG_IMG + off) = f2bf(kk[i] * suf[i]);
      }
      if (half) ((float*)(buf + 4 * HG_IMG))[ch] = P;
    }
    __syncthreads();
    const char* qtI = buf;
    const char* ktI = buf + HG_IMG;
    const float* dec = (const float*)(buf + 4 * HG_IMG);
    f32x4 at = (f32x4){0.f, 0.f, 0.f, 0.f};
#pragma unroll
    for (int ks = 0; ks < 4; ++ks) {
      bf16x8 a = *(const bf16x8*)(ktI + fr * HG_ROW + (32 * ks + fq * 8) * 2);
      bf16x8 b = *(const bf16x8*)(qtI + fr * HG_ROW + (32 * ks + fq * 8) * 2);
      at = __builtin_amdgcn_mfma_f32_16x16x32_bf16(a, b, at, 0, 0, 0);
    }
    s16x4 Pm;
    {
      u32x2 pk;
      pk[0] = pack2((fq * 4 + 0 <= fr) ? at[0] : 0.f, (fq * 4 + 1 <= fr) ? at[1] : 0.f);
      pk[1] = pack2((fq * 4 + 2 <= fr) ? at[2] : 0.f, (fq * 4 + 3 <= fr) ? at[3] : 0.f);
      Pm = __builtin_bit_cast(s16x4, pk);
    }
    const unsigned ldsb = (unsigned)(size_t)buf;
    const unsigned vaddr = ldsb + 3 * HG_IMG + (4 * fq + (fr >> 2)) * HG_ROW + (32 * w + 4 * (fr & 3)) * 2;
    const unsigned kaddr = ldsb + 2 * HG_IMG + (4 * fq + (fr >> 2)) * HG_ROW + (4 * (fr & 3)) * 2;
    s16x4 vf0, vf1, kf0, kf1, kf2, kf3, kf4, kf5, kf6, kf7;
    asm volatile(
        "ds_read_b64_tr_b16 %0, %10\n\t"
        "ds_read_b64_tr_b16 %1, %10 offset:32\n\t"
        "ds_read_b64_tr_b16 %2, %11\n\t"
        "ds_read_b64_tr_b16 %3, %11 offset:32\n\t"
        "ds_read_b64_tr_b16 %4, %11 offset:64\n\t"
        "ds_read_b64_tr_b16 %5, %11 offset:96\n\t"
        "ds_read_b64_tr_b16 %6, %11 offset:128\n\t"
        "ds_read_b64_tr_b16 %7, %11 offset:160\n\t"
        "ds_read_b64_tr_b16 %8, %11 offset:192\n\t"
        "ds_read_b64_tr_b16 %9, %11 offset:224\n\t"
        "s_waitcnt lgkmcnt(0)"
        : "=&v"(vf0), "=&v"(vf1), "=&v"(kf0), "=&v"(kf1), "=&v"(kf2), "=&v"(kf3), "=&v"(kf4), "=&v"(kf5), "=&v"(kf6), "=&v"(kf7)
        : "v"(vaddr), "v"(kaddr)
        : "memory");
    f32x4 o0 = __builtin_amdgcn_mfma_f32_16x16x16bf16_1k(Pm, vf0, (f32x4){0.f, 0.f, 0.f, 0.f}, 0, 0, 0);
    f32x4 o1 = __builtin_amdgcn_mfma_f32_16x16x16bf16_1k(Pm, vf1, (f32x4){0.f, 0.f, 0.f, 0.f}, 0, 0, 0);
#pragma unroll
    for (int ks = 0; ks < 4; ++ks) {
      u32x2 qa = *(const u32x2*)(qtI + fr * HG_ROW + (32 * ks + 4 * fq) * 2);
      u32x2 qb = *(const u32x2*)(qtI + fr * HG_ROW + (32 * ks + 16 + 4 * fq) * 2);
      u32x4 aa; aa[0] = qa[0]; aa[1] = qa[1]; aa[2] = qb[0]; aa[3] = qb[1];
      const bf16x8 A = __builtin_bit_cast(bf16x8, aa);
      u32x4 b0, b1;
      b0[0] = pack2(S[2 * ks][0][0], S[2 * ks][0][1]); b0[1] = pack2(S[2 * ks][0][2], S[2 * ks][0][3]);
      b0[2] = pack2(S[2 * ks + 1][0][0], S[2 * ks + 1][0][1]); b0[3] = pack2(S[2 * ks + 1][0][2], S[2 * ks + 1][0][3]);
      b1[0] = pack2(S[2 * ks][1][0], S[2 * ks][1][1]); b1[1] = pack2(S[2 * ks][1][2], S[2 * ks][1][3]);
      b1[2] = pack2(S[2 * ks + 1][1][0], S[2 * ks + 1][1][1]); b1[3] = pack2(S[2 * ks + 1][1][2], S[2 * ks + 1][1][3]);
      o0 = __builtin_amdgcn_mfma_f32_16x16x32_bf16(A, __builtin_bit_cast(bf16x8, b0), o0, 0, 0, 0);
      o1 = __builtin_amdgcn_mfma_f32_16x16x32_bf16(A, __builtin_bit_cast(bf16x8, b1), o1, 0, 0, 0);
    }
#pragma unroll
    for (int jj = 0; jj < 4; ++jj) {
      const int pos = c * 16 + fq * 4 + jj;
      const size_t tk = (size_t)(d == 0 ? tok0 + pos : tok0 + L - 1 - pos);
      odir[tk * 1024 + hd * 128 + 32 * w + fr] = o0[jj];
      odir[tk * 1024 + hd * 128 + 32 * w + 16 + fr] = o1[jj];
    }
    const s16x4 kfs[8] = {kf0, kf1, kf2, kf3, kf4, kf5, kf6, kf7};
#pragma unroll
    for (int kt = 0; kt < 8; ++kt) {
      const f32x4 dv = *(const f32x4*)(dec + 16 * kt + fq * 4);
      S[kt][0] = __builtin_amdgcn_mfma_f32_16x16x16bf16_1k(kfs[kt], vf0, S[kt][0] * dv, 0, 0, 0);
      S[kt][1] = __builtin_amdgcn_mfma_f32_16x16x16bf16_1k(kfs[kt], vf1, S[kt][1] * dv, 0, 0, 0);
    }
  }
  if (s < 32) {
    float* o = p.out + OUT_HGRN + ((((size_t)s * 4 + l) * 2 + d) * 8 + hd) * 16384;
#pragma unroll
    for (int kt = 0; kt < 8; ++kt)
#pragma unroll
      for (int vt = 0; vt < 2; ++vt)
#pragma unroll
        for (int jj = 0; jj < 4; ++jj) o[(size_t)(16 * kt + fq * 4 + jj) * 128 + 32 * w + 16 * vt + fr] = S[kt][vt][jj];
  }
}


constexpr size_t OFF_SST = OFF_YF;
constexpr size_t OFF_CS = OFF_YB;
constexpr int SS_BROW = 272, SS_XROW = 144;
constexpr int SS_R0 = 128 * SS_BROW;
constexpr int SS_R1 = 128 * SS_XROW;

template <int OFF>
__device__ __forceinline__ s16x4 tr_read(unsigned addr) {
  s16x4 r;
  asm volatile("ds_read_b64_tr_b16 %0, %1 offset:%2" : "=v"(r) : "v"(addr), "i"(OFF) : "memory");
  return r;
}
__device__ __forceinline__ bf16x8 cat8(s16x4 a, s16x4 b) {
  bf16x8 r;
  r[0] = a[0]; r[1] = a[1]; r[2] = a[2]; r[3] = a[3]; r[4] = b[0]; r[5] = b[1]; r[6] = b[2]; r[7] = b[3];
  return r;
}
#define TR_WAIT12(a, b, c, d, e, f, g, h, i, j, k, l_)                                                                            \
  asm volatile("s_waitcnt lgkmcnt(0)" : "+v"(a), "+v"(b), "+v"(c), "+v"(d), "+v"(e), "+v"(f), "+v"(g), "+v"(h), "+v"(i), "+v"(j), \
               "+v"(k), "+v"(l_)::"memory")
#define TR_WAIT8(a, b, c, d, e, f, g, h) \
  asm volatile("s_waitcnt lgkmcnt(0)" : "+v"(a), "+v"(b), "+v"(c), "+v"(d), "+v"(e), "+v"(f), "+v"(g), "+v"(h)::"memory")

template <int KS>
__device__ __forceinline__ void ssd_p1_kstep(f32x4 (&acc)[2][4], unsigned abase, unsigned xbase) {
  s16x4 a00, a01, a10, a11, b00, b01, b10, b11, b20, b21, b30, b31;
  asm volatile(
      "ds_read_b64_tr_b16 %0, %12 offset:%14\n\t"
      "ds_read_b64_tr_b16 %1, %12 offset:%15\n\t"
      "ds_read_b64_tr_b16 %2, %12 offset:%16\n\t"
      "ds_read_b64_tr_b16 %3, %12 offset:%17\n\t"
      "ds_read_b64_tr_b16 %4, %13 offset:%18\n\t"
      "ds_read_b64_tr_b16 %5, %13 offset:%19\n\t"
      "ds_read_b64_tr_b16 %6, %13 offset:%20\n\t"
      "ds_read_b64_tr_b16 %7, %13 offset:%21\n\t"
      "ds_read_b64_tr_b16 %8, %13 offset:%22\n\t"
      "ds_read_b64_tr_b16 %9, %13 offset:%23\n\t"
      "ds_read_b64_tr_b16 %10, %13 offset:%24\n\t"
      "ds_read_b64_tr_b16 %11, %13 offset:%25\n\t"
      "s_waitcnt lgkmcnt(0)"
      : "=&v"(a00), "=&v"(a01), "=&v"(a10), "=&v"(a11), "=&v"(b00), "=&v"(b01), "=&v"(b10), "=&v"(b11), "=&v"(b20), "=&v"(b21),
        "=&v"(b30), "=&v"(b31)
      : "v"(abase), "v"(xbase), "i"(KS * 32 * SS_BROW), "i"(KS * 32 * SS_BROW + 4 * SS_BROW), "i"(KS * 32 * SS_BROW + 32),
        "i"(KS * 32 * SS_BROW + 4 * SS_BROW + 32), "i"(KS * 32 * SS_XROW), "i"(KS * 32 * SS_XROW + 4 * SS_XROW),
        "i"(KS * 32 * SS_XROW + 32), "i"(KS * 32 * SS_XROW + 4 * SS_XROW + 32), "i"(KS * 32 * SS_XROW + 64),
        "i"(KS * 32 * SS_XROW + 4 * SS_XROW + 64), "i"(KS * 32 * SS_XROW + 96), "i"(KS * 32 * SS_XROW + 4 * SS_XROW + 96)
      : "memory");
  const bf16x8 A0 = cat8(a00, a01), A1 = cat8(a10, a11);
  const bf16x8 B0 = cat8(b00, b01), B1 = cat8(b10, b11), B2 = cat8(b20, b21), B3 = cat8(b30, b31);
  acc[0][0] = __builtin_amdgcn_mfma_f32_16x16x32_bf16(A0, B0, acc[0][0], 0, 0, 0);
  acc[0][1] = __builtin_amdgcn_mfma_f32_16x16x32_bf16(A0, B1, acc[0][1], 0, 0, 0);
  acc[0][2] = __builtin_amdgcn_mfma_f32_16x16x32_bf16(A0, B2, acc[0][2], 0, 0, 0);
  acc[0][3] = __builtin_amdgcn_mfma_f32_16x16x32_bf16(A0, B3, acc[0][3], 0, 0, 0);
  acc[1][0] = __builtin_amdgcn_mfma_f32_16x16x32_bf16(A1, B0, acc[1][0], 0, 0, 0);
  acc[1][1] = __builtin_amdgcn_mfma_f32_16x16x32_bf16(A1, B1, acc[1][1], 0, 0, 0);
  acc[1][2] = __builtin_amdgcn_mfma_f32_16x16x32_bf16(A1, B2, acc[1][2], 0, 0, 0);
  acc[1][3] = __builtin_amdgcn_mfma_f32_16x16x32_bf16(A1, B3, acc[1][3], 0, 0, 0);
}

__device__ __forceinline__ void ssd_pass1_item(const Params& p, int l, int item, char* smem) {
  const int d = item & 1, h = (item >> 1) & 31, s = item >> 6, g = h >> 2;
  const int nc = s < 32 ? 2 : 16, cg0 = s < 32 ? 2 * s : 64 + 16 * (s - 32);
  const int tid = tid_opaque(), lane = tid & 63, w = tid >> 6, fr = lane & 15, fq = lane >> 4;
  const float a = -expf(p.ssd_a_log[l * 64 + d * 32 + h]);
  f32x4 acc[2][4];
  if (s < 32) {
#pragma unroll
    for (int i = 0; i < 2; ++i)
#pragma unroll
      for (int j = 0; j < 4; ++j) acc[i][j] = (f32x4){0.f, 0.f, 0.f, 0.f};
  } else {
    const float* st = p.state_ssm + ((((size_t)(s - 32) * 4 + l) * 2 + d) * 32 + h) * 8192;
#pragma unroll
    for (int i = 0; i < 2; ++i)
#pragma unroll
      for (int j = 0; j < 4; ++j) acc[i][j] = *(const f32x4*)(st + (size_t)(16 * j + fr) * 128 + 32 * w + 16 * i + 4 * fq);
  }
  const bf16_t* xc = (const bf16_t*)(p.ws + OFF_XC);
  const float* dtb = (const float*)(p.ws + OFF_DT);
  float* csb = (float*)(p.ws + OFF_CS);
  bf16_t* sst = (bf16_t*)(p.ws + OFF_SST);
  float* wgt = (float*)(smem + SS_R0 + SS_R1);
  u32x4 pb[8], px[4];
  float dt0, dt1;
  {
    const int c = d == 0 ? 0 : nc - 1;
    const size_t tb = (size_t)(cg0 + c) * 128;
#pragma unroll
    for (int i = 0; i < 8; ++i) { const int q = tid + 256 * i; pb[i] = *(const u32x4*)(xc + (tb + (q >> 4)) * 4096 + 2048 + g * 128 + (q & 15) * 8); }
#pragma unroll
    for (int i = 0; i < 4; ++i) { const int q = tid + 256 * i; px[i] = *(const u32x4*)(xc + (tb + (q >> 3)) * 4096 + h * 64 + (q & 7) * 8); }
    dt0 = dtb[(tb + 2 * lane) * 64 + d * 32 + h];
    dt1 = dtb[(tb + 2 * lane + 1) * 64 + d * 32 + h];
  }
  const unsigned ldsb = (unsigned)(size_t)smem;
  const unsigned abase = ldsb + (8 * fq + (fr >> 2)) * SS_BROW + (32 * w + 4 * (fr & 3)) * 2;
  const unsigned xbase = ldsb + SS_R0 + (8 * fq + (fr >> 2)) * SS_XROW + (4 * (fr & 3)) * 2;
  for (int cc = 0; cc < nc; ++cc) {
    const int c = d == 0 ? cc : nc - 1 - cc, par = cc & 1;
    const size_t cgl = cg0 + c, tb = cgl * 128;
    {
      bf16_t* so = sst + ((cgl * 32 + h) * 2 + d) * 8192;
#pragma unroll
      for (int i = 0; i < 2; ++i)
#pragma unroll
        for (int j = 0; j < 4; ++j) {
          u32x2 o; o[0] = pack2(acc[i][j][0], acc[i][j][1]); o[1] = pack2(acc[i][j][2], acc[i][j][3]);
          *(u32x2*)(so + (size_t)(16 * j + fr) * 128 + 32 * w + 16 * i + 4 * fq) = o;
        }
    }
    if (w == 0) {
      const float v0 = dt0 * a, v1 = dt1 * a, sloc = v0 + v1;
      float incl = sloc;
#pragma unroll
      for (int off = 1; off < 64; off <<= 1) { const float t = __shfl_up(incl, off); if (lane >= off) incl += t; }
      const float excl = incl - sloc, c0 = excl + v0, tot = __shfl(incl, 63);
      float cs0, cs1, wg0, wg1;
      if (d == 0) { cs0 = c0; cs1 = incl; wg0 = dt0 * __expf(tot - c0); wg1 = dt1 * __expf(tot - incl); }
      else { cs0 = tot - excl; cs1 = tot - c0; wg0 = dt0 * __expf(excl); wg1 = dt1 * __expf(c0); }
      csb[(tb + 2 * lane) * 64 + d * 32 + h] = cs0;
      csb[(tb + 2 * lane + 1) * 64 + d * 32 + h] = cs1;
      wgt[par * 128 + 2 * lane] = wg0;
      wgt[par * 128 + 2 * lane + 1] = wg1;
      if (lane == 0) wgt[256 + par] = __expf(tot);
    }
    __syncthreads();
#pragma unroll
    for (int i = 0; i < 8; ++i) { const int q = tid + 256 * i; *(u32x4*)(smem + (q >> 4) * SS_BROW + (q & 15) * 16) = pb[i]; }
#pragma unroll
    for (int i = 0; i < 4; ++i) {
      const int q = tid + 256 * i, row = q >> 3;
      const float wv = wgt[par * 128 + row];
      u32x4 o;
#pragma unroll
      for (int e = 0; e < 4; ++e) o[e] = pack2(bf2f((bf16_t)(px[i][e] & 0xffff)) * wv, bf2f((bf16_t)(px[i][e] >> 16)) * wv);
      *(u32x4*)(smem + SS_R0 + row * SS_XROW + (q & 7) * 16) = o;
    }
    if (cc + 1 < nc) {
      const int cn = d == 0 ? cc + 1 : nc - 2 - cc;
      const size_t tbn = (size_t)(cg0 + cn) * 128;
#pragma unroll
      for (int i = 0; i < 8; ++i) { const int q = tid + 256 * i; pb[i] = *(const u32x4*)(xc + (tbn + (q >> 4)) * 4096 + 2048 + g * 128 + (q & 15) * 8); }
#pragma unroll
      for (int i = 0; i < 4; ++i) { const int q = tid + 256 * i; px[i] = *(const u32x4*)(xc + (tbn + (q >> 3)) * 4096 + h * 64 + (q & 7) * 8); }
      dt0 = dtb[(tbn + 2 * lane) * 64 + d * 32 + h];
      dt1 = dtb[(tbn + 2 * lane + 1) * 64 + d * 32 + h];
    }
    __syncthreads();
    const float dec = wgt[256 + par];
#pragma unroll
    for (int i = 0; i < 2; ++i)
#pragma unroll
      for (int j = 0; j < 4; ++j) acc[i][j] *= dec;
    ssd_p1_kstep<0>(acc, abase, xbase);
    ssd_p1_kstep<1>(acc, abase, xbase);
    ssd_p1_kstep<2>(acc, abase, xbase);
    ssd_p1_kstep<3>(acc, abase, xbase);
  }
  if (s < 32) {
    float* o = p.out + OUT_SSM + ((((size_t)s * 4 + l) * 2 + d) * 32 + h) * 8192;
#pragma unroll
    for (int i = 0; i < 2; ++i)
#pragma unroll
      for (int j = 0; j < 4; ++j) *(f32x4*)(o + (size_t)(16 * j + fr) * 128 + 32 * w + 16 * i + 4 * fq) = acc[i][j];
  }
  __syncthreads();
}

template <int KS>
__device__ __forceinline__ void ssd_p2_wx_kstep(f32x4 (&y)[4], const char* wrow, unsigned xbase) {
  s16x4 b00, b01, b10, b11, b20, b21, b30, b31;
  const bf16x8 A = *(const bf16x8*)(wrow + KS * 64);
  asm volatile(
      "ds_read_b64_tr_b16 %0, %8 offset:%9\n\t"
      "ds_read_b64_tr_b16 %1, %8 offset:%10\n\t"
      "ds_read_b64_tr_b16 %2, %8 offset:%11\n\t"
      "ds_read_b64_tr_b16 %3, %8 offset:%12\n\t"
      "ds_read_b64_tr_b16 %4, %8 offset:%13\n\t"
      "ds_read_b64_tr_b16 %5, %8 offset:%14\n\t"
      "ds_read_b64_tr_b16 %6, %8 offset:%15\n\t"
      "ds_read_b64_tr_b16 %7, %8 offset:%16\n\t"
      "s_waitcnt lgkmcnt(0)"
      : "=&v"(b00), "=&v"(b01), "=&v"(b10), "=&v"(b11), "=&v"(b20), "=&v"(b21), "=&v"(b30), "=&v"(b31)
      : "v"(xbase), "i"(KS * 32 * SS_XROW), "i"(KS * 32 * SS_XROW + 4 * SS_XROW), "i"(KS * 32 * SS_XROW + 32),
        "i"(KS * 32 * SS_XROW + 4 * SS_XROW + 32), "i"(KS * 32 * SS_XROW + 64), "i"(KS * 32 * SS_XROW + 4 * SS_XROW + 64),
        "i"(KS * 32 * SS_XROW + 96), "i"(KS * 32 * SS_XROW + 4 * SS_XROW + 96)
      : "memory");
  y[0] = __builtin_amdgcn_mfma_f32_16x16x32_bf16(A, cat8(b00, b01), y[0], 0, 0, 0);
  y[1] = __builtin_amdgcn_mfma_f32_16x16x32_bf16(A, cat8(b10, b11), y[1], 0, 0, 0);
  y[2] = __builtin_amdgcn_mfma_f32_16x16x32_bf16(A, cat8(b20, b21), y[2], 0, 0, 0);
  y[3] = __builtin_amdgcn_mfma_f32_16x16x32_bf16(A, cat8(b30, b31), y[3], 0, 0, 0);
}

__device__ __forceinline__ void ssd_pass2_item(const Params& p, int l, int item, char* smem) {
  const int hf = item & 1, g = (item >> 1) & 7, cg = item >> 4;
  const size_t tb = (size_t)cg * 128;
  const int tid = tid_opaque(), lane = tid & 63, w = tid >> 6, fr = lane & 15, fq = lane >> 4;
  const int i0 = 64 * hf + 16 * w;
  const bf16_t* xc = (const bf16_t*)(p.ws + OFF_XC);
  const bf16_t* proj = (const bf16_t*)(p.ws + OFF_PROJ);
  const float* dtb = (const float*)(p.ws + OFF_DT);
  const float* csb = (const float*)(p.ws + OFF_CS);
  const bf16_t* sst = (const bf16_t*)(p.ws + OFF_SST);
  bf16_t* ybuf = (bf16_t*)(p.ws + OFF_YBUF);
  float* arr = (float*)(smem + SS_R0 + SS_R1);
  __syncthreads();
  bf16x8 cfr[4];
#pragma unroll
  for (int ks = 0; ks < 4; ++ks) cfr[ks] = *(const bf16x8*)(xc + (tb + i0 + fr) * 4096 + 3072 + g * 128 + 32 * ks + 8 * fq);
#pragma unroll
  for (int i = 0; i < 8; ++i) {
    const int idx = tid + 256 * i, hh = idx >> 9, a = (idx >> 7) & 3, j = idx & 127;
    const float* src = (a < 2 ? csb : dtb) + (tb + j) * 64 + (a & 1) * 32 + 4 * g + hh;
    arr[idx] = *src;
  }
#pragma unroll
  for (int i = 0; i < 8; ++i) {
    const int q = tid + 256 * i;
    *(u32x4*)(smem + (q >> 4) * SS_BROW + (q & 15) * 16) = *(const u32x4*)(xc + (tb + (q >> 4)) * 4096 + 2048 + g * 128 + (q & 15) * 8);
  }
  __syncthreads();
  f32x4 cb[8];
#pragma unroll
  for (int jt = 0; jt < 8; ++jt) cb[jt] = (f32x4){0.f, 0.f, 0.f, 0.f};
#pragma unroll
  for (int ks = 0; ks < 4; ++ks)
#pragma unroll
    for (int jt = 0; jt < 8; ++jt) {
      const bf16x8 A = *(const bf16x8*)(smem + (16 * jt + fr) * SS_BROW + (32 * ks + 8 * fq) * 2);
      cb[jt] = __builtin_amdgcn_mfma_f32_16x16x32_bf16(A, cfr[ks], cb[jt], 0, 0, 0);
    }
  __syncthreads();
  float ss[4] = {0.f, 0.f, 0.f, 0.f};
  const unsigned ldsb = (unsigned)(size_t)smem;
  const unsigned xbase = ldsb + SS_R0 + (8 * fq + (fr >> 2)) * SS_XROW + (4 * (fr & 3)) * 2;
  const char* wrow = smem + (16 * w + fr) * SS_BROW + (8 * fq) * 2;
  const int il = i0 + fr;
#pragma unroll 1
  for (int hh = 0; hh < 4; ++hh) {
    const int h = 4 * g + hh;
    u32x4 pre[4];
#pragma unroll
    for (int i = 0; i < 4; ++i) { const int q = tid + 256 * i; pre[i] = *(const u32x4*)(xc + (tb + (q >> 3)) * 4096 + h * 64 + (q & 7) * 8); }
    const float* csf = arr + hh * 512;
    const float* csr = csf + 128;
    const float* dtf = csf + 256;
    const float* dtr = csf + 384;
    {
      const float cfi = csf[il], cbi = csr[il];
#pragma unroll
      for (int jt = 0; jt < 8; ++jt) {
        const f32x4 cfj = *(const f32x4*)(csf + 16 * jt + 4 * fq), cbj = *(const f32x4*)(csr + 16 * jt + 4 * fq);
        const f32x4 dfj = *(const f32x4*)(dtf + 16 * jt + 4 * fq), dbj = *(const f32x4*)(dtr + 16 * jt + 4 * fq);
        float wv[4];
#pragma unroll
        for (int jj = 0; jj < 4; ++jj) {
          const int j = 16 * jt + 4 * fq + jj;
          const bool le = j <= il;
          float mlt = __expf(le ? cfi - cfj[jj] : cbi - cbj[jj]) * (le ? dfj[jj] : dbj[jj]);
          if (j == il) mlt = dfj[jj] + dbj[jj];
          wv[jj] = cb[jt][jj] * mlt;
        }
        u32x2 o; o[0] = pack2(wv[0], wv[1]); o[1] = pack2(wv[2], wv[3]);
        *(u32x2*)(smem + (16 * w + fr) * SS_BROW + (16 * jt + 4 * fq) * 2) = o;
      }
    }
#pragma unroll
    for (int i = 0; i < 4; ++i) { const int q = tid + 256 * i; *(u32x4*)(smem + SS_R0 + (q >> 3) * SS_XROW + (q & 7) * 16) = pre[i]; }
#pragma unroll
    for (int i = 0; i < 4; ++i) { const int q = tid + 256 * i; pre[i] = *(const u32x4*)(sst + (((size_t)cg * 32 + h) * 2 + 0) * 8192 + (q >> 4) * 128 + (q & 15) * 8); }
    __syncthreads();
    f32x4 y[4];
#pragma unroll
    for (int pt = 0; pt < 4; ++pt) y[pt] = (f32x4){0.f, 0.f, 0.f, 0.f};
    ssd_p2_wx_kstep<0>(y, wrow, xbase);
    ssd_p2_wx_kstep<1>(y, wrow, xbase);
    ssd_p2_wx_kstep<2>(y, wrow, xbase);
    ssd_p2_wx_kstep<3>(y, wrow, xbase);
    float xsk[4][4];
#pragma unroll
    for (int pt = 0; pt < 4; ++pt)
#pragma unroll
      for (int jj = 0; jj < 4; ++jj) xsk[pt][jj] = bf2f(*(const bf16_t*)(smem + SS_R0 + (i0 + 4 * fq + jj) * SS_XROW + (16 * pt + fr) * 2));
    __syncthreads();
#pragma unroll
    for (int i = 0; i < 4; ++i) { const int q = tid + 256 * i; *(u32x4*)(smem + SS_R0 + (q >> 4) * SS_BROW + (q & 15) * 16) = pre[i]; }
#pragma unroll
    for (int i = 0; i < 4; ++i) { const int q = tid + 256 * i; pre[i] = *(const u32x4*)(sst + (((size_t)cg * 32 + h) * 2 + 1) * 8192 + (q >> 4) * 128 + (q & 15) * 8); }
    __syncthreads();
    f32x4 zf[4], zb[4];
#pragma unroll
    for (int pt = 0; pt < 4; ++pt) { zf[pt] = (f32x4){0.f, 0.f, 0.f, 0.f}; zb[pt] = (f32x4){0.f, 0.f, 0.f, 0.f}; }
#pragma unroll
    for (int ks = 0; ks < 4; ++ks)
#pragma unroll
      for (int pt = 0; pt < 4; ++pt) {
        const bf16x8 B = *(const bf16x8*)(smem + SS_R0 + (16 * pt + fr) * SS_BROW + (32 * ks + 8 * fq) * 2);
        zf[pt] = __builtin_amdgcn_mfma_f32_16x16x32_bf16(cfr[ks], B, zf[pt], 0, 0, 0);
      }
    __syncthreads();
#pragma unroll
    for (int i = 0; i < 4; ++i) { const int q = tid + 256 * i; *(u32x4*)(smem + SS_R0 + (q >> 4) * SS_BROW + (q & 15) * 16) = pre[i]; }
    __syncthreads();
#pragma unroll
    for (int ks = 0; ks < 4; ++ks)
#pragma unroll
      for (int pt = 0; pt < 4; ++pt) {
        const bf16x8 B = *(const bf16x8*)(smem + SS_R0 + (16 * pt + fr) * SS_BROW + (32 * ks + 8 * fq) * 2);
        zb[pt] = __builtin_amdgcn_mfma_f32_16x16x32_bf16(cfr[ks], B, zb[pt], 0, 0, 0);
      }
    const float dsk = p.ssd_d[l * 32 + h];
#pragma unroll
    for (int jj = 0; jj < 4; ++jj) {
      const int i2 = i0 + 4 * fq + jj;
      const float ef = __expf(csf[i2]), eb = __expf(csr[i2]);
#pragma unroll
      for (int pt = 0; pt < 4; ++pt) {
        const float z = bf2f(proj[(tb + i2) * NPROJ_PAD + C_Z + h * 64 + 16 * pt + fr]);
        float val = y[pt][jj] + ef * zf[pt][jj] + eb * zb[pt][jj] + dsk * xsk[pt][jj];
        val *= siluf_(z);
        ybuf[(tb + i2) * 2048 + h * 64 + 16 * pt + fr] = f2bf(val);
        ss[jj] += val * val;
      }
    }
    __syncthreads();
  }
#pragma unroll
  for (int jj = 0; jj < 4; ++jj) {
    float t = ss[jj];
    t += __shfl_xor(t, 1); t += __shfl_xor(t, 2); t += __shfl_xor(t, 4); t += __shfl_xor(t, 8);
    ss[jj] = rsqrtf(t * (1.f / 256.f) + 1e-6f);
  }
#pragma unroll
  for (int hh = 0; hh < 4; ++hh)
#pragma unroll
    for (int pt = 0; pt < 4; ++pt) {
      const int chn = (4 * g + hh) * 64 + 16 * pt + fr;
      const float nw = p.ssd_norm_w[l * 2048 + chn];
#pragma unroll
      for (int jj = 0; jj < 4; ++jj) {
        bf16_t* yp = ybuf + (tb + i0 + 4 * fq + jj) * 2048 + chn;
        *yp = f2bf(bf2f(*yp) * ss[jj] * nw);
      }
    }
}

__device__ __forceinline__ void phase_scan1(const Params& p, int l, char* smem) {
  const int bid = blockIdx.x;
  if (bid < 64) { hgrn_chunk_item(p, l, 32 * 16 + bid, smem); return; }
  if (bid >= 256 && bid < 320) return;
  const int wkr = bid < 256 ? bid - 64 : bid - 128;
  for (int it = wkr; it < 256 + 512 + 2048; it += 384) {
    if (it < 256) ssd_pass1_item(p, l, 32 * 64 + it, smem);
    else if (it < 768) hgrn_chunk_item(p, l, it - 256, smem);
    else ssd_pass1_item(p, l, it - 768, smem);
  }
}
__device__ __forceinline__ void phase_scan2(const Params& p, int l, char* smem) {
  for (int it = blockIdx.x; it < 2048; it += gridDim.x) ssd_pass2_item(p, l, it, smem);
}

__device__ __forceinline__ void phase_scan_naive(const Params& p, int l, char* smem) {
  const int n_ssd = 36 * 64, n_hg = 36 * 16;
  for (int it = blockIdx.x; it < n_ssd + n_hg; it += gridDim.x) {
    if (it < 256) ssd_naive_item(p, l, 32 * 64 + it, (float*)smem);
    else if (it < 320) hgrn_chunk_item(p, l, 32 * 16 + (it - 256), smem);
    else if (it < 320 + 2048) ssd_naive_item(p, l, it - 320, (float*)smem);
    else hgrn_chunk_item(p, l, it - 320 - 2048, smem);
  }
}

__device__ __forceinline__ void phase_post(const Params& p, int l) {
  const int tid = tid_opaque();
  const bf16_t* proj = (const bf16_t*)(p.ws + OFF_PROJ);
  const bf16_t* xc = (const bf16_t*)(p.ws + OFF_XC);
  const float* yf = (const float*)(p.ws + OFF_YF);
  const float* yb = (const float*)(p.ws + OFF_YB);
  const float* of = (const float*)(p.ws + OFF_OF);
  const float* ob = (const float*)(p.ws + OFF_OB);
  bf16_t* ybuf = (bf16_t*)(p.ws + OFF_YBUF);
  bf16_t* obuf = (bf16_t*)(p.ws + OFF_OBUF);
  for (int tok = blockIdx.x; tok < T; tok += gridDim.x) {
    {
      const int ch = tid * 4;
      const float* a = of + (size_t)tok * 1024 + ch;
      const float* b = ob + (size_t)tok * 1024 + ch;
      uint2 gv = *(const uint2*)(proj + (size_t)tok * NPROJ_PAD + C_HG + ch);
      const unsigned gw[2] = {gv.x, gv.y};
      float v[4];
      float ss = 0.f;
#pragma unroll
      for (int j = 0; j < 4; ++j) { v[j] = a[j] + b[j]; ss += v[j] * v[j]; }
#pragma unroll
      for (int o = 16; o >= 1; o >>= 1) ss += __shfl_xor(ss, o);
      const float rstd = rsqrtf(ss * (1.f / 128.f) + 1e-6f);
      const float* nw = p.hgrn_norm_w + l * 1024 + ch;
      float r[4];
#pragma unroll
      for (int j = 0; j < 4; ++j) {
        const float gz = bf2f((bf16_t)((j & 1) ? (gw[j >> 1] >> 16) : (gw[j >> 1] & 0xffff)));
        r[j] = v[j] * rstd * nw[j] * siluf_(gz);
      }
      uint2 o2; o2.x = pack2(r[0], r[1]); o2.y = pack2(r[2], r[3]);
      *(uint2*)(obuf + (size_t)tok * 1024 + ch) = o2;
    }
  }
}


#define XB_TMO 128
#define XB_XCNT(j) (256 + 64 * (j))
#define XB_XSUB(j) (1280 + 64 * (j))
#define XB_XGEN(j) (2304 + 64 * (j))
#define XB_TOP 3328
#define XB_TOPGEN 3392
#define XCD_BAR_WORDS 3456
#define XB_SPIN_CAP (1u << 22)
#define LAS __attribute__((address_space(3)))
__device__ __forceinline__ unsigned xb_ld(unsigned* p) { return __hip_atomic_load(p, __ATOMIC_RELAXED, __HIP_MEMORY_SCOPE_AGENT); }
__device__ __forceinline__ unsigned xb_add(unsigned* p, unsigned v) { return __hip_atomic_fetch_add(p, v, __ATOMIC_RELAXED, __HIP_MEMORY_SCOPE_AGENT); }
__device__ __forceinline__ unsigned xb_xcc_id() { return (unsigned)__builtin_amdgcn_s_getreg((3 << 11) | 20) & 0xFu; }
#define XB_SPIN(cond, bar)                                                                    \
  do {                                                                                        \
    unsigned _sp = 0;                                                                         \
    while (cond) {                                                                            \
      __builtin_amdgcn_s_sleep(1);                                                            \
      if ((++_sp & 255u) == 0u) {                                                             \
        if (xb_ld(&(bar)[XB_TMO])) break;                                                     \
        if (_sp > XB_SPIN_CAP) { atomicAdd(&(bar)[XB_TMO], 1u); break; }                      \
      }                                                                                       \
    }                                                                                         \
  } while (0)
struct XcdBarrier { unsigned* bar; unsigned x; volatile LAS unsigned* st; };
__device__ __forceinline__ XcdBarrier xcd_barrier_post(unsigned* bar, volatile LAS unsigned* st) {
  XcdBarrier b; b.bar = bar; b.x = xb_xcc_id(); b.st = st;
  if (threadIdx.x == 0) (void)xb_add(&bar[XB_XCNT(b.x)], 1u);
  return b;
}
__device__ __forceinline__ void xcd_barrier_complete(unsigned* bar, unsigned x, unsigned& nloc, unsigned& nx) {
  const unsigned G = gridDim.x * gridDim.y * gridDim.z;
  unsigned sum, cnt, mine, sp = 0u;
  for (;;) {
    sum = 0u; cnt = 0u; mine = 0u;
#pragma unroll
    for (unsigned j = 0; j < 16; ++j) { const unsigned c = xb_ld(&bar[XB_XCNT(j)]); sum += c; cnt += (c > 0u) ? 1u : 0u; mine = (j == x) ? c : mine; }
    if (sum == G) break;
    __builtin_amdgcn_s_sleep(1);
    if ((++sp & 255u) == 0u) { if (xb_ld(&bar[XB_TMO])) break; if (sp > XB_SPIN_CAP) { atomicAdd(&bar[XB_TMO], 1u); break; } }
  }
  nloc = mine > 0u ? mine : 1u; nx = cnt > 0u ? cnt : 1u;
}
__device__ __forceinline__ void xcd_barrier(const XcdBarrier& b) {
  asm volatile("s_waitcnt vmcnt(0)" ::: "memory");
  __syncthreads();
  if (threadIdx.x == 0) {
    unsigned* bar = b.bar;
    __builtin_amdgcn_s_waitcnt(0);
    unsigned nloc = b.st[0], nx = b.st[1];
    if (nloc == 0u) { xcd_barrier_complete(bar, b.x, nloc, nx); b.st[0] = nloc; b.st[1] = nx; }
    const unsigned old = xb_add(&bar[XB_XSUB(b.x)], 1u);
    const unsigned gen = old / nloc;
    if (old + 1u == (gen + 1u) * nloc) {
      __builtin_amdgcn_fence(__ATOMIC_RELEASE, "agent");
      asm volatile("s_waitcnt vmcnt(0)" ::: "memory");
      const unsigned og = xb_add(&bar[XB_TOP], 1u);
      const unsigned tg = og / nx;
      if (og + 1u == (tg + 1u) * nx) xb_add(&bar[XB_TOPGEN], 1u);
      else XB_SPIN(xb_ld(&bar[XB_TOPGEN]) == tg, bar);
      __builtin_amdgcn_fence(__ATOMIC_ACQUIRE, "agent");
      xb_add(&bar[XB_XGEN(b.x)], 1u);
      asm volatile("s_waitcnt vmcnt(0)" ::: "memory");
    } else {
      XB_SPIN(xb_ld(&bar[XB_XGEN(b.x)]) == gen, bar);
      __builtin_amdgcn_fence(__ATOMIC_ACQUIRE, "agent");
      asm volatile("s_waitcnt vmcnt(0)" ::: "memory");
    }
  }
  __syncthreads();
}

enum { PH_SETUP = 0, PH_NORM1, PH_PROJ, PH_CONV, PH_SCAN, PH_POST, PH_MERGE, PH_OUT, PH_NORM2, PH_FFN1, PH_FFN2, PH_FINAL };

__device__ __forceinline__ void run_phase(const Params& p, int ph, int l, char* smem) {
  switch (ph) {
    case PH_SETUP: phase_setup(p, smem); break;
    case PH_NORM1: phase_norm(p, l, 0); break;
    case PH_PROJ: phase_gemm<G_PROJ>(p, l, smem); break;
    case PH_CONV: phase_conv(p, l); break;
    case PH_SCAN: phase_scan_naive(p, l, smem); break;
    case PH_POST: phase_post(p, l); break;
    case PH_MERGE: phase_gemm<G_MERGE>(p, l, smem); break;
    case PH_OUT: phase_gemm<G_OUT>(p, l, smem); break;
    case PH_NORM2: phase_norm(p, l, 1); break;
    case PH_FFN1: phase_gemm<G_FFN1>(p, l, smem); break;
    case PH_FFN2: phase_gemm<G_FFN2>(p, l, smem); break;
    case PH_FINAL: phase_final_norm(p); break;
  }
}

extern __shared__ __attribute__((aligned(16))) char dyn_smem[];

#if !MEGA
__global__ void __launch_bounds__(256, 2) phase_kernel(Params p, int ph, int l) { run_phase(p, ph, l, dyn_smem); }
#endif

#if MEGA
__global__ void __launch_bounds__(256, 2) mega_kernel(Params p) {
  cg::grid_group grid = cg::this_grid();
  __shared__ uint4 xb_words;
  if (threadIdx.x == 0) xb_words = make_uint4(0u, 0u, 0u, 0u);
  __syncthreads();
  XcdBarrier xb = xcd_barrier_post((unsigned*)(p.ws + OFF_BAR), (volatile LAS unsigned*)&xb_words);
  phase_setup(p, dyn_smem);
  grid.sync();
  for (int l = 0; l < DEPTH; ++l) {
#pragma unroll 1
    for (int ph = 0; ph < 10; ++ph) {
      switch (ph) {
        case 0: phase_norm(p, l, 0); break;
        case 1: phase_gemm<G_PROJ>(p, l, dyn_smem); break;
        case 2: phase_conv(p, l); break;
        case 3: phase_scan1(p, l, dyn_smem); break;
        case 4: phase_scan2(p, l, dyn_smem); phase_post(p, l); break;
        case 5: phase_gemm<G_MERGE>(p, l, dyn_smem); break;
        case 6: phase_gemm<G_OUT>(p, l, dyn_smem); break;
        case 7: phase_norm(p, l, 1); break;
        case 8: phase_gemm<G_FFN1>(p, l, dyn_smem); break;
        default: phase_gemm<G_FFN2>(p, l, dyn_smem); break;
      }
      xcd_barrier(xb);
    }
  }
  phase_final_norm(p);
}
#endif

extern "C" void kernel_launch(void* const* d_in, const int* in_sizes, int n_in, void* d_out, int out_size, void* d_ws, size_t ws_size,
                              hipStream_t stream) {
  static int grid_blocks = 0;
  if (!grid_blocks) {
    int dev = 0, cus = 0, per_cu = 0;
    (void)hipGetDevice(&dev);
    (void)hipDeviceGetAttribute(&cus, hipDeviceAttributeMultiprocessorCount, dev);
#if MEGA
    (void)hipFuncSetAttribute((const void*)mega_kernel, hipFuncAttributeMaxDynamicSharedMemorySize, SMEM_BYTES);
#endif
#if !MEGA
    (void)hipFuncSetAttribute((const void*)phase_kernel, hipFuncAttributeMaxDynamicSharedMemorySize, SMEM_BYTES);
#endif
#if MEGA
    (void)hipOccupancyMaxActiveBlocksPerMultiprocessor(&per_cu, mega_kernel, 256, SMEM_BYTES);
#else
    (void)hipOccupancyMaxActiveBlocksPerMultiprocessor(&per_cu, phase_kernel, 256, SMEM_BYTES);
#endif
    per_cu = 2;
    grid_blocks = cus * per_cu;
  }
  Params p{};
  const float** pf = (const float**)&p;
  for (int i = 0; i < 26; ++i) pf[i] = (const float*)d_in[i];
  p.out = (float*)d_out;
  p.ws = (char*)d_ws;
#if MEGA
  (void)hipMemsetAsync((char*)d_ws + OFF_BAR, 0, XCD_BAR_WORDS * 4, stream);
  void* args[] = {&p};
  hipError_t e = hipLaunchCooperativeKernel((void*)mega_kernel, dim3(grid_blocks), dim3(256), args, SMEM_BYTES, stream);
  if (e != hipSuccess) fprintf(stderr, "coop launch failed: %s\n", hipGetErrorString(e));
#else
  const int G = grid_blocks;
  phase_kernel<<<G, 256, SMEM_BYTES, stream>>>(p, PH_SETUP, 0);
  for (int l = 0; l < DEPTH; ++l)
    for (int ph = PH_NORM1; ph <= PH_FFN2; ++ph) phase_kernel<<<G, 256, SMEM_BYTES, stream>>>(p, ph, l);
  phase_kernel<<<G, 256, SMEM_BYTES, stream>>>(p, PH_FINAL, 0);
#endif
}
```

```cpp
#include <hip/hip_runtime.h>
#include <hip/hip_cooperative_groups.h>
#include <cstdio>
#include <cstdint>
namespace cg = cooperative_groups;

#ifndef MEGA
#define MEGA 1
#endif

typedef unsigned short bf16_t;
typedef short bf16x8 __attribute__((ext_vector_type(8)));
typedef float f32x4 __attribute__((ext_vector_type(4)));
typedef unsigned u32x4 __attribute__((ext_vector_type(4)));
typedef short s16x4 __attribute__((ext_vector_type(4)));
typedef unsigned u32x2 __attribute__((ext_vector_type(2)));

constexpr int D = 1024, T = 16384, TCTX = 8192, DEPTH = 4;
constexpr int NPROJ = 13376, NPROJ_PAD = 13440;
constexpr int FFN = 2816;
constexpr int C_Z = 4096, C_DT = 6144, C_HQ = 6208, C_HF = 7232, C_HI = 9280, C_HG = 10304, C_GATE = 11328;
constexpr size_t WT_IN = 0;
constexpr size_t WT_SSO = WT_IN + (size_t)NPROJ_PAD * 1024;
constexpr size_t WT_HGO = WT_SSO + (size_t)1024 * 2048;
constexpr size_t WT_OUT = WT_HGO + (size_t)1024 * 1024;
constexpr size_t WT_W13 = WT_OUT + (size_t)1024 * 1024;
constexpr size_t WT_W2 = WT_W13 + (size_t)5632 * 1024;
constexpr size_t WT_LAYER = WT_W2 + (size_t)1024 * 2816;
constexpr size_t OFF_WT = 0;
constexpr size_t OFF_H = OFF_WT + WT_LAYER * 2 * DEPTH;
constexpr size_t OFF_PROJ = OFF_H + (size_t)T * 1024 * 2;
constexpr size_t OFF_XC = OFF_PROJ + (size_t)T * NPROJ_PAD * 2;
constexpr size_t OFF_DTRAW = OFF_XC + (size_t)T * 4096 * 2;
constexpr size_t OFF_DT = OFF_DTRAW + (size_t)T * 64 * 4;
constexpr size_t OFF_YF = OFF_DT + (size_t)T * 64 * 4;
constexpr size_t OFF_YB = OFF_YF + (size_t)T * 2048 * 4;
constexpr size_t OFF_OF = OFF_YB + (size_t)T * 2048 * 4;
constexpr size_t OFF_OB = OFF_OF + (size_t)T * 1024 * 4;
constexpr size_t OFF_YBUF = OFF_OB + (size_t)T * 1024 * 4;
constexpr size_t OFF_OBUF = OFF_YBUF + (size_t)T * 2048 * 2;
constexpr size_t OFF_MBUF = OFF_OBUF + (size_t)T * 1024 * 2;
constexpr size_t OFF_MOD = OFF_MBUF + (size_t)T * 1024 * 2;
constexpr size_t OFF_LB = OFF_MOD + (size_t)DEPTH * 5 * 6144 * 4;
constexpr size_t OFF_BAR = OFF_LB + (size_t)DEPTH * 2 * 1024 * 4;
constexpr size_t OFF_END = OFF_BAR + 16384;
constexpr size_t OUT_SSM = (size_t)T * 1024;
constexpr size_t OUT_HGRN = OUT_SSM + (size_t)32 * 4 * 2 * 32 * 64 * 128;

constexpr int SMEM_BYTES = 73728;
constexpr int LDS_ROW = 128;
constexpr int LDS_TILE = 128 * LDS_ROW;

struct Params {
  const float *x_prompt, *x_sample, *c, *state_ssm, *state_hgrn, *c_ctx, *norm_mix_w, *norm_ffn_w, *ada_w, *ada_b, *w_in,
      *ssd_conv_w, *ssd_conv_b, *ssd_dt_bias, *ssd_a_log, *ssd_d, *ssd_norm_w, *hgrn_lb, *hgrn_norm_w, *w_ssd_out, *w_hgrn_out,
      *w_out, *ffn_w1, *ffn_w3, *ffn_w2, *norm_final_w;
  float* out;
  char* ws;
};

__device__ __forceinline__ bf16_t f2bf(float f) {
  unsigned u = __float_as_uint(f);
  u += 0x7fffu + ((u >> 16) & 1u);
  return (bf16_t)(u >> 16);
}
__device__ __forceinline__ float bf2f(bf16_t b) { return __uint_as_float(((unsigned)b) << 16); }
typedef __bf16 bf16x2_t __attribute__((ext_vector_type(2)));
__device__ __forceinline__ unsigned pack2(float a, float b) { bf16x2_t v = {(__bf16)a, (__bf16)b}; return __builtin_bit_cast(unsigned, v); }
__device__ __forceinline__ float sigmoidf_(float x) { return __builtin_amdgcn_rcpf(1.0f + __expf(-x)); }
__device__ __forceinline__ float siluf_(float x) { return x * __builtin_amdgcn_rcpf(1.0f + __expf(-x)); }
__device__ __forceinline__ int tid_opaque() { int t = threadIdx.x; asm volatile("" : "+v"(t)); return t; }
__device__ __forceinline__ float clamp30(float x) { return fminf(fmaxf(x, -30.f), 30.f); }
__device__ __forceinline__ float gate_ratio(float g1, float g2) { return (1.0f + __expf(-clamp30(g2))) * __builtin_amdgcn_rcpf(1.0f + __expf(-clamp30(g1))); }
__device__ __forceinline__ int mod_row(int tok) { return tok < TCTX ? 0 : 1 + ((tok - TCTX) >> 11); }

__device__ __forceinline__ void phase_setup(const Params& p, char* smem) {
  const int tid = tid_opaque(), bid = blockIdx.x, G = gridDim.x;
  {
    const size_t n4 = (size_t)T * 1024 / 4, half4 = (size_t)TCTX * 1024 / 4;
    float4* dst = (float4*)p.out;
    const float4* s0 = (const float4*)p.x_prompt;
    const float4* s1 = (const float4*)p.x_sample;
    for (size_t i = (size_t)bid * 256 + tid; i < n4; i += (size_t)G * 256) dst[i] = i < half4 ? s0[i] : s1[i - half4];
  }
  {
    float* lb = (float*)(p.ws + OFF_LB);
    for (int i = bid * 256 + tid; i < 2048; i += G * 256) {
      float v0 = p.hgrn_lb[i], v1 = p.hgrn_lb[2048 + i], v2 = p.hgrn_lb[4096 + i], v3 = p.hgrn_lb[6144 + i];
      float m = fmaxf(fmaxf(v0, v1), fmaxf(v2, v3));
      float e0 = expf(v0 - m), e1 = expf(v1 - m), e2 = expf(v2 - m), e3 = expf(v3 - m);
      float inv = 1.0f / (e0 + e1 + e2 + e3);
      lb[i] = 0.f;
      lb[2048 + i] = e1 * inv;
      lb[4096 + i] = (e1 + e2) * inv;
      lb[6144 + i] = (e1 + e2 + e3) * inv;
    }
  }
  {
    float* sm = (float*)smem;
    float* modb = (float*)(p.ws + OFF_MOD);
    __syncthreads();
    for (int i = tid; i < 5 * 1024; i += 256) {
      int v = i >> 10, k = i & 1023;
      float cv = v == 0 ? p.c_ctx[k] : p.c[(v - 1) * 1024 + k];
      sm[i] = siluf_(cv);
    }
    __syncthreads();
    float* part = sm + 5 * 1024;
    for (int item = bid; item < DEPTH * 96; item += G) {
      int l = item / 96, cg_ = item % 96;
      int col = cg_ * 64 + (tid & 63), kg = tid >> 6;
      const float* w = p.ada_w + (size_t)l * 1024 * 6144 + col;
      float a0 = 0, a1 = 0, a2 = 0, a3 = 0, a4 = 0;
      for (int k = kg * 256; k < kg * 256 + 256; ++k) {
        float wv = w[(size_t)k * 6144];
        a0 += sm[k] * wv; a1 += sm[1024 + k] * wv; a2 += sm[2048 + k] * wv; a3 += sm[3072 + k] * wv; a4 += sm[4096 + k] * wv;
      }
      __syncthreads();
      part[(kg * 5 + 0) * 64 + (tid & 63)] = a0; part[(kg * 5 + 1) * 64 + (tid & 63)] = a1; part[(kg * 5 + 2) * 64 + (tid & 63)] = a2;
      part[(kg * 5 + 3) * 64 + (tid & 63)] = a3; part[(kg * 5 + 4) * 64 + (tid & 63)] = a4;
      __syncthreads();
      for (int i = tid; i < 320; i += 256) {
        int v = i >> 6, cc = i & 63;
        float s = part[(0 * 5 + v) * 64 + cc] + part[(1 * 5 + v) * 64 + cc] + part[(2 * 5 + v) * 64 + cc] + part[(3 * 5 + v) * 64 + cc];
        int colo = cg_ * 64 + cc;
        modb[((size_t)l * 5 + v) * 6144 + colo] = s + p.ada_b[l * 6144 + colo];
      }
    }
    __syncthreads();
  }
  {
    float* tile = (float*)smem;
    const int n_in = 210 * 16, n_sso = 16 * 32, n_hgo = 16 * 16, n_out = 16 * 16, n_w13 = 88 * 16, n_w2 = 16 * 44;
    const int per_layer = n_in + n_sso + n_hgo + n_out + n_w13 + n_w2;
    for (int it = bid; it < per_layer * DEPTH; it += G) {
      int l = it / per_layer, r = it % per_layer;
      bf16_t* wt = (bf16_t*)(p.ws + OFF_WT) + (size_t)l * WT_LAYER;
      const float *src0 = nullptr, *src1 = nullptr;
      int K, Nsrc, nt, kt;
      bf16_t* dst;
      bool zero = false;
      if (r < n_in) {
        nt = r / 16; kt = r % 16; K = 1024; Nsrc = NPROJ;
        dst = wt + WT_IN;
        if (nt >= 209) zero = true;
        src0 = p.w_in + (size_t)l * 1024 * NPROJ + nt * 64; src1 = src0 + 32;
      } else if ((r -= n_in) < n_sso) {
        nt = r / 32; kt = r % 32; K = 2048; Nsrc = 1024; dst = wt + WT_SSO;
        src0 = p.w_ssd_out + (size_t)l * 2048 * 1024 + nt * 64; src1 = src0 + 32;
      } else if ((r -= n_sso) < n_hgo) {
        nt = r / 16; kt = r % 16; K = 1024; Nsrc = 1024; dst = wt + WT_HGO;
        src0 = p.w_hgrn_out + (size_t)l * 1024 * 1024 + nt * 64; src1 = src0 + 32;
      } else if ((r -= n_hgo) < n_out) {
        nt = r / 16; kt = r % 16; K = 1024; Nsrc = 1024; dst = wt + WT_OUT;
        src0 = p.w_out + (size_t)l * 1024 * 1024 + nt * 64; src1 = src0 + 32;
      } else if ((r -= n_out) < n_w13) {
        nt = r / 16; kt = r % 16; K = 1024; Nsrc = FFN; dst = wt + WT_W13;
        src0 = p.ffn_w1 + (size_t)l * 1024 * FFN + nt * 32; src1 = p.ffn_w3 + (size_t)l * 1024 * FFN + nt * 32;
      } else {
        r -= n_w13;
        nt = r / 44; kt = r % 44; K = 2816; Nsrc = 1024; dst = wt + WT_W2;
        src0 = p.ffn_w2 + (size_t)l * 2816 * 1024 + nt * 64; src1 = src0 + 32;
      }
      __syncthreads();
      {
        int c4 = (tid & 15) * 4;
        const float* s = c4 < 32 ? src0 + c4 : src1 + (c4 - 32);
#pragma unroll
        for (int i = 0; i < 4; ++i) {
          int kr = (tid >> 4) + i * 16;
          float4 v = zero ? make_float4(0.f, 0.f, 0.f, 0.f) : *(const float4*)(s + (size_t)(kt * 64 + kr) * Nsrc);
          tile[kr * 65 + c4 + 0] = v.x; tile[kr * 65 + c4 + 1] = v.y; tile[kr * 65 + c4 + 2] = v.z; tile[kr * 65 + c4 + 3] = v.w;
        }
      }
      __syncthreads();
#pragma unroll
      for (int i = 0; i < 2; ++i) {
        int cidx = tid + i * 256, n = cidx >> 3, kc = cidx & 7;
        uint4 o;
        o.x = pack2(tile[(kc * 8 + 0) * 65 + n], tile[(kc * 8 + 1) * 65 + n]);
        o.y = pack2(tile[(kc * 8 + 2) * 65 + n], tile[(kc * 8 + 3) * 65 + n]);
        o.z = pack2(tile[(kc * 8 + 4) * 65 + n], tile[(kc * 8 + 5) * 65 + n]);
        o.w = pack2(tile[(kc * 8 + 6) * 65 + n], tile[(kc * 8 + 7) * 65 + n]);
        *(uint4*)(dst + (size_t)(nt * 64 + n) * K + kt * 64 + kc * 8) = o;
      }
    }
    __syncthreads();
  }
}

__device__ __forceinline__ void phase_norm(const Params& p, int l, int which) {
  const int lane = tid_opaque() & 63, wv = tid_opaque() >> 6;
  const float* nw = (which == 0 ? p.norm_mix_w : p.norm_ffn_w) + l * 1024;
  const float* modb = (const float*)(p.ws + OFF_MOD) + (size_t)l * 5 * 6144;
  bf16_t* h = (bf16_t*)(p.ws + OFF_H);
  for (int row = blockIdx.x * 4 + wv; row < T; row += gridDim.x * 4) {
    const float* x = p.out + (size_t)row * 1024;
    const float* md = modb + (size_t)mod_row(row) * 6144 + (which == 0 ? 0 : 3072);
    float4 v[4];
    float ss = 0.f;
#pragma unroll
    for (int i = 0; i < 4; ++i) {
      v[i] = *(const float4*)(x + i * 256 + lane * 4);
      ss += v[i].x * v[i].x + v[i].y * v[i].y + v[i].z * v[i].z + v[i].w * v[i].w;
    }
#pragma unroll
    for (int o = 32; o >= 1; o >>= 1) ss += __shfl_xor(ss, o);
    float rstd = rsqrtf(ss * (1.0f / 1024.f) + 1e-6f);
#pragma unroll
    for (int i = 0; i < 4; ++i) {
      int c = i * 256 + lane * 4;
      float4 w = *(const float4*)(nw + c), sh = *(const float4*)(md + c), sc = *(const float4*)(md + 1024 + c);
      float a0 = v[i].x * rstd * w.x * (1.f + sc.x) + sh.x, a1 = v[i].y * rstd * w.y * (1.f + sc.y) + sh.y;
      float a2 = v[i].z * rstd * w.z * (1.f + sc.z) + sh.z, a3 = v[i].w * rstd * w.w * (1.f + sc.w) + sh.w;
      uint2 o2; o2.x = pack2(a0, a1); o2.y = pack2(a2, a3);
      *(uint2*)(h + (size_t)row * 1024 + c) = o2;
    }
  }
}

__device__ __forceinline__ void phase_final_norm(const Params& p) {
  const int lane = tid_opaque() & 63, wv = tid_opaque() >> 6;
  for (int row = blockIdx.x * 4 + wv; row < T; row += gridDim.x * 4) {
    float* x = p.out + (size_t)row * 1024;
    float4 v[4];
    float ss = 0.f;
#pragma unroll
    for (int i = 0; i < 4; ++i) {
      v[i] = *(const float4*)(x + i * 256 + lane * 4);
      ss += v[i].x * v[i].x + v[i].y * v[i].y + v[i].z * v[i].z + v[i].w * v[i].w;
    }
#pragma unroll
    for (int o = 32; o >= 1; o >>= 1) ss += __shfl_xor(ss, o);
    float rstd = rsqrtf(ss * (1.0f / 1024.f) + 1e-6f);
#pragma unroll
    for (int i = 0; i < 4; ++i) {
      int c = i * 256 + lane * 4;
      float4 w = *(const float4*)(p.norm_final_w + c);
      float4 o4 = make_float4(v[i].x * rstd * w.x, v[i].y * rstd * w.y, v[i].z * rstd * w.z, v[i].w * rstd * w.w);
      *(float4*)(x + c) = o4;
    }
  }
}

template <bool HASMID>
__device__ __forceinline__ void gemm_kloop2(f32x4 (&acc)[4][4], const bf16_t* __restrict__ Ag, int lda, const bf16_t* __restrict__ Bg,
                                            int ldb, int K, const bf16_t* __restrict__ Ag2, int lda2, const bf16_t* __restrict__ Bg2,
                                            int ldb2, int K2, char* smem, const bf16_t* __restrict__ gate0) {
  const int tid = tid_opaque(), lane = tid & 63, wid = tid >> 6;
  const int wr = wid >> 1, wc = wid & 1, fr = lane & 15, fq = lane >> 4;
  const int srow = tid >> 3, schunk = (tid & 7) ^ ((tid >> 4) & 7);
  const int rofs0 = (fq ^ ((fr >> 1) & 7)) * 16;
  const bf16_t* ap = Ag + (size_t)srow * lda + schunk * 8;
  const bf16_t* bp = Bg + (size_t)srow * ldb + schunk * 8;
  const int nk1 = K >> 6;
  const int nk = nk1 + (K2 >> 6);
  char* const sdst = smem + tid * 16;
#define GK_DMA(buf, t)                                                                                                   \
  {                                                                                                                      \
    _Pragma("unroll") for (int i = 0; i < 4; ++i) {                                                                      \
      __builtin_amdgcn_global_load_lds((const unsigned*)(ap + (size_t)i * 32 * lda + (size_t)(t) * 64),                  \
                                       (unsigned*)(sdst + (buf) * LDS_TILE + i * 4096), 16, 0, 0);                       \
      __builtin_amdgcn_global_load_lds((const unsigned*)(bp + (size_t)i * 32 * ldb + (size_t)(t) * 64),                  \
                                       (unsigned*)(sdst + (2 + (buf)) * LDS_TILE + i * 4096), 16, 0, 0);                 \
    }                                                                                                                    \
  }
  GK_DMA(0, 0);
  __syncthreads();
  for (int kt = 0; kt < nk; ++kt) {
    const int cur = kt & 1;
    if (kt + 1 < nk) {
      if (kt + 1 == nk1) {
        ap = Ag2 + (size_t)srow * lda2 + schunk * 8 - (size_t)nk1 * 64;
        bp = Bg2 + (size_t)srow * ldb2 + schunk * 8 - (size_t)nk1 * 64;
        lda = lda2; ldb = ldb2;
      }
      GK_DMA(cur ^ 1, kt + 1);
    }
    if (HASMID && kt == nk1) {
#pragma unroll
      for (int m = 0; m < 4; ++m)
#pragma unroll
        for (int n = 0; n < 4; ++n) {
          uint2 g1 = *(const uint2*)(gate0 + (size_t)(m * 16) * NPROJ_PAD + n * 16);
          uint2 g2 = *(const uint2*)(gate0 + (size_t)(m * 16) * NPROJ_PAD + 1024 + n * 16);
          acc[m][n][0] *= gate_ratio(bf2f((bf16_t)(g1.x & 0xffff)), bf2f((bf16_t)(g2.x & 0xffff)));
          acc[m][n][1] *= gate_ratio(bf2f((bf16_t)(g1.x >> 16)), bf2f((bf16_t)(g2.x >> 16)));
          acc[m][n][2] *= gate_ratio(bf2f((bf16_t)(g1.y & 0xffff)), bf2f((bf16_t)(g2.y & 0xffff)));
          acc[m][n][3] *= gate_ratio(bf2f((bf16_t)(g1.y >> 16)), bf2f((bf16_t)(g2.y >> 16)));
        }
    }
    const char* sa = smem + cur * LDS_TILE + (wr * 64 + fr) * LDS_ROW;
    const char* sb = smem + (2 + cur) * LDS_TILE + (wc * 64 + fr) * LDS_ROW;
#pragma unroll
    for (int kk = 0; kk < 2; ++kk) {
      bf16x8 af[4], bfv[4];
      __builtin_amdgcn_sched_barrier(0);
#pragma unroll
      for (int m = 0; m < 4; ++m) af[m] = *(const bf16x8*)(sa + m * 16 * LDS_ROW + (rofs0 ^ (kk * 64)));
#pragma unroll
      for (int n = 0; n < 4; ++n) bfv[n] = *(const bf16x8*)(sb + n * 16 * LDS_ROW + (rofs0 ^ (kk * 64)));
      __builtin_amdgcn_sched_barrier(0);
#pragma unroll
      for (int m = 0; m < 4; ++m)
#pragma unroll
        for (int n = 0; n < 4; ++n) acc[m][n] = __builtin_amdgcn_mfma_f32_16x16x32_bf16(bfv[n], af[m], acc[m][n], 0, 0, 0);
    }
    __builtin_amdgcn_sched_barrier(0);
    __syncthreads();
  }
#undef GK_DMA
}

__device__ __forceinline__ void gemm_kloop(f32x4 (&acc)[4][4], const bf16_t* __restrict__ Ag, int lda, const bf16_t* __restrict__ Bg,
                                           int ldb, int K, char* smem) {
  gemm_kloop2<false>(acc, Ag, lda, Bg, ldb, K, Ag, lda, Bg, ldb, 0, smem, Ag);
}

constexpr int BG_STAGE = 24576;
__device__ __forceinline__ int swz4(int x) { return (0x78 >> (2 * x)) & 3; }
template <bool HASMID>
__device__ __forceinline__ void gemm_kloop_big(f32x4 (&acc)[8][4], const bf16_t* __restrict__ Ag, int lda, const bf16_t* __restrict__ Bg,
                                               int ldb, int K, const bf16_t* __restrict__ Ag2, int lda2,
                                               const bf16_t* __restrict__ Bg2, int ldb2, int K2, char* smem,
                                               const bf16_t* __restrict__ gate0) {
  const int tid = tid_opaque(), lane = tid & 63, wid = tid >> 6;
  const int wr = wid >> 1, wc = wid & 1, fr = lane & 15, fq = lane >> 4;
  const int srow = tid >> 2, schunk = (tid & 3) ^ swz4((tid >> 4) & 3);
  const int rofs = (fq ^ swz4((fr >> 2) & 3)) * 16;
  const int nks1 = K >> 5;
  const int nks = nks1 + (K2 >> 5);
  const bf16_t* ap1 = Ag + (size_t)srow * lda + schunk * 8;
  const bf16_t* bp1 = Bg + (size_t)srow * ldb + schunk * 8;
  const bf16_t* ap2 = Ag2 + (size_t)srow * lda2 + schunk * 8 - (size_t)nks1 * 32;
  const bf16_t* bp2 = Bg2 + (size_t)srow * ldb2 + schunk * 8 - (size_t)nks1 * 32;
  char* const sdst = smem + tid * 16;
#define BG_DMA(slot, kk_)                                                                                                  \
  {                                                                                                                        \
    const int t_ = (kk_) < nks ? (kk_) : nks - 1;                                                                          \
    const bool s2_ = t_ >= nks1;                                                                                           \
    const bf16_t* ap_ = (s2_ ? ap2 : ap1) + (size_t)t_ * 32;                                                               \
    const bf16_t* bp_ = (s2_ ? bp2 : bp1) + (size_t)t_ * 32;                                                               \
    const size_t la_ = (size_t)64 * (s2_ ? lda2 : lda), lb_ = (size_t)64 * (s2_ ? ldb2 : ldb);                             \
    _Pragma("unroll") for (int i = 0; i < 4; ++i)                                                                          \
        __builtin_amdgcn_global_load_lds((const unsigned*)(ap_ + i * la_), (unsigned*)(sdst + (slot) * BG_STAGE + i * 4096), 16, 0, 0); \
    _Pragma("unroll") for (int i = 0; i < 2; ++i)                                                                          \
        __builtin_amdgcn_global_load_lds((const unsigned*)(bp_ + i * lb_), (unsigned*)(sdst + (slot) * BG_STAGE + 16384 + i * 4096), 16, 0, 0); \
  }
  BG_DMA(0, 0);
  BG_DMA(1, 1);
  int slot = 0;
  for (int ks = 0; ks < nks; ++ks) {
    asm volatile("s_waitcnt vmcnt(6)" ::: "memory");
    __builtin_amdgcn_s_barrier();
    asm volatile("" ::: "memory");
    const int nslot = slot == 0 ? 2 : slot - 1;
    BG_DMA(nslot, ks + 2);
    if (HASMID && ks == nks1) {
      int zofs = 0;
      asm volatile("" : "+v"(zofs));
      const bf16_t* gz = gate0 + zofs;
#pragma unroll
      for (int m = 0; m < 8; ++m)
#pragma unroll
        for (int n = 0; n < 4; ++n) {
          uint2 g1 = *(const uint2*)(gz + (size_t)(m * 16) * NPROJ_PAD + n * 16);
          uint2 g2 = *(const uint2*)(gz + (size_t)(m * 16) * NPROJ_PAD + 1024 + n * 16);
          acc[m][n][0] *= gate_ratio(bf2f((bf16_t)(g1.x & 0xffff)), bf2f((bf16_t)(g2.x & 0xffff)));
          acc[m][n][1] *= gate_ratio(bf2f((bf16_t)(g1.x >> 16)), bf2f((bf16_t)(g2.x >> 16)));
          acc[m][n][2] *= gate_ratio(bf2f((bf16_t)(g1.y & 0xffff)), bf2f((bf16_t)(g2.y & 0xffff)));
          acc[m][n][3] *= gate_ratio(bf2f((bf16_t)(g1.y >> 16)), bf2f((bf16_t)(g2.y >> 16)));
        }
    }
    const char* sa = smem + slot * BG_STAGE + (wr * 128 + fr) * 64 + rofs;
    const char* sb = smem + slot * BG_STAGE + 16384 + (wc * 64 + fr) * 64 + rofs;
    bf16x8 af[8], bfv[4];
    __builtin_amdgcn_sched_barrier(0);
#pragma unroll
    for (int n = 0; n < 4; ++n) bfv[n] = *(const bf16x8*)(sb + n * 16 * 64);
#pragma unroll
    for (int m = 0; m < 8; ++m) af[m] = *(const bf16x8*)(sa + m * 16 * 64);
    __builtin_amdgcn_sched_barrier(0);
    __builtin_amdgcn_s_setprio(1);
#pragma unroll
    for (int m = 0; m < 8; ++m)
#pragma unroll
      for (int n = 0; n < 4; ++n) acc[m][n] = __builtin_amdgcn_mfma_f32_16x16x32_bf16(bfv[n], af[m], acc[m][n], 0, 0, 0);
    __builtin_amdgcn_s_setprio(0);
    __builtin_amdgcn_sched_barrier(0);
    slot = slot == 2 ? 0 : slot + 1;
  }
  asm volatile("s_waitcnt vmcnt(0)" ::: "memory");
  __builtin_amdgcn_s_barrier();
  asm volatile("" ::: "memory");
#undef BG_DMA
}
__device__ __forceinline__ void gemm_kloop_big1(f32x4 (&acc)[8][4], const bf16_t* __restrict__ Ag, int lda, const bf16_t* __restrict__ Bg,
                                                int ldb, int K, char* smem) {
  gemm_kloop_big<false>(acc, Ag, lda, Bg, ldb, K, Ag, lda, Bg, ldb, 0, smem, Ag);
}
enum { G_PROJ = 0, G_MERGE = 1, G_OUT = 2, G_FFN1 = 3, G_FFN2 = 4 };

template <int MODE>
__device__ __forceinline__ void phase_gemm(const Params& p, int l, char* smem) {
  const int tid = tid_opaque(), lane = tid & 63, wid = tid >> 6;
  const int wr = wid >> 1, wc = wid & 1, fr = lane & 15, fq = lane >> 4;
  const bf16_t* wt = (const bf16_t*)(p.ws + OFF_WT) + (size_t)l * WT_LAYER;
  const bf16_t* hbuf = (const bf16_t*)(p.ws + OFF_H);
  bf16_t* proj = (bf16_t*)(p.ws + OFF_PROJ);
  bf16_t* hidden = (bf16_t*)(p.ws + OFF_PROJ);
  const float* modb = (const float*)(p.ws + OFF_MOD) + (size_t)l * 5 * 6144;
  constexpr int nM = T / 256;
  constexpr int nN = MODE == G_PROJ ? NPROJ_PAD / 128 : (MODE == G_FFN1 ? 5632 / 128 : 1024 / 128);
  for (int t = blockIdx.x; t < nM * nN; t += gridDim.x) {
    const int pm = t % nM, pn = t / nM;
    const int row0 = pm * 256, col0 = pn * 128;
    f32x4 acc[8][4];
#pragma unroll
    for (int m = 0; m < 8; ++m)
#pragma unroll
      for (int n = 0; n < 4; ++n) acc[m][n] = (f32x4){0.f, 0.f, 0.f, 0.f};
    if (MODE == G_PROJ) {
      gemm_kloop_big1(acc, hbuf + (size_t)row0 * 1024, 1024, wt + WT_IN + (size_t)col0 * 1024, 1024, 1024, smem);
      float* dtraw = (float*)(p.ws + OFF_DTRAW);
      char* stg = smem + wid * 18432;
#pragma unroll
      for (int m = 0; m < 8; ++m) {
        const int row = row0 + wr * 128 + m * 16 + fr;
#pragma unroll
        for (int n = 0; n < 4; ++n) {
          const int col = col0 + wc * 64 + n * 16 + fq * 4;
          u32x2 o; o[0] = pack2(acc[m][n][0], acc[m][n][1]); o[1] = pack2(acc[m][n][2], acc[m][n][3]);
          *(u32x2*)(stg + (m * 16 + fr) * 144 + (n * 16 + fq * 4) * 2) = o;
          if (col >= C_DT && col < C_DT + 64) *(f32x4*)(dtraw + (size_t)row * 64 + (col - C_DT)) = acc[m][n];
        }
      }
      {
        bf16_t* dst = proj + (size_t)(row0 + wr * 128 + (lane >> 3)) * NPROJ_PAD + col0 + wc * 64 + (lane & 7) * 8;
        const char* src = stg + (lane >> 3) * 144 + (lane & 7) * 16;
#pragma unroll
        for (int i = 0; i < 16; ++i) *(u32x4*)(dst + (size_t)(8 * i) * NPROJ_PAD) = *(const u32x4*)(src + 8 * i * 144);
      }
      asm volatile("s_waitcnt lgkmcnt(0)" ::: "memory");
      __builtin_amdgcn_s_barrier();
      asm volatile("" ::: "memory");
    } else if (MODE == G_MERGE) {
      const bf16_t* ybuf = (const bf16_t*)(p.ws + OFF_YBUF);
      const bf16_t* obuf = (const bf16_t*)(p.ws + OFF_OBUF);
      bf16_t* mbuf = (bf16_t*)(p.ws + OFF_MBUF);
      gemm_kloop_big<true>(acc, ybuf + (size_t)row0 * 2048, 2048, wt + WT_SSO + (size_t)col0 * 2048, 2048, 2048,
                        obuf + (size_t)row0 * 1024, 1024, wt + WT_HGO + (size_t)col0 * 1024, 1024, 1024, smem,
                        proj + (size_t)(row0 + wr * 128 + fr) * NPROJ_PAD + C_GATE + col0 + wc * 64 + fq * 4);
      char* stg = smem + wid * 18432;
#pragma unroll
      for (int m = 0; m < 8; ++m) {
        const int row = row0 + wr * 128 + m * 16 + fr;
#pragma unroll
        for (int n = 0; n < 4; ++n) {
          const int col = col0 + wc * 64 + n * 16 + fq * 4;
          uint2 g = *(const uint2*)(proj + (size_t)row * NPROJ_PAD + C_GATE + 1024 + col);
          float r0 = acc[m][n][0] * sigmoidf_(clamp30(bf2f((bf16_t)(g.x & 0xffff))));
          float r1 = acc[m][n][1] * sigmoidf_(clamp30(bf2f((bf16_t)(g.x >> 16))));
          float r2 = acc[m][n][2] * sigmoidf_(clamp30(bf2f((bf16_t)(g.y & 0xffff))));
          float r3 = acc[m][n][3] * sigmoidf_(clamp30(bf2f((bf16_t)(g.y >> 16))));
          u32x2 o; o[0] = pack2(r0, r1); o[1] = pack2(r2, r3);
          *(u32x2*)(stg + (m * 16 + fr) * 144 + (n * 16 + fq * 4) * 2) = o;
        }
      }
      {
        bf16_t* dst = mbuf + (size_t)(row0 + wr * 128 + (lane >> 3)) * 1024 + col0 + wc * 64 + (lane & 7) * 8;
        const char* src = stg + (lane >> 3) * 144 + (lane & 7) * 16;
#pragma unroll
        for (int i = 0; i < 16; ++i) *(u32x4*)(dst + (size_t)(8 * i) * 1024) = *(const u32x4*)(src + 8 * i * 144);
      }
      asm volatile("s_waitcnt lgkmcnt(0)" ::: "memory");
      __builtin_amdgcn_s_barrier();
      asm volatile("" ::: "memory");
    } else if (MODE == G_OUT || MODE == G_FFN2) {
      if (MODE == G_OUT) {
        const bf16_t* mbuf = (const bf16_t*)(p.ws + OFF_MBUF);
        gemm_kloop_big1(acc, mbuf + (size_t)row0 * 1024, 1024, wt + WT_OUT + (size_t)col0 * 1024, 1024, 1024, smem);
      } else {
        gemm_kloop_big1(acc, hidden + (size_t)row0 * FFN, FFN, wt + WT_W2 + (size_t)col0 * FFN, FFN, FFN, smem);
      }
      const float* gate = modb + (size_t)mod_row(row0) * 6144 + (MODE == G_OUT ? 2048 : 5120);
#pragma unroll
      for (int m = 0; m < 8; ++m) {
        const int row = row0 + wr * 128 + m * 16 + fr;
#pragma unroll
        for (int n = 0; n < 4; ++n) {
          const int col = col0 + wc * 64 + n * 16 + fq * 4;
          f32x4 g = *(const f32x4*)(gate + col);
          f32x4* xp = (f32x4*)(p.out + (size_t)row * 1024 + col);
          f32x4 xv = *xp;
          xv += g * acc[m][n];
          *xp = xv;
        }
      }
    } else {
      gemm_kloop_big1(acc, hbuf + (size_t)row0 * 1024, 1024, wt + WT_W13 + (size_t)col0 * 1024, 1024, 1024, smem);
      char* stg = smem + wid * 18432;
#pragma unroll
      for (int m = 0; m < 8; ++m) {
#pragma unroll
        for (int n = 0; n < 2; ++n) {
          float r[4];
#pragma unroll
          for (int j = 0; j < 4; ++j) r[j] = siluf_(acc[m][n][j]) * acc[m][n + 2][j];
          u32x2 o; o[0] = pack2(r[0], r[1]); o[1] = pack2(r[2], r[3]);
          *(u32x2*)(stg + (m * 16 + fr) * 80 + (n * 16 + fq * 4) * 2) = o;
        }
      }
      {
        bf16_t* dst = hidden + (size_t)(row0 + wr * 128 + (lane >> 2)) * FFN + (pn * 2 + wc) * 32 + (lane & 3) * 8;
        const char* src = stg + (lane >> 2) * 80 + (lane & 3) * 16;
#pragma unroll
        for (int i = 0; i < 8; ++i) *(u32x4*)(dst + (size_t)(16 * i) * FFN) = *(const u32x4*)(src + 16 * i * 80);
      }
      asm volatile("s_waitcnt lgkmcnt(0)" ::: "memory");
      __builtin_amdgcn_s_barrier();
      asm volatile("" ::: "memory");
    }
  }
}

__device__ __forceinline__ void phase_conv(const Params& p, int l) {
  const bf16_t* proj = (const bf16_t*)(p.ws + OFF_PROJ);
  bf16_t* xc = (bf16_t*)(p.ws + OFF_XC);
  const float* cw = p.ssd_conv_w + (size_t)l * 5 * 4096;
  const float* cb = p.ssd_conv_b + (size_t)l * 4096;
  for (int unit = blockIdx.x * 256 + tid_opaque(); unit < 512 * 256; unit += gridDim.x * 256) {
    const int ch = (unit & 511) * 8, sg = unit >> 9;
    const int t0 = sg * 64;
    int lo, hi;
    if (t0 < TCTX) { lo = t0 & ~255; hi = lo + 256; } else { lo = t0; hi = t0 + 64; }
    float w[5][8], bias[8];
#pragma unroll
    for (int k = 0; k < 5; ++k) {
      const f32x4 a = *(const f32x4*)(cw + k * 4096 + ch), b = *(const f32x4*)(cw + k * 4096 + ch + 4);
      w[k][0] = a[0]; w[k][1] = a[1]; w[k][2] = a[2]; w[k][3] = a[3]; w[k][4] = b[0]; w[k][5] = b[1]; w[k][6] = b[2]; w[k][7] = b[3];
    }
    {
      const f32x4 a = *(const f32x4*)(cb + ch), b = *(const f32x4*)(cb + ch + 4);
      bias[0] = a[0]; bias[1] = a[1]; bias[2] = a[2]; bias[3] = a[3]; bias[4] = b[0]; bias[5] = b[1]; bias[6] = b[2]; bias[7] = b[3];
    }
    const u32x4 zero4 = (u32x4){0u, 0u, 0u, 0u};
    u32x4 r0, r1, r2, r3, r4;
#define CV_LD(tt) (((tt) >= lo && (tt) < hi) ? *(const u32x4*)(proj + (size_t)(tt) * NPROJ_PAD + ch) : zero4)
    r0 = CV_LD(t0 - 2); r1 = CV_LD(t0 - 1); r2 = CV_LD(t0); r3 = CV_LD(t0 + 1);
#pragma unroll 4
    for (int t = t0; t < t0 + 64; ++t) {
      r4 = CV_LD(t + 2);
      float a[8];
#pragma unroll
      for (int j = 0; j < 8; ++j) a[j] = bias[j];
#define CV_ACC(R, k)                                                                                                     \
  _Pragma("unroll") for (int e = 0; e < 4; ++e) {                                                                        \
    a[2 * e] += w[k][2 * e] * bf2f((bf16_t)(R[e] & 0xffff));                                                             \
    a[2 * e + 1] += w[k][2 * e + 1] * bf2f((bf16_t)(R[e] >> 16));                                                        \
  }
      CV_ACC(r0, 0) CV_ACC(r1, 1) CV_ACC(r2, 2) CV_ACC(r3, 3) CV_ACC(r4, 4)
      u32x4 o;
      o[0] = pack2(siluf_(a[0]), siluf_(a[1])); o[1] = pack2(siluf_(a[2]), siluf_(a[3]));
      o[2] = pack2(siluf_(a[4]), siluf_(a[5])); o[3] = pack2(siluf_(a[6]), siluf_(a[7]));
      *(u32x4*)(xc + (size_t)t * 4096 + ch) = o;
      r0 = r1; r1 = r2; r2 = r3; r3 = r4;
    }
#undef CV_LD
#undef CV_ACC
  }
  const float* dtraw = (const float*)(p.ws + OFF_DTRAW);
  float* dt = (float*)(p.ws + OFF_DT);
  for (size_t i = (size_t)blockIdx.x * 256 + tid_opaque(); i < (size_t)T * 64; i += (size_t)gridDim.x * 256) {
    float v = dtraw[i] + p.ssd_dt_bias[l * 64 + (int)(i & 63)];
    dt[i] = v > 20.f ? v : log1pf(expf(v));
  }
}

__device__ __forceinline__ void ssd_naive_item(const Params& p, int l, int item, float* sm) {
  const int d = item & 1, h = (item >> 1) & 31, s = item >> 6;
  int tok0, L;
  if (s < 32) { tok0 = s * 256; L = 256; } else { tok0 = TCTX + (s - 32) * 2048; L = 2048; }
  const int tid = tid_opaque(), pp = tid >> 2, nq = tid & 3, g = h >> 2;
  float S[32];
  if (s < 32) {
#pragma unroll
    for (int i = 0; i < 32; ++i) S[i] = 0.f;
  } else {
    const float* st = p.state_ssm + ((((size_t)(s - 32) * 4 + l) * 2 + d) * 32 + h) * 8192 + pp * 128 + nq * 32;
#pragma unroll
    for (int i = 0; i < 32; ++i) S[i] = st[i];
  }
  const float a = -expf(p.ssd_a_log[l * 64 + d * 32 + h]);
  float* xs = sm; float* Bs = sm + 1024; float* Cs = Bs + 2048; float* dts = Cs + 2048;
  const bf16_t* xc = (const bf16_t*)(p.ws + OFF_XC);
  const float* dtb = (const float*)(p.ws + OFF_DT);
  float* ydir = (float*)(p.ws + (d == 0 ? OFF_YF : OFF_YB));
  for (int bt = 0; bt < L / 16; ++bt) {
    const int tb = d == 0 ? bt * 16 : L - 16 - bt * 16;
    __syncthreads();
    for (int e = tid; e < 16 * 320; e += 256) {
      const int tt = e / 320, c = e % 320;
      const size_t base = (size_t)(tok0 + tb + tt) * 4096;
      if (c < 64) xs[tt * 64 + c] = bf2f(xc[base + h * 64 + c]);
      else if (c < 192) Bs[tt * 128 + c - 64] = bf2f(xc[base + 2048 + g * 128 + c - 64]);
      else Cs[tt * 128 + c - 192] = bf2f(xc[base + 3072 + g * 128 + c - 192]);
    }
    if (tid < 16) dts[tid] = dtb[(size_t)(tok0 + tb + tid) * 64 + d * 32 + h];
    __syncthreads();
    for (int i2 = 0; i2 < 16; ++i2) {
      const int tt = d == 0 ? i2 : 15 - i2;
      const float dt = dts[tt], dA = expf(dt * a), xdt = xs[tt * 64 + pp] * dt;
      float acc = 0.f;
      const float* Bp = Bs + tt * 128 + nq * 32;
      const float* Cp = Cs + tt * 128 + nq * 32;
#pragma unroll
      for (int i = 0; i < 32; ++i) { S[i] = dA * S[i] + xdt * Bp[i]; acc += S[i] * Cp[i]; }
      acc += __shfl_xor(acc, 1); acc += __shfl_xor(acc, 2);
      if (nq == 0) ydir[(size_t)(tok0 + tb + tt) * 2048 + h * 64 + pp] = acc;
    }
  }
  if (s < 32) {
    float* o = p.out + OUT_SSM + ((((size_t)s * 4 + l) * 2 + d) * 32 + h) * 8192 + pp * 128 + nq * 32;
#pragma unroll
    for (int i = 0; i < 32; ++i) o[i] = S[i];
  }
}

__device__ __forceinline__ void hgrn_naive_item(const Params& p, int l, int item, float* sm) {
  const int d = item & 1, hd = (item >> 1) & 7, s = item >> 4;
  int tok0, L;
  if (s < 32) { tok0 = s * 256; L = 256; } else { tok0 = TCTX + (s - 32) * 2048; L = 2048; }
  const int tid = tid_opaque(), vv = tid >> 1, kh = tid & 1;
  float S[64];
  if (s < 32) {
#pragma unroll
    for (int i = 0; i < 64; ++i) S[i] = 0.f;
  } else {
    const float* st = p.state_hgrn + ((((size_t)(s - 32) * 4 + l) * 2 + d) * 8 + hd) * 16384 + (size_t)(kh * 64) * 128 + vv;
#pragma unroll
    for (int i = 0; i < 64; ++i) S[i] = st[(size_t)i * 128];
  }
  float* qs = sm; float* fs = sm + 2048; float* ks = sm + 4096; float* vs = sm + 6144;
  const bf16_t* proj = (const bf16_t*)(p.ws + OFF_PROJ);
  const float* lb = (const float*)(p.ws + OFF_LB) + (size_t)l * 2048 + d * 1024 + hd * 128;
  float* odir = (float*)(p.ws + (d == 0 ? OFF_OF : OFF_OB));
  for (int bt = 0; bt < L / 16; ++bt) {
    const int tb = d == 0 ? bt * 16 : L - 16 - bt * 16;
    __syncthreads();
    for (int e = tid; e < 16 * 128; e += 256) {
      const int tt = e >> 7, c = e & 127;
      const size_t base = (size_t)(tok0 + tb + tt) * NPROJ_PAD;
      const float q = bf2f(proj[base + C_HQ + hd * 128 + c]);
      const float u = bf2f(proj[base + C_HF + d * 1024 + hd * 128 + c]);
      const float lbv = lb[c];
      const float sg = sigmoidf_(u);
      qs[e] = siluf_(q);
      fs[e] = lbv + (1.f - lbv) * sg;
      ks[e] = (1.f - lbv) * (1.f - sg);
      vs[e] = bf2f(proj[base + C_HI + hd * 128 + c]);
    }
    __syncthreads();
    for (int i2 = 0; i2 < 16; ++i2) {
      const int tt = d == 0 ? i2 : 15 - i2;
      const float vval = vs[tt * 128 + vv];
      const float* fp = fs + tt * 128 + kh * 64;
      const float* kp = ks + tt * 128 + kh * 64;
      const float* qp = qs + tt * 128 + kh * 64;
      float acc = 0.f;
#pragma unroll
      for (int i = 0; i < 64; ++i) { S[i] = fp[i] * S[i] + kp[i] * vval; acc += S[i] * qp[i]; }
      acc += __shfl_xor(acc, 1);
      if (kh == 0) odir[(size_t)(tok0 + tb + tt) * 1024 + hd * 128 + vv] = acc;
    }
  }
  if (s < 32) {
    float* o = p.out + OUT_HGRN + ((((size_t)s * 4 + l) * 2 + d) * 8 + hd) * 16384 + (size_t)(kh * 64) * 128 + vv;
#pragma unroll
    for (int i = 0; i < 64; ++i) o[(size_t)i * 128] = S[i];
  }
}


constexpr int HG_ROW = 272;
constexpr int HG_IMG = 16 * HG_ROW;
constexpr int HG_BUF = 4 * HG_IMG + 512;
__device__ __forceinline__ void hgrn_chunk_item(const Params& p, int l, int item, char* smem) {
  const int d = item & 1, hd = (item >> 1) & 7, s = item >> 4;
  int tok0, L;
  if (s < 32) { tok0 = s * 256; L = 256; } else { tok0 = TCTX + (s - 32) * 2048; L = 2048; }
  const int tid = tid_opaque(), lane = tid & 63, w = tid >> 6, fr = lane & 15, fq = lane >> 4;
  const int ch = tid & 127, half = tid >> 7;
  f32x4 S[8][2];
  if (s < 32) {
#pragma unroll
    for (int kt = 0; kt < 8; ++kt) { S[kt][0] = (f32x4){0.f, 0.f, 0.f, 0.f}; S[kt][1] = (f32x4){0.f, 0.f, 0.f, 0.f}; }
  } else {
    const float* st = p.state_hgrn + ((((size_t)(s - 32) * 4 + l) * 2 + d) * 8 + hd) * 16384;
#pragma unroll
    for (int kt = 0; kt < 8; ++kt)
#pragma unroll
      for (int vt = 0; vt < 2; ++vt)
#pragma unroll
        for (int jj = 0; jj < 4; ++jj) S[kt][vt][jj] = st[(size_t)(16 * kt + fq * 4 + jj) * 128 + 32 * w + 16 * vt + fr];
  }
  const float lbv = ((const float*)(p.ws + OFF_LB))[(size_t)l * 2048 + d * 1024 + hd * 128 + ch];
  const bf16_t* proj = (const bf16_t*)(p.ws + OFF_PROJ);
  float* odir = (float*)(p.ws + (d == 0 ? OFF_OF : OFF_OB));
  float* xch = (float*)(smem + 2 * HG_BUF);
  const int nch = L >> 4;
  bf16_t rq[8], ru[8], rv[8];
  __syncthreads();
  {
#pragma unroll
    for (int i = 0; i < 8; ++i) {
      const int pos = 8 * half + i;
      const size_t tk = (size_t)(d == 0 ? tok0 + pos : tok0 + L - 1 - pos) * NPROJ_PAD;
      rq[i] = proj[tk + C_HQ + hd * 128 + ch];
      ru[i] = proj[tk + C_HF + d * 1024 + hd * 128 + ch];
      rv[i] = proj[tk + C_HI + hd * 128 + ch];
    }
  }
  for (int c = 0; c < nch; ++c) {
    char* buf = smem + (c & 1) * HG_BUF;
    float* xc_ = xch + (c & 1) * 256;
    float fv[8], kk[8], qs[8];
    float loc = 1.f;
#pragma unroll
    for (int i = 0; i < 8; ++i) {
      const float u = bf2f(ru[i]);
      const float sg = sigmoidf_(u);
      fv[i] = lbv + (1.f - lbv) * sg;
      kk[i] = (1.f - lbv) * (1.f - sg);
      qs[i] = siluf_(bf2f(rq[i]));
      loc *= fv[i];
      *(bf16_t*)(buf + 3 * HG_IMG + (8 * half + i) * HG_ROW + ch * 2) = rv[i];
    }
    xc_[half * 128 + ch] = loc;
    if (c + 1 < nch) {
#pragma unroll
      for (int i = 0; i < 8; ++i) {
        const int pos = (c + 1) * 16 + 8 * half + i;
        const size_t tk = (size_t)(d == 0 ? tok0 + pos : tok0 + L - 1 - pos) * NPROJ_PAD;
        rq[i] = proj[tk + C_HQ + hd * 128 + ch];
        ru[i] = proj[tk + C_HF + d * 1024 + hd * 128 + ch];
        rv[i] = proj[tk + C_HI + hd * 128 + ch];
      }
    }
    __syncthreads();
    {
      const float other = xc_[(half ^ 1) * 128 + ch];
      float P = half ? other : 1.f;
      float sfx = half ? 1.f : other;
      float suf[8];
#pragma unroll
      for (int i = 7; i >= 0; --i) { suf[i] = sfx; sfx *= fv[i]; }
#pragma unroll
      for (int i = 0; i < 8; ++i) {
        P *= fv[i];
        const int off = (8 * half + i) * HG_ROW + ch * 2;
        *(bf16_t*)(buf + off) = f2bf(qs[i] * P);
        *(bf16_t*)(buf + HG_IMG + off) = f2bf(kk[i] * __builtin_amdgcn_rcpf(fmaxf(P, 1e-30f)));
        *(bf16_t*)(buf + 2 * HG_IMG + off) = f2bf(kk[i] * suf[i]);
      }
      if (half) ((float*)(buf + 4 * HG_IMG))[ch] = P;
    }
    __syncthreads();
    const char* qtI = buf;
    const char* ktI = buf + HG_IMG;
    const float* dec = (const float*)(buf + 4 * HG_IMG);
    f32x4 at = (f32x4){0.f, 0.f, 0.f, 0.f};
#pragma unroll
    for (int ks = 0; ks < 4; ++ks) {
      bf16x8 a = *(const bf16x8*)(ktI + fr * HG_ROW + (32 * ks + fq * 8) * 2);
      bf16x8 b = *(const bf16x8*)(qtI + fr * HG_ROW + (32 * ks + fq * 8) * 2);
      at = __builtin_amdgcn_mfma_f32_16x16x32_bf16(a, b, at, 0, 0, 0);
    }
    s16x4 Pm;
    {
      u32x2 pk;
      pk[0] = pack2((fq * 4 + 0 <= fr) ? at[0] : 0.f, (fq * 4 + 1 <= fr) ? at[1] : 0.f);
      pk[1] = pack2((fq * 4 + 2 <= fr) ? at[2] : 0.f, (fq * 4 + 3 <= fr) ? at[3] : 0.f);
      Pm = __builtin_bit_cast(s16x4, pk);
    }
    const unsigned ldsb = (unsigned)(size_t)buf;
    const unsigned vaddr = ldsb + 3 * HG_IMG + (4 * fq + (fr >> 2)) * HG_ROW + (32 * w + 4 * (fr & 3)) * 2;
    const unsigned kaddr = ldsb + 2 * HG_IMG + (4 * fq + (fr >> 2)) * HG_ROW + (4 * (fr & 3)) * 2;
    s16x4 vf0, vf1, kf0, kf1, kf2, kf3, kf4, kf5, kf6, kf7;
    asm volatile(
        "ds_read_b64_tr_b16 %0, %10\n\t"
        "ds_read_b64_tr_b16 %1, %10 offset:32\n\t"
        "ds_read_b64_tr_b16 %2, %11\n\t"
        "ds_read_b64_tr_b16 %3, %11 offset:32\n\t"
        "ds_read_b64_tr_b16 %4, %11 offset:64\n\t"
        "ds_read_b64_tr_b16 %5, %11 offset:96\n\t"
        "ds_read_b64_tr_b16 %6, %11 offset:128\n\t"
        "ds_read_b64_tr_b16 %7, %11 offset:160\n\t"
        "ds_read_b64_tr_b16 %8, %11 offset:192\n\t"
        "ds_read_b64_tr_b16 %9, %11 offset:224\n\t"
        "s_waitcnt lgkmcnt(0)"
        : "=&v"(vf0), "=&v"(vf1), "=&v"(kf0), "=&v"(kf1), "=&v"(kf2), "=&v"(kf3), "=&v"(kf4), "=&v"(kf5), "=&v"(kf6), "=&v"(kf7)
        : "v"(vaddr), "v"(kaddr)
        : "memory");
    f32x4 o0 = __builtin_amdgcn_mfma_f32_16x16x16bf16_1k(Pm, vf0, (f32x4){0.f, 0.f, 0.f, 0.f}, 0, 0, 0);
    f32x4 o1 = __builtin_amdgcn_mfma_f32_16x16x16bf16_1k(Pm, vf1, (f32x4){0.f, 0.f, 0.f, 0.f}, 0, 0, 0);
#pragma unroll
    for (int ks = 0; ks < 4; ++ks) {
      u32x2 qa = *(const u32x2*)(qtI + fr * HG_ROW + (32 * ks + 4 * fq) * 2);
      u32x2 qb = *(const u32x2*)(qtI + fr * HG_ROW + (32 * ks + 16 + 4 * fq) * 2);
      u32x4 aa; aa[0] = qa[0]; aa[1] = qa[1]; aa[2] = qb[0]; aa[3] = qb[1];
      const bf16x8 A = __builtin_bit_cast(bf16x8, aa);
      u32x4 b0, b1;
      b0[0] = pack2(S[2 * ks][0][0], S[2 * ks][0][1]); b0[1] = pack2(S[2 * ks][0][2], S[2 * ks][0][3]);
      b0[2] = pack2(S[2 * ks + 1][0][0], S[2 * ks + 1][0][1]); b0[3] = pack2(S[2 * ks + 1][0][2], S[2 * ks + 1][0][3]);
      b1[0] = pack2(S[2 * ks][1][0], S[2 * ks][1][1]); b1[1] = pack2(S[2 * ks][1][2], S[2 * ks][1][3]);
      b1[2] = pack2(S[2 * ks + 1][1][0], S[2 * ks + 1][1][1]); b1[3] = pack2(S[2 * ks + 1][1][2], S[2 * ks + 1][1][3]);
      o0 = __builtin_amdgcn_mfma_f32_16x16x32_bf16(A, __builtin_bit_cast(bf16x8, b0), o0, 0, 0, 0);
      o1 = __builtin_amdgcn_mfma_f32_16x16x32_bf16(A, __builtin_bit_cast(bf16x8, b1), o1, 0, 0, 0);
    }
#pragma unroll
    for (int jj = 0; jj < 4; ++jj) {
      const int pos = c * 16 + fq * 4 + jj;
      const size_t tk = (size_t)(d == 0 ? tok0 + pos : tok0 + L - 1 - pos);
      odir[tk * 1024 + hd * 128 + 32 * w + fr] = o0[jj];
      odir[tk * 1024 + hd * 128 + 32 * w + 16 + fr] = o1[jj];
    }
    const s16x4 kfs[8] = {kf0, kf1, kf2, kf3, kf4, kf5, kf6, kf7};
#pragma unroll
    for (int kt = 0; kt < 8; ++kt) {
      const f32x4 dv = *(const f32x4*)(dec + 16 * kt + fq * 4);
      S[kt][0] = __builtin_amdgcn_mfma_f32_16x16x16bf16_1k(kfs[kt], vf0, S[kt][0] * dv, 0, 0, 0);
      S[kt][1] = __builtin_amdgcn_mfma_f32_16x16x16bf16_1k(kfs[kt], vf1, S[kt][1] * dv, 0, 0, 0);
    }
  }
  if (s < 32) {
    float* o = p.out + OUT_HGRN + ((((size_t)s * 4 + l) * 2 + d) * 8 + hd) * 16384;
#pragma unroll
    for (int kt = 0; kt < 8; ++kt)
#pragma unroll
      for (int vt = 0; vt < 2; ++vt)
#pragma unroll
        for (int jj = 0; jj < 4; ++jj) o[(size_t)(16 * kt + fq * 4 + jj) * 128 + 32 * w + 16 * vt + fr] = S[kt][vt][jj];
  }
}


constexpr size_t OFF_SST = OFF_YF;
constexpr size_t OFF_CS = OFF_YB;
constexpr int SS_BROW = 272, SS_XROW = 144;
constexpr int SS_R0 = 128 * SS_BROW;
constexpr int SS_R1 = 128 * SS_XROW;

template <int OFF>
__device__ __forceinline__ s16x4 tr_read(unsigned addr) {
  s16x4 r;
  asm volatile("ds_read_b64_tr_b16 %0, %1 offset:%2" : "=v"(r) : "v"(addr), "i"(OFF) : "memory");
  return r;
}
__device__ __forceinline__ bf16x8 cat8(s16x4 a, s16x4 b) {
  bf16x8 r;
  r[0] = a[0]; r[1] = a[1]; r[2] = a[2]; r[3] = a[3]; r[4] = b[0]; r[5] = b[1]; r[6] = b[2]; r[7] = b[3];
  return r;
}
#define TR_WAIT12(a, b, c, d, e, f, g, h, i, j, k, l_)                                                                            \
  asm volatile("s_waitcnt lgkmcnt(0)" : "+v"(a), "+v"(b), "+v"(c), "+v"(d), "+v"(e), "+v"(f), "+v"(g), "+v"(h), "+v"(i), "+v"(j), \
               "+v"(k), "+v"(l_)::"memory")
#define TR_WAIT8(a, b, c, d, e, f, g, h) \
  asm volatile("s_waitcnt lgkmcnt(0)" : "+v"(a), "+v"(b), "+v"(c), "+v"(d), "+v"(e), "+v"(f), "+v"(g), "+v"(h)::"memory")

template <int KS>
__device__ __forceinline__ void ssd_p1_kstep(f32x4 (&acc)[2][4], unsigned abase, unsigned xbase) {
  s16x4 a00, a01, a10, a11, b00, b01, b10, b11, b20, b21, b30, b31;
  asm volatile(
      "ds_read_b64_tr_b16 %0, %12 offset:%14\n\t"
      "ds_read_b64_tr_b16 %1, %12 offset:%15\n\t"
      "ds_read_b64_tr_b16 %2, %12 offset:%16\n\t"
      "ds_read_b64_tr_b16 %3, %12 offset:%17\n\t"
      "ds_read_b64_tr_b16 %4, %13 offset:%18\n\t"
      "ds_read_b64_tr_b16 %5, %13 offset:%19\n\t"
      "ds_read_b64_tr_b16 %6, %13 offset:%20\n\t"
      "ds_read_b64_tr_b16 %7, %13 offset:%21\n\t"
      "ds_read_b64_tr_b16 %8, %13 offset:%22\n\t"
      "ds_read_b64_tr_b16 %9, %13 offset:%23\n\t"
      "ds_read_b64_tr_b16 %10, %13 offset:%24\n\t"
      "ds_read_b64_tr_b16 %11, %13 offset:%25\n\t"
      "s_waitcnt lgkmcnt(0)"
      : "=&v"(a00), "=&v"(a01), "=&v"(a10), "=&v"(a11), "=&v"(b00), "=&v"(b01), "=&v"(b10), "=&v"(b11), "=&v"(b20), "=&v"(b21),
        "=&v"(b30), "=&v"(b31)
      : "v"(abase), "v"(xbase), "i"(KS * 32 * SS_BROW), "i"(KS * 32 * SS_BROW + 4 * SS_BROW), "i"(KS * 32 * SS_BROW + 32),
        "i"(KS * 32 * SS_BROW + 4 * SS_BROW + 32), "i"(KS * 32 * SS_XROW), "i"(KS * 32 * SS_XROW + 4 * SS_XROW),
        "i"(KS * 32 * SS_XROW + 32), "i"(KS * 32 * SS_XROW + 4 * SS_XROW + 32), "i"(KS * 32 * SS_XROW + 64),
        "i"(KS * 32 * SS_XROW + 4 * SS_XROW + 64), "i"(KS * 32 * SS_XROW + 96), "i"(KS * 32 * SS_XROW + 4 * SS_XROW + 96)
      : "memory");
  const bf16x8 A0 = cat8(a00, a01), A1 = cat8(a10, a11);
  const bf16x8 B0 = cat8(b00, b01), B1 = cat8(b10, b11), B2 = cat8(b20, b21), B3 = cat8(b30, b31);
  acc[0][0] = __builtin_amdgcn_mfma_f32_16x16x32_bf16(A0, B0, acc[0][0], 0, 0, 0);
  acc[0][1] = __builtin_amdgcn_mfma_f32_16x16x32_bf16(A0, B1, acc[0][1], 0, 0, 0);
  acc[0][2] = __builtin_amdgcn_mfma_f32_16x16x32_bf16(A0, B2, acc[0][2], 0, 0, 0);
  acc[0][3] = __builtin_amdgcn_mfma_f32_16x16x32_bf16(A0, B3, acc[0][3], 0, 0, 0);
  acc[1][0] = __builtin_amdgcn_mfma_f32_16x16x32_bf16(A1, B0, acc[1][0], 0, 0, 0);
  acc[1][1] = __builtin_amdgcn_mfma_f32_16x16x32_bf16(A1, B1, acc[1][1], 0, 0, 0);
  acc[1][2] = __builtin_amdgcn_mfma_f32_16x16x32_bf16(A1, B2, acc[1][2], 0, 0, 0);
  acc[1][3] = __builtin_amdgcn_mfma_f32_16x16x32_bf16(A1, B3, acc[1][3], 0, 0, 0);
}

__device__ __forceinline__ void ssd_pass1_item(const Params& p, int l, int item, char* smem) {
  const int d = item & 1, h = (item >> 1) & 31, s = item >> 6, g = h >> 2;
  const int nc = s < 32 ? 2 : 16, cg0 = s < 32 ? 2 * s : 64 + 16 * (s - 32);
  const int tid = tid_opaque(), lane = tid & 63, w = tid >> 6, fr = lane & 15, fq = lane >> 4;
  const float a = -expf(p.ssd_a_log[l * 64 + d * 32 + h]);
  f32x4 acc[2][4];
  if (s < 32) {
#pragma unroll
    for (int i = 0; i < 2; ++i)
#pragma unroll
      for (int j = 0; j < 4; ++j) acc[i][j] = (f32x4){0.f, 0.f, 0.f, 0.f};
  } else {
    const float* st = p.state_ssm + ((((size_t)(s - 32) * 4 + l) * 2 + d) * 32 + h) * 8192;
#pragma unroll
    for (int i = 0; i < 2; ++i)
#pragma unroll
      for (int j = 0; j < 4; ++j) acc[i][j] = *(const f32x4*)(st + (size_t)(16 * j + fr) * 128 + 32 * w + 16 * i + 4 * fq);
  }
  const bf16_t* xc = (const bf16_t*)(p.ws + OFF_XC);
  const float* dtb = (const float*)(p.ws + OFF_DT);
  float* csb = (float*)(p.ws + OFF_CS);
  bf16_t* sst = (bf16_t*)(p.ws + OFF_SST);
  float* wgt = (float*)(smem + SS_R0 + SS_R1);
  u32x4 pb[8], px[4];
  float dt0, dt1;
  {
    const int c = d == 0 ? 0 : nc - 1;
    const size_t tb = (size_t)(cg0 + c) * 128;
#pragma unroll
    for (int i = 0; i < 8; ++i) { const int q = tid + 256 * i; pb[i] = *(const u32x4*)(xc + (tb + (q >> 4)) * 4096 + 2048 + g * 128 + (q & 15) * 8); }
#pragma unroll
    for (int i = 0; i < 4; ++i) { const int q = tid + 256 * i; px[i] = *(const u32x4*)(xc + (tb + (q >> 3)) * 4096 + h * 64 + (q & 7) * 8); }
    dt0 = dtb[(tb + 2 * lane) * 64 + d * 32 + h];
    dt1 = dtb[(tb + 2 * lane + 1) * 64 + d * 32 + h];
  }
  const unsigned ldsb = (unsigned)(size_t)smem;
  const unsigned abase = ldsb + (8 * fq + (fr >> 2)) * SS_BROW + (32 * w + 4 * (fr & 3)) * 2;
  const unsigned xbase = ldsb + SS_R0 + (8 * fq + (fr >> 2)) * SS_XROW + (4 * (fr & 3)) * 2;
  for (int cc = 0; cc < nc; ++cc) {
    const int c = d == 0 ? cc : nc - 1 - cc, par = cc & 1;
    const size_t cgl = cg0 + c, tb = cgl * 128;
    {
      bf16_t* so = sst + ((cgl * 32 + h) * 2 + d) * 8192;
#pragma unroll
      for (int i = 0; i < 2; ++i)
#pragma unroll
        for (int j = 0; j < 4; ++j) {
          u32x2 o; o[0] = pack2(acc[i][j][0], acc[i][j][1]); o[1] = pack2(acc[i][j][2], acc[i][j][3]);
          *(u32x2*)(so + (size_t)(16 * j + fr) * 128 + 32 * w + 16 * i + 4 * fq) = o;
        }
    }
    if (w == 0) {
      const float v0 = dt0 * a, v1 = dt1 * a, sloc = v0 + v1;
      float incl = sloc;
#pragma unroll
      for (int off = 1; off < 64; off <<= 1) { const float t = __shfl_up(incl, off); if (lane >= off) incl += t; }
      const float excl = incl - sloc, c0 = excl + v0, tot = __shfl(incl, 63);
      float cs0, cs1, wg0, wg1;
      if (d == 0) { cs0 = c0; cs1 = incl; wg0 = dt0 * __expf(tot - c0); wg1 = dt1 * __expf(tot - incl); }
      else { cs0 = tot - excl; cs1 = tot - c0; wg0 = dt0 * __expf(excl); wg1 = dt1 * __expf(c0); }
      csb[(tb + 2 * lane) * 64 + d * 32 + h] = cs0;
      csb[(tb + 2 * lane + 1) * 64 + d * 32 + h] = cs1;
      wgt[par * 128 + 2 * lane] = wg0;
      wgt[par * 128 + 2 * lane + 1] = wg1;
      if (lane == 0) wgt[256 + par] = __expf(tot);
    }
    __syncthreads();
#pragma unroll
    for (int i = 0; i < 8; ++i) { const int q = tid + 256 * i; *(u32x4*)(smem + (q >> 4) * SS_BROW + (q & 15) * 16) = pb[i]; }
#pragma unroll
    for (int i = 0; i < 4; ++i) {
      const int q = tid + 256 * i, row = q >> 3;
      const float wv = wgt[par * 128 + row];
      u32x4 o;
#pragma unroll
      for (int e = 0; e < 4; ++e) o[e] = pack2(bf2f((bf16_t)(px[i][e] & 0xffff)) * wv, bf2f((bf16_t)(px[i][e] >> 16)) * wv);
      *(u32x4*)(smem + SS_R0 + row * SS_XROW + (q & 7) * 16) = o;
    }
    if (cc + 1 < nc) {
      const int cn = d == 0 ? cc + 1 : nc - 2 - cc;
      const size_t tbn = (size_t)(cg0 + cn) * 128;
#pragma unroll
      for (int i = 0; i < 8; ++i) { const int q = tid + 256 * i; pb[i] = *(const u32x4*)(xc + (tbn + (q >> 4)) * 4096 + 2048 + g * 128 + (q & 15) * 8); }
#pragma unroll
      for (int i = 0; i < 4; ++i) { const int q = tid + 256 * i; px[i] = *(const u32x4*)(xc + (tbn + (q >> 3)) * 4096 + h * 64 + (q & 7) * 8); }
      dt0 = dtb[(tbn + 2 * lane) * 64 + d * 32 + h];
      dt1 = dtb[(tbn + 2 * lane + 1) * 64 + d * 32 + h];
    }
    __syncthreads();
    const float dec = wgt[256 + par];
#pragma unroll
    for (int i = 0; i < 2; ++i)
#pragma unroll
      for (int j = 0; j < 4; ++j) acc[i][j] *= dec;
    ssd_p1_kstep<0>(acc, abase, xbase);
    ssd_p1_kstep<1>(acc, abase, xbase);
    ssd_p1_kstep<2>(acc, abase, xbase);
    ssd_p1_kstep<3>(acc, abase, xbase);
  }
  if (s < 32) {
    float* o = p.out + OUT_SSM + ((((size_t)s * 4 + l) * 2 + d) * 32 + h) * 8192;
#pragma unroll
    for (int i = 0; i < 2; ++i)
#pragma unroll
      for (int j = 0; j < 4; ++j) *(f32x4*)(o + (size_t)(16 * j + fr) * 128 + 32 * w + 16 * i + 4 * fq) = acc[i][j];
  }
  __syncthreads();
}

template <int KS>
__device__ __forceinline__ void ssd_p2_wx_kstep(f32x4 (&y)[4], const char* wrow, unsigned xbase) {
  s16x4 b00, b01, b10, b11, b20, b21, b30, b31;
  const bf16x8 A = *(const bf16x8*)(wrow + KS * 64);
  asm volatile(
      "ds_read_b64_tr_b16 %0, %8 offset:%9\n\t"
      "ds_read_b64_tr_b16 %1, %8 offset:%10\n\t"
      "ds_read_b64_tr_b16 %2, %8 offset:%11\n\t"
      "ds_read_b64_tr_b16 %3, %8 offset:%12\n\t"
      "ds_read_b64_tr_b16 %4, %8 offset:%13\n\t"
      "ds_read_b64_tr_b16 %5, %8 offset:%14\n\t"
      "ds_read_b64_tr_b16 %6, %8 offset:%15\n\t"
      "ds_read_b64_tr_b16 %7, %8 offset:%16\n\t"
      "s_waitcnt lgkmcnt(0)"
      : "=&v"(b00), "=&v"(b01), "=&v"(b10), "=&v"(b11), "=&v"(b20), "=&v"(b21), "=&v"(b30), "=&v"(b31)
      : "v"(xbase), "i"(KS * 32 * SS_XROW), "i"(KS * 32 * SS_XROW + 4 * SS_XROW), "i"(KS * 32 * SS_XROW + 32),
        "i"(KS * 32 * SS_XROW + 4 * SS_XROW + 32), "i"(KS * 32 * SS_XROW + 64), "i"(KS * 32 * SS_XROW + 4 * SS_XROW + 64),
        "i"(KS * 32 * SS_XROW + 96), "i"(KS * 32 * SS_XROW + 4 * SS_XROW + 96)
      : "memory");
  y[0] = __builtin_amdgcn_mfma_f32_16x16x32_bf16(A, cat8(b00, b01), y[0], 0, 0, 0);
  y[1] = __builtin_amdgcn_mfma_f32_16x16x32_bf16(A, cat8(b10, b11), y[1], 0, 0, 0);
  y[2] = __builtin_amdgcn_mfma_f32_16x16x32_bf16(A, cat8(b20, b21), y[2], 0, 0, 0);
  y[3] = __builtin_amdgcn_mfma_f32_16x16x32_bf16(A, cat8(b30, b31), y[3], 0, 0, 0);
}

__device__ __forceinline__ void ssd_pass2_item(const Params& p, int l, int item, char* smem) {
  const int hf = item & 1, g = (item >> 1) & 7, cg = item >> 4;
  const size_t tb = (size_t)cg * 128;
  const int tid = tid_opaque(), lane = tid & 63, w = tid >> 6, fr = lane & 15, fq = lane >> 4;
  const int i0 = 64 * hf + 16 * w;
  const bf16_t* xc = (const bf16_t*)(p.ws + OFF_XC);
  const bf16_t* proj = (const bf16_t*)(p.ws + OFF_PROJ);
  const float* dtb = (const float*)(p.ws + OFF_DT);
  const float* csb = (const float*)(p.ws + OFF_CS);
  const bf16_t* sst = (const bf16_t*)(p.ws + OFF_SST);
  bf16_t* ybuf = (bf16_t*)(p.ws + OFF_YBUF);
  float* arr = (float*)(smem + SS_R0 + SS_R1);
  __syncthreads();
  bf16x8 cfr[4];
#pragma unroll
  for (int ks = 0; ks < 4; ++ks) cfr[ks] = *(const bf16x8*)(xc + (tb + i0 + fr) * 4096 + 3072 + g * 128 + 32 * ks + 8 * fq);
#pragma unroll
  for (int i = 0; i < 8; ++i) {
    const int idx = tid + 256 * i, hh = idx >> 9, a = (idx >> 7) & 3, j = idx & 127;
    const float* src = (a < 2 ? csb : dtb) + (tb + j) * 64 + (a & 1) * 32 + 4 * g + hh;
    arr[idx] = *src;
  }
#pragma unroll
  for (int i = 0; i < 8; ++i) {
    const int q = tid + 256 * i;
    *(u32x4*)(smem + (q >> 4) * SS_BROW + (q & 15) * 16) = *(const u32x4*)(xc + (tb + (q >> 4)) * 4096 + 2048 + g * 128 + (q & 15) * 8);
  }
  __syncthreads();
  f32x4 cb[8];
#pragma unroll
  for (int jt = 0; jt < 8; ++jt) cb[jt] = (f32x4){0.f, 0.f, 0.f, 0.f};
#pragma unroll
  for (int ks = 0; ks < 4; ++ks)
#pragma unroll
    for (int jt = 0; jt < 8; ++jt) {
      const bf16x8 A = *(const bf16x8*)(smem + (16 * jt + fr) * SS_BROW + (32 * ks + 8 * fq) * 2);
      cb[jt] = __builtin_amdgcn_mfma_f32_16x16x32_bf16(A, cfr[ks], cb[jt], 0, 0, 0);
    }
  __syncthreads();
  float ss[4] = {0.f, 0.f, 0.f, 0.f};
  const unsigned ldsb = (unsigned)(size_t)smem;
  const unsigned xbase = ldsb + SS_R0 + (8 * fq + (fr >> 2)) * SS_XROW + (4 * (fr & 3)) * 2;
  const char* wrow = smem + (16 * w + fr) * SS_BROW + (8 * fq) * 2;
  const int il = i0 + fr;
#pragma unroll 1
  for (int hh = 0; hh < 4; ++hh) {
    const int h = 4 * g + hh;
    u32x4 pre[4];
#pragma unroll
    for (int i = 0; i < 4; ++i) { const int q = tid + 256 * i; pre[i] = *(const u32x4*)(xc + (tb + (q >> 3)) * 4096 + h * 64 + (q & 7) * 8); }
    const float* csf = arr + hh * 512;
    const float* csr = csf + 128;
    const float* dtf = csf + 256;
    const float* dtr = csf + 384;
    {
      const float cfi = csf[il], cbi = csr[il];
#pragma unroll
      for (int jt = 0; jt < 8; ++jt) {
        const f32x4 cfj = *(const f32x4*)(csf + 16 * jt + 4 * fq), cbj = *(const f32x4*)(csr + 16 * jt + 4 * fq);
        const f32x4 dfj = *(const f32x4*)(dtf + 16 * jt + 4 * fq), dbj = *(const f32x4*)(dtr + 16 * jt + 4 * fq);
        float wv[4];
#pragma unroll
        for (int jj = 0; jj < 4; ++jj) {
          const int j = 16 * jt + 4 * fq + jj;
          const bool le = j <= il;
          float mlt = __expf(le ? cfi - cfj[jj] : cbi - cbj[jj]) * (le ? dfj[jj] : dbj[jj]);
          if (j == il) mlt = dfj[jj] + dbj[jj];
          wv[jj] = cb[jt][jj] * mlt;
        }
        u32x2 o; o[0] = pack2(wv[0], wv[1]); o[1] = pack2(wv[2], wv[3]);
        *(u32x2*)(smem + (16 * w + fr) * SS_BROW + (16 * jt + 4 * fq) * 2) = o;
      }
    }
#pragma unroll
    for (int i = 0; i < 4; ++i) { const int q = tid + 256 * i; *(u32x4*)(smem + SS_R0 + (q >> 3) * SS_XROW + (q & 7) * 16) = pre[i]; }
#pragma unroll
    for (int i = 0; i < 4; ++i) { const int q = tid + 256 * i; pre[i] = *(const u32x4*)(sst + (((size_t)cg * 32 + h) * 2 + 0) * 8192 + (q >> 4) * 128 + (q & 15) * 8); }
    __syncthreads();
    f32x4 y[4];
#pragma unroll
    for (int pt = 0; pt < 4; ++pt) y[pt] = (f32x4){0.f, 0.f, 0.f, 0.f};
    ssd_p2_wx_kstep<0>(y, wrow, xbase);
    ssd_p2_wx_kstep<1>(y, wrow, xbase);
    ssd_p2_wx_kstep<2>(y, wrow, xbase);
    ssd_p2_wx_kstep<3>(y, wrow, xbase);
    float xsk[4][4];
#pragma unroll
    for (int pt = 0; pt < 4; ++pt)
#pragma unroll
      for (int jj = 0; jj < 4; ++jj) xsk[pt][jj] = bf2f(*(const bf16_t*)(smem + SS_R0 + (i0 + 4 * fq + jj) * SS_XROW + (16 * pt + fr) * 2));
    __syncthreads();
#pragma unroll
    for (int i = 0; i < 4; ++i) { const int q = tid + 256 * i; *(u32x4*)(smem + SS_R0 + (q >> 4) * SS_BROW + (q & 15) * 16) = pre[i]; }
#pragma unroll
    for (int i = 0; i < 4; ++i) { const int q = tid + 256 * i; pre[i] = *(const u32x4*)(sst + (((size_t)cg * 32 + h) * 2 + 1) * 8192 + (q >> 4) * 128 + (q & 15) * 8); }
    __syncthreads();
    f32x4 zf[4], zb[4];
#pragma unroll
    for (int pt = 0; pt < 4; ++pt) { zf[pt] = (f32x4){0.f, 0.f, 0.f, 0.f}; zb[pt] = (f32x4){0.f, 0.f, 0.f, 0.f}; }
#pragma unroll
    for (int ks = 0; ks < 4; ++ks)
#pragma unroll
      for (int pt = 0; pt < 4; ++pt) {
        const bf16x8 B = *(const bf16x8*)(smem + SS_R0 + (16 * pt + fr) * SS_BROW + (32 * ks + 8 * fq) * 2);
        zf[pt] = __builtin_amdgcn_mfma_f32_16x16x32_bf16(cfr[ks], B, zf[pt], 0, 0, 0);
      }
    __syncthreads();
#pragma unroll
    for (int i = 0; i < 4; ++i) { const int q = tid + 256 * i; *(u32x4*)(smem + SS_R0 + (q >> 4) * SS_BROW + (q & 15) * 16) = pre[i]; }
    __syncthreads();
#pragma unroll
    for (int ks = 0; ks < 4; ++ks)
#pragma unroll
      for (int pt = 0; pt < 4; ++pt) {
        const bf16x8 B = *(const bf16x8*)(smem + SS_R0 + (16 * pt + fr) * SS_BROW + (32 * ks + 8 * fq) * 2);
        zb[pt] = __builtin_amdgcn_mfma_f32_16x16x32_bf16(cfr[ks], B, zb[pt], 0, 0, 0);
      }
    const float dsk = p.ssd_d[l * 32 + h];
#pragma unroll
    for (int jj = 0; jj < 4; ++jj) {
      const int i2 = i0 + 4 * fq + jj;
      const float ef = __expf(csf[i2]), eb = __expf(csr[i2]);
#pragma unroll
      for (int pt = 0; pt < 4; ++pt) {
        const float z = bf2f(proj[(tb + i2) * NPROJ_PAD + C_Z + h * 64 + 16 * pt + fr]);
        float val = y[pt][jj] + ef * zf[pt][jj] + eb * zb[pt][jj] + dsk * xsk[pt][jj];
        val *= siluf_(z);
        ybuf[(tb + i2) * 2048 + h * 64 + 16 * pt + fr] = f2bf(val);
        ss[jj] += val * val;
      }
    }
    __syncthreads();
  }
#pragma unroll
  for (int jj = 0; jj < 4; ++jj) {
    float t = ss[jj];
    t += __shfl_xor(t, 1); t += __shfl_xor(t, 2); t += __shfl_xor(t, 4); t += __shfl_xor(t, 8);
    ss[jj] = rsqrtf(t * (1.f / 256.f) + 1e-6f);
  }
#pragma unroll
  for (int hh = 0; hh < 4; ++hh)
#pragma unroll
    for (int pt = 0; pt < 4; ++pt) {
      const int chn = (4 * g + hh) * 64 + 16 * pt + fr;
      const float nw = p.ssd_norm_w[l * 2048 + chn];
#pragma unroll
      for (int jj = 0; jj < 4; ++jj) {
        bf16_t* yp = ybuf + (tb + i0 + 4 * fq + jj) * 2048 + chn;
        *yp = f2bf(bf2f(*yp) * ss[jj] * nw);
      }
    }
}

__device__ __forceinline__ void phase_scan1(const Params& p, int l, char* smem) {
  const int bid = blockIdx.x;
  if (bid < 64) { hgrn_chunk_item(p, l, 32 * 16 + bid, smem); return; }
  if (bid >= 256 && bid < 320) return;
  const int wkr = bid < 256 ? bid - 64 : bid - 128;
  for (int it = wkr; it < 256 + 512 + 2048; it += 384) {
    if (it < 256) ssd_pass1_item(p, l, 32 * 64 + it, smem);
    else if (it < 768) hgrn_chunk_item(p, l, it - 256, smem);
    else ssd_pass1_item(p, l, it - 768, smem);
  }
}
__device__ __forceinline__ void phase_scan2(const Params& p, int l, char* smem) {
  for (int it = blockIdx.x; it < 2048; it += gridDim.x) ssd_pass2_item(p, l, it, smem);
}

__device__ __forceinline__ void phase_scan_naive(const Params& p, int l, char* smem) {
  const int n_ssd = 36 * 64, n_hg = 36 * 16;
  for (int it = blockIdx.x; it < n_ssd + n_hg; it += gridDim.x) {
    if (it < 256) ssd_naive_item(p, l, 32 * 64 + it, (float*)smem);
    else if (it < 320) hgrn_chunk_item(p, l, 32 * 16 + (it - 256), smem);
    else if (it < 320 + 2048) ssd_naive_item(p, l, it - 320, (float*)smem);
    else hgrn_chunk_item(p, l, it - 320 - 2048, smem);
  }
}

__device__ __forceinline__ void phase_post(const Params& p, int l) {
  const int tid = tid_opaque();
  const bf16_t* proj = (const bf16_t*)(p.ws + OFF_PROJ);
  const bf16_t* xc = (const bf16_t*)(p.ws + OFF_XC);
  const float* yf = (const float*)(p.ws + OFF_YF);
  const float* yb = (const float*)(p.ws + OFF_YB);
  const float* of = (const float*)(p.ws + OFF_OF);
  const float* ob = (const float*)(p.ws + OFF_OB);
  bf16_t* ybuf = (bf16_t*)(p.ws + OFF_YBUF);
  bf16_t* obuf = (bf16_t*)(p.ws + OFF_OBUF);
  for (int tok = blockIdx.x; tok < T; tok += gridDim.x) {
    {
      const int ch = tid * 4;
      const float* a = of + (size_t)tok * 1024 + ch;
      const float* b = ob + (size_t)tok * 1024 + ch;
      uint2 gv = *(const uint2*)(proj + (size_t)tok * NPROJ_PAD + C_HG + ch);
      const unsigned gw[2] = {gv.x, gv.y};
      float v[4];
      float ss = 0.f;
#pragma unroll
      for (int j = 0; j < 4; ++j) { v[j] = a[j] + b[j]; ss += v[j] * v[j]; }
#pragma unroll
      for (int o = 16; o >= 1; o >>= 1) ss += __shfl_xor(ss, o);
      const float rstd = rsqrtf(ss * (1.f / 128.f) + 1e-6f);
      const float* nw = p.hgrn_norm_w + l * 1024 + ch;
      float r[4];
#pragma unroll
      for (int j = 0; j < 4; ++j) {
        const float gz = bf2f((bf16_t)((j & 1) ? (gw[j >> 1] >> 16) : (gw[j >> 1] & 0xffff)));
        r[j] = v[j] * rstd * nw[j] * siluf_(gz);
      }
      uint2 o2; o2.x = pack2(r[0], r[1]); o2.y = pack2(r[2], r[3]);
      *(uint2*)(obuf + (size_t)tok * 1024 + ch) = o2;
    }
  }
}


#define XB_TMO 128
#define XB_XCNT(j) (256 + 64 * (j))
#define XB_XSUB(j) (1280 + 64 * (j))
#define XB_XGEN(j) (2304 + 64 * (j))
#define XB_TOP 3328
#define XB_TOPGEN 3392
#define XCD_BAR_WORDS 3456
#define XB_SPIN_CAP (1u << 22)
#define LAS __attribute__((address_space(3)))
__device__ __forceinline__ unsigned xb_ld(unsigned* p) { return __hip_atomic_load(p, __ATOMIC_RELAXED, __HIP_MEMORY_SCOPE_AGENT); }
__device__ __forceinline__ unsigned xb_add(unsigned* p, unsigned v) { return __hip_atomic_fetch_add(p, v, __ATOMIC_RELAXED, __HIP_MEMORY_SCOPE_AGENT); }
__device__ __forceinline__ unsigned xb_xcc_id() { return (unsigned)__builtin_amdgcn_s_getreg((3 << 11) | 20) & 0xFu; }
#define XB_SPIN(cond, bar)                                                                    \
  do {                                                                                        \
    unsigned _sp = 0;                                                                         \
    while (cond) {                                                                            \
      __builtin_amdgcn_s_sleep(1);                                                            \
      if ((++_sp & 255u) == 0u) {                                                             \
        if (xb_ld(&(bar)[XB_TMO])) break;                                                     \
        if (_sp > XB_SPIN_CAP) { atomicAdd(&(bar)[XB_TMO], 1u); break; }                      \
      }                                                                                       \
    }                                                                                         \
  } while (0)
struct XcdBarrier { unsigned* bar; unsigned x; volatile LAS unsigned* st; };
__device__ __forceinline__ XcdBarrier xcd_barrier_post(unsigned* bar, volatile LAS unsigned* st) {
  XcdBarrier b; b.bar = bar; b.x = xb_xcc_id(); b.st = st;
  if (threadIdx.x == 0) (void)xb_add(&bar[XB_XCNT(b.x)], 1u);
  return b;
}
__device__ __forceinline__ void xcd_barrier_complete(unsigned* bar, unsigned x, unsigned& nloc, unsigned& nx) {
  const unsigned G = gridDim.x * gridDim.y * gridDim.z;
  unsigned sum, cnt, mine, sp = 0u;
  for (;;) {
    sum = 0u; cnt = 0u; mine = 0u;
#pragma unroll
    for (unsigned j = 0; j < 16; ++j) { const unsigned c = xb_ld(&bar[XB_XCNT(j)]); sum += c; cnt += (c > 0u) ? 1u : 0u; mine = (j == x) ? c : mine; }
    if (sum == G) break;
    __builtin_amdgcn_s_sleep(1);
    if ((++sp & 255u) == 0u) { if (xb_ld(&bar[XB_TMO])) break; if (sp > XB_SPIN_CAP) { atomicAdd(&bar[XB_TMO], 1u); break; } }
  }
  nloc = mine > 0u ? mine : 1u; nx = cnt > 0u ? cnt : 1u;
}
__device__ __forceinline__ void xcd_barrier(const XcdBarrier& b) {
  asm volatile("s_waitcnt vmcnt(0)" ::: "memory");
  __syncthreads();
  if (threadIdx.x == 0) {
    unsigned* bar = b.bar;
    __builtin_amdgcn_s_waitcnt(0);
    unsigned nloc = b.st[0], nx = b.st[1];
    if (nloc == 0u) { xcd_barrier_complete(bar, b.x, nloc, nx); b.st[0] = nloc; b.st[1] = nx; }
    const unsigned old = xb_add(&bar[XB_XSUB(b.x)], 1u);
    const unsigned gen = old / nloc;
    if (old + 1u == (gen + 1u) * nloc) {
      __builtin_amdgcn_fence(__ATOMIC_RELEASE, "agent");
      asm volatile("s_waitcnt vmcnt(0)" ::: "memory");
      const unsigned og = xb_add(&bar[XB_TOP], 1u);
      const unsigned tg = og / nx;
      if (og + 1u == (tg + 1u) * nx) xb_add(&bar[XB_TOPGEN], 1u);
      else XB_SPIN(xb_ld(&bar[XB_TOPGEN]) == tg, bar);
      __builtin_amdgcn_fence(__ATOMIC_ACQUIRE, "agent");
      xb_add(&bar[XB_XGEN(b.x)], 1u);
      asm volatile("s_waitcnt vmcnt(0)" ::: "memory");
    } else {
      XB_SPIN(xb_ld(&bar[XB_XGEN(b.x)]) == gen, bar);
      __builtin_amdgcn_fence(__ATOMIC_ACQUIRE, "agent");
      asm volatile("s_waitcnt vmcnt(0)" ::: "memory");
    }
  }
  __syncthreads();
}

enum { PH_SETUP = 0, PH_NORM1, PH_PROJ, PH_CONV, PH_SCAN, PH_POST, PH_MERGE, PH_OUT, PH_NORM2, PH_FFN1, PH_FFN2, PH_FINAL };

__device__ __forceinline__ void run_phase(const Params& p, int ph, int l, char* smem) {
  switch (ph) {
    case PH_SETUP: phase_setup(p, smem); break;
    case PH_NORM1: phase_norm(p, l, 0); break;
    case PH_PROJ: phase_gemm<G_PROJ>(p, l, smem); break;
    case PH_CONV: phase_conv(p, l); break;
    case PH_SCAN: phase_scan_naive(p, l, smem); break;
    case PH_POST: phase_post(p, l); break;
    case PH_MERGE: phase_gemm<G_MERGE>(p, l, smem); break;
    case PH_OUT: phase_gemm<G_OUT>(p, l, smem); break;
    case PH_NORM2: phase_norm(p, l, 1); break;
    case PH_FFN1: phase_gemm<G_FFN1>(p, l, smem); break;
    case PH_FFN2: phase_gemm<G_FFN2>(p, l, smem); break;
    case PH_FINAL: phase_final_norm(p); break;
  }
}

extern __shared__ __attribute__((aligned(16))) char dyn_smem[];

#if !MEGA
__global__ void __launch_bounds__(256, 2) phase_kernel(Params p, int ph, int l) { run_phase(p, ph, l, dyn_smem); }
#endif

#if MEGA
__global__ void __launch_bounds__(256, 2) mega_kernel(Params p) {
  cg::grid_group grid = cg::this_grid();
  __shared__ uint4 xb_words;
  if (threadIdx.x == 0) xb_words = make_uint4(0u, 0u, 0u, 0u);
  __syncthreads();
  XcdBarrier xb = xcd_barrier_post((unsigned*)(p.ws + OFF_BAR), (volatile LAS unsigned*)&xb_words);
  phase_setup(p, dyn_smem);
  grid.sync();
  for (int l = 0; l < DEPTH; ++l) {
#pragma unroll 1
    for (int ph = 0; ph < 10; ++ph) {
      switch (ph) {
        case 0: phase_norm(p, l, 0); break;
        case 1: phase_gemm<G_PROJ>(p, l, dyn_smem); break;
        case 2: phase_conv(p, l); break;
        case 3: phase_scan1(p, l, dyn_smem); break;
        case 4: phase_scan2(p, l, dyn_smem); phase_post(p, l); break;
        case 5: phase_gemm<G_MERGE>(p, l, dyn_smem); break;
        case 6: phase_gemm<G_OUT>(p, l, dyn_smem); break;
        case 7: phase_norm(p, l, 1); break;
        case 8: phase_gemm<G_FFN1>(p, l, dyn_smem); break;
        default: phase_gemm<G_FFN2>(p, l, dyn_smem); break;
      }
      xcd_barrier(xb);
    }
  }
  phase_final_norm(p);
}
#endif

extern "C" void kernel_launch(void* const* d_in, const int* in_sizes, int n_in, void* d_out, int out_size, void* d_ws, size_t ws_size,
                              hipStream_t stream) {
  static int grid_blocks = 0;
  if (!grid_blocks) {
    int dev = 0, cus = 0, per_cu = 0;
    (void)hipGetDevice(&dev);
    (void)hipDeviceGetAttribute(&cus, hipDeviceAttributeMultiprocessorCount, dev);
#if MEGA
    (void)hipFuncSetAttribute((const void*)mega_kernel, hipFuncAttributeMaxDynamicSharedMemorySize, SMEM_BYTES);
#endif
#if !MEGA
    (void)hipFuncSetAttribute((const void*)phase_kernel, hipFuncAttributeMaxDynamicSharedMemorySize, SMEM_BYTES);
#endif
#if MEGA
    (void)hipOccupancyMaxActiveBlocksPerMultiprocessor(&per_cu, mega_kernel, 256, SMEM_BYTES);
#else
    (void)hipOccupancyMaxActiveBlocksPerMultiprocessor(&per_cu, phase_kernel, 256, SMEM_BYTES);
#endif
    per_cu = 2;
    grid_blocks = cus * per_cu;
  }
  Params p{};
  const float** pf = (const float**)&p;
  for (int i = 0; i < 26; ++i) pf[i] = (const float*)d_in[i];
  p.out = (float*)d_out;
  p.ws = (char*)d_ws;
#if MEGA
  (void)hipMemsetAsync((char*)d_ws + OFF_BAR, 0, XCD_BAR_WORDS * 4, stream);
  void* args[] = {&p};
  hipError_t e = hipLaunchCooperativeKernel((void*)mega_kernel, dim3(grid_blocks), dim3(256), args, SMEM_BYTES, stream);
  if (e != hipSuccess) fprintf(stderr, "coop launch failed: %s\n", hipGetErrorString(e));
#else
  const int G = grid_blocks;
  phase_kernel<<<G, 256, SMEM_BYTES, stream>>>(p, PH_SETUP, 0);
  for (int l = 0; l < DEPTH; ++l)
    for (int ph = PH_NORM1; ph <= PH_FFN2; ++ph) phase_kernel<<<G, 256, SMEM_BYTES, stream>>>(p, ph, l);
  phase_kernel<<<G, 256, SMEM_BYTES, stream>>>(p, PH_FINAL, 0);
#endif
}
```

```cpp
#include <hip/hip_runtime.h>
#include <hip/hip_cooperative_groups.h>
#include <cstdio>
#include <cstdint>
namespace cg = cooperative_groups;

#ifndef MEGA
#define MEGA 1
#endif

typedef unsigned short bf16_t;
typedef short bf16x8 __attribute__((ext_vector_type(8)));
typedef float f32x4 __attribute__((ext_vector_type(4)));
typedef unsigned u32x4 __attribute__((ext_vector_type(4)));
typedef short s16x4 __attribute__((ext_vector_type(4)));
typedef unsigned u32x2 __attribute__((ext_vector_type(2)));

constexpr int D = 1024, T = 16384, TCTX = 8192, DEPTH = 4;
constexpr int NPROJ = 13376, NPROJ_PAD = 13440;
constexpr int FFN = 2816;
constexpr int C_Z = 4096, C_DT = 6144, C_HQ = 6208, C_HF = 7232, C_HI = 9280, C_HG = 10304, C_GATE = 11328;
constexpr size_t WT_IN = 0;
constexpr size_t WT_SSO = WT_IN + (size_t)NPROJ_PAD * 1024;
constexpr size_t WT_HGO = WT_SSO + (size_t)1024 * 2048;
constexpr size_t WT_OUT = WT_HGO + (size_t)1024 * 1024;
constexpr size_t WT_W13 = WT_OUT + (size_t)1024 * 1024;
constexpr size_t WT_W2 = WT_W13 + (size_t)5632 * 1024;
constexpr size_t WT_LAYER = WT_W2 + (size_t)1024 * 2816;
constexpr size_t OFF_WT = 0;
constexpr size_t OFF_H = OFF_WT + WT_LAYER * 2 * DEPTH;
constexpr size_t OFF_PROJ = OFF_H + (size_t)T * 1024 * 2;
constexpr size_t OFF_XC = OFF_PROJ + (size_t)T * NPROJ_PAD * 2;
constexpr size_t OFF_DTRAW = OFF_XC + (size_t)T * 4096 * 2;
constexpr size_t OFF_DT = OFF_DTRAW + (size_t)T * 64 * 4;
constexpr size_t OFF_YF = OFF_DT + (size_t)T * 64 * 4;
constexpr size_t OFF_YB = OFF_YF + (size_t)T * 2048 * 4;
constexpr size_t OFF_OF = OFF_YB + (size_t)T * 2048 * 4;
constexpr size_t OFF_OB = OFF_OF + (size_t)T * 1024 * 4;
constexpr size_t OFF_YBUF = OFF_OB + (size_t)T * 1024 * 4;
constexpr size_t OFF_OBUF = OFF_YBUF + (size_t)T * 2048 * 2;
constexpr size_t OFF_MBUF = OFF_OBUF + (size_t)T * 1024 * 2;
constexpr size_t OFF_MOD = OFF_MBUF + (size_t)T * 1024 * 2;
constexpr size_t OFF_LB = OFF_MOD + (size_t)DEPTH * 5 * 6144 * 4;
constexpr size_t OFF_BAR = OFF_LB + (size_t)DEPTH * 2 * 1024 * 4;
constexpr size_t OFF_END = OFF_BAR + 16384;
constexpr size_t OUT_SSM = (size_t)T * 1024;
constexpr size_t OUT_HGRN = OUT_SSM + (size_t)32 * 4 * 2 * 32 * 64 * 128;

constexpr int SMEM_BYTES = 73728;
constexpr int LDS_ROW = 128;
constexpr int LDS_TILE = 128 * LDS_ROW;

struct Params {
  const float *x_prompt, *x_sample, *c, *state_ssm, *state_hgrn, *c_ctx, *norm_mix_w, *norm_ffn_w, *ada_w, *ada_b, *w_in,
      *ssd_conv_w, *ssd_conv_b, *ssd_dt_bias, *ssd_a_log, *ssd_d, *ssd_norm_w, *hgrn_lb, *hgrn_norm_w, *w_ssd_out, *w_hgrn_out,
      *w_out, *ffn_w1, *ffn_w3, *ffn_w2, *norm_final_w;
  float* out;
  char* ws;
};

__device__ __forceinline__ bf16_t f2bf(float f) {
  unsigned u = __float_as_uint(f);
  u += 0x7fffu + ((u >> 16) & 1u);
  return (bf16_t)(u >> 16);
}
__device__ __forceinline__ float bf2f(bf16_t b) { return __uint_as_float(((unsigned)b) << 16); }
typedef __bf16 bf16x2_t __attribute__((ext_vector_type(2)));
__device__ __forceinline__ unsigned pack2(float a, float b) { bf16x2_t v = {(__bf16)a, (__bf16)b}; return __builtin_bit_cast(unsigned, v); }
__device__ __forceinline__ float sigmoidf_(float x) { return __builtin_amdgcn_rcpf(1.0f + __expf(-x)); }
__device__ __forceinline__ float siluf_(float x) { return x * __builtin_amdgcn_rcpf(1.0f + __expf(-x)); }
__device__ __forceinline__ int tid_opaque() { int t = threadIdx.x; asm volatile("" : "+v"(t)); return t; }
__device__ __forceinline__ float clamp30(float x) { return fminf(fmaxf(x, -30.f), 30.f); }
__device__ __forceinline__ float gate_ratio(float g1, float g2) { return (1.0f + __expf(-clamp30(g2))) * __builtin_amdgcn_rcpf(1.0f + __expf(-clamp30(g1))); }
__device__ __forceinline__ int mod_row(int tok) { return tok < TCTX ? 0 : 1 + ((tok - TCTX) >> 11); }

__device__ __forceinline__ void phase_setup(const Params& p, char* smem) {
  const int tid = tid_opaque(), bid = blockIdx.x, G = gridDim.x;
  {
    const size_t n4 = (size_t)T * 1024 / 4, half4 = (size_t)TCTX * 1024 / 4;
    float4* dst = (float4*)p.out;
    const float4* s0 = (const float4*)p.x_prompt;
    const float4* s1 = (const float4*)p.x_sample;
    for (size_t i = (size_t)bid * 256 + tid; i < n4; i += (size_t)G * 256) dst[i] = i < half4 ? s0[i] : s1[i - half4];
  }
  {
    float* lb = (float*)(p.ws + OFF_LB);
    for (int i = bid * 256 + tid; i < 2048; i += G * 256) {
      float v0 = p.hgrn_lb[i], v1 = p.hgrn_lb[2048 + i], v2 = p.hgrn_lb[4096 + i], v3 = p.hgrn_lb[6144 + i];
      float m = fmaxf(fmaxf(v0, v1), fmaxf(v2, v3));
      float e0 = expf(v0 - m), e1 = expf(v1 - m), e2 = expf(v2 - m), e3 = expf(v3 - m);
      float inv = 1.0f / (e0 + e1 + e2 + e3);
      lb[i] = 0.f;
      lb[2048 + i] = e1 * inv;
      lb[4096 + i] = (e1 + e2) * inv;
      lb[6144 + i] = (e1 + e2 + e3) * inv;
    }
  }
  {
    float* sm = (float*)smem;
    float* modb = (float*)(p.ws + OFF_MOD);
    __syncthreads();
    for (int i = tid; i < 5 * 1024; i += 256) {
      int v = i >> 10, k = i & 1023;
      float cv = v == 0 ? p.c_ctx[k] : p.c[(v - 1) * 1024 + k];
      sm[i] = siluf_(cv);
    }
    __syncthreads();
    float* part = sm + 5 * 1024;
    for (int item = bid; item < DEPTH * 96; item += G) {
      int l = item / 96, cg_ = item % 96;
      int col = cg_ * 64 + (tid & 63), kg = tid >> 6;
      const float* w = p.ada_w + (size_t)l * 1024 * 6144 + col;
      float a0 = 0, a1 = 0, a2 = 0, a3 = 0, a4 = 0;
      for (int k = kg * 256; k < kg * 256 + 256; ++k) {
        float wv = w[(size_t)k * 6144];
        a0 += sm[k] * wv; a1 += sm[1024 + k] * wv; a2 += sm[2048 + k] * wv; a3 += sm[3072 + k] * wv; a4 += sm[4096 + k] * wv;
      }
      __syncthreads();
      part[(kg * 5 + 0) * 64 + (tid & 63)] = a0; part[(kg * 5 + 1) * 64 + (tid & 63)] = a1; part[(kg * 5 + 2) * 64 + (tid & 63)] = a2;
      part[(kg * 5 + 3) * 64 + (tid & 63)] = a3; part[(kg * 5 + 4) * 64 + (tid & 63)] = a4;
      __syncthreads();
      for (int i = tid; i < 320; i += 256) {
        int v = i >> 6, cc = i & 63;
        float s = part[(0 * 5 + v) * 64 + cc] + part[(1 * 5 + v) * 64 + cc] + part[(2 * 5 + v) * 64 + cc] + part[(3 * 5 + v) * 64 + cc];
        int colo = cg_ * 64 + cc;
        modb[((size_t)l * 5 + v) * 6144 + colo] = s + p.ada_b[l * 6144 + colo];
      }
    }
    __syncthreads();
  }
  {
    float* tile = (float*)smem;
    const int n_in = 210 * 16, n_sso = 16 * 32, n_hgo = 16 * 16, n_out = 16 * 16, n_w13 = 88 * 16, n_w2 = 16 * 44;
    const int per_layer = n_in + n_sso + n_hgo + n_out + n_w13 + n_w2;
    for (int it = bid; it < per_layer * DEPTH; it += G) {
      int l = it / per_layer, r = it % per_layer;
      bf16_t* wt = (bf16_t*)(p.ws + OFF_WT) + (size_t)l * WT_LAYER;
      const float *src0 = nullptr, *src1 = nullptr;
      int K, Nsrc, nt, kt;
      bf16_t* dst;
      bool zero = false;
      if (r < n_in) {
        nt = r / 16; kt = r % 16; K = 1024; Nsrc = NPROJ;
        dst = wt + WT_IN;
        if (nt >= 209) zero = true;
        src0 = p.w_in + (size_t)l * 1024 * NPROJ + nt * 64; src1 = src0 + 32;
      } else if ((r -= n_in) < n_sso) {
        nt = r / 32; kt = r % 32; K = 2048; Nsrc = 1024; dst = wt + WT_SSO;
        src0 = p.w_ssd_out + (size_t)l * 2048 * 1024 + nt * 64; src1 = src0 + 32;
      } else if ((r -= n_sso) < n_hgo) {
        nt = r / 16; kt = r % 16; K = 1024; Nsrc = 1024; dst = wt + WT_HGO;
        src0 = p.w_hgrn_out + (size_t)l * 1024 * 1024 + nt * 64; src1 = src0 + 32;
      } else if ((r -= n_hgo) < n_out) {
        nt = r / 16; kt = r % 16; K = 1024; Nsrc = 1024; dst = wt + WT_OUT;
        src0 = p.w_out + (size_t)l * 1024 * 1024 + nt * 64; src1 = src0 + 32;
      } else if ((r -= n_out) < n_w13) {
        nt = r / 16; kt = r % 16; K = 1024; Nsrc = FFN; dst = wt + WT_W13;
        src0 = p.ffn_w1 + (size_t)l * 1024 * FFN + nt * 32; src1 = p.ffn_w3 + (size_t)l * 1024 * FFN + nt * 32;
      } else {
        r -= n_w13;
        nt = r / 44; kt = r % 44; K = 2816; Nsrc = 1024; dst = wt + WT_W2;
        src0 = p.ffn_w2 + (size_t)l * 2816 * 1024 + nt * 64; src1 = src0 + 32;
      }
      __syncthreads();
      {
        int c4 = (tid & 15) * 4;
        const float* s = c4 < 32 ? src0 + c4 : src1 + (c4 - 32);
#pragma unroll
        for (int i = 0; i < 4; ++i) {
          int kr = (tid >> 4) + i * 16;
          float4 v = zero ? make_float4(0.f, 0.f, 0.f, 0.f) : *(const float4*)(s + (size_t)(kt * 64 + kr) * Nsrc);
          tile[kr * 65 + c4 + 0] = v.x; tile[kr * 65 + c4 + 1] = v.y; tile[kr * 65 + c4 + 2] = v.z; tile[kr * 65 + c4 + 3] = v.w;
        }
      }
      __syncthreads();
#pragma unroll
      for (int i = 0; i < 2; ++i) {
        int cidx = tid + i * 256, n = cidx >> 3, kc = cidx & 7;
        uint4 o;
        o.x = pack2(tile[(kc * 8 + 0) * 65 + n], tile[(kc * 8 + 1) * 65 + n]);
        o.y = pack2(tile[(kc * 8 + 2) * 65 + n], tile[(kc * 8 + 3) * 65 + n]);
        o.z = pack2(tile[(kc * 8 + 4) * 65 + n], tile[(kc * 8 + 5) * 65 + n]);
        o.w = pack2(tile[(kc * 8 + 6) * 65 + n], tile[(kc * 8 + 7) * 65 + n]);
        *(uint4*)(dst + (size_t)(nt * 64 + n) * K + kt * 64 + kc * 8) = o;
      }
    }
    __syncthreads();
  }
}

__device__ __forceinline__ void phase_norm(const Params& p, int l, int which) {
  const int lane = tid_opaque() & 63, wv = tid_opaque() >> 6;
  const float* nw = (which == 0 ? p.norm_mix_w : p.norm_ffn_w) + l * 1024;
  const float* modb = (const float*)(p.ws + OFF_MOD) + (size_t)l * 5 * 6144;
  bf16_t* h = (bf16_t*)(p.ws + OFF_H);
  for (int row = blockIdx.x * 4 + wv; row < T; row += gridDim.x * 4) {
    const float* x = p.out + (size_t)row * 1024;
    const float* md = modb + (size_t)mod_row(row) * 6144 + (which == 0 ? 0 : 3072);
    float4 v[4];
    float ss = 0.f;
#pragma unroll
    for (int i = 0; i < 4; ++i) {
      v[i] = *(const float4*)(x + i * 256 + lane * 4);
      ss += v[i].x * v[i].x + v[i].y * v[i].y + v[i].z * v[i].z + v[i].w * v[i].w;
    }
#pragma unroll
    for (int o = 32; o >= 1; o >>= 1) ss += __shfl_xor(ss, o);
    float rstd = rsqrtf(ss * (1.0f / 1024.f) + 1e-6f);
#pragma unroll
    for (int i = 0; i < 4; ++i) {
      int c = i * 256 + lane * 4;
      float4 w = *(const float4*)(nw + c), sh = *(const float4*)(md + c), sc = *(const float4*)(md + 1024 + c);
      float a0 = v[i].x * rstd * w.x * (1.f + sc.x) + sh.x, a1 = v[i].y * rstd * w.y * (1.f + sc.y) + sh.y;
      float a2 = v[i].z * rstd * w.z * (1.f + sc.z) + sh.z, a3 = v[i].w * rstd * w.w * (1.f + sc.w) + sh.w;
      uint2 o2; o2.x = pack2(a0, a1); o2.y = pack2(a2, a3);
      *(uint2*)(h + (size_t)row * 1024 + c) = o2;
    }
  }
}

__device__ __forceinline__ void phase_final_norm(const Params& p) {
  const int lane = tid_opaque() & 63, wv = tid_opaque() >> 6;
  for (int row = blockIdx.x * 4 + wv; row < T; row += gridDim.x * 4) {
    float* x = p.out + (size_t)row * 1024;
    float4 v[4];
    float ss = 0.f;
#pragma unroll
    for (int i = 0; i < 4; ++i) {
      v[i] = *(const float4*)(x + i * 256 + lane * 4);
      ss += v[i].x * v[i].x + v[i].y * v[i].y + v[i].z * v[i].z + v[i].w * v[i].w;
    }
#pragma unroll
    for (int o = 32; o >= 1; o >>= 1) ss += __shfl_xor(ss, o);
    float rstd = rsqrtf(ss * (1.0f / 1024.f) + 1e-6f);
#pragma unroll
    for (int i = 0; i < 4; ++i) {
      int c = i * 256 + lane * 4;
      float4 w = *(const float4*)(p.norm_final_w + c);
      float4 o4 = make_float4(v[i].x * rstd * w.x, v[i].y * rstd * w.y, v[i].z * rstd * w.z, v[i].w * rstd * w.w);
      *(float4*)(x + c) = o4;
    }
  }
}

template <bool HASMID>
__device__ __forceinline__ void gemm_kloop2(f32x4 (&acc)[4][4], const bf16_t* __restrict__ Ag, int lda, const bf16_t* __restrict__ Bg,
                                            int ldb, int K, const bf16_t* __restrict__ Ag2, int lda2, const bf16_t* __restrict__ Bg2,
                                            int ldb2, int K2, char* smem, const bf16_t* __restrict__ gate0) {
  const int tid = tid_opaque(), lane = tid & 63, wid = tid >> 6;
  const int wr = wid >> 1, wc = wid & 1, fr = lane & 15, fq = lane >> 4;
  const int srow = tid >> 3, schunk = (tid & 7) ^ ((tid >> 4) & 7);
  const int rofs0 = (fq ^ ((fr >> 1) & 7)) * 16;
  const bf16_t* ap = Ag + (size_t)srow * lda + schunk * 8;
  const bf16_t* bp = Bg + (size_t)srow * ldb + schunk * 8;
  const int nk1 = K >> 6;
  const int nk = nk1 + (K2 >> 6);
  char* const sdst = smem + tid * 16;
#define GK_DMA(buf, t)                                                                                                   \
  {                                                                                                                      \
    _Pragma("unroll") for (int i = 0; i < 4; ++i) {                                                                      \
      __builtin_amdgcn_global_load_lds((const unsigned*)(ap + (size_t)i * 32 * lda + (size_t)(t) * 64),                  \
                                       (unsigned*)(sdst + (buf) * LDS_TILE + i * 4096), 16, 0, 0);                       \
      __builtin_amdgcn_global_load_lds((const unsigned*)(bp + (size_t)i * 32 * ldb + (size_t)(t) * 64),                  \
                                       (unsigned*)(sdst + (2 + (buf)) * LDS_TILE + i * 4096), 16, 0, 0);                 \
    }                                                                                                                    \
  }
  GK_DMA(0, 0);
  __syncthreads();
  for (int kt = 0; kt < nk; ++kt) {
    const int cur = kt & 1;
    if (kt + 1 < nk) {
      if (kt + 1 == nk1) {
        ap = Ag2 + (size_t)srow * lda2 + schunk * 8 - (size_t)nk1 * 64;
        bp = Bg2 + (size_t)srow * ldb2 + schunk * 8 - (size_t)nk1 * 64;
        lda = lda2; ldb = ldb2;
      }
      GK_DMA(cur ^ 1, kt + 1);
    }
    if (HASMID && kt == nk1) {
#pragma unroll
      for (int m = 0; m < 4; ++m)
#pragma unroll
        for (int n = 0; n < 4; ++n) {
          uint2 g1 = *(const uint2*)(gate0 + (size_t)(m * 16) * NPROJ_PAD + n * 16);
          uint2 g2 = *(const uint2*)(gate0 + (size_t)(m * 16) * NPROJ_PAD + 1024 + n * 16);
          acc[m][n][0] *= gate_ratio(bf2f((bf16_t)(g1.x & 0xffff)), bf2f((bf16_t)(g2.x & 0xffff)));
          acc[m][n][1] *= gate_ratio(bf2f((bf16_t)(g1.x >> 16)), bf2f((bf16_t)(g2.x >> 16)));
          acc[m][n][2] *= gate_ratio(bf2f((bf16_t)(g1.y & 0xffff)), bf2f((bf16_t)(g2.y & 0xffff)));
          acc[m][n][3] *= gate_ratio(bf2f((bf16_t)(g1.y >> 16)), bf2f((bf16_t)(g2.y >> 16)));
        }
    }
    const char* sa = smem + cur * LDS_TILE + (wr * 64 + fr) * LDS_ROW;
    const char* sb = smem + (2 + cur) * LDS_TILE + (wc * 64 + fr) * LDS_ROW;
#pragma unroll
    for (int kk = 0; kk < 2; ++kk) {
      bf16x8 af[4], bfv[4];
      __builtin_amdgcn_sched_barrier(0);
#pragma unroll
      for (int m = 0; m < 4; ++m) af[m] = *(const bf16x8*)(sa + m * 16 * LDS_ROW + (rofs0 ^ (kk * 64)));
#pragma unroll
      for (int n = 0; n < 4; ++n) bfv[n] = *(const bf16x8*)(sb + n * 16 * LDS_ROW + (rofs0 ^ (kk * 64)));
      __builtin_amdgcn_sched_barrier(0);
#pragma unroll
      for (int m = 0; m < 4; ++m)
#pragma unroll
        for (int n = 0; n < 4; ++n) acc[m][n] = __builtin_amdgcn_mfma_f32_16x16x32_bf16(bfv[n], af[m], acc[m][n], 0, 0, 0);
    }
    __builtin_amdgcn_sched_barrier(0);
    __syncthreads();
  }
#undef GK_DMA
}

__device__ __forceinline__ void gemm_kloop(f32x4 (&acc)[4][4], const bf16_t* __restrict__ Ag, int lda, const bf16_t* __restrict__ Bg,
                                           int ldb, int K, char* smem) {
  gemm_kloop2<false>(acc, Ag, lda, Bg, ldb, K, Ag, lda, Bg, ldb, 0, smem, Ag);
}

constexpr int BG_STAGE = 24576;
__device__ __forceinline__ int swz4(int x) { return (0x78 >> (2 * x)) & 3; }
template <bool HASMID>
__device__ __forceinline__ void gemm_kloop_big(f32x4 (&acc)[8][4], const bf16_t* __restrict__ Ag, int lda, const bf16_t* __restrict__ Bg,
                                               int ldb, int K, const bf16_t* __restrict__ Ag2, int lda2,
                                               const bf16_t* __restrict__ Bg2, int ldb2, int K2, char* smem,
                                               const bf16_t* __restrict__ gate0) {
  const int tid = tid_opaque(), lane = tid & 63, wid = tid >> 6;
  const int wr = wid >> 1, wc = wid & 1, fr = lane & 15, fq = lane >> 4;
  const int srow = tid >> 2, schunk = (tid & 3) ^ swz4((tid >> 4) & 3);
  const int rofs = (fq ^ swz4((fr >> 2) & 3)) * 16;
  const int nks1 = K >> 5;
  const int nks = nks1 + (K2 >> 5);
  const bf16_t* ap1 = Ag + (size_t)srow * lda + schunk * 8;
  const bf16_t* bp1 = Bg + (size_t)srow * ldb + schunk * 8;
  const bf16_t* ap2 = Ag2 + (size_t)srow * lda2 + schunk * 8 - (size_t)nks1 * 32;
  const bf16_t* bp2 = Bg2 + (size_t)srow * ldb2 + schunk * 8 - (size_t)nks1 * 32;
  char* const sdst = smem + tid * 16;
#define BG_DMA(slot, kk_)                                                                                                  \
  {                                                                                                                        \
    const int t_ = (kk_) < nks ? (kk_) : nks - 1;                                                                          \
    const bool s2_ = t_ >= nks1;                                                                                           \
    const bf16_t* ap_ = (s2_ ? ap2 : ap1) + (size_t)t_ * 32;                                                               \
    const bf16_t* bp_ = (s2_ ? bp2 : bp1) + (size_t)t_ * 32;                                                               \
    const size_t la_ = (size_t)64 * (s2_ ? lda2 : lda), lb_ = (size_t)64 * (s2_ ? ldb2 : ldb);                             \
    _Pragma("unroll") for (int i = 0; i < 4; ++i)                                                                          \
        __builtin_amdgcn_global_load_lds((const unsigned*)(ap_ + i * la_), (unsigned*)(sdst + (slot) * BG_STAGE + i * 4096), 16, 0, 0); \
    _Pragma("unroll") for (int i = 0; i < 2; ++i)                                                                          \
        __builtin_amdgcn_global_load_lds((const unsigned*)(bp_ + i * lb_), (unsigned*)(sdst + (slot) * BG_STAGE + 16384 + i * 4096), 16, 0, 0); \
  }
  BG_DMA(0, 0);
  BG_DMA(1, 1);
  int slot = 0;
  for (int ks = 0; ks < nks; ++ks) {
    asm volatile("s_waitcnt vmcnt(6)" ::: "memory");
    __builtin_amdgcn_s_barrier();
    asm volatile("" ::: "memory");
    const int nslot = slot == 0 ? 2 : slot - 1;
    BG_DMA(nslot, ks + 2);
    if (HASMID && ks == nks1) {
      int zofs = 0;
      asm volatile("" : "+v"(zofs));
      const bf16_t* gz = gate0 + zofs;
#pragma unroll
      for (int m = 0; m < 8; ++m)
#pragma unroll
        for (int n = 0; n < 4; ++n) {
          uint2 g1 = *(const uint2*)(gz + (size_t)(m * 16) * NPROJ_PAD + n * 16);
          uint2 g2 = *(const uint2*)(gz + (size_t)(m * 16) * NPROJ_PAD + 1024 + n * 16);
          acc[m][n][0] *= gate_ratio(bf2f((bf16_t)(g1.x & 0xffff)), bf2f((bf16_t)(g2.x & 0xffff)));
          acc[m][n][1] *= gate_ratio(bf2f((bf16_t)(g1.x >> 16)), bf2f((bf16_t)(g2.x >> 16)));
          acc[m][n][2] *= gate_ratio(bf2f((bf16_t)(g1.y & 0xffff)), bf2f((bf16_t)(g2.y & 0xffff)));
          acc[m][n][3] *= gate_ratio(bf2f((bf16_t)(g1.y >> 16)), bf2f((bf16_t)(g2.y >> 16)));
        }
    }
    const char* sa = smem + slot * BG_STAGE + (wr * 128 + fr) * 64 + rofs;
    const char* sb = smem + slot * BG_STAGE + 16384 + (wc * 64 + fr) * 64 + rofs;
    bf16x8 af[8], bfv[4];
    __builtin_amdgcn_sched_barrier(0);
#pragma unroll
    for (int n = 0; n < 4; ++n) bfv[n] = *(const bf16x8*)(sb + n * 16 * 64);
#pragma unroll
    for (int m = 0; m < 8; ++m) af[m] = *(const bf16x8*)(sa + m * 16 * 64);
    __builtin_amdgcn_sched_barrier(0);
    __builtin_amdgcn_s_setprio(1);
#pragma unroll
    for (int m = 0; m < 8; ++m)
#pragma unroll
      for (int n = 0; n < 4; ++n) acc[m][n] = __builtin_amdgcn_mfma_f32_16x16x32_bf16(bfv[n], af[m], acc[m][n], 0, 0, 0);
    __builtin_amdgcn_s_setprio(0);
    __builtin_amdgcn_sched_barrier(0);
    slot = slot == 2 ? 0 : slot + 1;
  }
  asm volatile("s_waitcnt vmcnt(0)" ::: "memory");
  __builtin_amdgcn_s_barrier();
  asm volatile("" ::: "memory");
#undef BG_DMA
}
__device__ __forceinline__ void gemm_kloop_big1(f32x4 (&acc)[8][4], const bf16_t* __restrict__ Ag, int lda, const bf16_t* __restrict__ Bg,
                                                int ldb, int K, char* smem) {
  gemm_kloop_big<false>(acc, Ag, lda, Bg, ldb, K, Ag, lda, Bg, ldb, 0, smem, Ag);
}
enum { G_PROJ = 0, G_MERGE = 1, G_OUT = 2, G_FFN1 = 3, G_FFN2 = 4 };

template <int MODE>
__device__ __forceinline__ void phase_gemm(const Params& p, int l, char* smem) {
  const int tid = tid_opaque(), lane = tid & 63, wid = tid >> 6;
  const int wr = wid >> 1, wc = wid & 1, fr = lane & 15, fq = lane >> 4;
  const bf16_t* wt = (const bf16_t*)(p.ws + OFF_WT) + (size_t)l * WT_LAYER;
  const bf16_t* hbuf = (const bf16_t*)(p.ws + OFF_H);
  bf16_t* proj = (bf16_t*)(p.ws + OFF_PROJ);
  bf16_t* hidden = (bf16_t*)(p.ws + OFF_PROJ);
  const float* modb = (const float*)(p.ws + OFF_MOD) + (size_t)l * 5 * 6144;
  constexpr int nM = T / 256;
  constexpr int nN = MODE == G_PROJ ? NPROJ_PAD / 128 : (MODE == G_FFN1 ? 5632 / 128 : 1024 / 128);
  for (int t = blockIdx.x; t < nM * nN; t += gridDim.x) {
    const int pm = t % nM, pn = t / nM;
    const int row0 = pm * 256, col0 = pn * 128;
    f32x4 acc[8][4];
#pragma unroll
    for (int m = 0; m < 8; ++m)
#pragma unroll
      for (int n = 0; n < 4; ++n) acc[m][n] = (f32x4){0.f, 0.f, 0.f, 0.f};
    if (MODE == G_PROJ) {
      gemm_kloop_big1(acc, hbuf + (size_t)row0 * 1024, 1024, wt + WT_IN + (size_t)col0 * 1024, 1024, 1024, smem);
      float* dtraw = (float*)(p.ws + OFF_DTRAW);
      char* stg = smem + wid * 18432;
#pragma unroll
      for (int m = 0; m < 8; ++m) {
        const int row = row0 + wr * 128 + m * 16 + fr;
#pragma unroll
        for (int n = 0; n < 4; ++n) {
          const int col = col0 + wc * 64 + n * 16 + fq * 4;
          u32x2 o; o[0] = pack2(acc[m][n][0], acc[m][n][1]); o[1] = pack2(acc[m][n][2], acc[m][n][3]);
          *(u32x2*)(stg + (m * 16 + fr) * 144 + (n * 16 + fq * 4) * 2) = o;
          if (col >= C_DT && col < C_DT + 64) *(f32x4*)(dtraw + (size_t)row * 64 + (col - C_DT)) = acc[m][n];
        }
      }
      {
        bf16_t* dst = proj + (size_t)(row0 + wr * 128 + (lane >> 3)) * NPROJ_PAD + col0 + wc * 64 + (lane & 7) * 8;
        const char* src = stg + (lane >> 3) * 144 + (lane & 7) * 16;
#pragma unroll
        for (int i = 0; i < 16; ++i) *(u32x4*)(dst + (size_t)(8 * i) * NPROJ_PAD) = *(const u32x4*)(src + 8 * i * 144);
      }
      asm volatile("s_waitcnt lgkmcnt(0)" ::: "memory");
      __builtin_amdgcn_s_barrier();
      asm volatile("" ::: "memory");
    } else if (MODE == G_MERGE) {
      const bf16_t* ybuf = (const bf16_t*)(p.ws + OFF_YBUF);
      const bf16_t* obuf = (const bf16_t*)(p.ws + OFF_OBUF);
      bf16_t* mbuf = (bf16_t*)(p.ws + OFF_MBUF);
      gemm_kloop_big<true>(acc, ybuf + (size_t)row0 * 2048, 2048, wt + WT_SSO + (size_t)col0 * 2048, 2048, 2048,
                        obuf + (size_t)row0 * 1024, 1024, wt + WT_HGO + (size_t)col0 * 1024, 1024, 1024, smem,
                        proj + (size_t)(row0 + wr * 128 + fr) * NPROJ_PAD + C_GATE + col0 + wc * 64 + fq * 4);
      char* stg = smem + wid * 18432;
#pragma unroll
      for (int m = 0; m < 8; ++m) {
        const int row = row0 + wr * 128 + m * 16 + fr;
#pragma unroll
        for (int n = 0; n < 4; ++n) {
          const int col = col0 + wc * 64 + n * 16 + fq * 4;
          uint2 g = *(const uint2*)(proj + (size_t)row * NPROJ_PAD + C_GATE + 1024 + col);
          float r0 = acc[m][n][0] * sigmoidf_(clamp30(bf2f((bf16_t)(g.x & 0xffff))));
          float r1 = acc[m][n][1] * sigmoidf_(clamp30(bf2f((bf16_t)(g.x >> 16))));
          float r2 = acc[m][n][2] * sigmoidf_(clamp30(bf2f((bf16_t)(g.y & 0xffff))));
          float r3 = acc[m][n][3] * sigmoidf_(clamp30(bf2f((bf16_t)(g.y >> 16))));
          u32x2 o; o[0] = pack2(r0, r1); o[1] = pack2(r2, r3);
          *(u32x2*)(stg + (m * 16 + fr) * 144 + (n * 16 + fq * 4) * 2) = o;
        }
      }
      {
        bf16_t* dst = mbuf + (size_t)(row0 + wr * 128 + (lane >> 3)) * 1024 + col0 + wc * 64 + (lane & 7) * 8;
        const char* src = stg + (lane >> 3) * 144 + (lane & 7) * 16;
#pragma unroll
        for (int i = 0; i < 16; ++i) *(u32x4*)(dst + (size_t)(8 * i) * 1024) = *(const u32x4*)(src + 8 * i * 144);
      }
      asm volatile("s_waitcnt lgkmcnt(0)" ::: "memory");
      __builtin_amdgcn_s_barrier();
      asm volatile("" ::: "memory");
    } else if (MODE == G_OUT || MODE == G_FFN2) {
      if (MODE == G_OUT) {
        const bf16_t* mbuf = (const bf16_t*)(p.ws + OFF_MBUF);
        gemm_kloop_big1(acc, mbuf + (size_t)row0 * 1024, 1024, wt + WT_OUT + (size_t)col0 * 1024, 1024, 1024, smem);
      } else {
        gemm_kloop_big1(acc, hidden + (size_t)row0 * FFN, FFN, wt + WT_W2 + (size_t)col0 * FFN, FFN, FFN, smem);
      }
      const float* gate = modb + (size_t)mod_row(row0) * 6144 + (MODE == G_OUT ? 2048 : 5120);
#pragma unroll
      for (int m = 0; m < 8; ++m) {
        const int row = row0 + wr * 128 + m * 16 + fr;
#pragma unroll
        for (int n = 0; n < 4; ++n) {
          const int col = col0 + wc * 64 + n * 16 + fq * 4;
          f32x4 g = *(const f32x4*)(gate + col);
          f32x4* xp = (f32x4*)(p.out + (size_t)row * 1024 + col);
          f32x4 xv = *xp;
          xv += g * acc[m][n];
          *xp = xv;
        }
      }
    } else {
      gemm_kloop_big1(acc, hbuf + (size_t)row0 * 1024, 1024, wt + WT_W13 + (size_t)col0 * 1024, 1024, 1024, smem);
      char* stg = smem + wid * 18432;
#pragma unroll
      for (int m = 0; m < 8; ++m) {
#pragma unroll
        for (int n = 0; n < 2; ++n) {
          float r[4];
#pragma unroll
          for (int j = 0; j < 4; ++j) r[j] = siluf_(acc[m][n][j]) * acc[m][n + 2][j];
          u32x2 o; o[0] = pack2(r[0], r[1]); o[1] = pack2(r[2], r[3]);
          *(u32x2*)(stg + (m * 16 + fr) * 80 + (n * 16 + fq * 4) * 2) = o;
        }
      }
      {
        bf16_t* dst = hidden + (size_t)(row0 + wr * 128 + (lane >> 2)) * FFN + (pn * 2 + wc) * 32 + (lane & 3) * 8;
        const char* src = stg + (lane >> 2) * 80 + (lane & 3) * 16;
#pragma unroll
        for (int i = 0; i < 8; ++i) *(u32x4*)(dst + (size_t)(16 * i) * FFN) = *(const u32x4*)(src + 16 * i * 80);
      }
      asm volatile("s_waitcnt lgkmcnt(0)" ::: "memory");
      __builtin_amdgcn_s_barrier();
      asm volatile("" ::: "memory");
    }
  }
}

__device__ __forceinline__ void phase_conv(const Params& p, int l) {
  const bf16_t* proj = (const bf16_t*)(p.ws + OFF_PROJ);
  bf16_t* xc = (bf16_t*)(p.ws + OFF_XC);
  const float* cw = p.ssd_conv_w + (size_t)l * 5 * 4096;
  const float* cb = p.ssd_conv_b + (size_t)l * 4096;
  for (int unit = blockIdx.x * 256 + tid_opaque(); unit < 512 * 256; unit += gridDim.x * 256) {
    const int ch = (unit & 511) * 8, sg = unit >> 9;
    const int t0 = sg * 64;
    int lo, hi;
    if (t0 < TCTX) { lo = t0 & ~255; hi = lo + 256; } else { lo = t0; hi = t0 + 64; }
    float w[5][8], bias[8];
#pragma unroll
    for (int k = 0; k < 5; ++k) {
      const f32x4 a = *(const f32x4*)(cw + k * 4096 + ch), b = *(const f32x4*)(cw + k * 4096 + ch + 4);
      w[k][0] = a[0]; w[k][1] = a[1]; w[k][2] = a[2]; w[k][3] = a[3]; w[k][4] = b[0]; w[k][5] = b[1]; w[k][6] = b[2]; w[k][7] = b[3];
    }
    {
      const f32x4 a = *(const f32x4*)(cb + ch), b = *(const f32x4*)(cb + ch + 4);
      bias[0] = a[0]; bias[1] = a[1]; bias[2] = a[2]; bias[3] = a[3]; bias[4] = b[0]; bias[5] = b[1]; bias[6] = b[2]; bias[7] = b[3];
    }
    const u32x4 zero4 = (u32x4){0u, 0u, 0u, 0u};
    u32x4 r0, r1, r2, r3, r4;
#define CV_LD(tt) (((tt) >= lo && (tt) < hi) ? *(const u32x4*)(proj + (size_t)(tt) * NPROJ_PAD + ch) : zero4)
    r0 = CV_LD(t0 - 2); r1 = CV_LD(t0 - 1); r2 = CV_LD(t0); r3 = CV_LD(t0 + 1);
#pragma unroll 4
    for (int t = t0; t < t0 + 64; ++t) {
      r4 = CV_LD(t + 2);
      float a[8];
#pragma unroll
      for (int j = 0; j < 8; ++j) a[j] = bias[j];
#define CV_ACC(R, k)                                                                                                     \
  _Pragma("unroll") for (int e = 0; e < 4; ++e) {                                                                        \
    a[2 * e] += w[k][2 * e] * bf2f((bf16_t)(R[e] & 0xffff));                                                             \
    a[2 * e + 1] += w[k][2 * e + 1] * bf2f((bf16_t)(R[e] >> 16));                                                        \
  }
      CV_ACC(r0, 0) CV_ACC(r1, 1) CV_ACC(r2, 2) CV_ACC(r3, 3) CV_ACC(r4, 4)
      u32x4 o;
      o[0] = pack2(siluf_(a[0]), siluf_(a[1])); o[1] = pack2(siluf_(a[2]), siluf_(a[3]));
      o[2] = pack2(siluf_(a[4]), siluf_(a[5])); o[3] = pack2(siluf_(a[6]), siluf_(a[7]));
      *(u32x4*)(xc + (size_t)t * 4096 + ch) = o;
      r0 = r1; r1 = r2; r2 = r3; r3 = r4;
    }
#undef CV_LD
#undef CV_ACC
  }
  const float* dtraw = (const float*)(p.ws + OFF_DTRAW);
  float* dt = (float*)(p.ws + OFF_DT);
  for (size_t i = (size_t)blockIdx.x * 256 + tid_opaque(); i < (size_t)T * 64; i += (size_t)gridDim.x * 256) {
    float v = dtraw[i] + p.ssd_dt_bias[l * 64 + (int)(i & 63)];
    dt[i] = v > 20.f ? v : log1pf(expf(v));
  }
}

__device__ __forceinline__ void ssd_naive_item(const Params& p, int l, int item, float* sm) {
  const int d = item & 1, h = (item >> 1) & 31, s = item >> 6;
  int tok0, L;
  if (s < 32) { tok0 = s * 256; L = 256; } else { tok0 = TCTX + (s - 32) * 2048; L = 2048; }
  const int tid = tid_opaque(), pp = tid >> 2, nq = tid & 3, g = h >> 2;
  float S[32];
  if (s < 32) {
#pragma unroll
    for (int i = 0; i < 32; ++i) S[i] = 0.f;
  } else {
    const float* st = p.state_ssm + ((((size_t)(s - 32) * 4 + l) * 2 + d) * 32 + h) * 8192 + pp * 128 + nq * 32;
#pragma unroll
    for (int i = 0; i < 32; ++i) S[i] = st[i];
  }
  const float a = -expf(p.ssd_a_log[l * 64 + d * 32 + h]);
  float* xs = sm; float* Bs = sm + 1024; float* Cs = Bs + 2048; float* dts = Cs + 2048;
  const bf16_t* xc = (const bf16_t*)(p.ws + OFF_XC);
  const float* dtb = (const float*)(p.ws + OFF_DT);
  float* ydir = (float*)(p.ws + (d == 0 ? OFF_YF : OFF_YB));
  for (int bt = 0; bt < L / 16; ++bt) {
    const int tb = d == 0 ? bt * 16 : L - 16 - bt * 16;
    __syncthreads();
    for (int e = tid; e < 16 * 320; e += 256) {
      const int tt = e / 320, c = e % 320;
      const size_t base = (size_t)(tok0 + tb + tt) * 4096;
      if (c < 64) xs[tt * 64 + c] = bf2f(xc[base + h * 64 + c]);
      else if (c < 192) Bs[tt * 128 + c - 64] = bf2f(xc[base + 2048 + g * 128 + c - 64]);
      else Cs[tt * 128 + c - 192] = bf2f(xc[base + 3072 + g * 128 + c - 192]);
    }
    if (tid < 16) dts[tid] = dtb[(size_t)(tok0 + tb + tid) * 64 + d * 32 + h];
    __syncthreads();
    for (int i2 = 0; i2 < 16; ++i2) {
      const int tt = d == 0 ? i2 : 15 - i2;
      const float dt = dts[tt], dA = expf(dt * a), xdt = xs[tt * 64 + pp] * dt;
      float acc = 0.f;
      const float* Bp = Bs + tt * 128 + nq * 32;
      const float* Cp = Cs + tt * 128 + nq * 32;
#pragma unroll
      for (int i = 0; i < 32; ++i) { S[i] = dA * S[i] + xdt * Bp[i]; acc += S[i] * Cp[i]; }
      acc += __shfl_xor(acc, 1); acc += __shfl_xor(acc, 2);
      if (nq == 0) ydir[(size_t)(tok0 + tb + tt) * 2048 + h * 64 + pp] = acc;
    }
  }
  if (s < 32) {
    float* o = p.out + OUT_SSM + ((((size_t)s * 4 + l) * 2 + d) * 32 + h) * 8192 + pp * 128 + nq * 32;
#pragma unroll
    for (int i = 0; i < 32; ++i) o[i] = S[i];
  }
}

__device__ __forceinline__ void hgrn_naive_item(const Params& p, int l, int item, float* sm) {
  const int d = item & 1, hd = (item >> 1) & 7, s = item >> 4;
  int tok0, L;
  if (s < 32) { tok0 = s * 256; L = 256; } else { tok0 = TCTX + (s - 32) * 2048; L = 2048; }
  const int tid = tid_opaque(), vv = tid >> 1, kh = tid & 1;
  float S[64];
  if (s < 32) {
#pragma unroll
    for (int i = 0; i < 64; ++i) S[i] = 0.f;
  } else {
    const float* st = p.state_hgrn + ((((size_t)(s - 32) * 4 + l) * 2 + d) * 8 + hd) * 16384 + (size_t)(kh * 64) * 128 + vv;
#pragma unroll
    for (int i = 0; i < 64; ++i) S[i] = st[(size_t)i * 128];
  }
  float* qs = sm; float* fs = sm + 2048; float* ks = sm + 4096; float* vs = sm + 6144;
  const bf16_t* proj = (const bf16_t*)(p.ws + OFF_PROJ);
  const float* lb = (const float*)(p.ws + OFF_LB) + (size_t)l * 2048 + d * 1024 + hd * 128;
  float* odir = (float*)(p.ws + (d == 0 ? OFF_OF : OFF_OB));
  for (int bt = 0; bt < L / 16; ++bt) {
    const int tb = d == 0 ? bt * 16 : L - 16 - bt * 16;
    __syncthreads();
    for (int e = tid; e < 16 * 128; e += 256) {
      const int tt = e >> 7, c = e & 127;
      const size_t base = (size_t)(tok0 + tb + tt) * NPROJ_PAD;
      const float q = bf2f(proj[base + C_HQ + hd * 128 + c]);
      const float u = bf2f(proj[base + C_HF + d * 1024 + hd * 128 + c]);
      const float lbv = lb[c];
      const float sg = sigmoidf_(u);
      qs[e] = siluf_(q);
      fs[e] = lbv + (1.f - lbv) * sg;
      ks[e] = (1.f - lbv) * (1.f - sg);
      vs[e] = bf2f(proj[base + C_HI + hd * 128 + c]);
    }
    __syncthreads();
    for (int i2 = 0; i2 < 16; ++i2) {
      const int tt = d == 0 ? i2 : 15 - i2;
      const float vval = vs[tt * 128 + vv];
      const float* fp = fs + tt * 128 + kh * 64;
      const float* kp = ks + tt * 128 + kh * 64;
      const float* qp = qs + tt * 128 + kh * 64;
      float acc = 0.f;
#pragma unroll
      for (int i = 0; i < 64; ++i) { S[i] = fp[i] * S[i] + kp[i] * vval; acc += S[i] * qp[i]; }
      acc += __shfl_xor(acc, 1);
      if (kh == 0) odir[(size_t)(tok0 + tb + tt) * 1024 + hd * 128 + vv] = acc;
    }
  }
  if (s < 32) {
    float* o = p.out + OUT_HGRN + ((((size_t)s * 4 + l) * 2 + d) * 8 + hd) * 16384 + (size_t)(kh * 64) * 128 + vv;
#pragma unroll
    for (int i = 0; i < 64; ++i) o[(size_t)i * 128] = S[i];
  }
}


constexpr int HG_ROW = 272;
constexpr int HG_IMG = 16 * HG_ROW;
constexpr int HG_BUF = 4 * HG_IMG + 512;
__device__ __forceinline__ void hgrn_chunk_item(const Params& p, int l, int item, char* smem) {
  const int d = item & 1, hd = (item >> 1) & 7, s = item >> 4;
  int tok0, L;
  if (s < 32) { tok0 = s * 256; L = 256; } else { tok0 = TCTX + (s - 32) * 2048; L = 2048; }
  const int tid = tid_opaque(), lane = tid & 63, w = tid >> 6, fr = lane & 15, fq = lane >> 4;
  const int ch = tid & 127, half = tid >> 7;
  f32x4 S[8][2];
  if (s < 32) {
#pragma unroll
    for (int kt = 0; kt < 8; ++kt) { S[kt][0] = (f32x4){0.f, 0.f, 0.f, 0.f}; S[kt][1] = (f32x4){0.f, 0.f, 0.f, 0.f}; }
  } else {
    const float* st = p.state_hgrn + ((((size_t)(s - 32) * 4 + l) * 2 + d) * 8 + hd) * 16384;
#pragma unroll
    for (int kt = 0; kt < 8; ++kt)
#pragma unroll
      for (int vt = 0; vt < 2; ++vt)
#pragma unroll
        for (int jj = 0; jj < 4; ++jj) S[kt][vt][jj] = st[(size_t)(16 * kt + fq * 4 + jj) * 128 + 32 * w + 16 * vt + fr];
  }
  const float lbv = ((const float*)(p.ws + OFF_LB))[(size_t)l * 2048 + d * 1024 + hd * 128 + ch];
  const bf16_t* proj = (const bf16_t*)(p.ws + OFF_PROJ);
  float* odir = (float*)(p.ws + (d == 0 ? OFF_OF : OFF_OB));
  float* xch = (float*)(smem + 2 * HG_BUF);
  const int nch = L >> 4;
  bf16_t rq[8], ru[8], rv[8];
  __syncthreads();
  {
#pragma unroll
    for (int i = 0; i < 8; ++i) {
      const int pos = 8 * half + i;
      const size_t tk = (size_t)(d == 0 ? tok0 + pos : tok0 + L - 1 - pos) * NPROJ_PAD;
      rq[i] = proj[tk + C_HQ + hd * 128 + ch];
      ru[i] = proj[tk + C_HF + d * 1024 + hd * 128 + ch];
      rv[i] = proj[tk + C_HI + hd * 128 + ch];
    }
  }
  for (int c = 0; c < nch; ++c) {
    char* buf = smem + (c & 1) * HG_BUF;
    float* xc_ = xch + (c & 1) * 256;
    float fv[8], kk[8], qs[8];
    float loc = 1.f;
#pragma unroll
    for (int i = 0; i < 8; ++i) {
      const float u = bf2f(ru[i]);
      const float sg = sigmoidf_(u);
      fv[i] = lbv + (1.f - lbv) * sg;
      kk[i] = (1.f - lbv) * (1.f - sg);
      qs[i] = siluf_(bf2f(rq[i]));
      loc *= fv[i];
      *(bf16_t*)(buf + 3 * HG_IMG + (8 * half + i) * HG_ROW + ch * 2) = rv[i];
    }
    xc_[half * 128 + ch] = loc;
    if (c + 1 < nch) {
#pragma unroll
      for (int i = 0; i < 8; ++i) {
        const int pos = (c + 1) * 16 + 8 * half + i;
        const size_t tk = (size_t)(d == 0 ? tok0 + pos : tok0 + L - 1 - pos) * NPROJ_PAD;
        rq[i] = proj[tk + C_HQ + hd * 128 + ch];
        ru[i] = proj[tk + C_HF + d * 1024 + hd * 128 + ch];
        rv[i] = proj[tk + C_HI + hd * 128 + ch];
      }
    }
    __syncthreads();
    {
      const float other = xc_[(half ^ 1) * 128 + ch];
      float P = half ? other : 1.f;
      float sfx = half ? 1.f : other;
      float suf[8];
#pragma unroll
      for (int i = 7; i >= 0; --i) { suf[i] = sfx; sfx *= fv[i]; }
#pragma unroll
      for (int i = 0; i < 8; ++i) {
        P *= fv[i];
        const int off = (8 * half + i) * HG_ROW + ch * 2;
        *(bf16_t*)(buf + off) = f2bf(qs[i] * P);
        *(bf16_t*)(buf + HG_IMG + off) = f2bf(kk[i] * __builtin_amdgcn_rcpf(fmaxf(P, 1e-30f)));
        *(bf16_t*)(buf + 2 * HG_IMG + off) = f2bf(kk[i] * suf[i]);
      }
      if (half) ((float*)(buf + 4 * HG_IMG))[ch] = P;
    }
    __syncthreads();
    const char* qtI = buf;
    const char* ktI = buf + HG_IMG;
    const float* dec = (const float*)(buf + 4 * HG_IMG);
    f32x4 at = (f32x4){0.f, 0.f, 0.f, 0.f};
#pragma unroll
    for (int ks = 0; ks < 4; ++ks) {
      bf16x8 a = *(const bf16x8*)(ktI + fr * HG_ROW + (32 * ks + fq * 8) * 2);
      bf16x8 b = *(const bf16x8*)(qtI + fr * HG_ROW + (32 * ks + fq * 8) * 2);
      at = __builtin_amdgcn_mfma_f32_16x16x32_bf16(a, b, at, 0, 0, 0);
    }
    s16x4 Pm;
    {
      u32x2 pk;
      pk[0] = pack2((fq * 4 + 0 <= fr) ? at[0] : 0.f, (fq * 4 + 1 <= fr) ? at[1] : 0.f);
      pk[1] = pack2((fq * 4 + 2 <= fr) ? at[2] : 0.f, (fq * 4 + 3 <= fr) ? at[3] : 0.f);
      Pm = __builtin_bit_cast(s16x4, pk);
    }
    const unsigned ldsb = (unsigned)(size_t)buf;
    const unsigned vaddr = ldsb + 3 * HG_IMG + (4 * fq + (fr >> 2)) * HG_ROW + (32 * w + 4 * (fr & 3)) * 2;
    const unsigned kaddr = ldsb + 2 * HG_IMG + (4 * fq + (fr >> 2)) * HG_ROW + (4 * (fr & 3)) * 2;
    s16x4 vf0, vf1, kf0, kf1, kf2, kf3, kf4, kf5, kf6, kf7;
    asm volatile(
        "ds_read_b64_tr_b16 %0, %10\n\t"
        "ds_read_b64_tr_b16 %1, %10 offset:32\n\t"
        "ds_read_b64_tr_b16 %2, %11\n\t"
        "ds_read_b64_tr_b16 %3, %11 offset:32\n\t"
        "ds_read_b64_tr_b16 %4, %11 offset:64\n\t"
        "ds_read_b64_tr_b16 %5, %11 offset:96\n\t"
        "ds_read_b64_tr_b16 %6, %11 offset:128\n\t"
        "ds_read_b64_tr_b16 %7, %11 offset:160\n\t"
        "ds_read_b64_tr_b16 %8, %11 offset:192\n\t"
        "ds_read_b64_tr_b16 %9, %11 offset:224\n\t"
        "s_waitcnt lgkmcnt(0)"
        : "=&v"(vf0), "=&v"(vf1), "=&v"(kf0), "=&v"(kf1), "=&v"(kf2), "=&v"(kf3), "=&v"(kf4), "=&v"(kf5), "=&v"(kf6), "=&v"(kf7)
        : "v"(vaddr), "v"(kaddr)
        : "memory");
    f32x4 o0 = __builtin_amdgcn_mfma_f32_16x16x16bf16_1k(Pm, vf0, (f32x4){0.f, 0.f, 0.f, 0.f}, 0, 0, 0);
    f32x4 o1 = __builtin_amdgcn_mfma_f32_16x16x16bf16_1k(Pm, vf1, (f32x4){0.f, 0.f, 0.f, 0.f}, 0, 0, 0);
#pragma unroll
    for (int ks = 0; ks < 4; ++ks) {
      u32x2 qa = *(const u32x2*)(qtI + fr * HG_ROW + (32 * ks + 4 * fq) * 2);
      u32x2 qb = *(const u32x2*)(qtI + fr * HG_ROW + (32 * ks + 16 + 4 * fq) * 2);
      u32x4 aa; aa[0] = qa[0]; aa[1] = qa[1]; aa[2] = qb[0]; aa[3] = qb[1];
      const bf16x8 A = __builtin_bit_cast(bf16x8, aa);
      u32x4 b0, b1;
      b0[0] = pack2(S[2 * ks][0][0], S[2 * ks][0][1]); b0[1] = pack2(S[2 * ks][0][2], S[2 * ks][0][3]);
      b0[2] = pack2(S[2 * ks + 1][0][0], S[2 * ks + 1][0][1]); b0[3] = pack2(S[2 * ks + 1][0][2], S[2 * ks + 1][0][3]);
      b1[0] = pack2(S[2 * ks][1][0], S[2 * ks][1][1]); b1[1] = pack2(S[2 * ks][1][2], S[2 * ks][1][3]);
      b1[2] = pack2(S[2 * ks + 1][1][0], S[2 * ks + 1][1][1]); b1[3] = pack2(S[2 * ks + 1][1][2], S[2 * ks + 1][1][3]);
      o0 = __builtin_amdgcn_mfma_f32_16x16x32_bf16(A, __builtin_bit_cast(bf16x8, b0), o0, 0, 0, 0);
      o1 = __builtin_amdgcn_mfma_f32_16x16x32_bf16(A, __builtin_bit_cast(bf16x8, b1), o1, 0, 0, 0);
    }
#pragma unroll
    for (int jj = 0; jj < 4; ++jj) {
      const int pos = c * 16 + fq * 4 + jj;
      const size_t tk = (size_t)(d == 0 ? tok0 + pos : tok0 + L - 1 - pos);
      odir[tk * 1024 + hd * 128 + 32 * w + fr] = o0[jj];
      odir[tk * 1024 + hd * 128 + 32 * w + 16 + fr] = o1[jj];
    }
    const s16x4 kfs[8] = {kf0, kf1, kf2, kf3, kf4, kf5, kf6, kf7};
#pragma unroll
    for (int kt = 0; kt < 8; ++kt) {
      const f32x4 dv = *(const f32x4*)(dec + 16 * kt + fq * 4);
      S[kt][0] = __builtin_amdgcn_mfma_f32_16x16x16bf16_1k(kfs[kt], vf0, S[kt][0] * dv, 0, 0, 0);
      S[kt][1] = __builtin_amdgcn_mfma_f32_16x16x16bf16_1k(kfs[kt], vf1, S[kt][1] * dv, 0, 0, 0);
    }
  }
  if (s < 32) {
    float* o = p.out + OUT_HGRN + ((((size_t)s * 4 + l) * 2 + d) * 8 + hd) * 16384;
#pragma unroll
    for (int kt = 0; kt < 8; ++kt)
#pragma unroll
      for (int vt = 0; vt < 2; ++vt)
#pragma unroll
        for (int jj = 0; jj < 4; ++jj) o[(size_t)(16 * kt + fq * 4 + jj) * 128 + 32 * w + 16 * vt + fr] = S[kt][vt][jj];
  }
}


constexpr size_t OFF_SST = OFF_YF;
constexpr size_t OFF_CS = OFF_YB;
constexpr int SS_BROW = 272, SS_XROW = 144;
constexpr int SS_R0 = 128 * SS_BROW;
constexpr int SS_R1 = 128 * SS_XROW;

template <int OFF>
__device__ __forceinline__ s16x4 tr_read(unsigned addr) {
  s16x4 r;
  asm volatile("ds_read_b64_tr_b16 %0, %1 offset:%2" : "=v"(r) : "v"(addr), "i"(OFF) : "memory");
  return r;
}
__device__ __forceinline__ bf16x8 cat8(s16x4 a, s16x4 b) {
  bf16x8 r;
  r[0] = a[0]; r[1] = a[1]; r[2] = a[2]; r[3] = a[3]; r[4] = b[0]; r[5] = b[1]; r[6] = b[2]; r[7] = b[3];
  return r;
}
#define TR_WAIT12(a, b, c, d, e, f, g, h, i, j, k, l_)                                                                            \
  asm volatile("s_waitcnt lgkmcnt(0)" : "+v"(a), "+v"(b), "+v"(c), "+v"(d), "+v"(e), "+v"(f), "+v"(g), "+v"(h), "+v"(i), "+v"(j), \
               "+v"(k), "+v"(l_)::"memory")
#define TR_WAIT8(a, b, c, d, e, f, g, h) \
  asm volatile("s_waitcnt lgkmcnt(0)" : "+v"(a), "+v"(b), "+v"(c), "+v"(d), "+v"(e), "+v"(f), "+v"(g), "+v"(h)::"memory")

template <int KS>
__device__ __forceinline__ void ssd_p1_kstep(f32x4 (&acc)[2][4], unsigned abase, unsigned xbase) {
  s16x4 a00, a01, a10, a11, b00, b01, b10, b11, b20, b21, b30, b31;
  asm volatile(
      "ds_read_b64_tr_b16 %0, %12 offset:%14\n\t"
      "ds_read_b64_tr_b16 %1, %12 offset:%15\n\t"
      "ds_read_b64_tr_b16 %2, %12 offset:%16\n\t"
      "ds_read_b64_tr_b16 %3, %12 offset:%17\n\t"
      "ds_read_b64_tr_b16 %4, %13 offset:%18\n\t"
      "ds_read_b64_tr_b16 %5, %13 offset:%19\n\t"
      "ds_read_b64_tr_b16 %6, %13 offset:%20\n\t"
      "ds_read_b64_tr_b16 %7, %13 offset:%21\n\t"
      "ds_read_b64_tr_b16 %8, %13 offset:%22\n\t"
      "ds_read_b64_tr_b16 %9, %13 offset:%23\n\t"
      "ds_read_b64_tr_b16 %10, %13 offset:%24\n\t"
      "ds_read_b64_tr_b16 %11, %13 offset:%25\n\t"
      "s_waitcnt lgkmcnt(0)"
      : "=&v"(a00), "=&v"(a01), "=&v"(a10), "=&v"(a11), "=&v"(b00), "=&v"(b01), "=&v"(b10), "=&v"(b11), "=&v"(b20), "=&v"(b21),
        "=&v"(b30), "=&v"(b31)
      : "v"(abase), "v"(xbase), "i"(KS * 32 * SS_BROW), "i"(KS * 32 * SS_BROW + 4 * SS_BROW), "i"(KS * 32 * SS_BROW + 32),
        "i"(KS * 32 * SS_BROW + 4 * SS_BROW + 32), "i"(KS * 32 * SS_XROW), "i"(KS * 32 * SS_XROW + 4 * SS_XROW),
        "i"(KS * 32 * SS_XROW + 32), "i"(KS * 32 * SS_XROW + 4 * SS_XROW + 32), "i"(KS * 32 * SS_XROW + 64),
        "i"(KS * 32 * SS_XROW + 4 * SS_XROW + 64), "i"(KS * 32 * SS_XROW + 96), "i"(KS * 32 * SS_XROW + 4 * SS_XROW + 96)
      : "memory");
  const bf16x8 A0 = cat8(a00, a01), A1 = cat8(a10, a11);
  const bf16x8 B0 = cat8(b00, b01), B1 = cat8(b10, b11), B2 = cat8(b20, b21), B3 = cat8(b30, b31);
  acc[0][0] = __builtin_amdgcn_mfma_f32_16x16x32_bf16(A0, B0, acc[0][0], 0, 0, 0);
  acc[0][1] = __builtin_amdgcn_mfma_f32_16x16x32_bf16(A0, B1, acc[0][1], 0, 0, 0);
  acc[0][2] = __builtin_amdgcn_mfma_f32_16x16x32_bf16(A0, B2, acc[0][2], 0, 0, 0);
  acc[0][3] = __builtin_amdgcn_mfma_f32_16x16x32_bf16(A0, B3, acc[0][3], 0, 0, 0);
  acc[1][0] = __builtin_amdgcn_mfma_f32_16x16x32_bf16(A1, B0, acc[1][0], 0, 0, 0);
  acc[1][1] = __builtin_amdgcn_mfma_f32_16x16x32_bf16(A1, B1, acc[1][1], 0, 0, 0);
  acc[1][2] = __builtin_amdgcn_mfma_f32_16x16x32_bf16(A1, B2, acc[1][2], 0, 0, 0);
  acc[1][3] = __builtin_amdgcn_mfma_f32_16x16x32_bf16(A1, B3, acc[1][3], 0, 0, 0);
}

__device__ __forceinline__ void ssd_pass1_item(const Params& p, int l, int item, char* smem) {
  const int d = item & 1, h = (item >> 1) & 31, s = item >> 6, g = h >> 2;
  const int nc = s < 32 ? 2 : 16, cg0 = s < 32 ? 2 * s : 64 + 16 * (s - 32);
  const int tid = tid_opaque(), lane = tid & 63, w = tid >> 6, fr = lane & 15, fq = lane >> 4;
  const float a = -expf(p.ssd_a_log[l * 64 + d * 32 + h]);
  f32x4 acc[2][4];
  if (s < 32) {
#pragma unroll
    for (int i = 0; i < 2; ++i)
#pragma unroll
      for (int j = 0; j < 4; ++j) acc[i][j] = (f32x4){0.f, 0.f, 0.f, 0.f};
  } else {
    const float* st = p.state_ssm + ((((size_t)(s - 32) * 4 + l) * 2 + d) * 32 + h) * 8192;
#pragma unroll
    for (int i = 0; i < 2; ++i)
#pragma unroll
      for (int j = 0; j < 4; ++j) acc[i][j] = *(const f32x4*)(st + (size_t)(16 * j + fr) * 128 + 32 * w + 16 * i + 4 * fq);
  }
  const bf16_t* xc = (const bf16_t*)(p.ws + OFF_XC);
  const float* dtb = (const float*)(p.ws + OFF_DT);
  float* csb = (float*)(p.ws + OFF_CS);
  bf16_t* sst = (bf16_t*)(p.ws + OFF_SST);
  float* wgt = (float*)(smem + SS_R0 + SS_R1);
  u32x4 pb[8], px[4];
  float dt0, dt1;
  {
    const int c = d == 0 ? 0 : nc - 1;
    const size_t tb = (size_t)(cg0 + c) * 128;
#pragma unroll
    for (int i = 0; i < 8; ++i) { const int q = tid + 256 * i; pb[i] = *(const u32x4*)(xc + (tb + (q >> 4)) * 4096 + 2048 + g * 128 + (q & 15) * 8); }
#pragma unroll
    for (int i = 0; i < 4; ++i) { const int q = tid + 256 * i; px[i] = *(const u32x4*)(xc + (tb + (q >> 3)) * 4096 + h * 64 + (q & 7) * 8); }
    dt0 = dtb[(tb + 2 * lane) * 64 + d * 32 + h];
    dt1 = dtb[(tb + 2 * lane + 1) * 64 + d * 32 + h];
  }
  const unsigned ldsb = (unsigned)(size_t)smem;
  const unsigned abase = ldsb + (8 * fq + (fr >> 2)) * SS_BROW + (32 * w + 4 * (fr & 3)) * 2;
  const unsigned xbase = ldsb + SS_R0 + (8 * fq + (fr >> 2)) * SS_XROW + (4 * (fr & 3)) * 2;
  for (int cc = 0; cc < nc; ++cc) {
    const int c = d == 0 ? cc : nc - 1 - cc, par = cc & 1;
    const size_t cgl = cg0 + c, tb = cgl * 128;
    {
      bf16_t* so = sst + ((cgl * 32 + h) * 2 + d) * 8192;
#pragma unroll
      for (int i = 0; i < 2; ++i)
#pragma unroll
        for (int j = 0; j < 4; ++j) {
          u32x2 o; o[0] = pack2(acc[i][j][0], acc[i][j][1]); o[1] = pack2(acc[i][j][2], acc[i][j][3]);
          *(u32x2*)(so + (size_t)(16 * j + fr) * 128 + 32 * w + 16 * i + 4 * fq) = o;
        }
    }
    if (w == 0) {
      const float v0 = dt0 * a, v1 = dt1 * a, sloc = v0 + v1;
      float incl = sloc;
#pragma unroll
      for (int off = 1; off < 64; off <<= 1) { const float t = __shfl_up(incl, off); if (lane >= off) incl += t; }
      const float excl = incl - sloc, c0 = excl + v0, tot = __shfl(incl, 63);
      float cs0, cs1, wg0, wg1;
      if (d == 0) { cs0 = c0; cs1 = incl; wg0 = dt0 * __expf(tot - c0); wg1 = dt1 * __expf(tot - incl); }
      else { cs0 = tot - excl; cs1 = tot - c0; wg0 = dt0 * __expf(excl); wg1 = dt1 * __expf(c0); }
      csb[(tb + 2 * lane) * 64 + d * 32 + h] = cs0;
      csb[(tb + 2 * lane + 1) * 64 + d * 32 + h] = cs1;
      wgt[par * 128 + 2 * lane] = wg0;
      wgt[par * 128 + 2 * lane + 1] = wg1;
      if (lane == 0) wgt[256 + par] = __expf(tot);
    }
    __syncthreads();
#pragma unroll
    for (int i = 0; i < 8; ++i) { const int q = tid + 256 * i; *(u32x4*)(smem + (q >> 4) * SS_BROW + (q & 15) * 16) = pb[i]; }
#pragma unroll
    for (int i = 0; i < 4; ++i) {
      const int q = tid + 256 * i, row = q >> 3;
      const float wv = wgt[par * 128 + row];
      u32x4 o;
#pragma unroll
      for (int e = 0; e < 4; ++e) o[e] = pack2(bf2f((bf16_t)(px[i][e] & 0xffff)) * wv, bf2f((bf16_t)(px[i][e] >> 16)) * wv);
      *(u32x4*)(smem + SS_R0 + row * SS_XROW + (q & 7) * 16) = o;
    }
    if (cc + 1 < nc) {
      const int cn = d == 0 ? cc + 1 : nc - 2 - cc;
      const size_t tbn = (size_t)(cg0 + cn) * 128;
#pragma unroll
      for (int i = 0; i < 8; ++i) { const int q = tid + 256 * i; pb[i] = *(const u32x4*)(xc + (tbn + (q >> 4)) * 4096 + 2048 + g * 128 + (q & 15) * 8); }
#pragma unroll
      for (int i = 0; i < 4; ++i) { const int q = tid + 256 * i; px[i] = *(const u32x4*)(xc + (tbn + (q >> 3)) * 4096 + h * 64 + (q & 7) * 8); }
      dt0 = dtb[(tbn + 2 * lane) * 64 + d * 32 + h];
      dt1 = dtb[(tbn + 2 * lane + 1) * 64 + d * 32 + h];
    }
    __syncthreads();
    const float dec = wgt[256 + par];
#pragma unroll
    for (int i = 0; i < 2; ++i)
#pragma unroll
      for (int j = 0; j < 4; ++j) acc[i][j] *= dec;
    ssd_p1_kstep<0>(acc, abase, xbase);
    ssd_p1_kstep<1>(acc, abase, xbase);
    ssd_p1_kstep<2>(acc, abase, xbase);
    ssd_p1_kstep<3>(acc, abase, xbase);
  }
  if (s < 32) {
    float* o = p.out + OUT_SSM + ((((size_t)s * 4 + l) * 2 + d) * 32 + h) * 8192;
#pragma unroll
    for (int i = 0; i < 2; ++i)
#pragma unroll
      for (int j = 0; j < 4; ++j) *(f32x4*)(o + (size_t)(16 * j + fr) * 128 + 32 * w + 16 * i + 4 * fq) = acc[i][j];
  }
  __syncthreads();
}

template <int KS>
__device__ __forceinline__ void ssd_p2_wx_kstep(f32x4 (&y)[4], const char* wrow, unsigned xbase) {
  s16x4 b00, b01, b10, b11, b20, b21, b30, b31;
  const bf16x8 A = *(const bf16x8*)(wrow + KS * 64);
  asm volatile(
      "ds_read_b64_tr_b16 %0, %8 offset:%9\n\t"
      "ds_read_b64_tr_b16 %1, %8 offset:%10\n\t"
      "ds_read_b64_tr_b16 %2, %8 offset:%11\n\t"
      "ds_read_b64_tr_b16 %3, %8 offset:%12\n\t"
      "ds_read_b64_tr_b16 %4, %8 offset:%13\n\t"
      "ds_read_b64_tr_b16 %5, %8 offset:%14\n\t"
      "ds_read_b64_tr_b16 %6, %8 offset:%15\n\t"
      "ds_read_b64_tr_b16 %7, %8 offset:%16\n\t"
      "s_waitcnt lgkmcnt(0)"
      : "=&v"(b00), "=&v"(b01), "=&v"(b10), "=&v"(b11), "=&v"(b20), "=&v"(b21), "=&v"(b30), "=&v"(b31)
      : "v"(xbase), "i"(KS * 32 * SS_XROW), "i"(KS * 32 * SS_XROW + 4 * SS_XROW), "i"(KS * 32 * SS_XROW + 32),
        "i"(KS * 32 * SS_XROW + 4 * SS_XROW + 32), "i"(KS * 32 * SS_XROW + 64), "i"(KS * 32 * SS_XROW + 4 * SS_XROW + 64),
        "i"(KS * 32 * SS_XROW + 96), "i"(KS * 32 * SS_XROW + 4 * SS_XROW + 96)
      : "memory");
  y[0] = __builtin_amdgcn_mfma_f32_16x16x32_bf16(A, cat8(b00, b01), y[0], 0, 0, 0);
  y[1] = __builtin_amdgcn_mfma_f32_16x16x32_bf16(A, cat8(b10, b11), y[1], 0, 0, 0);
  y[2] = __builtin_amdgcn_mfma_f32_16x16x32_bf16(A, cat8(b20, b21), y[2], 0, 0, 0);
  y[3] = __builtin_amdgcn_mfma_f32_16x16x32_bf16(A, cat8(b30, b31), y[3], 0, 0, 0);
}

__device__ __forceinline__ void ssd_pass2_item(const Params& p, int l, int item, char* smem) {
  const int hf = item & 1, g = (item >> 1) & 7, cg = item >> 4;
  const size_t tb = (size_t)cg * 128;
  const int tid = tid_opaque(), lane = tid & 63, w = tid >> 6, fr = lane & 15, fq = lane >> 4;
  const int i0 = 64 * hf + 16 * w;
  const bf16_t* xc = (const bf16_t*)(p.ws + OFF_XC);
  const bf16_t* proj = (const bf16_t*)(p.ws + OFF_PROJ);
  const float* dtb = (const float*)(p.ws + OFF_DT);
  const float* csb = (const float*)(p.ws + OFF_CS);
  const bf16_t* sst = (const bf16_t*)(p.ws + OFF_SST);
  bf16_t* ybuf = (bf16_t*)(p.ws + OFF_YBUF);
  float* arr = (float*)(smem + SS_R0 + SS_R1);
  __syncthreads();
  bf16x8 cfr[4];
#pragma unroll
  for (int ks = 0; ks < 4; ++ks) cfr[ks] = *(const bf16x8*)(xc + (tb + i0 + fr) * 4096 + 3072 + g * 128 + 32 * ks + 8 * fq);
#pragma unroll
  for (int i = 0; i < 8; ++i) {
    const int idx = tid + 256 * i, hh = idx >> 9, a = (idx >> 7) & 3, j = idx & 127;
    const float* src = (a < 2 ? csb : dtb) + (tb + j) * 64 + (a & 1) * 32 + 4 * g + hh;
    arr[idx] = *src;
  }
#pragma unroll
  for (int i = 0; i < 8; ++i) {
    const int q = tid + 256 * i;
    *(u32x4*)(smem + (q >> 4) * SS_BROW + (q & 15) * 16) = *(const u32x4*)(xc + (tb + (q >> 4)) * 4096 + 2048 + g * 128 + (q & 15) * 8);
  }
  __syncthreads();
  f32x4 cb[8];
#pragma unroll
  for (int jt = 0; jt < 8; ++jt) cb[jt] = (f32x4){0.f, 0.f, 0.f, 0.f};
#pragma unroll
  for (int ks = 0; ks < 4; ++ks)
#pragma unroll
    for (int jt = 0; jt < 8; ++jt) {
      const bf16x8 A = *(const bf16x8*)(smem + (16 * jt + fr) * SS_BROW + (32 * ks + 8 * fq) * 2);
      cb[jt] = __builtin_amdgcn_mfma_f32_16x16x32_bf16(A, cfr[ks], cb[jt], 0, 0, 0);
    }
  __syncthreads();
  float ssr[2] = {0.f, 0.f};
  const unsigned ldsb = (unsigned)(size_t)smem;
  const unsigned xbase = ldsb + SS_R0 + (8 * fq + (fr >> 2)) * SS_XROW + (4 * (fr & 3)) * 2;
  const char* wrow = smem + (16 * w + fr) * SS_BROW + (8 * fq) * 2;
  const int il = i0 + fr;
#pragma unroll 1
  for (int hh = 0; hh < 4; ++hh) {
    const int h = 4 * g + hh;
    u32x4 pre[4];
#pragma unroll
    for (int i = 0; i < 4; ++i) { const int q = tid + 256 * i; pre[i] = *(const u32x4*)(xc + (tb + (q >> 3)) * 4096 + h * 64 + (q & 7) * 8); }
    const float* csf = arr + hh * 512;
    const float* csr = csf + 128;
    const float* dtf = csf + 256;
    const float* dtr = csf + 384;
    {
      const float cfi = csf[il], cbi = csr[il];
#pragma unroll
      for (int jt = 0; jt < 8; ++jt) {
        const f32x4 cfj = *(const f32x4*)(csf + 16 * jt + 4 * fq), cbj = *(const f32x4*)(csr + 16 * jt + 4 * fq);
        const f32x4 dfj = *(const f32x4*)(dtf + 16 * jt + 4 * fq), dbj = *(const f32x4*)(dtr + 16 * jt + 4 * fq);
        float wv[4];
#pragma unroll
        for (int jj = 0; jj < 4; ++jj) {
          const int j = 16 * jt + 4 * fq + jj;
          const bool le = j <= il;
          float mlt = __expf(le ? cfi - cfj[jj] : cbi - cbj[jj]) * (le ? dfj[jj] : dbj[jj]);
          if (j == il) mlt = dfj[jj] + dbj[jj];
          wv[jj] = cb[jt][jj] * mlt;
        }
        u32x2 o; o[0] = pack2(wv[0], wv[1]); o[1] = pack2(wv[2], wv[3]);
        *(u32x2*)(smem + (16 * w + fr) * SS_BROW + (16 * jt + 4 * fq) * 2) = o;
      }
    }
#pragma unroll
    for (int i = 0; i < 4; ++i) { const int q = tid + 256 * i; *(u32x4*)(smem + SS_R0 + (q >> 3) * SS_XROW + (q & 7) * 16) = pre[i]; }
#pragma unroll
    for (int i = 0; i < 4; ++i) { const int q = tid + 256 * i; pre[i] = *(const u32x4*)(sst + (((size_t)cg * 32 + h) * 2 + 0) * 8192 + (q >> 4) * 128 + (q & 15) * 8); }
    __syncthreads();
    f32x4 y[4];
#pragma unroll
    for (int pt = 0; pt < 4; ++pt) y[pt] = (f32x4){0.f, 0.f, 0.f, 0.f};
    ssd_p2_wx_kstep<0>(y, wrow, xbase);
    ssd_p2_wx_kstep<1>(y, wrow, xbase);
    ssd_p2_wx_kstep<2>(y, wrow, xbase);
    ssd_p2_wx_kstep<3>(y, wrow, xbase);
    float xsk[4][4];
#pragma unroll
    for (int pt = 0; pt < 4; ++pt)
#pragma unroll
      for (int jj = 0; jj < 4; ++jj) xsk[pt][jj] = bf2f(*(const bf16_t*)(smem + SS_R0 + (i0 + 4 * fq + jj) * SS_XROW + (16 * pt + fr) * 2));
    __syncthreads();
#pragma unroll
    for (int i = 0; i < 4; ++i) { const int q = tid + 256 * i; *(u32x4*)(smem + SS_R0 + (q >> 4) * SS_BROW + (q & 15) * 16) = pre[i]; }
#pragma unroll
    for (int i = 0; i < 4; ++i) { const int q = tid + 256 * i; pre[i] = *(const u32x4*)(sst + (((size_t)cg * 32 + h) * 2 + 1) * 8192 + (q >> 4) * 128 + (q & 15) * 8); }
    __syncthreads();
    f32x4 zf[4], zb[4];
#pragma unroll
    for (int pt = 0; pt < 4; ++pt) { zf[pt] = (f32x4){0.f, 0.f, 0.f, 0.f}; zb[pt] = (f32x4){0.f, 0.f, 0.f, 0.f}; }
#pragma unroll
    for (int ks = 0; ks < 4; ++ks)
#pragma unroll
      for (int pt = 0; pt < 4; ++pt) {
        const bf16x8 B = *(const bf16x8*)(smem + SS_R0 + (16 * pt + fr) * SS_BROW + (32 * ks + 8 * fq) * 2);
        zf[pt] = __builtin_amdgcn_mfma_f32_16x16x32_bf16(cfr[ks], B, zf[pt], 0, 0, 0);
      }
    __syncthreads();
#pragma unroll
    for (int i = 0; i < 4; ++i) { const int q = tid + 256 * i; *(u32x4*)(smem + SS_R0 + (q >> 4) * SS_BROW + (q & 15) * 16) = pre[i]; }
    __syncthreads();
#pragma unroll
    for (int ks = 0; ks < 4; ++ks)
#pragma unroll
      for (int pt = 0; pt < 4; ++pt) {
        const bf16x8 B = *(const bf16x8*)(smem + SS_R0 + (16 * pt + fr) * SS_BROW + (32 * ks + 8 * fq) * 2);
        zb[pt] = __builtin_amdgcn_mfma_f32_16x16x32_bf16(cfr[ks], B, zb[pt], 0, 0, 0);
      }
    const float dsk = p.ssd_d[l * 32 + h];
    char* est = smem + 61440 + w * 2304;
#pragma unroll
    for (int jj = 0; jj < 4; ++jj) {
      const int i2 = i0 + 4 * fq + jj;
      const float ef = __expf(csf[i2]), eb = __expf(csr[i2]);
#pragma unroll
      for (int pt = 0; pt < 4; ++pt) {
        const float val = y[pt][jj] + ef * zf[pt][jj] + eb * zb[pt][jj] + dsk * xsk[pt][jj];
        *(bf16_t*)(est + (4 * fq + jj) * 144 + (16 * pt + fr) * 2) = f2bf(val);
      }
    }
#pragma unroll
    for (int ps = 0; ps < 2; ++ps) {
      const int r = (lane >> 3) + 8 * ps, c8 = lane & 7;
      const u32x4 pv = *(const u32x4*)(est + r * 144 + c8 * 16);
      const size_t tk = tb + i0 + r;
      const u32x4 zv = *(const u32x4*)(proj + tk * NPROJ_PAD + C_Z + h * 64 + c8 * 8);
      u32x4 o;
#pragma unroll
      for (int e = 0; e < 4; ++e) {
        const float g0 = bf2f((bf16_t)(pv[e] & 0xffff)) * siluf_(bf2f((bf16_t)(zv[e] & 0xffff)));
        const float g1 = bf2f((bf16_t)(pv[e] >> 16)) * siluf_(bf2f((bf16_t)(zv[e] >> 16)));
        ssr[ps] += g0 * g0 + g1 * g1;
        o[e] = pack2(g0, g1);
      }
      *(u32x4*)(ybuf + tk * 2048 + h * 64 + c8 * 8) = o;
    }
    __syncthreads();
  }
#pragma unroll
  for (int ps = 0; ps < 2; ++ps) {
    float t = ssr[ps];
    t += __shfl_xor(t, 1); t += __shfl_xor(t, 2); t += __shfl_xor(t, 4);
    ssr[ps] = rsqrtf(t * (1.f / 256.f) + 1e-6f);
  }
#pragma unroll
  for (int hh = 0; hh < 4; ++hh) {
    const int chb = (4 * g + hh) * 64 + (lane & 7) * 8;
    const f32x4 nwa = *(const f32x4*)(p.ssd_norm_w + l * 2048 + chb), nwb = *(const f32x4*)(p.ssd_norm_w + l * 2048 + chb + 4);
#pragma unroll
    for (int ps = 0; ps < 2; ++ps) {
      bf16_t* yp = ybuf + (tb + i0 + (lane >> 3) + 8 * ps) * 2048 + chb;
      const u32x4 v = *(const u32x4*)yp;
      const float rs = ssr[ps];
      u32x4 o;
      o[0] = pack2(bf2f((bf16_t)(v[0] & 0xffff)) * rs * nwa[0], bf2f((bf16_t)(v[0] >> 16)) * rs * nwa[1]);
      o[1] = pack2(bf2f((bf16_t)(v[1] & 0xffff)) * rs * nwa[2], bf2f((bf16_t)(v[1] >> 16)) * rs * nwa[3]);
      o[2] = pack2(bf2f((bf16_t)(v[2] & 0xffff)) * rs * nwb[0], bf2f((bf16_t)(v[2] >> 16)) * rs * nwb[1]);
      o[3] = pack2(bf2f((bf16_t)(v[3] & 0xffff)) * rs * nwb[2], bf2f((bf16_t)(v[3] >> 16)) * rs * nwb[3]);
      *(u32x4*)yp = o;
    }
  }
}

__device__ __forceinline__ void phase_scan1(const Params& p, int l, char* smem) {
  const int bid = blockIdx.x;
  if (bid < 64) { hgrn_chunk_item(p, l, 32 * 16 + bid, smem); return; }
  if (bid >= 256 && bid < 320) return;
  const int wkr = bid < 256 ? bid - 64 : bid - 128;
  for (int it = wkr; it < 256 + 512 + 2048; it += 384) {
    if (it < 256) ssd_pass1_item(p, l, 32 * 64 + it, smem);
    else if (it < 768) hgrn_chunk_item(p, l, it - 256, smem);
    else ssd_pass1_item(p, l, it - 768, smem);
  }
}
__device__ __forceinline__ void phase_scan2(const Params& p, int l, char* smem) {
  for (int it = blockIdx.x; it < 2048; it += gridDim.x) ssd_pass2_item(p, l, it, smem);
}

__device__ __forceinline__ void phase_scan_naive(const Params& p, int l, char* smem) {
  const int n_ssd = 36 * 64, n_hg = 36 * 16;
  for (int it = blockIdx.x; it < n_ssd + n_hg; it += gridDim.x) {
    if (it < 256) ssd_naive_item(p, l, 32 * 64 + it, (float*)smem);
    else if (it < 320) hgrn_chunk_item(p, l, 32 * 16 + (it - 256), smem);
    else if (it < 320 + 2048) ssd_naive_item(p, l, it - 320, (float*)smem);
    else hgrn_chunk_item(p, l, it - 320 - 2048, smem);
  }
}

__device__ __forceinline__ void phase_post(const Params& p, int l) {
  const int tid = tid_opaque();
  const bf16_t* proj = (const bf16_t*)(p.ws + OFF_PROJ);
  const bf16_t* xc = (const bf16_t*)(p.ws + OFF_XC);
  const float* yf = (const float*)(p.ws + OFF_YF);
  const float* yb = (const float*)(p.ws + OFF_YB);
  const float* of = (const float*)(p.ws + OFF_OF);
  const float* ob = (const float*)(p.ws + OFF_OB);
  bf16_t* ybuf = (bf16_t*)(p.ws + OFF_YBUF);
  bf16_t* obuf = (bf16_t*)(p.ws + OFF_OBUF);
  for (int tok = blockIdx.x; tok < T; tok += gridDim.x) {
    {
      const int ch = tid * 4;
      const float* a = of + (size_t)tok * 1024 + ch;
      const float* b = ob + (size_t)tok * 1024 + ch;
      uint2 gv = *(const uint2*)(proj + (size_t)tok * NPROJ_PAD + C_HG + ch);
      const unsigned gw[2] = {gv.x, gv.y};
      float v[4];
      float ss = 0.f;
#pragma unroll
      for (int j = 0; j < 4; ++j) { v[j] = a[j] + b[j]; ss += v[j] * v[j]; }
#pragma unroll
      for (int o = 16; o >= 1; o >>= 1) ss += __shfl_xor(ss, o);
      const float rstd = rsqrtf(ss * (1.f / 128.f) + 1e-6f);
      const float* nw = p.hgrn_norm_w + l * 1024 + ch;
      float r[4];
#pragma unroll
      for (int j = 0; j < 4; ++j) {
        const float gz = bf2f((bf16_t)((j & 1) ? (gw[j >> 1] >> 16) : (gw[j >> 1] & 0xffff)));
        r[j] = v[j] * rstd * nw[j] * siluf_(gz);
      }
      uint2 o2; o2.x = pack2(r[0], r[1]); o2.y = pack2(r[2], r[3]);
      *(uint2*)(obuf + (size_t)tok * 1024 + ch) = o2;
    }
  }
}


#define XB_TMO 128
#define XB_XCNT(j) (256 + 64 * (j))
#define XB_XSUB(j) (1280 + 64 * (j))
#define XB_XGEN(j) (2304 + 64 * (j))
#define XB_TOP 3328
#define XB_TOPGEN 3392
#define XCD_BAR_WORDS 3456
#define XB_SPIN_CAP (1u << 22)
#define LAS __attribute__((address_space(3)))
__device__ __forceinline__ unsigned xb_ld(unsigned* p) { return __hip_atomic_load(p, __ATOMIC_RELAXED, __HIP_MEMORY_SCOPE_AGENT); }
__device__ __forceinline__ unsigned xb_add(unsigned* p, unsigned v) { return __hip_atomic_fetch_add(p, v, __ATOMIC_RELAXED, __HIP_MEMORY_SCOPE_AGENT); }
__device__ __forceinline__ unsigned xb_xcc_id() { return (unsigned)__builtin_amdgcn_s_getreg((3 << 11) | 20) & 0xFu; }
#define XB_SPIN(cond, bar)                                                                    \
  do {                                                                                        \
    unsigned _sp = 0;                                                                         \
    while (cond) {                                                                            \
      __builtin_amdgcn_s_sleep(1);                                                            \
      if ((++_sp & 255u) == 0u) {                                                             \
        if (xb_ld(&(bar)[XB_TMO])) break;                                                     \
        if (_sp > XB_SPIN_CAP) { atomicAdd(&(bar)[XB_TMO], 1u); break; }                      \
      }                                                                                       \
    }                                                                                         \
  } while (0)
struct XcdBarrier { unsigned* bar; unsigned x; volatile LAS unsigned* st; };
__device__ __forceinline__ XcdBarrier xcd_barrier_post(unsigned* bar, volatile LAS unsigned* st) {
  XcdBarrier b; b.bar = bar; b.x = xb_xcc_id(); b.st = st;
  if (threadIdx.x == 0) (void)xb_add(&bar[XB_XCNT(b.x)], 1u);
  return b;
}
__device__ __forceinline__ void xcd_barrier_complete(unsigned* bar, unsigned x, unsigned& nloc, unsigned& nx) {
  const unsigned G = gridDim.x * gridDim.y * gridDim.z;
  unsigned sum, cnt, mine, sp = 0u;
  for (;;) {
    sum = 0u; cnt = 0u; mine = 0u;
#pragma unroll
    for (unsigned j = 0; j < 16; ++j) { const unsigned c = xb_ld(&bar[XB_XCNT(j)]); sum += c; cnt += (c > 0u) ? 1u : 0u; mine = (j == x) ? c : mine; }
    if (sum == G) break;
    __builtin_amdgcn_s_sleep(1);
    if ((++sp & 255u) == 0u) { if (xb_ld(&bar[XB_TMO])) break; if (sp > XB_SPIN_CAP) { atomicAdd(&bar[XB_TMO], 1u); break; } }
  }
  nloc = mine > 0u ? mine : 1u; nx = cnt > 0u ? cnt : 1u;
}
__device__ __forceinline__ void xcd_barrier(const XcdBarrier& b) {
  asm volatile("s_waitcnt vmcnt(0)" ::: "memory");
  __syncthreads();
  if (threadIdx.x == 0) {
    unsigned* bar = b.bar;
    __builtin_amdgcn_s_waitcnt(0);
    unsigned nloc = b.st[0], nx = b.st[1];
    if (nloc == 0u) { xcd_barrier_complete(bar, b.x, nloc, nx); b.st[0] = nloc; b.st[1] = nx; }
    const unsigned old = xb_add(&bar[XB_XSUB(b.x)], 1u);
    const unsigned gen = old / nloc;
    if (old + 1u == (gen + 1u) * nloc) {
      __builtin_amdgcn_fence(__ATOMIC_RELEASE, "agent");
      asm volatile("s_waitcnt vmcnt(0)" ::: "memory");
      const unsigned og = xb_add(&bar[XB_TOP], 1u);
      const unsigned tg = og / nx;
      if (og + 1u == (tg + 1u) * nx) xb_add(&bar[XB_TOPGEN], 1u);
      else XB_SPIN(xb_ld(&bar[XB_TOPGEN]) == tg, bar);
      __builtin_amdgcn_fence(__ATOMIC_ACQUIRE, "agent");
      xb_add(&bar[XB_XGEN(b.x)], 1u);
      asm volatile("s_waitcnt vmcnt(0)" ::: "memory");
    } else {
      XB_SPIN(xb_ld(&bar[XB_XGEN(b.x)]) == gen, bar);
      __builtin_amdgcn_fence(__ATOMIC_ACQUIRE, "agent");
      asm volatile("s_waitcnt vmcnt(0)" ::: "memory");
    }
  }
  __syncthreads();
}

enum { PH_SETUP = 0, PH_NORM1, PH_PROJ, PH_CONV, PH_SCAN, PH_POST, PH_MERGE, PH_OUT, PH_NORM2, PH_FFN1, PH_FFN2, PH_FINAL };

__device__ __forceinline__ void run_phase(const Params& p, int ph, int l, char* smem) {
  switch (ph) {
    case PH_SETUP: phase_setup(p, smem); break;
    case PH_NORM1: phase_norm(p, l, 0); break;
    case PH_PROJ: phase_gemm<G_PROJ>(p, l, smem); break;
    case PH_CONV: phase_conv(p, l); break;
    case PH_SCAN: phase_scan_naive(p, l, smem); break;
    case PH_POST: phase_post(p, l); break;
    case PH_MERGE: phase_gemm<G_MERGE>(p, l, smem); break;
    case PH_OUT: phase_gemm<G_OUT>(p, l, smem); break;
    case PH_NORM2: phase_norm(p, l, 1); break;
    case PH_FFN1: phase_gemm<G_FFN1>(p, l, smem); break;
    case PH_FFN2: phase_gemm<G_FFN2>(p, l, smem); break;
    case PH_FINAL: phase_final_norm(p); break;
  }
}

extern __shared__ __attribute__((aligned(16))) char dyn_smem[];

#if !MEGA
__global__ void __launch_bounds__(256, 2) phase_kernel(Params p, int ph, int l) { run_phase(p, ph, l, dyn_smem); }
#endif

#if MEGA
__global__ void __launch_bounds__(256, 2) mega_kernel(Params p) {
  cg::grid_group grid = cg::this_grid();
  __shared__ uint4 xb_words;
  if (threadIdx.x == 0) xb_words = make_uint4(0u, 0u, 0u, 0u);
  __syncthreads();
  XcdBarrier xb = xcd_barrier_post((unsigned*)(p.ws + OFF_BAR), (volatile LAS unsigned*)&xb_words);
  phase_setup(p, dyn_smem);
  grid.sync();
  for (int l = 0; l < DEPTH; ++l) {
#pragma unroll 1
    for (int ph = 0; ph < 10; ++ph) {
      switch (ph) {
        case 0: phase_norm(p, l, 0); break;
        case 1: phase_gemm<G_PROJ>(p, l, dyn_smem); break;
        case 2: phase_conv(p, l); break;
        case 3: phase_scan1(p, l, dyn_smem); break;
        case 4: phase_scan2(p, l, dyn_smem); phase_post(p, l); break;
        case 5: phase_gemm<G_MERGE>(p, l, dyn_smem); break;
        case 6: phase_gemm<G_OUT>(p, l, dyn_smem); break;
        case 7: phase_norm(p, l, 1); break;
        case 8: phase_gemm<G_FFN1>(p, l, dyn_smem); break;
        default: phase_gemm<G_FFN2>(p, l, dyn_smem); break;
      }
      xcd_barrier(xb);
    }
  }
  phase_final_norm(p);
}
#endif

extern "C" void kernel_launch(void* const* d_in, const int* in_sizes, int n_in, void* d_out, int out_size, void* d_ws, size_t ws_size,
                              hipStream_t stream) {
  static int grid_blocks = 0;
  if (!grid_blocks) {
    int dev = 0, cus = 0, per_cu = 0;
    (void)hipGetDevice(&dev);
    (void)hipDeviceGetAttribute(&cus, hipDeviceAttributeMultiprocessorCount, dev);
#if MEGA
    (void)hipFuncSetAttribute((const void*)mega_kernel, hipFuncAttributeMaxDynamicSharedMemorySize, SMEM_BYTES);
#endif
#if !MEGA
    (void)hipFuncSetAttribute((const void*)phase_kernel, hipFuncAttributeMaxDynamicSharedMemorySize, SMEM_BYTES);
#endif
#if MEGA
    (void)hipOccupancyMaxActiveBlocksPerMultiprocessor(&per_cu, mega_kernel, 256, SMEM_BYTES);
#else
    (void)hipOccupancyMaxActiveBlocksPerMultiprocessor(&per_cu, phase_kernel, 256, SMEM_BYTES);
#endif
    per_cu = 2;
    grid_blocks = cus * per_cu;
  }
  Params p{};
  const float** pf = (const float**)&p;
  for (int i = 0; i < 26; ++i) pf[i] = (const float*)d_in[i];
  p.out = (float*)d_out;
  p.ws = (char*)d_ws;
#if MEGA
  (void)hipMemsetAsync((char*)d_ws + OFF_BAR, 0, XCD_BAR_WORDS * 4, stream);
  void* args[] = {&p};
  hipError_t e = hipLaunchCooperativeKernel((void*)mega_kernel, dim3(grid_blocks), dim3(256), args, SMEM_BYTES, stream);
  if (e != hipSuccess) fprintf(stderr, "coop launch failed: %s\n", hipGetErrorString(e));
#else
  const int G = grid_blocks;
  phase_kernel<<<G, 256, SMEM_BYTES, stream>>>(p, PH_SETUP, 0);
  for (int l = 0; l < DEPTH; ++l)
    for (int ph = PH_NORM1; ph <= PH_FFN2; ++ph) phase_kernel<<<G, 256, SMEM_BYTES, stream>>>(p, ph, l);
  phase_kernel<<<G, 256, SMEM_BYTES, stream>>>(p, PH_FINAL, 0);
#endif
}
```

```cpp
#include <hip/hip_runtime.h>
#include <hip/hip_cooperative_groups.h>
#include <cstdio>
#include <cstdint>
namespace cg = cooperative_groups;

#ifndef MEGA
#define MEGA 1
#endif

typedef unsigned short bf16_t;
typedef short bf16x8 __attribute__((ext_vector_type(8)));
typedef float f32x4 __attribute__((ext_vector_type(4)));
typedef unsigned u32x4 __attribute__((ext_vector_type(4)));
typedef short s16x4 __attribute__((ext_vector_type(4)));
typedef unsigned u32x2 __attribute__((ext_vector_type(2)));

constexpr int D = 1024, T = 16384, TCTX = 8192, DEPTH = 4;
constexpr int NPROJ = 13376, NPROJ_PAD = 13440;
constexpr int FFN = 2816;
constexpr int C_Z = 4096, C_DT = 6144, C_HQ = 6208, C_HF = 7232, C_HI = 9280, C_HG = 10304, C_GATE = 11328;
constexpr size_t WT_IN = 0;
constexpr size_t WT_SSO = WT_IN + (size_t)NPROJ_PAD * 1024;
constexpr size_t WT_HGO = WT_SSO + (size_t)1024 * 2048;
constexpr size_t WT_OUT = WT_HGO + (size_t)1024 * 1024;
constexpr size_t WT_W13 = WT_OUT + (size_t)1024 * 1024;
constexpr size_t WT_W2 = WT_W13 + (size_t)5632 * 1024;
constexpr size_t WT_LAYER = WT_W2 + (size_t)1024 * 2816;
constexpr size_t OFF_WT = 0;
constexpr size_t OFF_H = OFF_WT + WT_LAYER * 2 * DEPTH;
constexpr size_t OFF_PROJ = OFF_H + (size_t)T * 1024 * 2;
constexpr size_t OFF_XC = OFF_PROJ + (size_t)T * NPROJ_PAD * 2;
constexpr size_t OFF_DTRAW = OFF_XC + (size_t)T * 4096 * 2;
constexpr size_t OFF_DT = OFF_DTRAW + (size_t)T * 64 * 4;
constexpr size_t OFF_YF = OFF_DT + (size_t)T * 64 * 4;
constexpr size_t OFF_YB = OFF_YF + (size_t)T * 2048 * 4;
constexpr size_t OFF_OF = OFF_YB + (size_t)T * 2048 * 4;
constexpr size_t OFF_OB = OFF_OF + (size_t)T * 1024 * 4;
constexpr size_t OFF_YBUF = OFF_OB + (size_t)T * 1024 * 4;
constexpr size_t OFF_OBUF = OFF_YBUF + (size_t)T * 2048 * 2;
constexpr size_t OFF_MBUF = OFF_OBUF + (size_t)T * 1024 * 2;
constexpr size_t OFF_MOD = OFF_MBUF + (size_t)T * 1024 * 2;
constexpr size_t OFF_LB = OFF_MOD + (size_t)DEPTH * 5 * 6144 * 4;
constexpr size_t OFF_BAR = OFF_LB + (size_t)DEPTH * 2 * 1024 * 4;
constexpr size_t OFF_END = OFF_BAR + 16384;
constexpr size_t OUT_SSM = (size_t)T * 1024;
constexpr size_t OUT_HGRN = OUT_SSM + (size_t)32 * 4 * 2 * 32 * 64 * 128;

constexpr int SMEM_BYTES = 73728;
constexpr int LDS_ROW = 128;
constexpr int LDS_TILE = 128 * LDS_ROW;

struct Params {
  const float *x_prompt, *x_sample, *c, *state_ssm, *state_hgrn, *c_ctx, *norm_mix_w, *norm_ffn_w, *ada_w, *ada_b, *w_in,
      *ssd_conv_w, *ssd_conv_b, *ssd_dt_bias, *ssd_a_log, *ssd_d, *ssd_norm_w, *hgrn_lb, *hgrn_norm_w, *w_ssd_out, *w_hgrn_out,
      *w_out, *ffn_w1, *ffn_w3, *ffn_w2, *norm_final_w;
  float* out;
  char* ws;
};

__device__ __forceinline__ bf16_t f2bf(float f) {
  unsigned u = __float_as_uint(f);
  u += 0x7fffu + ((u >> 16) & 1u);
  return (bf16_t)(u >> 16);
}
__device__ __forceinline__ float bf2f(bf16_t b) { return __uint_as_float(((unsigned)b) << 16); }
typedef __bf16 bf16x2_t __attribute__((ext_vector_type(2)));
__device__ __forceinline__ unsigned pack2(float a, float b) { bf16x2_t v = {(__bf16)a, (__bf16)b}; return __builtin_bit_cast(unsigned, v); }
__device__ __forceinline__ float sigmoidf_(float x) { return __builtin_amdgcn_rcpf(1.0f + __expf(-x)); }
__device__ __forceinline__ float siluf_(float x) { return x * __builtin_amdgcn_rcpf(1.0f + __expf(-x)); }
__device__ __forceinline__ int tid_opaque() { int t = threadIdx.x; asm volatile("" : "+v"(t)); return t; }
__device__ __forceinline__ float clamp30(float x) { return fminf(fmaxf(x, -30.f), 30.f); }
__device__ __forceinline__ float gate_ratio(float g1, float g2) { return (1.0f + __expf(-clamp30(g2))) * __builtin_amdgcn_rcpf(1.0f + __expf(-clamp30(g1))); }
__device__ __forceinline__ int mod_row(int tok) { return tok < TCTX ? 0 : 1 + ((tok - TCTX) >> 11); }

__device__ __forceinline__ void phase_setup(const Params& p, char* smem) {
  const int tid = tid_opaque(), bid = blockIdx.x, G = gridDim.x;
  {
    const size_t n4 = (size_t)T * 1024 / 4, half4 = (size_t)TCTX * 1024 / 4;
    float4* dst = (float4*)p.out;
    const float4* s0 = (const float4*)p.x_prompt;
    const float4* s1 = (const float4*)p.x_sample;
    for (size_t i = (size_t)bid * 256 + tid; i < n4; i += (size_t)G * 256) dst[i] = i < half4 ? s0[i] : s1[i - half4];
  }
  {
    float* lb = (float*)(p.ws + OFF_LB);
    for (int i = bid * 256 + tid; i < 2048; i += G * 256) {
      float v0 = p.hgrn_lb[i], v1 = p.hgrn_lb[2048 + i], v2 = p.hgrn_lb[4096 + i], v3 = p.hgrn_lb[6144 + i];
      float m = fmaxf(fmaxf(v0, v1), fmaxf(v2, v3));
      float e0 = expf(v0 - m), e1 = expf(v1 - m), e2 = expf(v2 - m), e3 = expf(v3 - m);
      float inv = 1.0f / (e0 + e1 + e2 + e3);
      lb[i] = 0.f;
      lb[2048 + i] = e1 * inv;
      lb[4096 + i] = (e1 + e2) * inv;
      lb[6144 + i] = (e1 + e2 + e3) * inv;
    }
  }
  {
    float* sm = (float*)smem;
    float* modb = (float*)(p.ws + OFF_MOD);
    __syncthreads();
    for (int i = tid; i < 5 * 1024; i += 256) {
      int v = i >> 10, k = i & 1023;
      float cv = v == 0 ? p.c_ctx[k] : p.c[(v - 1) * 1024 + k];
      sm[i] = siluf_(cv);
    }
    __syncthreads();
    float* part = sm + 5 * 1024;
    for (int item = bid; item < DEPTH * 96; item += G) {
      int l = item / 96, cg_ = item % 96;
      int col = cg_ * 64 + (tid & 63), kg = tid >> 6;
      const float* w = p.ada_w + (size_t)l * 1024 * 6144 + col;
      float a0 = 0, a1 = 0, a2 = 0, a3 = 0, a4 = 0;
      for (int k = kg * 256; k < kg * 256 + 256; ++k) {
        float wv = w[(size_t)k * 6144];
        a0 += sm[k] * wv; a1 += sm[1024 + k] * wv; a2 += sm[2048 + k] * wv; a3 += sm[3072 + k] * wv; a4 += sm[4096 + k] * wv;
      }
      __syncthreads();
      part[(kg * 5 + 0) * 64 + (tid & 63)] = a0; part[(kg * 5 + 1) * 64 + (tid & 63)] = a1; part[(kg * 5 + 2) * 64 + (tid & 63)] = a2;
      part[(kg * 5 + 3) * 64 + (tid & 63)] = a3; part[(kg * 5 + 4) * 64 + (tid & 63)] = a4;
      __syncthreads();
      for (int i = tid; i < 320; i += 256) {
        int v = i >> 6, cc = i & 63;
        float s = part[(0 * 5 + v) * 64 + cc] + part[(1 * 5 + v) * 64 + cc] + part[(2 * 5 + v) * 64 + cc] + part[(3 * 5 + v) * 64 + cc];
        int colo = cg_ * 64 + cc;
        modb[((size_t)l * 5 + v) * 6144 + colo] = s + p.ada_b[l * 6144 + colo];
      }
    }
    __syncthreads();
  }
  {
    float* tile = (float*)smem;
    const int n_in = 210 * 16, n_sso = 16 * 32, n_hgo = 16 * 16, n_out = 16 * 16, n_w13 = 88 * 16, n_w2 = 16 * 44;
    const int per_layer = n_in + n_sso + n_hgo + n_out + n_w13 + n_w2;
    for (int it = bid; it < per_layer * DEPTH; it += G) {
      int l = it / per_layer, r = it % per_layer;
      bf16_t* wt = (bf16_t*)(p.ws + OFF_WT) + (size_t)l * WT_LAYER;
      const float *src0 = nullptr, *src1 = nullptr;
      int K, Nsrc, nt, kt;
      bf16_t* dst;
      bool zero = false;
      if (r < n_in) {
        nt = r / 16; kt = r % 16; K = 1024; Nsrc = NPROJ;
        dst = wt + WT_IN;
        if (nt >= 209) zero = true;
        src0 = p.w_in + (size_t)l * 1024 * NPROJ + nt * 64; src1 = src0 + 32;
      } else if ((r -= n_in) < n_sso) {
        nt = r / 32; kt = r % 32; K = 2048; Nsrc = 1024; dst = wt + WT_SSO;
        src0 = p.w_ssd_out + (size_t)l * 2048 * 1024 + nt * 64; src1 = src0 + 32;
      } else if ((r -= n_sso) < n_hgo) {
        nt = r / 16; kt = r % 16; K = 1024; Nsrc = 1024; dst = wt + WT_HGO;
        src0 = p.w_hgrn_out + (size_t)l * 1024 * 1024 + nt * 64; src1 = src0 + 32;
      } else if ((r -= n_hgo) < n_out) {
        nt = r / 16; kt = r % 16; K = 1024; Nsrc = 1024; dst = wt + WT_OUT;
        src0 = p.w_out + (size_t)l * 1024 * 1024 + nt * 64; src1 = src0 + 32;
      } else if ((r -= n_out) < n_w13) {
        nt = r / 16; kt = r % 16; K = 1024; Nsrc = FFN; dst = wt + WT_W13;
        src0 = p.ffn_w1 + (size_t)l * 1024 * FFN + nt * 32; src1 = p.ffn_w3 + (size_t)l * 1024 * FFN + nt * 32;
      } else {
        r -= n_w13;
        nt = r / 44; kt = r % 44; K = 2816; Nsrc = 1024; dst = wt + WT_W2;
        src0 = p.ffn_w2 + (size_t)l * 2816 * 1024 + nt * 64; src1 = src0 + 32;
      }
      __syncthreads();
      {
        int c4 = (tid & 15) * 4;
        const float* s = c4 < 32 ? src0 + c4 : src1 + (c4 - 32);
#pragma unroll
        for (int i = 0; i < 4; ++i) {
          int kr = (tid >> 4) + i * 16;
          float4 v = zero ? make_float4(0.f, 0.f, 0.f, 0.f) : *(const float4*)(s + (size_t)(kt * 64 + kr) * Nsrc);
          tile[kr * 65 + c4 + 0] = v.x; tile[kr * 65 + c4 + 1] = v.y; tile[kr * 65 + c4 + 2] = v.z; tile[kr * 65 + c4 + 3] = v.w;
        }
      }
      __syncthreads();
#pragma unroll
      for (int i = 0; i < 2; ++i) {
        int cidx = tid + i * 256, n = cidx >> 3, kc = cidx & 7;
        uint4 o;
        o.x = pack2(tile[(kc * 8 + 0) * 65 + n], tile[(kc * 8 + 1) * 65 + n]);
        o.y = pack2(tile[(kc * 8 + 2) * 65 + n], tile[(kc * 8 + 3) * 65 + n]);
        o.z = pack2(tile[(kc * 8 + 4) * 65 + n], tile[(kc * 8 + 5) * 65 + n]);
        o.w = pack2(tile[(kc * 8 + 6) * 65 + n], tile[(kc * 8 + 7) * 65 + n]);
        *(uint4*)(dst + (size_t)(nt * 64 + n) * K + kt * 64 + kc * 8) = o;
      }
    }
    __syncthreads();
  }
}

__device__ __forceinline__ void phase_norm(const Params& p, int l, int which) {
  const int lane = tid_opaque() & 63, wv = tid_opaque() >> 6;
  const float* nw = (which == 0 ? p.norm_mix_w : p.norm_ffn_w) + l * 1024;
  const float* modb = (const float*)(p.ws + OFF_MOD) + (size_t)l * 5 * 6144;
  bf16_t* h = (bf16_t*)(p.ws + OFF_H);
  for (int row = blockIdx.x * 4 + wv; row < T; row += gridDim.x * 4) {
    const float* x = p.out + (size_t)row * 1024;
    const float* md = modb + (size_t)mod_row(row) * 6144 + (which == 0 ? 0 : 3072);
    float4 v[4];
    float ss = 0.f;
#pragma unroll
    for (int i = 0; i < 4; ++i) {
      v[i] = *(const float4*)(x + i * 256 + lane * 4);
      ss += v[i].x * v[i].x + v[i].y * v[i].y + v[i].z * v[i].z + v[i].w * v[i].w;
    }
#pragma unroll
    for (int o = 32; o >= 1; o >>= 1) ss += __shfl_xor(ss, o);
    float rstd = rsqrtf(ss * (1.0f / 1024.f) + 1e-6f);
#pragma unroll
    for (int i = 0; i < 4; ++i) {
      int c = i * 256 + lane * 4;
      float4 w = *(const float4*)(nw + c), sh = *(const float4*)(md + c), sc = *(const float4*)(md + 1024 + c);
      float a0 = v[i].x * rstd * w.x * (1.f + sc.x) + sh.x, a1 = v[i].y * rstd * w.y * (1.f + sc.y) + sh.y;
      float a2 = v[i].z * rstd * w.z * (1.f + sc.z) + sh.z, a3 = v[i].w * rstd * w.w * (1.f + sc.w) + sh.w;
      uint2 o2; o2.x = pack2(a0, a1); o2.y = pack2(a2, a3);
      *(uint2*)(h + (size_t)row * 1024 + c) = o2;
    }
  }
}

__device__ __forceinline__ void phase_final_norm(const Params& p) {
  const int lane = tid_opaque() & 63, wv = tid_opaque() >> 6;
  for (int row = blockIdx.x * 4 + wv; row < T; row += gridDim.x * 4) {
    float* x = p.out + (size_t)row * 1024;
    float4 v[4];
    float ss = 0.f;
#pragma unroll
    for (int i = 0; i < 4; ++i) {
      v[i] = *(const float4*)(x + i * 256 + lane * 4);
      ss += v[i].x * v[i].x + v[i].y * v[i].y + v[i].z * v[i].z + v[i].w * v[i].w;
    }
#pragma unroll
    for (int o = 32; o >= 1; o >>= 1) ss += __shfl_xor(ss, o);
    float rstd = rsqrtf(ss * (1.0f / 1024.f) + 1e-6f);
#pragma unroll
    for (int i = 0; i < 4; ++i) {
      int c = i * 256 + lane * 4;
      float4 w = *(const float4*)(p.norm_final_w + c);
      float4 o4 = make_float4(v[i].x * rstd * w.x, v[i].y * rstd * w.y, v[i].z * rstd * w.z, v[i].w * rstd * w.w);
      *(float4*)(x + c) = o4;
    }
  }
}

template <bool HASMID>
__device__ __forceinline__ void gemm_kloop2(f32x4 (&acc)[4][4], const bf16_t* __restrict__ Ag, int lda, const bf16_t* __restrict__ Bg,
                                            int ldb, int K, const bf16_t* __restrict__ Ag2, int lda2, const bf16_t* __restrict__ Bg2,
                                            int ldb2, int K2, char* smem, const bf16_t* __restrict__ gate0) {
  const int tid = tid_opaque(), lane = tid & 63, wid = tid >> 6;
  const int wr = wid >> 1, wc = wid & 1, fr = lane & 15, fq = lane >> 4;
  const int srow = tid >> 3, schunk = (tid & 7) ^ ((tid >> 4) & 7);
  const int rofs0 = (fq ^ ((fr >> 1) & 7)) * 16;
  const bf16_t* ap = Ag + (size_t)srow * lda + schunk * 8;
  const bf16_t* bp = Bg + (size_t)srow * ldb + schunk * 8;
  const int nk1 = K >> 6;
  const int nk = nk1 + (K2 >> 6);
  char* const sdst = smem + tid * 16;
#define GK_DMA(buf, t)                                                                                                   \
  {                                                                                                                      \
    _Pragma("unroll") for (int i = 0; i < 4; ++i) {                                                                      \
      __builtin_amdgcn_global_load_lds((const unsigned*)(ap + (size_t)i * 32 * lda + (size_t)(t) * 64),                  \
                                       (unsigned*)(sdst + (buf) * LDS_TILE + i * 4096), 16, 0, 0);                       \
      __builtin_amdgcn_global_load_lds((const unsigned*)(bp + (size_t)i * 32 * ldb + (size_t)(t) * 64),                  \
                                       (unsigned*)(sdst + (2 + (buf)) * LDS_TILE + i * 4096), 16, 0, 0);                 \
    }                                                                                                                    \
  }
  GK_DMA(0, 0);
  __syncthreads();
  for (int kt = 0; kt < nk; ++kt) {
    const int cur = kt & 1;
    if (kt + 1 < nk) {
      if (kt + 1 == nk1) {
        ap = Ag2 + (size_t)srow * lda2 + schunk * 8 - (size_t)nk1 * 64;
        bp = Bg2 + (size_t)srow * ldb2 + schunk * 8 - (size_t)nk1 * 64;
        lda = lda2; ldb = ldb2;
      }
      GK_DMA(cur ^ 1, kt + 1);
    }
    if (HASMID && kt == nk1) {
#pragma unroll
      for (int m = 0; m < 4; ++m)
#pragma unroll
        for (int n = 0; n < 4; ++n) {
          uint2 g1 = *(const uint2*)(gate0 + (size_t)(m * 16) * NPROJ_PAD + n * 16);
          uint2 g2 = *(const uint2*)(gate0 + (size_t)(m * 16) * NPROJ_PAD + 1024 + n * 16);
          acc[m][n][0] *= gate_ratio(bf2f((bf16_t)(g1.x & 0xffff)), bf2f((bf16_t)(g2.x & 0xffff)));
          acc[m][n][1] *= gate_ratio(bf2f((bf16_t)(g1.x >> 16)), bf2f((bf16_t)(g2.x >> 16)));
          acc[m][n][2] *= gate_ratio(bf2f((bf16_t)(g1.y & 0xffff)), bf2f((bf16_t)(g2.y & 0xffff)));
          acc[m][n][3] *= gate_ratio(bf2f((bf16_t)(g1.y >> 16)), bf2f((bf16_t)(g2.y >> 16)));
        }
    }
    const char* sa = smem + cur * LDS_TILE + (wr * 64 + fr) * LDS_ROW;
    const char* sb = smem + (2 + cur) * LDS_TILE + (wc * 64 + fr) * LDS_ROW;
#pragma unroll
    for (int kk = 0; kk < 2; ++kk) {
      bf16x8 af[4], bfv[4];
      __builtin_amdgcn_sched_barrier(0);
#pragma unroll
      for (int m = 0; m < 4; ++m) af[m] = *(const bf16x8*)(sa + m * 16 * LDS_ROW + (rofs0 ^ (kk * 64)));
#pragma unroll
      for (int n = 0; n < 4; ++n) bfv[n] = *(const bf16x8*)(sb + n * 16 * LDS_ROW + (rofs0 ^ (kk * 64)));
      __builtin_amdgcn_sched_barrier(0);
#pragma unroll
      for (int m = 0; m < 4; ++m)
#pragma unroll
        for (int n = 0; n < 4; ++n) acc[m][n] = __builtin_amdgcn_mfma_f32_16x16x32_bf16(bfv[n], af[m], acc[m][n], 0, 0, 0);
    }
    __builtin_amdgcn_sched_barrier(0);
    __syncthreads();
  }
#undef GK_DMA
}

__device__ __forceinline__ void gemm_kloop(f32x4 (&acc)[4][4], const bf16_t* __restrict__ Ag, int lda, const bf16_t* __restrict__ Bg,
                                           int ldb, int K, char* smem) {
  gemm_kloop2<false>(acc, Ag, lda, Bg, ldb, K, Ag, lda, Bg, ldb, 0, smem, Ag);
}

constexpr int BG_STAGE = 24576;
__device__ __forceinline__ int swz4(int x) { return (0x78 >> (2 * x)) & 3; }
template <bool HASMID>
__device__ __forceinline__ void gemm_kloop_big(f32x4 (&acc)[8][4], const bf16_t* __restrict__ Ag, int lda, const bf16_t* __restrict__ Bg,
                                               int ldb, int K, const bf16_t* __restrict__ Ag2, int lda2,
                                               const bf16_t* __restrict__ Bg2, int ldb2, int K2, char* smem,
                                               const bf16_t* __restrict__ gate0) {
  const int tid = tid_opaque(), lane = tid & 63, wid = tid >> 6;
  const int wr = wid >> 1, wc = wid & 1, fr = lane & 15, fq = lane >> 4;
  const int srow = tid >> 2, schunk = (tid & 3) ^ swz4((tid >> 4) & 3);
  const int rofs = (fq ^ swz4((fr >> 2) & 3)) * 16;
  const int nks1 = K >> 5;
  const int nks = nks1 + (K2 >> 5);
  const bf16_t* ap1 = Ag + (size_t)srow * lda + schunk * 8;
  const bf16_t* bp1 = Bg + (size_t)srow * ldb + schunk * 8;
  const bf16_t* ap2 = Ag2 + (size_t)srow * lda2 + schunk * 8 - (size_t)nks1 * 32;
  const bf16_t* bp2 = Bg2 + (size_t)srow * ldb2 + schunk * 8 - (size_t)nks1 * 32;
  char* const sdst = smem + tid * 16;
#define BG_DMA(slot, kk_)                                                                                                  \
  {                                                                                                                        \
    const int t_ = (kk_) < nks ? (kk_) : nks - 1;                                                                          \
    const bool s2_ = t_ >= nks1;                                                                                           \
    const bf16_t* ap_ = (s2_ ? ap2 : ap1) + (size_t)t_ * 32;                                                               \
    const bf16_t* bp_ = (s2_ ? bp2 : bp1) + (size_t)t_ * 32;                                                               \
    const size_t la_ = (size_t)64 * (s2_ ? lda2 : lda), lb_ = (size_t)64 * (s2_ ? ldb2 : ldb);                             \
    _Pragma("unroll") for (int i = 0; i < 4; ++i)                                                                          \
        __builtin_amdgcn_global_load_lds((const unsigned*)(ap_ + i * la_), (unsigned*)(sdst + (slot) * BG_STAGE + i * 4096), 16, 0, 0); \
    _Pragma("unroll") for (int i = 0; i < 2; ++i)                                                                          \
        __builtin_amdgcn_global_load_lds((const unsigned*)(bp_ + i * lb_), (unsigned*)(sdst + (slot) * BG_STAGE + 16384 + i * 4096), 16, 0, 0); \
  }
  BG_DMA(0, 0);
  BG_DMA(1, 1);
  int slot = 0;
  for (int ks = 0; ks < nks; ++ks) {
    asm volatile("s_waitcnt vmcnt(6)" ::: "memory");
    __builtin_amdgcn_s_barrier();
    asm volatile("" ::: "memory");
    const int nslot = slot == 0 ? 2 : slot - 1;
    BG_DMA(nslot, ks + 2);
    if (HASMID && ks == nks1) {
      int zofs = 0;
      asm volatile("" : "+v"(zofs));
      const bf16_t* gz = gate0 + zofs;
#pragma unroll
      for (int m = 0; m < 8; ++m)
#pragma unroll
        for (int n = 0; n < 4; ++n) {
          uint2 g1 = *(const uint2*)(gz + (size_t)(m * 16) * NPROJ_PAD + n * 16);
          uint2 g2 = *(const uint2*)(gz + (size_t)(m * 16) * NPROJ_PAD + 1024 + n * 16);
          acc[m][n][0] *= gate_ratio(bf2f((bf16_t)(g1.x & 0xffff)), bf2f((bf16_t)(g2.x & 0xffff)));
          acc[m][n][1] *= gate_ratio(bf2f((bf16_t)(g1.x >> 16)), bf2f((bf16_t)(g2.x >> 16)));
          acc[m][n][2] *= gate_ratio(bf2f((bf16_t)(g1.y & 0xffff)), bf2f((bf16_t)(g2.y & 0xffff)));
          acc[m][n][3] *= gate_ratio(bf2f((bf16_t)(g1.y >> 16)), bf2f((bf16_t)(g2.y >> 16)));
        }
    }
    const char* sa = smem + slot * BG_STAGE + (wr * 128 + fr) * 64 + rofs;
    const char* sb = smem + slot * BG_STAGE + 16384 + (wc * 64 + fr) * 64 + rofs;
    bf16x8 af[8], bfv[4];
    __builtin_amdgcn_sched_barrier(0);
#pragma unroll
    for (int n = 0; n < 4; ++n) bfv[n] = *(const bf16x8*)(sb + n * 16 * 64);
#pragma unroll
    for (int m = 0; m < 8; ++m) af[m] = *(const bf16x8*)(sa + m * 16 * 64);
    __builtin_amdgcn_sched_barrier(0);
    __builtin_amdgcn_s_setprio(1);
#pragma unroll
    for (int m = 0; m < 8; ++m)
#pragma unroll
      for (int n = 0; n < 4; ++n) acc[m][n] = __builtin_amdgcn_mfma_f32_16x16x32_bf16(bfv[n], af[m], acc[m][n], 0, 0, 0);
    __builtin_amdgcn_s_setprio(0);
    __builtin_amdgcn_sched_barrier(0);
    slot = slot == 2 ? 0 : slot + 1;
  }
  asm volatile("s_waitcnt vmcnt(0)" ::: "memory");
  __builtin_amdgcn_s_barrier();
  asm volatile("" ::: "memory");
#undef BG_DMA
}
__device__ __forceinline__ void gemm_kloop_big1(f32x4 (&acc)[8][4], const bf16_t* __restrict__ Ag, int lda, const bf16_t* __restrict__ Bg,
                                                int ldb, int K, char* smem) {
  gemm_kloop_big<false>(acc, Ag, lda, Bg, ldb, K, Ag, lda, Bg, ldb, 0, smem, Ag);
}
enum { G_PROJ = 0, G_MERGE = 1, G_OUT = 2, G_FFN1 = 3, G_FFN2 = 4 };

template <int MODE>
__device__ __forceinline__ void phase_gemm(const Params& p, int l, char* smem) {
  const int tid = tid_opaque(), lane = tid & 63, wid = tid >> 6;
  const int wr = wid >> 1, wc = wid & 1, fr = lane & 15, fq = lane >> 4;
  const bf16_t* wt = (const bf16_t*)(p.ws + OFF_WT) + (size_t)l * WT_LAYER;
  const bf16_t* hbuf = (const bf16_t*)(p.ws + OFF_H);
  bf16_t* proj = (bf16_t*)(p.ws + OFF_PROJ);
  bf16_t* hidden = (bf16_t*)(p.ws + OFF_PROJ);
  const float* modb = (const float*)(p.ws + OFF_MOD) + (size_t)l * 5 * 6144;
  constexpr int nM = T / 256;
  constexpr int nN = MODE == G_PROJ ? NPROJ_PAD / 128 : (MODE == G_FFN1 ? 5632 / 128 : 1024 / 128);
  for (int t = blockIdx.x; t < nM * nN; t += gridDim.x) {
    const int pm = t % nM, pn = t / nM;
    const int row0 = pm * 256, col0 = pn * 128;
    f32x4 acc[8][4];
#pragma unroll
    for (int m = 0; m < 8; ++m)
#pragma unroll
      for (int n = 0; n < 4; ++n) acc[m][n] = (f32x4){0.f, 0.f, 0.f, 0.f};
    if (MODE == G_PROJ) {
      gemm_kloop_big1(acc, hbuf + (size_t)row0 * 1024, 1024, wt + WT_IN + (size_t)col0 * 1024, 1024, 1024, smem);
      float* dtraw = (float*)(p.ws + OFF_DTRAW);
      char* stg = smem + wid * 18432;
#pragma unroll
      for (int m = 0; m < 8; ++m) {
        const int row = row0 + wr * 128 + m * 16 + fr;
#pragma unroll
        for (int n = 0; n < 4; ++n) {
          const int col = col0 + wc * 64 + n * 16 + fq * 4;
          u32x2 o; o[0] = pack2(acc[m][n][0], acc[m][n][1]); o[1] = pack2(acc[m][n][2], acc[m][n][3]);
          *(u32x2*)(stg + (m * 16 + fr) * 144 + (n * 16 + fq * 4) * 2) = o;
          if (col >= C_DT && col < C_DT + 64) *(f32x4*)(dtraw + (size_t)row * 64 + (col - C_DT)) = acc[m][n];
        }
      }
      {
        bf16_t* dst = proj + (size_t)(row0 + wr * 128 + (lane >> 3)) * NPROJ_PAD + col0 + wc * 64 + (lane & 7) * 8;
        const char* src = stg + (lane >> 3) * 144 + (lane & 7) * 16;
#pragma unroll
        for (int i = 0; i < 16; ++i) *(u32x4*)(dst + (size_t)(8 * i) * NPROJ_PAD) = *(const u32x4*)(src + 8 * i * 144);
      }
      asm volatile("s_waitcnt lgkmcnt(0)" ::: "memory");
      __builtin_amdgcn_s_barrier();
      asm volatile("" ::: "memory");
    } else if (MODE == G_MERGE) {
      const bf16_t* ybuf = (const bf16_t*)(p.ws + OFF_YBUF);
      const bf16_t* obuf = (const bf16_t*)(p.ws + OFF_OBUF);
      bf16_t* mbuf = (bf16_t*)(p.ws + OFF_MBUF);
      gemm_kloop_big<true>(acc, ybuf + (size_t)row0 * 2048, 2048, wt + WT_SSO + (size_t)col0 * 2048, 2048, 2048,
                        obuf + (size_t)row0 * 1024, 1024, wt + WT_HGO + (size_t)col0 * 1024, 1024, 1024, smem,
                        proj + (size_t)(row0 + wr * 128 + fr) * NPROJ_PAD + C_GATE + col0 + wc * 64 + fq * 4);
      char* stg = smem + wid * 18432;
#pragma unroll
      for (int m = 0; m < 8; ++m) {
        const int row = row0 + wr * 128 + m * 16 + fr;
#pragma unroll
        for (int n = 0; n < 4; ++n) {
          const int col = col0 + wc * 64 + n * 16 + fq * 4;
          uint2 g = *(const uint2*)(proj + (size_t)row * NPROJ_PAD + C_GATE + 1024 + col);
          float r0 = acc[m][n][0] * sigmoidf_(clamp30(bf2f((bf16_t)(g.x & 0xffff))));
          float r1 = acc[m][n][1] * sigmoidf_(clamp30(bf2f((bf16_t)(g.x >> 16))));
          float r2 = acc[m][n][2] * sigmoidf_(clamp30(bf2f((bf16_t)(g.y & 0xffff))));
          float r3 = acc[m][n][3] * sigmoidf_(clamp30(bf2f((bf16_t)(g.y >> 16))));
          u32x2 o; o[0] = pack2(r0, r1); o[1] = pack2(r2, r3);
          *(u32x2*)(stg + (m * 16 + fr) * 144 + (n * 16 + fq * 4) * 2) = o;
        }
      }
      {
        bf16_t* dst = mbuf + (size_t)(row0 + wr * 128 + (lane >> 3)) * 1024 + col0 + wc * 64 + (lane & 7) * 8;
        const char* src = stg + (lane >> 3) * 144 + (lane & 7) * 16;
#pragma unroll
        for (int i = 0; i < 16; ++i) *(u32x4*)(dst + (size_t)(8 * i) * 1024) = *(const u32x4*)(src + 8 * i * 144);
      }
      asm volatile("s_waitcnt lgkmcnt(0)" ::: "memory");
      __builtin_amdgcn_s_barrier();
      asm volatile("" ::: "memory");
    } else if (MODE == G_OUT || MODE == G_FFN2) {
      if (MODE == G_OUT) {
        const bf16_t* mbuf = (const bf16_t*)(p.ws + OFF_MBUF);
        gemm_kloop_big1(acc, mbuf + (size_t)row0 * 1024, 1024, wt + WT_OUT + (size_t)col0 * 1024, 1024, 1024, smem);
      } else {
        gemm_kloop_big1(acc, hidden + (size_t)row0 * FFN, FFN, wt + WT_W2 + (size_t)col0 * FFN, FFN, FFN, smem);
      }
      const float* gate = modb + (size_t)mod_row(row0) * 6144 + (MODE == G_OUT ? 2048 : 5120);
#pragma unroll
      for (int m = 0; m < 8; ++m) {
        const int row = row0 + wr * 128 + m * 16 + fr;
#pragma unroll
        for (int n = 0; n < 4; ++n) {
          const int col = col0 + wc * 64 + n * 16 + fq * 4;
          f32x4 g = *(const f32x4*)(gate + col);
          f32x4* xp = (f32x4*)(p.out + (size_t)row * 1024 + col);
          f32x4 xv = *xp;
          xv += g * acc[m][n];
          *xp = xv;
        }
      }
    } else {
      gemm_kloop_big1(acc, hbuf + (size_t)row0 * 1024, 1024, wt + WT_W13 + (size_t)col0 * 1024, 1024, 1024, smem);
      char* stg = smem + wid * 18432;
#pragma unroll
      for (int m = 0; m < 8; ++m) {
#pragma unroll
        for (int n = 0; n < 2; ++n) {
          float r[4];
#pragma unroll
          for (int j = 0; j < 4; ++j) r[j] = siluf_(acc[m][n][j]) * acc[m][n + 2][j];
          u32x2 o; o[0] = pack2(r[0], r[1]); o[1] = pack2(r[2], r[3]);
          *(u32x2*)(stg + (m * 16 + fr) * 80 + (n * 16 + fq * 4) * 2) = o;
        }
      }
      {
        bf16_t* dst = hidden + (size_t)(row0 + wr * 128 + (lane >> 2)) * FFN + (pn * 2 + wc) * 32 + (lane & 3) * 8;
        const char* src = stg + (lane >> 2) * 80 + (lane & 3) * 16;
#pragma unroll
        for (int i = 0; i < 8; ++i) *(u32x4*)(dst + (size_t)(16 * i) * FFN) = *(const u32x4*)(src + 16 * i * 80);
      }
      asm volatile("s_waitcnt lgkmcnt(0)" ::: "memory");
      __builtin_amdgcn_s_barrier();
      asm volatile("" ::: "memory");
    }
  }
}

__device__ __forceinline__ void phase_conv(const Params& p, int l, int cbid, int cnb) {
  const bf16_t* proj = (const bf16_t*)(p.ws + OFF_PROJ);
  bf16_t* xc = (bf16_t*)(p.ws + OFF_XC);
  const float* cw = p.ssd_conv_w + (size_t)l * 5 * 4096;
  const float* cb = p.ssd_conv_b + (size_t)l * 4096;
  for (int unit = cbid * 256 + tid_opaque(); unit < 512 * 256; unit += cnb * 256) {
    const int ch = (unit & 511) * 8, sg = unit >> 9;
    const int t0 = sg * 64;
    int lo, hi;
    if (t0 < TCTX) { lo = t0 & ~255; hi = lo + 256; } else { lo = t0; hi = t0 + 64; }
    float w[5][8], bias[8];
#pragma unroll
    for (int k = 0; k < 5; ++k) {
      const f32x4 a = *(const f32x4*)(cw + k * 4096 + ch), b = *(const f32x4*)(cw + k * 4096 + ch + 4);
      w[k][0] = a[0]; w[k][1] = a[1]; w[k][2] = a[2]; w[k][3] = a[3]; w[k][4] = b[0]; w[k][5] = b[1]; w[k][6] = b[2]; w[k][7] = b[3];
    }
    {
      const f32x4 a = *(const f32x4*)(cb + ch), b = *(const f32x4*)(cb + ch + 4);
      bias[0] = a[0]; bias[1] = a[1]; bias[2] = a[2]; bias[3] = a[3]; bias[4] = b[0]; bias[5] = b[1]; bias[6] = b[2]; bias[7] = b[3];
    }
    const u32x4 zero4 = (u32x4){0u, 0u, 0u, 0u};
    u32x4 r0, r1, r2, r3, r4;
#define CV_LD(tt) (((tt) >= lo && (tt) < hi) ? *(const u32x4*)(proj + (size_t)(tt) * NPROJ_PAD + ch) : zero4)
    r0 = CV_LD(t0 - 2); r1 = CV_LD(t0 - 1); r2 = CV_LD(t0); r3 = CV_LD(t0 + 1);
#pragma unroll 4
    for (int t = t0; t < t0 + 64; ++t) {
      r4 = CV_LD(t + 2);
      float a[8];
#pragma unroll
      for (int j = 0; j < 8; ++j) a[j] = bias[j];
#define CV_ACC(R, k)                                                                                                     \
  _Pragma("unroll") for (int e = 0; e < 4; ++e) {                                                                        \
    a[2 * e] += w[k][2 * e] * bf2f((bf16_t)(R[e] & 0xffff));                                                             \
    a[2 * e + 1] += w[k][2 * e + 1] * bf2f((bf16_t)(R[e] >> 16));                                                        \
  }
      CV_ACC(r0, 0) CV_ACC(r1, 1) CV_ACC(r2, 2) CV_ACC(r3, 3) CV_ACC(r4, 4)
      u32x4 o;
      o[0] = pack2(siluf_(a[0]), siluf_(a[1])); o[1] = pack2(siluf_(a[2]), siluf_(a[3]));
      o[2] = pack2(siluf_(a[4]), siluf_(a[5])); o[3] = pack2(siluf_(a[6]), siluf_(a[7]));
      *(u32x4*)(xc + (size_t)t * 4096 + ch) = o;
      r0 = r1; r1 = r2; r2 = r3; r3 = r4;
    }
#undef CV_LD
#undef CV_ACC
  }
  const float* dtraw = (const float*)(p.ws + OFF_DTRAW);
  float* dt = (float*)(p.ws + OFF_DT);
  for (size_t i = (size_t)cbid * 256 + tid_opaque(); i < (size_t)T * 64; i += (size_t)cnb * 256) {
    float v = dtraw[i] + p.ssd_dt_bias[l * 64 + (int)(i & 63)];
    dt[i] = v > 20.f ? v : log1pf(expf(v));
  }
}

__device__ __forceinline__ void ssd_naive_item(const Params& p, int l, int item, float* sm) {
  const int d = item & 1, h = (item >> 1) & 31, s = item >> 6;
  int tok0, L;
  if (s < 32) { tok0 = s * 256; L = 256; } else { tok0 = TCTX + (s - 32) * 2048; L = 2048; }
  const int tid = tid_opaque(), pp = tid >> 2, nq = tid & 3, g = h >> 2;
  float S[32];
  if (s < 32) {
#pragma unroll
    for (int i = 0; i < 32; ++i) S[i] = 0.f;
  } else {
    const float* st = p.state_ssm + ((((size_t)(s - 32) * 4 + l) * 2 + d) * 32 + h) * 8192 + pp * 128 + nq * 32;
#pragma unroll
    for (int i = 0; i < 32; ++i) S[i] = st[i];
  }
  const float a = -expf(p.ssd_a_log[l * 64 + d * 32 + h]);
  float* xs = sm; float* Bs = sm + 1024; float* Cs = Bs + 2048; float* dts = Cs + 2048;
  const bf16_t* xc = (const bf16_t*)(p.ws + OFF_XC);
  const float* dtb = (const float*)(p.ws + OFF_DT);
  float* ydir = (float*)(p.ws + (d == 0 ? OFF_YF : OFF_YB));
  for (int bt = 0; bt < L / 16; ++bt) {
    const int tb = d == 0 ? bt * 16 : L - 16 - bt * 16;
    __syncthreads();
    for (int e = tid; e < 16 * 320; e += 256) {
      const int tt = e / 320, c = e % 320;
      const size_t base = (size_t)(tok0 + tb + tt) * 4096;
      if (c < 64) xs[tt * 64 + c] = bf2f(xc[base + h * 64 + c]);
      else if (c < 192) Bs[tt * 128 + c - 64] = bf2f(xc[base + 2048 + g * 128 + c - 64]);
      else Cs[tt * 128 + c - 192] = bf2f(xc[base + 3072 + g * 128 + c - 192]);
    }
    if (tid < 16) dts[tid] = dtb[(size_t)(tok0 + tb + tid) * 64 + d * 32 + h];
    __syncthreads();
    for (int i2 = 0; i2 < 16; ++i2) {
      const int tt = d == 0 ? i2 : 15 - i2;
      const float dt = dts[tt], dA = expf(dt * a), xdt = xs[tt * 64 + pp] * dt;
      float acc = 0.f;
      const float* Bp = Bs + tt * 128 + nq * 32;
      const float* Cp = Cs + tt * 128 + nq * 32;
#pragma unroll
      for (int i = 0; i < 32; ++i) { S[i] = dA * S[i] + xdt * Bp[i]; acc += S[i] * Cp[i]; }
      acc += __shfl_xor(acc, 1); acc += __shfl_xor(acc, 2);
      if (nq == 0) ydir[(size_t)(tok0 + tb + tt) * 2048 + h * 64 + pp] = acc;
    }
  }
  if (s < 32) {
    float* o = p.out + OUT_SSM + ((((size_t)s * 4 + l) * 2 + d) * 32 + h) * 8192 + pp * 128 + nq * 32;
#pragma unroll
    for (int i = 0; i < 32; ++i) o[i] = S[i];
  }
}

__device__ __forceinline__ void hgrn_naive_item(const Params& p, int l, int item, float* sm) {
  const int d = item & 1, hd = (item >> 1) & 7, s = item >> 4;
  int tok0, L;
  if (s < 32) { tok0 = s * 256; L = 256; } else { tok0 = TCTX + (s - 32) * 2048; L = 2048; }
  const int tid = tid_opaque(), vv = tid >> 1, kh = tid & 1;
  float S[64];
  if (s < 32) {
#pragma unroll
    for (int i = 0; i < 64; ++i) S[i] = 0.f;
  } else {
    const float* st = p.state_hgrn + ((((size_t)(s - 32) * 4 + l) * 2 + d) * 8 + hd) * 16384 + (size_t)(kh * 64) * 128 + vv;
#pragma unroll
    for (int i = 0; i < 64; ++i) S[i] = st[(size_t)i * 128];
  }
  float* qs = sm; float* fs = sm + 2048; float* ks = sm + 4096; float* vs = sm + 6144;
  const bf16_t* proj = (const bf16_t*)(p.ws + OFF_PROJ);
  const float* lb = (const float*)(p.ws + OFF_LB) + (size_t)l * 2048 + d * 1024 + hd * 128;
  float* odir = (float*)(p.ws + (d == 0 ? OFF_OF : OFF_OB));
  for (int bt = 0; bt < L / 16; ++bt) {
    const int tb = d == 0 ? bt * 16 : L - 16 - bt * 16;
    __syncthreads();
    for (int e = tid; e < 16 * 128; e += 256) {
      const int tt = e >> 7, c = e & 127;
      const size_t base = (size_t)(tok0 + tb + tt) * NPROJ_PAD;
      const float q = bf2f(proj[base + C_HQ + hd * 128 + c]);
      const float u = bf2f(proj[base + C_HF + d * 1024 + hd * 128 + c]);
      const float lbv = lb[c];
      const float sg = sigmoidf_(u);
      qs[e] = siluf_(q);
      fs[e] = lbv + (1.f - lbv) * sg;
      ks[e] = (1.f - lbv) * (1.f - sg);
      vs[e] = bf2f(proj[base + C_HI + hd * 128 + c]);
    }
    __syncthreads();
    for (int i2 = 0; i2 < 16; ++i2) {
      const int tt = d == 0 ? i2 : 15 - i2;
      const float vval = vs[tt * 128 + vv];
      const float* fp = fs + tt * 128 + kh * 64;
      const float* kp = ks + tt * 128 + kh * 64;
      const float* qp = qs + tt * 128 + kh * 64;
      float acc = 0.f;
#pragma unroll
      for (int i = 0; i < 64; ++i) { S[i] = fp[i] * S[i] + kp[i] * vval; acc += S[i] * qp[i]; }
      acc += __shfl_xor(acc, 1);
      if (kh == 0) odir[(size_t)(tok0 + tb + tt) * 1024 + hd * 128 + vv] = acc;
    }
  }
  if (s < 32) {
    float* o = p.out + OUT_HGRN + ((((size_t)s * 4 + l) * 2 + d) * 8 + hd) * 16384 + (size_t)(kh * 64) * 128 + vv;
#pragma unroll
    for (int i = 0; i < 64; ++i) o[(size_t)i * 128] = S[i];
  }
}


constexpr int HG_ROW = 272;
constexpr int HG_IMG = 16 * HG_ROW;
constexpr int HG_BUF = 4 * HG_IMG + 512;
__device__ __forceinline__ void hgrn_chunk_item(const Params& p, int l, int item, char* smem, int c0 = 0, int c1 = 1 << 20) {
  const int d = item & 1, hd = (item >> 1) & 7, s = item >> 4;
  int tok0, L;
  if (s < 32) { tok0 = s * 256; L = 256; } else { tok0 = TCTX + (s - 32) * 2048; L = 2048; }
  const int tid = tid_opaque(), lane = tid & 63, w = tid >> 6, fr = lane & 15, fq = lane >> 4;
  const int ch = tid & 127, half = tid >> 7;
  f32x4 S[8][2];
  if (s < 32) {
#pragma unroll
    for (int kt = 0; kt < 8; ++kt) { S[kt][0] = (f32x4){0.f, 0.f, 0.f, 0.f}; S[kt][1] = (f32x4){0.f, 0.f, 0.f, 0.f}; }
  } else {
    const float* st = c0 == 0 ? p.state_hgrn + ((((size_t)(s - 32) * 4 + l) * 2 + d) * 8 + hd) * 16384
                              : (const float*)(p.ws + OFF_YB + ((size_t)8 << 20)) + (size_t)(item - 512) * 16384;
#pragma unroll
    for (int kt = 0; kt < 8; ++kt)
#pragma unroll
      for (int vt = 0; vt < 2; ++vt)
#pragma unroll
        for (int jj = 0; jj < 4; ++jj) S[kt][vt][jj] = st[(size_t)(16 * kt + fq * 4 + jj) * 128 + 32 * w + 16 * vt + fr];
  }
  const float lbv = ((const float*)(p.ws + OFF_LB))[(size_t)l * 2048 + d * 1024 + hd * 128 + ch];
  const bf16_t* proj = (const bf16_t*)(p.ws + OFF_PROJ);
  float* odir = (float*)(p.ws + (d == 0 ? OFF_OF : OFF_OB));
  float* xch = (float*)(smem + 2 * HG_BUF);
  const int nch = L >> 4;
  if (c1 > nch) c1 = nch;
  bf16_t rq[8], ru[8], rv[8];
  __syncthreads();
  {
#pragma unroll
    for (int i = 0; i < 8; ++i) {
      const int pos = c0 * 16 + 8 * half + i;
      const size_t tk = (size_t)(d == 0 ? tok0 + pos : tok0 + L - 1 - pos) * NPROJ_PAD;
      rq[i] = proj[tk + C_HQ + hd * 128 + ch];
      ru[i] = proj[tk + C_HF + d * 1024 + hd * 128 + ch];
      rv[i] = proj[tk + C_HI + hd * 128 + ch];
    }
  }
  for (int c = c0; c < c1; ++c) {
    char* buf = smem + (c & 1) * HG_BUF;
    float* xc_ = xch + (c & 1) * 256;
    float fv[8], kk[8], qs[8];
    float loc = 1.f;
#pragma unroll
    for (int i = 0; i < 8; ++i) {
      const float u = bf2f(ru[i]);
      const float sg = sigmoidf_(u);
      fv[i] = lbv + (1.f - lbv) * sg;
      kk[i] = (1.f - lbv) * (1.f - sg);
      qs[i] = siluf_(bf2f(rq[i]));
      loc *= fv[i];
      *(bf16_t*)(buf + 3 * HG_IMG + (8 * half + i) * HG_ROW + ch * 2) = rv[i];
    }
    xc_[half * 128 + ch] = loc;
    if (c + 1 < c1) {
#pragma unroll
      for (int i = 0; i < 8; ++i) {
        const int pos = (c + 1) * 16 + 8 * half + i;
        const size_t tk = (size_t)(d == 0 ? tok0 + pos : tok0 + L - 1 - pos) * NPROJ_PAD;
        rq[i] = proj[tk + C_HQ + hd * 128 + ch];
        ru[i] = proj[tk + C_HF + d * 1024 + hd * 128 + ch];
        rv[i] = proj[tk + C_HI + hd * 128 + ch];
      }
    }
    __syncthreads();
    {
      const float other = xc_[(half ^ 1) * 128 + ch];
      float P = half ? other : 1.f;
      float sfx = half ? 1.f : other;
      float suf[8];
#pragma unroll
      for (int i = 7; i >= 0; --i) { suf[i] = sfx; sfx *= fv[i]; }
#pragma unroll
      for (int i = 0; i < 8; ++i) {
        P *= fv[i];
        const int off = (8 * half + i) * HG_ROW + ch * 2;
        *(bf16_t*)(buf + off) = f2bf(qs[i] * P);
        *(bf16_t*)(buf + HG_IMG + off) = f2bf(kk[i] * __builtin_amdgcn_rcpf(fmaxf(P, 1e-30f)));
        *(bf16_t*)(buf + 2 * HG_IMG + off) = f2bf(kk[i] * suf[i]);
      }
      if (half) ((float*)(buf + 4 * HG_IMG))[ch] = P;
    }
    __syncthreads();
    const char* qtI = buf;
    const char* ktI = buf + HG_IMG;
    const float* dec = (const float*)(buf + 4 * HG_IMG);
    f32x4 at = (f32x4){0.f, 0.f, 0.f, 0.f};
#pragma unroll
    for (int ks = 0; ks < 4; ++ks) {
      bf16x8 a = *(const bf16x8*)(ktI + fr * HG_ROW + (32 * ks + fq * 8) * 2);
      bf16x8 b = *(const bf16x8*)(qtI + fr * HG_ROW + (32 * ks + fq * 8) * 2);
      at = __builtin_amdgcn_mfma_f32_16x16x32_bf16(a, b, at, 0, 0, 0);
    }
    s16x4 Pm;
    {
      u32x2 pk;
      pk[0] = pack2((fq * 4 + 0 <= fr) ? at[0] : 0.f, (fq * 4 + 1 <= fr) ? at[1] : 0.f);
      pk[1] = pack2((fq * 4 + 2 <= fr) ? at[2] : 0.f, (fq * 4 + 3 <= fr) ? at[3] : 0.f);
      Pm = __builtin_bit_cast(s16x4, pk);
    }
    const unsigned ldsb = (unsigned)(size_t)buf;
    const unsigned vaddr = ldsb + 3 * HG_IMG + (4 * fq + (fr >> 2)) * HG_ROW + (32 * w + 4 * (fr & 3)) * 2;
    const unsigned kaddr = ldsb + 2 * HG_IMG + (4 * fq + (fr >> 2)) * HG_ROW + (4 * (fr & 3)) * 2;
    s16x4 vf0, vf1, kf0, kf1, kf2, kf3, kf4, kf5, kf6, kf7;
    asm volatile(
        "ds_read_b64_tr_b16 %0, %10\n\t"
        "ds_read_b64_tr_b16 %1, %10 offset:32\n\t"
        "ds_read_b64_tr_b16 %2, %11\n\t"
        "ds_read_b64_tr_b16 %3, %11 offset:32\n\t"
        "ds_read_b64_tr_b16 %4, %11 offset:64\n\t"
        "ds_read_b64_tr_b16 %5, %11 offset:96\n\t"
        "ds_read_b64_tr_b16 %6, %11 offset:128\n\t"
        "ds_read_b64_tr_b16 %7, %11 offset:160\n\t"
        "ds_read_b64_tr_b16 %8, %11 offset:192\n\t"
        "ds_read_b64_tr_b16 %9, %11 offset:224\n\t"
        "s_waitcnt lgkmcnt(0)"
        : "=&v"(vf0), "=&v"(vf1), "=&v"(kf0), "=&v"(kf1), "=&v"(kf2), "=&v"(kf3), "=&v"(kf4), "=&v"(kf5), "=&v"(kf6), "=&v"(kf7)
        : "v"(vaddr), "v"(kaddr)
        : "memory");
    f32x4 o0 = __builtin_amdgcn_mfma_f32_16x16x16bf16_1k(Pm, vf0, (f32x4){0.f, 0.f, 0.f, 0.f}, 0, 0, 0);
    f32x4 o1 = __builtin_amdgcn_mfma_f32_16x16x16bf16_1k(Pm, vf1, (f32x4){0.f, 0.f, 0.f, 0.f}, 0, 0, 0);
#pragma unroll
    for (int ks = 0; ks < 4; ++ks) {
      u32x2 qa = *(const u32x2*)(qtI + fr * HG_ROW + (32 * ks + 4 * fq) * 2);
      u32x2 qb = *(const u32x2*)(qtI + fr * HG_ROW + (32 * ks + 16 + 4 * fq) * 2);
      u32x4 aa; aa[0] = qa[0]; aa[1] = qa[1]; aa[2] = qb[0]; aa[3] = qb[1];
      const bf16x8 A = __builtin_bit_cast(bf16x8, aa);
      u32x4 b0, b1;
      b0[0] = pack2(S[2 * ks][0][0], S[2 * ks][0][1]); b0[1] = pack2(S[2 * ks][0][2], S[2 * ks][0][3]);
      b0[2] = pack2(S[2 * ks + 1][0][0], S[2 * ks + 1][0][1]); b0[3] = pack2(S[2 * ks + 1][0][2], S[2 * ks + 1][0][3]);
      b1[0] = pack2(S[2 * ks][1][0], S[2 * ks][1][1]); b1[1] = pack2(S[2 * ks][1][2], S[2 * ks][1][3]);
      b1[2] = pack2(S[2 * ks + 1][1][0], S[2 * ks + 1][1][1]); b1[3] = pack2(S[2 * ks + 1][1][2], S[2 * ks + 1][1][3]);
      o0 = __builtin_amdgcn_mfma_f32_16x16x32_bf16(A, __builtin_bit_cast(bf16x8, b0), o0, 0, 0, 0);
      o1 = __builtin_amdgcn_mfma_f32_16x16x32_bf16(A, __builtin_bit_cast(bf16x8, b1), o1, 0, 0, 0);
    }
#pragma unroll
    for (int jj = 0; jj < 4; ++jj) {
      const int pos = c * 16 + fq * 4 + jj;
      const size_t tk = (size_t)(d == 0 ? tok0 + pos : tok0 + L - 1 - pos);
      odir[tk * 1024 + hd * 128 + 32 * w + fr] = o0[jj];
      odir[tk * 1024 + hd * 128 + 32 * w + 16 + fr] = o1[jj];
    }
    const s16x4 kfs[8] = {kf0, kf1, kf2, kf3, kf4, kf5, kf6, kf7};
#pragma unroll
    for (int kt = 0; kt < 8; ++kt) {
      const f32x4 dv = *(const f32x4*)(dec + 16 * kt + fq * 4);
      S[kt][0] = __builtin_amdgcn_mfma_f32_16x16x16bf16_1k(kfs[kt], vf0, S[kt][0] * dv, 0, 0, 0);
      S[kt][1] = __builtin_amdgcn_mfma_f32_16x16x16bf16_1k(kfs[kt], vf1, S[kt][1] * dv, 0, 0, 0);
    }
  }
  if (s < 32 || c1 < nch) {
    float* o = s < 32 ? p.out + OUT_HGRN + ((((size_t)s * 4 + l) * 2 + d) * 8 + hd) * 16384
                      : (float*)(p.ws + OFF_YB + ((size_t)8 << 20)) + (size_t)(item - 512) * 16384;
#pragma unroll
    for (int kt = 0; kt < 8; ++kt)
#pragma unroll
      for (int vt = 0; vt < 2; ++vt)
#pragma unroll
        for (int jj = 0; jj < 4; ++jj) o[(size_t)(16 * kt + fq * 4 + jj) * 128 + 32 * w + 16 * vt + fr] = S[kt][vt][jj];
  }
}


constexpr size_t OFF_SST = OFF_YF;
constexpr size_t OFF_CS = OFF_YB;
constexpr int SS_BROW = 272, SS_XROW = 144;
constexpr int SS_R0 = 128 * SS_BROW;
constexpr int SS_R1 = 128 * SS_XROW;

template <int OFF>
__device__ __forceinline__ s16x4 tr_read(unsigned addr) {
  s16x4 r;
  asm volatile("ds_read_b64_tr_b16 %0, %1 offset:%2" : "=v"(r) : "v"(addr), "i"(OFF) : "memory");
  return r;
}
__device__ __forceinline__ bf16x8 cat8(s16x4 a, s16x4 b) {
  bf16x8 r;
  r[0] = a[0]; r[1] = a[1]; r[2] = a[2]; r[3] = a[3]; r[4] = b[0]; r[5] = b[1]; r[6] = b[2]; r[7] = b[3];
  return r;
}
#define TR_WAIT12(a, b, c, d, e, f, g, h, i, j, k, l_)                                                                            \
  asm volatile("s_waitcnt lgkmcnt(0)" : "+v"(a), "+v"(b), "+v"(c), "+v"(d), "+v"(e), "+v"(f), "+v"(g), "+v"(h), "+v"(i), "+v"(j), \
               "+v"(k), "+v"(l_)::"memory")
#define TR_WAIT8(a, b, c, d, e, f, g, h) \
  asm volatile("s_waitcnt lgkmcnt(0)" : "+v"(a), "+v"(b), "+v"(c), "+v"(d), "+v"(e), "+v"(f), "+v"(g), "+v"(h)::"memory")

template <int KS>
__device__ __forceinline__ void ssd_p1_kstep(f32x4 (&acc)[2][4], unsigned abase, unsigned xbase) {
  s16x4 a00, a01, a10, a11, b00, b01, b10, b11, b20, b21, b30, b31;
  asm volatile(
      "ds_read_b64_tr_b16 %0, %12 offset:%14\n\t"
      "ds_read_b64_tr_b16 %1, %12 offset:%15\n\t"
      "ds_read_b64_tr_b16 %2, %12 offset:%16\n\t"
      "ds_read_b64_tr_b16 %3, %12 offset:%17\n\t"
      "ds_read_b64_tr_b16 %4, %13 offset:%18\n\t"
      "ds_read_b64_tr_b16 %5, %13 offset:%19\n\t"
      "ds_read_b64_tr_b16 %6, %13 offset:%20\n\t"
      "ds_read_b64_tr_b16 %7, %13 offset:%21\n\t"
      "ds_read_b64_tr_b16 %8, %13 offset:%22\n\t"
      "ds_read_b64_tr_b16 %9, %13 offset:%23\n\t"
      "ds_read_b64_tr_b16 %10, %13 offset:%24\n\t"
      "ds_read_b64_tr_b16 %11, %13 offset:%25\n\t"
      "s_waitcnt lgkmcnt(0)"
      : "=&v"(a00), "=&v"(a01), "=&v"(a10), "=&v"(a11), "=&v"(b00), "=&v"(b01), "=&v"(b10), "=&v"(b11), "=&v"(b20), "=&v"(b21),
        "=&v"(b30), "=&v"(b31)
      : "v"(abase), "v"(xbase), "i"(KS * 32 * SS_BROW), "i"(KS * 32 * SS_BROW + 4 * SS_BROW), "i"(KS * 32 * SS_BROW + 32),
        "i"(KS * 32 * SS_BROW + 4 * SS_BROW + 32), "i"(KS * 32 * SS_XROW), "i"(KS * 32 * SS_XROW + 4 * SS_XROW),
        "i"(KS * 32 * SS_XROW + 32), "i"(KS * 32 * SS_XROW + 4 * SS_XROW + 32), "i"(KS * 32 * SS_XROW + 64),
        "i"(KS * 32 * SS_XROW + 4 * SS_XROW + 64), "i"(KS * 32 * SS_XROW + 96), "i"(KS * 32 * SS_XROW + 4 * SS_XROW + 96)
      : "memory");
  const bf16x8 A0 = cat8(a00, a01), A1 = cat8(a10, a11);
  const bf16x8 B0 = cat8(b00, b01), B1 = cat8(b10, b11), B2 = cat8(b20, b21), B3 = cat8(b30, b31);
  acc[0][0] = __builtin_amdgcn_mfma_f32_16x16x32_bf16(A0, B0, acc[0][0], 0, 0, 0);
  acc[0][1] = __builtin_amdgcn_mfma_f32_16x16x32_bf16(A0, B1, acc[0][1], 0, 0, 0);
  acc[0][2] = __builtin_amdgcn_mfma_f32_16x16x32_bf16(A0, B2, acc[0][2], 0, 0, 0);
  acc[0][3] = __builtin_amdgcn_mfma_f32_16x16x32_bf16(A0, B3, acc[0][3], 0, 0, 0);
  acc[1][0] = __builtin_amdgcn_mfma_f32_16x16x32_bf16(A1, B0, acc[1][0], 0, 0, 0);
  acc[1][1] = __builtin_amdgcn_mfma_f32_16x16x32_bf16(A1, B1, acc[1][1], 0, 0, 0);
  acc[1][2] = __builtin_amdgcn_mfma_f32_16x16x32_bf16(A1, B2, acc[1][2], 0, 0, 0);
  acc[1][3] = __builtin_amdgcn_mfma_f32_16x16x32_bf16(A1, B3, acc[1][3], 0, 0, 0);
}

__device__ __forceinline__ void ssd_pass1_item(const Params& p, int l, int item, char* smem) {
  const int d = item & 1, h = (item >> 1) & 31, s = item >> 6, g = h >> 2;
  const int nc = s < 32 ? 2 : 16, cg0 = s < 32 ? 2 * s : 64 + 16 * (s - 32);
  const int tid = tid_opaque(), lane = tid & 63, w = tid >> 6, fr = lane & 15, fq = lane >> 4;
  const float a = -expf(p.ssd_a_log[l * 64 + d * 32 + h]);
  f32x4 acc[2][4];
  if (s < 32) {
#pragma unroll
    for (int i = 0; i < 2; ++i)
#pragma unroll
      for (int j = 0; j < 4; ++j) acc[i][j] = (f32x4){0.f, 0.f, 0.f, 0.f};
  } else {
    const float* st = p.state_ssm + ((((size_t)(s - 32) * 4 + l) * 2 + d) * 32 + h) * 8192;
#pragma unroll
    for (int i = 0; i < 2; ++i)
#pragma unroll
      for (int j = 0; j < 4; ++j) acc[i][j] = *(const f32x4*)(st + (size_t)(16 * j + fr) * 128 + 32 * w + 16 * i + 4 * fq);
  }
  const bf16_t* xc = (const bf16_t*)(p.ws + OFF_XC);
  const float* dtb = (const float*)(p.ws + OFF_DT);
  float* csb = (float*)(p.ws + OFF_CS);
  bf16_t* sst = (bf16_t*)(p.ws + OFF_SST);
  float* wgt = (float*)(smem + SS_R0 + SS_R1);
  u32x4 pb[8], px[4];
  float dt0, dt1;
  {
    const int c = d == 0 ? 0 : nc - 1;
    const size_t tb = (size_t)(cg0 + c) * 128;
#pragma unroll
    for (int i = 0; i < 8; ++i) { const int q = tid + 256 * i; pb[i] = *(const u32x4*)(xc + (tb + (q >> 4)) * 4096 + 2048 + g * 128 + (q & 15) * 8); }
#pragma unroll
    for (int i = 0; i < 4; ++i) { const int q = tid + 256 * i; px[i] = *(const u32x4*)(xc + (tb + (q >> 3)) * 4096 + h * 64 + (q & 7) * 8); }
    dt0 = dtb[(tb + 2 * lane) * 64 + d * 32 + h];
    dt1 = dtb[(tb + 2 * lane + 1) * 64 + d * 32 + h];
  }
  const unsigned ldsb = (unsigned)(size_t)smem;
  const unsigned abase = ldsb + (8 * fq + (fr >> 2)) * SS_BROW + (32 * w + 4 * (fr & 3)) * 2;
  const unsigned xbase = ldsb + SS_R0 + (8 * fq + (fr >> 2)) * SS_XROW + (4 * (fr & 3)) * 2;
  for (int cc = 0; cc < nc; ++cc) {
    const int c = d == 0 ? cc : nc - 1 - cc, par = cc & 1;
    const size_t cgl = cg0 + c, tb = cgl * 128;
    {
      bf16_t* so = sst + ((cgl * 32 + h) * 2 + d) * 8192;
#pragma unroll
      for (int i = 0; i < 2; ++i)
#pragma unroll
        for (int j = 0; j < 4; ++j) {
          u32x2 o; o[0] = pack2(acc[i][j][0], acc[i][j][1]); o[1] = pack2(acc[i][j][2], acc[i][j][3]);
          *(u32x2*)(so + (size_t)(16 * j + fr) * 128 + 32 * w + 16 * i + 4 * fq) = o;
        }
    }
    if (w == 0) {
      const float v0 = dt0 * a, v1 = dt1 * a, sloc = v0 + v1;
      float incl = sloc;
#pragma unroll
      for (int off = 1; off < 64; off <<= 1) { const float t = __shfl_up(incl, off); if (lane >= off) incl += t; }
      const float excl = incl - sloc, c0 = excl + v0, tot = __shfl(incl, 63);
      float cs0, cs1, wg0, wg1;
      if (d == 0) { cs0 = c0; cs1 = incl; wg0 = dt0 * __expf(tot - c0); wg1 = dt1 * __expf(tot - incl); }
      else { cs0 = tot - excl; cs1 = tot - c0; wg0 = dt0 * __expf(excl); wg1 = dt1 * __expf(c0); }
      csb[(tb + 2 * lane) * 64 + d * 32 + h] = cs0;
      csb[(tb + 2 * lane + 1) * 64 + d * 32 + h] = cs1;
      wgt[par * 128 + 2 * lane] = wg0;
      wgt[par * 128 + 2 * lane + 1] = wg1;
      if (lane == 0) wgt[256 + par] = __expf(tot);
    }
    __syncthreads();
#pragma unroll
    for (int i = 0; i < 8; ++i) { const int q = tid + 256 * i; *(u32x4*)(smem + (q >> 4) * SS_BROW + (q & 15) * 16) = pb[i]; }
#pragma unroll
    for (int i = 0; i < 4; ++i) {
      const int q = tid + 256 * i, row = q >> 3;
      const float wv = wgt[par * 128 + row];
      u32x4 o;
#pragma unroll
      for (int e = 0; e < 4; ++e) o[e] = pack2(bf2f((bf16_t)(px[i][e] & 0xffff)) * wv, bf2f((bf16_t)(px[i][e] >> 16)) * wv);
      *(u32x4*)(smem + SS_R0 + row * SS_XROW + (q & 7) * 16) = o;
    }
    if (cc + 1 < nc) {
      const int cn = d == 0 ? cc + 1 : nc - 2 - cc;
      const size_t tbn = (size_t)(cg0 + cn) * 128;
#pragma unroll
      for (int i = 0; i < 8; ++i) { const int q = tid + 256 * i; pb[i] = *(const u32x4*)(xc + (tbn + (q >> 4)) * 4096 + 2048 + g * 128 + (q & 15) * 8); }
#pragma unroll
      for (int i = 0; i < 4; ++i) { const int q = tid + 256 * i; px[i] = *(const u32x4*)(xc + (tbn + (q >> 3)) * 4096 + h * 64 + (q & 7) * 8); }
      dt0 = dtb[(tbn + 2 * lane) * 64 + d * 32 + h];
      dt1 = dtb[(tbn + 2 * lane + 1) * 64 + d * 32 + h];
    }
    __syncthreads();
    const float dec = wgt[256 + par];
#pragma unroll
    for (int i = 0; i < 2; ++i)
#pragma unroll
      for (int j = 0; j < 4; ++j) acc[i][j] *= dec;
    ssd_p1_kstep<0>(acc, abase, xbase);
    ssd_p1_kstep<1>(acc, abase, xbase);
    ssd_p1_kstep<2>(acc, abase, xbase);
    ssd_p1_kstep<3>(acc, abase, xbase);
  }
  if (s < 32) {
    float* o = p.out + OUT_SSM + ((((size_t)s * 4 + l) * 2 + d) * 32 + h) * 8192;
#pragma unroll
    for (int i = 0; i < 2; ++i)
#pragma unroll
      for (int j = 0; j < 4; ++j) *(f32x4*)(o + (size_t)(16 * j + fr) * 128 + 32 * w + 16 * i + 4 * fq) = acc[i][j];
  }
  __syncthreads();
}

template <int KS>
__device__ __forceinline__ void ssd_p2_wx_kstep(f32x4 (&y)[4], const char* wrow, unsigned xbase) {
  s16x4 b00, b01, b10, b11, b20, b21, b30, b31;
  const bf16x8 A = *(const bf16x8*)(wrow + KS * 64);
  asm volatile(
      "ds_read_b64_tr_b16 %0, %8 offset:%9\n\t"
      "ds_read_b64_tr_b16 %1, %8 offset:%10\n\t"
      "ds_read_b64_tr_b16 %2, %8 offset:%11\n\t"
      "ds_read_b64_tr_b16 %3, %8 offset:%12\n\t"
      "ds_read_b64_tr_b16 %4, %8 offset:%13\n\t"
      "ds_read_b64_tr_b16 %5, %8 offset:%14\n\t"
      "ds_read_b64_tr_b16 %6, %8 offset:%15\n\t"
      "ds_read_b64_tr_b16 %7, %8 offset:%16\n\t"
      "s_waitcnt lgkmcnt(0)"
      : "=&v"(b00), "=&v"(b01), "=&v"(b10), "=&v"(b11), "=&v"(b20), "=&v"(b21), "=&v"(b30), "=&v"(b31)
      : "v"(xbase), "i"(KS * 32 * SS_XROW), "i"(KS * 32 * SS_XROW + 4 * SS_XROW), "i"(KS * 32 * SS_XROW + 32),
        "i"(KS * 32 * SS_XROW + 4 * SS_XROW + 32), "i"(KS * 32 * SS_XROW + 64), "i"(KS * 32 * SS_XROW + 4 * SS_XROW + 64),
        "i"(KS * 32 * SS_XROW + 96), "i"(KS * 32 * SS_XROW + 4 * SS_XROW + 96)
      : "memory");
  y[0] = __builtin_amdgcn_mfma_f32_16x16x32_bf16(A, cat8(b00, b01), y[0], 0, 0, 0);
  y[1] = __builtin_amdgcn_mfma_f32_16x16x32_bf16(A, cat8(b10, b11), y[1], 0, 0, 0);
  y[2] = __builtin_amdgcn_mfma_f32_16x16x32_bf16(A, cat8(b20, b21), y[2], 0, 0, 0);
  y[3] = __builtin_amdgcn_mfma_f32_16x16x32_bf16(A, cat8(b30, b31), y[3], 0, 0, 0);
}

__device__ __forceinline__ void ssd_pass2_item(const Params& p, int l, int item, char* smem) {
  const int hf = item & 1, g = (item >> 1) & 7, cg = item >> 4;
  const size_t tb = (size_t)cg * 128;
  const int tid = tid_opaque(), lane = tid & 63, w = tid >> 6, fr = lane & 15, fq = lane >> 4;
  const int i0 = 64 * hf + 16 * w;
  const bf16_t* xc = (const bf16_t*)(p.ws + OFF_XC);
  const bf16_t* proj = (const bf16_t*)(p.ws + OFF_PROJ);
  const float* dtb = (const float*)(p.ws + OFF_DT);
  const float* csb = (const float*)(p.ws + OFF_CS);
  const bf16_t* sst = (const bf16_t*)(p.ws + OFF_SST);
  bf16_t* ybuf = (bf16_t*)(p.ws + OFF_YBUF);
  float* arr = (float*)(smem + SS_R0 + SS_R1);
  __syncthreads();
  bf16x8 cfr[4];
#pragma unroll
  for (int ks = 0; ks < 4; ++ks) cfr[ks] = *(const bf16x8*)(xc + (tb + i0 + fr) * 4096 + 3072 + g * 128 + 32 * ks + 8 * fq);
#pragma unroll
  for (int i = 0; i < 8; ++i) {
    const int idx = tid + 256 * i, hh = idx >> 9, a = (idx >> 7) & 3, j = idx & 127;
    const float* src = (a < 2 ? csb : dtb) + (tb + j) * 64 + (a & 1) * 32 + 4 * g + hh;
    arr[idx] = *src;
  }
#pragma unroll
  for (int i = 0; i < 8; ++i) {
    const int q = tid + 256 * i;
    *(u32x4*)(smem + (q >> 4) * SS_BROW + (q & 15) * 16) = *(const u32x4*)(xc + (tb + (q >> 4)) * 4096 + 2048 + g * 128 + (q & 15) * 8);
  }
  __syncthreads();
  f32x4 cb[8];
#pragma unroll
  for (int jt = 0; jt < 8; ++jt) cb[jt] = (f32x4){0.f, 0.f, 0.f, 0.f};
#pragma unroll
  for (int ks = 0; ks < 4; ++ks)
#pragma unroll
    for (int jt = 0; jt < 8; ++jt) {
      const bf16x8 A = *(const bf16x8*)(smem + (16 * jt + fr) * SS_BROW + (32 * ks + 8 * fq) * 2);
      cb[jt] = __builtin_amdgcn_mfma_f32_16x16x32_bf16(A, cfr[ks], cb[jt], 0, 0, 0);
    }
  __syncthreads();
  float ssr[2] = {0.f, 0.f};
  const unsigned ldsb = (unsigned)(size_t)smem;
  const unsigned xbase = ldsb + SS_R0 + (8 * fq + (fr >> 2)) * SS_XROW + (4 * (fr & 3)) * 2;
  const char* wrow = smem + (16 * w + fr) * SS_BROW + (8 * fq) * 2;
  const int il = i0 + fr;
#pragma unroll 1
  for (int hh = 0; hh < 4; ++hh) {
    const int h = 4 * g + hh;
    u32x4 pre[4];
#pragma unroll
    for (int i = 0; i < 4; ++i) { const int q = tid + 256 * i; pre[i] = *(const u32x4*)(xc + (tb + (q >> 3)) * 4096 + h * 64 + (q & 7) * 8); }
    const float* csf = arr + hh * 512;
    const float* csr = csf + 128;
    const float* dtf = csf + 256;
    const float* dtr = csf + 384;
    {
      const float cfi = csf[il], cbi = csr[il];
#pragma unroll
      for (int jt = 0; jt < 8; ++jt) {
        const f32x4 cfj = *(const f32x4*)(csf + 16 * jt + 4 * fq), cbj = *(const f32x4*)(csr + 16 * jt + 4 * fq);
        const f32x4 dfj = *(const f32x4*)(dtf + 16 * jt + 4 * fq), dbj = *(const f32x4*)(dtr + 16 * jt + 4 * fq);
        float wv[4];
#pragma unroll
        for (int jj = 0; jj < 4; ++jj) {
          const int j = 16 * jt + 4 * fq + jj;
          const bool le = j <= il;
          float mlt = __expf(le ? cfi - cfj[jj] : cbi - cbj[jj]) * (le ? dfj[jj] : dbj[jj]);
          if (j == il) mlt = dfj[jj] + dbj[jj];
          wv[jj] = cb[jt][jj] * mlt;
        }
        u32x2 o; o[0] = pack2(wv[0], wv[1]); o[1] = pack2(wv[2], wv[3]);
        *(u32x2*)(smem + (16 * w + fr) * SS_BROW + (16 * jt + 4 * fq) * 2) = o;
      }
    }
#pragma unroll
    for (int i = 0; i < 4; ++i) { const int q = tid + 256 * i; *(u32x4*)(smem + SS_R0 + (q >> 3) * SS_XROW + (q & 7) * 16) = pre[i]; }
#pragma unroll
    for (int i = 0; i < 4; ++i) { const int q = tid + 256 * i; pre[i] = *(const u32x4*)(sst + (((size_t)cg * 32 + h) * 2 + 0) * 8192 + (q >> 4) * 128 + (q & 15) * 8); }
    __syncthreads();
    f32x4 y[4];
#pragma unroll
    for (int pt = 0; pt < 4; ++pt) y[pt] = (f32x4){0.f, 0.f, 0.f, 0.f};
    ssd_p2_wx_kstep<0>(y, wrow, xbase);
    ssd_p2_wx_kstep<1>(y, wrow, xbase);
    ssd_p2_wx_kstep<2>(y, wrow, xbase);
    ssd_p2_wx_kstep<3>(y, wrow, xbase);
    float xsk[4][4];
#pragma unroll
    for (int pt = 0; pt < 4; ++pt)
#pragma unroll
      for (int jj = 0; jj < 4; ++jj) xsk[pt][jj] = bf2f(*(const bf16_t*)(smem + SS_R0 + (i0 + 4 * fq + jj) * SS_XROW + (16 * pt + fr) * 2));
    __syncthreads();
#pragma unroll
    for (int i = 0; i < 4; ++i) { const int q = tid + 256 * i; *(u32x4*)(smem + SS_R0 + (q >> 4) * SS_BROW + (q & 15) * 16) = pre[i]; }
#pragma unroll
    for (int i = 0; i < 4; ++i) { const int q = tid + 256 * i; pre[i] = *(const u32x4*)(sst + (((size_t)cg * 32 + h) * 2 + 1) * 8192 + (q >> 4) * 128 + (q & 15) * 8); }
    __syncthreads();
    f32x4 zf[4], zb[4];
#pragma unroll
    for (int pt = 0; pt < 4; ++pt) { zf[pt] = (f32x4){0.f, 0.f, 0.f, 0.f}; zb[pt] = (f32x4){0.f, 0.f, 0.f, 0.f}; }
#pragma unroll
    for (int ks = 0; ks < 4; ++ks)
#pragma unroll
      for (int pt = 0; pt < 4; ++pt) {
        const bf16x8 B = *(const bf16x8*)(smem + SS_R0 + (16 * pt + fr) * SS_BROW + (32 * ks + 8 * fq) * 2);
        zf[pt] = __builtin_amdgcn_mfma_f32_16x16x32_bf16(cfr[ks], B, zf[pt], 0, 0, 0);
      }
    __syncthreads();
#pragma unroll
    for (int i = 0; i < 4; ++i) { const int q = tid + 256 * i; *(u32x4*)(smem + SS_R0 + (q >> 4) * SS_BROW + (q & 15) * 16) = pre[i]; }
    __syncthreads();
#pragma unroll
    for (int ks = 0; ks < 4; ++ks)
#pragma unroll
      for (int pt = 0; pt < 4; ++pt) {
        const bf16x8 B = *(const bf16x8*)(smem + SS_R0 + (16 * pt + fr) * SS_BROW + (32 * ks + 8 * fq) * 2);
        zb[pt] = __builtin_amdgcn_mfma_f32_16x16x32_bf16(cfr[ks], B, zb[pt], 0, 0, 0);
      }
    const float dsk = p.ssd_d[l * 32 + h];
    char* est = smem + 61440 + w * 2304;
#pragma unroll
    for (int jj = 0; jj < 4; ++jj) {
      const int i2 = i0 + 4 * fq + jj;
      const float ef = __expf(csf[i2]), eb = __expf(csr[i2]);
#pragma unroll
      for (int pt = 0; pt < 4; ++pt) {
        const float val = y[pt][jj] + ef * zf[pt][jj] + eb * zb[pt][jj] + dsk * xsk[pt][jj];
        *(bf16_t*)(est + (4 * fq + jj) * 144 + (16 * pt + fr) * 2) = f2bf(val);
      }
    }
#pragma unroll
    for (int ps = 0; ps < 2; ++ps) {
      const int r = (lane >> 3) + 8 * ps, c8 = lane & 7;
      const u32x4 pv = *(const u32x4*)(est + r * 144 + c8 * 16);
      const size_t tk = tb + i0 + r;
      const u32x4 zv = *(const u32x4*)(proj + tk * NPROJ_PAD + C_Z + h * 64 + c8 * 8);
      u32x4 o;
#pragma unroll
      for (int e = 0; e < 4; ++e) {
        const float g0 = bf2f((bf16_t)(pv[e] & 0xffff)) * siluf_(bf2f((bf16_t)(zv[e] & 0xffff)));
        const float g1 = bf2f((bf16_t)(pv[e] >> 16)) * siluf_(bf2f((bf16_t)(zv[e] >> 16)));
        ssr[ps] += g0 * g0 + g1 * g1;
        o[e] = pack2(g0, g1);
      }
      *(u32x4*)(ybuf + tk * 2048 + h * 64 + c8 * 8) = o;
    }
    __syncthreads();
  }
#pragma unroll
  for (int ps = 0; ps < 2; ++ps) {
    float t = ssr[ps];
    t += __shfl_xor(t, 1); t += __shfl_xor(t, 2); t += __shfl_xor(t, 4);
    ssr[ps] = rsqrtf(t * (1.f / 256.f) + 1e-6f);
  }
#pragma unroll
  for (int hh = 0; hh < 4; ++hh) {
    const int chb = (4 * g + hh) * 64 + (lane & 7) * 8;
    const f32x4 nwa = *(const f32x4*)(p.ssd_norm_w + l * 2048 + chb), nwb = *(const f32x4*)(p.ssd_norm_w + l * 2048 + chb + 4);
#pragma unroll
    for (int ps = 0; ps < 2; ++ps) {
      bf16_t* yp = ybuf + (tb + i0 + (lane >> 3) + 8 * ps) * 2048 + chb;
      const u32x4 v = *(const u32x4*)yp;
      const float rs = ssr[ps];
      u32x4 o;
      o[0] = pack2(bf2f((bf16_t)(v[0] & 0xffff)) * rs * nwa[0], bf2f((bf16_t)(v[0] >> 16)) * rs * nwa[1]);
      o[1] = pack2(bf2f((bf16_t)(v[1] & 0xffff)) * rs * nwa[2], bf2f((bf16_t)(v[1] >> 16)) * rs * nwa[3]);
      o[2] = pack2(bf2f((bf16_t)(v[2] & 0xffff)) * rs * nwb[0], bf2f((bf16_t)(v[2] >> 16)) * rs * nwb[1]);
      o[3] = pack2(bf2f((bf16_t)(v[3] & 0xffff)) * rs * nwb[2], bf2f((bf16_t)(v[3] >> 16)) * rs * nwb[3]);
      *(u32x4*)yp = o;
    }
  }
}

__device__ __forceinline__ void phase_scan1(const Params& p, int l, char* smem) {
  const int bid = blockIdx.x;
  if (bid < 64) { hgrn_chunk_item(p, l, 32 * 16 + bid, smem, 32, 128); return; }
  if (bid >= 256 && bid < 320) return;
  const int wkr = bid < 256 ? bid - 64 : bid - 128;
  for (int it = wkr; it < 256 + 512 + 2048; it += 384) {
    if (it < 256) ssd_pass1_item(p, l, 32 * 64 + it, smem);
    else if (it < 768) hgrn_chunk_item(p, l, it - 256, smem);
    else ssd_pass1_item(p, l, it - 768, smem);
  }
}
__device__ __forceinline__ void phase_scan2(const Params& p, int l, char* smem) {
  for (int it = blockIdx.x; it < 2048; it += gridDim.x) ssd_pass2_item(p, l, it, smem);
}

__device__ __forceinline__ void phase_scan_naive(const Params& p, int l, char* smem) {
  const int n_ssd = 36 * 64, n_hg = 36 * 16;
  for (int it = blockIdx.x; it < n_ssd + n_hg; it += gridDim.x) {
    if (it < 256) ssd_naive_item(p, l, 32 * 64 + it, (float*)smem);
    else if (it < 320) hgrn_chunk_item(p, l, 32 * 16 + (it - 256), smem);
    else if (it < 320 + 2048) ssd_naive_item(p, l, it - 320, (float*)smem);
    else hgrn_chunk_item(p, l, it - 320 - 2048, smem);
  }
}

__device__ __forceinline__ void phase_post(const Params& p, int l) {
  const int tid = tid_opaque();
  const bf16_t* proj = (const bf16_t*)(p.ws + OFF_PROJ);
  const bf16_t* xc = (const bf16_t*)(p.ws + OFF_XC);
  const float* yf = (const float*)(p.ws + OFF_YF);
  const float* yb = (const float*)(p.ws + OFF_YB);
  const float* of = (const float*)(p.ws + OFF_OF);
  const float* ob = (const float*)(p.ws + OFF_OB);
  bf16_t* ybuf = (bf16_t*)(p.ws + OFF_YBUF);
  bf16_t* obuf = (bf16_t*)(p.ws + OFF_OBUF);
  for (int tok = blockIdx.x; tok < T; tok += gridDim.x) {
    {
      const int ch = tid * 4;
      const float* a = of + (size_t)tok * 1024 + ch;
      const float* b = ob + (size_t)tok * 1024 + ch;
      uint2 gv = *(const uint2*)(proj + (size_t)tok * NPROJ_PAD + C_HG + ch);
      const unsigned gw[2] = {gv.x, gv.y};
      float v[4];
      float ss = 0.f;
#pragma unroll
      for (int j = 0; j < 4; ++j) { v[j] = a[j] + b[j]; ss += v[j] * v[j]; }
#pragma unroll
      for (int o = 16; o >= 1; o >>= 1) ss += __shfl_xor(ss, o);
      const float rstd = rsqrtf(ss * (1.f / 128.f) + 1e-6f);
      const float* nw = p.hgrn_norm_w + l * 1024 + ch;
      float r[4];
#pragma unroll
      for (int j = 0; j < 4; ++j) {
        const float gz = bf2f((bf16_t)((j & 1) ? (gw[j >> 1] >> 16) : (gw[j >> 1] & 0xffff)));
        r[j] = v[j] * rstd * nw[j] * siluf_(gz);
      }
      uint2 o2; o2.x = pack2(r[0], r[1]); o2.y = pack2(r[2], r[3]);
      *(uint2*)(obuf + (size_t)tok * 1024 + ch) = o2;
    }
  }
}


#define XB_TMO 128
#define XB_XCNT(j) (256 + 64 * (j))
#define XB_XSUB(j) (1280 + 64 * (j))
#define XB_XGEN(j) (2304 + 64 * (j))
#define XB_TOP 3328
#define XB_TOPGEN 3392
#define XCD_BAR_WORDS 3456
#define XB_SPIN_CAP (1u << 22)
#define LAS __attribute__((address_space(3)))
__device__ __forceinline__ unsigned xb_ld(unsigned* p) { return __hip_atomic_load(p, __ATOMIC_RELAXED, __HIP_MEMORY_SCOPE_AGENT); }
__device__ __forceinline__ unsigned xb_add(unsigned* p, unsigned v) { return __hip_atomic_fetch_add(p, v, __ATOMIC_RELAXED, __HIP_MEMORY_SCOPE_AGENT); }
__device__ __forceinline__ unsigned xb_xcc_id() { return (unsigned)__builtin_amdgcn_s_getreg((3 << 11) | 20) & 0xFu; }
#define XB_SPIN(cond, bar)                                                                    \
  do {                                                                                        \
    unsigned _sp = 0;                                                                         \
    while (cond) {                                                                            \
      __builtin_amdgcn_s_sleep(1);                                                            \
      if ((++_sp & 255u) == 0u) {                                                             \
        if (xb_ld(&(bar)[XB_TMO])) break;                                                     \
        if (_sp > XB_SPIN_CAP) { atomicAdd(&(bar)[XB_TMO], 1u); break; }                      \
      }                                                                                       \
    }                                                                                         \
  } while (0)
struct XcdBarrier { unsigned* bar; unsigned x; volatile LAS unsigned* st; };
__device__ __forceinline__ XcdBarrier xcd_barrier_post(unsigned* bar, volatile LAS unsigned* st) {
  XcdBarrier b; b.bar = bar; b.x = xb_xcc_id(); b.st = st;
  if (threadIdx.x == 0) (void)xb_add(&bar[XB_XCNT(b.x)], 1u);
  return b;
}
__device__ __forceinline__ void xcd_barrier_complete(unsigned* bar, unsigned x, unsigned& nloc, unsigned& nx) {
  const unsigned G = gridDim.x * gridDim.y * gridDim.z;
  unsigned sum, cnt, mine, sp = 0u;
  for (;;) {
    sum = 0u; cnt = 0u; mine = 0u;
#pragma unroll
    for (unsigned j = 0; j < 16; ++j) { const unsigned c = xb_ld(&bar[XB_XCNT(j)]); sum += c; cnt += (c > 0u) ? 1u : 0u; mine = (j == x) ? c : mine; }
    if (sum == G) break;
    __builtin_amdgcn_s_sleep(1);
    if ((++sp & 255u) == 0u) { if (xb_ld(&bar[XB_TMO])) break; if (sp > XB_SPIN_CAP) { atomicAdd(&bar[XB_TMO], 1u); break; } }
  }
  nloc = mine > 0u ? mine : 1u; nx = cnt > 0u ? cnt : 1u;
}
__device__ __forceinline__ void xcd_barrier(const XcdBarrier& b) {
  asm volatile("s_waitcnt vmcnt(0)" ::: "memory");
  __syncthreads();
  if (threadIdx.x == 0) {
    unsigned* bar = b.bar;
    __builtin_amdgcn_s_waitcnt(0);
    unsigned nloc = b.st[0], nx = b.st[1];
    if (nloc == 0u) { xcd_barrier_complete(bar, b.x, nloc, nx); b.st[0] = nloc; b.st[1] = nx; }
    const unsigned old = xb_add(&bar[XB_XSUB(b.x)], 1u);
    const unsigned gen = old / nloc;
    if (old + 1u == (gen + 1u) * nloc) {
      __builtin_amdgcn_fence(__ATOMIC_RELEASE, "agent");
      asm volatile("s_waitcnt vmcnt(0)" ::: "memory");
      const unsigned og = xb_add(&bar[XB_TOP], 1u);
      const unsigned tg = og / nx;
      if (og + 1u == (tg + 1u) * nx) xb_add(&bar[XB_TOPGEN], 1u);
      else XB_SPIN(xb_ld(&bar[XB_TOPGEN]) == tg, bar);
      __builtin_amdgcn_fence(__ATOMIC_ACQUIRE, "agent");
      xb_add(&bar[XB_XGEN(b.x)], 1u);
      asm volatile("s_waitcnt vmcnt(0)" ::: "memory");
    } else {
      XB_SPIN(xb_ld(&bar[XB_XGEN(b.x)]) == gen, bar);
      __builtin_amdgcn_fence(__ATOMIC_ACQUIRE, "agent");
      asm volatile("s_waitcnt vmcnt(0)" ::: "memory");
    }
  }
  __syncthreads();
}

enum { PH_SETUP = 0, PH_NORM1, PH_PROJ, PH_CONV, PH_SCAN, PH_POST, PH_MERGE, PH_OUT, PH_NORM2, PH_FFN1, PH_FFN2, PH_FINAL };

__device__ __forceinline__ void run_phase(const Params& p, int ph, int l, char* smem) {
  switch (ph) {
    case PH_SETUP: phase_setup(p, smem); break;
    case PH_NORM1: phase_norm(p, l, 0); break;
    case PH_PROJ: phase_gemm<G_PROJ>(p, l, smem); break;
    case PH_CONV: phase_conv(p, l, blockIdx.x, gridDim.x); break;
    case PH_SCAN: phase_scan_naive(p, l, smem); break;
    case PH_POST: phase_post(p, l); break;
    case PH_MERGE: phase_gemm<G_MERGE>(p, l, smem); break;
    case PH_OUT: phase_gemm<G_OUT>(p, l, smem); break;
    case PH_NORM2: phase_norm(p, l, 1); break;
    case PH_FFN1: phase_gemm<G_FFN1>(p, l, smem); break;
    case PH_FFN2: phase_gemm<G_FFN2>(p, l, smem); break;
    case PH_FINAL: phase_final_norm(p); break;
  }
}

extern __shared__ __attribute__((aligned(16))) char dyn_smem[];

#if !MEGA
__global__ void __launch_bounds__(256, 2) phase_kernel(Params p, int ph, int l) { run_phase(p, ph, l, dyn_smem); }
#endif

#if MEGA
__global__ void __launch_bounds__(256, 2) mega_kernel(Params p) {
  cg::grid_group grid = cg::this_grid();
  __shared__ uint4 xb_words;
  if (threadIdx.x == 0) xb_words = make_uint4(0u, 0u, 0u, 0u);
  __syncthreads();
  XcdBarrier xb = xcd_barrier_post((unsigned*)(p.ws + OFF_BAR), (volatile LAS unsigned*)&xb_words);
  phase_setup(p, dyn_smem);
  grid.sync();
  for (int l = 0; l < DEPTH; ++l) {
#pragma unroll 1
    for (int ph = 0; ph < 10; ++ph) {
      switch (ph) {
        case 0: phase_norm(p, l, 0); break;
        case 1: phase_gemm<G_PROJ>(p, l, dyn_smem); break;
        case 2:
          if (blockIdx.x < 64) hgrn_chunk_item(p, l, 32 * 16 + blockIdx.x, dyn_smem, 0, 32);
          else phase_conv(p, l, blockIdx.x - 64, gridDim.x - 64);
          break;
        case 3: phase_scan1(p, l, dyn_smem); break;
        case 4: phase_scan2(p, l, dyn_smem); phase_post(p, l); break;
        case 5: phase_gemm<G_MERGE>(p, l, dyn_smem); break;
        case 6: phase_gemm<G_OUT>(p, l, dyn_smem); break;
        case 7: phase_norm(p, l, 1); break;
        case 8: phase_gemm<G_FFN1>(p, l, dyn_smem); break;
        default: phase_gemm<G_FFN2>(p, l, dyn_smem); break;
      }
      xcd_barrier(xb);
    }
  }
  phase_final_norm(p);
}
#endif

extern "C" void kernel_launch(void* const* d_in, const int* in_sizes, int n_in, void* d_out, int out_size, void* d_ws, size_t ws_size,
                              hipStream_t stream) {
  static int grid_blocks = 0;
  if (!grid_blocks) {
    int dev = 0, cus = 0, per_cu = 0;
    (void)hipGetDevice(&dev);
    (void)hipDeviceGetAttribute(&cus, hipDeviceAttributeMultiprocessorCount, dev);
#if MEGA
    (void)hipFuncSetAttribute((const void*)mega_kernel, hipFuncAttributeMaxDynamicSharedMemorySize, SMEM_BYTES);
#endif
#if !MEGA
    (void)hipFuncSetAttribute((const void*)phase_kernel, hipFuncAttributeMaxDynamicSharedMemorySize, SMEM_BYTES);
#endif
#if MEGA
    (void)hipOccupancyMaxActiveBlocksPerMultiprocessor(&per_cu, mega_kernel, 256, SMEM_BYTES);
#else
    (void)hipOccupancyMaxActiveBlocksPerMultiprocessor(&per_cu, phase_kernel, 256, SMEM_BYTES);
#endif
    per_cu = 2;
    grid_blocks = cus * per_cu;
  }
  Params p{};
  const float** pf = (const float**)&p;
  for (int i = 0; i < 26; ++i) pf[i] = (const float*)d_in[i];
  p.out = (float*)d_out;
  p.ws = (char*)d_ws;
#if MEGA
  (void)hipMemsetAsync((char*)d_ws + OFF_BAR, 0, XCD_BAR_WORDS * 4, stream);
  void* args[] = {&p};
  hipError_t e = hipLaunchCooperativeKernel((void*)mega_kernel, dim3(grid_blocks), dim3(256), args, SMEM_BYTES, stream);
  if (e != hipSuccess) fprintf(stderr, "coop launch failed: %s\n", hipGetErrorString(e));
#else
  const int G = grid_blocks;
  phase_kernel<<<G, 256, SMEM_BYTES, stream>>>(p, PH_SETUP, 0);
  for (int l = 0; l < DEPTH; ++l)
    for (int ph = PH_NORM1; ph <= PH_FFN2; ++ph) phase_kernel<<<G, 256, SMEM_BYTES, stream>>>(p, ph, l);
  phase_kernel<<<G, 256, SMEM_BYTES, stream>>>(p, PH_FINAL, 0);
#endif
}
```
